# Optimizing an MI355X kernel written in HIP

```python
import math
import jax, jax.numpy as jnp
from jax import lax
import numpy as np

D_MODEL = 1024
BATCH = 16
SEQ = 256
DEPTH = 2
DEC_BATCH = 2
DEC_SEQ = 4096
PAST_LEN = 512

GRID_W = 64
HEAD_DIM = 64
ROPE_FREQS = HEAD_DIM // 4
ROPE_BASE = 10000.0
EPS = 1e-6
NEG_INF = -1e30
Q_BLOCK = 128
WINDOW = 128
BAND = Q_BLOCK + 2 * WINDOW
A_WIDTH = D_MODEL // 2
B_WIDTH = D_MODEL // 2
POOL_WINDOWS = (2, 4, 8, 16)
N_POOL_GROUPS = len(POOL_WINDOWS)
POOL_GW = A_WIDTH // N_POOL_GROUPS
N_FFT_GROUPS = 4
FFT_GW = B_WIDTH // N_FFT_GROUPS
EVEN_WIDTH = A_WIDTH + B_WIDTH
C_HEADS = D_MODEL // 256
D_HEADS = D_MODEL // 128
D_KV_HEADS = 2
D_GROUP = D_HEADS // D_KV_HEADS
C_Q = C_HEADS * 2 * HEAD_DIM
C_K = C_HEADS * 2 * HEAD_DIM
C_V = C_HEADS * 2 * HEAD_DIM
D_Q = D_HEADS * HEAD_DIM
D_K = D_KV_HEADS * HEAD_DIM
D_V = D_KV_HEADS * HEAD_DIM
ODD_SPLITS = (C_Q, C_Q + C_K, C_Q + C_K + C_V, C_Q + C_K + C_V + D_Q, C_Q + C_K + C_V + D_Q + D_K)
ODD_IN = C_Q + C_K + C_V + D_Q + D_K + D_V
ODD_OUT = C_V + D_Q
D_FF = 4 * D_MODEL
N_EVEN = (DEPTH + 1) // 2
N_ODD = DEPTH // 2
ATTN_SCALE = HEAD_DIM ** -0.5

kernel_name = "hybrid_diffusion_prefix_trunk_step"


def _rms(x, g):
    xf = x.astype(jnp.float32)
    y = xf * lax.rsqrt(jnp.mean(xf * xf, axis=-1, keepdims=True) + EPS)
    return y.astype(x.dtype) * g


def _adaln(cond, w, b):
    m = jax.nn.silu(cond) @ w + b
    return jnp.split(m[:, None, :], 6, axis=-1)


def _channel_mixer(h, w1, w2):
    return jnp.square(jax.nn.relu(h @ w1)) @ w2


def _pool_mix(u, w_pool, scale):
    B, N, _ = u.shape
    ug = u.reshape(B, N, N_POOL_GROUPS, POOL_GW)
    cs = jnp.concatenate([jnp.zeros((B, 1, N_POOL_GROUPS, POOL_GW), jnp.float32),
                          jnp.cumsum(ug.astype(jnp.float32), axis=1)], axis=1)
    t = jnp.arange(N)
    outs = []
    for gi, w in enumerate(POOL_WINDOWS):
        lo = jnp.clip(t - w // 2, 0, N)
        hi = jnp.clip(t + w // 2, 0, N)
        csg = cs[:, :, gi]
        cnt = (hi - lo).astype(jnp.float32)
        outs.append((csg[:, hi] - csg[:, lo]) / cnt[None, :, None])
    pooled = jnp.stack(outs, axis=2).astype(u.dtype) - ug
    y = jnp.einsum('bngc,gcd->bngd', pooled, w_pool)
    return y.reshape(B, N, A_WIDTH) * scale


def _fourier_mix(u, w_fft):
    B, N, _ = u.shape
    uf = u.reshape(B, N, N_FFT_GROUPS, FFT_GW).astype(jnp.float32)
    f = jnp.fft.fft2(uf, axes=(1, 3)).real * ((N * FFT_GW) ** -0.5)
    y = jnp.einsum('bngc,gcd->bngd', f.astype(u.dtype), w_fft)
    return y.reshape(B, N, B_WIDTH)


def _even_mixer(h, w_in, w_pool, pool_scale, w_fft, w_out):
    u = h @ w_in
    a = _pool_mix(u[..., :A_WIDTH], w_pool, pool_scale)
    b = _fourier_mix(u[..., A_WIDTH:], w_fft)
    return jnp.concatenate([a, b], axis=-1) @ w_out


def _axial_rope(n):
    rows = n // GRID_W
    row = jnp.repeat(jnp.arange(rows), GRID_W).astype(jnp.float32)
    col = jnp.tile(jnp.arange(GRID_W), rows).astype(jnp.float32)
    freqs = ROPE_BASE ** (-jnp.arange(ROPE_FREQS, dtype=jnp.float32) / ROPE_FREQS)
    ang = jnp.stack([row[:, None] * freqs, col[:, None] * freqs], axis=1)
    ang = jnp.concatenate([ang, ang], axis=-1).reshape(n, HEAD_DIM)
    return jnp.cos(ang), jnp.sin(ang)


def _apply_rope(x, cos, sin):
    shp = x.shape
    xa = x.reshape(shp[:-1] + (2, 2, ROPE_FREQS))
    rot = jnp.stack([-xa[..., 1, :], xa[..., 0, :]], axis=-2).reshape(shp)
    bshape = (1, shp[1]) + (1,) * (x.ndim - 3) + (HEAD_DIM,)
    return x * cos.reshape(bshape).astype(x.dtype) + rot * sin.reshape(bshape).astype(x.dtype)


def _odd_qkv(h, w_in, c_qn, c_kn, d_qn, d_kn):
    B, N, _ = h.shape
    cq, ck, cv, dq, dk, dv = jnp.split(h @ w_in, ODD_SPLITS, axis=-1)
    cq = _rms(cq.reshape(B, N, C_HEADS, 2, HEAD_DIM), c_qn)
    ck = _rms(ck.reshape(B, N, C_HEADS, 2, HEAD_DIM), c_kn)
    cv = cv.reshape(B, N, C_HEADS, 2 * HEAD_DIM)
    dq = _rms(dq.reshape(B, N, D_KV_HEADS, D_GROUP, HEAD_DIM), d_qn)
    dk = _rms(dk.reshape(B, N, D_KV_HEADS, HEAD_DIM), d_kn)
    dv = dv.reshape(B, N, D_KV_HEADS, HEAD_DIM)
    return cq, ck, cv, dq, dk, dv


def _map_query_blocks(fn, q):
    B, N = q.shape[0], q.shape[1]
    nb = N // Q_BLOCK
    qb = jnp.moveaxis(q.reshape((B, nb, Q_BLOCK) + q.shape[2:]), 1, 0)
    out = lax.map(lambda args: fn(*args), (jnp.arange(nb), qb))
    out = jnp.moveaxis(out, 0, 1)
    return out.reshape((B, N) + out.shape[3:])


def _diff_lambda(lq1, lk1, lq2, lk2, lam_init):
    f = jnp.float32
    return (jnp.exp(jnp.sum(lq1.astype(f) * lk1.astype(f))) -
            jnp.exp(jnp.sum(lq2.astype(f) * lk2.astype(f))) + lam_init)


def _diff_attend_block(qb, k, v, lam):
    s = jnp.einsum('bqhcd,bkhcd->bhcqk', qb, k).astype(jnp.float32) * ATTN_SCALE
    p = jax.nn.softmax(s, axis=-1)
    p = p[:, :, 0] - lam * p[:, :, 1]
    return jnp.einsum('bhqk,bkhe->bqhe', p.astype(v.dtype), v)


def _sink_attend_block(qb, k, v, sink, mask):
    s = jnp.einsum('bqjgd,bkjd->bjgqk', qb, k).astype(jnp.float32) * ATTN_SCALE
    if mask is not None:
        s = jnp.where(mask, s, NEG_INF)
    sk = jnp.broadcast_to(sink.astype(jnp.float32)[None, :, :, None, None], s.shape[:-1] + (1,))
    p = jax.nn.softmax(jnp.concatenate([s, sk], axis=-1), axis=-1)[..., :-1]
    return jnp.einsum('bjgqk,bkjd->bqjgd', p.astype(v.dtype), v)


def _window_attention(q, k, v, ctx_k, ctx_v, sink):
    N = q.shape[1]
    L = ctx_k.shape[1]
    pad = ((0, 0), (WINDOW, WINDOW), (0, 0), (0, 0))
    kp = jnp.pad(k, pad)
    vp = jnp.pad(v, pad)
    qq = jnp.arange(Q_BLOCK)[:, None]
    kk = jnp.arange(BAND)[None, :]
    band_ok = jnp.abs(qq + WINDOW - kk) <= WINDOW
    ctx_ok = jnp.ones((Q_BLOCK, L), bool)

    def fn(b, qb):
        start = b * Q_BLOCK
        kb = lax.dynamic_slice_in_dim(kp, start, BAND, axis=1)
        vb = lax.dynamic_slice_in_dim(vp, start, BAND, axis=1)
        jpos = start - WINDOW + kk
        valid = band_ok & (jpos >= 0) & (jpos < N)
        mask = jnp.concatenate([ctx_ok, valid], axis=1)
        return _sink_attend_block(qb, jnp.concatenate([ctx_k, kb], axis=1),
                                  jnp.concatenate([ctx_v, vb], axis=1), sink, mask)

    return _map_query_blocks(fn, q)


def _odd_output(c_out, d_out, subln_g, lam_init, w_out):
    B, N = c_out.shape[0], c_out.shape[1]
    c = (_rms(c_out, subln_g) * (1.0 - lam_init)).reshape(B, N, C_V)
    d = d_out.reshape(B, N, D_Q)
    return jnp.concatenate([c, d], axis=-1) @ w_out


def _lam_init(layer):
    return 0.8 - 0.6 * math.exp(-0.3 * layer)


def setup_inputs(seed: int = 0) -> dict:
    key = jax.random.key(seed)
    ks = iter(jax.random.split(key, 40))
    f = jnp.float32

    def nrm(shape, s):
        return jax.random.normal(next(ks), shape, f) * s

    def gain(shape):
        return 1.0 + nrm(shape, 0.02)

    return {
        "x_prompt": nrm((BATCH, SEQ, D_MODEL), 1.0),
        "x_sample": nrm((DEC_BATCH, DEC_SEQ, D_MODEL), 1.0),
        "c": nrm((DEC_BATCH, D_MODEL), 1.0),
        "cache_c_k": nrm((DEC_BATCH, N_ODD, PAST_LEN, C_HEADS, 2, HEAD_DIM), 1.0),
        "cache_c_v": nrm((DEC_BATCH, N_ODD, PAST_LEN, C_HEADS, 2 * HEAD_DIM), 1.0),
        "cache_d_k": nrm((DEC_BATCH, N_ODD, PAST_LEN, D_KV_HEADS, HEAD_DIM), 1.0),
        "cache_d_v": nrm((DEC_BATCH, N_ODD, PAST_LEN, D_KV_HEADS, HEAD_DIM), 1.0),
        "c_ctx": nrm((D_MODEL,), 1.0),
        "norm1_g": gain((DEPTH, D_MODEL)),
        "norm2_g": gain((DEPTH, D_MODEL)),
        "w_ada": nrm((DEPTH, D_MODEL, 6 * D_MODEL), 0.5 * D_MODEL ** -0.5),
        "b_ada": nrm((DEPTH, 6 * D_MODEL), 0.01),
        "w_in_even": nrm((N_EVEN, D_MODEL, EVEN_WIDTH), D_MODEL ** -0.5),
        "w_pool": nrm((N_EVEN, N_POOL_GROUPS, POOL_GW, POOL_GW), POOL_GW ** -0.5),
        "pool_scale": gain((N_EVEN, A_WIDTH)),
        "w_fft": nrm((N_EVEN, N_FFT_GROUPS, FFT_GW, FFT_GW), FFT_GW ** -0.5),
        "w_out_even": nrm((N_EVEN, EVEN_WIDTH, D_MODEL), EVEN_WIDTH ** -0.5),
        "w_in_odd": nrm((N_ODD, D_MODEL, ODD_IN), D_MODEL ** -0.5),
        "c_qn_g": gain((N_ODD, HEAD_DIM)),
        "c_kn_g": gain((N_ODD, HEAD_DIM)),
        "lam_q1": nrm((N_ODD, HEAD_DIM), 0.1),
        "lam_k1": nrm((N_ODD, HEAD_DIM), 0.1),
        "lam_q2": nrm((N_ODD, HEAD_DIM), 0.1),
        "lam_k2": nrm((N_ODD, HEAD_DIM), 0.1),
        "c_subln_g": gain((N_ODD, 2 * HEAD_DIM)),
        "d_qn_g": gain((N_ODD, HEAD_DIM)),
        "d_kn_g": gain((N_ODD, HEAD_DIM)),
        "d_sink": nrm((N_ODD, D_HEADS), 0.5),
        "w_out_odd": nrm((N_ODD, ODD_OUT, D_MODEL), ODD_OUT ** -0.5),
        "w_mlp1": nrm((DEPTH, D_MODEL, D_FF), D_MODEL ** -0.5),
        "w_mlp2": nrm((DEPTH, D_FF, D_MODEL), D_FF ** -0.5),
    }


def reference(x_prompt, x_sample, c, cache_c_k, cache_c_v, cache_d_k, cache_d_v, c_ctx,
              norm1_g, norm2_g, w_ada, b_ada, w_in_even, w_pool, pool_scale, w_fft, w_out_even,
              w_in_odd, c_qn_g, c_kn_g, lam_q1, lam_k1, lam_q2, lam_k2, c_subln_g,
              d_qn_g, d_kn_g, d_sink, w_out_odd, w_mlp1, w_mlp2):
    x = x_prompt
    cond_ctx = c_ctx[None, :]
    st_ck, st_cv, st_dk, st_dv = [], [], [], []
    for l in range(DEPTH):
        sh1, sc1, g1, sh2, sc2, g2 = _adaln(cond_ctx, w_ada[l], b_ada[l])
        h = _rms(x, norm1_g[l]) * (1.0 + sc1) + sh1
        if l % 2 == 0:
            e = l // 2
            mix = _even_mixer(h, w_in_even[e], w_pool[e], pool_scale[e], w_fft[e], w_out_even[e])
        else:
            o = l // 2
            cq, ck, cv, dq, dk, dv = _odd_qkv(h, w_in_odd[o], c_qn_g[o], c_kn_g[o], d_qn_g[o], d_kn_g[o])
            lam = _diff_lambda(lam_q1[o], lam_k1[o], lam_q2[o], lam_k2[o], _lam_init(l))
            sink = d_sink[o].reshape(D_KV_HEADS, D_GROUP)
            c_out = _map_query_blocks(lambda b, qb: _diff_attend_block(qb, ck, cv, lam), cq)
            d_out = _map_query_blocks(lambda b, qb: _sink_attend_block(qb, dk, dv, sink, None), dq)
            mix = _odd_output(c_out, d_out, c_subln_g[o], _lam_init(l), w_out_odd[o])
            st_ck.append(ck)
            st_cv.append(cv)
            st_dk.append(dk)
            st_dv.append(dv)
        x = x + g1 * mix
        h = _rms(x, norm2_g[l]) * (1.0 + sc2) + sh2
        x = x + g2 * _channel_mixer(h, w_mlp1[l], w_mlp2[l])
    y_prompt = x
    new_c_k = jnp.stack(st_ck, axis=1)
    new_c_v = jnp.stack(st_cv, axis=1)
    new_d_k = jnp.stack(st_dk, axis=1)
    new_d_v = jnp.stack(st_dv, axis=1)

    x = x_sample
    n_lat = x.shape[1]
    cos, sin = _axial_rope(n_lat)
    for l in range(DEPTH):
        sh1, sc1, g1, sh2, sc2, g2 = _adaln(c, w_ada[l], b_ada[l])
        h = _rms(x, norm1_g[l]) * (1.0 + sc1) + sh1
        if l % 2 == 0:
            e = l // 2
            mix = _even_mixer(h, w_in_even[e], w_pool[e], pool_scale[e], w_fft[e], w_out_even[e])
        else:
            o = l // 2
            cq, ck, cv, dq, dk, dv = _odd_qkv(h, w_in_odd[o], c_qn_g[o], c_kn_g[o], d_qn_g[o], d_kn_g[o])
            cq = _apply_rope(cq, cos, sin)
            ck = _apply_rope(ck, cos, sin)
            dq = _apply_rope(dq, cos, sin)
            dk = _apply_rope(dk, cos, sin)
            lam = _diff_lambda(lam_q1[o], lam_k1[o], lam_q2[o], lam_k2[o], _lam_init(l))
            sink = d_sink[o].reshape(D_KV_HEADS, D_GROUP)
            k_all = jnp.concatenate([cache_c_k[:, o], ck], axis=1)
            v_all = jnp.concatenate([cache_c_v[:, o], cv], axis=1)
            c_out = _map_query_blocks(lambda b, qb: _diff_attend_block(qb, k_all, v_all, lam), cq)
            d_out = _window_attention(dq, dk, dv, cache_d_k[:, o], cache_d_v[:, o], sink)
            mix = _odd_output(c_out, d_out, c_subln_g[o], _lam_init(l), w_out_odd[o])
        x = x + g1 * mix
        h = _rms(x, norm2_g[l]) * (1.0 + sc2) + sh2
        x = x + g2 * _channel_mixer(h, w_mlp1[l], w_mlp2[l])
    y_sample = x
    return (y_prompt, y_sample, new_c_k, new_c_v, new_d_k, new_d_v)
```

```cpp
#include <hip/hip_runtime.h>
#include <hip/hip_cooperative_groups.h>
#include <cstdio>
namespace cg = cooperative_groups;

#ifndef ONE_LAUNCH
#define ONE_LAUNCH 1
#endif

#ifndef ONLYPH
#define ONLYPH -1
#endif
typedef unsigned short u16;
typedef short bf16x8 __attribute__((ext_vector_type(8)));
typedef float f32x16 __attribute__((ext_vector_type(16)));
typedef __bf16 bf2_t __attribute__((ext_vector_type(2)));
typedef float f2_t __attribute__((ext_vector_type(2)));

#define DI __device__ __forceinline__

constexpr int T = 12288, TP = 4096, DM = 1024;
constexpr int NPH = 17;
constexpr float EPS = 1e-6f;
constexpr float LOG2E = 1.4426950408889634f;
constexpr float QSCALE = 0.125f * LOG2E;
constexpr float LAM_INIT = 0.35550906759f;

constexpr size_t al(size_t x) { return (x + 255) & ~size_t(255); }
constexpr size_t OFF_MODS   = 0;
constexpr size_t OFF_WIN_E  = OFF_MODS + al(2 * 3 * 6144 * 4);
constexpr size_t OFF_WINB   = OFF_WIN_E + al(1536 * 1024 * 2);
constexpr size_t OFF_CBD    = OFF_WINB + al(1024 * 512 * 2);
constexpr size_t OFF_WOUT_ET= OFF_CBD + al(1024 * 512 * 2);
constexpr size_t OFF_BD     = OFF_WOUT_ET + al(1024 * 1024 * 2);
constexpr size_t OFF_WOUT_E = OFF_BD + al(1024 * 1024 * 2);
constexpr size_t OFF_WIN_O  = OFF_WOUT_E + al(1024 * 1024 * 2);
constexpr size_t OFF_WOUT_O = OFF_WIN_O + al(2304 * 1024 * 2);
constexpr size_t OFF_W1     = OFF_WOUT_O + al(1024 * 1024 * 2);
constexpr size_t OFF_W2     = OFF_W1 + al(2 * 4096 * 1024 * 2);
constexpr size_t OFF_D256   = OFF_W2 + al(2 * 4096 * 1024 * 2);
constexpr size_t OFF_H      = OFF_D256 + al(256 * 512 * 2);
constexpr size_t OFF_R2     = OFF_H + al((size_t)T * 1024 * 2);
constexpr size_t R2_BYTES   = (size_t)T * 512 * 2 + (size_t)T * 1024 * 2 * 2;
constexpr size_t OFF_R1     = OFF_R2 + al(R2_BYTES);
constexpr size_t R1_BYTES   = (size_t)T * 4096 * 2;
constexpr size_t WS_END     = OFF_R1 + R1_BYTES;
constexpr size_t OFF_UA  = OFF_R2;
constexpr size_t OFF_PQT = OFF_UA + (size_t)T * 512 * 2;
constexpr size_t OFF_AB  = OFF_PQT + (size_t)T * 1024 * 2;
constexpr size_t OFF_CQ   = OFF_R2;
constexpr size_t OFF_DQ   = OFF_CQ + (size_t)T * 512 * 2;
constexpr size_t OFF_CKP  = OFF_DQ + (size_t)T * 512 * 2;
constexpr size_t OFF_CKS  = OFF_CKP + (size_t)16 * 8 * 256 * 64 * 2;
constexpr size_t OFF_CVTP = OFF_CKS + (size_t)2 * 8 * 4608 * 64 * 2;
constexpr size_t OFF_CVTS = OFF_CVTP + (size_t)16 * 4 * 128 * 256 * 2;
constexpr size_t OFF_DKP  = OFF_CVTS + (size_t)2 * 4 * 128 * 4608 * 2;
constexpr size_t OFF_DKS  = OFF_DKP + (size_t)16 * 2 * 256 * 64 * 2;
constexpr size_t OFF_DVTP = OFF_DKS + (size_t)2 * 2 * 4608 * 64 * 2;
constexpr size_t OFF_DVTS = OFF_DVTP + (size_t)16 * 2 * 64 * 256 * 2;
constexpr size_t R2_LATE_END = OFF_DVTS + (size_t)2 * 2 * 64 * 4608 * 2;
static_assert(R2_LATE_END <= OFF_R2 + R2_BYTES, "R2 overflow");
constexpr size_t OFF_D4096 = OFF_R1;
constexpr size_t OFF_M1    = OFF_R1;
constexpr size_t OFF_QKV   = OFF_R1;
constexpr size_t OFF_OM    = OFF_R1 + al((size_t)T * 2304 * 2);
static_assert(OFF_OM + (size_t)T * 1024 * 2 <= WS_END, "R1 overflow");

constexpr size_t OUT_Y   = 0;
constexpr size_t OUT_NCK = (size_t)T * 1024;
constexpr size_t OUT_NCV = OUT_NCK + (size_t)TP * 512;
constexpr size_t OUT_NDK = OUT_NCV + (size_t)TP * 512;
constexpr size_t OUT_NDV = OUT_NDK + (size_t)TP * 128;

struct Params {
  const float* in[31];
  float* out;
  unsigned char* ws;
};

DI float bf2f(u16 v) { return __uint_as_float(((unsigned)v) << 16); }
DI unsigned pack2(float a, float b) { f2_t f = {a, b}; bf2_t v = __builtin_convertvector(f, bf2_t); return __builtin_bit_cast(unsigned, v); }
DI u16 f2bf(float a) { return (u16)(pack2(a, 0.f) & 0xffffu); }
DI int cond_of(int m) { return m < 4096 ? 0 : (m < 8192 ? 1 : 2); }
DI float wave_sum(float v) {
#pragma unroll
  for (int o = 32; o >= 1; o >>= 1) v += __shfl_xor(v, o);
  return v;
}
#define MFMA(a, b, c) __builtin_amdgcn_mfma_f32_32x32x16_bf16((a), (b), (c), 0, 0, 0)

constexpr int LROW = 144;
constexpr int GEMM_BUF = 2 * 128 * LROW;
constexpr int LDS_BYTES = 2 * GEMM_BUF;

template <class Epi>
DI void gemm_tile(const u16* A, int lda, const u16* Bt, int ldb, int K, int m0, int n0, Epi epi, char* lds) {
  const int tid = threadIdx.x, lane = tid & 63, wave = tid >> 6;
  const int r = lane & 31, h = lane >> 5;
  const int wm = wave >> 1, wn = wave & 1;
  const int lrow = tid >> 3, lcol = (tid & 7) * 8;
  const u16* ga = A + (size_t)(m0 + lrow) * lda + lcol;
  const u16* gb = Bt + (size_t)(n0 + lrow) * ldb + lcol;
  uint4 ra[4], rb[4];
  f32x16 acc[2][2];
#pragma unroll
  for (int i = 0; i < 2; ++i)
#pragma unroll
    for (int j = 0; j < 2; ++j)
#pragma unroll
      for (int e = 0; e < 16; ++e) acc[i][j][e] = 0.f;
#pragma unroll
  for (int i = 0; i < 4; ++i) {
    ra[i] = *(const uint4*)(ga + (size_t)(32 * i) * lda);
    rb[i] = *(const uint4*)(gb + (size_t)(32 * i) * ldb);
  }
  char* sw = lds + lrow * LROW + lcol * 2;
#pragma unroll
  for (int i = 0; i < 4; ++i) {
    *(uint4*)(sw + (32 * i) * LROW) = ra[i];
    *(uint4*)(sw + 128 * LROW + (32 * i) * LROW) = rb[i];
  }
  __syncthreads();
  const int nk = K >> 6;
  const char* fa = lds + (wm * 64 + r) * LROW + h * 16;
  const char* fb = lds + 128 * LROW + (wn * 64 + r) * LROW + h * 16;
  for (int kt = 0; kt < nk; ++kt) {
    const int cur = (kt & 1) * GEMM_BUF;
    if (kt + 1 < nk) {
      const int k0 = (kt + 1) << 6;
#pragma unroll
      for (int i = 0; i < 4; ++i) {
        ra[i] = *(const uint4*)(ga + (size_t)(32 * i) * lda + k0);
        rb[i] = *(const uint4*)(gb + (size_t)(32 * i) * ldb + k0);
      }
    }
#pragma unroll
    for (int ks = 0; ks < 4; ++ks) {
      bf16x8 a0 = *(const bf16x8*)(fa + cur + ks * 32);
      bf16x8 a1 = *(const bf16x8*)(fa + cur + 32 * LROW + ks * 32);
      bf16x8 b0 = *(const bf16x8*)(fb + cur + ks * 32);
      bf16x8 b1 = *(const bf16x8*)(fb + cur + 32 * LROW + ks * 32);
      acc[0][0] = MFMA(a0, b0, acc[0][0]);
      acc[0][1] = MFMA(a0, b1, acc[0][1]);
      acc[1][0] = MFMA(a1, b0, acc[1][0]);
      acc[1][1] = MFMA(a1, b1, acc[1][1]);
    }
    if (kt + 1 < nk) {
      const int nxt = GEMM_BUF - cur;
#pragma unroll
      for (int i = 0; i < 4; ++i) {
        *(uint4*)(sw + nxt + (32 * i) * LROW) = ra[i];
        *(uint4*)(sw + nxt + 128 * LROW + (32 * i) * LROW) = rb[i];
      }
    }
    __syncthreads();
  }
#pragma unroll
  for (int i = 0; i < 2; ++i)
#pragma unroll
    for (int j = 0; j < 2; ++j)
#pragma unroll
      for (int q = 0; q < 4; ++q) {
        const int m = m0 + wm * 64 + i * 32 + 8 * q + 4 * h;
        const int n = n0 + wn * 64 + j * 32 + r;
        epi(m, n, acc[i][j][4 * q], acc[i][j][4 * q + 1], acc[i][j][4 * q + 2], acc[i][j][4 * q + 3]);
      }
}

struct EpiBf16 {
  u16* C; int ldc;
  DI void operator()(int m, int n, float v0, float v1, float v2, float v3) const {
    u16* p = C + (size_t)m * ldc + n;
    p[0] = f2bf(v0); p[ldc] = f2bf(v1); p[2 * ldc] = f2bf(v2); p[3 * ldc] = f2bf(v3);
  }
};
struct EpiU {
  u16* UA; u16* PQt;
  DI void operator()(int m, int n, float v0, float v1, float v2, float v3) const {
    if (n < 512) {
      u16* p = UA + (size_t)m * 512 + n;
      p[0] = f2bf(v0); p[512] = f2bf(v1); p[1024] = f2bf(v2); p[1536] = f2bf(v3);
    } else {
      const int np = n - 512, g = np >> 8, pq = (np >> 7) & 1, mm = np & 127;
      size_t off;
      if (m < 4096) { const int b = m >> 8, nl = m & 255; off = ((size_t)(b * 512 + g * 128 + mm)) * 512 + pq * 256 + nl; }
      else { const int ms = m - 4096, b = ms >> 12, nl = ms & 4095; off = (size_t)16 * 512 * 512 + ((size_t)(b * 512 + g * 128 + mm)) * 8192 + pq * 4096 + nl; }
      uint2 w; w.x = pack2(v0, v1); w.y = pack2(v2, v3);
      *(uint2*)(PQt + off) = w;
    }
  }
};
struct EpiDft {
  u16* AB; int rowbase; float norm; int sample;
  DI void operator()(int m, int n, float v0, float v1, float v2, float v3) const {
    size_t row; int c;
    if (sample) { row = (size_t)4096 + (size_t)(n >> 9) * 4096 + m; c = n & 511; }
    else { row = (size_t)rowbase + m; c = n; }
    u16* p = AB + row * 1024 + 512 + c;
    p[0] = f2bf(v0 * norm); p[1024] = f2bf(v1 * norm); p[2048] = f2bf(v2 * norm); p[3072] = f2bf(v3 * norm);
  }
};
struct EpiRes {
  const float* xin_p; const float* xin_s;
  float* X; const float* gate;
  DI void operator()(int m, int n, float v0, float v1, float v2, float v3) const {
    const float* xi = (m < 4096) ? xin_p + (size_t)m * 1024 + n : xin_s + (size_t)(m - 4096) * 1024 + n;
    const float g = gate[cond_of(m) * 6144 + n];
    float* xo = X + (size_t)m * 1024 + n;
    xo[0] = xi[0] + g * v0; xo[1024] = xi[1024] + g * v1; xo[2048] = xi[2048] + g * v2; xo[3072] = xi[3072] + g * v3;
  }
};
struct EpiRelu2 {
  u16* C;
  DI void operator()(int m, int n, float v0, float v1, float v2, float v3) const {
    v0 = fmaxf(v0, 0.f); v1 = fmaxf(v1, 0.f); v2 = fmaxf(v2, 0.f); v3 = fmaxf(v3, 0.f);
    u16* p = C + (size_t)m * 4096 + n;
    p[0] = f2bf(v0 * v0); p[4096] = f2bf(v1 * v1); p[8192] = f2bf(v2 * v2); p[12288] = f2bf(v3 * v3);
  }
};
struct EpiQkv {
  u16* QKV; u16* CVtP; u16* CVtS; u16* DVtP; u16* DVtS; float* ncv; float* ndv;
  DI void operator()(int m, int n, float v0, float v1, float v2, float v3) const {
    const bool is_cv = (n >= 1024 && n < 1536), is_dv = (n >= 2176);
    if (!is_cv && !is_dv) {
      u16* p = QKV + (size_t)m * 2304 + n;
      p[0] = f2bf(v0); p[2304] = f2bf(v1); p[4608] = f2bf(v2); p[6912] = f2bf(v3);
      return;
    }
    uint2 w; w.x = pack2(v0, v1); w.y = pack2(v2, v3);
    if (is_cv) {
      const int c = n - 1024;
      if (m < 4096) {
        const int b = m >> 8, nl = m & 255;
        *(uint2*)(CVtP + ((size_t)(b * 512 + c)) * 256 + nl) = w;
        float* o = ncv + (size_t)m * 512 + c; o[0] = v0; o[512] = v1; o[1024] = v2; o[1536] = v3;
      } else {
        const int ms = m - 4096, b = ms >> 12, nl = ms & 4095;
        *(uint2*)(CVtS + ((size_t)(b * 512 + c)) * 4608 + 512 + nl) = w;
      }
    } else {
      const int c = n - 2176;
      if (m < 4096) {
        const int b = m >> 8, nl = m & 255;
        *(uint2*)(DVtP + ((size_t)(b * 128 + c)) * 256 + nl) = w;
        float* o = ndv + (size_t)m * 128 + c; o[0] = v0; o[128] = v1; o[256] = v2; o[384] = v3;
      } else {
        const int ms = m - 4096, b = ms >> 12, nl = ms & 4095;
        *(uint2*)(DVtS + ((size_t)(b * 128 + c)) * 4608 + 512 + nl) = w;
      }
    }
  }
};

DI void ada_item(const Params& p, int id, char* lds) {
  const int tid = threadIdx.x;
  float* ssil = (float*)lds;
  float* red = (float*)(lds + 12288);
  const int l = id / 96, cb = id % 96;
  for (int i = tid; i < 3072; i += 256) {
    const int j = i >> 10, k = i & 1023;
    const float v = (j == 0) ? p.in[7][k] : p.in[2][(j - 1) * 1024 + k];
    ssil[i] = v / (1.f + __expf(-v));
  }
  __syncthreads();
  const int cq = tid & 15, kg = tid >> 4;
  const float* w = p.in[10] + (size_t)l * 1024 * 6144 + cb * 64 + cq * 4;
  float4 a0 = {0, 0, 0, 0}, a1 = {0, 0, 0, 0}, a2 = {0, 0, 0, 0};
#pragma unroll 8
  for (int kk = 0; kk < 64; ++kk) {
    const int k = kg * 64 + kk;
    const float4 wv = *(const float4*)(w + (size_t)k * 6144);
    const float s0 = ssil[k], s1 = ssil[1024 + k], s2 = ssil[2048 + k];
    a0.x += s0 * wv.x; a0.y += s0 * wv.y; a0.z += s0 * wv.z; a0.w += s0 * wv.w;
    a1.x += s1 * wv.x; a1.y += s1 * wv.y; a1.z += s1 * wv.z; a1.w += s1 * wv.w;
    a2.x += s2 * wv.x; a2.y += s2 * wv.y; a2.z += s2 * wv.z; a2.w += s2 * wv.w;
  }
  float* rp = red + kg * 192 + cq * 4;
  rp[0] = a0.x; rp[1] = a0.y; rp[2] = a0.z; rp[3] = a0.w;
  rp[64] = a1.x; rp[65] = a1.y; rp[66] = a1.z; rp[67] = a1.w;
  rp[128] = a2.x; rp[129] = a2.y; rp[130] = a2.z; rp[131] = a2.w;
  __syncthreads();
  if (tid < 192) {
    const int j = tid >> 6, c = tid & 63;
    float s = 0.f;
#pragma unroll
    for (int g = 0; g < 16; ++g) s += red[g * 192 + j * 64 + c];
    const int col = cb * 64 + c;
    ((float*)(p.ws + OFF_MODS))[(size_t)(l * 3 + j) * 6144 + col] = s + p.in[11][l * 6144 + col];
  }
  __syncthreads();
}

DI void transpose_tile(const float* src, int ld_src, u16* dst, int ld_dst, int r0, int c0, char* lds) {
  float* tile = (float*)lds;
  const int tid = threadIdx.x;
  const int j = tid & 63, i0 = tid >> 6;
#pragma unroll
  for (int it = 0; it < 16; ++it) {
    const int i = i0 + 4 * it;
    tile[i * 65 + j] = src[(size_t)(r0 + i) * ld_src + c0 + j];
  }
  __syncthreads();
  const int i2 = (tid & 31) * 2, j0 = tid >> 5;
#pragma unroll
  for (int it = 0; it < 8; ++it) {
    const int jj = j0 + 8 * it;
    *(unsigned*)(dst + (size_t)(c0 + jj) * ld_dst + r0 + i2) = pack2(tile[i2 * 65 + jj], tile[(i2 + 1) * 65 + jj]);
  }
  __syncthreads();
}

DI void prep_transposes(const Params& p, int vb, int G, char* lds) {
  for (int t = vb; t < 5312; t += G) {
    const float* src; u16* dst; int lds_, ldd, r0, c0;
    int q = t;
    if (q < 128) { src = p.in[12]; lds_ = 1024; dst = (u16*)(p.ws + OFF_WIN_E); ldd = 1024; r0 = (q >> 3) * 64; c0 = (q & 7) * 64; }
    else if ((q -= 128) < 256) { src = p.in[16]; lds_ = 1024; dst = (u16*)(p.ws + OFF_WOUT_ET); ldd = 1024; r0 = (q >> 4) * 64; c0 = (q & 15) * 64; }
    else if ((q -= 256) < 576) { src = p.in[17]; lds_ = 2304; dst = (u16*)(p.ws + OFF_WIN_O); ldd = 1024; r0 = (q / 36) * 64; c0 = (q % 36) * 64; }
    else if ((q -= 576) < 256) { src = p.in[28]; lds_ = 1024; dst = (u16*)(p.ws + OFF_WOUT_O); ldd = 1024; r0 = (q >> 4) * 64; c0 = (q & 15) * 64; }
    else if ((q -= 256) < 2048) { const int l = q >> 10; q &= 1023; src = p.in[29] + (size_t)l * 1024 * 4096; lds_ = 4096; dst = (u16*)(p.ws + OFF_W1) + (size_t)l * 4096 * 1024; ldd = 1024; r0 = (q >> 6) * 64; c0 = (q & 63) * 64; }
    else { q -= 2048; const int l = q >> 10; q &= 1023; src = p.in[30] + (size_t)l * 4096 * 1024; lds_ = 1024; dst = (u16*)(p.ws + OFF_W2) + (size_t)l * 1024 * 4096; ldd = 4096; r0 = (q >> 4) * 64; c0 = (q & 15) * 64; }
    transpose_tile(src, lds_, dst, ldd, r0, c0, lds);
  }
}

DI void prep_elementwise(const Params& p, int vb, int G) {
  const size_t gt = (size_t)vb * 256 + threadIdx.x, gs = (size_t)G * 256;
  {
    u16* d = (u16*)(p.ws + OFF_WINB);
    for (size_t i = gt; i < 1024 * 256; i += gs) {
      const int k = (int)(i >> 8), c = (int)(i & 255) * 2;
      const float* s = p.in[12] + (size_t)k * 1024 + 512 + c;
      *(unsigned*)(d + (size_t)k * 512 + c) = pack2(s[0], s[1]);
    }
  }
  {
    u16* d = (u16*)(p.ws + OFF_CBD);
    for (size_t i = gt; i < 1024 * 512; i += gs) {
      const int np = (int)(i >> 9), cp = (int)(i & 511);
      const int g = np >> 8, pq = (np >> 7) & 1, m = np & 127;
      float v = 0.f;
      if ((cp >> 7) == g) {
        const int c = cp & 127; const int rr = (m * c) & 127;
        const float x = (float)rr * (2.0f / 128.0f);
        v = pq ? sinpif(x) : cospif(x);
      }
      d[i] = f2bf(v);
    }
  }
  {
    u16* d = (u16*)(p.ws + OFF_BD);
    for (size_t i = gt; i < 1024 * 1024; i += gs) {
      const int kp = (int)(i >> 10), c = (int)(i & 1023);
      float v = 0.f;
      if (kp < 512) { const int g = kp >> 7; if (c < 512 && (c >> 7) == g) v = p.in[13][(size_t)g * 16384 + (kp & 127) * 128 + (c & 127)] * p.in[14][c]; }
      else { const int g = (kp - 512) >> 7; if (c >= 512 && ((c - 512) >> 7) == g) v = p.in[15][(size_t)g * 16384 + ((kp - 512) & 127) * 128 + ((c - 512) & 127)]; }
      d[i] = f2bf(v);
    }
  }
  {
    u16* d = (u16*)(p.ws + OFF_D256);
    for (size_t i = gt; i < 256 * 512; i += gs) {
      const int k = (int)(i >> 9), np = (int)(i & 511);
      const int n = np & 255; const int rr = (k * n) & 255;
      const float x = (float)rr * (2.0f / 256.0f);
      d[i] = f2bf(np < 256 ? cospif(x) : -sinpif(x));
    }
  }
  {
    u16* d = (u16*)(p.ws + OFF_D4096);
    for (size_t i = gt; i < (size_t)4096 * 4096; i += gs) {
      const int k = (int)(i >> 12), np = (int)(i & 4095) * 2;
      const int n = np & 4095;
      const int r0 = (k * n) & 4095, r1 = (k * (n + 1)) & 4095;
      const float x0 = (float)r0 * (2.0f / 4096.0f), x1 = (float)r1 * (2.0f / 4096.0f);
      float v0, v1;
      if (np < 4096) { v0 = cospif(x0); v1 = cospif(x1); } else { v0 = -sinpif(x0); v1 = -sinpif(x1); }
      *(unsigned*)(d + (size_t)k * 8192 + np) = pack2(v0, v1);
    }
  }
}

DI void normmod_phase(const Params& p, int vb, int G, const float* xp, const float* xs, const float* gain, int l, int which) {
  const int lane = threadIdx.x & 63, wave = threadIdx.x >> 6;
  u16* H = (u16*)(p.ws + OFF_H);
  const float* mods = (const float*)(p.ws + OFF_MODS) + (size_t)l * 3 * 6144;
  for (int row = vb * 4 + wave; row < T; row += G * 4) {
    const float* x = (row < 4096) ? xp + (size_t)row * 1024 : xs + (size_t)(row - 4096) * 1024;
    float4 v[4];
    float ss = 0.f;
#pragma unroll
    for (int i = 0; i < 4; ++i) {
      v[i] = *(const float4*)(x + i * 256 + lane * 4);
      ss += v[i].x * v[i].x + v[i].y * v[i].y + v[i].z * v[i].z + v[i].w * v[i].w;
    }
    ss = wave_sum(ss);
    const float rinv = rsqrtf(ss * (1.0f / 1024.0f) + EPS);
    const float* md = mods + cond_of(row) * 6144 + which * 3072;
#pragma unroll
    for (int i = 0; i < 4; ++i) {
      const int c = i * 256 + lane * 4;
      const float4 g = *(const float4*)(gain + c);
      const float4 sh = *(const float4*)(md + c);
      const float4 sc = *(const float4*)(md + 1024 + c);
      const float o0 = v[i].x * rinv * g.x * (1.f + sc.x) + sh.x;
      const float o1 = v[i].y * rinv * g.y * (1.f + sc.y) + sh.y;
      const float o2 = v[i].z * rinv * g.z * (1.f + sc.z) + sh.z;
      const float o3 = v[i].w * rinv * g.w * (1.f + sc.w) + sh.w;
      uint2 w; w.x = pack2(o0, o1); w.y = pack2(o2, o3);
      *(uint2*)(H + (size_t)row * 1024 + c) = w;
    }
  }
}

template <class Epi>
DI void gemm_phase(const u16* A, int lda, const u16* Bt, int ldb, int K, int M, int N, Epi epi, int vb, int G, char* lds) {
  const int nN = N >> 7, nt = (M >> 7) * nN;
  for (int t = vb; t < nt; t += G) gemm_tile(A, lda, Bt, ldb, K, (t / nN) << 7, (t % nN) << 7, epi, lds);
}

DI void pool_phase(const Params& p, int vb, int G) {
  const u16* UA = (const u16*)(p.ws + OFF_UA);
  u16* AB = (u16*)(p.ws + OFF_AB);
  const size_t gt = (size_t)vb * 256 + threadIdx.x, gs = (size_t)G * 256;
  for (size_t i = gt; i < (size_t)T * 64; i += gs) {
    const int t = (int)(i >> 6), c8 = (int)(i & 63) * 8;
    const int g = c8 >> 7, hw = 1 << g;
    int nl, N, base;
    if (t < 4096) { nl = t & 255; N = 256; base = t - nl; } else { nl = (t - 4096) & 4095; N = 4096; base = t - nl; }
    const int lo = max(nl - hw, 0), hi = min(nl + hw, N);
    float s[8] = {0, 0, 0, 0, 0, 0, 0, 0};
    for (int j = lo; j < hi; ++j) {
      const uint4 w = *(const uint4*)(UA + (size_t)(base + j) * 512 + c8);
      s[0] += __uint_as_float(w.x << 16); s[1] += __uint_as_float(w.x & 0xffff0000u);
      s[2] += __uint_as_float(w.y << 16); s[3] += __uint_as_float(w.y & 0xffff0000u);
      s[4] += __uint_as_float(w.z << 16); s[5] += __uint_as_float(w.z & 0xffff0000u);
      s[6] += __uint_as_float(w.w << 16); s[7] += __uint_as_float(w.w & 0xffff0000u);
    }
    const float inv = 1.0f / (float)(hi - lo);
    const uint4 w = *(const uint4*)(UA + (size_t)t * 512 + c8);
    uint4 o;
    o.x = pack2(s[0] * inv - __uint_as_float(w.x << 16), s[1] * inv - __uint_as_float(w.x & 0xffff0000u));
    o.y = pack2(s[2] * inv - __uint_as_float(w.y << 16), s[3] * inv - __uint_as_float(w.y & 0xffff0000u));
    o.z = pack2(s[4] * inv - __uint_as_float(w.z << 16), s[5] * inv - __uint_as_float(w.z & 0xffff0000u));
    o.w = pack2(s[6] * inv - __uint_as_float(w.w << 16), s[7] * inv - __uint_as_float(w.w & 0xffff0000u));
    *(uint4*)(AB + (size_t)t * 1024 + c8) = o;
  }
}

DI void qkvpost_phase(const Params& p, int vb, int G) {
  const int lane = threadIdx.x & 63, wave = threadIdx.x >> 6;
  const int q = lane & 15, sub = lane >> 4;
  const u16* QKV = (const u16*)(p.ws + OFF_QKV);
  u16* CQ = (u16*)(p.ws + OFF_CQ); u16* DQ = (u16*)(p.ws + OFF_DQ);
  u16* CKP = (u16*)(p.ws + OFF_CKP); u16* CKS = (u16*)(p.ws + OFF_CKS);
  u16* DKP = (u16*)(p.ws + OFF_DKP); u16* DKS = (u16*)(p.ws + OFF_DKS);
  float* nck = p.out + OUT_NCK; float* ndk = p.out + OUT_NDK;
  const int d0 = q * 4;
  float fr[4];
#pragma unroll
  for (int e = 0; e < 4; ++e) fr[e] = exp2f(-(float)((d0 + e) & 15) * (13.287712379549449f / 16.0f));
  const bool firsthalf = ((d0 >> 4) & 1) == 0;
  for (int t = vb * 4 + wave; t < T; t += G * 4) {
    const bool samp = t >= 4096;
    int b, nl;
    if (!samp) { b = t >> 8; nl = t & 255; } else { b = (t - 4096) >> 12; nl = (t - 4096) & 4095; }
    float cs[4], sn[4];
    if (samp) {
      const float pos = (d0 < 32) ? (float)(nl >> 6) : (float)(nl & 63);
#pragma unroll
      for (int e = 0; e < 4; ++e) { const float a = pos * fr[e]; cs[e] = cosf(a); sn[e] = sinf(a); }
    } else {
#pragma unroll
      for (int e = 0; e < 4; ++e) { cs[e] = 1.f; sn[e] = 0.f; }
    }
    for (int rd = 0; rd < 7; ++rd) {
      const int slot = rd * 4 + sub;
      const bool act = slot < 26;
      const int vi = act ? (slot < 16 ? slot : slot + 8) : 0;
      const uint2 raw = *(const uint2*)(QKV + (size_t)t * 2304 + vi * 64 + d0);
      float x[4] = {__uint_as_float(raw.x << 16), __uint_as_float(raw.x & 0xffff0000u), __uint_as_float(raw.y << 16), __uint_as_float(raw.y & 0xffff0000u)};
      float ss = x[0] * x[0] + x[1] * x[1] + x[2] * x[2] + x[3] * x[3];
      ss += __shfl_xor(ss, 1); ss += __shfl_xor(ss, 2); ss += __shfl_xor(ss, 4); ss += __shfl_xor(ss, 8);
      const float rinv = rsqrtf(ss * (1.0f / 64.0f) + EPS);
      const float* gp = (vi < 8) ? p.in[18] : (vi < 16) ? p.in[19] : (vi < 32) ? p.in[25] : p.in[26];
      const float4 g = *(const float4*)(gp + d0);
      float y[4] = {x[0] * rinv * g.x, x[1] * rinv * g.y, x[2] * rinv * g.z, x[3] * rinv * g.w};
      float o[4];
#pragma unroll
      for (int e = 0; e < 4; ++e) {
        const float part = __shfl_xor(y[e], 4);
        o[e] = firsthalf ? (y[e] * cs[e] - part * sn[e]) : (y[e] * cs[e] + part * sn[e]);
      }
      if (!act) continue;
      const bool isq = (vi < 8) || (vi >= 24 && vi < 32);
      if (isq) {
        const int hd = (vi < 8) ? vi : vi - 24;
        u16* base = (vi < 8) ? CQ : DQ;
        size_t off = samp ? (size_t)16 * 8 * 256 * 64 + ((size_t)(b * 8 + hd) * 4096 + nl) * 64 : ((size_t)(b * 8 + hd) * 256 + nl) * 64;
        uint2 w; w.x = pack2(o[0] * QSCALE, o[1] * QSCALE); w.y = pack2(o[2] * QSCALE, o[3] * QSCALE);
        *(uint2*)(base + off + d0) = w;
      } else if (vi < 16) {
        const int hm = vi - 8;
        uint2 w; w.x = pack2(o[0], o[1]); w.y = pack2(o[2], o[3]);
        if (samp) *(uint2*)(CKS + ((size_t)(b * 8 + hm) * 4608 + 512 + nl) * 64 + d0) = w;
        else {
          *(uint2*)(CKP + ((size_t)(b * 8 + hm) * 256 + nl) * 64 + d0) = w;
          *(float4*)(nck + (size_t)t * 512 + hm * 64 + d0) = make_float4(o[0], o[1], o[2], o[3]);
        }
      } else {
        const int j = vi - 32;
        uint2 w; w.x = pack2(o[0], o[1]); w.y = pack2(o[2], o[3]);
        if (samp) *(uint2*)(DKS + ((size_t)(b * 2 + j) * 4608 + 512 + nl) * 64 + d0) = w;
        else {
          *(uint2*)(DKP + ((size_t)(b * 2 + j) * 256 + nl) * 64 + d0) = w;
          *(float4*)(ndk + (size_t)t * 128 + j * 64 + d0) = make_float4(o[0], o[1], o[2], o[3]);
        }
      }
    }
  }
  const size_t gt = (size_t)vb * 256 + threadIdx.x, gs = (size_t)G * 256;
  {
    u16* CVTS = (u16*)(p.ws + OFF_CVTS); u16* DVTS = (u16*)(p.ws + OFF_DVTS);
    for (size_t i = gt; i < (size_t)2 * 512 * 512; i += gs) {
      const int b = (int)(i >> 18), key = (int)(i >> 9) & 511, c = (int)(i & 511);
      CKS[((size_t)(b * 8 + (c >> 6)) * 4608 + key) * 64 + (c & 63)] = f2bf(p.in[3][i]);
    }
    for (size_t i = gt; i < (size_t)2 * 512 * 512; i += gs) {
      const int b = (int)(i >> 18), c = (int)(i >> 9) & 511, key = (int)(i & 511);
      CVTS[((size_t)(b * 512 + c)) * 4608 + key] = f2bf(p.in[4][((size_t)b * 512 + key) * 512 + c]);
    }
    for (size_t i = gt; i < (size_t)2 * 512 * 128; i += gs) {
      const int b = (int)(i >> 16), key = (int)(i >> 7) & 511, c = (int)(i & 127);
      DKS[((size_t)(b * 2 + (c >> 6)) * 4608 + key) * 64 + (c & 63)] = f2bf(p.in[5][i]);
    }
    for (size_t i = gt; i < (size_t)2 * 128 * 512; i += gs) {
      const int b = (int)(i >> 16), c = (int)(i >> 9) & 127, key = (int)(i & 511);
      DVTS[((size_t)(b * 128 + c)) * 4608 + key] = f2bf(p.in[6][((size_t)b * 512 + key) * 128 + c]);
    }
  }
}

template <int DV>
DI void attn_item(const u16* Q, const u16* Kb, const u16* Vt, int ldv, int nt0, int key1, int nt1,
                  bool masked, int qpos0, bool has_sink, float sink2, u16* out, int ldo, char* lds) {
  constexpr int NDB = DV / 32;
  constexpr int KVBUF = (64 + DV) * LROW;
  const int tid = threadIdx.x, lane = tid & 63, wave = tid >> 6;
  const int r = lane & 31, h = lane >> 5;
  const int nt = nt0 + nt1;
  bf16x8 qf[4];
#pragma unroll
  for (int ks = 0; ks < 4; ++ks) qf[ks] = *(const bf16x8*)(Q + (size_t)(wave * 32 + r) * 64 + ks * 16 + h * 8);
  f32x16 O[NDB];
#pragma unroll
  for (int i = 0; i < NDB; ++i)
#pragma unroll
    for (int e = 0; e < 16; ++e) O[i][e] = 0.f;
  float mrun = has_sink ? sink2 : -1e30f;
  float lrun = has_sink ? (h == 0 ? 1.f : 0.f) : 0.f;
  const int lrow = tid >> 3, lpart = (tid & 7) * 8;
  uint4 rk0, rk1, rv0, rv1, rv2, rv3;
  rv2 = rv3 = make_uint4(0, 0, 0, 0);
  const u16* gk = Kb + (size_t)lrow * 64 + lpart;
  const u16* gv = Vt + (size_t)lrow * ldv + lpart;
#define ATT_GLOAD(key0_)                                                         \
  do {                                                                           \
    rk0 = *(const uint4*)(gk + (size_t)(key0_) * 64);                            \
    rk1 = *(const uint4*)(gk + (size_t)((key0_) + 32) * 64);                     \
    rv0 = *(const uint4*)(gv + (key0_));                                         \
    rv1 = *(const uint4*)(gv + (size_t)32 * ldv + (key0_));                      \
    if constexpr (DV == 128) {                                                   \
      rv2 = *(const uint4*)(gv + (size_t)64 * ldv + (key0_));                    \
      rv3 = *(const uint4*)(gv + (size_t)96 * ldv + (key0_));                    \
    }                                                                            \
  } while (0)
#define ATT_SSTORE(boff_)                                                        \
  do {                                                                           \
    *(uint4*)(sw + (boff_)) = rk0;                                               \
    *(uint4*)(sw + (boff_) + 32 * LROW) = rk1;                                   \
    *(uint4*)(sw + (boff_) + 64 * LROW) = rv0;                                   \
    *(uint4*)(sw + (boff_) + 96 * LROW) = rv1;                                   \
    if constexpr (DV == 128) {                                                   \
      *(uint4*)(sw + (boff_) + 128 * LROW) = rv2;                                \
      *(uint4*)(sw + (boff_) + 160 * LROW) = rv3;                                \
    }                                                                            \
  } while (0)
  char* sw = lds + lrow * LROW + lpart * 2;
  {
    const int key0 = (nt0 > 0) ? 0 : key1;
    ATT_GLOAD(key0);
  }
  ATT_SSTORE(0);
  __syncthreads();
  const int pr = (r & 0x13) | ((r & 4) << 1) | ((r & 8) >> 1);
  const char* fk = lds + pr * LROW + h * 16;
  const char* fv = lds + 64 * LROW + r * LROW + h * 16;
  const int qpos = qpos0 + wave * 32 + r;
  for (int t = 0; t < nt; ++t) {
    const int cur = (t & 1) * KVBUF;
    const int key0 = (t < nt0) ? t * 64 : key1 + (t - nt0) * 64;
    {
      const int tn = (t + 1 < nt) ? t + 1 : t;
      const int kn = (tn < nt0) ? tn * 64 : key1 + (tn - nt0) * 64;
      ATT_GLOAD(kn);
    }
    f32x16 S[2];
#pragma unroll
    for (int kb = 0; kb < 2; ++kb) {
#pragma unroll
      for (int e = 0; e < 16; ++e) S[kb][e] = 0.f;
#pragma unroll
      for (int ks = 0; ks < 4; ++ks) {
        const bf16x8 kf = *(const bf16x8*)(fk + cur + kb * 32 * LROW + ks * 32);
        S[kb] = MFMA(kf, qf[ks], S[kb]);
      }
    }
    if (masked && t >= nt0) {
#pragma unroll
      for (int kb = 0; kb < 2; ++kb)
#pragma unroll
        for (int e = 0; e < 16; ++e) {
          const int jpos = key0 - 512 + kb * 32 + 16 * (e >> 3) + 8 * h + (e & 7);
          const int dlt = qpos - jpos;
          if (dlt > 128 || dlt < -128) S[kb][e] = -1e30f;
        }
    }
    float mloc = S[0][0];
#pragma unroll
    for (int kb = 0; kb < 2; ++kb)
#pragma unroll
      for (int e = 0; e < 16; ++e) mloc = fmaxf(mloc, S[kb][e]);
    mloc = fmaxf(mloc, __shfl_xor(mloc, 32));
    const float mnew = fmaxf(mrun, mloc);
    const float alpha = __builtin_amdgcn_exp2f(mrun - mnew);
    mrun = mnew;
    float ps = 0.f;
#pragma unroll
    for (int kb = 0; kb < 2; ++kb)
#pragma unroll
      for (int e = 0; e < 16; ++e) { const float pv = __builtin_amdgcn_exp2f(S[kb][e] - mnew); S[kb][e] = pv; ps += pv; }
    lrun = lrun * alpha + ps;
#pragma unroll
    for (int i = 0; i < NDB; ++i)
#pragma unroll
      for (int e = 0; e < 16; ++e) O[i][e] *= alpha;
    bf16x8 pf[4];
#pragma unroll
    for (int jj = 0; jj < 4; ++jj) {
      const int kb = jj >> 1, o8 = (jj & 1) * 8;
      uint4 w;
      w.x = pack2(S[kb][o8 + 0], S[kb][o8 + 1]); w.y = pack2(S[kb][o8 + 2], S[kb][o8 + 3]);
      w.z = pack2(S[kb][o8 + 4], S[kb][o8 + 5]); w.w = pack2(S[kb][o8 + 6], S[kb][o8 + 7]);
      pf[jj] = __builtin_bit_cast(bf16x8, w);
    }
#pragma unroll
    for (int i = 0; i < NDB; ++i)
#pragma unroll
      for (int jj = 0; jj < 4; ++jj) {
        const bf16x8 vf = *(const bf16x8*)(fv + cur + i * 32 * LROW + jj * 32);
        O[i] = MFMA(vf, pf[jj], O[i]);
      }
    ATT_SSTORE(KVBUF - cur);
    __syncthreads();
  }
#undef ATT_GLOAD
#undef ATT_SSTORE
  const float ltot = lrun + __shfl_xor(lrun, 32);
  const float inv = 1.0f / ltot;
  u16* op = out + (size_t)(wave * 32 + r) * ldo;
#pragma unroll
  for (int i = 0; i < NDB; ++i)
#pragma unroll
    for (int qd = 0; qd < 4; ++qd) {
      uint2 w;
      w.x = pack2(O[i][4 * qd] * inv, O[i][4 * qd + 1] * inv);
      w.y = pack2(O[i][4 * qd + 2] * inv, O[i][4 * qd + 3] * inv);
      *(uint2*)(op + i * 32 + 8 * qd + 4 * h) = w;
    }
}

DI void attention_phase(const Params& p, int vb, int G, char* lds) {
  const u16* CQ = (const u16*)(p.ws + OFF_CQ); const u16* DQ = (const u16*)(p.ws + OFF_DQ);
  const u16* CKP = (const u16*)(p.ws + OFF_CKP); const u16* CKS = (const u16*)(p.ws + OFF_CKS);
  const u16* CVTP = (const u16*)(p.ws + OFF_CVTP); const u16* CVTS = (const u16*)(p.ws + OFF_CVTS);
  const u16* DKP = (const u16*)(p.ws + OFF_DKP); const u16* DKS = (const u16*)(p.ws + OFF_DKS);
  const u16* DVTP = (const u16*)(p.ws + OFF_DVTP); const u16* DVTS = (const u16*)(p.ws + OFF_DVTS);
  u16* OM = (u16*)(p.ws + OFF_OM); u16* AC = (u16*)(p.ws + OFF_H);
  constexpr size_t QS = (size_t)16 * 8 * 256 * 64;
  for (int it = vb; it < 1536; it += G) {
    const bool diff = (it < 512) || (it >= 1024 && it < 1280);
    const bool samp = it < 1024;
    int qb, hd, b;
    if (samp) { const int i2 = it & 511; qb = i2 & 31; hd = (i2 >> 5) & 7; b = i2 >> 8; }
    else { const int i2 = (it - 1024) & 255; qb = i2 & 1; hd = (i2 >> 1) & 7; b = i2 >> 4; }
    const int nseq = samp ? 4096 : 256, nkeys = samp ? 4608 : 256;
    const int tok = samp ? 4096 + b * 4096 + qb * 128 : b * 256 + qb * 128;
    const size_t qoff = (samp ? QS : 0) + ((size_t)(b * 8 + hd) * nseq + qb * 128) * 64;
    if (diff) {
      const u16* Kp = (samp ? CKS : CKP) + (size_t)(b * 8 + hd) * nkeys * 64;
      const u16* Vp = (samp ? CVTS : CVTP) + (size_t)(b * 4 + (hd >> 1)) * 128 * nkeys;
      attn_item<128>(CQ + qoff, Kp, Vp, nkeys, nkeys >> 6, 0, 0, false, 0, false, 0.f, OM + (size_t)tok * 1024 + hd * 128, 1024, lds);
    } else {
      const u16* Kp = (samp ? DKS : DKP) + (size_t)(b * 2 + (hd >> 2)) * nkeys * 64;
      const u16* Vp = (samp ? DVTS : DVTP) + (size_t)(b * 2 + (hd >> 2)) * 64 * nkeys;
      int nt0 = 4, key1 = 0, nt1 = 0;
      if (samp) { const int lo = max(qb * 128 - 128, 0), hi = min(qb * 128 + 256, 4096); nt0 = 8; key1 = 512 + lo; nt1 = (hi - lo) >> 6; }
      attn_item<64>(DQ + qoff, Kp, Vp, nkeys, nt0, key1, nt1, samp, qb * 128, true, p.in[27][hd] * LOG2E, AC + (size_t)tok * 1024 + 512 + hd * 64, 1024, lds);
    }
  }
}

DI void combine_phase(const Params& p, int vb, int G) {
  const int lane = threadIdx.x & 63, wave = threadIdx.x >> 6;
  const float a = wave_sum(p.in[20][lane] * p.in[21][lane]);
  const float bsum = wave_sum(p.in[22][lane] * p.in[23][lane]);
  const float lam = expf(a) - expf(bsum) + LAM_INIT;
  const u16* OM = (const u16*)(p.ws + OFF_OM);
  u16* AC = (u16*)(p.ws + OFF_H);
  const int hh = lane >> 4, e0 = (lane & 15) * 8;
  float g[8];
#pragma unroll
  for (int e = 0; e < 8; ++e) g[e] = p.in[24][e0 + e] * (1.0f - LAM_INIT);
  for (int t = vb * 4 + wave; t < T; t += G * 4) {
    const uint4 w0 = *(const uint4*)(OM + (size_t)t * 1024 + (hh * 2) * 128 + e0);
    const uint4 w1 = *(const uint4*)(OM + (size_t)t * 1024 + (hh * 2 + 1) * 128 + e0);
    const unsigned a0[4] = {w0.x, w0.y, w0.z, w0.w}, a1[4] = {w1.x, w1.y, w1.z, w1.w};
    float d[8];
    float ss = 0.f;
#pragma unroll
    for (int e = 0; e < 4; ++e) {
      d[2 * e] = __uint_as_float(a0[e] << 16) - lam * __uint_as_float(a1[e] << 16);
      d[2 * e + 1] = __uint_as_float(a0[e] & 0xffff0000u) - lam * __uint_as_float(a1[e] & 0xffff0000u);
      ss += d[2 * e] * d[2 * e] + d[2 * e + 1] * d[2 * e + 1];
    }
    ss += __shfl_xor(ss, 1); ss += __shfl_xor(ss, 2); ss += __shfl_xor(ss, 4); ss += __shfl_xor(ss, 8);
    const float rinv = rsqrtf(ss * (1.0f / 128.0f) + EPS);
    uint4 o;
    o.x = pack2(d[0] * rinv * g[0], d[1] * rinv * g[1]); o.y = pack2(d[2] * rinv * g[2], d[3] * rinv * g[3]);
    o.z = pack2(d[4] * rinv * g[4], d[5] * rinv * g[5]); o.w = pack2(d[6] * rinv * g[6], d[7] * rinv * g[7]);
    *(uint4*)(AC + (size_t)t * 1024 + hh * 128 + e0) = o;
  }
}

__global__ void __launch_bounds__(256, 2) fwd_kernel(Params p, int ph_lo, int ph_hi) {
  __shared__ __attribute__((aligned(16))) char lds[LDS_BYTES];
  const int G = gridDim.x;
  int vb = blockIdx.x;
  if ((G & 7) == 0) vb = (blockIdx.x & 7) * (G >> 3) + (blockIdx.x >> 3);
  unsigned char* ws = p.ws;
  const float* mods = (const float*)(ws + OFF_MODS);
  float* X = p.out + OUT_Y;
  u16* H = (u16*)(ws + OFF_H);

#define RUNPH(n) ((ONLYPH < 0 || ONLYPH == (n)) && ph_lo <= (n) && (n) < ph_hi)
#define SEAM(n) if (ph_lo < (n) && (n) < ph_hi) cg::this_grid().sync();
  if (RUNPH(0)) {
    for (int id = vb; id < 192; id += G) ada_item(p, id, lds);
    prep_transposes(p, vb, G, lds);
    prep_elementwise(p, vb, G);
  }
  SEAM(1)
  if (RUNPH(1)) {
    for (int t = vb; t < 128; t += G) {
      const bool f1 = t < 64;
      const int q = t & 63;
      gemm_tile(f1 ? (const u16*)(ws + OFF_CBD) : (const u16*)(ws + OFF_WOUT_ET), f1 ? 512 : 1024,
                f1 ? (const u16*)(ws + OFF_WINB) : (const u16*)(ws + OFF_BD), f1 ? 512 : 1024, f1 ? 512 : 1024, (q >> 3) << 7, (q & 7) << 7,
                EpiBf16{f1 ? (u16*)(ws + OFF_WIN_E) + (size_t)512 * 1024 : (u16*)(ws + OFF_WOUT_E), 1024}, lds);
    }
    normmod_phase(p, vb, G, p.in[0], p.in[1], p.in[8], 0, 0);
  }
  SEAM(2)
  if (RUNPH(2))
    gemm_phase(H, 1024, (const u16*)(ws + OFF_WIN_E), 1024, 1024, T, 1536, EpiU{(u16*)(ws + OFF_UA), (u16*)(ws + OFF_PQT)}, vb, G, lds);
  SEAM(3)
  if (RUNPH(3)) {
    const u16* PQT = (const u16*)(ws + OFF_PQT);
    for (int t = vb; t < 256 + 128; t += G) {
      const bool big = t < 256;
      const int q = t - 256, b = q >> 3;
      const int m0 = big ? (t >> 3) << 7 : ((q >> 2) & 1) << 7;
      const int n0 = big ? (t & 7) << 7 : (q & 3) << 7;
      gemm_tile(big ? (const u16*)(ws + OFF_D4096) : (const u16*)(ws + OFF_D256), big ? 8192 : 512,
                big ? PQT + (size_t)16 * 512 * 512 : PQT + (size_t)b * 512 * 512, big ? 8192 : 512, big ? 8192 : 512, m0, n0,
                EpiDft{(u16*)(ws + OFF_AB), big ? 0 : b * 256, big ? 0.0013810679320049757f : 0.005524271728019903f, big ? 1 : 0}, lds);
    }
    pool_phase(p, vb, G);
  }
  SEAM(4)
  if (RUNPH(4))
    gemm_phase((const u16*)(ws + OFF_AB), 1024, (const u16*)(ws + OFF_WOUT_E), 1024, 1024, T, 1024,
               EpiRes{p.in[0], p.in[1], X, mods + 2048}, vb, G, lds);
  SEAM(5)
  if (RUNPH(5)) normmod_phase(p, vb, G, X, X + (size_t)4096 * 1024, p.in[9], 0, 1);
  SEAM(6)
  if (RUNPH(6)) gemm_phase(H, 1024, (const u16*)(ws + OFF_W1), 1024, 1024, T, 4096, EpiRelu2{(u16*)(ws + OFF_M1)}, vb, G, lds);
  SEAM(7)
  if (RUNPH(7)) gemm_phase((const u16*)(ws + OFF_M1), 4096, (const u16*)(ws + OFF_W2), 4096, 4096, T, 1024,
                           EpiRes{X, X + (size_t)4096 * 1024, X, mods + 5120}, vb, G, lds);
  SEAM(8)
  if (RUNPH(8)) normmod_phase(p, vb, G, X, X + (size_t)4096 * 1024, p.in[8] + 1024, 1, 0);
  SEAM(9)
  if (RUNPH(9)) gemm_phase(H, 1024, (const u16*)(ws + OFF_WIN_O), 1024, 1024, T, 2304,
                           EpiQkv{(u16*)(ws + OFF_QKV), (u16*)(ws + OFF_CVTP), (u16*)(ws + OFF_CVTS), (u16*)(ws + OFF_DVTP), (u16*)(ws + OFF_DVTS),
                                  p.out + OUT_NCV, p.out + OUT_NDV}, vb, G, lds);
  SEAM(10)
  if (RUNPH(10)) qkvpost_phase(p, vb, G);
  SEAM(11)
  if (RUNPH(11)) attention_phase(p, vb, G, lds);
  SEAM(12)
  if (RUNPH(12)) combine_phase(p, vb, G);
  SEAM(13)
  if (RUNPH(13)) gemm_phase(H, 1024, (const u16*)(ws + OFF_WOUT_O), 1024, 1024, T, 1024,
                            EpiRes{X, X + (size_t)4096 * 1024, X, mods + 3 * 6144 + 2048}, vb, G, lds);
  SEAM(14)
  if (RUNPH(14)) normmod_phase(p, vb, G, X, X + (size_t)4096 * 1024, p.in[9] + 1024, 1, 1);
  SEAM(15)
  if (RUNPH(15)) gemm_phase(H, 1024, (const u16*)(ws + OFF_W1) + (size_t)4096 * 1024, 1024, 1024, T, 4096, EpiRelu2{(u16*)(ws + OFF_M1)}, vb, G, lds);
  SEAM(16)
  if (RUNPH(16)) gemm_phase((const u16*)(ws + OFF_M1), 4096, (const u16*)(ws + OFF_W2) + (size_t)4096 * 1024, 4096, 4096, T, 1024,
                            EpiRes{X, X + (size_t)4096 * 1024, X, mods + 3 * 6144 + 5120}, vb, G, lds);
}

extern "C" void kernel_launch(void* const* d_in, const int* in_sizes, int n_in, void* d_out, int out_size, void* d_ws, size_t ws_size,
                              hipStream_t stream) {
  static int grid = 0;
  if (!grid) {
    int dev = 0, cus = 0, per_cu = 0;
    hipGetDevice(&dev);
    hipDeviceGetAttribute(&cus, hipDeviceAttributeMultiprocessorCount, dev);
    hipOccupancyMaxActiveBlocksPerMultiprocessor(&per_cu, fwd_kernel, 256, 0);
    if (per_cu < 1) per_cu = 1;
    if (per_cu > 2) per_cu = 2;
    grid = cus * per_cu;
    if (ws_size < WS_END) fprintf(stderr, "workspace too small: %zu < %zu\n", ws_size, (size_t)WS_END);
  }
  Params p{};
  for (int i = 0; i < 31; ++i) p.in[i] = (const float*)d_in[i];
  p.out = (float*)d_out;
  p.ws = (unsigned char*)d_ws;
#if ONE_LAUNCH
  int lo = 0, hi = NPH;
  void* args[] = {&p, &lo, &hi};
  hipError_t e = hipLaunchCooperativeKernel((void*)fwd_kernel, dim3(grid), dim3(256), args, 0, stream);
  if (e != hipSuccess) fprintf(stderr, "cooperative launch failed: %s (grid %d)\n", hipGetErrorString(e), grid);
#else
  for (int ph = 0; ph < NPH; ++ph) hipLaunchKernelGGL(fwd_kernel, dim3(grid), dim3(256), 0, stream, p, ph, ph + 1);
#endif
}
```

```cpp
#include <hip/hip_runtime.h>
#include <hip/hip_cooperative_groups.h>
#include <cstdio>
namespace cg = cooperative_groups;

#ifndef ONE_LAUNCH
#define ONE_LAUNCH 1
#endif

#ifndef ONLYPH
#define ONLYPH -1
#endif
typedef unsigned short u16;
typedef short bf16x8 __attribute__((ext_vector_type(8)));
typedef float f32x16 __attribute__((ext_vector_type(16)));
typedef __bf16 bf2_t __attribute__((ext_vector_type(2)));
typedef float f2_t __attribute__((ext_vector_type(2)));

#define DI __device__ __forceinline__

constexpr int T = 12288, TP = 4096, DM = 1024;
constexpr int NPH = 17;
constexpr float EPS = 1e-6f;
constexpr float LOG2E = 1.4426950408889634f;
constexpr float QSCALE = 0.125f * LOG2E;
constexpr float LAM_INIT = 0.35550906759f;

constexpr size_t al(size_t x) { return (x + 255) & ~size_t(255); }
constexpr size_t OFF_MODS   = 0;
constexpr size_t OFF_WIN_E  = OFF_MODS + al(2 * 3 * 6144 * 4);
constexpr size_t OFF_WINB   = OFF_WIN_E + al(1536 * 1024 * 2);
constexpr size_t OFF_CBD    = OFF_WINB + al(1024 * 512 * 2);
constexpr size_t OFF_WOUT_ET= OFF_CBD + al(1024 * 512 * 2);
constexpr size_t OFF_BD     = OFF_WOUT_ET + al(1024 * 1024 * 2);
constexpr size_t OFF_WOUT_E = OFF_BD + al(1024 * 1024 * 2);
constexpr size_t OFF_WIN_O  = OFF_WOUT_E + al(1024 * 1024 * 2);
constexpr size_t OFF_WOUT_O = OFF_WIN_O + al(2304 * 1024 * 2);
constexpr size_t OFF_W1     = OFF_WOUT_O + al(1024 * 1024 * 2);
constexpr size_t OFF_W2     = OFF_W1 + al(2 * 4096 * 1024 * 2);
constexpr size_t OFF_D256   = OFF_W2 + al(2 * 4096 * 1024 * 2);
constexpr size_t OFF_H      = OFF_D256 + al(256 * 512 * 2);
constexpr size_t OFF_R2     = OFF_H + al((size_t)T * 1024 * 2);
constexpr size_t R2_BYTES   = (size_t)T * 512 * 2 + (size_t)T * 1024 * 2 * 2;
constexpr size_t OFF_R1     = OFF_R2 + al(R2_BYTES);
constexpr size_t R1_BYTES   = (size_t)T * 4096 * 2;
constexpr size_t OFF_BAR    = OFF_R1 + R1_BYTES;
constexpr size_t WS_END     = OFF_BAR + 3456 * 4;
constexpr size_t OFF_UA  = OFF_R2;
constexpr size_t OFF_PQT = OFF_UA + (size_t)T * 512 * 2;
constexpr size_t OFF_AB  = OFF_PQT + (size_t)T * 1024 * 2;
constexpr size_t OFF_CQ   = OFF_R2;
constexpr size_t OFF_DQ   = OFF_CQ + (size_t)T * 512 * 2;
constexpr size_t OFF_CKP  = OFF_DQ + (size_t)T * 512 * 2;
constexpr size_t OFF_CKS  = OFF_CKP + (size_t)16 * 8 * 256 * 64 * 2;
constexpr size_t OFF_CVTP = OFF_CKS + (size_t)2 * 8 * 4608 * 64 * 2;
constexpr size_t OFF_CVTS = OFF_CVTP + (size_t)16 * 4 * 128 * 256 * 2;
constexpr size_t OFF_DKP  = OFF_CVTS + (size_t)2 * 4 * 128 * 4608 * 2;
constexpr size_t OFF_DKS  = OFF_DKP + (size_t)16 * 2 * 256 * 64 * 2;
constexpr size_t OFF_DVTP = OFF_DKS + (size_t)2 * 2 * 4608 * 64 * 2;
constexpr size_t OFF_DVTS = OFF_DVTP + (size_t)16 * 2 * 64 * 256 * 2;
constexpr size_t R2_LATE_END = OFF_DVTS + (size_t)2 * 2 * 64 * 4608 * 2;
static_assert(R2_LATE_END <= OFF_R2 + R2_BYTES, "R2 overflow");
constexpr size_t OFF_D4096 = OFF_R1;
constexpr size_t OFF_M1    = OFF_R1;
constexpr size_t OFF_QKV   = OFF_R1;
constexpr size_t OFF_OM    = OFF_R1 + al((size_t)T * 2304 * 2);
static_assert(OFF_OM + (size_t)T * 1024 * 2 <= WS_END, "R1 overflow");

constexpr size_t OUT_Y   = 0;
constexpr size_t OUT_NCK = (size_t)T * 1024;
constexpr size_t OUT_NCV = OUT_NCK + (size_t)TP * 512;
constexpr size_t OUT_NDK = OUT_NCV + (size_t)TP * 512;
constexpr size_t OUT_NDV = OUT_NDK + (size_t)TP * 128;

struct Params {
  const float* in[31];
  float* out;
  unsigned char* ws;
};

DI float bf2f(u16 v) { return __uint_as_float(((unsigned)v) << 16); }
DI unsigned pack2(float a, float b) { f2_t f = {a, b}; bf2_t v = __builtin_convertvector(f, bf2_t); return __builtin_bit_cast(unsigned, v); }
DI u16 f2bf(float a) { return (u16)(pack2(a, 0.f) & 0xffffu); }
DI int cond_of(int m) { return m < 4096 ? 0 : (m < 8192 ? 1 : 2); }
DI float wave_sum(float v) {
#pragma unroll
  for (int o = 32; o >= 1; o >>= 1) v += __shfl_xor(v, o);
  return v;
}
#define MFMA(a, b, c) __builtin_amdgcn_mfma_f32_32x32x16_bf16((a), (b), (c), 0, 0, 0)

constexpr int LROW = 144;
constexpr int GEMM_BUF = 2 * 128 * LROW;
constexpr int LDS_BYTES = 2 * GEMM_BUF;

template <class Epi>
DI void gemm_tile(const u16* A, int lda, const u16* Bt, int ldb, int K, int m0, int n0, Epi epi, char* lds) {
  const int tid = threadIdx.x, lane = tid & 63, wave = tid >> 6;
  const int r = lane & 31, h = lane >> 5;
  const int wm = wave >> 1, wn = wave & 1;
  const int lrow = tid >> 3, lcol = (tid & 7) * 8;
  const u16* ga = A + (size_t)(m0 + lrow) * lda + lcol;
  const u16* gb = Bt + (size_t)(n0 + lrow) * ldb + lcol;
  uint4 ra[4], rb[4];
  f32x16 acc[2][2];
#pragma unroll
  for (int i = 0; i < 2; ++i)
#pragma unroll
    for (int j = 0; j < 2; ++j)
#pragma unroll
      for (int e = 0; e < 16; ++e) acc[i][j][e] = 0.f;
#pragma unroll
  for (int i = 0; i < 4; ++i) {
    ra[i] = *(const uint4*)(ga + (size_t)(32 * i) * lda);
    rb[i] = *(const uint4*)(gb + (size_t)(32 * i) * ldb);
  }
  char* sw = lds + lrow * LROW + lcol * 2;
#pragma unroll
  for (int i = 0; i < 4; ++i) {
    *(uint4*)(sw + (32 * i) * LROW) = ra[i];
    *(uint4*)(sw + 128 * LROW + (32 * i) * LROW) = rb[i];
  }
  __syncthreads();
  const int nk = K >> 6;
  const char* fa = lds + (wm * 64 + r) * LROW + h * 16;
  const char* fb = lds + 128 * LROW + (wn * 64 + r) * LROW + h * 16;
  for (int kt = 0; kt < nk; ++kt) {
    const int cur = (kt & 1) * GEMM_BUF;
    if (kt + 1 < nk) {
      const int k0 = (kt + 1) << 6;
#pragma unroll
      for (int i = 0; i < 4; ++i) {
        ra[i] = *(const uint4*)(ga + (size_t)(32 * i) * lda + k0);
        rb[i] = *(const uint4*)(gb + (size_t)(32 * i) * ldb + k0);
      }
    }
#pragma unroll
    for (int ks = 0; ks < 4; ++ks) {
      bf16x8 a0 = *(const bf16x8*)(fa + cur + ks * 32);
      bf16x8 a1 = *(const bf16x8*)(fa + cur + 32 * LROW + ks * 32);
      bf16x8 b0 = *(const bf16x8*)(fb + cur + ks * 32);
      bf16x8 b1 = *(const bf16x8*)(fb + cur + 32 * LROW + ks * 32);
      acc[0][0] = MFMA(a0, b0, acc[0][0]);
      acc[0][1] = MFMA(a0, b1, acc[0][1]);
      acc[1][0] = MFMA(a1, b0, acc[1][0]);
      acc[1][1] = MFMA(a1, b1, acc[1][1]);
    }
    if (kt + 1 < nk) {
      const int nxt = GEMM_BUF - cur;
#pragma unroll
      for (int i = 0; i < 4; ++i) {
        *(uint4*)(sw + nxt + (32 * i) * LROW) = ra[i];
        *(uint4*)(sw + nxt + 128 * LROW + (32 * i) * LROW) = rb[i];
      }
    }
    __syncthreads();
  }
#pragma unroll
  for (int i = 0; i < 2; ++i)
#pragma unroll
    for (int j = 0; j < 2; ++j)
#pragma unroll
      for (int q = 0; q < 4; ++q) {
        const int m = m0 + wm * 64 + i * 32 + 8 * q + 4 * h;
        const int n = n0 + wn * 64 + j * 32 + r;
        epi(m, n, acc[i][j][4 * q], acc[i][j][4 * q + 1], acc[i][j][4 * q + 2], acc[i][j][4 * q + 3]);
      }
}

struct EpiBf16 {
  u16* C; int ldc;
  DI void operator()(int m, int n, float v0, float v1, float v2, float v3) const {
    u16* p = C + (size_t)m * ldc + n;
    p[0] = f2bf(v0); p[ldc] = f2bf(v1); p[2 * ldc] = f2bf(v2); p[3 * ldc] = f2bf(v3);
  }
};
struct EpiU {
  u16* UA; u16* PQt;
  DI void operator()(int m, int n, float v0, float v1, float v2, float v3) const {
    if (n < 512) {
      u16* p = UA + (size_t)m * 512 + n;
      p[0] = f2bf(v0); p[512] = f2bf(v1); p[1024] = f2bf(v2); p[1536] = f2bf(v3);
    } else {
      const int np = n - 512, g = np >> 8, pq = (np >> 7) & 1, mm = np & 127;
      size_t off;
      if (m < 4096) { const int b = m >> 8, nl = m & 255; off = ((size_t)(b * 512 + g * 128 + mm)) * 512 + pq * 256 + nl; }
      else { const int ms = m - 4096, b = ms >> 12, nl = ms & 4095; off = (size_t)16 * 512 * 512 + ((size_t)(b * 512 + g * 128 + mm)) * 8192 + pq * 4096 + nl; }
      uint2 w; w.x = pack2(v0, v1); w.y = pack2(v2, v3);
      *(uint2*)(PQt + off) = w;
    }
  }
};
struct EpiDft {
  u16* AB; int rowbase; float norm; int sample;
  DI void operator()(int m, int n, float v0, float v1, float v2, float v3) const {
    size_t row; int c;
    if (sample) { row = (size_t)4096 + (size_t)(n >> 9) * 4096 + m; c = n & 511; }
    else { row = (size_t)rowbase + m; c = n; }
    u16* p = AB + row * 1024 + 512 + c;
    p[0] = f2bf(v0 * norm); p[1024] = f2bf(v1 * norm); p[2048] = f2bf(v2 * norm); p[3072] = f2bf(v3 * norm);
  }
};
struct EpiRes {
  const float* xin_p; const float* xin_s;
  float* X; const float* gate;
  DI void operator()(int m, int n, float v0, float v1, float v2, float v3) const {
    const float* xi = (m < 4096) ? xin_p + (size_t)m * 1024 + n : xin_s + (size_t)(m - 4096) * 1024 + n;
    const float g = gate[cond_of(m) * 6144 + n];
    float* xo = X + (size_t)m * 1024 + n;
    xo[0] = xi[0] + g * v0; xo[1024] = xi[1024] + g * v1; xo[2048] = xi[2048] + g * v2; xo[3072] = xi[3072] + g * v3;
  }
};
struct EpiRelu2 {
  u16* C;
  DI void operator()(int m, int n, float v0, float v1, float v2, float v3) const {
    v0 = fmaxf(v0, 0.f); v1 = fmaxf(v1, 0.f); v2 = fmaxf(v2, 0.f); v3 = fmaxf(v3, 0.f);
    u16* p = C + (size_t)m * 4096 + n;
    p[0] = f2bf(v0 * v0); p[4096] = f2bf(v1 * v1); p[8192] = f2bf(v2 * v2); p[12288] = f2bf(v3 * v3);
  }
};
struct EpiQkv {
  u16* QKV; u16* CVtP; u16* CVtS; u16* DVtP; u16* DVtS; float* ncv; float* ndv;
  DI void operator()(int m, int n, float v0, float v1, float v2, float v3) const {
    const bool is_cv = (n >= 1024 && n < 1536), is_dv = (n >= 2176);
    if (!is_cv && !is_dv) {
      u16* p = QKV + (size_t)m * 2304 + n;
      p[0] = f2bf(v0); p[2304] = f2bf(v1); p[4608] = f2bf(v2); p[6912] = f2bf(v3);
      return;
    }
    uint2 w; w.x = pack2(v0, v1); w.y = pack2(v2, v3);
    if (is_cv) {
      const int c = n - 1024;
      if (m < 4096) {
        const int b = m >> 8, nl = m & 255;
        *(uint2*)(CVtP + ((size_t)(b * 512 + c)) * 256 + nl) = w;
        float* o = ncv + (size_t)m * 512 + c; o[0] = v0; o[512] = v1; o[1024] = v2; o[1536] = v3;
      } else {
        const int ms = m - 4096, b = ms >> 12, nl = ms & 4095;
        *(uint2*)(CVtS + ((size_t)(b * 512 + c)) * 4608 + 512 + nl) = w;
      }
    } else {
      const int c = n - 2176;
      if (m < 4096) {
        const int b = m >> 8, nl = m & 255;
        *(uint2*)(DVtP + ((size_t)(b * 128 + c)) * 256 + nl) = w;
        float* o = ndv + (size_t)m * 128 + c; o[0] = v0; o[128] = v1; o[256] = v2; o[384] = v3;
      } else {
        const int ms = m - 4096, b = ms >> 12, nl = ms & 4095;
        *(uint2*)(DVtS + ((size_t)(b * 128 + c)) * 4608 + 512 + nl) = w;
      }
    }
  }
};

DI void ada_item(const Params& p, int id, char* lds) {
  const int tid = threadIdx.x;
  float* ssil = (float*)lds;
  float* red = (float*)(lds + 12288);
  const int l = id / 96, cb = id % 96;
  for (int i = tid; i < 3072; i += 256) {
    const int j = i >> 10, k = i & 1023;
    const float v = (j == 0) ? p.in[7][k] : p.in[2][(j - 1) * 1024 + k];
    ssil[i] = v / (1.f + __expf(-v));
  }
  __syncthreads();
  const int cq = tid & 15, kg = tid >> 4;
  const float* w = p.in[10] + (size_t)l * 1024 * 6144 + cb * 64 + cq * 4;
  float4 a0 = {0, 0, 0, 0}, a1 = {0, 0, 0, 0}, a2 = {0, 0, 0, 0};
#pragma unroll 8
  for (int kk = 0; kk < 64; ++kk) {
    const int k = kg * 64 + kk;
    const float4 wv = *(const float4*)(w + (size_t)k * 6144);
    const float s0 = ssil[k], s1 = ssil[1024 + k], s2 = ssil[2048 + k];
    a0.x += s0 * wv.x; a0.y += s0 * wv.y; a0.z += s0 * wv.z; a0.w += s0 * wv.w;
    a1.x += s1 * wv.x; a1.y += s1 * wv.y; a1.z += s1 * wv.z; a1.w += s1 * wv.w;
    a2.x += s2 * wv.x; a2.y += s2 * wv.y; a2.z += s2 * wv.z; a2.w += s2 * wv.w;
  }
  float* rp = red + kg * 192 + cq * 4;
  rp[0] = a0.x; rp[1] = a0.y; rp[2] = a0.z; rp[3] = a0.w;
  rp[64] = a1.x; rp[65] = a1.y; rp[66] = a1.z; rp[67] = a1.w;
  rp[128] = a2.x; rp[129] = a2.y; rp[130] = a2.z; rp[131] = a2.w;
  __syncthreads();
  if (tid < 192) {
    const int j = tid >> 6, c = tid & 63;
    float s = 0.f;
#pragma unroll
    for (int g = 0; g < 16; ++g) s += red[g * 192 + j * 64 + c];
    const int col = cb * 64 + c;
    ((float*)(p.ws + OFF_MODS))[(size_t)(l * 3 + j) * 6144 + col] = s + p.in[11][l * 6144 + col];
  }
  __syncthreads();
}

DI void transpose_tile(const float* src, int ld_src, u16* dst, int ld_dst, int r0, int c0, char* lds) {
  float* tile = (float*)lds;
  const int tid = threadIdx.x;
  const int j = tid & 63, i0 = tid >> 6;
#pragma unroll
  for (int it = 0; it < 16; ++it) {
    const int i = i0 + 4 * it;
    tile[i * 65 + j] = src[(size_t)(r0 + i) * ld_src + c0 + j];
  }
  __syncthreads();
  const int i2 = (tid & 31) * 2, j0 = tid >> 5;
#pragma unroll
  for (int it = 0; it < 8; ++it) {
    const int jj = j0 + 8 * it;
    *(unsigned*)(dst + (size_t)(c0 + jj) * ld_dst + r0 + i2) = pack2(tile[i2 * 65 + jj], tile[(i2 + 1) * 65 + jj]);
  }
  __syncthreads();
}

DI void prep_transposes(const Params& p, int vb, int G, char* lds) {
  for (int t = vb; t < 5312; t += G) {
    const float* src; u16* dst; int lds_, ldd, r0, c0;
    int q = t;
    if (q < 128) { src = p.in[12]; lds_ = 1024; dst = (u16*)(p.ws + OFF_WIN_E); ldd = 1024; r0 = (q >> 3) * 64; c0 = (q & 7) * 64; }
    else if ((q -= 128) < 256) { src = p.in[16]; lds_ = 1024; dst = (u16*)(p.ws + OFF_WOUT_ET); ldd = 1024; r0 = (q >> 4) * 64; c0 = (q & 15) * 64; }
    else if ((q -= 256) < 576) { src = p.in[17]; lds_ = 2304; dst = (u16*)(p.ws + OFF_WIN_O); ldd = 1024; r0 = (q / 36) * 64; c0 = (q % 36) * 64; }
    else if ((q -= 576) < 256) { src = p.in[28]; lds_ = 1024; dst = (u16*)(p.ws + OFF_WOUT_O); ldd = 1024; r0 = (q >> 4) * 64; c0 = (q & 15) * 64; }
    else if ((q -= 256) < 2048) { const int l = q >> 10; q &= 1023; src = p.in[29] + (size_t)l * 1024 * 4096; lds_ = 4096; dst = (u16*)(p.ws + OFF_W1) + (size_t)l * 4096 * 1024; ldd = 1024; r0 = (q >> 6) * 64; c0 = (q & 63) * 64; }
    else { q -= 2048; const int l = q >> 10; q &= 1023; src = p.in[30] + (size_t)l * 4096 * 1024; lds_ = 1024; dst = (u16*)(p.ws + OFF_W2) + (size_t)l * 1024 * 4096; ldd = 4096; r0 = (q >> 4) * 64; c0 = (q & 15) * 64; }
    transpose_tile(src, lds_, dst, ldd, r0, c0, lds);
  }
}

DI void prep_elementwise(const Params& p, int vb, int G) {
  const size_t gt = (size_t)vb * 256 + threadIdx.x, gs = (size_t)G * 256;
  {
    u16* d = (u16*)(p.ws + OFF_WINB);
    for (size_t i = gt; i < 1024 * 256; i += gs) {
      const int k = (int)(i >> 8), c = (int)(i & 255) * 2;
      const float* s = p.in[12] + (size_t)k * 1024 + 512 + c;
      *(unsigned*)(d + (size_t)k * 512 + c) = pack2(s[0], s[1]);
    }
  }
  {
    u16* d = (u16*)(p.ws + OFF_CBD);
    for (size_t i = gt; i < 1024 * 512; i += gs) {
      const int np = (int)(i >> 9), cp = (int)(i & 511);
      const int g = np >> 8, pq = (np >> 7) & 1, m = np & 127;
      float v = 0.f;
      if ((cp >> 7) == g) {
        const int c = cp & 127; const int rr = (m * c) & 127;
        const float x = (float)rr * (2.0f / 128.0f);
        v = pq ? sinpif(x) : cospif(x);
      }
      d[i] = f2bf(v);
    }
  }
  {
    u16* d = (u16*)(p.ws + OFF_BD);
    for (size_t i = gt; i < 1024 * 1024; i += gs) {
      const int kp = (int)(i >> 10), c = (int)(i & 1023);
      float v = 0.f;
      if (kp < 512) { const int g = kp >> 7; if (c < 512 && (c >> 7) == g) v = p.in[13][(size_t)g * 16384 + (kp & 127) * 128 + (c & 127)] * p.in[14][c]; }
      else { const int g = (kp - 512) >> 7; if (c >= 512 && ((c - 512) >> 7) == g) v = p.in[15][(size_t)g * 16384 + ((kp - 512) & 127) * 128 + ((c - 512) & 127)]; }
      d[i] = f2bf(v);
    }
  }
  {
    u16* d = (u16*)(p.ws + OFF_D256);
    for (size_t i = gt; i < 256 * 512; i += gs) {
      const int k = (int)(i >> 9), np = (int)(i & 511);
      const int n = np & 255; const int rr = (k * n) & 255;
      const float x = (float)rr * (2.0f / 256.0f);
      d[i] = f2bf(np < 256 ? cospif(x) : -sinpif(x));
    }
  }
  {
    u16* d = (u16*)(p.ws + OFF_D4096);
    for (size_t i = gt; i < (size_t)4096 * 4096; i += gs) {
      const int k = (int)(i >> 12), np = (int)(i & 4095) * 2;
      const int n = np & 4095;
      const int r0 = (k * n) & 4095, r1 = (k * (n + 1)) & 4095;
      const float x0 = (float)r0 * (2.0f / 4096.0f), x1 = (float)r1 * (2.0f / 4096.0f);
      float v0, v1;
      if (np < 4096) { v0 = cospif(x0); v1 = cospif(x1); } else { v0 = -sinpif(x0); v1 = -sinpif(x1); }
      *(unsigned*)(d + (size_t)k * 8192 + np) = pack2(v0, v1);
    }
  }
}

DI void normmod_phase(const Params& p, int vb, int G, const float* xp, const float* xs, const float* gain, int l, int which) {
  const int lane = threadIdx.x & 63, wave = threadIdx.x >> 6;
  u16* H = (u16*)(p.ws + OFF_H);
  const float* mods = (const float*)(p.ws + OFF_MODS) + (size_t)l * 3 * 6144;
  for (int row = vb * 4 + wave; row < T; row += G * 4) {
    const float* x = (row < 4096) ? xp + (size_t)row * 1024 : xs + (size_t)(row - 4096) * 1024;
    float4 v[4];
    float ss = 0.f;
#pragma unroll
    for (int i = 0; i < 4; ++i) {
      v[i] = *(const float4*)(x + i * 256 + lane * 4);
      ss += v[i].x * v[i].x + v[i].y * v[i].y + v[i].z * v[i].z + v[i].w * v[i].w;
    }
    ss = wave_sum(ss);
    const float rinv = rsqrtf(ss * (1.0f / 1024.0f) + EPS);
    const float* md = mods + cond_of(row) * 6144 + which * 3072;
#pragma unroll
    for (int i = 0; i < 4; ++i) {
      const int c = i * 256 + lane * 4;
      const float4 g = *(const float4*)(gain + c);
      const float4 sh = *(const float4*)(md + c);
      const float4 sc = *(const float4*)(md + 1024 + c);
      const float o0 = v[i].x * rinv * g.x * (1.f + sc.x) + sh.x;
      const float o1 = v[i].y * rinv * g.y * (1.f + sc.y) + sh.y;
      const float o2 = v[i].z * rinv * g.z * (1.f + sc.z) + sh.z;
      const float o3 = v[i].w * rinv * g.w * (1.f + sc.w) + sh.w;
      uint2 w; w.x = pack2(o0, o1); w.y = pack2(o2, o3);
      *(uint2*)(H + (size_t)row * 1024 + c) = w;
    }
  }
}

template <class Epi>
DI void gemm_phase(const u16* A, int lda, const u16* Bt, int ldb, int K, int M, int N, Epi epi, int vb, int G, char* lds) {
  const int nN = N >> 7, nt = (M >> 7) * nN;
  for (int t = vb; t < nt; t += G) gemm_tile(A, lda, Bt, ldb, K, (t / nN) << 7, (t % nN) << 7, epi, lds);
}

DI void pool_phase(const Params& p, int vb, int G) {
  const u16* UA = (const u16*)(p.ws + OFF_UA);
  u16* AB = (u16*)(p.ws + OFF_AB);
  const size_t gt = (size_t)vb * 256 + threadIdx.x, gs = (size_t)G * 256;
  for (size_t i = gt; i < (size_t)T * 64; i += gs) {
    const int t = (int)(i >> 6), c8 = (int)(i & 63) * 8;
    const int g = c8 >> 7, hw = 1 << g;
    int nl, N, base;
    if (t < 4096) { nl = t & 255; N = 256; base = t - nl; } else { nl = (t - 4096) & 4095; N = 4096; base = t - nl; }
    const int lo = max(nl - hw, 0), hi = min(nl + hw, N);
    float s[8] = {0, 0, 0, 0, 0, 0, 0, 0};
    for (int j = lo; j < hi; ++j) {
      const uint4 w = *(const uint4*)(UA + (size_t)(base + j) * 512 + c8);
      s[0] += __uint_as_float(w.x << 16); s[1] += __uint_as_float(w.x & 0xffff0000u);
      s[2] += __uint_as_float(w.y << 16); s[3] += __uint_as_float(w.y & 0xffff0000u);
      s[4] += __uint_as_float(w.z << 16); s[5] += __uint_as_float(w.z & 0xffff0000u);
      s[6] += __uint_as_float(w.w << 16); s[7] += __uint_as_float(w.w & 0xffff0000u);
    }
    const float inv = 1.0f / (float)(hi - lo);
    const uint4 w = *(const uint4*)(UA + (size_t)t * 512 + c8);
    uint4 o;
    o.x = pack2(s[0] * inv - __uint_as_float(w.x << 16), s[1] * inv - __uint_as_float(w.x & 0xffff0000u));
    o.y = pack2(s[2] * inv - __uint_as_float(w.y << 16), s[3] * inv - __uint_as_float(w.y & 0xffff0000u));
    o.z = pack2(s[4] * inv - __uint_as_float(w.z << 16), s[5] * inv - __uint_as_float(w.z & 0xffff0000u));
    o.w = pack2(s[6] * inv - __uint_as_float(w.w << 16), s[7] * inv - __uint_as_float(w.w & 0xffff0000u));
    *(uint4*)(AB + (size_t)t * 1024 + c8) = o;
  }
}

DI void qkvpost_phase(const Params& p, int vb, int G) {
  const int lane = threadIdx.x & 63, wave = threadIdx.x >> 6;
  const int q = lane & 15, sub = lane >> 4;
  const u16* QKV = (const u16*)(p.ws + OFF_QKV);
  u16* CQ = (u16*)(p.ws + OFF_CQ); u16* DQ = (u16*)(p.ws + OFF_DQ);
  u16* CKP = (u16*)(p.ws + OFF_CKP); u16* CKS = (u16*)(p.ws + OFF_CKS);
  u16* DKP = (u16*)(p.ws + OFF_DKP); u16* DKS = (u16*)(p.ws + OFF_DKS);
  float* nck = p.out + OUT_NCK; float* ndk = p.out + OUT_NDK;
  const int d0 = q * 4;
  float fr[4];
#pragma unroll
  for (int e = 0; e < 4; ++e) fr[e] = exp2f(-(float)((d0 + e) & 15) * (13.287712379549449f / 16.0f));
  const bool firsthalf = ((d0 >> 4) & 1) == 0;
  for (int t = vb * 4 + wave; t < T; t += G * 4) {
    const bool samp = t >= 4096;
    int b, nl;
    if (!samp) { b = t >> 8; nl = t & 255; } else { b = (t - 4096) >> 12; nl = (t - 4096) & 4095; }
    float cs[4], sn[4];
    if (samp) {
      const float pos = (d0 < 32) ? (float)(nl >> 6) : (float)(nl & 63);
#pragma unroll
      for (int e = 0; e < 4; ++e) { const float a = pos * fr[e]; cs[e] = cosf(a); sn[e] = sinf(a); }
    } else {
#pragma unroll
      for (int e = 0; e < 4; ++e) { cs[e] = 1.f; sn[e] = 0.f; }
    }
    for (int rd = 0; rd < 7; ++rd) {
      const int slot = rd * 4 + sub;
      const bool act = slot < 26;
      const int vi = act ? (slot < 16 ? slot : slot + 8) : 0;
      const uint2 raw = *(const uint2*)(QKV + (size_t)t * 2304 + vi * 64 + d0);
      float x[4] = {__uint_as_float(raw.x << 16), __uint_as_float(raw.x & 0xffff0000u), __uint_as_float(raw.y << 16), __uint_as_float(raw.y & 0xffff0000u)};
      float ss = x[0] * x[0] + x[1] * x[1] + x[2] * x[2] + x[3] * x[3];
      ss += __shfl_xor(ss, 1); ss += __shfl_xor(ss, 2); ss += __shfl_xor(ss, 4); ss += __shfl_xor(ss, 8);
      const float rinv = rsqrtf(ss * (1.0f / 64.0f) + EPS);
      const float* gp = (vi < 8) ? p.in[18] : (vi < 16) ? p.in[19] : (vi < 32) ? p.in[25] : p.in[26];
      const float4 g = *(const float4*)(gp + d0);
      float y[4] = {x[0] * rinv * g.x, x[1] * rinv * g.y, x[2] * rinv * g.z, x[3] * rinv * g.w};
      float o[4];
#pragma unroll
      for (int e = 0; e < 4; ++e) {
        const float part = __shfl_xor(y[e], 4);
        o[e] = firsthalf ? (y[e] * cs[e] - part * sn[e]) : (y[e] * cs[e] + part * sn[e]);
      }
      if (!act) continue;
      const bool isq = (vi < 8) || (vi >= 24 && vi < 32);
      if (isq) {
        const int hd = (vi < 8) ? vi : vi - 24;
        u16* base = (vi < 8) ? CQ : DQ;
        size_t off = samp ? (size_t)16 * 8 * 256 * 64 + ((size_t)(b * 8 + hd) * 4096 + nl) * 64 : ((size_t)(b * 8 + hd) * 256 + nl) * 64;
        uint2 w; w.x = pack2(o[0] * QSCALE, o[1] * QSCALE); w.y = pack2(o[2] * QSCALE, o[3] * QSCALE);
        *(uint2*)(base + off + d0) = w;
      } else if (vi < 16) {
        const int hm = vi - 8;
        uint2 w; w.x = pack2(o[0], o[1]); w.y = pack2(o[2], o[3]);
        if (samp) *(uint2*)(CKS + ((size_t)(b * 8 + hm) * 4608 + 512 + nl) * 64 + d0) = w;
        else {
          *(uint2*)(CKP + ((size_t)(b * 8 + hm) * 256 + nl) * 64 + d0) = w;
          *(float4*)(nck + (size_t)t * 512 + hm * 64 + d0) = make_float4(o[0], o[1], o[2], o[3]);
        }
      } else {
        const int j = vi - 32;
        uint2 w; w.x = pack2(o[0], o[1]); w.y = pack2(o[2], o[3]);
        if (samp) *(uint2*)(DKS + ((size_t)(b * 2 + j) * 4608 + 512 + nl) * 64 + d0) = w;
        else {
          *(uint2*)(DKP + ((size_t)(b * 2 + j) * 256 + nl) * 64 + d0) = w;
          *(float4*)(ndk + (size_t)t * 128 + j * 64 + d0) = make_float4(o[0], o[1], o[2], o[3]);
        }
      }
    }
  }
  const size_t gt = (size_t)vb * 256 + threadIdx.x, gs = (size_t)G * 256;
  {
    u16* CVTS = (u16*)(p.ws + OFF_CVTS); u16* DVTS = (u16*)(p.ws + OFF_DVTS);
    for (size_t i = gt; i < (size_t)2 * 512 * 512; i += gs) {
      const int b = (int)(i >> 18), key = (int)(i >> 9) & 511, c = (int)(i & 511);
      CKS[((size_t)(b * 8 + (c >> 6)) * 4608 + key) * 64 + (c & 63)] = f2bf(p.in[3][i]);
    }
    for (size_t i = gt; i < (size_t)2 * 512 * 512; i += gs) {
      const int b = (int)(i >> 18), c = (int)(i >> 9) & 511, key = (int)(i & 511);
      CVTS[((size_t)(b * 512 + c)) * 4608 + key] = f2bf(p.in[4][((size_t)b * 512 + key) * 512 + c]);
    }
    for (size_t i = gt; i < (size_t)2 * 512 * 128; i += gs) {
      const int b = (int)(i >> 16), key = (int)(i >> 7) & 511, c = (int)(i & 127);
      DKS[((size_t)(b * 2 + (c >> 6)) * 4608 + key) * 64 + (c & 63)] = f2bf(p.in[5][i]);
    }
    for (size_t i = gt; i < (size_t)2 * 128 * 512; i += gs) {
      const int b = (int)(i >> 16), c = (int)(i >> 9) & 127, key = (int)(i & 511);
      DVTS[((size_t)(b * 128 + c)) * 4608 + key] = f2bf(p.in[6][((size_t)b * 512 + key) * 128 + c]);
    }
  }
}

template <int DV>
DI void attn_item(const u16* Q, const u16* Kb, const u16* Vt, int ldv, int nt0, int key1, int nt1,
                  bool masked, int qpos0, bool has_sink, float sink2, u16* out, int ldo, char* lds) {
  constexpr int NDB = DV / 32;
  constexpr int KVBUF = (64 + DV) * LROW;
  const int tid = threadIdx.x, lane = tid & 63, wave = tid >> 6;
  const int r = lane & 31, h = lane >> 5;
  const int nt = nt0 + nt1;
  bf16x8 qf[4];
#pragma unroll
  for (int ks = 0; ks < 4; ++ks) qf[ks] = *(const bf16x8*)(Q + (size_t)(wave * 32 + r) * 64 + ks * 16 + h * 8);
  f32x16 O[NDB];
#pragma unroll
  for (int i = 0; i < NDB; ++i)
#pragma unroll
    for (int e = 0; e < 16; ++e) O[i][e] = 0.f;
  float mrun = has_sink ? sink2 : -1e30f;
  float lrun = has_sink ? (h == 0 ? 1.f : 0.f) : 0.f;
  const int lrow = tid >> 3, lpart = (tid & 7) * 8;
  uint4 rk0, rk1, rv0, rv1, rv2, rv3;
  rv2 = rv3 = make_uint4(0, 0, 0, 0);
  const u16* gk = Kb + (size_t)lrow * 64 + lpart;
  const u16* gv = Vt + (size_t)lrow * ldv + lpart;
#define ATT_GLOAD(key0_)                                                         \
  do {                                                                           \
    rk0 = *(const uint4*)(gk + (size_t)(key0_) * 64);                            \
    rk1 = *(const uint4*)(gk + (size_t)((key0_) + 32) * 64);                     \
    rv0 = *(const uint4*)(gv + (key0_));                                         \
    rv1 = *(const uint4*)(gv + (size_t)32 * ldv + (key0_));                      \
    if constexpr (DV == 128) {                                                   \
      rv2 = *(const uint4*)(gv + (size_t)64 * ldv + (key0_));                    \
      rv3 = *(const uint4*)(gv + (size_t)96 * ldv + (key0_));                    \
    }                                                                            \
  } while (0)
#define ATT_SSTORE(boff_)                                                        \
  do {                                                                           \
    *(uint4*)(sw + (boff_)) = rk0;                                               \
    *(uint4*)(sw + (boff_) + 32 * LROW) = rk1;                                   \
    *(uint4*)(sw + (boff_) + 64 * LROW) = rv0;                                   \
    *(uint4*)(sw + (boff_) + 96 * LROW) = rv1;                                   \
    if constexpr (DV == 128) {                                                   \
      *(uint4*)(sw + (boff_) + 128 * LROW) = rv2;                                \
      *(uint4*)(sw + (boff_) + 160 * LROW) = rv3;                                \
    }                                                                            \
  } while (0)
  char* sw = lds + lrow * LROW + lpart * 2;
  {
    const int key0 = (nt0 > 0) ? 0 : key1;
    ATT_GLOAD(key0);
  }
  ATT_SSTORE(0);
  __syncthreads();
  const int pr = (r & 0x13) | ((r & 4) << 1) | ((r & 8) >> 1);
  const char* fk = lds + pr * LROW + h * 16;
  const char* fv = lds + 64 * LROW + r * LROW + h * 16;
  const int qpos = qpos0 + wave * 32 + r;
  for (int t = 0; t < nt; ++t) {
    const int cur = (t & 1) * KVBUF;
    const int key0 = (t < nt0) ? t * 64 : key1 + (t - nt0) * 64;
    {
      const int tn = (t + 1 < nt) ? t + 1 : t;
      const int kn = (tn < nt0) ? tn * 64 : key1 + (tn - nt0) * 64;
      ATT_GLOAD(kn);
    }
    f32x16 S[2];
#pragma unroll
    for (int kb = 0; kb < 2; ++kb) {
#pragma unroll
      for (int e = 0; e < 16; ++e) S[kb][e] = 0.f;
#pragma unroll
      for (int ks = 0; ks < 4; ++ks) {
        const bf16x8 kf = *(const bf16x8*)(fk + cur + kb * 32 * LROW + ks * 32);
        S[kb] = MFMA(kf, qf[ks], S[kb]);
      }
    }
    if (masked && t >= nt0) {
#pragma unroll
      for (int kb = 0; kb < 2; ++kb)
#pragma unroll
        for (int e = 0; e < 16; ++e) {
          const int jpos = key0 - 512 + kb * 32 + 16 * (e >> 3) + 8 * h + (e & 7);
          const int dlt = qpos - jpos;
          if (dlt > 128 || dlt < -128) S[kb][e] = -1e30f;
        }
    }
    float mloc = S[0][0];
#pragma unroll
    for (int kb = 0; kb < 2; ++kb)
#pragma unroll
      for (int e = 0; e < 16; ++e) mloc = fmaxf(mloc, S[kb][e]);
    mloc = fmaxf(mloc, __shfl_xor(mloc, 32));
    const float mnew = fmaxf(mrun, mloc);
    const float alpha = __builtin_amdgcn_exp2f(mrun - mnew);
    mrun = mnew;
    float ps = 0.f;
#pragma unroll
    for (int kb = 0; kb < 2; ++kb)
#pragma unroll
      for (int e = 0; e < 16; ++e) { const float pv = __builtin_amdgcn_exp2f(S[kb][e] - mnew); S[kb][e] = pv; ps += pv; }
    lrun = lrun * alpha + ps;
#pragma unroll
    for (int i = 0; i < NDB; ++i)
#pragma unroll
      for (int e = 0; e < 16; ++e) O[i][e] *= alpha;
    bf16x8 pf[4];
#pragma unroll
    for (int jj = 0; jj < 4; ++jj) {
      const int kb = jj >> 1, o8 = (jj & 1) * 8;
      uint4 w;
      w.x = pack2(S[kb][o8 + 0], S[kb][o8 + 1]); w.y = pack2(S[kb][o8 + 2], S[kb][o8 + 3]);
      w.z = pack2(S[kb][o8 + 4], S[kb][o8 + 5]); w.w = pack2(S[kb][o8 + 6], S[kb][o8 + 7]);
      pf[jj] = __builtin_bit_cast(bf16x8, w);
    }
#pragma unroll
    for (int i = 0; i < NDB; ++i)
#pragma unroll
      for (int jj = 0; jj < 4; ++jj) {
        const bf16x8 vf = *(const bf16x8*)(fv + cur + i * 32 * LROW + jj * 32);
        O[i] = MFMA(vf, pf[jj], O[i]);
      }
    ATT_SSTORE(KVBUF - cur);
    __syncthreads();
  }
#undef ATT_GLOAD
#undef ATT_SSTORE
  const float ltot = lrun + __shfl_xor(lrun, 32);
  const float inv = 1.0f / ltot;
  u16* op = out + (size_t)(wave * 32 + r) * ldo;
#pragma unroll
  for (int i = 0; i < NDB; ++i)
#pragma unroll
    for (int qd = 0; qd < 4; ++qd) {
      uint2 w;
      w.x = pack2(O[i][4 * qd] * inv, O[i][4 * qd + 1] * inv);
      w.y = pack2(O[i][4 * qd + 2] * inv, O[i][4 * qd + 3] * inv);
      *(uint2*)(op + i * 32 + 8 * qd + 4 * h) = w;
    }
}

DI void attention_phase(const Params& p, int vb, int G, char* lds) {
  const u16* CQ = (const u16*)(p.ws + OFF_CQ); const u16* DQ = (const u16*)(p.ws + OFF_DQ);
  const u16* CKP = (const u16*)(p.ws + OFF_CKP); const u16* CKS = (const u16*)(p.ws + OFF_CKS);
  const u16* CVTP = (const u16*)(p.ws + OFF_CVTP); const u16* CVTS = (const u16*)(p.ws + OFF_CVTS);
  const u16* DKP = (const u16*)(p.ws + OFF_DKP); const u16* DKS = (const u16*)(p.ws + OFF_DKS);
  const u16* DVTP = (const u16*)(p.ws + OFF_DVTP); const u16* DVTS = (const u16*)(p.ws + OFF_DVTS);
  u16* OM = (u16*)(p.ws + OFF_OM); u16* AC = (u16*)(p.ws + OFF_H);
  constexpr size_t QS = (size_t)16 * 8 * 256 * 64;
  for (int it = vb; it < 1536; it += G) {
    const bool diff = (it < 512) || (it >= 1024 && it < 1280);
    const bool samp = it < 1024;
    int qb, hd, b;
    if (samp) { const int i2 = it & 511; qb = i2 & 31; hd = (i2 >> 5) & 7; b = i2 >> 8; }
    else { const int i2 = (it - 1024) & 255; qb = i2 & 1; hd = (i2 >> 1) & 7; b = i2 >> 4; }
    const int nseq = samp ? 4096 : 256, nkeys = samp ? 4608 : 256;
    const int tok = samp ? 4096 + b * 4096 + qb * 128 : b * 256 + qb * 128;
    const size_t qoff = (samp ? QS : 0) + ((size_t)(b * 8 + hd) * nseq + qb * 128) * 64;
    if (diff) {
      const u16* Kp = (samp ? CKS : CKP) + (size_t)(b * 8 + hd) * nkeys * 64;
      const u16* Vp = (samp ? CVTS : CVTP) + (size_t)(b * 4 + (hd >> 1)) * 128 * nkeys;
      attn_item<128>(CQ + qoff, Kp, Vp, nkeys, nkeys >> 6, 0, 0, false, 0, false, 0.f, OM + (size_t)tok * 1024 + hd * 128, 1024, lds);
    } else {
      const u16* Kp = (samp ? DKS : DKP) + (size_t)(b * 2 + (hd >> 2)) * nkeys * 64;
      const u16* Vp = (samp ? DVTS : DVTP) + (size_t)(b * 2 + (hd >> 2)) * 64 * nkeys;
      int nt0 = 4, key1 = 0, nt1 = 0;
      if (samp) { const int lo = max(qb * 128 - 128, 0), hi = min(qb * 128 + 256, 4096); nt0 = 8; key1 = 512 + lo; nt1 = (hi - lo) >> 6; }
      attn_item<64>(DQ + qoff, Kp, Vp, nkeys, nt0, key1, nt1, samp, qb * 128, true, p.in[27][hd] * LOG2E, AC + (size_t)tok * 1024 + 512 + hd * 64, 1024, lds);
    }
  }
}

DI void combine_phase(const Params& p, int vb, int G) {
  const int lane = threadIdx.x & 63, wave = threadIdx.x >> 6;
  const float a = wave_sum(p.in[20][lane] * p.in[21][lane]);
  const float bsum = wave_sum(p.in[22][lane] * p.in[23][lane]);
  const float lam = expf(a) - expf(bsum) + LAM_INIT;
  const u16* OM = (const u16*)(p.ws + OFF_OM);
  u16* AC = (u16*)(p.ws + OFF_H);
  const int hh = lane >> 4, e0 = (lane & 15) * 8;
  float g[8];
#pragma unroll
  for (int e = 0; e < 8; ++e) g[e] = p.in[24][e0 + e] * (1.0f - LAM_INIT);
  for (int t = vb * 4 + wave; t < T; t += G * 4) {
    const uint4 w0 = *(const uint4*)(OM + (size_t)t * 1024 + (hh * 2) * 128 + e0);
    const uint4 w1 = *(const uint4*)(OM + (size_t)t * 1024 + (hh * 2 + 1) * 128 + e0);
    const unsigned a0[4] = {w0.x, w0.y, w0.z, w0.w}, a1[4] = {w1.x, w1.y, w1.z, w1.w};
    float d[8];
    float ss = 0.f;
#pragma unroll
    for (int e = 0; e < 4; ++e) {
      d[2 * e] = __uint_as_float(a0[e] << 16) - lam * __uint_as_float(a1[e] << 16);
      d[2 * e + 1] = __uint_as_float(a0[e] & 0xffff0000u) - lam * __uint_as_float(a1[e] & 0xffff0000u);
      ss += d[2 * e] * d[2 * e] + d[2 * e + 1] * d[2 * e + 1];
    }
    ss += __shfl_xor(ss, 1); ss += __shfl_xor(ss, 2); ss += __shfl_xor(ss, 4); ss += __shfl_xor(ss, 8);
    const float rinv = rsqrtf(ss * (1.0f / 128.0f) + EPS);
    uint4 o;
    o.x = pack2(d[0] * rinv * g[0], d[1] * rinv * g[1]); o.y = pack2(d[2] * rinv * g[2], d[3] * rinv * g[3]);
    o.z = pack2(d[4] * rinv * g[4], d[5] * rinv * g[5]); o.w = pack2(d[6] * rinv * g[6], d[7] * rinv * g[7]);
    *(uint4*)(AC + (size_t)t * 1024 + hh * 128 + e0) = o;
  }
}

#define XB_TMO      128
#define XB_XCNT(j)  (256  + 64 * (j))
#define XB_XSUB(j)  (1280 + 64 * (j))
#define XB_XGEN(j)  (2304 + 64 * (j))
#define XB_TOP      3328
#define XB_TOPGEN   3392
#define XCD_BAR_WORDS 3456
#define XB_SPIN_CAP (1u << 18)
#define LAS __attribute__((address_space(3)))
DI unsigned xb_ld(unsigned* p)              { return __hip_atomic_load(p, __ATOMIC_RELAXED, __HIP_MEMORY_SCOPE_AGENT); }
DI unsigned xb_add(unsigned* p, unsigned v) { return __hip_atomic_fetch_add(p, v, __ATOMIC_RELAXED, __HIP_MEMORY_SCOPE_AGENT); }
DI unsigned xb_xcc_id() { return (unsigned)__builtin_amdgcn_s_getreg((3 << 11) | 20) & 0xFu; }
#define XB_SPIN(cond, bar) do { unsigned _sp = 0; while (cond) { __builtin_amdgcn_s_sleep(1); \
    if ((++_sp & 255u) == 0u) { if (xb_ld(&(bar)[XB_TMO])) break; if (_sp > XB_SPIN_CAP) { atomicAdd(&(bar)[XB_TMO], 1u); break; } } } } while (0)
struct XcdBarrier { unsigned* bar; unsigned x; volatile LAS unsigned* st; };
DI XcdBarrier xcd_barrier_post(unsigned* bar, volatile LAS unsigned* st) {
  XcdBarrier b; b.bar = bar; b.x = xb_xcc_id(); b.st = st;
  if (threadIdx.x == 0) (void)xb_add(&bar[XB_XCNT(b.x)], 1u);
  return b;
}
DI void xcd_barrier_complete(unsigned* bar, unsigned x, unsigned& nloc, unsigned& nx) {
  const unsigned G = gridDim.x;
  unsigned sum, cnt, mine, sp = 0u;
  for (;;) {
    sum = 0u; cnt = 0u; mine = 0u;
#pragma unroll
    for (unsigned j = 0; j < 16; ++j) { const unsigned c = xb_ld(&bar[XB_XCNT(j)]); sum += c; cnt += (c > 0u) ? 1u : 0u; mine = (j == x) ? c : mine; }
    if (sum == G) break;
    __builtin_amdgcn_s_sleep(1);
    if ((++sp & 255u) == 0u) { if (xb_ld(&bar[XB_TMO])) break; if (sp > XB_SPIN_CAP) { atomicAdd(&bar[XB_TMO], 1u); break; } }
  }
  nloc = mine > 0u ? mine : 1u; nx = cnt > 0u ? cnt : 1u;
}
DI void xcd_barrier(const XcdBarrier& b) {
  asm volatile("s_waitcnt vmcnt(0)" ::: "memory");
  __syncthreads();
  if (threadIdx.x == 0) {
    unsigned* bar = b.bar;
    __builtin_amdgcn_s_waitcnt(0);
    unsigned nloc = b.st[0], nx = b.st[1];
    if (nloc == 0u) { xcd_barrier_complete(bar, b.x, nloc, nx); b.st[0] = nloc; b.st[1] = nx; }
    const unsigned old = xb_add(&bar[XB_XSUB(b.x)], 1u);
    const unsigned gen = old / nloc;
    if (old + 1u == (gen + 1u) * nloc) {
      __builtin_amdgcn_fence(__ATOMIC_RELEASE, "agent");
      asm volatile("s_waitcnt vmcnt(0)" ::: "memory");
      const unsigned og = xb_add(&bar[XB_TOP], 1u);
      const unsigned tg = og / nx;
      if (og + 1u == (tg + 1u) * nx) xb_add(&bar[XB_TOPGEN], 1u);
      else XB_SPIN(xb_ld(&bar[XB_TOPGEN]) == tg, bar);
      __builtin_amdgcn_fence(__ATOMIC_ACQUIRE, "agent");
      xb_add(&bar[XB_XGEN(b.x)], 1u);
      asm volatile("s_waitcnt vmcnt(0)" ::: "memory");
    } else {
      XB_SPIN(xb_ld(&bar[XB_XGEN(b.x)]) == gen, bar);
      __builtin_amdgcn_fence(__ATOMIC_ACQUIRE, "agent");
      asm volatile("s_waitcnt vmcnt(0)" ::: "memory");
    }
  }
  __syncthreads();
}

__global__ void __launch_bounds__(256, 2) fwd_kernel(Params p, int ph_lo, int ph_hi) {
  __shared__ __attribute__((aligned(16))) char lds[LDS_BYTES];
  const int G = gridDim.x;
  int vb = blockIdx.x;
  if ((G & 7) == 0) vb = (blockIdx.x & 7) * (G >> 3) + (blockIdx.x >> 3);
  unsigned char* ws = p.ws;
  const float* mods = (const float*)(ws + OFF_MODS);
  float* X = p.out + OUT_Y;
  u16* H = (u16*)(ws + OFF_H);

#define RUNPH(n) ((ONLYPH < 0 || ONLYPH == (n)) && ph_lo <= (n) && (n) < ph_hi)
#define SEAM(n) if (ph_lo < (n) && (n) < ph_hi) xcd_barrier(xb);
  __shared__ uint4 xb_words;
  if (threadIdx.x == 0) xb_words = make_uint4(0u, 0u, 0u, 0u);
  __syncthreads();
  XcdBarrier xb = xcd_barrier_post((unsigned*)(ws + OFF_BAR), (volatile LAS unsigned*)&xb_words);
  if (ph_hi > 1000) cg::this_grid().sync();
  if (RUNPH(0)) {
    for (int id = vb; id < 192; id += G) ada_item(p, id, lds);
    prep_transposes(p, vb, G, lds);
    prep_elementwise(p, vb, G);
  }
  SEAM(1)
  if (RUNPH(1)) {
    for (int t = vb; t < 128; t += G) {
      const bool f1 = t < 64;
      const int q = t & 63;
      gemm_tile(f1 ? (const u16*)(ws + OFF_CBD) : (const u16*)(ws + OFF_WOUT_ET), f1 ? 512 : 1024,
                f1 ? (const u16*)(ws + OFF_WINB) : (const u16*)(ws + OFF_BD), f1 ? 512 : 1024, f1 ? 512 : 1024, (q >> 3) << 7, (q & 7) << 7,
                EpiBf16{f1 ? (u16*)(ws + OFF_WIN_E) + (size_t)512 * 1024 : (u16*)(ws + OFF_WOUT_E), 1024}, lds);
    }
    normmod_phase(p, vb, G, p.in[0], p.in[1], p.in[8], 0, 0);
  }
  SEAM(2)
  if (RUNPH(2))
    gemm_phase(H, 1024, (const u16*)(ws + OFF_WIN_E), 1024, 1024, T, 1536, EpiU{(u16*)(ws + OFF_UA), (u16*)(ws + OFF_PQT)}, vb, G, lds);
  SEAM(3)
  if (RUNPH(3)) {
    const u16* PQT = (const u16*)(ws + OFF_PQT);
    for (int t = vb; t < 256 + 128; t += G) {
      const bool big = t < 256;
      const int q = t - 256, b = q >> 3;
      const int m0 = big ? (t >> 3) << 7 : ((q >> 2) & 1) << 7;
      const int n0 = big ? (t & 7) << 7 : (q & 3) << 7;
      gemm_tile(big ? (const u16*)(ws + OFF_D4096) : (const u16*)(ws + OFF_D256), big ? 8192 : 512,
                big ? PQT + (size_t)16 * 512 * 512 : PQT + (size_t)b * 512 * 512, big ? 8192 : 512, big ? 8192 : 512, m0, n0,
                EpiDft{(u16*)(ws + OFF_AB), big ? 0 : b * 256, big ? 0.0013810679320049757f : 0.005524271728019903f, big ? 1 : 0}, lds);
    }
    pool_phase(p, vb, G);
  }
  SEAM(4)
  if (RUNPH(4))
    gemm_phase((const u16*)(ws + OFF_AB), 1024, (const u16*)(ws + OFF_WOUT_E), 1024, 1024, T, 1024,
               EpiRes{p.in[0], p.in[1], X, mods + 2048}, vb, G, lds);
  SEAM(5)
  if (RUNPH(5)) normmod_phase(p, vb, G, X, X + (size_t)4096 * 1024, p.in[9], 0, 1);
  SEAM(6)
  if (RUNPH(6)) gemm_phase(H, 1024, (const u16*)(ws + OFF_W1), 1024, 1024, T, 4096, EpiRelu2{(u16*)(ws + OFF_M1)}, vb, G, lds);
  SEAM(7)
  if (RUNPH(7)) gemm_phase((const u16*)(ws + OFF_M1), 4096, (const u16*)(ws + OFF_W2), 4096, 4096, T, 1024,
                           EpiRes{X, X + (size_t)4096 * 1024, X, mods + 5120}, vb, G, lds);
  SEAM(8)
  if (RUNPH(8)) normmod_phase(p, vb, G, X, X + (size_t)4096 * 1024, p.in[8] + 1024, 1, 0);
  SEAM(9)
  if (RUNPH(9)) gemm_phase(H, 1024, (const u16*)(ws + OFF_WIN_O), 1024, 1024, T, 2304,
                           EpiQkv{(u16*)(ws + OFF_QKV), (u16*)(ws + OFF_CVTP), (u16*)(ws + OFF_CVTS), (u16*)(ws + OFF_DVTP), (u16*)(ws + OFF_DVTS),
                                  p.out + OUT_NCV, p.out + OUT_NDV}, vb, G, lds);
  SEAM(10)
  if (RUNPH(10)) qkvpost_phase(p, vb, G);
  SEAM(11)
  if (RUNPH(11)) attention_phase(p, vb, G, lds);
  SEAM(12)
  if (RUNPH(12)) combine_phase(p, vb, G);
  SEAM(13)
  if (RUNPH(13)) gemm_phase(H, 1024, (const u16*)(ws + OFF_WOUT_O), 1024, 1024, T, 1024,
                            EpiRes{X, X + (size_t)4096 * 1024, X, mods + 3 * 6144 + 2048}, vb, G, lds);
  SEAM(14)
  if (RUNPH(14)) normmod_phase(p, vb, G, X, X + (size_t)4096 * 1024, p.in[9] + 1024, 1, 1);
  SEAM(15)
  if (RUNPH(15)) gemm_phase(H, 1024, (const u16*)(ws + OFF_W1) + (size_t)4096 * 1024, 1024, 1024, T, 4096, EpiRelu2{(u16*)(ws + OFF_M1)}, vb, G, lds);
  SEAM(16)
  if (RUNPH(16)) gemm_phase((const u16*)(ws + OFF_M1), 4096, (const u16*)(ws + OFF_W2) + (size_t)4096 * 1024, 4096, 4096, T, 1024,
                            EpiRes{X, X + (size_t)4096 * 1024, X, mods + 3 * 6144 + 5120}, vb, G, lds);
}

extern "C" void kernel_launch(void* const* d_in, const int* in_sizes, int n_in, void* d_out, int out_size, void* d_ws, size_t ws_size,
                              hipStream_t stream) {
  static int grid = 0;
  if (!grid) {
    int dev = 0, cus = 0, per_cu = 0;
    hipGetDevice(&dev);
    hipDeviceGetAttribute(&cus, hipDeviceAttributeMultiprocessorCount, dev);
    hipOccupancyMaxActiveBlocksPerMultiprocessor(&per_cu, fwd_kernel, 256, 0);
    if (per_cu < 1) per_cu = 1;
    if (per_cu > 2) per_cu = 2;
    grid = cus * per_cu;
    if (ws_size < WS_END) fprintf(stderr, "workspace too small: %zu < %zu\n", ws_size, (size_t)WS_END);
  }
  Params p{};
  for (int i = 0; i < 31; ++i) p.in[i] = (const float*)d_in[i];
  p.out = (float*)d_out;
  p.ws = (unsigned char*)d_ws;
#if ONE_LAUNCH
  hipMemsetAsync((char*)d_ws + OFF_BAR, 0, XCD_BAR_WORDS * 4, stream);
  int lo = 0, hi = NPH;
  void* args[] = {&p, &lo, &hi};
  hipError_t e = hipLaunchCooperativeKernel((void*)fwd_kernel, dim3(grid), dim3(256), args, 0, stream);
  if (e != hipSuccess) fprintf(stderr, "cooperative launch failed: %s (grid %d)\n", hipGetErrorString(e), grid);
#else
  for (int ph = 0; ph < NPH; ++ph) hipLaunchKernelGGL(fwd_kernel, dim3(grid), dim3(256), 0, stream, p, ph, ph + 1);
#endif
}
```

```cpp
#include <hip/hip_runtime.h>
#include <hip/hip_cooperative_groups.h>
#include <cstdio>
namespace cg = cooperative_groups;

#ifndef ONE_LAUNCH
#define ONE_LAUNCH 1
#endif

#ifndef ONLYPH
#define ONLYPH -1
#endif
#ifndef DUPPH
#define DUPPH -1
#endif
typedef unsigned short u16;
typedef short bf16x8 __attribute__((ext_vector_type(8)));
typedef float f32x16 __attribute__((ext_vector_type(16)));
typedef __bf16 bf2_t __attribute__((ext_vector_type(2)));
typedef float f2_t __attribute__((ext_vector_type(2)));
typedef unsigned u32x4 __attribute__((ext_vector_type(4)));

#define DI __device__ __forceinline__

constexpr int T = 12288, TP = 4096, DM = 1024;
constexpr int NPH = 18;
constexpr float EPS = 1e-6f;
constexpr float LOG2E = 1.4426950408889634f;
constexpr float QSCALE = 0.125f * LOG2E;
constexpr float LAM_INIT = 0.35550906759f;

constexpr size_t al(size_t x) { return (x + 255) & ~size_t(255); }
constexpr size_t OFF_MODS   = 0;
constexpr size_t OFF_WIN_E  = OFF_MODS + al(2 * 3 * 6144 * 4);
constexpr size_t OFF_WINB   = OFF_WIN_E + al(1536 * 1024 * 2);
constexpr size_t OFF_CBD    = OFF_WINB + al(1024 * 512 * 2);
constexpr size_t OFF_WOUT_ET= OFF_CBD + al(1024 * 512 * 2);
constexpr size_t OFF_BD     = OFF_WOUT_ET + al(1024 * 1024 * 2);
constexpr size_t OFF_WOUT_E = OFF_BD + al(1024 * 1024 * 2);
constexpr size_t OFF_WIN_O  = OFF_WOUT_E + al(1024 * 1024 * 2);
constexpr size_t OFF_WOUT_O = OFF_WIN_O + al(2304 * 1024 * 2);
constexpr size_t OFF_W1     = OFF_WOUT_O + al(1024 * 1024 * 2);
constexpr size_t OFF_W2     = OFF_W1 + al(2 * 4096 * 1024 * 2);
constexpr size_t OFF_D256   = OFF_W2 + al(2 * 4096 * 1024 * 2);
constexpr size_t OFF_H      = OFF_D256 + al(256 * 512 * 2);
constexpr size_t OFF_R2     = OFF_H + al((size_t)T * 1024 * 2);
constexpr size_t R2_BYTES   = (size_t)T * 512 * 2 + (size_t)T * 1024 * 2 * 2;
constexpr size_t OFF_R1     = OFF_R2 + al(R2_BYTES);
constexpr size_t R1_BYTES   = (size_t)T * 4096 * 2;
constexpr size_t OFF_BAR    = OFF_R1 + R1_BYTES;
constexpr size_t WS_END     = OFF_BAR + 3456 * 4;
constexpr size_t OFF_UA  = OFF_R2;
constexpr size_t OFF_PQT = OFF_UA + (size_t)T * 512 * 2;
constexpr size_t OFF_AB  = OFF_PQT + (size_t)T * 1024 * 2;
constexpr size_t OFF_CQ   = OFF_R2;
constexpr size_t OFF_DQ   = OFF_CQ + (size_t)T * 512 * 2;
constexpr size_t OFF_CKP  = OFF_DQ + (size_t)T * 512 * 2;
constexpr size_t OFF_CKS  = OFF_CKP + (size_t)16 * 8 * 256 * 64 * 2;
constexpr size_t OFF_CVTP = OFF_CKS + (size_t)2 * 8 * 4608 * 64 * 2;
constexpr size_t OFF_CVTS = OFF_CVTP + (size_t)16 * 4 * 128 * 256 * 2;
constexpr size_t OFF_DKP  = OFF_CVTS + (size_t)2 * 4 * 128 * 4608 * 2;
constexpr size_t OFF_DKS  = OFF_DKP + (size_t)16 * 2 * 256 * 64 * 2;
constexpr size_t OFF_DVTP = OFF_DKS + (size_t)2 * 2 * 4608 * 64 * 2;
constexpr size_t OFF_DVTS = OFF_DVTP + (size_t)16 * 2 * 64 * 256 * 2;
constexpr size_t R2_LATE_END = OFF_DVTS + (size_t)2 * 2 * 64 * 4608 * 2;
static_assert(R2_LATE_END <= OFF_R2 + R2_BYTES, "R2 overflow");
constexpr size_t OFF_D4096 = OFF_R1;
constexpr size_t OFF_PEQO  = OFF_R1 + (size_t)32 * 1024 * 1024;
constexpr size_t OFF_M1    = OFF_R1;
constexpr size_t OFF_QKV   = OFF_R1;
constexpr size_t OFF_OM    = OFF_R1 + al((size_t)T * 2304 * 2);
static_assert(OFF_OM + (size_t)T * 1024 * 2 <= WS_END, "R1 overflow");

constexpr size_t OUT_Y   = 0;
constexpr size_t OUT_NCK = (size_t)T * 1024;
constexpr size_t OUT_NCV = OUT_NCK + (size_t)TP * 512;
constexpr size_t OUT_NDK = OUT_NCV + (size_t)TP * 512;
constexpr size_t OUT_NDV = OUT_NDK + (size_t)TP * 128;

struct Params {
  const float* in[31];
  float* out;
  unsigned char* ws;
};

DI float bf2f(u16 v) { return __uint_as_float(((unsigned)v) << 16); }
DI unsigned pack2(float a, float b) { f2_t f = {a, b}; bf2_t v = __builtin_convertvector(f, bf2_t); return __builtin_bit_cast(unsigned, v); }
DI u16 f2bf(float a) { return (u16)(pack2(a, 0.f) & 0xffffu); }
DI int cond_of(int m) { return m < 4096 ? 0 : (m < 8192 ? 1 : 2); }
DI float wave_sum(float v) {
#pragma unroll
  for (int o = 32; o >= 1; o >>= 1) v += __shfl_xor(v, o);
  return v;
}
#define MFMA(a, b, c) __builtin_amdgcn_mfma_f32_32x32x16_bf16((a), (b), (c), 0, 0, 0)

constexpr int LROW = 144;
constexpr int GEMM_BUF = 2 * 128 * LROW;
constexpr int LDS_BYTES = 2 * GEMM_BUF;

template <int NR>
DI void g_load(u32x4 (&R)[NR], const u16* g, int ld, int k0) {
#pragma unroll
  for (int i = 0; i < NR; ++i) R[i] = *(const u32x4*)(g + (size_t)(32 * i) * ld + k0);
}
template <int NR>
DI void g_store(const u32x4 (&R)[NR], char* sw) {
#pragma unroll
  for (int i = 0; i < NR; ++i) *(u32x4*)(sw + (32 * i) * LROW) = R[i];
}
template <int NB>
DI void g_compute(f32x16 (&acc)[2][NB], const char* fa, const char* fb) {
#pragma unroll
  for (int ks = 0; ks < 4; ++ks) {
    bf16x8 a0 = *(const bf16x8*)(fa + ks * 32);
    bf16x8 a1 = *(const bf16x8*)(fa + 32 * LROW + ks * 32);
#pragma unroll
    for (int j = 0; j < NB; ++j) {
      bf16x8 b = *(const bf16x8*)(fb + j * 32 * LROW + ks * 32);
      acc[0][j] = MFMA(a0, b, acc[0][j]);
      acc[1][j] = MFMA(a1, b, acc[1][j]);
    }
  }
}
template <int NB>
DI void gemm_acc(f32x16 (&acc)[2][NB], const u16* A, int lda, const u16* Bt, int ldb, int K, int m0, int n0, char* lds) {
  const int tid = threadIdx.x, lane = tid & 63, wave = tid >> 6;
  const int r = lane & 31, h = lane >> 5;
  const int wm = wave >> 1, wn = wave & 1;
  const int lrow = tid >> 3, lcol = (tid & 7) * 8;
  const u16* ga = A + (size_t)(m0 + lrow) * lda + lcol;
  const u16* gb = Bt + (size_t)(n0 + lrow) * ldb + lcol;
  u32x4 ra0[4], ra1[4], rb0[2 * NB], rb1[2 * NB];
  const int nk = K >> 6;
  char* sw = lds + lrow * LROW + lcol * 2;
  const char* fa = lds + (wm * 64 + r) * LROW + h * 16;
  const char* fb = lds + 128 * LROW + (wn * 32 * NB + r) * LROW + h * 16;
#define G_LOAD(RA, RB, kt_) do { const int k0_ = ((kt_) < nk ? (kt_) : nk - 1) << 6; g_load<4>(RA, ga, lda, k0_); g_load<2 * NB>(RB, gb, ldb, k0_); } while (0)
#define G_STORE(RA, RB, boff_) do { g_store<4>(RA, sw + (boff_)); g_store<2 * NB>(RB, sw + (boff_) + 128 * LROW); } while (0)
  G_LOAD(ra0, rb0, 0);
  G_LOAD(ra1, rb1, 1);
  G_STORE(ra0, rb0, 0);
  __syncthreads();
  for (int kt = 0; kt < nk; kt += 2) {
    G_LOAD(ra0, rb0, kt + 2);
    g_compute<NB>(acc, fa, fb);
    G_STORE(ra1, rb1, GEMM_BUF);
    __syncthreads();
    G_LOAD(ra1, rb1, kt + 3);
    g_compute<NB>(acc, fa + GEMM_BUF, fb + GEMM_BUF);
    G_STORE(ra0, rb0, 0);
    __syncthreads();
  }
#undef G_LOAD
#undef G_STORE
}

template <class Epi>
DI void gemm_tile(const u16* A, int lda, const u16* Bt, int ldb, int K, int m0, int n0, Epi epi, char* lds) {
  const int lane = threadIdx.x & 63, wave = threadIdx.x >> 6;
  const int r = lane & 31, h = lane >> 5, wm = wave >> 1, wn = wave & 1;
  f32x16 acc[2][2];
#pragma unroll
  for (int i = 0; i < 2; ++i)
#pragma unroll
    for (int j = 0; j < 2; ++j)
#pragma unroll
      for (int e = 0; e < 16; ++e) acc[i][j][e] = 0.f;
  gemm_acc<2>(acc, A, lda, Bt, ldb, K, m0, n0, lds);
#pragma unroll
  for (int i = 0; i < 2; ++i)
#pragma unroll
    for (int j = 0; j < 2; ++j)
#pragma unroll
      for (int q = 0; q < 4; ++q) {
        const int m = m0 + wm * 64 + i * 32 + 8 * q + 4 * h;
        const int n = n0 + wn * 64 + j * 32 + r;
        epi(m, n, acc[i][j][4 * q], acc[i][j][4 * q + 1], acc[i][j][4 * q + 2], acc[i][j][4 * q + 3]);
      }
}

DI void dft_tile(const u16* Dm, const u16* PeQo, const u16* PH, int phstride, int H, int m0, int n0, u16* AB, int rowbase, int colsPerBatch, float norm, char* lds) {
  const int lane = threadIdx.x & 63, wave = threadIdx.x >> 6;
  const int r = lane & 31, h = lane >> 5, wm = wave >> 1, wn = wave & 1;
  f32x16 accA[2][1], accB[2][1];
#pragma unroll
  for (int i = 0; i < 2; ++i)
#pragma unroll
    for (int e = 0; e < 16; ++e) { accA[i][0][e] = 0.f; accB[i][0][e] = 0.f; }
  gemm_acc<1>(accA, Dm, 2 * H, PeQo, 2 * H, H, m0, n0, lds);
  gemm_acc<1>(accB, Dm + H, 2 * H, PeQo + H, 2 * H, H, m0, n0, lds);
  const int N = 2 * H;
  const int col = n0 + wn * 32 + r;
  const int b = col / colsPerBatch, c = col - b * colsPerBatch;
  const float ph = bf2f(PH[(size_t)col * phstride]);
  u16* base = AB + ((size_t)rowbase + (size_t)b * N) * 1024 + 512 + c;
#pragma unroll
  for (int i = 0; i < 2; ++i)
#pragma unroll
    for (int q = 0; q < 4; ++q)
#pragma unroll
      for (int e = 0; e < 4; ++e) {
        const int k = m0 + wm * 64 + i * 32 + 8 * q + 4 * h + e;
        const float a = accA[i][0][4 * q + e] + ((k & 1) ? -ph : ph);
        const float bb = accB[i][0][4 * q + e];
        base[(size_t)k * 1024] = f2bf((a - bb) * norm);
        if (k > 0) base[(size_t)(N - k) * 1024] = f2bf((a + bb) * norm);
      }
}

struct EpiBf16 {
  u16* C; int ldc;
  DI void operator()(int m, int n, float v0, float v1, float v2, float v3) const {
    u16* p = C + (size_t)m * ldc + n;
    p[0] = f2bf(v0); p[ldc] = f2bf(v1); p[2 * ldc] = f2bf(v2); p[3 * ldc] = f2bf(v3);
  }
};
struct EpiU {
  u16* UA; u16* PQt;
  DI void operator()(int m, int n, float v0, float v1, float v2, float v3) const {
    if (n < 512) {
      u16* p = UA + (size_t)m * 512 + n;
      p[0] = f2bf(v0); p[512] = f2bf(v1); p[1024] = f2bf(v2); p[1536] = f2bf(v3);
    } else {
      const int np = n - 512, g = np >> 8, pq = (np >> 7) & 1, mm = np & 127;
      size_t off;
      if (m < 4096) { const int b = m >> 8, nl = m & 255; off = ((size_t)(b * 512 + g * 128 + mm)) * 512 + pq * 256 + nl; }
      else { const int ms = m - 4096, b = ms >> 12, nl = ms & 4095; off = (size_t)16 * 512 * 512 + ((size_t)(b * 512 + g * 128 + mm)) * 8192 + pq * 4096 + nl; }
      uint2 w; w.x = pack2(v0, v1); w.y = pack2(v2, v3);
      *(uint2*)(PQt + off) = w;
    }
  }
};
struct EpiDft {
  u16* AB; int rowbase; float norm; int sample;
  DI void operator()(int m, int n, float v0, float v1, float v2, float v3) const {
    size_t row; int c;
    if (sample) { row = (size_t)4096 + (size_t)(n >> 9) * 4096 + m; c = n & 511; }
    else { row = (size_t)rowbase + m; c = n; }
    u16* p = AB + row * 1024 + 512 + c;
    p[0] = f2bf(v0 * norm); p[1024] = f2bf(v1 * norm); p[2048] = f2bf(v2 * norm); p[3072] = f2bf(v3 * norm);
  }
};
struct EpiRes {
  const float* xin_p; const float* xin_s;
  float* X; const float* gate;
  DI void operator()(int m, int n, float v0, float v1, float v2, float v3) const {
    const float* xi = (m < 4096) ? xin_p + (size_t)m * 1024 + n : xin_s + (size_t)(m - 4096) * 1024 + n;
    const float g = gate[cond_of(m) * 6144 + n];
    float* xo = X + (size_t)m * 1024 + n;
    xo[0] = xi[0] + g * v0; xo[1024] = xi[1024] + g * v1; xo[2048] = xi[2048] + g * v2; xo[3072] = xi[3072] + g * v3;
  }
};
struct EpiRelu2 {
  u16* C;
  DI void operator()(int m, int n, float v0, float v1, float v2, float v3) const {
    v0 = fmaxf(v0, 0.f); v1 = fmaxf(v1, 0.f); v2 = fmaxf(v2, 0.f); v3 = fmaxf(v3, 0.f);
    u16* p = C + (size_t)m * 4096 + n;
    p[0] = f2bf(v0 * v0); p[4096] = f2bf(v1 * v1); p[8192] = f2bf(v2 * v2); p[12288] = f2bf(v3 * v3);
  }
};
struct EpiQkv {
  u16* QKV; u16* CVtP; u16* CVtS; u16* DVtP; u16* DVtS; float* ncv; float* ndv;
  DI void operator()(int m, int n, float v0, float v1, float v2, float v3) const {
    const bool is_cv = (n >= 1024 && n < 1536), is_dv = (n >= 2176);
    if (!is_cv && !is_dv) {
      u16* p = QKV + (size_t)m * 2304 + n;
      p[0] = f2bf(v0); p[2304] = f2bf(v1); p[4608] = f2bf(v2); p[6912] = f2bf(v3);
      return;
    }
    uint2 w; w.x = pack2(v0, v1); w.y = pack2(v2, v3);
    if (is_cv) {
      const int c = n - 1024;
      if (m < 4096) {
        const int b = m >> 8, nl = m & 255;
        *(uint2*)(CVtP + ((size_t)(b * 512 + c)) * 256 + nl) = w;
        float* o = ncv + (size_t)m * 512 + c; o[0] = v0; o[512] = v1; o[1024] = v2; o[1536] = v3;
      } else {
        const int ms = m - 4096, b = ms >> 12, nl = ms & 4095;
        *(uint2*)(CVtS + ((size_t)(b * 512 + c)) * 4608 + 512 + nl) = w;
      }
    } else {
      const int c = n - 2176;
      if (m < 4096) {
        const int b = m >> 8, nl = m & 255;
        *(uint2*)(DVtP + ((size_t)(b * 128 + c)) * 256 + nl) = w;
        float* o = ndv + (size_t)m * 128 + c; o[0] = v0; o[128] = v1; o[256] = v2; o[384] = v3;
      } else {
        const int ms = m - 4096, b = ms >> 12, nl = ms & 4095;
        *(uint2*)(DVtS + ((size_t)(b * 128 + c)) * 4608 + 512 + nl) = w;
      }
    }
  }
};

DI void ada_item(const Params& p, int id, char* lds) {
  const int tid = threadIdx.x;
  float* ssil = (float*)lds;
  float* red = (float*)(lds + 12288);
  const int l = id / 192, cb = id % 192;
  for (int i = tid; i < 3072; i += 256) {
    const int j = i >> 10, k = i & 1023;
    const float v = (j == 0) ? p.in[7][k] : p.in[2][(j - 1) * 1024 + k];
    ssil[i] = v / (1.f + __expf(-v));
  }
  __syncthreads();
  const int cq = tid & 7, kg = tid >> 3;
  const float* w = p.in[10] + (size_t)l * 1024 * 6144 + cb * 32 + cq * 4;
  float4 a0 = {0, 0, 0, 0}, a1 = {0, 0, 0, 0}, a2 = {0, 0, 0, 0};
#pragma unroll 8
  for (int kk = 0; kk < 32; ++kk) {
    const int k = kg * 32 + kk;
    const float4 wv = *(const float4*)(w + (size_t)k * 6144);
    const float s0 = ssil[k], s1 = ssil[1024 + k], s2 = ssil[2048 + k];
    a0.x += s0 * wv.x; a0.y += s0 * wv.y; a0.z += s0 * wv.z; a0.w += s0 * wv.w;
    a1.x += s1 * wv.x; a1.y += s1 * wv.y; a1.z += s1 * wv.z; a1.w += s1 * wv.w;
    a2.x += s2 * wv.x; a2.y += s2 * wv.y; a2.z += s2 * wv.z; a2.w += s2 * wv.w;
  }
  float* rp = red + kg * 96 + cq * 4;
  rp[0] = a0.x; rp[1] = a0.y; rp[2] = a0.z; rp[3] = a0.w;
  rp[32] = a1.x; rp[33] = a1.y; rp[34] = a1.z; rp[35] = a1.w;
  rp[64] = a2.x; rp[65] = a2.y; rp[66] = a2.z; rp[67] = a2.w;
  __syncthreads();
  if (tid < 96) {
    const int j = tid >> 5, c = tid & 31;
    float sum = 0.f;
#pragma unroll
    for (int g = 0; g < 32; ++g) sum += red[g * 96 + j * 32 + c];
    const int col = cb * 32 + c;
    ((float*)(p.ws + OFF_MODS))[(size_t)(l * 3 + j) * 6144 + col] = sum + p.in[11][l * 6144 + col];
  }
  __syncthreads();
}

DI void transpose_tile(const float* src, int ld_src, u16* dst, int ld_dst, int r0, int c0, char* lds) {
  float* tile = (float*)lds;
  const int tid = threadIdx.x;
  const int j4 = (tid & 15) * 4, i0 = tid >> 4;
#pragma unroll
  for (int it = 0; it < 4; ++it) {
    const int i = i0 + 16 * it;
    const float4 v = *(const float4*)(src + (size_t)(r0 + i) * ld_src + c0 + j4);
    float* tp = tile + i * 65 + j4;
    tp[0] = v.x; tp[1] = v.y; tp[2] = v.z; tp[3] = v.w;
  }
  __syncthreads();
  const int kc = (tid & 7) * 8, jr = tid >> 3;
#pragma unroll
  for (int it = 0; it < 2; ++it) {
    const int j = jr + 32 * it;
    const float* tp = tile + kc * 65 + j;
    uint4 o;
    o.x = pack2(tp[0], tp[65]); o.y = pack2(tp[130], tp[195]); o.z = pack2(tp[260], tp[325]); o.w = pack2(tp[390], tp[455]);
    *(uint4*)(dst + (size_t)(c0 + j) * ld_dst + r0 + kc) = o;
  }
  __syncthreads();
}

DI void prep_transposes(const Params& p, int vb, int G, char* lds) {
  for (int t = vb; t < 5312; t += G) {
    const float* src; u16* dst; int lds_, ldd, r0, c0;
    int q = t;
    if (q < 128) { src = p.in[12]; lds_ = 1024; dst = (u16*)(p.ws + OFF_WIN_E); ldd = 1024; r0 = (q >> 3) * 64; c0 = (q & 7) * 64; }
    else if ((q -= 128) < 256) { src = p.in[16]; lds_ = 1024; dst = (u16*)(p.ws + OFF_WOUT_ET); ldd = 1024; r0 = (q >> 4) * 64; c0 = (q & 15) * 64; }
    else if ((q -= 256) < 576) { src = p.in[17]; lds_ = 2304; dst = (u16*)(p.ws + OFF_WIN_O); ldd = 1024; r0 = (q / 36) * 64; c0 = (q % 36) * 64; }
    else if ((q -= 576) < 256) { src = p.in[28]; lds_ = 1024; dst = (u16*)(p.ws + OFF_WOUT_O); ldd = 1024; r0 = (q >> 4) * 64; c0 = (q & 15) * 64; }
    else if ((q -= 256) < 2048) { const int l = q >> 10; q &= 1023; src = p.in[29] + (size_t)l * 1024 * 4096; lds_ = 4096; dst = (u16*)(p.ws + OFF_W1) + (size_t)l * 4096 * 1024; ldd = 1024; r0 = (q >> 6) * 64; c0 = (q & 63) * 64; }
    else { q -= 2048; const int l = q >> 10; q &= 1023; src = p.in[30] + (size_t)l * 4096 * 1024; lds_ = 1024; dst = (u16*)(p.ws + OFF_W2) + (size_t)l * 1024 * 4096; ldd = 4096; r0 = (q >> 4) * 64; c0 = (q & 15) * 64; }
    transpose_tile(src, lds_, dst, ldd, r0, c0, lds);
  }
}

DI void prep_elementwise(const Params& p, int vb, int G) {
  const size_t gt = (size_t)vb * 256 + threadIdx.x, gs = (size_t)G * 256;
  {
    u16* d = (u16*)(p.ws + OFF_WINB);
    for (size_t i = gt; i < 1024 * 256; i += gs) {
      const int k = (int)(i >> 8), c = (int)(i & 255) * 2;
      const float* s = p.in[12] + (size_t)k * 1024 + 512 + c;
      *(unsigned*)(d + (size_t)k * 512 + c) = pack2(s[0], s[1]);
    }
  }
  {
    u16* d = (u16*)(p.ws + OFF_CBD);
    for (size_t i = gt; i < 1024 * 512; i += gs) {
      const int np = (int)(i >> 9), cp = (int)(i & 511);
      const int g = np >> 8, pq = (np >> 7) & 1, m = np & 127;
      float v = 0.f;
      if ((cp >> 7) == g) {
        const int c = cp & 127; const int rr = (m * c) & 127;
        const float x = (float)rr * (2.0f / 128.0f);
        v = pq ? sinpif(x) : cospif(x);
      }
      d[i] = f2bf(v);
    }
  }
  {
    u16* d = (u16*)(p.ws + OFF_BD);
    for (size_t i = gt; i < 1024 * 1024; i += gs) {
      const int kp = (int)(i >> 10), c = (int)(i & 1023);
      float v = 0.f;
      if (kp < 512) { const int g = kp >> 7; if (c < 512 && (c >> 7) == g) v = p.in[13][(size_t)g * 16384 + (kp & 127) * 128 + (c & 127)] * p.in[14][c]; }
      else { const int g = (kp - 512) >> 7; if (c >= 512 && ((c - 512) >> 7) == g) v = p.in[15][(size_t)g * 16384 + ((kp - 512) & 127) * 128 + ((c - 512) & 127)]; }
      d[i] = f2bf(v);
    }
  }
#pragma unroll 1
  for (int which = 0; which < 2; ++which) {
    const int H = which ? 2048 : 128, N = 2 * H, lg = which ? 9 : 5;
    u16* d = (u16*)(p.ws + (which ? OFF_D4096 : OFF_D256));
    const float invN = 1.0f / (float)N;
    for (size_t i = gt; i < ((size_t)H << lg); i += gs) {
      const int k = (int)(i >> lg), np = (int)(i & ((1 << lg) - 1)) * 8;
      const bool is_sin = np >= H;
      const int n = np & (H - 1);
      unsigned w[4];
#pragma unroll
      for (int e = 0; e < 4; ++e) {
        const float x0 = (float)((k * (n + 2 * e)) & (N - 1)) * invN, x1 = (float)((k * (n + 2 * e + 1)) & (N - 1)) * invN;
        const float v0 = is_sin ? __builtin_amdgcn_sinf(x0) : __builtin_amdgcn_cosf(x0);
        const float v1 = is_sin ? __builtin_amdgcn_sinf(x1) : __builtin_amdgcn_cosf(x1);
        w[e] = pack2(v0, v1);
      }
      *(uint4*)(d + (size_t)k * N + np) = make_uint4(w[0], w[1], w[2], w[3]);
    }
  }
}

DI void sym_phase(const Params& p, int vb, int G) {
  const int lane = threadIdx.x & 63, wave = threadIdx.x >> 6;
  const u16* PQT = (const u16*)(p.ws + OFF_PQT);
  u16* PEQO = (u16*)(p.ws + OFF_PEQO);
  u16* AB = (u16*)(p.ws + OFF_AB);
  for (int it = vb * 4 + wave; it < 1024 + 2048; it += G * 4) {
    const bool samp = it < 1024;
    const int H = samp ? 2048 : 128, N = 2 * H;
    int col, n0base, nstep;
    if (samp) { col = it; n0base = lane * 8; nstep = 512; }
    else { col = (it - 1024) * 4 + (lane >> 4); n0base = (lane & 15) * 8; nstep = 128; }
    const u16* Pp = samp ? PQT + (size_t)16 * 512 * 512 + (size_t)col * 8192 : PQT + (size_t)col * 512;
    const u16* Qp = Pp + N;
    u16* Pe = samp ? PEQO + (size_t)16 * 512 * 256 + (size_t)col * 4096 : PEQO + (size_t)col * 256;
    u16* Qo = Pe + H;
    float alt = 0.f;
    for (int n0 = n0base; n0 < H; n0 += nstep) {
      const uint4 pw = *(const uint4*)(Pp + n0), qw = *(const uint4*)(Qp + n0);
      const unsigned pa[4] = {pw.x, pw.y, pw.z, pw.w}, qa[4] = {qw.x, qw.y, qw.z, qw.w};
      float pe[8], qo[8];
#pragma unroll
      for (int e = 0; e < 8; ++e) {
        const float pv = (e & 1) ? __uint_as_float(pa[e >> 1] & 0xffff0000u) : __uint_as_float(pa[e >> 1] << 16);
        const float qv = (e & 1) ? __uint_as_float(qa[e >> 1] & 0xffff0000u) : __uint_as_float(qa[e >> 1] << 16);
        const int n = n0 + e;
        float pm = 0.f, qm = 0.f;
        if (n > 0) { pm = bf2f(Pp[N - n]); qm = bf2f(Qp[N - n]); }
        pe[e] = pv + pm;
        qo[e] = (n > 0) ? qv - qm : 0.f;
        alt += (e & 1) ? -pe[e] : pe[e];
      }
      *(uint4*)(Pe + n0) = make_uint4(pack2(pe[0], pe[1]), pack2(pe[2], pe[3]), pack2(pe[4], pe[5]), pack2(pe[6], pe[7]));
      *(uint4*)(Qo + n0) = make_uint4(pack2(qo[0], qo[1]), pack2(qo[2], qo[3]), pack2(qo[4], qo[5]), pack2(qo[6], qo[7]));
    }
    alt += __shfl_xor(alt, 1); alt += __shfl_xor(alt, 2); alt += __shfl_xor(alt, 4); alt += __shfl_xor(alt, 8);
    if (samp) { alt += __shfl_xor(alt, 16); alt += __shfl_xor(alt, 32); }
    if ((samp && lane == 0) || (!samp && (lane & 15) == 0)) {
      const float fh = alt + bf2f(Pp[H]);
      size_t row; int c; float norm;
      if (samp) { row = (size_t)4096 + (size_t)(col >> 9) * 4096 + 2048; c = col & 511; norm = 0.0013810679320049757f; }
      else { row = (size_t)(col >> 9) * 256 + 128; c = col & 511; norm = 0.005524271728019903f; }
      AB[row * 1024 + 512 + c] = f2bf(fh * norm);
    }
  }
}

DI void normmod_phase(const Params& p, int vb, int G, const float* xp, const float* xs, const float* gain, int l, int which) {
  const int lane = threadIdx.x & 63, wave = threadIdx.x >> 6;
  u16* H = (u16*)(p.ws + OFF_H);
  const float* mods = (const float*)(p.ws + OFF_MODS) + (size_t)l * 3 * 6144;
  for (int row = vb * 4 + wave; row < T; row += G * 4) {
    const float* x = (row < 4096) ? xp + (size_t)row * 1024 : xs + (size_t)(row - 4096) * 1024;
    float4 v[4];
    float ss = 0.f;
#pragma unroll
    for (int i = 0; i < 4; ++i) {
      v[i] = *(const float4*)(x + i * 256 + lane * 4);
      ss += v[i].x * v[i].x + v[i].y * v[i].y + v[i].z * v[i].z + v[i].w * v[i].w;
    }
    ss = wave_sum(ss);
    const float rinv = rsqrtf(ss * (1.0f / 1024.0f) + EPS);
    const float* md = mods + cond_of(row) * 6144 + which * 3072;
#pragma unroll
    for (int i = 0; i < 4; ++i) {
      const int c = i * 256 + lane * 4;
      const float4 g = *(const float4*)(gain + c);
      const float4 sh = *(const float4*)(md + c);
      const float4 sc = *(const float4*)(md + 1024 + c);
      const float o0 = v[i].x * rinv * g.x * (1.f + sc.x) + sh.x;
      const float o1 = v[i].y * rinv * g.y * (1.f + sc.y) + sh.y;
      const float o2 = v[i].z * rinv * g.z * (1.f + sc.z) + sh.z;
      const float o3 = v[i].w * rinv * g.w * (1.f + sc.w) + sh.w;
      uint2 w; w.x = pack2(o0, o1); w.y = pack2(o2, o3);
      *(uint2*)(H + (size_t)row * 1024 + c) = w;
    }
  }
}

template <class Epi>
DI void gemm_phase(const u16* A, int lda, const u16* Bt, int ldb, int K, int M, int N, Epi epi, int vb, int G, char* lds) {
  const int nN = N >> 7, nt = (M >> 7) * nN, grp = 8 * nN;
  for (int t = vb; t < nt; t += G) {
    const int gi = t / grp, rem = t - gi * grp;
    gemm_tile(A, lda, Bt, ldb, K, (gi * 8 + (rem & 7)) << 7, (rem >> 3) << 7, epi, lds);
  }
}

DI void pool_phase(const Params& p, int vb, int G) {
  const u16* UA = (const u16*)(p.ws + OFF_UA);
  u16* AB = (u16*)(p.ws + OFF_AB);
  const size_t gt = (size_t)vb * 256 + threadIdx.x, gs = (size_t)G * 256;
  for (size_t i = gt; i < (size_t)T * 64; i += gs) {
    const int t = (int)(i >> 6), c8 = (int)(i & 63) * 8;
    const int g = c8 >> 7, hw = 1 << g;
    int nl, N, base;
    if (t < 4096) { nl = t & 255; N = 256; base = t - nl; } else { nl = (t - 4096) & 4095; N = 4096; base = t - nl; }
    const int lo = max(nl - hw, 0), hi = min(nl + hw, N);
    float s[8] = {0, 0, 0, 0, 0, 0, 0, 0};
    for (int j = lo; j < hi; ++j) {
      const uint4 w = *(const uint4*)(UA + (size_t)(base + j) * 512 + c8);
      s[0] += __uint_as_float(w.x << 16); s[1] += __uint_as_float(w.x & 0xffff0000u);
      s[2] += __uint_as_float(w.y << 16); s[3] += __uint_as_float(w.y & 0xffff0000u);
      s[4] += __uint_as_float(w.z << 16); s[5] += __uint_as_float(w.z & 0xffff0000u);
      s[6] += __uint_as_float(w.w << 16); s[7] += __uint_as_float(w.w & 0xffff0000u);
    }
    const float inv = 1.0f / (float)(hi - lo);
    const uint4 w = *(const uint4*)(UA + (size_t)t * 512 + c8);
    uint4 o;
    o.x = pack2(s[0] * inv - __uint_as_float(w.x << 16), s[1] * inv - __uint_as_float(w.x & 0xffff0000u));
    o.y = pack2(s[2] * inv - __uint_as_float(w.y << 16), s[3] * inv - __uint_as_float(w.y & 0xffff0000u));
    o.z = pack2(s[4] * inv - __uint_as_float(w.z << 16), s[5] * inv - __uint_as_float(w.z & 0xffff0000u));
    o.w = pack2(s[6] * inv - __uint_as_float(w.w << 16), s[7] * inv - __uint_as_float(w.w & 0xffff0000u));
    *(uint4*)(AB + (size_t)t * 1024 + c8) = o;
  }
}

DI void qkvpost_phase(const Params& p, int vb, int G) {
  const int lane = threadIdx.x & 63, wave = threadIdx.x >> 6;
  const int q = lane & 15, sub = lane >> 4;
  const u16* QKV = (const u16*)(p.ws + OFF_QKV);
  u16* CQ = (u16*)(p.ws + OFF_CQ); u16* DQ = (u16*)(p.ws + OFF_DQ);
  u16* CKP = (u16*)(p.ws + OFF_CKP); u16* CKS = (u16*)(p.ws + OFF_CKS);
  u16* DKP = (u16*)(p.ws + OFF_DKP); u16* DKS = (u16*)(p.ws + OFF_DKS);
  float* nck = p.out + OUT_NCK; float* ndk = p.out + OUT_NDK;
  const int d0 = q * 4;
  float fr[4];
#pragma unroll
  for (int e = 0; e < 4; ++e) fr[e] = exp2f(-(float)((d0 + e) & 15) * (13.287712379549449f / 16.0f));
  const bool firsthalf = ((d0 >> 4) & 1) == 0;
  for (int t = vb * 4 + wave; t < T; t += G * 4) {
    const bool samp = t >= 4096;
    int b, nl;
    if (!samp) { b = t >> 8; nl = t & 255; } else { b = (t - 4096) >> 12; nl = (t - 4096) & 4095; }
    float cs[4], sn[4];
    if (samp) {
      const float pos = (d0 < 32) ? (float)(nl >> 6) : (float)(nl & 63);
#pragma unroll
      for (int e = 0; e < 4; ++e) { const float a = pos * fr[e]; cs[e] = cosf(a); sn[e] = sinf(a); }
    } else {
#pragma unroll
      for (int e = 0; e < 4; ++e) { cs[e] = 1.f; sn[e] = 0.f; }
    }
    for (int rd = 0; rd < 7; ++rd) {
      const int slot = rd * 4 + sub;
      const bool act = slot < 26;
      const int vi = act ? (slot < 16 ? slot : slot + 8) : 0;
      const uint2 raw = *(const uint2*)(QKV + (size_t)t * 2304 + vi * 64 + d0);
      float x[4] = {__uint_as_float(raw.x << 16), __uint_as_float(raw.x & 0xffff0000u), __uint_as_float(raw.y << 16), __uint_as_float(raw.y & 0xffff0000u)};
      float ss = x[0] * x[0] + x[1] * x[1] + x[2] * x[2] + x[3] * x[3];
      ss += __shfl_xor(ss, 1); ss += __shfl_xor(ss, 2); ss += __shfl_xor(ss, 4); ss += __shfl_xor(ss, 8);
      const float rinv = rsqrtf(ss * (1.0f / 64.0f) + EPS);
      const float* gp = (vi < 8) ? p.in[18] : (vi < 16) ? p.in[19] : (vi < 32) ? p.in[25] : p.in[26];
      const float4 g = *(const float4*)(gp + d0);
      float y[4] = {x[0] * rinv * g.x, x[1] * rinv * g.y, x[2] * rinv * g.z, x[3] * rinv * g.w};
      float o[4];
#pragma unroll
      for (int e = 0; e < 4; ++e) {
        const float part = __shfl_xor(y[e], 4);
        o[e] = firsthalf ? (y[e] * cs[e] - part * sn[e]) : (y[e] * cs[e] + part * sn[e]);
      }
      if (!act) continue;
      const bool isq = (vi < 8) || (vi >= 24 && vi < 32);
      if (isq) {
        const int hd = (vi < 8) ? vi : vi - 24;
        u16* base = (vi < 8) ? CQ : DQ;
        size_t off = samp ? (size_t)16 * 8 * 256 * 64 + ((size_t)(b * 8 + hd) * 4096 + nl) * 64 : ((size_t)(b * 8 + hd) * 256 + nl) * 64;
        uint2 w; w.x = pack2(o[0] * QSCALE, o[1] * QSCALE); w.y = pack2(o[2] * QSCALE, o[3] * QSCALE);
        *(uint2*)(base + off + d0) = w;
      } else if (vi < 16) {
        const int hm = vi - 8;
        uint2 w; w.x = pack2(o[0], o[1]); w.y = pack2(o[2], o[3]);
        if (samp) *(uint2*)(CKS + ((size_t)(b * 8 + hm) * 4608 + 512 + nl) * 64 + d0) = w;
        else {
          *(uint2*)(CKP + ((size_t)(b * 8 + hm) * 256 + nl) * 64 + d0) = w;
          *(float4*)(nck + (size_t)t * 512 + hm * 64 + d0) = make_float4(o[0], o[1], o[2], o[3]);
        }
      } else {
        const int j = vi - 32;
        uint2 w; w.x = pack2(o[0], o[1]); w.y = pack2(o[2], o[3]);
        if (samp) *(uint2*)(DKS + ((size_t)(b * 2 + j) * 4608 + 512 + nl) * 64 + d0) = w;
        else {
          *(uint2*)(DKP + ((size_t)(b * 2 + j) * 256 + nl) * 64 + d0) = w;
          *(float4*)(ndk + (size_t)t * 128 + j * 64 + d0) = make_float4(o[0], o[1], o[2], o[3]);
        }
      }
    }
  }
  const size_t gt = (size_t)vb * 256 + threadIdx.x, gs = (size_t)G * 256;
  {
    u16* CVTS = (u16*)(p.ws + OFF_CVTS); u16* DVTS = (u16*)(p.ws + OFF_DVTS);
    for (size_t i = gt; i < (size_t)2 * 512 * 512; i += gs) {
      const int b = (int)(i >> 18), key = (int)(i >> 9) & 511, c = (int)(i & 511);
      CKS[((size_t)(b * 8 + (c >> 6)) * 4608 + key) * 64 + (c & 63)] = f2bf(p.in[3][i]);
    }
    for (size_t i = gt; i < (size_t)2 * 512 * 512; i += gs) {
      const int b = (int)(i >> 18), c = (int)(i >> 9) & 511, key = (int)(i & 511);
      CVTS[((size_t)(b * 512 + c)) * 4608 + key] = f2bf(p.in[4][((size_t)b * 512 + key) * 512 + c]);
    }
    for (size_t i = gt; i < (size_t)2 * 512 * 128; i += gs) {
      const int b = (int)(i >> 16), key = (int)(i >> 7) & 511, c = (int)(i & 127);
      DKS[((size_t)(b * 2 + (c >> 6)) * 4608 + key) * 64 + (c & 63)] = f2bf(p.in[5][i]);
    }
    for (size_t i = gt; i < (size_t)2 * 128 * 512; i += gs) {
      const int b = (int)(i >> 16), c = (int)(i >> 9) & 127, key = (int)(i & 511);
      DVTS[((size_t)(b * 128 + c)) * 4608 + key] = f2bf(p.in[6][((size_t)b * 512 + key) * 128 + c]);
    }
  }
}

template <int DV>
DI void attn_item(const u16* Q, const u16* Kb, const u16* Vt, int ldv, int nt0, int key1, int nt1,
                  bool masked, int qpos0, bool has_sink, float sink2, u16* out, int ldo, char* lds) {
  constexpr int NDB = DV / 32;
  constexpr int KVBUF = (64 + DV) * LROW;
  const int tid = threadIdx.x, lane = tid & 63, wave = tid >> 6;
  const int r = lane & 31, h = lane >> 5;
  const int nt = nt0 + nt1;
  bf16x8 qf[4];
#pragma unroll
  for (int ks = 0; ks < 4; ++ks) qf[ks] = *(const bf16x8*)(Q + (size_t)(wave * 32 + r) * 64 + ks * 16 + h * 8);
  f32x16 O[NDB];
#pragma unroll
  for (int i = 0; i < NDB; ++i)
#pragma unroll
    for (int e = 0; e < 16; ++e) O[i][e] = 0.f;
  float mrun = has_sink ? sink2 : -1e30f;
  float lrun = has_sink ? (h == 0 ? 1.f : 0.f) : 0.f;
  const int lrow = tid >> 3, lpart = (tid & 7) * 8;
  uint4 rk0, rk1, rv0, rv1, rv2, rv3;
  rv2 = rv3 = make_uint4(0, 0, 0, 0);
  const u16* gk = Kb + (size_t)lrow * 64 + lpart;
  const u16* gv = Vt + (size_t)lrow * ldv + lpart;
#define ATT_GLOAD(key0_)                                                         \
  do {                                                                           \
    rk0 = *(const uint4*)(gk + (size_t)(key0_) * 64);                            \
    rk1 = *(const uint4*)(gk + (size_t)((key0_) + 32) * 64);                     \
    rv0 = *(const uint4*)(gv + (key0_));                                         \
    rv1 = *(const uint4*)(gv + (size_t)32 * ldv + (key0_));                      \
    if constexpr (DV == 128) {                                                   \
      rv2 = *(const uint4*)(gv + (size_t)64 * ldv + (key0_));                    \
      rv3 = *(const uint4*)(gv + (size_t)96 * ldv + (key0_));                    \
    }                                                                            \
  } while (0)
#define ATT_SSTORE(boff_)                                                        \
  do {                                                                           \
    *(uint4*)(sw + (boff_)) = rk0;                                               \
    *(uint4*)(sw + (boff_) + 32 * LROW) = rk1;                                   \
    *(uint4*)(sw + (boff_) + 64 * LROW) = rv0;                                   \
    *(uint4*)(sw + (boff_) + 96 * LROW) = rv1;                                   \
    if constexpr (DV == 128) {                                                   \
      *(uint4*)(sw + (boff_) + 128 * LROW) = rv2;                                \
      *(uint4*)(sw + (boff_) + 160 * LROW) = rv3;                                \
    }                                                                            \
  } while (0)
  char* sw = lds + lrow * LROW + lpart * 2;
  {
    const int key0 = (nt0 > 0) ? 0 : key1;
    ATT_GLOAD(key0);
  }
  ATT_SSTORE(0);
  __syncthreads();
  const int pr = (r & 0x13) | ((r & 4) << 1) | ((r & 8) >> 1);
  const char* fk = lds + pr * LROW + h * 16;
  const char* fv = lds + 64 * LROW + r * LROW + h * 16;
  const int qpos = qpos0 + wave * 32 + r;
  for (int t = 0; t < nt; ++t) {
    const int cur = (t & 1) * KVBUF;
    const int key0 = (t < nt0) ? t * 64 : key1 + (t - nt0) * 64;
    {
      const int tn = (t + 1 < nt) ? t + 1 : t;
      const int kn = (tn < nt0) ? tn * 64 : key1 + (tn - nt0) * 64;
      ATT_GLOAD(kn);
    }
    f32x16 S[2];
#pragma unroll
    for (int kb = 0; kb < 2; ++kb) {
#pragma unroll
      for (int e = 0; e < 16; ++e) S[kb][e] = 0.f;
#pragma unroll
      for (int ks = 0; ks < 4; ++ks) {
        const bf16x8 kf = *(const bf16x8*)(fk + cur + kb * 32 * LROW + ks * 32);
        S[kb] = MFMA(kf, qf[ks], S[kb]);
      }
    }
    if (masked && t >= nt0) {
#pragma unroll
      for (int kb = 0; kb < 2; ++kb)
#pragma unroll
        for (int e = 0; e < 16; ++e) {
          const int jpos = key0 - 512 + kb * 32 + 16 * (e >> 3) + 8 * h + (e & 7);
          const int dlt = qpos - jpos;
          if (dlt > 128 || dlt < -128) S[kb][e] = -1e30f;
        }
    }
    float mloc = S[0][0];
#pragma unroll
    for (int kb = 0; kb < 2; ++kb)
#pragma unroll
      for (int e = 0; e < 16; ++e) mloc = fmaxf(mloc, S[kb][e]);
    mloc = fmaxf(mloc, __shfl_xor(mloc, 32));
    const float mnew = fmaxf(mrun, mloc);
    const float alpha = __builtin_amdgcn_exp2f(mrun - mnew);
    mrun = mnew;
    float ps = 0.f;
#pragma unroll
    for (int kb = 0; kb < 2; ++kb)
#pragma unroll
      for (int e = 0; e < 16; ++e) { const float pv = __builtin_amdgcn_exp2f(S[kb][e] - mnew); S[kb][e] = pv; ps += pv; }
    lrun = lrun * alpha + ps;
#pragma unroll
    for (int i = 0; i < NDB; ++i)
#pragma unroll
      for (int e = 0; e < 16; ++e) O[i][e] *= alpha;
    bf16x8 pf[4];
#pragma unroll
    for (int jj = 0; jj < 4; ++jj) {
      const int kb = jj >> 1, o8 = (jj & 1) * 8;
      uint4 w;
      w.x = pack2(S[kb][o8 + 0], S[kb][o8 + 1]); w.y = pack2(S[kb][o8 + 2], S[kb][o8 + 3]);
      w.z = pack2(S[kb][o8 + 4], S[kb][o8 + 5]); w.w = pack2(S[kb][o8 + 6], S[kb][o8 + 7]);
      pf[jj] = __builtin_bit_cast(bf16x8, w);
    }
    __builtin_amdgcn_sched_barrier(0);
#pragma unroll
    for (int i = 0; i < NDB; ++i) {
#pragma unroll
      for (int jj = 0; jj < 4; ++jj) {
        const bf16x8 vf = *(const bf16x8*)(fv + cur + i * 32 * LROW + jj * 32);
        O[i] = MFMA(vf, pf[jj], O[i]);
      }
      if (i & 1) __builtin_amdgcn_sched_barrier(0);
    }
    ATT_SSTORE(KVBUF - cur);
    __syncthreads();
  }
#undef ATT_GLOAD
#undef ATT_SSTORE
  const float ltot = lrun + __shfl_xor(lrun, 32);
  const float inv = 1.0f / ltot;
  u16* op = out + (size_t)(wave * 32 + r) * ldo;
#pragma unroll
  for (int i = 0; i < NDB; ++i)
#pragma unroll
    for (int qd = 0; qd < 4; ++qd) {
      uint2 w;
      w.x = pack2(O[i][4 * qd] * inv, O[i][4 * qd + 1] * inv);
      w.y = pack2(O[i][4 * qd + 2] * inv, O[i][4 * qd + 3] * inv);
      *(uint2*)(op + i * 32 + 8 * qd + 4 * h) = w;
    }
}

DI void attention_phase(const Params& p, int vb, int G, char* lds) {
  const u16* CQ = (const u16*)(p.ws + OFF_CQ); const u16* DQ = (const u16*)(p.ws + OFF_DQ);
  const u16* CKP = (const u16*)(p.ws + OFF_CKP); const u16* CKS = (const u16*)(p.ws + OFF_CKS);
  const u16* CVTP = (const u16*)(p.ws + OFF_CVTP); const u16* CVTS = (const u16*)(p.ws + OFF_CVTS);
  const u16* DKP = (const u16*)(p.ws + OFF_DKP); const u16* DKS = (const u16*)(p.ws + OFF_DKS);
  const u16* DVTP = (const u16*)(p.ws + OFF_DVTP); const u16* DVTS = (const u16*)(p.ws + OFF_DVTS);
  u16* OM = (u16*)(p.ws + OFF_OM); u16* AC = (u16*)(p.ws + OFF_H);
  constexpr size_t QS = (size_t)16 * 8 * 256 * 64;
  for (int it = vb; it < 1536; it += G) {
    const bool diff = (it < 512) || (it >= 1024 && it < 1280);
    const bool samp = it < 1024;
    int qb, hd, b;
    if (samp) { const int i2 = it & 511; qb = i2 & 31; hd = (i2 >> 5) & 7; b = i2 >> 8; }
    else { const int i2 = (it - 1024) & 255; qb = i2 & 1; hd = (i2 >> 1) & 7; b = i2 >> 4; }
    const int nseq = samp ? 4096 : 256, nkeys = samp ? 4608 : 256;
    const int tok = samp ? 4096 + b * 4096 + qb * 128 : b * 256 + qb * 128;
    const size_t qoff = (samp ? QS : 0) + ((size_t)(b * 8 + hd) * nseq + qb * 128) * 64;
    if (diff) {
      const u16* Kp = (samp ? CKS : CKP) + (size_t)(b * 8 + hd) * nkeys * 64;
      const u16* Vp = (samp ? CVTS : CVTP) + (size_t)(b * 4 + (hd >> 1)) * 128 * nkeys;
      attn_item<128>(CQ + qoff, Kp, Vp, nkeys, nkeys >> 6, 0, 0, false, 0, false, 0.f, OM + (size_t)tok * 1024 + hd * 128, 1024, lds);
    } else {
      const u16* Kp = (samp ? DKS : DKP) + (size_t)(b * 2 + (hd >> 2)) * nkeys * 64;
      const u16* Vp = (samp ? DVTS : DVTP) + (size_t)(b * 2 + (hd >> 2)) * 64 * nkeys;
      int nt0 = 4, key1 = 0, nt1 = 0;
      if (samp) { const int lo = max(qb * 128 - 128, 0), hi = min(qb * 128 + 256, 4096); nt0 = 8; key1 = 512 + lo; nt1 = (hi - lo) >> 6; }
      attn_item<64>(DQ + qoff, Kp, Vp, nkeys, nt0, key1, nt1, samp, qb * 128, true, p.in[27][hd] * LOG2E, AC + (size_t)tok * 1024 + 512 + hd * 64, 1024, lds);
    }
  }
}

DI void combine_phase(const Params& p, int vb, int G) {
  const int lane = threadIdx.x & 63, wave = threadIdx.x >> 6;
  const float a = wave_sum(p.in[20][lane] * p.in[21][lane]);
  const float bsum = wave_sum(p.in[22][lane] * p.in[23][lane]);
  const float lam = expf(a) - expf(bsum) + LAM_INIT;
  const u16* OM = (const u16*)(p.ws + OFF_OM);
  u16* AC = (u16*)(p.ws + OFF_H);
  const int hh = lane >> 4, e0 = (lane & 15) * 8;
  float g[8];
#pragma unroll
  for (int e = 0; e < 8; ++e) g[e] = p.in[24][e0 + e] * (1.0f - LAM_INIT);
  for (int t = vb * 4 + wave; t < T; t += G * 4) {
    const uint4 w0 = *(const uint4*)(OM + (size_t)t * 1024 + (hh * 2) * 128 + e0);
    const uint4 w1 = *(const uint4*)(OM + (size_t)t * 1024 + (hh * 2 + 1) * 128 + e0);
    const unsigned a0[4] = {w0.x, w0.y, w0.z, w0.w}, a1[4] = {w1.x, w1.y, w1.z, w1.w};
    float d[8];
    float ss = 0.f;
#pragma unroll
    for (int e = 0; e < 4; ++e) {
      d[2 * e] = __uint_as_float(a0[e] << 16) - lam * __uint_as_float(a1[e] << 16);
      d[2 * e + 1] = __uint_as_float(a0[e] & 0xffff0000u) - lam * __uint_as_float(a1[e] & 0xffff0000u);
      ss += d[2 * e] * d[2 * e] + d[2 * e + 1] * d[2 * e + 1];
    }
    ss += __shfl_xor(ss, 1); ss += __shfl_xor(ss, 2); ss += __shfl_xor(ss, 4); ss += __shfl_xor(ss, 8);
    const float rinv = rsqrtf(ss * (1.0f / 128.0f) + EPS);
    uint4 o;
    o.x = pack2(d[0] * rinv * g[0], d[1] * rinv * g[1]); o.y = pack2(d[2] * rinv * g[2], d[3] * rinv * g[3]);
    o.z = pack2(d[4] * rinv * g[4], d[5] * rinv * g[5]); o.w = pack2(d[6] * rinv * g[6], d[7] * rinv * g[7]);
    *(uint4*)(AC + (size_t)t * 1024 + hh * 128 + e0) = o;
  }
}

#define XB_TMO      128
#define XB_XCNT(j)  (256  + 64 * (j))
#define XB_XSUB(j)  (1280 + 64 * (j))
#define XB_XGEN(j)  (2304 + 64 * (j))
#define XB_TOP      3328
#define XB_TOPGEN   3392
#define XCD_BAR_WORDS 3456
#define XB_SPIN_CAP (1u << 18)
#define LAS __attribute__((address_space(3)))
DI unsigned xb_ld(unsigned* p)              { return __hip_atomic_load(p, __ATOMIC_RELAXED, __HIP_MEMORY_SCOPE_AGENT); }
DI unsigned xb_add(unsigned* p, unsigned v) { return __hip_atomic_fetch_add(p, v, __ATOMIC_RELAXED, __HIP_MEMORY_SCOPE_AGENT); }
DI unsigned xb_xcc_id() { return (unsigned)__builtin_amdgcn_s_getreg((3 << 11) | 20) & 0xFu; }
#define XB_SPIN(cond, bar) do { unsigned _sp = 0; while (cond) { __builtin_amdgcn_s_sleep(1); \
    if ((++_sp & 255u) == 0u) { if (xb_ld(&(bar)[XB_TMO])) break; if (_sp > XB_SPIN_CAP) { atomicAdd(&(bar)[XB_TMO], 1u); break; } } } } while (0)
struct XcdBarrier { unsigned* bar; unsigned x; volatile LAS unsigned* st; };
DI XcdBarrier xcd_barrier_post(unsigned* bar, volatile LAS unsigned* st) {
  XcdBarrier b; b.bar = bar; b.x = xb_xcc_id(); b.st = st;
  if (threadIdx.x == 0) (void)xb_add(&bar[XB_XCNT(b.x)], 1u);
  return b;
}
DI void xcd_barrier_complete(unsigned* bar, unsigned x, unsigned& nloc, unsigned& nx) {
  const unsigned G = gridDim.x;
  unsigned sum, cnt, mine, sp = 0u;
  for (;;) {
    sum = 0u; cnt = 0u; mine = 0u;
#pragma unroll
    for (unsigned j = 0; j < 16; ++j) { const unsigned c = xb_ld(&bar[XB_XCNT(j)]); sum += c; cnt += (c > 0u) ? 1u : 0u; mine = (j == x) ? c : mine; }
    if (sum == G) break;
    __builtin_amdgcn_s_sleep(1);
    if ((++sp & 255u) == 0u) { if (xb_ld(&bar[XB_TMO])) break; if (sp > XB_SPIN_CAP) { atomicAdd(&bar[XB_TMO], 1u); break; } }
  }
  nloc = mine > 0u ? mine : 1u; nx = cnt > 0u ? cnt : 1u;
}
DI void xcd_barrier(const XcdBarrier& b) {
  asm volatile("s_waitcnt vmcnt(0)" ::: "memory");
  __syncthreads();
  if (threadIdx.x == 0) {
    unsigned* bar = b.bar;
    __builtin_amdgcn_s_waitcnt(0);
    unsigned nloc = b.st[0], nx = b.st[1];
    if (nloc == 0u) { xcd_barrier_complete(bar, b.x, nloc, nx); b.st[0] = nloc; b.st[1] = nx; }
    const unsigned old = xb_add(&bar[XB_XSUB(b.x)], 1u);
    const unsigned gen = old / nloc;
    if (old + 1u == (gen + 1u) * nloc) {
      __builtin_amdgcn_fence(__ATOMIC_RELEASE, "agent");
      asm volatile("s_waitcnt vmcnt(0)" ::: "memory");
      const unsigned og = xb_add(&bar[XB_TOP], 1u);
      const unsigned tg = og / nx;
      if (og + 1u == (tg + 1u) * nx) xb_add(&bar[XB_TOPGEN], 1u);
      else XB_SPIN(xb_ld(&bar[XB_TOPGEN]) == tg, bar);
      __builtin_amdgcn_fence(__ATOMIC_ACQUIRE, "agent");
      xb_add(&bar[XB_XGEN(b.x)], 1u);
      asm volatile("s_waitcnt vmcnt(0)" ::: "memory");
    } else {
      XB_SPIN(xb_ld(&bar[XB_XGEN(b.x)]) == gen, bar);
      __builtin_amdgcn_fence(__ATOMIC_ACQUIRE, "agent");
      asm volatile("s_waitcnt vmcnt(0)" ::: "memory");
    }
  }
  __syncthreads();
}

__global__ void __launch_bounds__(256, 2) fwd_kernel(Params p, int ph_lo, int ph_hi) {
  __shared__ __attribute__((aligned(16))) char lds[LDS_BYTES];
  const int G = gridDim.x;
  int vb = blockIdx.x;
  if ((G & 7) == 0) vb = (blockIdx.x & 7) * (G >> 3) + (blockIdx.x >> 3);
  unsigned char* ws = p.ws;
  const float* mods = (const float*)(ws + OFF_MODS);
  float* X = p.out + OUT_Y;
  u16* H = (u16*)(ws + OFF_H);

#define RUNPH(n) ((ONLYPH < 0 || ONLYPH == (n)) && ph_lo <= (n) && (n) < ph_hi)
#define REP(n) _Pragma("unroll") for (int rep_ = 0; rep_ < ((DUPPH == (n)) ? 2 : 1); ++rep_)
#define SEAM(n) if (ph_lo < (n) && (n) < ph_hi) xcd_barrier(xb);
  __shared__ uint4 xb_words;
  if (threadIdx.x == 0) xb_words = make_uint4(0u, 0u, 0u, 0u);
  __syncthreads();
  XcdBarrier xb = xcd_barrier_post((unsigned*)(ws + OFF_BAR), (volatile LAS unsigned*)&xb_words);
  if (ph_hi > 1000) cg::this_grid().sync();
  if (RUNPH(0)) REP(0) {
    for (int id = vb; id < 384; id += G) ada_item(p, id, lds);
    prep_transposes(p, vb, G, lds);
    prep_elementwise(p, vb, G);
  }
  SEAM(1)
  if (RUNPH(1)) {
    for (int t = vb; t < 128; t += G) {
      const bool f1 = t < 64;
      const int q = t & 63;
      gemm_tile(f1 ? (const u16*)(ws + OFF_CBD) : (const u16*)(ws + OFF_WOUT_ET), f1 ? 512 : 1024,
                f1 ? (const u16*)(ws + OFF_WINB) : (const u16*)(ws + OFF_BD), f1 ? 512 : 1024, f1 ? 512 : 1024, (q >> 3) << 7, (q & 7) << 7,
                EpiBf16{f1 ? (u16*)(ws + OFF_WIN_E) + (size_t)512 * 1024 : (u16*)(ws + OFF_WOUT_E), 1024}, lds);
    }
    normmod_phase(p, vb, G, p.in[0], p.in[1], p.in[8], 0, 0);
  }
  SEAM(2)
  if (RUNPH(2)) REP(2)
    gemm_phase(H, 1024, (const u16*)(ws + OFF_WIN_E), 1024, 1024, T, 1536, EpiU{(u16*)(ws + OFF_UA), (u16*)(ws + OFF_PQT)}, vb, G, lds);
  SEAM(3)
  if (RUNPH(3)) sym_phase(p, vb, G);
  SEAM(4)
  if (RUNPH(4)) REP(4) {
    const u16* PQT = (const u16*)(ws + OFF_PQT);
    const u16* PEQO = (const u16*)(ws + OFF_PEQO);
    for (int t = vb; t < 256 + 128; t += G) {
      const bool big = t < 256;
      const int q = t - 256, b = q >> 3;
      dft_tile(big ? (const u16*)(ws + OFF_D4096) : (const u16*)(ws + OFF_D256),
               big ? PEQO + (size_t)16 * 512 * 256 : PEQO + (size_t)b * 512 * 256,
               big ? PQT + (size_t)16 * 512 * 512 + 2048 : PQT + (size_t)b * 512 * 512 + 128,
               big ? 8192 : 512, big ? 2048 : 128, big ? (t & 15) << 7 : 0, big ? (t >> 4) << 6 : (q & 7) << 6,
               (u16*)(ws + OFF_AB), big ? 4096 : b * 256, 512, big ? 0.0013810679320049757f : 0.005524271728019903f, lds);
    }
    pool_phase(p, vb, G);
  }
  SEAM(5)
  if (RUNPH(5))
    gemm_phase((const u16*)(ws + OFF_AB), 1024, (const u16*)(ws + OFF_WOUT_E), 1024, 1024, T, 1024,
               EpiRes{p.in[0], p.in[1], X, mods + 2048}, vb, G, lds);
  SEAM(6)
  if (RUNPH(6)) normmod_phase(p, vb, G, X, X + (size_t)4096 * 1024, p.in[9], 0, 1);
  SEAM(7)
  if (RUNPH(7)) REP(7) gemm_phase(H, 1024, (const u16*)(ws + OFF_W1), 1024, 1024, T, 4096, EpiRelu2{(u16*)(ws + OFF_M1)}, vb, G, lds);
  SEAM(8)
  if (RUNPH(8)) gemm_phase((const u16*)(ws + OFF_M1), 4096, (const u16*)(ws + OFF_W2), 4096, 4096, T, 1024,
                           EpiRes{X, X + (size_t)4096 * 1024, X, mods + 5120}, vb, G, lds);
  SEAM(9)
  if (RUNPH(9)) normmod_phase(p, vb, G, X, X + (size_t)4096 * 1024, p.in[8] + 1024, 1, 0);
  SEAM(10)
  if (RUNPH(10)) gemm_phase(H, 1024, (const u16*)(ws + OFF_WIN_O), 1024, 1024, T, 2304,
                           EpiQkv{(u16*)(ws + OFF_QKV), (u16*)(ws + OFF_CVTP), (u16*)(ws + OFF_CVTS), (u16*)(ws + OFF_DVTP), (u16*)(ws + OFF_DVTS),
                                  p.out + OUT_NCV, p.out + OUT_NDV}, vb, G, lds);
  SEAM(11)
  if (RUNPH(11)) REP(11) qkvpost_phase(p, vb, G);
  SEAM(12)
  if (RUNPH(12)) REP(12) attention_phase(p, vb, G, lds);
  SEAM(13)
  if (RUNPH(13)) combine_phase(p, vb, G);
  SEAM(14)
  if (RUNPH(14)) gemm_phase(H, 1024, (const u16*)(ws + OFF_WOUT_O), 1024, 1024, T, 1024,
                            EpiRes{X, X + (size_t)4096 * 1024, X, mods + 3 * 6144 + 2048}, vb, G, lds);
  SEAM(15)
  if (RUNPH(15)) normmod_phase(p, vb, G, X, X + (size_t)4096 * 1024, p.in[9] + 1024, 1, 1);
  SEAM(16)
  if (RUNPH(16)) gemm_phase(H, 1024, (const u16*)(ws + OFF_W1) + (size_t)4096 * 1024, 1024, 1024, T, 4096, EpiRelu2{(u16*)(ws + OFF_M1)}, vb, G, lds);
  SEAM(17)
  if (RUNPH(17)) gemm_phase((const u16*)(ws + OFF_M1), 4096, (const u16*)(ws + OFF_W2) + (size_t)4096 * 1024, 4096, 4096, T, 1024,
                            EpiRes{X, X + (size_t)4096 * 1024, X, mods + 3 * 6144 + 5120}, vb, G, lds);
}

extern "C" void kernel_launch(void* const* d_in, const int* in_sizes, int n_in, void* d_out, int out_size, void* d_ws, size_t ws_size,
                              hipStream_t stream) {
  static int grid = 0;
  if (!grid) {
    int dev = 0, cus = 0, per_cu = 0;
    hipGetDevice(&dev);
    hipDeviceGetAttribute(&cus, hipDeviceAttributeMultiprocessorCount, dev);
    hipOccupancyMaxActiveBlocksPerMultiprocessor(&per_cu, fwd_kernel, 256, 0);
    if (per_cu < 1) per_cu = 1;
    if (per_cu > 2) per_cu = 2;
    grid = cus * per_cu;
    if (ws_size < WS_END) fprintf(stderr, "workspace too small: %zu < %zu\n", ws_size, (size_t)WS_END);
  }
  Params p{};
  for (int i = 0; i < 31; ++i) p.in[i] = (const float*)d_in[i];
  p.out = (float*)d_out;
  p.ws = (unsigned char*)d_ws;
#if ONE_LAUNCH
  hipMemsetAsync((char*)d_ws + OFF_BAR, 0, XCD_BAR_WORDS * 4, stream);
  int lo = 0, hi = NPH;
  void* args[] = {&p, &lo, &hi};
  hipError_t e = hipLaunchCooperativeKernel((void*)fwd_kernel, dim3(grid), dim3(256), args, 0, stream);
  if (e != hipSuccess) fprintf(stderr, "cooperative launch failed: %s (grid %d)\n", hipGetErrorString(e), grid);
#else
  for (int ph = 0; ph < NPH; ++ph) hipLaunchKernelGGL(fwd_kernel, dim3(grid), dim3(256), 0, stream, p, ph, ph + 1);
#endif
}
```

```cpp
#include <hip/hip_runtime.h>
#include <hip/hip_cooperative_groups.h>
#include <cstdio>
namespace cg = cooperative_groups;

#ifndef ONE_LAUNCH
#define ONE_LAUNCH 1
#endif

#ifndef ONLYPH
#define ONLYPH -1
#endif
#ifndef DUPPH
#define DUPPH -1
#endif
typedef unsigned short u16;
typedef short bf16x8 __attribute__((ext_vector_type(8)));
typedef float f32x16 __attribute__((ext_vector_type(16)));
typedef __bf16 bf2_t __attribute__((ext_vector_type(2)));
typedef float f2_t __attribute__((ext_vector_type(2)));
typedef unsigned u32x4 __attribute__((ext_vector_type(4)));

#define DI __device__ __forceinline__
#define TIDX ((int)(threadIdx.x & 255u))

constexpr int T = 12288, TP = 4096, DM = 1024;
constexpr int NPH = 18;
constexpr float EPS = 1e-6f;
constexpr float LOG2E = 1.4426950408889634f;
constexpr float QSCALE = 0.125f * LOG2E;
constexpr float LAM_INIT = 0.35550906759f;

constexpr size_t al(size_t x) { return (x + 255) & ~size_t(255); }
constexpr size_t OFF_MODS   = 0;
constexpr size_t OFF_WIN_E  = OFF_MODS + al(2 * 3 * 6144 * 4);
constexpr size_t OFF_WINB   = OFF_WIN_E + al(1536 * 1024 * 2);
constexpr size_t OFF_CBD    = OFF_WINB + al(1024 * 512 * 2);
constexpr size_t OFF_WOUT_ET= OFF_CBD + al(1024 * 512 * 2);
constexpr size_t OFF_BD     = OFF_WOUT_ET + al(1024 * 1024 * 2);
constexpr size_t OFF_WOUT_E = OFF_BD + al(1024 * 1024 * 2);
constexpr size_t OFF_WIN_O  = OFF_WOUT_E + al(1024 * 1024 * 2);
constexpr size_t OFF_WOUT_O = OFF_WIN_O + al(2304 * 1024 * 2);
constexpr size_t OFF_W1     = OFF_WOUT_O + al(1024 * 1024 * 2);
constexpr size_t OFF_W2     = OFF_W1 + al(2 * 4096 * 1024 * 2);
constexpr size_t OFF_D256   = OFF_W2 + al(2 * 4096 * 1024 * 2);
constexpr size_t OFF_H      = OFF_D256 + al(256 * 512 * 2);
constexpr size_t OFF_R2     = OFF_H + al((size_t)T * 1024 * 2);
constexpr size_t R2_BYTES   = (size_t)T * 512 * 2 + (size_t)T * 1024 * 2 * 2;
constexpr size_t OFF_R1     = OFF_R2 + al(R2_BYTES);
constexpr size_t R1_BYTES   = (size_t)T * 4096 * 2;
constexpr size_t OFF_BAR    = OFF_R1 + R1_BYTES;
constexpr size_t WS_END     = OFF_BAR + 3456 * 4;
constexpr size_t OFF_UA  = OFF_R2;
constexpr size_t OFF_PQT = OFF_UA + (size_t)T * 512 * 2;
constexpr size_t OFF_AB  = OFF_PQT + (size_t)T * 1024 * 2;
constexpr size_t OFF_CQ   = OFF_R2;
constexpr size_t OFF_DQ   = OFF_CQ + (size_t)T * 512 * 2;
constexpr size_t OFF_CKP  = OFF_DQ + (size_t)T * 512 * 2;
constexpr size_t OFF_CKS  = OFF_CKP + (size_t)16 * 8 * 256 * 64 * 2;
constexpr size_t OFF_CVTP = OFF_CKS + (size_t)2 * 8 * 4608 * 64 * 2;
constexpr size_t OFF_CVTS = OFF_CVTP + (size_t)16 * 4 * 128 * 256 * 2;
constexpr size_t OFF_DKP  = OFF_CVTS + (size_t)2 * 4 * 128 * 4608 * 2;
constexpr size_t OFF_DKS  = OFF_DKP + (size_t)16 * 2 * 256 * 64 * 2;
constexpr size_t OFF_DVTP = OFF_DKS + (size_t)2 * 2 * 4608 * 64 * 2;
constexpr size_t OFF_DVTS = OFF_DVTP + (size_t)16 * 2 * 64 * 256 * 2;
constexpr size_t R2_LATE_END = OFF_DVTS + (size_t)2 * 2 * 64 * 4608 * 2;
static_assert(R2_LATE_END <= OFF_R2 + R2_BYTES, "R2 overflow");
constexpr size_t OFF_D4096 = OFF_R1;
constexpr size_t OFF_PEQO  = OFF_R1 + (size_t)32 * 1024 * 1024;
constexpr size_t OFF_M1    = OFF_R1;
constexpr size_t OFF_QKV   = OFF_R1;
constexpr size_t OFF_OM    = OFF_R1 + al((size_t)T * 2304 * 2);
static_assert(OFF_OM + (size_t)T * 1024 * 2 <= WS_END, "R1 overflow");

constexpr size_t OUT_Y   = 0;
constexpr size_t OUT_NCK = (size_t)T * 1024;
constexpr size_t OUT_NCV = OUT_NCK + (size_t)TP * 512;
constexpr size_t OUT_NDK = OUT_NCV + (size_t)TP * 512;
constexpr size_t OUT_NDV = OUT_NDK + (size_t)TP * 128;

struct Params {
  const float* in[31];
  float* out;
  unsigned char* ws;
};

DI float bf2f(u16 v) { return __uint_as_float(((unsigned)v) << 16); }
DI unsigned pack2(float a, float b) { f2_t f = {a, b}; bf2_t v = __builtin_convertvector(f, bf2_t); return __builtin_bit_cast(unsigned, v); }
DI u16 f2bf(float a) { return (u16)(pack2(a, 0.f) & 0xffffu); }
DI int cond_of(int m) { return m < 4096 ? 0 : (m < 8192 ? 1 : 2); }
DI float wave_sum(float v) {
#pragma unroll
  for (int o = 32; o >= 1; o >>= 1) v += __shfl_xor(v, o);
  return v;
}
#define MFMA(a, b, c) __builtin_amdgcn_mfma_f32_32x32x16_bf16((a), (b), (c), 0, 0, 0)

constexpr int LROW = 144;
constexpr int GEMM_BUF = 2 * 128 * LROW;
constexpr int LDS_BYTES = 2 * GEMM_BUF;

template <int NR>
DI void g_load(u32x4 (&R)[NR], const u16* g, int ld, int k0) {
#pragma unroll
  for (int i = 0; i < NR; ++i) R[i] = *(const u32x4*)(g + (size_t)(32 * i) * ld + k0);
}
template <int NR>
DI void g_store(const u32x4 (&R)[NR], char* sw) {
#pragma unroll
  for (int i = 0; i < NR; ++i) *(u32x4*)(sw + (32 * i) * LROW) = R[i];
}
template <int NB>
DI void g_compute(f32x16 (&acc)[2][NB], const char* fa, const char* fb) {
#pragma unroll
  for (int ks = 0; ks < 4; ++ks) {
    bf16x8 a0 = *(const bf16x8*)(fa + ks * 32);
    bf16x8 a1 = *(const bf16x8*)(fa + 32 * LROW + ks * 32);
#pragma unroll
    for (int j = 0; j < NB; ++j) {
      bf16x8 b = *(const bf16x8*)(fb + j * 32 * LROW + ks * 32);
      acc[0][j] = MFMA(a0, b, acc[0][j]);
      acc[1][j] = MFMA(a1, b, acc[1][j]);
    }
  }
}
template <int NB>
DI void gemm_acc(f32x16 (&acc)[2][NB], const u16* A, int lda, const u16* Bt, int ldb, int K, int m0, int n0, char* lds) {
  const int tid = TIDX, lane = tid & 63, wave = tid >> 6;
  const int r = lane & 31, h = lane >> 5;
  const int wm = wave >> 1, wn = wave & 1;
  const int lrow = tid >> 3, lcol = (tid & 7) * 8;
  const u16* ga = A + (size_t)(m0 + lrow) * lda + lcol;
  const u16* gb = Bt + (size_t)(n0 + lrow) * ldb + lcol;
  u32x4 ra0[4], ra1[4], rb0[2 * NB], rb1[2 * NB];
  const int nk = K >> 6;
  char* sw = lds + lrow * LROW + lcol * 2;
  const char* fa = lds + (wm * 64 + r) * LROW + h * 16;
  const char* fb = lds + 128 * LROW + (wn * 32 * NB + r) * LROW + h * 16;
#define G_LOAD(RA, RB, kt_) do { const int k0_ = ((kt_) < nk ? (kt_) : nk - 1) << 6; g_load<4>(RA, ga, lda, k0_); g_load<2 * NB>(RB, gb, ldb, k0_); } while (0)
#define G_STORE(RA, RB, boff_) do { g_store<4>(RA, sw + (boff_)); g_store<2 * NB>(RB, sw + (boff_) + 128 * LROW); } while (0)
  G_LOAD(ra0, rb0, 0);
  G_LOAD(ra1, rb1, 1);
  G_STORE(ra0, rb0, 0);
  __syncthreads();
  for (int kt = 0; kt < nk; kt += 2) {
    G_LOAD(ra0, rb0, kt + 2);
    g_compute<NB>(acc, fa, fb);
    G_STORE(ra1, rb1, GEMM_BUF);
    __syncthreads();
    G_LOAD(ra1, rb1, kt + 3);
    g_compute<NB>(acc, fa + GEMM_BUF, fb + GEMM_BUF);
    G_STORE(ra0, rb0, 0);
    __syncthreads();
  }
#undef G_LOAD
#undef G_STORE
}

template <class Epi>
DI void gemm_tile(const u16* A, int lda, const u16* Bt, int ldb, int K, int m0, int n0, Epi epi, char* lds) {
  const int lane = TIDX & 63, wave = TIDX >> 6;
  const int r = lane & 31, h = lane >> 5, wm = wave >> 1, wn = wave & 1;
  f32x16 acc[2][2];
#pragma unroll
  for (int i = 0; i < 2; ++i)
#pragma unroll
    for (int j = 0; j < 2; ++j)
#pragma unroll
      for (int e = 0; e < 16; ++e) acc[i][j][e] = 0.f;
  gemm_acc<2>(acc, A, lda, Bt, ldb, K, m0, n0, lds);
#pragma unroll
  for (int i = 0; i < 2; ++i)
#pragma unroll
    for (int j = 0; j < 2; ++j)
#pragma unroll
      for (int q = 0; q < 4; ++q) {
        const int m = m0 + wm * 64 + i * 32 + 8 * q + 4 * h;
        const int n = n0 + wn * 64 + j * 32 + r;
        epi(m, n, acc[i][j][4 * q], acc[i][j][4 * q + 1], acc[i][j][4 * q + 2], acc[i][j][4 * q + 3]);
      }
}

DI void dft_tile(const u16* Dm, const u16* PeQo, const u16* PH, int phstride, int H, int m0, int n0, u16* AB, int rowbase, int colsPerBatch, float norm, char* lds) {
  const int lane = TIDX & 63, wave = TIDX >> 6;
  const int r = lane & 31, h = lane >> 5, wm = wave >> 1, wn = wave & 1;
  f32x16 accA[2][1], accB[2][1];
#pragma unroll
  for (int i = 0; i < 2; ++i)
#pragma unroll
    for (int e = 0; e < 16; ++e) { accA[i][0][e] = 0.f; accB[i][0][e] = 0.f; }
  gemm_acc<1>(accA, Dm, 2 * H, PeQo, 2 * H, H, m0, n0, lds);
  gemm_acc<1>(accB, Dm + H, 2 * H, PeQo + H, 2 * H, H, m0, n0, lds);
  const int N = 2 * H;
  const int col = n0 + wn * 32 + r;
  const int b = col / colsPerBatch, c = col - b * colsPerBatch;
  const float ph = bf2f(PH[(size_t)col * phstride]);
  u16* base = AB + ((size_t)rowbase + (size_t)b * N) * 1024 + 512 + c;
#pragma unroll
  for (int i = 0; i < 2; ++i)
#pragma unroll
    for (int q = 0; q < 4; ++q)
#pragma unroll
      for (int e = 0; e < 4; ++e) {
        const int k = m0 + wm * 64 + i * 32 + 8 * q + 4 * h + e;
        const float a = accA[i][0][4 * q + e] + ((k & 1) ? -ph : ph);
        const float bb = accB[i][0][4 * q + e];
        base[(size_t)k * 1024] = f2bf((a - bb) * norm);
        if (k > 0) base[(size_t)(N - k) * 1024] = f2bf((a + bb) * norm);
      }
}

struct EpiBf16 {
  u16* C; int ldc;
  DI void operator()(int m, int n, float v0, float v1, float v2, float v3) const {
    u16* p = C + (size_t)m * ldc + n;
    p[0] = f2bf(v0); p[ldc] = f2bf(v1); p[2 * ldc] = f2bf(v2); p[3 * ldc] = f2bf(v3);
  }
};
struct EpiU {
  u16* UA; u16* PQt;
  DI void operator()(int m, int n, float v0, float v1, float v2, float v3) const {
    if (n < 512) {
      u16* p = UA + (size_t)m * 512 + n;
      p[0] = f2bf(v0); p[512] = f2bf(v1); p[1024] = f2bf(v2); p[1536] = f2bf(v3);
    } else {
      const int np = n - 512, g = np >> 8, pq = (np >> 7) & 1, mm = np & 127;
      size_t off;
      if (m < 4096) { const int b = m >> 8, nl = m & 255; off = ((size_t)(b * 512 + g * 128 + mm)) * 512 + pq * 256 + nl; }
      else { const int ms = m - 4096, b = ms >> 12, nl = ms & 4095; off = (size_t)16 * 512 * 512 + ((size_t)(b * 512 + g * 128 + mm)) * 8192 + pq * 4096 + nl; }
      uint2 w; w.x = pack2(v0, v1); w.y = pack2(v2, v3);
      *(uint2*)(PQt + off) = w;
    }
  }
};
struct EpiDft {
  u16* AB; int rowbase; float norm; int sample;
  DI void operator()(int m, int n, float v0, float v1, float v2, float v3) const {
    size_t row; int c;
    if (sample) { row = (size_t)4096 + (size_t)(n >> 9) * 4096 + m; c = n & 511; }
    else { row = (size_t)rowbase + m; c = n; }
    u16* p = AB + row * 1024 + 512 + c;
    p[0] = f2bf(v0 * norm); p[1024] = f2bf(v1 * norm); p[2048] = f2bf(v2 * norm); p[3072] = f2bf(v3 * norm);
  }
};
struct EpiRes {
  const float* xin_p; const float* xin_s;
  float* X; const float* gate;
  DI void operator()(int m, int n, float v0, float v1, float v2, float v3) const {
    const float* xi = (m < 4096) ? xin_p + (size_t)m * 1024 + n : xin_s + (size_t)(m - 4096) * 1024 + n;
    const float g = gate[cond_of(m) * 6144 + n];
    float* xo = X + (size_t)m * 1024 + n;
    xo[0] = xi[0] + g * v0; xo[1024] = xi[1024] + g * v1; xo[2048] = xi[2048] + g * v2; xo[3072] = xi[3072] + g * v3;
  }
};
struct EpiRelu2 {
  u16* C;
  DI void operator()(int m, int n, float v0, float v1, float v2, float v3) const {
    v0 = fmaxf(v0, 0.f); v1 = fmaxf(v1, 0.f); v2 = fmaxf(v2, 0.f); v3 = fmaxf(v3, 0.f);
    u16* p = C + (size_t)m * 4096 + n;
    p[0] = f2bf(v0 * v0); p[4096] = f2bf(v1 * v1); p[8192] = f2bf(v2 * v2); p[12288] = f2bf(v3 * v3);
  }
};
struct EpiQkv {
  u16* QKV; u16* CVtP; u16* CVtS; u16* DVtP; u16* DVtS; float* ncv; float* ndv;
  DI void operator()(int m, int n, float v0, float v1, float v2, float v3) const {
    const bool is_cv = (n >= 1024 && n < 1536), is_dv = (n >= 2176);
    if (!is_cv && !is_dv) {
      u16* p = QKV + (size_t)m * 2304 + n;
      p[0] = f2bf(v0); p[2304] = f2bf(v1); p[4608] = f2bf(v2); p[6912] = f2bf(v3);
      return;
    }
    uint2 w; w.x = pack2(v0, v1); w.y = pack2(v2, v3);
    if (is_cv) {
      const int c = n - 1024;
      if (m < 4096) {
        const int b = m >> 8, nl = m & 255;
        *(uint2*)(CVtP + ((size_t)(b * 512 + c)) * 256 + nl) = w;
        float* o = ncv + (size_t)m * 512 + c; o[0] = v0; o[512] = v1; o[1024] = v2; o[1536] = v3;
      } else {
        const int ms = m - 4096, b = ms >> 12, nl = ms & 4095;
        *(uint2*)(CVtS + ((size_t)(b * 512 + c)) * 4608 + 512 + nl) = w;
      }
    } else {
      const int c = n - 2176;
      if (m < 4096) {
        const int b = m >> 8, nl = m & 255;
        *(uint2*)(DVtP + ((size_t)(b * 128 + c)) * 256 + nl) = w;
        float* o = ndv + (size_t)m * 128 + c; o[0] = v0; o[128] = v1; o[256] = v2; o[384] = v3;
      } else {
        const int ms = m - 4096, b = ms >> 12, nl = ms & 4095;
        *(uint2*)(DVtS + ((size_t)(b * 128 + c)) * 4608 + 512 + nl) = w;
      }
    }
  }
};

DI void ada_item(const Params& p, int id, char* lds) {
  const int tid = TIDX;
  float* ssil = (float*)lds;
  float* red = (float*)(lds + 12288);
  const int l = id / 192, cb = id % 192;
  for (int i = tid; i < 3072; i += 256) {
    const int j = i >> 10, k = i & 1023;
    const float v = (j == 0) ? p.in[7][k] : p.in[2][(j - 1) * 1024 + k];
    ssil[i] = v / (1.f + __expf(-v));
  }
  __syncthreads();
  const int cq = tid & 7, kg = tid >> 3;
  const float* w = p.in[10] + (size_t)l * 1024 * 6144 + cb * 32 + cq * 4;
  float4 a0 = {0, 0, 0, 0}, a1 = {0, 0, 0, 0}, a2 = {0, 0, 0, 0};
#pragma unroll 8
  for (int kk = 0; kk < 32; ++kk) {
    const int k = kg * 32 + kk;
    const float4 wv = *(const float4*)(w + (size_t)k * 6144);
    const float s0 = ssil[k], s1 = ssil[1024 + k], s2 = ssil[2048 + k];
    a0.x += s0 * wv.x; a0.y += s0 * wv.y; a0.z += s0 * wv.z; a0.w += s0 * wv.w;
    a1.x += s1 * wv.x; a1.y += s1 * wv.y; a1.z += s1 * wv.z; a1.w += s1 * wv.w;
    a2.x += s2 * wv.x; a2.y += s2 * wv.y; a2.z += s2 * wv.z; a2.w += s2 * wv.w;
  }
  float* rp = red + kg * 96 + cq * 4;
  rp[0] = a0.x; rp[1] = a0.y; rp[2] = a0.z; rp[3] = a0.w;
  rp[32] = a1.x; rp[33] = a1.y; rp[34] = a1.z; rp[35] = a1.w;
  rp[64] = a2.x; rp[65] = a2.y; rp[66] = a2.z; rp[67] = a2.w;
  __syncthreads();
  if (tid < 96) {
    const int j = tid >> 5, c = tid & 31;
    float sum = 0.f;
#pragma unroll
    for (int g = 0; g < 32; ++g) sum += red[g * 96 + j * 32 + c];
    const int col = cb * 32 + c;
    ((float*)(p.ws + OFF_MODS))[(size_t)(l * 3 + j) * 6144 + col] = sum + p.in[11][l * 6144 + col];
  }
  __syncthreads();
}

DI void transpose_tile(const float* src, int ld_src, u16* dst, int ld_dst, int r0, int c0, char* lds) {
  float* tile = (float*)lds;
  const int tid = TIDX;
  const int j4 = (tid & 15) * 4, i0 = tid >> 4;
#pragma unroll
  for (int it = 0; it < 4; ++it) {
    const int i = i0 + 16 * it;
    const float4 v = *(const float4*)(src + (size_t)(r0 + i) * ld_src + c0 + j4);
    float* tp = tile + i * 65 + j4;
    tp[0] = v.x; tp[1] = v.y; tp[2] = v.z; tp[3] = v.w;
  }
  __syncthreads();
  const int kc = (tid & 7) * 8, jr = tid >> 3;
#pragma unroll
  for (int it = 0; it < 2; ++it) {
    const int j = jr + 32 * it;
    const float* tp = tile + kc * 65 + j;
    uint4 o;
    o.x = pack2(tp[0], tp[65]); o.y = pack2(tp[130], tp[195]); o.z = pack2(tp[260], tp[325]); o.w = pack2(tp[390], tp[455]);
    *(uint4*)(dst + (size_t)(c0 + j) * ld_dst + r0 + kc) = o;
  }
  __syncthreads();
}

DI void prep_transposes(const Params& p, int vb, int G, char* lds) {
  for (int t = vb; t < 5312; t += G) {
    const float* src; u16* dst; int lds_, ldd, r0, c0;
    int q = t;
    if (q < 128) { src = p.in[12]; lds_ = 1024; dst = (u16*)(p.ws + OFF_WIN_E); ldd = 1024; r0 = (q >> 3) * 64; c0 = (q & 7) * 64; }
    else if ((q -= 128) < 256) { src = p.in[16]; lds_ = 1024; dst = (u16*)(p.ws + OFF_WOUT_ET); ldd = 1024; r0 = (q >> 4) * 64; c0 = (q & 15) * 64; }
    else if ((q -= 256) < 576) { src = p.in[17]; lds_ = 2304; dst = (u16*)(p.ws + OFF_WIN_O); ldd = 1024; r0 = (q / 36) * 64; c0 = (q % 36) * 64; }
    else if ((q -= 576) < 256) { src = p.in[28]; lds_ = 1024; dst = (u16*)(p.ws + OFF_WOUT_O); ldd = 1024; r0 = (q >> 4) * 64; c0 = (q & 15) * 64; }
    else if ((q -= 256) < 2048) { const int l = q >> 10; q &= 1023; src = p.in[29] + (size_t)l * 1024 * 4096; lds_ = 4096; dst = (u16*)(p.ws + OFF_W1) + (size_t)l * 4096 * 1024; ldd = 1024; r0 = (q >> 6) * 64; c0 = (q & 63) * 64; }
    else { q -= 2048; const int l = q >> 10; q &= 1023; src = p.in[30] + (size_t)l * 4096 * 1024; lds_ = 1024; dst = (u16*)(p.ws + OFF_W2) + (size_t)l * 1024 * 4096; ldd = 4096; r0 = (q >> 4) * 64; c0 = (q & 15) * 64; }
    transpose_tile(src, lds_, dst, ldd, r0, c0, lds);
  }
}

DI void prep_elementwise(const Params& p, int vb, int G) {
  const size_t gt = (size_t)vb * 256 + TIDX, gs = (size_t)G * 256;
  {
    u16* d = (u16*)(p.ws + OFF_WINB);
    for (size_t i = gt; i < 1024 * 256; i += gs) {
      const int k = (int)(i >> 8), c = (int)(i & 255) * 2;
      const float* s = p.in[12] + (size_t)k * 1024 + 512 + c;
      *(unsigned*)(d + (size_t)k * 512 + c) = pack2(s[0], s[1]);
    }
  }
  {
    u16* d = (u16*)(p.ws + OFF_CBD);
    for (size_t i = gt; i < 1024 * 512; i += gs) {
      const int np = (int)(i >> 9), cp = (int)(i & 511);
      const int g = np >> 8, pq = (np >> 7) & 1, m = np & 127;
      float v = 0.f;
      if ((cp >> 7) == g) {
        const int c = cp & 127; const int rr = (m * c) & 127;
        const float x = (float)rr * (2.0f / 128.0f);
        v = pq ? sinpif(x) : cospif(x);
      }
      d[i] = f2bf(v);
    }
  }
  {
    u16* d = (u16*)(p.ws + OFF_BD);
    for (size_t i = gt; i < 1024 * 1024; i += gs) {
      const int kp = (int)(i >> 10), c = (int)(i & 1023);
      float v = 0.f;
      if (kp < 512) { const int g = kp >> 7; if (c < 512 && (c >> 7) == g) v = p.in[13][(size_t)g * 16384 + (kp & 127) * 128 + (c & 127)] * p.in[14][c]; }
      else { const int g = (kp - 512) >> 7; if (c >= 512 && ((c - 512) >> 7) == g) v = p.in[15][(size_t)g * 16384 + ((kp - 512) & 127) * 128 + ((c - 512) & 127)]; }
      d[i] = f2bf(v);
    }
  }
#pragma unroll 1
  for (int which = 0; which < 2; ++which) {
    const int H = which ? 2048 : 128, N = 2 * H, lg = which ? 9 : 5;
    u16* d = (u16*)(p.ws + (which ? OFF_D4096 : OFF_D256));
    const float invN = 1.0f / (float)N;
    for (size_t i = gt; i < ((size_t)H << lg); i += gs) {
      const int k = (int)(i >> lg), np = (int)(i & ((1 << lg) - 1)) * 8;
      const bool is_sin = np >= H;
      const int n = np & (H - 1);
      unsigned w[4];
#pragma unroll
      for (int e = 0; e < 4; ++e) {
        const float x0 = (float)((k * (n + 2 * e)) & (N - 1)) * invN, x1 = (float)((k * (n + 2 * e + 1)) & (N - 1)) * invN;
        const float v0 = is_sin ? __builtin_amdgcn_sinf(x0) : __builtin_amdgcn_cosf(x0);
        const float v1 = is_sin ? __builtin_amdgcn_sinf(x1) : __builtin_amdgcn_cosf(x1);
        w[e] = pack2(v0, v1);
      }
      *(uint4*)(d + (size_t)k * N + np) = make_uint4(w[0], w[1], w[2], w[3]);
    }
  }
}

DI void sym_phase(const Params& p, int vb, int G) {
  const int lane = TIDX & 63, wave = TIDX >> 6;
  const u16* PQT = (const u16*)(p.ws + OFF_PQT);
  u16* PEQO = (u16*)(p.ws + OFF_PEQO);
  u16* AB = (u16*)(p.ws + OFF_AB);
  for (int it = vb * 4 + wave; it < 1024 + 2048; it += G * 4) {
    const bool samp = it < 1024;
    const int H = samp ? 2048 : 128, N = 2 * H;
    int col, n0base, nstep;
    if (samp) { col = it; n0base = lane * 8; nstep = 512; }
    else { col = (it - 1024) * 4 + (lane >> 4); n0base = (lane & 15) * 8; nstep = 128; }
    const u16* Pp = samp ? PQT + (size_t)16 * 512 * 512 + (size_t)col * 8192 : PQT + (size_t)col * 512;
    const u16* Qp = Pp + N;
    u16* Pe = samp ? PEQO + (size_t)16 * 512 * 256 + (size_t)col * 4096 : PEQO + (size_t)col * 256;
    u16* Qo = Pe + H;
    float alt = 0.f;
    for (int n0 = n0base; n0 < H; n0 += nstep) {
      const uint4 pw = *(const uint4*)(Pp + n0), qw = *(const uint4*)(Qp + n0);
      const unsigned pa[4] = {pw.x, pw.y, pw.z, pw.w}, qa[4] = {qw.x, qw.y, qw.z, qw.w};
      float pe[8], qo[8];
#pragma unroll
      for (int e = 0; e < 8; ++e) {
        const float pv = (e & 1) ? __uint_as_float(pa[e >> 1] & 0xffff0000u) : __uint_as_float(pa[e >> 1] << 16);
        const float qv = (e & 1) ? __uint_as_float(qa[e >> 1] & 0xffff0000u) : __uint_as_float(qa[e >> 1] << 16);
        const int n = n0 + e;
        float pm = 0.f, qm = 0.f;
        if (n > 0) { pm = bf2f(Pp[N - n]); qm = bf2f(Qp[N - n]); }
        pe[e] = pv + pm;
        qo[e] = (n > 0) ? qv - qm : 0.f;
        alt += (e & 1) ? -pe[e] : pe[e];
      }
      *(uint4*)(Pe + n0) = make_uint4(pack2(pe[0], pe[1]), pack2(pe[2], pe[3]), pack2(pe[4], pe[5]), pack2(pe[6], pe[7]));
      *(uint4*)(Qo + n0) = make_uint4(pack2(qo[0], qo[1]), pack2(qo[2], qo[3]), pack2(qo[4], qo[5]), pack2(qo[6], qo[7]));
    }
    alt += __shfl_xor(alt, 1); alt += __shfl_xor(alt, 2); alt += __shfl_xor(alt, 4); alt += __shfl_xor(alt, 8);
    if (samp) { alt += __shfl_xor(alt, 16); alt += __shfl_xor(alt, 32); }
    if ((samp && lane == 0) || (!samp && (lane & 15) == 0)) {
      const float fh = alt + bf2f(Pp[H]);
      size_t row; int c; float norm;
      if (samp) { row = (size_t)4096 + (size_t)(col >> 9) * 4096 + 2048; c = col & 511; norm = 0.0013810679320049757f; }
      else { row = (size_t)(col >> 9) * 256 + 128; c = col & 511; norm = 0.005524271728019903f; }
      AB[row * 1024 + 512 + c] = f2bf(fh * norm);
    }
  }
}

DI void normmod_phase(const Params& p, int vb, int G, const float* xp, const float* xs, const float* gain, int l, int which) {
  const int lane = TIDX & 63, wave = TIDX >> 6;
  u16* H = (u16*)(p.ws + OFF_H);
  const float* mods = (const float*)(p.ws + OFF_MODS) + (size_t)l * 3 * 6144;
  for (int row = vb * 4 + wave; row < T; row += G * 4) {
    const float* x = (row < 4096) ? xp + (size_t)row * 1024 : xs + (size_t)(row - 4096) * 1024;
    float4 v[4];
    float ss = 0.f;
#pragma unroll
    for (int i = 0; i < 4; ++i) {
      v[i] = *(const float4*)(x + i * 256 + lane * 4);
      ss += v[i].x * v[i].x + v[i].y * v[i].y + v[i].z * v[i].z + v[i].w * v[i].w;
    }
    ss = wave_sum(ss);
    const float rinv = rsqrtf(ss * (1.0f / 1024.0f) + EPS);
    const float* md = mods + cond_of(row) * 6144 + which * 3072;
#pragma unroll
    for (int i = 0; i < 4; ++i) {
      const int c = i * 256 + lane * 4;
      const float4 g = *(const float4*)(gain + c);
      const float4 sh = *(const float4*)(md + c);
      const float4 sc = *(const float4*)(md + 1024 + c);
      const float o0 = v[i].x * rinv * g.x * (1.f + sc.x) + sh.x;
      const float o1 = v[i].y * rinv * g.y * (1.f + sc.y) + sh.y;
      const float o2 = v[i].z * rinv * g.z * (1.f + sc.z) + sh.z;
      const float o3 = v[i].w * rinv * g.w * (1.f + sc.w) + sh.w;
      uint2 w; w.x = pack2(o0, o1); w.y = pack2(o2, o3);
      *(uint2*)(H + (size_t)row * 1024 + c) = w;
    }
  }
}

template <class Epi>
DI void gemm_phase(const u16* A, int lda, const u16* Bt, int ldb, int K, int M, int N, Epi epi, int vb, int G, char* lds) {
  const int nN = N >> 7, nt = (M >> 7) * nN, grp = 8 * nN;
  for (int t = vb; t < nt; t += G) {
    const int gi = t / grp, rem = t - gi * grp;
    gemm_tile(A, lda, Bt, ldb, K, (gi * 8 + (rem & 7)) << 7, (rem >> 3) << 7, epi, lds);
  }
}

DI void pool_phase(const Params& p, int vb, int G) {
  const u16* UA = (const u16*)(p.ws + OFF_UA);
  u16* AB = (u16*)(p.ws + OFF_AB);
  const size_t gt = (size_t)vb * 256 + TIDX, gs = (size_t)G * 256;
  for (size_t i = gt; i < (size_t)T * 64; i += gs) {
    const int t = (int)(i >> 6), c8 = (int)(i & 63) * 8;
    const int g = c8 >> 7, hw = 1 << g;
    int nl, N, base;
    if (t < 4096) { nl = t & 255; N = 256; base = t - nl; } else { nl = (t - 4096) & 4095; N = 4096; base = t - nl; }
    const int lo = max(nl - hw, 0), hi = min(nl + hw, N);
    float s[8] = {0, 0, 0, 0, 0, 0, 0, 0};
    for (int j = lo; j < hi; ++j) {
      const uint4 w = *(const uint4*)(UA + (size_t)(base + j) * 512 + c8);
      s[0] += __uint_as_float(w.x << 16); s[1] += __uint_as_float(w.x & 0xffff0000u);
      s[2] += __uint_as_float(w.y << 16); s[3] += __uint_as_float(w.y & 0xffff0000u);
      s[4] += __uint_as_float(w.z << 16); s[5] += __uint_as_float(w.z & 0xffff0000u);
      s[6] += __uint_as_float(w.w << 16); s[7] += __uint_as_float(w.w & 0xffff0000u);
    }
    const float inv = 1.0f / (float)(hi - lo);
    const uint4 w = *(const uint4*)(UA + (size_t)t * 512 + c8);
    uint4 o;
    o.x = pack2(s[0] * inv - __uint_as_float(w.x << 16), s[1] * inv - __uint_as_float(w.x & 0xffff0000u));
    o.y = pack2(s[2] * inv - __uint_as_float(w.y << 16), s[3] * inv - __uint_as_float(w.y & 0xffff0000u));
    o.z = pack2(s[4] * inv - __uint_as_float(w.z << 16), s[5] * inv - __uint_as_float(w.z & 0xffff0000u));
    o.w = pack2(s[6] * inv - __uint_as_float(w.w << 16), s[7] * inv - __uint_as_float(w.w & 0xffff0000u));
    *(uint4*)(AB + (size_t)t * 1024 + c8) = o;
  }
}

DI void qkvpost_phase(const Params& p, int vb, int G) {
  const int lane = TIDX & 63, wave = TIDX >> 6;
  const int q = lane & 15, sub = lane >> 4;
  const u16* QKV = (const u16*)(p.ws + OFF_QKV);
  u16* CQ = (u16*)(p.ws + OFF_CQ); u16* DQ = (u16*)(p.ws + OFF_DQ);
  u16* CKP = (u16*)(p.ws + OFF_CKP); u16* CKS = (u16*)(p.ws + OFF_CKS);
  u16* DKP = (u16*)(p.ws + OFF_DKP); u16* DKS = (u16*)(p.ws + OFF_DKS);
  float* nck = p.out + OUT_NCK; float* ndk = p.out + OUT_NDK;
  const int d0 = q * 4;
  float fr[4];
#pragma unroll
  for (int e = 0; e < 4; ++e) fr[e] = exp2f(-(float)((d0 + e) & 15) * (13.287712379549449f / 16.0f));
  const bool firsthalf = ((d0 >> 4) & 1) == 0;
  for (int t = vb * 4 + wave; t < T; t += G * 4) {
    const bool samp = t >= 4096;
    int b, nl;
    if (!samp) { b = t >> 8; nl = t & 255; } else { b = (t - 4096) >> 12; nl = (t - 4096) & 4095; }
    float cs[4], sn[4];
    if (samp) {
      const float pos = (d0 < 32) ? (float)(nl >> 6) : (float)(nl & 63);
#pragma unroll
      for (int e = 0; e < 4; ++e) { const float a = pos * fr[e]; cs[e] = cosf(a); sn[e] = sinf(a); }
    } else {
#pragma unroll
      for (int e = 0; e < 4; ++e) { cs[e] = 1.f; sn[e] = 0.f; }
    }
    for (int rd = 0; rd < 7; ++rd) {
      const int slot = rd * 4 + sub;
      const bool act = slot < 26;
      const int vi = act ? (slot < 16 ? slot : slot + 8) : 0;
      const uint2 raw = *(const uint2*)(QKV + (size_t)t * 2304 + vi * 64 + d0);
      float x[4] = {__uint_as_float(raw.x << 16), __uint_as_float(raw.x & 0xffff0000u), __uint_as_float(raw.y << 16), __uint_as_float(raw.y & 0xffff0000u)};
      float ss = x[0] * x[0] + x[1] * x[1] + x[2] * x[2] + x[3] * x[3];
      ss += __shfl_xor(ss, 1); ss += __shfl_xor(ss, 2); ss += __shfl_xor(ss, 4); ss += __shfl_xor(ss, 8);
      const float rinv = rsqrtf(ss * (1.0f / 64.0f) + EPS);
      const float* gp = (vi < 8) ? p.in[18] : (vi < 16) ? p.in[19] : (vi < 32) ? p.in[25] : p.in[26];
      const float4 g = *(const float4*)(gp + d0);
      float y[4] = {x[0] * rinv * g.x, x[1] * rinv * g.y, x[2] * rinv * g.z, x[3] * rinv * g.w};
      float o[4];
#pragma unroll
      for (int e = 0; e < 4; ++e) {
        const float part = __shfl_xor(y[e], 4);
        o[e] = firsthalf ? (y[e] * cs[e] - part * sn[e]) : (y[e] * cs[e] + part * sn[e]);
      }
      if (!act) continue;
      const bool isq = (vi < 8) || (vi >= 24 && vi < 32);
      if (isq) {
        const int hd = (vi < 8) ? vi : vi - 24;
        u16* base = (vi < 8) ? CQ : DQ;
        size_t off = samp ? (size_t)16 * 8 * 256 * 64 + ((size_t)(b * 8 + hd) * 4096 + nl) * 64 : ((size_t)(b * 8 + hd) * 256 + nl) * 64;
        uint2 w; w.x = pack2(o[0] * QSCALE, o[1] * QSCALE); w.y = pack2(o[2] * QSCALE, o[3] * QSCALE);
        *(uint2*)(base + off + d0) = w;
      } else if (vi < 16) {
        const int hm = vi - 8;
        uint2 w; w.x = pack2(o[0], o[1]); w.y = pack2(o[2], o[3]);
        if (samp) *(uint2*)(CKS + ((size_t)(b * 8 + hm) * 4608 + 512 + nl) * 64 + d0) = w;
        else {
          *(uint2*)(CKP + ((size_t)(b * 8 + hm) * 256 + nl) * 64 + d0) = w;
          *(float4*)(nck + (size_t)t * 512 + hm * 64 + d0) = make_float4(o[0], o[1], o[2], o[3]);
        }
      } else {
        const int j = vi - 32;
        uint2 w; w.x = pack2(o[0], o[1]); w.y = pack2(o[2], o[3]);
        if (samp) *(uint2*)(DKS + ((size_t)(b * 2 + j) * 4608 + 512 + nl) * 64 + d0) = w;
        else {
          *(uint2*)(DKP + ((size_t)(b * 2 + j) * 256 + nl) * 64 + d0) = w;
          *(float4*)(ndk + (size_t)t * 128 + j * 64 + d0) = make_float4(o[0], o[1], o[2], o[3]);
        }
      }
    }
  }
  const size_t gt = (size_t)vb * 256 + TIDX, gs = (size_t)G * 256;
  {
    u16* CVTS = (u16*)(p.ws + OFF_CVTS); u16* DVTS = (u16*)(p.ws + OFF_DVTS);
    for (size_t i = gt; i < (size_t)2 * 512 * 512; i += gs) {
      const int b = (int)(i >> 18), key = (int)(i >> 9) & 511, c = (int)(i & 511);
      CKS[((size_t)(b * 8 + (c >> 6)) * 4608 + key) * 64 + (c & 63)] = f2bf(p.in[3][i]);
    }
    for (size_t i = gt; i < (size_t)2 * 512 * 512; i += gs) {
      const int b = (int)(i >> 18), c = (int)(i >> 9) & 511, key = (int)(i & 511);
      CVTS[((size_t)(b * 512 + c)) * 4608 + key] = f2bf(p.in[4][((size_t)b * 512 + key) * 512 + c]);
    }
    for (size_t i = gt; i < (size_t)2 * 512 * 128; i += gs) {
      const int b = (int)(i >> 16), key = (int)(i >> 7) & 511, c = (int)(i & 127);
      DKS[((size_t)(b * 2 + (c >> 6)) * 4608 + key) * 64 + (c & 63)] = f2bf(p.in[5][i]);
    }
    for (size_t i = gt; i < (size_t)2 * 128 * 512; i += gs) {
      const int b = (int)(i >> 16), c = (int)(i >> 9) & 127, key = (int)(i & 511);
      DVTS[((size_t)(b * 128 + c)) * 4608 + key] = f2bf(p.in[6][((size_t)b * 512 + key) * 128 + c]);
    }
  }
}

template <int DV>
DI void attn_item(const u16* Q, const u16* Kb, const u16* Vt, int ldv, int nt0, int key1, int nt1,
                  bool masked, int qpos0, bool has_sink, float sink2, u16* out, int ldo, char* lds) {
  constexpr int NDB = DV / 32;
  constexpr int KVBUF = (64 + DV) * LROW;
  const int tid = TIDX, lane = tid & 63, wave = tid >> 6;
  const int r = lane & 31, h = lane >> 5;
  const int nt = nt0 + nt1;
  bf16x8 qf[4];
#pragma unroll
  for (int ks = 0; ks < 4; ++ks) qf[ks] = *(const bf16x8*)(Q + (size_t)(wave * 32 + r) * 64 + ks * 16 + h * 8);
  f32x16 O[NDB];
#pragma unroll
  for (int i = 0; i < NDB; ++i)
#pragma unroll
    for (int e = 0; e < 16; ++e) O[i][e] = 0.f;
  float mrun = has_sink ? sink2 : -1e30f;
  float lrun = has_sink ? (h == 0 ? 1.f : 0.f) : 0.f;
  const int lrow = tid >> 3, lpart = (tid & 7) * 8;
  uint4 rk0, rk1, rv0, rv1, rv2, rv3;
  rv2 = rv3 = make_uint4(0, 0, 0, 0);
  const u16* gk = Kb + (size_t)lrow * 64 + lpart;
  const u16* gv = Vt + (size_t)lrow * ldv + lpart;
#define ATT_GLOAD(key0_)                                                         \
  do {                                                                           \
    rk0 = *(const uint4*)(gk + (size_t)(key0_) * 64);                            \
    rk1 = *(const uint4*)(gk + (size_t)((key0_) + 32) * 64);                     \
    rv0 = *(const uint4*)(gv + (key0_));                                         \
    rv1 = *(const uint4*)(gv + (size_t)32 * ldv + (key0_));                      \
    if constexpr (DV == 128) {                                                   \
      rv2 = *(const uint4*)(gv + (size_t)64 * ldv + (key0_));                    \
      rv3 = *(const uint4*)(gv + (size_t)96 * ldv + (key0_));                    \
    }                                                                            \
  } while (0)
#define ATT_SSTORE(boff_)                                                        \
  do {                                                                           \
    *(uint4*)(sw + (boff_)) = rk0;                                               \
    *(uint4*)(sw + (boff_) + 32 * LROW) = rk1;                                   \
    *(uint4*)(sw + (boff_) + 64 * LROW) = rv0;                                   \
    *(uint4*)(sw + (boff_) + 96 * LROW) = rv1;                                   \
    if constexpr (DV == 128) {                                                   \
      *(uint4*)(sw + (boff_) + 128 * LROW) = rv2;                                \
      *(uint4*)(sw + (boff_) + 160 * LROW) = rv3;                                \
    }                                                                            \
  } while (0)
  char* sw = lds + lrow * LROW + lpart * 2;
  {
    const int key0 = (nt0 > 0) ? 0 : key1;
    ATT_GLOAD(key0);
  }
  ATT_SSTORE(0);
  __syncthreads();
  const int pr = (r & 0x13) | ((r & 4) << 1) | ((r & 8) >> 1);
  const char* fk = lds + pr * LROW + h * 16;
  const char* fv = lds + 64 * LROW + r * LROW + h * 16;
  const int qpos = qpos0 + wave * 32 + r;
  for (int t = 0; t < nt; ++t) {
    const int cur = (t & 1) * KVBUF;
    const int key0 = (t < nt0) ? t * 64 : key1 + (t - nt0) * 64;
    {
      const int tn = (t + 1 < nt) ? t + 1 : t;
      const int kn = (tn < nt0) ? tn * 64 : key1 + (tn - nt0) * 64;
      ATT_GLOAD(kn);
    }
    f32x16 S[2];
#pragma unroll
    for (int kb = 0; kb < 2; ++kb) {
#pragma unroll
      for (int e = 0; e < 16; ++e) S[kb][e] = 0.f;
#pragma unroll
      for (int ks = 0; ks < 4; ++ks) {
        const bf16x8 kf = *(const bf16x8*)(fk + cur + kb * 32 * LROW + ks * 32);
        S[kb] = MFMA(kf, qf[ks], S[kb]);
      }
    }
    if (masked && t >= nt0) {
#pragma unroll
      for (int kb = 0; kb < 2; ++kb)
#pragma unroll
        for (int e = 0; e < 16; ++e) {
          const int jpos = key0 - 512 + kb * 32 + 16 * (e >> 3) + 8 * h + (e & 7);
          const int dlt = qpos - jpos;
          if (dlt > 128 || dlt < -128) S[kb][e] = -1e30f;
        }
    }
    float mloc = S[0][0];
#pragma unroll
    for (int kb = 0; kb < 2; ++kb)
#pragma unroll
      for (int e = 0; e < 16; ++e) mloc = fmaxf(mloc, S[kb][e]);
    mloc = fmaxf(mloc, __shfl_xor(mloc, 32));
    const float mnew = fmaxf(mrun, mloc);
    const float alpha = __builtin_amdgcn_exp2f(mrun - mnew);
    mrun = mnew;
    float ps = 0.f;
#pragma unroll
    for (int kb = 0; kb < 2; ++kb)
#pragma unroll
      for (int e = 0; e < 16; ++e) { const float pv = __builtin_amdgcn_exp2f(S[kb][e] - mnew); S[kb][e] = pv; ps += pv; }
    lrun = lrun * alpha + ps;
#pragma unroll
    for (int i = 0; i < NDB; ++i)
#pragma unroll
      for (int e = 0; e < 16; ++e) O[i][e] *= alpha;
    bf16x8 pf[4];
#pragma unroll
    for (int jj = 0; jj < 4; ++jj) {
      const int kb = jj >> 1, o8 = (jj & 1) * 8;
      uint4 w;
      w.x = pack2(S[kb][o8 + 0], S[kb][o8 + 1]); w.y = pack2(S[kb][o8 + 2], S[kb][o8 + 3]);
      w.z = pack2(S[kb][o8 + 4], S[kb][o8 + 5]); w.w = pack2(S[kb][o8 + 6], S[kb][o8 + 7]);
      pf[jj] = __builtin_bit_cast(bf16x8, w);
    }
    __builtin_amdgcn_sched_barrier(0);
#pragma unroll
    for (int i = 0; i < NDB; ++i) {
#pragma unroll
      for (int jj = 0; jj < 4; ++jj) {
        const bf16x8 vf = *(const bf16x8*)(fv + cur + i * 32 * LROW + jj * 32);
        O[i] = MFMA(vf, pf[jj], O[i]);
      }
      if (i & 1) __builtin_amdgcn_sched_barrier(0);
    }
    ATT_SSTORE(KVBUF - cur);
    __syncthreads();
  }
#undef ATT_GLOAD
#undef ATT_SSTORE
  const float ltot = lrun + __shfl_xor(lrun, 32);
  const float inv = 1.0f / ltot;
  u16* op = out + (size_t)(wave * 32 + r) * ldo;
#pragma unroll
  for (int i = 0; i < NDB; ++i)
#pragma unroll
    for (int qd = 0; qd < 4; ++qd) {
      uint2 w;
      w.x = pack2(O[i][4 * qd] * inv, O[i][4 * qd + 1] * inv);
      w.y = pack2(O[i][4 * qd + 2] * inv, O[i][4 * qd + 3] * inv);
      *(uint2*)(op + i * 32 + 8 * qd + 4 * h) = w;
    }
}

DI void attention_phase(const Params& p, int vb, int G, char* lds) {
  const u16* CQ = (const u16*)(p.ws + OFF_CQ); const u16* DQ = (const u16*)(p.ws + OFF_DQ);
  const u16* CKP = (const u16*)(p.ws + OFF_CKP); const u16* CKS = (const u16*)(p.ws + OFF_CKS);
  const u16* CVTP = (const u16*)(p.ws + OFF_CVTP); const u16* CVTS = (const u16*)(p.ws + OFF_CVTS);
  const u16* DKP = (const u16*)(p.ws + OFF_DKP); const u16* DKS = (const u16*)(p.ws + OFF_DKS);
  const u16* DVTP = (const u16*)(p.ws + OFF_DVTP); const u16* DVTS = (const u16*)(p.ws + OFF_DVTS);
  u16* OM = (u16*)(p.ws + OFF_OM); u16* AC = (u16*)(p.ws + OFF_H);
  constexpr size_t QS = (size_t)16 * 8 * 256 * 64;
  for (int it = vb; it < 1536; it += G) {
    const bool diff = (it < 512) || (it >= 1024 && it < 1280);
    const bool samp = it < 1024;
    int qb, hd, b;
    if (samp) { const int i2 = it & 511; qb = i2 & 31; hd = (i2 >> 5) & 7; b = i2 >> 8; }
    else { const int i2 = (it - 1024) & 255; qb = i2 & 1; hd = (i2 >> 1) & 7; b = i2 >> 4; }
    const int nseq = samp ? 4096 : 256, nkeys = samp ? 4608 : 256;
    const int tok = samp ? 4096 + b * 4096 + qb * 128 : b * 256 + qb * 128;
    const size_t qoff = (samp ? QS : 0) + ((size_t)(b * 8 + hd) * nseq + qb * 128) * 64;
    if (diff) {
      const u16* Kp = (samp ? CKS : CKP) + (size_t)(b * 8 + hd) * nkeys * 64;
      const u16* Vp = (samp ? CVTS : CVTP) + (size_t)(b * 4 + (hd >> 1)) * 128 * nkeys;
      attn_item<128>(CQ + qoff, Kp, Vp, nkeys, nkeys >> 6, 0, 0, false, 0, false, 0.f, OM + (size_t)tok * 1024 + hd * 128, 1024, lds);
    } else {
      const u16* Kp = (samp ? DKS : DKP) + (size_t)(b * 2 + (hd >> 2)) * nkeys * 64;
      const u16* Vp = (samp ? DVTS : DVTP) + (size_t)(b * 2 + (hd >> 2)) * 64 * nkeys;
      int nt0 = 4, key1 = 0, nt1 = 0;
      if (samp) { const int lo = min(max(qb * 128 - 128, 0), 4096 - 384); nt0 = 8; key1 = 512 + lo; nt1 = 6; }
      attn_item<64>(DQ + qoff, Kp, Vp, nkeys, nt0, key1, nt1, samp, qb * 128, true, p.in[27][hd] * LOG2E, AC + (size_t)tok * 1024 + 512 + hd * 64, 1024, lds);
    }
  }
}

DI void combine_phase(const Params& p, int vb, int G) {
  const int lane = TIDX & 63, wave = TIDX >> 6;
  const float a = wave_sum(p.in[20][lane] * p.in[21][lane]);
  const float bsum = wave_sum(p.in[22][lane] * p.in[23][lane]);
  const float lam = expf(a) - expf(bsum) + LAM_INIT;
  const u16* OM = (const u16*)(p.ws + OFF_OM);
  u16* AC = (u16*)(p.ws + OFF_H);
  const int hh = lane >> 4, e0 = (lane & 15) * 8;
  float g[8];
#pragma unroll
  for (int e = 0; e < 8; ++e) g[e] = p.in[24][e0 + e] * (1.0f - LAM_INIT);
  for (int t = vb * 4 + wave; t < T; t += G * 4) {
    const uint4 w0 = *(const uint4*)(OM + (size_t)t * 1024 + (hh * 2) * 128 + e0);
    const uint4 w1 = *(const uint4*)(OM + (size_t)t * 1024 + (hh * 2 + 1) * 128 + e0);
    const unsigned a0[4] = {w0.x, w0.y, w0.z, w0.w}, a1[4] = {w1.x, w1.y, w1.z, w1.w};
    float d[8];
    float ss = 0.f;
#pragma unroll
    for (int e = 0; e < 4; ++e) {
      d[2 * e] = __uint_as_float(a0[e] << 16) - lam * __uint_as_float(a1[e] << 16);
      d[2 * e + 1] = __uint_as_float(a0[e] & 0xffff0000u) - lam * __uint_as_float(a1[e] & 0xffff0000u);
      ss += d[2 * e] * d[2 * e] + d[2 * e + 1] * d[2 * e + 1];
    }
    ss += __shfl_xor(ss, 1); ss += __shfl_xor(ss, 2); ss += __shfl_xor(ss, 4); ss += __shfl_xor(ss, 8);
    const float rinv = rsqrtf(ss * (1.0f / 128.0f) + EPS);
    uint4 o;
    o.x = pack2(d[0] * rinv * g[0], d[1] * rinv * g[1]); o.y = pack2(d[2] * rinv * g[2], d[3] * rinv * g[3]);
    o.z = pack2(d[4] * rinv * g[4], d[5] * rinv * g[5]); o.w = pack2(d[6] * rinv * g[6], d[7] * rinv * g[7]);
    *(uint4*)(AC + (size_t)t * 1024 + hh * 128 + e0) = o;
  }
}


namespace pg8 {
#define PG8_LAS __attribute__((address_space(3)))
typedef unsigned short bf16_t;
typedef short bf16x8 __attribute__((ext_vector_type(8)));
typedef float f32x4 __attribute__((ext_vector_type(4)));
typedef unsigned u32x4 __attribute__((ext_vector_type(4)));
constexpr int BM = 256, BK = 64, HALF = 128, HTB = HALF * BK * 2  , STAGE_BYTES = 8 * HTB, NXCD = 8, WGM = 8;

__host__ __device__ __forceinline__ int lds_byte(int r, int c) { const int st = (r >> 4) * 2 + (c >> 5), rr = r & 15, cc = c & 31, ob = rr * 64 + cc * 2; return st * 1024 + (ob ^ (((ob >> 9) & 1) << 5)); }
__host__ __device__ __forceinline__ void stage_rc(int b, int& R, int& C) { const int st = b / 1024, sb = b % 1024, swz = sb ^ (((sb >> 9) & 1) << 5); R = (st >> 1) * 16 + swz / 64; C = (st & 1) * 32 + (swz % 64) / 2; }
__host__ __device__ __forceinline__ int perm32(int rho) { const int n = rho >> 4, i = rho & 15; return 8 * (i >> 2) + 4 * n + (i & 3); }

struct Unit { int pm, pn; };
struct Gemm { const bf16_t* A; const bf16_t* Bt; int M, N, K; };

struct StaticOrder {
    int nM, nN, nwg, G, c;
    __host__ __device__ void init(int M, int N, int G_, int c_) { nM = M / BM; nN = N / BM; nwg = nM * nN; G = G_; c = c_; }
    __host__ __device__ bool next(int i, Unit& u) const {
        const long L = (long)i * G + c; if (L >= nwg) return false;
        int wgid = (int)L; { const int q = nwg / NXCD, r = nwg % NXCD, xcd = wgid % NXCD, off = wgid / NXCD; wgid = (xcd < r ? xcd * (q + 1) : r * (q + 1) + (xcd - r) * q) + off; }
        const int nig = WGM * nN, gid = wgid / nig, fm = gid * WGM, gsz = (nM - fm) < WGM ? (nM - fm) : WGM;
        u.pm = fm + ((wgid % nig) % gsz); u.pn = (wgid % nig) / gsz; return true;
    }
    __device__ __forceinline__ void a_ready(const Unit&) const {}
    __device__ __forceinline__ void done(const Unit&) const {}
};
template <class Epi, class Sched, bool STAMP = false>
__device__ __forceinline__ void gemm_phase(PG8_LAS unsigned char* lds, const Gemm g, const Sched& S, const Epi& E, unsigned long long* stamps) {
    const int tid = threadIdx.x, wid = __builtin_amdgcn_readfirstlane(tid >> 6), lane = tid & 63, wr = wid >> 2, wc = wid & 3, fr = lane & 15, fq = lane >> 4;
    const int K = g.K, nt = K / BK;
    int ts_lo = 0, ts_hi = 0, nts = 0; const unsigned long long rt_entry = STAMP ? (unsigned long long)wall_clock64() : 0ull;
#define PG8_STAMP() do { if (STAMP && wid == 0 && nts < 64) { const unsigned long long _c = (unsigned long long)clock64(); \
        ts_lo = (lane == nts) ? (int)(unsigned)_c : ts_lo; ts_hi = (lane == nts) ? (int)(unsigned)(_c >> 32) : ts_hi; ++nts; } } while (0)
    PG8_STAMP();
    unsigned voffA[2], voffB[2];
#pragma unroll
    for (int i = 0; i < 2; ++i) { int R, C; stage_rc(tid * 16 + i * 8192, R, C); const int Rb = Epi::PERM ? ((R & ~31) + perm32(R & 31)) : R;
        voffA[i] = (unsigned)(R * K + C) * 2u; voffB[i] = (unsigned)(Rb * K + C) * 2u; }
    const size_t kstep = (size_t)(BK * 2);
    const size_t hstep = (size_t)HALF * K * 2;
    const size_t tstep = 2 * hstep;
    const unsigned ldsw = (unsigned)wid * 1024u;
    const int aoff = lds_byte(wr * 64 + fr, fq * 8), boff = lds_byte(wc * 32 + fr, fq * 8);
#define PG8_SA(b, h) (((b) * 2 + (h)) * HTB)
#define PG8_SB(b, h) ((4 + (b) * 2 + (h)) * HTB)
#define PG8_STAGE(bufoff, gbase, voff) do { _Pragma("unroll") for (int _i = 0; _i < 2; ++_i) \
        __builtin_amdgcn_global_load_lds((const unsigned*)((const char*)(gbase) + (voff)[_i]), (PG8_LAS unsigned*)(lds + (bufoff) + ldsw + _i * 8192), 16, 0, 0); } while (0)
#define PG8_LDA(dst, b, h) do { _Pragma("unroll") for (int m = 0; m < 4; ++m) _Pragma("unroll") for (int k = 0; k < 2; ++k) dst[m][k] = *(const PG8_LAS bf16x8*)(lds + PG8_SA(b, h) + aoff + m * 2048 + k * 1024); } while (0)
#define PG8_LDB(dst, b, h) do { _Pragma("unroll") for (int n = 0; n < 2; ++n) _Pragma("unroll") for (int k = 0; k < 2; ++k) dst[n][k] = *(const PG8_LAS bf16x8*)(lds + PG8_SB(b, h) + boff + n * 2048 + k * 1024); } while (0)
#define PG8_MMA(ai, bj, At, Bt) do { __builtin_amdgcn_s_setprio(1); _Pragma("unroll") for (int m = 0; m < 4; ++m) _Pragma("unroll") for (int n = 0; n < 2; ++n) _Pragma("unroll") for (int k = 0; k < 2; ++k) \
        acc[ai][bj][m][n] = __builtin_amdgcn_mfma_f32_16x16x32_bf16(Bt[n][k], At[m][k], acc[ai][bj][m][n], 0, 0, 0); __builtin_amdgcn_s_setprio(0); } while (0)
#define PG8_WAIT_V(n) asm volatile("s_waitcnt vmcnt(" #n ")" ::: "memory")
#define PG8_WAIT_L(n) asm volatile("s_waitcnt lgkmcnt(" #n ")" ::: "memory")
#define PG8_BAR __builtin_amdgcn_s_barrier()
#define PG8_SCHED __builtin_amdgcn_sched_barrier(0)
    Unit cur, nxt; int ui = 0;
    if (!S.next(0, cur)) return;
    f32x4 acc[2][2][4][2];
#pragma unroll
    for (int a = 0; a < 2; ++a)
#pragma unroll
        for (int b = 0; b < 2; ++b)
#pragma unroll
            for (int m = 0; m < 4; ++m)
#pragma unroll
                for (int n = 0; n < 2; ++n) acc[a][b][m][n] = (f32x4){0.f, 0.f, 0.f, 0.f};
    bf16x8 At[4][2], B0[2][2], B1[2][2];
    const char* cA = (const char*)g.A + (size_t)cur.pm * tstep; const char* cB = (const char*)g.Bt + (size_t)cur.pn * tstep;
    S.a_ready(cur);
    PG8_STAGE(PG8_SB(0, 0), cB, voffB); PG8_STAGE(PG8_SA(0, 0), cA, voffA); PG8_STAGE(PG8_SB(0, 1), cB + hstep, voffB); PG8_STAGE(PG8_SA(0, 1), cA + hstep, voffA);
    if (wr == 1) PG8_BAR;
    PG8_WAIT_V(4); PG8_BAR;
    PG8_STAGE(PG8_SB(1, 0), cB + kstep, voffB); PG8_STAGE(PG8_SA(1, 0), cA + kstep, voffA); PG8_STAGE(PG8_SB(1, 1), cB + hstep + kstep, voffB);
    PG8_WAIT_V(6); PG8_BAR;
    PG8_STAMP();
    for (;;) {
        const bool has_next = S.next(ui + 1, nxt);
        const char* nA = has_next ? (const char*)g.A + (size_t)nxt.pm * tstep : cA; const char* nB = has_next ? (const char*)g.Bt + (size_t)nxt.pn * tstep : cB;
        for (int t = 0; t < nt; t += 2) {
            const bool last = (t == nt - 2);
            const char* a1 = cA + (size_t)(t + 1) * kstep;
            const char* a2 = last ? nA : cA + (size_t)(t + 2) * kstep; const char* b2 = last ? nB : cB + (size_t)(t + 2) * kstep;
            const char* a3 = a2 + kstep; const char* b3 = b2 + kstep;
            if (last && has_next) S.a_ready(nxt);
            PG8_LDB(B0, 0, 0); PG8_SCHED; PG8_LDA(At, 0, 0); PG8_STAGE(PG8_SA(1, 1), a1 + hstep, voffA);
            PG8_WAIT_L(8); PG8_BAR; PG8_WAIT_L(0); PG8_MMA(0, 0, At, B0); PG8_BAR; PG8_SCHED;
            PG8_LDB(B1, 0, 1); PG8_STAGE(PG8_SB(0, 0), b2, voffB);
            PG8_BAR; PG8_WAIT_L(0); PG8_MMA(0, 1, At, B1); PG8_BAR;
            PG8_LDA(At, 0, 1); PG8_STAGE(PG8_SA(0, 0), a2, voffA);
            PG8_BAR; PG8_WAIT_L(0); PG8_MMA(1, 0, At, B0); PG8_BAR; PG8_SCHED;
            PG8_STAGE(PG8_SB(0, 1), b2 + hstep, voffB);
            PG8_WAIT_V(6); PG8_BAR; PG8_MMA(1, 1, At, B1); PG8_BAR;
            PG8_LDB(B0, 1, 0); PG8_SCHED; PG8_LDA(At, 1, 0); PG8_STAGE(PG8_SA(0, 1), a2 + hstep, voffA);
            PG8_WAIT_L(8); PG8_BAR; PG8_WAIT_L(0); PG8_MMA(0, 0, At, B0); PG8_BAR; PG8_SCHED;
            PG8_LDB(B1, 1, 1); PG8_STAGE(PG8_SB(1, 0), b3, voffB);
            PG8_BAR; PG8_WAIT_L(0); PG8_MMA(0, 1, At, B1); PG8_BAR;
            PG8_LDA(At, 1, 1); PG8_STAGE(PG8_SA(1, 0), a3, voffA);
            PG8_BAR; PG8_WAIT_L(0); PG8_MMA(1, 0, At, B0); PG8_BAR; PG8_SCHED;
            PG8_STAGE(PG8_SB(1, 1), b3 + hstep, voffB);
            PG8_WAIT_V(6); PG8_BAR; PG8_MMA(1, 1, At, B1); PG8_BAR;
        }
        PG8_STAMP();
        if constexpr (!Epi::AFTER_DRAIN) { E(acc, cur, wr, wc, fr, fq); S.done(cur); }
        PG8_STAMP();
        if (!has_next) break;
#pragma unroll
        for (int a = 0; a < 2; ++a)
#pragma unroll
            for (int b = 0; b < 2; ++b)
#pragma unroll
                for (int m = 0; m < 4; ++m)
#pragma unroll
                    for (int n = 0; n < 2; ++n) acc[a][b][m][n] = (f32x4){0.f, 0.f, 0.f, 0.f};
        cur = nxt; cA = nA; cB = nB; ++ui;
    }
    PG8_WAIT_V(0);
    if (wr == 0) PG8_BAR;
    PG8_BAR;
    if constexpr (Epi::AFTER_DRAIN) { E.fused(acc, cur, wr, wc, fr, fq, lds, wid, lane); S.done(cur); }
    PG8_STAMP();
    if (STAMP && wid == 0) { stamps[lane] = lane < nts ? (((unsigned long long)(unsigned)ts_hi << 32) | (unsigned)ts_lo) : 0ull;
        if (lane == 62) stamps[62] = rt_entry; if (lane == 63) stamps[63] = (unsigned long long)wall_clock64(); }
#undef PG8_STAMP
#undef PG8_SA
#undef PG8_SB
#undef PG8_STAGE
#undef PG8_LDA
#undef PG8_LDB
#undef PG8_MMA
#undef PG8_WAIT_V
#undef PG8_WAIT_L
#undef PG8_BAR
#undef PG8_SCHED
}
}

typedef float f32x4 __attribute__((ext_vector_type(4)));
template <class F> struct RowEpi {
  static constexpr bool PERM = false, AFTER_DRAIN = false;
  F f;
  DI void operator()(const pg8::f32x4 (&acc)[2][2][4][2], const pg8::Unit& u, int wr, int wc, int fr, int fq) const {
    const int row0 = u.pm * 256 + wr * 64 + fr, col0 = u.pn * 256 + wc * 32 + 4 * fq;
#pragma unroll
    for (int ai = 0; ai < 2; ++ai)
#pragma unroll
      for (int m = 0; m < 4; ++m)
#pragma unroll
        for (int bj = 0; bj < 2; ++bj)
#pragma unroll
          for (int n = 0; n < 2; ++n) f(row0 + ai * 128 + m * 16, col0 + bj * 128 + n * 16, acc[ai][bj][m][n]);
  }
};
struct FU {
  u16* UA; u16* PQt;
  DI void operator()(int m, int n, pg8::f32x4 v) const {
    if (n < 512) {
      uint2 w; w.x = pack2(v[0], v[1]); w.y = pack2(v[2], v[3]);
      *(uint2*)(UA + (size_t)m * 512 + n) = w;
    } else {
      const int np = n - 512, g = np >> 8, pq = (np >> 7) & 1, mm = np & 127;
      u16* q; size_t st;
      if (m < 4096) { const int b = m >> 8, nl = m & 255; q = PQt + ((size_t)(b * 512 + g * 128 + mm)) * 512 + pq * 256 + nl; st = 512; }
      else { const int ms = m - 4096, b = ms >> 12, nl = ms & 4095; q = PQt + (size_t)16 * 512 * 512 + ((size_t)(b * 512 + g * 128 + mm)) * 8192 + pq * 4096 + nl; st = 8192; }
      q[0] = f2bf(v[0]); q[st] = f2bf(v[1]); q[2 * st] = f2bf(v[2]); q[3 * st] = f2bf(v[3]);
    }
  }
};
struct FRes {
  const float* xin_p; const float* xin_s; float* X; const float* gate;
  DI void operator()(int m, int n, pg8::f32x4 v) const {
    const float* xi = (m < 4096) ? xin_p + (size_t)m * 1024 + n : xin_s + (size_t)(m - 4096) * 1024 + n;
    const float4 x = *(const float4*)xi;
    const float4 g = *(const float4*)(gate + cond_of(m) * 6144 + n);
    *(float4*)(X + (size_t)m * 1024 + n) = make_float4(x.x + g.x * v[0], x.y + g.y * v[1], x.z + g.z * v[2], x.w + g.w * v[3]);
  }
};
struct FRelu2 {
  u16* C;
  DI void operator()(int m, int n, pg8::f32x4 v) const {
    const float a = fmaxf(v[0], 0.f), b = fmaxf(v[1], 0.f), c = fmaxf(v[2], 0.f), d = fmaxf(v[3], 0.f);
    uint2 w; w.x = pack2(a * a, b * b); w.y = pack2(c * c, d * d);
    *(uint2*)(C + (size_t)m * 4096 + n) = w;
  }
};
struct FQkv {
  u16* QKV; u16* CVtP; u16* CVtS; u16* DVtP; u16* DVtS; float* ncv; float* ndv;
  DI void operator()(int m, int n, pg8::f32x4 v) const {
    const bool is_cv = (n >= 1024 && n < 1536), is_dv = (n >= 2176);
    if (!is_cv && !is_dv) {
      uint2 w; w.x = pack2(v[0], v[1]); w.y = pack2(v[2], v[3]);
      *(uint2*)(QKV + (size_t)m * 2304 + n) = w;
      return;
    }
    const int c = is_cv ? n - 1024 : n - 2176;
    const int feat = is_cv ? 512 : 128;
    u16* q; size_t st;
    if (m < 4096) {
      const int b = m >> 8, nl = m & 255;
      q = (is_cv ? CVtP : DVtP) + ((size_t)(b * feat + c)) * 256 + nl; st = 256;
      *(float4*)((is_cv ? ncv : ndv) + (size_t)m * feat + c) = make_float4(v[0], v[1], v[2], v[3]);
    } else {
      const int ms = m - 4096, b = ms >> 12, nl = ms & 4095;
      q = (is_cv ? CVtS : DVtS) + ((size_t)(b * feat + c)) * 4608 + 512 + nl; st = 4608;
    }
    q[0] = f2bf(v[0]); q[st] = f2bf(v[1]); q[2 * st] = f2bf(v[2]); q[3 * st] = f2bf(v[3]);
  }
};
template <class F>
DI void big_gemm(PG8_LAS unsigned char* lds, const u16* A, const u16* Bt, int M, int N, int K, F f) {
  pg8::Gemm g{A, Bt, M, N, K};
  pg8::StaticOrder S; S.init(M, N, (int)gridDim.x, (int)blockIdx.x);
  RowEpi<F> E{f};
  pg8::gemm_phase<RowEpi<F>, pg8::StaticOrder, false>(lds, g, S, E, nullptr);
}

#define XB_TMO      128
#define XB_XCNT(j)  (256  + 64 * (j))
#define XB_XSUB(j)  (1280 + 64 * (j))
#define XB_XGEN(j)  (2304 + 64 * (j))
#define XB_TOP      3328
#define XB_TOPGEN   3392
#define XCD_BAR_WORDS 3456
#define XB_SPIN_CAP (1u << 18)
#define LAS __attribute__((address_space(3)))
DI unsigned xb_ld(unsigned* p)              { return __hip_atomic_load(p, __ATOMIC_RELAXED, __HIP_MEMORY_SCOPE_AGENT); }
DI unsigned xb_add(unsigned* p, unsigned v) { return __hip_atomic_fetch_add(p, v, __ATOMIC_RELAXED, __HIP_MEMORY_SCOPE_AGENT); }
DI unsigned xb_xcc_id() { return (unsigned)__builtin_amdgcn_s_getreg((3 << 11) | 20) & 0xFu; }
#define XB_SPIN(cond, bar) do { unsigned _sp = 0; while (cond) { __builtin_amdgcn_s_sleep(1); \
    if ((++_sp & 255u) == 0u) { if (xb_ld(&(bar)[XB_TMO])) break; if (_sp > XB_SPIN_CAP) { atomicAdd(&(bar)[XB_TMO], 1u); break; } } } } while (0)
struct XcdBarrier { unsigned* bar; unsigned x; volatile LAS unsigned* st; };
DI XcdBarrier xcd_barrier_post(unsigned* bar, volatile LAS unsigned* st) {
  XcdBarrier b; b.bar = bar; b.x = xb_xcc_id(); b.st = st;
  if (threadIdx.x == 0) (void)xb_add(&bar[XB_XCNT(b.x)], 1u);
  return b;
}
DI void xcd_barrier_complete(unsigned* bar, unsigned x, unsigned& nloc, unsigned& nx) {
  const unsigned G = gridDim.x;
  unsigned sum, cnt, mine, sp = 0u;
  for (;;) {
    sum = 0u; cnt = 0u; mine = 0u;
#pragma unroll
    for (unsigned j = 0; j < 16; ++j) { const unsigned c = xb_ld(&bar[XB_XCNT(j)]); sum += c; cnt += (c > 0u) ? 1u : 0u; mine = (j == x) ? c : mine; }
    if (sum == G) break;
    __builtin_amdgcn_s_sleep(1);
    if ((++sp & 255u) == 0u) { if (xb_ld(&bar[XB_TMO])) break; if (sp > XB_SPIN_CAP) { atomicAdd(&bar[XB_TMO], 1u); break; } }
  }
  nloc = mine > 0u ? mine : 1u; nx = cnt > 0u ? cnt : 1u;
}
DI void xcd_barrier(const XcdBarrier& b) {
  asm volatile("s_waitcnt vmcnt(0)" ::: "memory");
  __syncthreads();
  if (threadIdx.x == 0) {
    unsigned* bar = b.bar;
    __builtin_amdgcn_s_waitcnt(0);
    unsigned nloc = b.st[0], nx = b.st[1];
    if (nloc == 0u) { xcd_barrier_complete(bar, b.x, nloc, nx); b.st[0] = nloc; b.st[1] = nx; }
    const unsigned old = xb_add(&bar[XB_XSUB(b.x)], 1u);
    const unsigned gen = old / nloc;
    if (old + 1u == (gen + 1u) * nloc) {
      __builtin_amdgcn_fence(__ATOMIC_RELEASE, "agent");
      asm volatile("s_waitcnt vmcnt(0)" ::: "memory");
      const unsigned og = xb_add(&bar[XB_TOP], 1u);
      const unsigned tg = og / nx;
      if (og + 1u == (tg + 1u) * nx) xb_add(&bar[XB_TOPGEN], 1u);
      else XB_SPIN(xb_ld(&bar[XB_TOPGEN]) == tg, bar);
      __builtin_amdgcn_fence(__ATOMIC_ACQUIRE, "agent");
      xb_add(&bar[XB_XGEN(b.x)], 1u);
      asm volatile("s_waitcnt vmcnt(0)" ::: "memory");
    } else {
      XB_SPIN(xb_ld(&bar[XB_XGEN(b.x)]) == gen, bar);
      __builtin_amdgcn_fence(__ATOMIC_ACQUIRE, "agent");
      asm volatile("s_waitcnt vmcnt(0)" ::: "memory");
    }
  }
  __syncthreads();
}

__global__ void __launch_bounds__(512) fwd_kernel(Params p, int ph_lo, int ph_hi) {
  extern __shared__ __attribute__((aligned(16))) unsigned char shm[];
  const int half = threadIdx.x >> 8;
  char* lds = (char*)shm + half * LDS_BYTES;
  PG8_LAS unsigned char* lds8 = (PG8_LAS unsigned char*)shm;
  const int G = 2 * (int)gridDim.x;
  int vb0 = blockIdx.x;
  if ((gridDim.x & 7) == 0) vb0 = (blockIdx.x & 7) * (gridDim.x >> 3) + (blockIdx.x >> 3);
  const int vb = 2 * vb0 + half;
  unsigned char* ws = p.ws;
  const float* mods = (const float*)(ws + OFF_MODS);
  float* X = p.out + OUT_Y;
  u16* H = (u16*)(ws + OFF_H);

#define RUNPH(n) ((ONLYPH < 0 || ONLYPH == (n)) && ph_lo <= (n) && (n) < ph_hi)
#define REP(n) _Pragma("unroll") for (int rep_ = 0; rep_ < ((DUPPH == (n)) ? 2 : 1); ++rep_)
#define SEAM(n) if (ph_lo < (n) && (n) < ph_hi) xcd_barrier(xb);
  __shared__ uint4 xb_words;
  if (threadIdx.x == 0) xb_words = make_uint4(0u, 0u, 0u, 0u);
  __syncthreads();
  XcdBarrier xb = xcd_barrier_post((unsigned*)(ws + OFF_BAR), (volatile LAS unsigned*)&xb_words);
  if (ph_hi > 1000) cg::this_grid().sync();
  if (RUNPH(0)) REP(0) {
    for (int id = vb; id < 384; id += G) ada_item(p, id, lds);
    prep_transposes(p, vb, G, lds);
    prep_elementwise(p, vb, G);
  }
  SEAM(1)
  if (RUNPH(1)) {
    for (int t = vb; t < 128; t += G) {
      const bool f1 = t < 64;
      const int q = t & 63;
      gemm_tile(f1 ? (const u16*)(ws + OFF_CBD) : (const u16*)(ws + OFF_WOUT_ET), f1 ? 512 : 1024,
                f1 ? (const u16*)(ws + OFF_WINB) : (const u16*)(ws + OFF_BD), f1 ? 512 : 1024, f1 ? 512 : 1024, (q >> 3) << 7, (q & 7) << 7,
                EpiBf16{f1 ? (u16*)(ws + OFF_WIN_E) + (size_t)512 * 1024 : (u16*)(ws + OFF_WOUT_E), 1024}, lds);
    }
    normmod_phase(p, vb, G, p.in[0], p.in[1], p.in[8], 0, 0);
  }
  SEAM(2)
  if (RUNPH(2)) REP(2)
    big_gemm(lds8, H, (const u16*)(ws + OFF_WIN_E), T, 1536, 1024, FU{(u16*)(ws + OFF_UA), (u16*)(ws + OFF_PQT)});
  SEAM(3)
  if (RUNPH(3)) sym_phase(p, vb, G);
  SEAM(4)
  if (RUNPH(4)) REP(4) {
    const u16* PQT = (const u16*)(ws + OFF_PQT);
    const u16* PEQO = (const u16*)(ws + OFF_PEQO);
    for (int t = vb; t < 256 + 128; t += G) {
      const bool big = t < 256;
      const int q = t - 256, b = q >> 3;
      dft_tile(big ? (const u16*)(ws + OFF_D4096) : (const u16*)(ws + OFF_D256),
               big ? PEQO + (size_t)16 * 512 * 256 : PEQO + (size_t)b * 512 * 256,
               big ? PQT + (size_t)16 * 512 * 512 + 2048 : PQT + (size_t)b * 512 * 512 + 128,
               big ? 8192 : 512, big ? 2048 : 128, big ? (t & 15) << 7 : 0, big ? (t >> 4) << 6 : (q & 7) << 6,
               (u16*)(ws + OFF_AB), big ? 4096 : b * 256, 512, big ? 0.0013810679320049757f : 0.005524271728019903f, lds);
    }
    pool_phase(p, vb, G);
  }
  SEAM(5)
  if (RUNPH(5))
    big_gemm(lds8, (const u16*)(ws + OFF_AB), (const u16*)(ws + OFF_WOUT_E), T, 1024, 1024, FRes{p.in[0], p.in[1], X, mods + 2048});
  SEAM(6)
  if (RUNPH(6)) normmod_phase(p, vb, G, X, X + (size_t)4096 * 1024, p.in[9], 0, 1);
  SEAM(7)
  if (RUNPH(7)) REP(7) big_gemm(lds8, H, (const u16*)(ws + OFF_W1), T, 4096, 1024, FRelu2{(u16*)(ws + OFF_M1)});
  SEAM(8)
  if (RUNPH(8)) big_gemm(lds8, (const u16*)(ws + OFF_M1), (const u16*)(ws + OFF_W2), T, 1024, 4096, FRes{X, X + (size_t)4096 * 1024, X, mods + 5120});
  SEAM(9)
  if (RUNPH(9)) normmod_phase(p, vb, G, X, X + (size_t)4096 * 1024, p.in[8] + 1024, 1, 0);
  SEAM(10)
  if (RUNPH(10)) big_gemm(lds8, H, (const u16*)(ws + OFF_WIN_O), T, 2304, 1024,
                            FQkv{(u16*)(ws + OFF_QKV), (u16*)(ws + OFF_CVTP), (u16*)(ws + OFF_CVTS), (u16*)(ws + OFF_DVTP), (u16*)(ws + OFF_DVTS), p.out + OUT_NCV, p.out + OUT_NDV});
  SEAM(11)
  if (RUNPH(11)) REP(11) qkvpost_phase(p, vb, G);
  SEAM(12)
  if (RUNPH(12)) REP(12) attention_phase(p, vb, G, lds);
  SEAM(13)
  if (RUNPH(13)) combine_phase(p, vb, G);
  SEAM(14)
  if (RUNPH(14)) big_gemm(lds8, H, (const u16*)(ws + OFF_WOUT_O), T, 1024, 1024, FRes{X, X + (size_t)4096 * 1024, X, mods + 3 * 6144 + 2048});
  SEAM(15)
  if (RUNPH(15)) normmod_phase(p, vb, G, X, X + (size_t)4096 * 1024, p.in[9] + 1024, 1, 1);
  SEAM(16)
  if (RUNPH(16)) big_gemm(lds8, H, (const u16*)(ws + OFF_W1) + (size_t)4096 * 1024, T, 4096, 1024, FRelu2{(u16*)(ws + OFF_M1)});
  SEAM(17)
  if (RUNPH(17)) big_gemm(lds8, (const u16*)(ws + OFF_M1), (const u16*)(ws + OFF_W2) + (size_t)4096 * 1024, T, 1024, 4096, FRes{X, X + (size_t)4096 * 1024, X, mods + 3 * 6144 + 5120});
}

extern "C" void kernel_launch(void* const* d_in, const int* in_sizes, int n_in, void* d_out, int out_size, void* d_ws, size_t ws_size,
                              hipStream_t stream) {
  constexpr int kDynLds = 2 * LDS_BYTES;
  static int grid = 0;
  if (!grid) {
    int dev = 0, cus = 0, per_cu = 0;
    (void)hipGetDevice(&dev);
    (void)hipDeviceGetAttribute(&cus, hipDeviceAttributeMultiprocessorCount, dev);
    if (hipFuncSetAttribute((const void*)fwd_kernel, hipFuncAttributeMaxDynamicSharedMemorySize, kDynLds) != hipSuccess) fprintf(stderr, "hipFuncSetAttribute(%d) failed\n", kDynLds);
    (void)hipOccupancyMaxActiveBlocksPerMultiprocessor(&per_cu, fwd_kernel, 512, kDynLds);
    if (per_cu < 1) fprintf(stderr, "occupancy query says %d blocks/CU\n", per_cu);
    grid = cus;
    if (ws_size < WS_END) fprintf(stderr, "workspace too small: %zu < %zu\n", ws_size, (size_t)WS_END);
  }
  Params p{};
  for (int i = 0; i < 31; ++i) p.in[i] = (const float*)d_in[i];
  p.out = (float*)d_out;
  p.ws = (unsigned char*)d_ws;
#if ONE_LAUNCH
  hipMemsetAsync((char*)d_ws + OFF_BAR, 0, XCD_BAR_WORDS * 4, stream);
  int lo = 0, hi = NPH;
  void* args[] = {&p, &lo, &hi};
  hipError_t e = hipLaunchCooperativeKernel((void*)fwd_kernel, dim3(grid), dim3(512), args, kDynLds, stream);
  if (e != hipSuccess) fprintf(stderr, "cooperative launch failed: %s (grid %d)\n", hipGetErrorString(e), grid);
#else
  for (int ph = 0; ph < NPH; ++ph) hipLaunchKernelGGL(fwd_kernel, dim3(grid), dim3(512), kDynLds, stream, p, ph, ph + 1);
#endif
}
```

```cpp
#include <hip/hip_runtime.h>
#include <hip/hip_cooperative_groups.h>
#include <cstdio>
namespace cg = cooperative_groups;

#ifndef ONE_LAUNCH
#define ONE_LAUNCH 1
#endif

#ifndef ONLYPH
#define ONLYPH -1
#endif
#ifndef DUPPH
#define DUPPH -1
#endif
typedef unsigned short u16;
typedef short bf16x8 __attribute__((ext_vector_type(8)));
typedef float f32x16 __attribute__((ext_vector_type(16)));
typedef __bf16 bf2_t __attribute__((ext_vector_type(2)));
typedef float f2_t __attribute__((ext_vector_type(2)));
typedef unsigned u32x4 __attribute__((ext_vector_type(4)));

#define DI __device__ __forceinline__
#define TIDX ((int)(threadIdx.x & 255u))

constexpr int T = 12288, TP = 4096, DM = 1024;
constexpr int NPH = 18;
constexpr float EPS = 1e-6f;
constexpr float LOG2E = 1.4426950408889634f;
constexpr float QSCALE = 0.125f * LOG2E;
constexpr float LAM_INIT = 0.35550906759f;

constexpr size_t al(size_t x) { return (x + 255) & ~size_t(255); }
constexpr size_t OFF_MODS   = 0;
constexpr size_t OFF_WIN_E  = OFF_MODS + al(2 * 3 * 6144 * 4);
constexpr size_t OFF_WINB   = OFF_WIN_E + al(1536 * 1024 * 2);
constexpr size_t OFF_CBD    = OFF_WINB + al(1024 * 512 * 2);
constexpr size_t OFF_WOUT_ET= OFF_CBD + al(1024 * 512 * 2);
constexpr size_t OFF_BD     = OFF_WOUT_ET + al(1024 * 1024 * 2);
constexpr size_t OFF_WOUT_E = OFF_BD + al(1024 * 1024 * 2);
constexpr size_t OFF_WIN_O  = OFF_WOUT_E + al(1024 * 1024 * 2);
constexpr size_t OFF_WOUT_O = OFF_WIN_O + al(2304 * 1024 * 2);
constexpr size_t OFF_W1     = OFF_WOUT_O + al(1024 * 1024 * 2);
constexpr size_t OFF_W2     = OFF_W1 + al(2 * 4096 * 1024 * 2);
constexpr size_t OFF_D256   = OFF_W2 + al(2 * 4096 * 1024 * 2);
constexpr size_t OFF_H      = OFF_D256 + al(256 * 512 * 2);
constexpr size_t OFF_R2     = OFF_H + al((size_t)T * 1024 * 2);
constexpr size_t R2_BYTES   = (size_t)T * 512 * 2 + (size_t)T * 1024 * 2 * 2;
constexpr size_t OFF_R1     = OFF_R2 + al(R2_BYTES);
constexpr size_t R1_BYTES   = (size_t)T * 4096 * 2;
constexpr size_t OFF_BAR    = OFF_R1 + R1_BYTES;
constexpr size_t WS_END     = OFF_BAR + 3456 * 4;
constexpr size_t OFF_UA  = OFF_R2;
constexpr size_t OFF_PQT = OFF_UA + (size_t)T * 512 * 2;
constexpr size_t OFF_AB  = OFF_PQT + (size_t)T * 1024 * 2;
constexpr size_t OFF_CQ   = OFF_R2;
constexpr size_t OFF_DQ   = OFF_CQ + (size_t)T * 512 * 2;
constexpr size_t OFF_CKP  = OFF_DQ + (size_t)T * 512 * 2;
constexpr size_t OFF_CKS  = OFF_CKP + (size_t)16 * 8 * 256 * 64 * 2;
constexpr size_t OFF_CVTP = OFF_CKS + (size_t)2 * 8 * 4608 * 64 * 2;
constexpr size_t OFF_CVTS = OFF_CVTP + (size_t)16 * 4 * 128 * 256 * 2;
constexpr size_t OFF_DKP  = OFF_CVTS + (size_t)2 * 4 * 128 * 4608 * 2;
constexpr size_t OFF_DKS  = OFF_DKP + (size_t)16 * 2 * 256 * 64 * 2;
constexpr size_t OFF_DVTP = OFF_DKS + (size_t)2 * 2 * 4608 * 64 * 2;
constexpr size_t OFF_DVTS = OFF_DVTP + (size_t)16 * 2 * 64 * 256 * 2;
constexpr size_t R2_LATE_END = OFF_DVTS + (size_t)2 * 2 * 64 * 4608 * 2;
static_assert(R2_LATE_END <= OFF_R2 + R2_BYTES, "R2 overflow");
constexpr size_t OFF_D4096 = OFF_R1;
constexpr size_t OFF_PEQO  = OFF_R1 + (size_t)32 * 1024 * 1024;
constexpr size_t OFF_M1    = OFF_R1;
constexpr size_t OFF_QKV   = OFF_R1;
constexpr size_t OFF_OM    = OFF_R1 + al((size_t)T * 2304 * 2);
static_assert(OFF_OM + (size_t)T * 1024 * 2 <= WS_END, "R1 overflow");

constexpr size_t OUT_Y   = 0;
constexpr size_t OUT_NCK = (size_t)T * 1024;
constexpr size_t OUT_NCV = OUT_NCK + (size_t)TP * 512;
constexpr size_t OUT_NDK = OUT_NCV + (size_t)TP * 512;
constexpr size_t OUT_NDV = OUT_NDK + (size_t)TP * 128;

struct Params {
  const float* in[31];
  float* out;
  unsigned char* ws;
};

DI float bf2f(u16 v) { return __uint_as_float(((unsigned)v) << 16); }
DI unsigned pack2(float a, float b) { f2_t f = {a, b}; bf2_t v = __builtin_convertvector(f, bf2_t); return __builtin_bit_cast(unsigned, v); }
DI u16 f2bf(float a) { return (u16)(pack2(a, 0.f) & 0xffffu); }
DI int cond_of(int m) { return m < 4096 ? 0 : (m < 8192 ? 1 : 2); }
DI float wave_sum(float v) {
#pragma unroll
  for (int o = 32; o >= 1; o >>= 1) v += __shfl_xor(v, o);
  return v;
}
#define MFMA(a, b, c) __builtin_amdgcn_mfma_f32_32x32x16_bf16((a), (b), (c), 0, 0, 0)

constexpr int LROW = 144;
constexpr int GEMM_BUF = 2 * 128 * LROW;
constexpr int LDS_BYTES = 2 * GEMM_BUF;

template <int NR>
DI void g_load(u32x4 (&R)[NR], const u16* g, int ld, int k0) {
#pragma unroll
  for (int i = 0; i < NR; ++i) R[i] = *(const u32x4*)(g + (size_t)(32 * i) * ld + k0);
}
template <int NR>
DI void g_store(const u32x4 (&R)[NR], char* sw) {
#pragma unroll
  for (int i = 0; i < NR; ++i) *(u32x4*)(sw + (32 * i) * LROW) = R[i];
}
template <int NB>
DI void g_compute(f32x16 (&acc)[2][NB], const char* fa, const char* fb) {
#pragma unroll
  for (int ks = 0; ks < 4; ++ks) {
    bf16x8 a0 = *(const bf16x8*)(fa + ks * 32);
    bf16x8 a1 = *(const bf16x8*)(fa + 32 * LROW + ks * 32);
#pragma unroll
    for (int j = 0; j < NB; ++j) {
      bf16x8 b = *(const bf16x8*)(fb + j * 32 * LROW + ks * 32);
      acc[0][j] = MFMA(a0, b, acc[0][j]);
      acc[1][j] = MFMA(a1, b, acc[1][j]);
    }
  }
}
template <int NB>
DI void gemm_acc(f32x16 (&acc)[2][NB], const u16* A, int lda, const u16* Bt, int ldb, int K, int m0, int n0, char* lds) {
  const int tid = TIDX, lane = tid & 63, wave = tid >> 6;
  const int r = lane & 31, h = lane >> 5;
  const int wm = wave >> 1, wn = wave & 1;
  const int lrow = tid >> 3, lcol = (tid & 7) * 8;
  const u16* ga = A + (size_t)(m0 + lrow) * lda + lcol;
  const u16* gb = Bt + (size_t)(n0 + lrow) * ldb + lcol;
  u32x4 ra0[4], ra1[4], rb0[2 * NB], rb1[2 * NB];
  const int nk = K >> 6;
  char* sw = lds + lrow * LROW + lcol * 2;
  const char* fa = lds + (wm * 64 + r) * LROW + h * 16;
  const char* fb = lds + 128 * LROW + (wn * 32 * NB + r) * LROW + h * 16;
#define G_LOAD(RA, RB, kt_) do { const int k0_ = ((kt_) < nk ? (kt_) : nk - 1) << 6; g_load<4>(RA, ga, lda, k0_); g_load<2 * NB>(RB, gb, ldb, k0_); } while (0)
#define G_STORE(RA, RB, boff_) do { g_store<4>(RA, sw + (boff_)); g_store<2 * NB>(RB, sw + (boff_) + 128 * LROW); } while (0)
  G_LOAD(ra0, rb0, 0);
  G_LOAD(ra1, rb1, 1);
  G_STORE(ra0, rb0, 0);
  __syncthreads();
  for (int kt = 0; kt < nk; kt += 2) {
    G_LOAD(ra0, rb0, kt + 2);
    g_compute<NB>(acc, fa, fb);
    G_STORE(ra1, rb1, GEMM_BUF);
    __syncthreads();
    G_LOAD(ra1, rb1, kt + 3);
    g_compute<NB>(acc, fa + GEMM_BUF, fb + GEMM_BUF);
    G_STORE(ra0, rb0, 0);
    __syncthreads();
  }
#undef G_LOAD
#undef G_STORE
}

template <class Epi>
DI void gemm_tile(const u16* A, int lda, const u16* Bt, int ldb, int K, int m0, int n0, Epi epi, char* lds) {
  const int lane = TIDX & 63, wave = TIDX >> 6;
  const int r = lane & 31, h = lane >> 5, wm = wave >> 1, wn = wave & 1;
  f32x16 acc[2][2];
#pragma unroll
  for (int i = 0; i < 2; ++i)
#pragma unroll
    for (int j = 0; j < 2; ++j)
#pragma unroll
      for (int e = 0; e < 16; ++e) acc[i][j][e] = 0.f;
  gemm_acc<2>(acc, A, lda, Bt, ldb, K, m0, n0, lds);
#pragma unroll
  for (int i = 0; i < 2; ++i)
#pragma unroll
    for (int j = 0; j < 2; ++j)
#pragma unroll
      for (int q = 0; q < 4; ++q) {
        const int m = m0 + wm * 64 + i * 32 + 8 * q + 4 * h;
        const int n = n0 + wn * 64 + j * 32 + r;
        epi(m, n, acc[i][j][4 * q], acc[i][j][4 * q + 1], acc[i][j][4 * q + 2], acc[i][j][4 * q + 3]);
      }
}

DI void dft_tile(const u16* Dm, const u16* PeQo, const u16* PH, int phstride, int H, int m0, int n0, u16* AB, int rowbase, int colsPerBatch, float norm, char* lds) {
  const int lane = TIDX & 63, wave = TIDX >> 6;
  const int r = lane & 31, h = lane >> 5, wm = wave >> 1, wn = wave & 1;
  f32x16 accA[2][1], accB[2][1];
#pragma unroll
  for (int i = 0; i < 2; ++i)
#pragma unroll
    for (int e = 0; e < 16; ++e) { accA[i][0][e] = 0.f; accB[i][0][e] = 0.f; }
  gemm_acc<1>(accA, Dm, 2 * H, PeQo, 2 * H, H, m0, n0, lds);
  gemm_acc<1>(accB, Dm + H, 2 * H, PeQo + H, 2 * H, H, m0, n0, lds);
  const int N = 2 * H;
  const int col = n0 + wn * 32 + r;
  const int b = col / colsPerBatch, c = col - b * colsPerBatch;
  const float ph = bf2f(PH[(size_t)col * phstride]);
  u16* base = AB + ((size_t)rowbase + (size_t)b * N) * 1024 + 512 + c;
#pragma unroll
  for (int i = 0; i < 2; ++i)
#pragma unroll
    for (int q = 0; q < 4; ++q)
#pragma unroll
      for (int e = 0; e < 4; ++e) {
        const int k = m0 + wm * 64 + i * 32 + 8 * q + 4 * h + e;
        const float a = accA[i][0][4 * q + e] + ((k & 1) ? -ph : ph);
        const float bb = accB[i][0][4 * q + e];
        base[(size_t)k * 1024] = f2bf((a - bb) * norm);
        if (k > 0) base[(size_t)(N - k) * 1024] = f2bf((a + bb) * norm);
      }
}

struct EpiBf16 {
  u16* C; int ldc;
  DI void operator()(int m, int n, float v0, float v1, float v2, float v3) const {
    u16* p = C + (size_t)m * ldc + n;
    p[0] = f2bf(v0); p[ldc] = f2bf(v1); p[2 * ldc] = f2bf(v2); p[3 * ldc] = f2bf(v3);
  }
};
struct EpiU {
  u16* UA; u16* PQt;
  DI void operator()(int m, int n, float v0, float v1, float v2, float v3) const {
    if (n < 512) {
      u16* p = UA + (size_t)m * 512 + n;
      p[0] = f2bf(v0); p[512] = f2bf(v1); p[1024] = f2bf(v2); p[1536] = f2bf(v3);
    } else {
      const int np = n - 512, g = np >> 8, pq = (np >> 7) & 1, mm = np & 127;
      size_t off;
      if (m < 4096) { const int b = m >> 8, nl = m & 255; off = ((size_t)(b * 512 + g * 128 + mm)) * 512 + pq * 256 + nl; }
      else { const int ms = m - 4096, b = ms >> 12, nl = ms & 4095; off = (size_t)16 * 512 * 512 + ((size_t)(b * 512 + g * 128 + mm)) * 8192 + pq * 4096 + nl; }
      uint2 w; w.x = pack2(v0, v1); w.y = pack2(v2, v3);
      *(uint2*)(PQt + off) = w;
    }
  }
};
struct EpiDft {
  u16* AB; int rowbase; float norm; int sample;
  DI void operator()(int m, int n, float v0, float v1, float v2, float v3) const {
    size_t row; int c;
    if (sample) { row = (size_t)4096 + (size_t)(n >> 9) * 4096 + m; c = n & 511; }
    else { row = (size_t)rowbase + m; c = n; }
    u16* p = AB + row * 1024 + 512 + c;
    p[0] = f2bf(v0 * norm); p[1024] = f2bf(v1 * norm); p[2048] = f2bf(v2 * norm); p[3072] = f2bf(v3 * norm);
  }
};
struct EpiRes {
  const float* xin_p; const float* xin_s;
  float* X; const float* gate;
  DI void operator()(int m, int n, float v0, float v1, float v2, float v3) const {
    const float* xi = (m < 4096) ? xin_p + (size_t)m * 1024 + n : xin_s + (size_t)(m - 4096) * 1024 + n;
    const float g = gate[cond_of(m) * 6144 + n];
    float* xo = X + (size_t)m * 1024 + n;
    xo[0] = xi[0] + g * v0; xo[1024] = xi[1024] + g * v1; xo[2048] = xi[2048] + g * v2; xo[3072] = xi[3072] + g * v3;
  }
};
struct EpiRelu2 {
  u16* C;
  DI void operator()(int m, int n, float v0, float v1, float v2, float v3) const {
    v0 = fmaxf(v0, 0.f); v1 = fmaxf(v1, 0.f); v2 = fmaxf(v2, 0.f); v3 = fmaxf(v3, 0.f);
    u16* p = C + (size_t)m * 4096 + n;
    p[0] = f2bf(v0 * v0); p[4096] = f2bf(v1 * v1); p[8192] = f2bf(v2 * v2); p[12288] = f2bf(v3 * v3);
  }
};
struct EpiQkv {
  u16* QKV; u16* CVtP; u16* CVtS; u16* DVtP; u16* DVtS; float* ncv; float* ndv;
  DI void operator()(int m, int n, float v0, float v1, float v2, float v3) const {
    const bool is_cv = (n >= 1024 && n < 1536), is_dv = (n >= 2176);
    if (!is_cv && !is_dv) {
      u16* p = QKV + (size_t)m * 2304 + n;
      p[0] = f2bf(v0); p[2304] = f2bf(v1); p[4608] = f2bf(v2); p[6912] = f2bf(v3);
      return;
    }
    uint2 w; w.x = pack2(v0, v1); w.y = pack2(v2, v3);
    if (is_cv) {
      const int c = n - 1024;
      if (m < 4096) {
        const int b = m >> 8, nl = m & 255;
        *(uint2*)(CVtP + ((size_t)(b * 512 + c)) * 256 + nl) = w;
        float* o = ncv + (size_t)m * 512 + c; o[0] = v0; o[512] = v1; o[1024] = v2; o[1536] = v3;
      } else {
        const int ms = m - 4096, b = ms >> 12, nl = ms & 4095;
        *(uint2*)(CVtS + ((size_t)(b * 512 + c)) * 4608 + 512 + nl) = w;
      }
    } else {
      const int c = n - 2176;
      if (m < 4096) {
        const int b = m >> 8, nl = m & 255;
        *(uint2*)(DVtP + ((size_t)(b * 128 + c)) * 256 + nl) = w;
        float* o = ndv + (size_t)m * 128 + c; o[0] = v0; o[128] = v1; o[256] = v2; o[384] = v3;
      } else {
        const int ms = m - 4096, b = ms >> 12, nl = ms & 4095;
        *(uint2*)(DVtS + ((size_t)(b * 128 + c)) * 4608 + 512 + nl) = w;
      }
    }
  }
};

DI void ada_item(const Params& p, int id, char* lds) {
  const int tid = TIDX;
  float* ssil = (float*)lds;
  float* red = (float*)(lds + 12288);
  const int l = id / 192, cb = id % 192;
  for (int i = tid; i < 3072; i += 256) {
    const int j = i >> 10, k = i & 1023;
    const float v = (j == 0) ? p.in[7][k] : p.in[2][(j - 1) * 1024 + k];
    ssil[i] = v / (1.f + __expf(-v));
  }
  __syncthreads();
  const int cq = tid & 7, kg = tid >> 3;
  const float* w = p.in[10] + (size_t)l * 1024 * 6144 + cb * 32 + cq * 4;
  float4 a0 = {0, 0, 0, 0}, a1 = {0, 0, 0, 0}, a2 = {0, 0, 0, 0};
#pragma unroll 8
  for (int kk = 0; kk < 32; ++kk) {
    const int k = kg * 32 + kk;
    const float4 wv = *(const float4*)(w + (size_t)k * 6144);
    const float s0 = ssil[k], s1 = ssil[1024 + k], s2 = ssil[2048 + k];
    a0.x += s0 * wv.x; a0.y += s0 * wv.y; a0.z += s0 * wv.z; a0.w += s0 * wv.w;
    a1.x += s1 * wv.x; a1.y += s1 * wv.y; a1.z += s1 * wv.z; a1.w += s1 * wv.w;
    a2.x += s2 * wv.x; a2.y += s2 * wv.y; a2.z += s2 * wv.z; a2.w += s2 * wv.w;
  }
  float* rp = red + kg * 96 + cq * 4;
  rp[0] = a0.x; rp[1] = a0.y; rp[2] = a0.z; rp[3] = a0.w;
  rp[32] = a1.x; rp[33] = a1.y; rp[34] = a1.z; rp[35] = a1.w;
  rp[64] = a2.x; rp[65] = a2.y; rp[66] = a2.z; rp[67] = a2.w;
  __syncthreads();
  if (tid < 96) {
    const int j = tid >> 5, c = tid & 31;
    float sum = 0.f;
#pragma unroll
    for (int g = 0; g < 32; ++g) sum += red[g * 96 + j * 32 + c];
    const int col = cb * 32 + c;
    ((float*)(p.ws + OFF_MODS))[(size_t)(l * 3 + j) * 6144 + col] = sum + p.in[11][l * 6144 + col];
  }
  __syncthreads();
}

DI void transpose_tile(const float* src, int ld_src, u16* dst, int ld_dst, int r0, int c0, char* lds) {
  float* tile = (float*)lds;
  const int tid = TIDX;
  const int j4 = (tid & 15) * 4, i0 = tid >> 4;
#pragma unroll
  for (int it = 0; it < 4; ++it) {
    const int i = i0 + 16 * it;
    const float4 v = *(const float4*)(src + (size_t)(r0 + i) * ld_src + c0 + j4);
    float* tp = tile + i * 65 + j4;
    tp[0] = v.x; tp[1] = v.y; tp[2] = v.z; tp[3] = v.w;
  }
  __syncthreads();
  const int kc = (tid & 7) * 8, jr = tid >> 3;
#pragma unroll
  for (int it = 0; it < 2; ++it) {
    const int j = jr + 32 * it;
    const float* tp = tile + kc * 65 + j;
    uint4 o;
    o.x = pack2(tp[0], tp[65]); o.y = pack2(tp[130], tp[195]); o.z = pack2(tp[260], tp[325]); o.w = pack2(tp[390], tp[455]);
    *(uint4*)(dst + (size_t)(c0 + j) * ld_dst + r0 + kc) = o;
  }
  __syncthreads();
}

DI void prep_transposes(const Params& p, int vb, int G, char* lds, int layer) {
  const int ntile = layer ? 2880 : 2432;
  for (int t = vb; t < ntile; t += G) {
    const float* src; u16* dst; int lds_, ldd, r0, c0;
    int q = t;
    if (layer == 0) {
      if (q < 128) { src = p.in[12]; lds_ = 1024; dst = (u16*)(p.ws + OFF_WIN_E); ldd = 1024; r0 = (q >> 3) * 64; c0 = (q & 7) * 64; }
      else if ((q -= 128) < 256) { src = p.in[16]; lds_ = 1024; dst = (u16*)(p.ws + OFF_WOUT_ET); ldd = 1024; r0 = (q >> 4) * 64; c0 = (q & 15) * 64; }
      else if ((q -= 256) < 1024) { src = p.in[29]; lds_ = 4096; dst = (u16*)(p.ws + OFF_W1); ldd = 1024; r0 = (q >> 6) * 64; c0 = (q & 63) * 64; }
      else { q -= 1024; src = p.in[30]; lds_ = 1024; dst = (u16*)(p.ws + OFF_W2); ldd = 4096; r0 = (q >> 4) * 64; c0 = (q & 15) * 64; }
    } else {
      if (q < 576) { src = p.in[17]; lds_ = 2304; dst = (u16*)(p.ws + OFF_WIN_O); ldd = 1024; r0 = (q / 36) * 64; c0 = (q % 36) * 64; }
      else if ((q -= 576) < 256) { src = p.in[28]; lds_ = 1024; dst = (u16*)(p.ws + OFF_WOUT_O); ldd = 1024; r0 = (q >> 4) * 64; c0 = (q & 15) * 64; }
      else if ((q -= 256) < 1024) { src = p.in[29] + (size_t)1024 * 4096; lds_ = 4096; dst = (u16*)(p.ws + OFF_W1) + (size_t)4096 * 1024; ldd = 1024; r0 = (q >> 6) * 64; c0 = (q & 63) * 64; }
      else { q -= 1024; src = p.in[30] + (size_t)4096 * 1024; lds_ = 1024; dst = (u16*)(p.ws + OFF_W2) + (size_t)1024 * 4096; ldd = 4096; r0 = (q >> 4) * 64; c0 = (q & 15) * 64; }
    }
    transpose_tile(src, lds_, dst, ldd, r0, c0, lds);
  }
}

DI void prep_elementwise(const Params& p, int vb, int G) {
  const size_t gt = (size_t)vb * 256 + TIDX, gs = (size_t)G * 256;
  {
    u16* d = (u16*)(p.ws + OFF_WINB);
    for (size_t i = gt; i < 1024 * 256; i += gs) {
      const int k = (int)(i >> 8), c = (int)(i & 255) * 2;
      const float* s = p.in[12] + (size_t)k * 1024 + 512 + c;
      *(unsigned*)(d + (size_t)k * 512 + c) = pack2(s[0], s[1]);
    }
  }
  {
    u16* d = (u16*)(p.ws + OFF_CBD);
    for (size_t i = gt; i < 1024 * 512; i += gs) {
      const int np = (int)(i >> 9), cp = (int)(i & 511);
      const int g = np >> 8, pq = (np >> 7) & 1, m = np & 127;
      float v = 0.f;
      if ((cp >> 7) == g) {
        const int c = cp & 127; const int rr = (m * c) & 127;
        const float x = (float)rr * (2.0f / 128.0f);
        v = pq ? sinpif(x) : cospif(x);
      }
      d[i] = f2bf(v);
    }
  }
  {
    u16* d = (u16*)(p.ws + OFF_BD);
    for (size_t i = gt; i < 1024 * 1024; i += gs) {
      const int kp = (int)(i >> 10), c = (int)(i & 1023);
      float v = 0.f;
      if (kp < 512) { const int g = kp >> 7; if (c < 512 && (c >> 7) == g) v = p.in[13][(size_t)g * 16384 + (kp & 127) * 128 + (c & 127)] * p.in[14][c]; }
      else { const int g = (kp - 512) >> 7; if (c >= 512 && ((c - 512) >> 7) == g) v = p.in[15][(size_t)g * 16384 + ((kp - 512) & 127) * 128 + ((c - 512) & 127)]; }
      d[i] = f2bf(v);
    }
  }
#pragma unroll 1
  for (int which = 0; which < 2; ++which) {
    const int H = which ? 2048 : 128, N = 2 * H, lg = which ? 9 : 5;
    u16* d = (u16*)(p.ws + (which ? OFF_D4096 : OFF_D256));
    const float invN = 1.0f / (float)N;
    for (size_t i = gt; i < ((size_t)H << lg); i += gs) {
      const int k = (int)(i >> lg), np = (int)(i & ((1 << lg) - 1)) * 8;
      const bool is_sin = np >= H;
      const int n = np & (H - 1);
      unsigned w[4];
#pragma unroll
      for (int e = 0; e < 4; ++e) {
        const float x0 = (float)((k * (n + 2 * e)) & (N - 1)) * invN, x1 = (float)((k * (n + 2 * e + 1)) & (N - 1)) * invN;
        const float v0 = is_sin ? __builtin_amdgcn_sinf(x0) : __builtin_amdgcn_cosf(x0);
        const float v1 = is_sin ? __builtin_amdgcn_sinf(x1) : __builtin_amdgcn_cosf(x1);
        w[e] = pack2(v0, v1);
      }
      *(uint4*)(d + (size_t)k * N + np) = make_uint4(w[0], w[1], w[2], w[3]);
    }
  }
}

DI void sym_phase(const Params& p, int vb, int G) {
  const int lane = TIDX & 63, wave = TIDX >> 6;
  const u16* PQT = (const u16*)(p.ws + OFF_PQT);
  u16* PEQO = (u16*)(p.ws + OFF_PEQO);
  u16* AB = (u16*)(p.ws + OFF_AB);
  for (int it = vb * 4 + wave; it < 1024 + 2048; it += G * 4) {
    const bool samp = it < 1024;
    const int H = samp ? 2048 : 128, N = 2 * H;
    int col, n0base, nstep;
    if (samp) { col = it; n0base = lane * 8; nstep = 512; }
    else { col = (it - 1024) * 4 + (lane >> 4); n0base = (lane & 15) * 8; nstep = 128; }
    const u16* Pp = samp ? PQT + (size_t)16 * 512 * 512 + (size_t)col * 8192 : PQT + (size_t)col * 512;
    const u16* Qp = Pp + N;
    u16* Pe = samp ? PEQO + (size_t)16 * 512 * 256 + (size_t)col * 4096 : PEQO + (size_t)col * 256;
    u16* Qo = Pe + H;
    float alt = 0.f;
    for (int n0 = n0base; n0 < H; n0 += nstep) {
      const uint4 pw = *(const uint4*)(Pp + n0), qw = *(const uint4*)(Qp + n0);
      const unsigned pa[4] = {pw.x, pw.y, pw.z, pw.w}, qa[4] = {qw.x, qw.y, qw.z, qw.w};
      float pe[8], qo[8];
#pragma unroll
      for (int e = 0; e < 8; ++e) {
        const float pv = (e & 1) ? __uint_as_float(pa[e >> 1] & 0xffff0000u) : __uint_as_float(pa[e >> 1] << 16);
        const float qv = (e & 1) ? __uint_as_float(qa[e >> 1] & 0xffff0000u) : __uint_as_float(qa[e >> 1] << 16);
        const int n = n0 + e;
        float pm = 0.f, qm = 0.f;
        if (n > 0) { pm = bf2f(Pp[N - n]); qm = bf2f(Qp[N - n]); }
        pe[e] = pv + pm;
        qo[e] = (n > 0) ? qv - qm : 0.f;
        alt += (e & 1) ? -pe[e] : pe[e];
      }
      *(uint4*)(Pe + n0) = make_uint4(pack2(pe[0], pe[1]), pack2(pe[2], pe[3]), pack2(pe[4], pe[5]), pack2(pe[6], pe[7]));
      *(uint4*)(Qo + n0) = make_uint4(pack2(qo[0], qo[1]), pack2(qo[2], qo[3]), pack2(qo[4], qo[5]), pack2(qo[6], qo[7]));
    }
    alt += __shfl_xor(alt, 1); alt += __shfl_xor(alt, 2); alt += __shfl_xor(alt, 4); alt += __shfl_xor(alt, 8);
    if (samp) { alt += __shfl_xor(alt, 16); alt += __shfl_xor(alt, 32); }
    if ((samp && lane == 0) || (!samp && (lane & 15) == 0)) {
      const float fh = alt + bf2f(Pp[H]);
      size_t row; int c; float norm;
      if (samp) { row = (size_t)4096 + (size_t)(col >> 9) * 4096 + 2048; c = col & 511; norm = 0.0013810679320049757f; }
      else { row = (size_t)(col >> 9) * 256 + 128; c = col & 511; norm = 0.005524271728019903f; }
      AB[row * 1024 + 512 + c] = f2bf(fh * norm);
    }
  }
}

DI void normmod_phase(const Params& p, int vb, int G, const float* xp, const float* xs, const float* gain, int l, int which) {
  const int lane = TIDX & 63, wave = TIDX >> 6;
  u16* H = (u16*)(p.ws + OFF_H);
  const float* mods = (const float*)(p.ws + OFF_MODS) + (size_t)l * 3 * 6144;
  for (int row = vb * 4 + wave; row < T; row += G * 4) {
    const float* x = (row < 4096) ? xp + (size_t)row * 1024 : xs + (size_t)(row - 4096) * 1024;
    float4 v[4];
    float ss = 0.f;
#pragma unroll
    for (int i = 0; i < 4; ++i) {
      v[i] = *(const float4*)(x + i * 256 + lane * 4);
      ss += v[i].x * v[i].x + v[i].y * v[i].y + v[i].z * v[i].z + v[i].w * v[i].w;
    }
    ss = wave_sum(ss);
    const float rinv = rsqrtf(ss * (1.0f / 1024.0f) + EPS);
    const float* md = mods + cond_of(row) * 6144 + which * 3072;
#pragma unroll
    for (int i = 0; i < 4; ++i) {
      const int c = i * 256 + lane * 4;
      const float4 g = *(const float4*)(gain + c);
      const float4 sh = *(const float4*)(md + c);
      const float4 sc = *(const float4*)(md + 1024 + c);
      const float o0 = v[i].x * rinv * g.x * (1.f + sc.x) + sh.x;
      const float o1 = v[i].y * rinv * g.y * (1.f + sc.y) + sh.y;
      const float o2 = v[i].z * rinv * g.z * (1.f + sc.z) + sh.z;
      const float o3 = v[i].w * rinv * g.w * (1.f + sc.w) + sh.w;
      uint2 w; w.x = pack2(o0, o1); w.y = pack2(o2, o3);
      *(uint2*)(H + (size_t)row * 1024 + c) = w;
    }
  }
}

template <class Epi>
DI void gemm_phase(const u16* A, int lda, const u16* Bt, int ldb, int K, int M, int N, Epi epi, int vb, int G, char* lds) {
  const int nN = N >> 7, nt = (M >> 7) * nN, grp = 8 * nN;
  for (int t = vb; t < nt; t += G) {
    const int gi = t / grp, rem = t - gi * grp;
    gemm_tile(A, lda, Bt, ldb, K, (gi * 8 + (rem & 7)) << 7, (rem >> 3) << 7, epi, lds);
  }
}

DI void pool_phase(const Params& p, int vb, int G) {
  const u16* UA = (const u16*)(p.ws + OFF_UA);
  u16* AB = (u16*)(p.ws + OFF_AB);
  const size_t gt = (size_t)vb * 256 + TIDX, gs = (size_t)G * 256;
  for (size_t i = gt; i < (size_t)T * 64; i += gs) {
    const int t = (int)(i >> 6), c8 = (int)(i & 63) * 8;
    const int g = c8 >> 7, hw = 1 << g;
    int nl, N, base;
    if (t < 4096) { nl = t & 255; N = 256; base = t - nl; } else { nl = (t - 4096) & 4095; N = 4096; base = t - nl; }
    const int lo = max(nl - hw, 0), hi = min(nl + hw, N);
    float s[8] = {0, 0, 0, 0, 0, 0, 0, 0};
    for (int j = lo; j < hi; ++j) {
      const uint4 w = *(const uint4*)(UA + (size_t)(base + j) * 512 + c8);
      s[0] += __uint_as_float(w.x << 16); s[1] += __uint_as_float(w.x & 0xffff0000u);
      s[2] += __uint_as_float(w.y << 16); s[3] += __uint_as_float(w.y & 0xffff0000u);
      s[4] += __uint_as_float(w.z << 16); s[5] += __uint_as_float(w.z & 0xffff0000u);
      s[6] += __uint_as_float(w.w << 16); s[7] += __uint_as_float(w.w & 0xffff0000u);
    }
    const float inv = 1.0f / (float)(hi - lo);
    const uint4 w = *(const uint4*)(UA + (size_t)t * 512 + c8);
    uint4 o;
    o.x = pack2(s[0] * inv - __uint_as_float(w.x << 16), s[1] * inv - __uint_as_float(w.x & 0xffff0000u));
    o.y = pack2(s[2] * inv - __uint_as_float(w.y << 16), s[3] * inv - __uint_as_float(w.y & 0xffff0000u));
    o.z = pack2(s[4] * inv - __uint_as_float(w.z << 16), s[5] * inv - __uint_as_float(w.z & 0xffff0000u));
    o.w = pack2(s[6] * inv - __uint_as_float(w.w << 16), s[7] * inv - __uint_as_float(w.w & 0xffff0000u));
    *(uint4*)(AB + (size_t)t * 1024 + c8) = o;
  }
}

DI void qkvpost_phase(const Params& p, int vb, int G) {
  const int lane = TIDX & 63, wave = TIDX >> 6;
  const int q = lane & 15, sub = lane >> 4;
  const u16* QKV = (const u16*)(p.ws + OFF_QKV);
  u16* CQ = (u16*)(p.ws + OFF_CQ); u16* DQ = (u16*)(p.ws + OFF_DQ);
  u16* CKP = (u16*)(p.ws + OFF_CKP); u16* CKS = (u16*)(p.ws + OFF_CKS);
  u16* DKP = (u16*)(p.ws + OFF_DKP); u16* DKS = (u16*)(p.ws + OFF_DKS);
  float* nck = p.out + OUT_NCK; float* ndk = p.out + OUT_NDK;
  const int d0 = q * 4;
  float fr[4];
#pragma unroll
  for (int e = 0; e < 4; ++e) fr[e] = exp2f(-(float)((d0 + e) & 15) * (13.287712379549449f / 16.0f));
  const bool firsthalf = ((d0 >> 4) & 1) == 0;
  for (int t = vb * 4 + wave; t < T; t += G * 4) {
    const bool samp = t >= 4096;
    int b, nl;
    if (!samp) { b = t >> 8; nl = t & 255; } else { b = (t - 4096) >> 12; nl = (t - 4096) & 4095; }
    float cs[4], sn[4];
    if (samp) {
      const float pos = (d0 < 32) ? (float)(nl >> 6) : (float)(nl & 63);
#pragma unroll
      for (int e = 0; e < 4; ++e) { const float a = pos * fr[e]; cs[e] = cosf(a); sn[e] = sinf(a); }
    } else {
#pragma unroll
      for (int e = 0; e < 4; ++e) { cs[e] = 1.f; sn[e] = 0.f; }
    }
    for (int rd = 0; rd < 7; ++rd) {
      const int slot = rd * 4 + sub;
      const bool act = slot < 26;
      const int vi = act ? (slot < 16 ? slot : slot + 8) : 0;
      const uint2 raw = *(const uint2*)(QKV + (size_t)t * 2304 + vi * 64 + d0);
      float x[4] = {__uint_as_float(raw.x << 16), __uint_as_float(raw.x & 0xffff0000u), __uint_as_float(raw.y << 16), __uint_as_float(raw.y & 0xffff0000u)};
      float ss = x[0] * x[0] + x[1] * x[1] + x[2] * x[2] + x[3] * x[3];
      ss += __shfl_xor(ss, 1); ss += __shfl_xor(ss, 2); ss += __shfl_xor(ss, 4); ss += __shfl_xor(ss, 8);
      const float rinv = rsqrtf(ss * (1.0f / 64.0f) + EPS);
      const float* gp = (vi < 8) ? p.in[18] : (vi < 16) ? p.in[19] : (vi < 32) ? p.in[25] : p.in[26];
      const float4 g = *(const float4*)(gp + d0);
      float y[4] = {x[0] * rinv * g.x, x[1] * rinv * g.y, x[2] * rinv * g.z, x[3] * rinv * g.w};
      float o[4];
#pragma unroll
      for (int e = 0; e < 4; ++e) {
        const float part = __shfl_xor(y[e], 4);
        o[e] = firsthalf ? (y[e] * cs[e] - part * sn[e]) : (y[e] * cs[e] + part * sn[e]);
      }
      if (!act) continue;
      const bool isq = (vi < 8) || (vi >= 24 && vi < 32);
      if (isq) {
        const int hd = (vi < 8) ? vi : vi - 24;
        u16* base = (vi < 8) ? CQ : DQ;
        size_t off = samp ? (size_t)16 * 8 * 256 * 64 + ((size_t)(b * 8 + hd) * 4096 + nl) * 64 : ((size_t)(b * 8 + hd) * 256 + nl) * 64;
        uint2 w; w.x = pack2(o[0] * QSCALE, o[1] * QSCALE); w.y = pack2(o[2] * QSCALE, o[3] * QSCALE);
        *(uint2*)(base + off + d0) = w;
      } else if (vi < 16) {
        const int hm = vi - 8;
        uint2 w; w.x = pack2(o[0], o[1]); w.y = pack2(o[2], o[3]);
        if (samp) *(uint2*)(CKS + ((size_t)(b * 8 + hm) * 4608 + 512 + nl) * 64 + d0) = w;
        else {
          *(uint2*)(CKP + ((size_t)(b * 8 + hm) * 256 + nl) * 64 + d0) = w;
          *(float4*)(nck + (size_t)t * 512 + hm * 64 + d0) = make_float4(o[0], o[1], o[2], o[3]);
        }
      } else {
        const int j = vi - 32;
        uint2 w; w.x = pack2(o[0], o[1]); w.y = pack2(o[2], o[3]);
        if (samp) *(uint2*)(DKS + ((size_t)(b * 2 + j) * 4608 + 512 + nl) * 64 + d0) = w;
        else {
          *(uint2*)(DKP + ((size_t)(b * 2 + j) * 256 + nl) * 64 + d0) = w;
          *(float4*)(ndk + (size_t)t * 128 + j * 64 + d0) = make_float4(o[0], o[1], o[2], o[3]);
        }
      }
    }
  }
  const size_t gt = (size_t)vb * 256 + TIDX, gs = (size_t)G * 256;
  {
    u16* CVTS = (u16*)(p.ws + OFF_CVTS); u16* DVTS = (u16*)(p.ws + OFF_DVTS);
    for (size_t i = gt; i < (size_t)2 * 512 * 512; i += gs) {
      const int b = (int)(i >> 18), key = (int)(i >> 9) & 511, c = (int)(i & 511);
      CKS[((size_t)(b * 8 + (c >> 6)) * 4608 + key) * 64 + (c & 63)] = f2bf(p.in[3][i]);
    }
    for (size_t i = gt; i < (size_t)2 * 512 * 512; i += gs) {
      const int b = (int)(i >> 18), c = (int)(i >> 9) & 511, key = (int)(i & 511);
      CVTS[((size_t)(b * 512 + c)) * 4608 + key] = f2bf(p.in[4][((size_t)b * 512 + key) * 512 + c]);
    }
    for (size_t i = gt; i < (size_t)2 * 512 * 128; i += gs) {
      const int b = (int)(i >> 16), key = (int)(i >> 7) & 511, c = (int)(i & 127);
      DKS[((size_t)(b * 2 + (c >> 6)) * 4608 + key) * 64 + (c & 63)] = f2bf(p.in[5][i]);
    }
    for (size_t i = gt; i < (size_t)2 * 128 * 512; i += gs) {
      const int b = (int)(i >> 16), c = (int)(i >> 9) & 127, key = (int)(i & 511);
      DVTS[((size_t)(b * 128 + c)) * 4608 + key] = f2bf(p.in[6][((size_t)b * 512 + key) * 128 + c]);
    }
  }
}

template <int DV>
DI void attn_item(const u16* Q, const u16* Kb, const u16* Vt, int ldv, int nt0, int key1, int nt1,
                  bool masked, int qpos0, bool has_sink, float sink2, u16* out, int ldo, char* lds) {
  constexpr int NDB = DV / 32;
  constexpr int KVBUF = (64 + DV) * LROW;
  const int tid = TIDX, lane = tid & 63, wave = tid >> 6;
  const int r = lane & 31, h = lane >> 5;
  const int nt = nt0 + nt1;
  bf16x8 qf[4];
#pragma unroll
  for (int ks = 0; ks < 4; ++ks) qf[ks] = *(const bf16x8*)(Q + (size_t)(wave * 32 + r) * 64 + ks * 16 + h * 8);
  f32x16 O[NDB];
#pragma unroll
  for (int i = 0; i < NDB; ++i)
#pragma unroll
    for (int e = 0; e < 16; ++e) O[i][e] = 0.f;
  float mrun = has_sink ? sink2 : -1e30f;
  float lrun = has_sink ? (h == 0 ? 1.f : 0.f) : 0.f;
  const int lrow = tid >> 3, lpart = (tid & 7) * 8;
  uint4 rk0, rk1, rv0, rv1, rv2, rv3;
  rv2 = rv3 = make_uint4(0, 0, 0, 0);
  const u16* gk = Kb + (size_t)lrow * 64 + lpart;
  const u16* gv = Vt + (size_t)lrow * ldv + lpart;
#define ATT_GLOAD(key0_)                                                         \
  do {                                                                           \
    rk0 = *(const uint4*)(gk + (size_t)(key0_) * 64);                            \
    rk1 = *(const uint4*)(gk + (size_t)((key0_) + 32) * 64);                     \
    rv0 = *(const uint4*)(gv + (key0_));                                         \
    rv1 = *(const uint4*)(gv + (size_t)32 * ldv + (key0_));                      \
    if constexpr (DV == 128) {                                                   \
      rv2 = *(const uint4*)(gv + (size_t)64 * ldv + (key0_));                    \
      rv3 = *(const uint4*)(gv + (size_t)96 * ldv + (key0_));                    \
    }                                                                            \
  } while (0)
#define ATT_SSTORE(boff_)                                                        \
  do {                                                                           \
    *(uint4*)(sw + (boff_)) = rk0;                                               \
    *(uint4*)(sw + (boff_) + 32 * LROW) = rk1;                                   \
    *(uint4*)(sw + (boff_) + 64 * LROW) = rv0;                                   \
    *(uint4*)(sw + (boff_) + 96 * LROW) = rv1;                                   \
    if constexpr (DV == 128) {                                                   \
      *(uint4*)(sw + (boff_) + 128 * LROW) = rv2;                                \
      *(uint4*)(sw + (boff_) + 160 * LROW) = rv3;                                \
    }                                                                            \
  } while (0)
  char* sw = lds + lrow * LROW + lpart * 2;
  {
    const int key0 = (nt0 > 0) ? 0 : key1;
    ATT_GLOAD(key0);
  }
  ATT_SSTORE(0);
  __syncthreads();
  const int pr = (r & 0x13) | ((r & 4) << 1) | ((r & 8) >> 1);
  const char* fk = lds + pr * LROW + h * 16;
  const char* fv = lds + 64 * LROW + r * LROW + h * 16;
  const int qpos = qpos0 + wave * 32 + r;
  for (int t = 0; t < nt; ++t) {
    const int cur = (t & 1) * KVBUF;
    const int key0 = (t < nt0) ? t * 64 : key1 + (t - nt0) * 64;
    {
      const int tn = (t + 1 < nt) ? t + 1 : t;
      const int kn = (tn < nt0) ? tn * 64 : key1 + (tn - nt0) * 64;
      ATT_GLOAD(kn);
    }
    f32x16 S[2];
#pragma unroll
    for (int kb = 0; kb < 2; ++kb) {
#pragma unroll
      for (int e = 0; e < 16; ++e) S[kb][e] = 0.f;
#pragma unroll
      for (int ks = 0; ks < 4; ++ks) {
        const bf16x8 kf = *(const bf16x8*)(fk + cur + kb * 32 * LROW + ks * 32);
        S[kb] = MFMA(kf, qf[ks], S[kb]);
      }
    }
    if (masked && t >= nt0) {
#pragma unroll
      for (int kb = 0; kb < 2; ++kb)
#pragma unroll
        for (int e = 0; e < 16; ++e) {
          const int jpos = key0 - 512 + kb * 32 + 16 * (e >> 3) + 8 * h + (e & 7);
          const int dlt = qpos - jpos;
          if (dlt > 128 || dlt < -128) S[kb][e] = -1e30f;
        }
    }
    float mloc = S[0][0];
#pragma unroll
    for (int kb = 0; kb < 2; ++kb)
#pragma unroll
      for (int e = 0; e < 16; ++e) mloc = fmaxf(mloc, S[kb][e]);
    mloc = fmaxf(mloc, __shfl_xor(mloc, 32));
    const float mnew = fmaxf(mrun, mloc);
    const float alpha = __builtin_amdgcn_exp2f(mrun - mnew);
    mrun = mnew;
    float ps = 0.f;
#pragma unroll
    for (int kb = 0; kb < 2; ++kb)
#pragma unroll
      for (int e = 0; e < 16; ++e) { const float pv = __builtin_amdgcn_exp2f(S[kb][e] - mnew); S[kb][e] = pv; ps += pv; }
    lrun = lrun * alpha + ps;
#pragma unroll
    for (int i = 0; i < NDB; ++i)
#pragma unroll
      for (int e = 0; e < 16; ++e) O[i][e] *= alpha;
    bf16x8 pf[4];
#pragma unroll
    for (int jj = 0; jj < 4; ++jj) {
      const int kb = jj >> 1, o8 = (jj & 1) * 8;
      uint4 w;
      w.x = pack2(S[kb][o8 + 0], S[kb][o8 + 1]); w.y = pack2(S[kb][o8 + 2], S[kb][o8 + 3]);
      w.z = pack2(S[kb][o8 + 4], S[kb][o8 + 5]); w.w = pack2(S[kb][o8 + 6], S[kb][o8 + 7]);
      pf[jj] = __builtin_bit_cast(bf16x8, w);
    }
    __builtin_amdgcn_sched_barrier(0);
#pragma unroll
    for (int i = 0; i < NDB; ++i) {
#pragma unroll
      for (int jj = 0; jj < 4; ++jj) {
        const bf16x8 vf = *(const bf16x8*)(fv + cur + i * 32 * LROW + jj * 32);
        O[i] = MFMA(vf, pf[jj], O[i]);
      }
      if (i & 1) __builtin_amdgcn_sched_barrier(0);
    }
    ATT_SSTORE(KVBUF - cur);
    __syncthreads();
  }
#undef ATT_GLOAD
#undef ATT_SSTORE
  const float ltot = lrun + __shfl_xor(lrun, 32);
  const float inv = 1.0f / ltot;
  u16* op = out + (size_t)(wave * 32 + r) * ldo;
#pragma unroll
  for (int i = 0; i < NDB; ++i)
#pragma unroll
    for (int qd = 0; qd < 4; ++qd) {
      uint2 w;
      w.x = pack2(O[i][4 * qd] * inv, O[i][4 * qd + 1] * inv);
      w.y = pack2(O[i][4 * qd + 2] * inv, O[i][4 * qd + 3] * inv);
      *(uint2*)(op + i * 32 + 8 * qd + 4 * h) = w;
    }
}

DI void attention_phase(const Params& p, int vb, int G, char* lds) {
  const u16* CQ = (const u16*)(p.ws + OFF_CQ); const u16* DQ = (const u16*)(p.ws + OFF_DQ);
  const u16* CKP = (const u16*)(p.ws + OFF_CKP); const u16* CKS = (const u16*)(p.ws + OFF_CKS);
  const u16* CVTP = (const u16*)(p.ws + OFF_CVTP); const u16* CVTS = (const u16*)(p.ws + OFF_CVTS);
  const u16* DKP = (const u16*)(p.ws + OFF_DKP); const u16* DKS = (const u16*)(p.ws + OFF_DKS);
  const u16* DVTP = (const u16*)(p.ws + OFF_DVTP); const u16* DVTS = (const u16*)(p.ws + OFF_DVTS);
  u16* OM = (u16*)(p.ws + OFF_OM); u16* AC = (u16*)(p.ws + OFF_H);
  constexpr size_t QS = (size_t)16 * 8 * 256 * 64;
  for (int it = vb; it < 1536; it += G) {
    const bool diff = (it < 512) || (it >= 1024 && it < 1280);
    const bool samp = it < 1024;
    int qb, hd, b;
    if (samp) { const int i2 = it & 511; qb = i2 & 31; hd = (i2 >> 5) & 7; b = i2 >> 8; }
    else { const int i2 = (it - 1024) & 255; qb = i2 & 1; hd = (i2 >> 1) & 7; b = i2 >> 4; }
    const int nseq = samp ? 4096 : 256, nkeys = samp ? 4608 : 256;
    const int tok = samp ? 4096 + b * 4096 + qb * 128 : b * 256 + qb * 128;
    const size_t qoff = (samp ? QS : 0) + ((size_t)(b * 8 + hd) * nseq + qb * 128) * 64;
    if (diff) {
      const u16* Kp = (samp ? CKS : CKP) + (size_t)(b * 8 + hd) * nkeys * 64;
      const u16* Vp = (samp ? CVTS : CVTP) + (size_t)(b * 4 + (hd >> 1)) * 128 * nkeys;
      attn_item<128>(CQ + qoff, Kp, Vp, nkeys, nkeys >> 6, 0, 0, false, 0, false, 0.f, OM + (size_t)tok * 1024 + hd * 128, 1024, lds);
    } else {
      const u16* Kp = (samp ? DKS : DKP) + (size_t)(b * 2 + (hd >> 2)) * nkeys * 64;
      const u16* Vp = (samp ? DVTS : DVTP) + (size_t)(b * 2 + (hd >> 2)) * 64 * nkeys;
      int nt0 = 4, key1 = 0, nt1 = 0;
      if (samp) { const int lo = min(max(qb * 128 - 128, 0), 4096 - 384); nt0 = 8; key1 = 512 + lo; nt1 = 6; }
      attn_item<64>(DQ + qoff, Kp, Vp, nkeys, nt0, key1, nt1, samp, qb * 128, true, p.in[27][hd] * LOG2E, AC + (size_t)tok * 1024 + 512 + hd * 64, 1024, lds);
    }
  }
}

DI void combine_phase(const Params& p, int vb, int G) {
  const int lane = TIDX & 63, wave = TIDX >> 6;
  const float a = wave_sum(p.in[20][lane] * p.in[21][lane]);
  const float bsum = wave_sum(p.in[22][lane] * p.in[23][lane]);
  const float lam = expf(a) - expf(bsum) + LAM_INIT;
  const u16* OM = (const u16*)(p.ws + OFF_OM);
  u16* AC = (u16*)(p.ws + OFF_H);
  const int hh = lane >> 4, e0 = (lane & 15) * 8;
  float g[8];
#pragma unroll
  for (int e = 0; e < 8; ++e) g[e] = p.in[24][e0 + e] * (1.0f - LAM_INIT);
  for (int t = vb * 4 + wave; t < T; t += G * 4) {
    const uint4 w0 = *(const uint4*)(OM + (size_t)t * 1024 + (hh * 2) * 128 + e0);
    const uint4 w1 = *(const uint4*)(OM + (size_t)t * 1024 + (hh * 2 + 1) * 128 + e0);
    const unsigned a0[4] = {w0.x, w0.y, w0.z, w0.w}, a1[4] = {w1.x, w1.y, w1.z, w1.w};
    float d[8];
    float ss = 0.f;
#pragma unroll
    for (int e = 0; e < 4; ++e) {
      d[2 * e] = __uint_as_float(a0[e] << 16) - lam * __uint_as_float(a1[e] << 16);
      d[2 * e + 1] = __uint_as_float(a0[e] & 0xffff0000u) - lam * __uint_as_float(a1[e] & 0xffff0000u);
      ss += d[2 * e] * d[2 * e] + d[2 * e + 1] * d[2 * e + 1];
    }
    ss += __shfl_xor(ss, 1); ss += __shfl_xor(ss, 2); ss += __shfl_xor(ss, 4); ss += __shfl_xor(ss, 8);
    const float rinv = rsqrtf(ss * (1.0f / 128.0f) + EPS);
    uint4 o;
    o.x = pack2(d[0] * rinv * g[0], d[1] * rinv * g[1]); o.y = pack2(d[2] * rinv * g[2], d[3] * rinv * g[3]);
    o.z = pack2(d[4] * rinv * g[4], d[5] * rinv * g[5]); o.w = pack2(d[6] * rinv * g[6], d[7] * rinv * g[7]);
    *(uint4*)(AC + (size_t)t * 1024 + hh * 128 + e0) = o;
  }
}


namespace pg8 {
#define PG8_LAS __attribute__((address_space(3)))
typedef unsigned short bf16_t;
typedef short bf16x8 __attribute__((ext_vector_type(8)));
typedef float f32x4 __attribute__((ext_vector_type(4)));
typedef unsigned u32x4 __attribute__((ext_vector_type(4)));
constexpr int BM = 256, BK = 64, HALF = 128, HTB = HALF * BK * 2  , STAGE_BYTES = 8 * HTB, NXCD = 8, WGM = 8;

__host__ __device__ __forceinline__ int lds_byte(int r, int c) { const int st = (r >> 4) * 2 + (c >> 5), rr = r & 15, cc = c & 31, ob = rr * 64 + cc * 2; return st * 1024 + (ob ^ (((ob >> 9) & 1) << 5)); }
__host__ __device__ __forceinline__ void stage_rc(int b, int& R, int& C) { const int st = b / 1024, sb = b % 1024, swz = sb ^ (((sb >> 9) & 1) << 5); R = (st >> 1) * 16 + swz / 64; C = (st & 1) * 32 + (swz % 64) / 2; }
__host__ __device__ __forceinline__ int perm32(int rho) { const int n = rho >> 4, i = rho & 15; return 8 * (i >> 2) + 4 * n + (i & 3); }

struct Unit { int pm, pn; };
struct Gemm { const bf16_t* A; const bf16_t* Bt; int M, N, K; };

struct StaticOrder {
    int nM, nN, nwg, G, c;
    __host__ __device__ void init(int M, int N, int G_, int c_) { nM = M / BM; nN = N / BM; nwg = nM * nN; G = G_; c = c_; }
    __host__ __device__ bool next(int i, Unit& u) const {
        const long L = (long)i * G + c; if (L >= nwg) return false;
        int wgid = (int)L; { const int q = nwg / NXCD, r = nwg % NXCD, xcd = wgid % NXCD, off = wgid / NXCD; wgid = (xcd < r ? xcd * (q + 1) : r * (q + 1) + (xcd - r) * q) + off; }
        const int nig = WGM * nN, gid = wgid / nig, fm = gid * WGM, gsz = (nM - fm) < WGM ? (nM - fm) : WGM;
        u.pm = fm + ((wgid % nig) % gsz); u.pn = (wgid % nig) / gsz; return true;
    }
    __device__ __forceinline__ void a_ready(const Unit&) const {}
    __device__ __forceinline__ void done(const Unit&) const {}
};
template <class Epi, class Sched, bool STAMP = false>
__device__ __forceinline__ void gemm_phase(PG8_LAS unsigned char* lds, const Gemm g, const Sched& S, const Epi& E, unsigned long long* stamps) {
    const int tid = threadIdx.x, wid = __builtin_amdgcn_readfirstlane(tid >> 6), lane = tid & 63, wr = wid >> 2, wc = wid & 3, fr = lane & 15, fq = lane >> 4;
    const int K = g.K, nt = K / BK;
    int ts_lo = 0, ts_hi = 0, nts = 0; const unsigned long long rt_entry = STAMP ? (unsigned long long)wall_clock64() : 0ull;
#define PG8_STAMP() do { if (STAMP && wid == 0 && nts < 64) { const unsigned long long _c = (unsigned long long)clock64(); \
        ts_lo = (lane == nts) ? (int)(unsigned)_c : ts_lo; ts_hi = (lane == nts) ? (int)(unsigned)(_c >> 32) : ts_hi; ++nts; } } while (0)
    PG8_STAMP();
    unsigned voffA[2], voffB[2];
#pragma unroll
    for (int i = 0; i < 2; ++i) { int R, C; stage_rc(tid * 16 + i * 8192, R, C); const int Rb = Epi::PERM ? ((R & ~31) + perm32(R & 31)) : R;
        voffA[i] = (unsigned)(R * K + C) * 2u; voffB[i] = (unsigned)(Rb * K + C) * 2u; }
    const size_t kstep = (size_t)(BK * 2);
    const size_t hstep = (size_t)HALF * K * 2;
    const size_t tstep = 2 * hstep;
    const unsigned ldsw = (unsigned)wid * 1024u;
    const int aoff = lds_byte(wr * 64 + fr, fq * 8), boff = lds_byte(wc * 32 + fr, fq * 8);
#define PG8_SA(b, h) (((b) * 2 + (h)) * HTB)
#define PG8_SB(b, h) ((4 + (b) * 2 + (h)) * HTB)
#define PG8_STAGE(bufoff, gbase, voff) do { _Pragma("unroll") for (int _i = 0; _i < 2; ++_i) \
        __builtin_amdgcn_global_load_lds((const unsigned*)((const char*)(gbase) + (voff)[_i]), (PG8_LAS unsigned*)(lds + (bufoff) + ldsw + _i * 8192), 16, 0, 0); } while (0)
#define PG8_LDA(dst, b, h) do { _Pragma("unroll") for (int m = 0; m < 4; ++m) _Pragma("unroll") for (int k = 0; k < 2; ++k) dst[m][k] = *(const PG8_LAS bf16x8*)(lds + PG8_SA(b, h) + aoff + m * 2048 + k * 1024); } while (0)
#define PG8_LDB(dst, b, h) do { _Pragma("unroll") for (int n = 0; n < 2; ++n) _Pragma("unroll") for (int k = 0; k < 2; ++k) dst[n][k] = *(const PG8_LAS bf16x8*)(lds + PG8_SB(b, h) + boff + n * 2048 + k * 1024); } while (0)
#define PG8_MMA(ai, bj, At, Bt) do { __builtin_amdgcn_s_setprio(1); _Pragma("unroll") for (int m = 0; m < 4; ++m) _Pragma("unroll") for (int n = 0; n < 2; ++n) _Pragma("unroll") for (int k = 0; k < 2; ++k) \
        acc[ai][bj][m][n] = __builtin_amdgcn_mfma_f32_16x16x32_bf16(Bt[n][k], At[m][k], acc[ai][bj][m][n], 0, 0, 0); __builtin_amdgcn_s_setprio(0); } while (0)
#define PG8_WAIT_V(n) asm volatile("s_waitcnt vmcnt(" #n ")" ::: "memory")
#define PG8_WAIT_L(n) asm volatile("s_waitcnt lgkmcnt(" #n ")" ::: "memory")
#define PG8_BAR __builtin_amdgcn_s_barrier()
#define PG8_SCHED __builtin_amdgcn_sched_barrier(0)
    Unit cur, nxt; int ui = 0;
    if (!S.next(0, cur)) return;
    f32x4 acc[2][2][4][2];
#pragma unroll
    for (int a = 0; a < 2; ++a)
#pragma unroll
        for (int b = 0; b < 2; ++b)
#pragma unroll
            for (int m = 0; m < 4; ++m)
#pragma unroll
                for (int n = 0; n < 2; ++n) acc[a][b][m][n] = (f32x4){0.f, 0.f, 0.f, 0.f};
    bf16x8 At[4][2], B0[2][2], B1[2][2];
    const char* cA = (const char*)g.A + (size_t)cur.pm * tstep; const char* cB = (const char*)g.Bt + (size_t)cur.pn * tstep;
    S.a_ready(cur);
    PG8_STAGE(PG8_SB(0, 0), cB, voffB); PG8_STAGE(PG8_SA(0, 0), cA, voffA); PG8_STAGE(PG8_SB(0, 1), cB + hstep, voffB); PG8_STAGE(PG8_SA(0, 1), cA + hstep, voffA);
    if (wr == 1) PG8_BAR;
    PG8_WAIT_V(4); PG8_BAR;
    PG8_STAGE(PG8_SB(1, 0), cB + kstep, voffB); PG8_STAGE(PG8_SA(1, 0), cA + kstep, voffA); PG8_STAGE(PG8_SB(1, 1), cB + hstep + kstep, voffB);
    PG8_WAIT_V(6); PG8_BAR;
    PG8_STAMP();
    for (;;) {
        const bool has_next = S.next(ui + 1, nxt);
        const char* nA = has_next ? (const char*)g.A + (size_t)nxt.pm * tstep : cA; const char* nB = has_next ? (const char*)g.Bt + (size_t)nxt.pn * tstep : cB;
        for (int t = 0; t < nt; t += 2) {
            const bool last = (t == nt - 2);
            const char* a1 = cA + (size_t)(t + 1) * kstep;
            const char* a2 = last ? nA : cA + (size_t)(t + 2) * kstep; const char* b2 = last ? nB : cB + (size_t)(t + 2) * kstep;
            const char* a3 = a2 + kstep; const char* b3 = b2 + kstep;
            if (last && has_next) S.a_ready(nxt);
            PG8_LDB(B0, 0, 0); PG8_SCHED; PG8_LDA(At, 0, 0); PG8_STAGE(PG8_SA(1, 1), a1 + hstep, voffA);
            PG8_WAIT_L(8); PG8_BAR; PG8_WAIT_L(0); PG8_MMA(0, 0, At, B0); PG8_BAR; PG8_SCHED;
            PG8_LDB(B1, 0, 1); PG8_STAGE(PG8_SB(0, 0), b2, voffB);
            PG8_BAR; PG8_WAIT_L(0); PG8_MMA(0, 1, At, B1); PG8_BAR;
            PG8_LDA(At, 0, 1); PG8_STAGE(PG8_SA(0, 0), a2, voffA);
            PG8_BAR; PG8_WAIT_L(0); PG8_MMA(1, 0, At, B0); PG8_BAR; PG8_SCHED;
            PG8_STAGE(PG8_SB(0, 1), b2 + hstep, voffB);
            PG8_WAIT_V(6); PG8_BAR; PG8_MMA(1, 1, At, B1); PG8_BAR;
            PG8_LDB(B0, 1, 0); PG8_SCHED; PG8_LDA(At, 1, 0); PG8_STAGE(PG8_SA(0, 1), a2 + hstep, voffA);
            PG8_WAIT_L(8); PG8_BAR; PG8_WAIT_L(0); PG8_MMA(0, 0, At, B0); PG8_BAR; PG8_SCHED;
            PG8_LDB(B1, 1, 1); PG8_STAGE(PG8_SB(1, 0), b3, voffB);
            PG8_BAR; PG8_WAIT_L(0); PG8_MMA(0, 1, At, B1); PG8_BAR;
            PG8_LDA(At, 1, 1); PG8_STAGE(PG8_SA(1, 0), a3, voffA);
            PG8_BAR; PG8_WAIT_L(0); PG8_MMA(1, 0, At, B0); PG8_BAR; PG8_SCHED;
            PG8_STAGE(PG8_SB(1, 1), b3 + hstep, voffB);
            PG8_WAIT_V(6); PG8_BAR; PG8_MMA(1, 1, At, B1); PG8_BAR;
        }
        PG8_STAMP();
        if constexpr (!Epi::AFTER_DRAIN) { E(acc, cur, wr, wc, fr, fq); S.done(cur); }
        PG8_STAMP();
        if (!has_next) break;
#pragma unroll
        for (int a = 0; a < 2; ++a)
#pragma unroll
            for (int b = 0; b < 2; ++b)
#pragma unroll
                for (int m = 0; m < 4; ++m)
#pragma unroll
                    for (int n = 0; n < 2; ++n) acc[a][b][m][n] = (f32x4){0.f, 0.f, 0.f, 0.f};
        cur = nxt; cA = nA; cB = nB; ++ui;
    }
    PG8_WAIT_V(0);
    if (wr == 0) PG8_BAR;
    PG8_BAR;
    if constexpr (Epi::AFTER_DRAIN) { E.fused(acc, cur, wr, wc, fr, fq, lds, wid, lane); S.done(cur); }
    PG8_STAMP();
    if (STAMP && wid == 0) { stamps[lane] = lane < nts ? (((unsigned long long)(unsigned)ts_hi << 32) | (unsigned)ts_lo) : 0ull;
        if (lane == 62) stamps[62] = rt_entry; if (lane == 63) stamps[63] = (unsigned long long)wall_clock64(); }
#undef PG8_STAMP
#undef PG8_SA
#undef PG8_SB
#undef PG8_STAGE
#undef PG8_LDA
#undef PG8_LDB
#undef PG8_MMA
#undef PG8_WAIT_V
#undef PG8_WAIT_L
#undef PG8_BAR
#undef PG8_SCHED
}
}

typedef float f32x4 __attribute__((ext_vector_type(4)));
template <class F> struct RowEpi {
  static constexpr bool PERM = false, AFTER_DRAIN = false;
  F f;
  DI void operator()(const pg8::f32x4 (&acc)[2][2][4][2], const pg8::Unit& u, int wr, int wc, int fr, int fq) const {
    const int row0 = u.pm * 256 + wr * 64 + fr, col0 = u.pn * 256 + wc * 32 + 4 * fq;
#pragma unroll
    for (int ai = 0; ai < 2; ++ai)
#pragma unroll
      for (int m = 0; m < 4; ++m)
#pragma unroll
        for (int bj = 0; bj < 2; ++bj)
#pragma unroll
          for (int n = 0; n < 2; ++n) f(row0 + ai * 128 + m * 16, col0 + bj * 128 + n * 16, acc[ai][bj][m][n]);
  }
};
struct FU {
  u16* UA; u16* PQt;
  DI void operator()(int m, int n, pg8::f32x4 v) const {
    if (n < 512) {
      uint2 w; w.x = pack2(v[0], v[1]); w.y = pack2(v[2], v[3]);
      *(uint2*)(UA + (size_t)m * 512 + n) = w;
    } else {
      const int np = n - 512, g = np >> 8, pq = (np >> 7) & 1, mm = np & 127;
      u16* q; size_t st;
      if (m < 4096) { const int b = m >> 8, nl = m & 255; q = PQt + ((size_t)(b * 512 + g * 128 + mm)) * 512 + pq * 256 + nl; st = 512; }
      else { const int ms = m - 4096, b = ms >> 12, nl = ms & 4095; q = PQt + (size_t)16 * 512 * 512 + ((size_t)(b * 512 + g * 128 + mm)) * 8192 + pq * 4096 + nl; st = 8192; }
      q[0] = f2bf(v[0]); q[st] = f2bf(v[1]); q[2 * st] = f2bf(v[2]); q[3 * st] = f2bf(v[3]);
    }
  }
};
struct FRes {
  const float* xin_p; const float* xin_s; float* X; const float* gate;
  DI void operator()(int m, int n, pg8::f32x4 v) const {
    const float* xi = (m < 4096) ? xin_p + (size_t)m * 1024 + n : xin_s + (size_t)(m - 4096) * 1024 + n;
    const float4 x = *(const float4*)xi;
    const float4 g = *(const float4*)(gate + cond_of(m) * 6144 + n);
    *(float4*)(X + (size_t)m * 1024 + n) = make_float4(x.x + g.x * v[0], x.y + g.y * v[1], x.z + g.z * v[2], x.w + g.w * v[3]);
  }
};
struct FRelu2 {
  u16* C;
  DI void operator()(int m, int n, pg8::f32x4 v) const {
    const float a = fmaxf(v[0], 0.f), b = fmaxf(v[1], 0.f), c = fmaxf(v[2], 0.f), d = fmaxf(v[3], 0.f);
    uint2 w; w.x = pack2(a * a, b * b); w.y = pack2(c * c, d * d);
    *(uint2*)(C + (size_t)m * 4096 + n) = w;
  }
};
struct FQkv {
  u16* QKV; u16* CVtP; u16* CVtS; u16* DVtP; u16* DVtS; float* ncv; float* ndv;
  DI void operator()(int m, int n, pg8::f32x4 v) const {
    const bool is_cv = (n >= 1024 && n < 1536), is_dv = (n >= 2176);
    if (!is_cv && !is_dv) {
      uint2 w; w.x = pack2(v[0], v[1]); w.y = pack2(v[2], v[3]);
      *(uint2*)(QKV + (size_t)m * 2304 + n) = w;
      return;
    }
    const int c = is_cv ? n - 1024 : n - 2176;
    const int feat = is_cv ? 512 : 128;
    u16* q; size_t st;
    if (m < 4096) {
      const int b = m >> 8, nl = m & 255;
      q = (is_cv ? CVtP : DVtP) + ((size_t)(b * feat + c)) * 256 + nl; st = 256;
      *(float4*)((is_cv ? ncv : ndv) + (size_t)m * feat + c) = make_float4(v[0], v[1], v[2], v[3]);
    } else {
      const int ms = m - 4096, b = ms >> 12, nl = ms & 4095;
      q = (is_cv ? CVtS : DVtS) + ((size_t)(b * feat + c)) * 4608 + 512 + nl; st = 4608;
    }
    q[0] = f2bf(v[0]); q[st] = f2bf(v[1]); q[2 * st] = f2bf(v[2]); q[3 * st] = f2bf(v[3]);
  }
};
template <class F>
DI void big_gemm(PG8_LAS unsigned char* lds, const u16* A, const u16* Bt, int M, int N, int K, F f) {
  pg8::Gemm g{A, Bt, M, N, K};
  pg8::StaticOrder S; S.init(M, N, (int)gridDim.x, (int)blockIdx.x);
  RowEpi<F> E{f};
  pg8::gemm_phase<RowEpi<F>, pg8::StaticOrder, false>(lds, g, S, E, nullptr);
}

#define XB_TMO      128
#define XB_XCNT(j)  (256  + 64 * (j))
#define XB_XSUB(j)  (1280 + 64 * (j))
#define XB_XGEN(j)  (2304 + 64 * (j))
#define XB_TOP      3328
#define XB_TOPGEN   3392
#define XCD_BAR_WORDS 3456
#define XB_SPIN_CAP (1u << 18)
#define LAS __attribute__((address_space(3)))
DI unsigned xb_ld(unsigned* p)              { return __hip_atomic_load(p, __ATOMIC_RELAXED, __HIP_MEMORY_SCOPE_AGENT); }
DI unsigned xb_add(unsigned* p, unsigned v) { return __hip_atomic_fetch_add(p, v, __ATOMIC_RELAXED, __HIP_MEMORY_SCOPE_AGENT); }
DI unsigned xb_xcc_id() { return (unsigned)__builtin_amdgcn_s_getreg((3 << 11) | 20) & 0xFu; }
#define XB_SPIN(cond, bar) do { unsigned _sp = 0; while (cond) { __builtin_amdgcn_s_sleep(1); \
    if ((++_sp & 255u) == 0u) { if (xb_ld(&(bar)[XB_TMO])) break; if (_sp > XB_SPIN_CAP) { atomicAdd(&(bar)[XB_TMO], 1u); break; } } } } while (0)
struct XcdBarrier { unsigned* bar; unsigned x; volatile LAS unsigned* st; };
DI XcdBarrier xcd_barrier_post(unsigned* bar, volatile LAS unsigned* st) {
  XcdBarrier b; b.bar = bar; b.x = xb_xcc_id(); b.st = st;
  if (threadIdx.x == 0) (void)xb_add(&bar[XB_XCNT(b.x)], 1u);
  return b;
}
DI void xcd_barrier_complete(unsigned* bar, unsigned x, unsigned& nloc, unsigned& nx) {
  const unsigned G = gridDim.x;
  unsigned sum, cnt, mine, sp = 0u;
  for (;;) {
    sum = 0u; cnt = 0u; mine = 0u;
#pragma unroll
    for (unsigned j = 0; j < 16; ++j) { const unsigned c = xb_ld(&bar[XB_XCNT(j)]); sum += c; cnt += (c > 0u) ? 1u : 0u; mine = (j == x) ? c : mine; }
    if (sum == G) break;
    __builtin_amdgcn_s_sleep(1);
    if ((++sp & 255u) == 0u) { if (xb_ld(&bar[XB_TMO])) break; if (sp > XB_SPIN_CAP) { atomicAdd(&bar[XB_TMO], 1u); break; } }
  }
  nloc = mine > 0u ? mine : 1u; nx = cnt > 0u ? cnt : 1u;
}
DI void xcd_barrier(const XcdBarrier& b) {
  asm volatile("s_waitcnt vmcnt(0)" ::: "memory");
  __syncthreads();
  if (threadIdx.x == 0) {
    unsigned* bar = b.bar;
    __builtin_amdgcn_s_waitcnt(0);
    unsigned nloc = b.st[0], nx = b.st[1];
    if (nloc == 0u) { xcd_barrier_complete(bar, b.x, nloc, nx); b.st[0] = nloc; b.st[1] = nx; }
    const unsigned old = xb_add(&bar[XB_XSUB(b.x)], 1u);
    const unsigned gen = old / nloc;
    if (old + 1u == (gen + 1u) * nloc) {
      __builtin_amdgcn_fence(__ATOMIC_RELEASE, "agent");
      asm volatile("s_waitcnt vmcnt(0)" ::: "memory");
      const unsigned og = xb_add(&bar[XB_TOP], 1u);
      const unsigned tg = og / nx;
      if (og + 1u == (tg + 1u) * nx) xb_add(&bar[XB_TOPGEN], 1u);
      else XB_SPIN(xb_ld(&bar[XB_TOPGEN]) == tg, bar);
      __builtin_amdgcn_fence(__ATOMIC_ACQUIRE, "agent");
      xb_add(&bar[XB_XGEN(b.x)], 1u);
      asm volatile("s_waitcnt vmcnt(0)" ::: "memory");
    } else {
      XB_SPIN(xb_ld(&bar[XB_XGEN(b.x)]) == gen, bar);
      __builtin_amdgcn_fence(__ATOMIC_ACQUIRE, "agent");
      asm volatile("s_waitcnt vmcnt(0)" ::: "memory");
    }
  }
  __syncthreads();
}

__global__ void __launch_bounds__(512) fwd_kernel(Params p, int ph_lo, int ph_hi) {
  extern __shared__ __attribute__((aligned(16))) unsigned char shm[];
  const int half = threadIdx.x >> 8;
  char* lds = (char*)shm + half * LDS_BYTES;
  PG8_LAS unsigned char* lds8 = (PG8_LAS unsigned char*)shm;
  const int G = 2 * (int)gridDim.x;
  int vb0 = blockIdx.x;
  if ((gridDim.x & 7) == 0) vb0 = (blockIdx.x & 7) * (gridDim.x >> 3) + (blockIdx.x >> 3);
  const int vb = 2 * vb0 + half;
  unsigned char* ws = p.ws;
  const float* mods = (const float*)(ws + OFF_MODS);
  float* X = p.out + OUT_Y;
  u16* H = (u16*)(ws + OFF_H);

#define RUNPH(n) ((ONLYPH < 0 || ONLYPH == (n)) && ph_lo <= (n) && (n) < ph_hi)
#define REP(n) _Pragma("unroll") for (int rep_ = 0; rep_ < ((DUPPH == (n)) ? 2 : 1); ++rep_)
#define SEAM(n) if (ph_lo < (n) && (n) < ph_hi) xcd_barrier(xb);
  __shared__ uint4 xb_words;
  if (threadIdx.x == 0) xb_words = make_uint4(0u, 0u, 0u, 0u);
  __syncthreads();
  XcdBarrier xb = xcd_barrier_post((unsigned*)(ws + OFF_BAR), (volatile LAS unsigned*)&xb_words);
  if (ph_hi > 1000) cg::this_grid().sync();
  if (RUNPH(0)) REP(0) {
    for (int id = vb; id < 384; id += G) ada_item(p, id, lds);
    prep_transposes(p, vb, G, lds, 0);
    prep_elementwise(p, vb, G);
  }
  SEAM(1)
  if (RUNPH(1)) {
    for (int t = vb; t < 128; t += G) {
      const bool f1 = t < 64;
      const int q = t & 63;
      gemm_tile(f1 ? (const u16*)(ws + OFF_CBD) : (const u16*)(ws + OFF_WOUT_ET), f1 ? 512 : 1024,
                f1 ? (const u16*)(ws + OFF_WINB) : (const u16*)(ws + OFF_BD), f1 ? 512 : 1024, f1 ? 512 : 1024, (q >> 3) << 7, (q & 7) << 7,
                EpiBf16{f1 ? (u16*)(ws + OFF_WIN_E) + (size_t)512 * 1024 : (u16*)(ws + OFF_WOUT_E), 1024}, lds);
    }
    normmod_phase(p, vb, G, p.in[0], p.in[1], p.in[8], 0, 0);
  }
  SEAM(2)
  if (RUNPH(2)) REP(2)
    big_gemm(lds8, H, (const u16*)(ws + OFF_WIN_E), T, 1536, 1024, FU{(u16*)(ws + OFF_UA), (u16*)(ws + OFF_PQT)});
  SEAM(3)
  if (RUNPH(3)) sym_phase(p, vb, G);
  SEAM(4)
  if (RUNPH(4)) REP(4) {
    const u16* PQT = (const u16*)(ws + OFF_PQT);
    const u16* PEQO = (const u16*)(ws + OFF_PEQO);
    for (int t = vb; t < 256 + 128; t += G) {
      const bool big = t < 256;
      const int q = t - 256, b = q >> 3;
      dft_tile(big ? (const u16*)(ws + OFF_D4096) : (const u16*)(ws + OFF_D256),
               big ? PEQO + (size_t)16 * 512 * 256 : PEQO + (size_t)b * 512 * 256,
               big ? PQT + (size_t)16 * 512 * 512 + 2048 : PQT + (size_t)b * 512 * 512 + 128,
               big ? 8192 : 512, big ? 2048 : 128, big ? (t & 15) << 7 : 0, big ? (t >> 4) << 6 : (q & 7) << 6,
               (u16*)(ws + OFF_AB), big ? 4096 : b * 256, 512, big ? 0.0013810679320049757f : 0.005524271728019903f, lds);
    }
    if (vb >= 256) pool_phase(p, vb - 256, G - 256);
  }
  SEAM(5)
  if (RUNPH(5))
    big_gemm(lds8, (const u16*)(ws + OFF_AB), (const u16*)(ws + OFF_WOUT_E), T, 1024, 1024, FRes{p.in[0], p.in[1], X, mods + 2048});
  SEAM(6)
  if (RUNPH(6)) normmod_phase(p, vb, G, X, X + (size_t)4096 * 1024, p.in[9], 0, 1);
  SEAM(7)
  if (RUNPH(7)) REP(7) big_gemm(lds8, H, (const u16*)(ws + OFF_W1), T, 4096, 1024, FRelu2{(u16*)(ws + OFF_M1)});
  SEAM(8)
  if (RUNPH(8)) {
    big_gemm(lds8, (const u16*)(ws + OFF_M1), (const u16*)(ws + OFF_W2), T, 1024, 4096, FRes{X, X + (size_t)4096 * 1024, X, mods + 5120});
    if (blockIdx.x >= 192) prep_transposes(p, ((int)blockIdx.x - 192) * 2 + half, ((int)gridDim.x - 192) * 2, lds, 1);
  }
  SEAM(9)
  if (RUNPH(9)) normmod_phase(p, vb, G, X, X + (size_t)4096 * 1024, p.in[8] + 1024, 1, 0);
  SEAM(10)
  if (RUNPH(10)) big_gemm(lds8, H, (const u16*)(ws + OFF_WIN_O), T, 2304, 1024,
                            FQkv{(u16*)(ws + OFF_QKV), (u16*)(ws + OFF_CVTP), (u16*)(ws + OFF_CVTS), (u16*)(ws + OFF_DVTP), (u16*)(ws + OFF_DVTS), p.out + OUT_NCV, p.out + OUT_NDV});
  SEAM(11)
  if (RUNPH(11)) REP(11) qkvpost_phase(p, vb, G);
  SEAM(12)
  if (RUNPH(12)) REP(12) attention_phase(p, vb, G, lds);
  SEAM(13)
  if (RUNPH(13)) combine_phase(p, vb, G);
  SEAM(14)
  if (RUNPH(14)) big_gemm(lds8, H, (const u16*)(ws + OFF_WOUT_O), T, 1024, 1024, FRes{X, X + (size_t)4096 * 1024, X, mods + 3 * 6144 + 2048});
  SEAM(15)
  if (RUNPH(15)) normmod_phase(p, vb, G, X, X + (size_t)4096 * 1024, p.in[9] + 1024, 1, 1);
  SEAM(16)
  if (RUNPH(16)) big_gemm(lds8, H, (const u16*)(ws + OFF_W1) + (size_t)4096 * 1024, T, 4096, 1024, FRelu2{(u16*)(ws + OFF_M1)});
  SEAM(17)
  if (RUNPH(17)) big_gemm(lds8, (const u16*)(ws + OFF_M1), (const u16*)(ws + OFF_W2) + (size_t)4096 * 1024, T, 1024, 4096, FRes{X, X + (size_t)4096 * 1024, X, mods + 3 * 6144 + 5120});
}

extern "C" void kernel_launch(void* const* d_in, const int* in_sizes, int n_in, void* d_out, int out_size, void* d_ws, size_t ws_size,
                              hipStream_t stream) {
  constexpr int kDynLds = 2 * LDS_BYTES;
  static int grid = 0;
  if (!grid) {
    int dev = 0, cus = 0, per_cu = 0;
    (void)hipGetDevice(&dev);
    (void)hipDeviceGetAttribute(&cus, hipDeviceAttributeMultiprocessorCount, dev);
    if (hipFuncSetAttribute((const void*)fwd_kernel, hipFuncAttributeMaxDynamicSharedMemorySize, kDynLds) != hipSuccess) fprintf(stderr, "hipFuncSetAttribute(%d) failed\n", kDynLds);
    (void)hipOccupancyMaxActiveBlocksPerMultiprocessor(&per_cu, fwd_kernel, 512, kDynLds);
    if (per_cu < 1) fprintf(stderr, "occupancy query says %d blocks/CU\n", per_cu);
    grid = cus;
    if (ws_size < WS_END) fprintf(stderr, "workspace too small: %zu < %zu\n", ws_size, (size_t)WS_END);
  }
  Params p{};
  for (int i = 0; i < 31; ++i) p.in[i] = (const float*)d_in[i];
  p.out = (float*)d_out;
  p.ws = (unsigned char*)d_ws;
#if ONE_LAUNCH
  hipMemsetAsync((char*)d_ws + OFF_BAR, 0, XCD_BAR_WORDS * 4, stream);
  int lo = 0, hi = NPH;
  void* args[] = {&p, &lo, &hi};
  hipError_t e = hipLaunchCooperativeKernel((void*)fwd_kernel, dim3(grid), dim3(512), args, kDynLds, stream);
  if (e != hipSuccess) fprintf(stderr, "cooperative launch failed: %s (grid %d)\n", hipGetErrorString(e), grid);
#else
  for (int ph = 0; ph < NPH; ++ph) hipLaunchKernelGGL(fwd_kernel, dim3(grid), dim3(512), kDynLds, stream, p, ph, ph + 1);
#endif
}
```

```cpp
#include <hip/hip_runtime.h>
#include <hip/hip_cooperative_groups.h>
#include <cstdio>
namespace cg = cooperative_groups;

#ifndef ONE_LAUNCH
#define ONE_LAUNCH 1
#endif

#ifndef ONLYPH
#define ONLYPH -1
#endif
#ifndef DUPPH
#define DUPPH -1
#endif
typedef unsigned short u16;
typedef short bf16x8 __attribute__((ext_vector_type(8)));
typedef float f32x16 __attribute__((ext_vector_type(16)));
typedef __bf16 bf2_t __attribute__((ext_vector_type(2)));
typedef float f2_t __attribute__((ext_vector_type(2)));
typedef unsigned u32x4 __attribute__((ext_vector_type(4)));

#define DI __device__ __forceinline__
#define TIDX ((int)(threadIdx.x & 255u))

constexpr int T = 12288, TP = 4096, DM = 1024;
constexpr int NPH = 18;
constexpr float EPS = 1e-6f;
constexpr float LOG2E = 1.4426950408889634f;
constexpr float QSCALE = 0.125f * LOG2E;
constexpr float LAM_INIT = 0.35550906759f;

constexpr size_t al(size_t x) { return (x + 255) & ~size_t(255); }
constexpr size_t OFF_MODS   = 0;
constexpr size_t OFF_WIN_E  = OFF_MODS + al(2 * 3 * 6144 * 4);
constexpr size_t OFF_WINB   = OFF_WIN_E + al(1536 * 1024 * 2);
constexpr size_t OFF_CBD    = OFF_WINB + al(1024 * 512 * 2);
constexpr size_t OFF_WOUT_ET= OFF_CBD + al(1024 * 512 * 2);
constexpr size_t OFF_BD     = OFF_WOUT_ET + al(1024 * 1024 * 2);
constexpr size_t OFF_WOUT_E = OFF_BD + al(1024 * 1024 * 2);
constexpr size_t OFF_WIN_O  = OFF_WOUT_E + al(1024 * 1024 * 2);
constexpr size_t OFF_WOUT_O = OFF_WIN_O + al(2304 * 1024 * 2);
constexpr size_t OFF_W1     = OFF_WOUT_O + al(1024 * 1024 * 2);
constexpr size_t OFF_W2     = OFF_W1 + al(2 * 4096 * 1024 * 2);
constexpr size_t OFF_D256   = OFF_W2 + al(2 * 4096 * 1024 * 2);
constexpr size_t OFF_H      = OFF_D256 + al(256 * 512 * 2);
constexpr size_t OFF_R2     = OFF_H + al((size_t)T * 1024 * 2);
constexpr size_t R2_BYTES   = (size_t)T * 512 * 2 + (size_t)T * 1024 * 2 * 2;
constexpr size_t OFF_R1     = OFF_R2 + al(R2_BYTES);
constexpr size_t R1_BYTES   = (size_t)T * 4096 * 2;
constexpr size_t OFF_BAR    = OFF_R1 + R1_BYTES;
constexpr size_t WS_END     = OFF_BAR + 3456 * 4;
constexpr size_t OFF_UA  = OFF_R2;
constexpr size_t OFF_PQT = OFF_UA + (size_t)T * 512 * 2;
constexpr size_t OFF_AB  = OFF_PQT + (size_t)T * 1024 * 2;
constexpr size_t OFF_CQ   = OFF_R2;
constexpr size_t OFF_DQ   = OFF_CQ + (size_t)T * 512 * 2;
constexpr size_t OFF_CKP  = OFF_DQ + (size_t)T * 512 * 2;
constexpr size_t OFF_CKS  = OFF_CKP + (size_t)16 * 8 * 256 * 64 * 2;
constexpr size_t OFF_CVTP = OFF_CKS + (size_t)2 * 8 * 4608 * 64 * 2;
constexpr size_t OFF_CVTS = OFF_CVTP + (size_t)16 * 4 * 128 * 256 * 2;
constexpr size_t OFF_DKP  = OFF_CVTS + (size_t)2 * 4 * 128 * 4608 * 2;
constexpr size_t OFF_DKS  = OFF_DKP + (size_t)16 * 2 * 256 * 64 * 2;
constexpr size_t OFF_DVTP = OFF_DKS + (size_t)2 * 2 * 4608 * 64 * 2;
constexpr size_t OFF_DVTS = OFF_DVTP + (size_t)16 * 2 * 64 * 256 * 2;
constexpr size_t R2_LATE_END = OFF_DVTS + (size_t)2 * 2 * 64 * 4608 * 2;
static_assert(R2_LATE_END <= OFF_R2 + R2_BYTES, "R2 overflow");
constexpr size_t OFF_D4096 = OFF_R1;
constexpr size_t OFF_PEQO  = OFF_R1 + (size_t)32 * 1024 * 1024;
constexpr size_t OFF_M1    = OFF_R1;
constexpr size_t OFF_QKV   = OFF_R1;
constexpr size_t OFF_OM    = OFF_R1 + al((size_t)T * 2304 * 2);
static_assert(OFF_OM + (size_t)T * 1024 * 2 <= WS_END, "R1 overflow");

constexpr size_t OUT_Y   = 0;
constexpr size_t OUT_NCK = (size_t)T * 1024;
constexpr size_t OUT_NCV = OUT_NCK + (size_t)TP * 512;
constexpr size_t OUT_NDK = OUT_NCV + (size_t)TP * 512;
constexpr size_t OUT_NDV = OUT_NDK + (size_t)TP * 128;

struct Params {
  const float* in[31];
  float* out;
  unsigned char* ws;
};

DI float bf2f(u16 v) { return __uint_as_float(((unsigned)v) << 16); }
DI unsigned pack2(float a, float b) { f2_t f = {a, b}; bf2_t v = __builtin_convertvector(f, bf2_t); return __builtin_bit_cast(unsigned, v); }
DI u16 f2bf(float a) { return (u16)(pack2(a, 0.f) & 0xffffu); }
DI int cond_of(int m) { return m < 4096 ? 0 : (m < 8192 ? 1 : 2); }
DI float wave_sum(float v) {
#pragma unroll
  for (int o = 32; o >= 1; o >>= 1) v += __shfl_xor(v, o);
  return v;
}
#define MFMA(a, b, c) __builtin_amdgcn_mfma_f32_32x32x16_bf16((a), (b), (c), 0, 0, 0)

constexpr int LROW = 144;
constexpr int GEMM_BUF = 2 * 128 * LROW;
constexpr int LDS_BYTES = 2 * GEMM_BUF;

template <int NR>
DI void g_load(u32x4 (&R)[NR], const u16* g, int ld, int k0) {
#pragma unroll
  for (int i = 0; i < NR; ++i) R[i] = *(const u32x4*)(g + (size_t)(32 * i) * ld + k0);
}
template <int NR>
DI void g_store(const u32x4 (&R)[NR], char* sw) {
#pragma unroll
  for (int i = 0; i < NR; ++i) *(u32x4*)(sw + (32 * i) * LROW) = R[i];
}
template <int NB>
DI void g_compute(f32x16 (&acc)[2][NB], const char* fa, const char* fb) {
#pragma unroll
  for (int ks = 0; ks < 4; ++ks) {
    bf16x8 a0 = *(const bf16x8*)(fa + ks * 32);
    bf16x8 a1 = *(const bf16x8*)(fa + 32 * LROW + ks * 32);
#pragma unroll
    for (int j = 0; j < NB; ++j) {
      bf16x8 b = *(const bf16x8*)(fb + j * 32 * LROW + ks * 32);
      acc[0][j] = MFMA(a0, b, acc[0][j]);
      acc[1][j] = MFMA(a1, b, acc[1][j]);
    }
  }
}
template <int NB>
DI void gemm_acc(f32x16 (&acc)[2][NB], const u16* A, int lda, const u16* Bt, int ldb, int K, int m0, int n0, char* lds) {
  const int tid = TIDX, lane = tid & 63, wave = tid >> 6;
  const int r = lane & 31, h = lane >> 5;
  const int wm = wave >> 1, wn = wave & 1;
  const int lrow = tid >> 3, lcol = (tid & 7) * 8;
  const u16* ga = A + (size_t)(m0 + lrow) * lda + lcol;
  const u16* gb = Bt + (size_t)(n0 + lrow) * ldb + lcol;
  u32x4 ra0[4], ra1[4], rb0[2 * NB], rb1[2 * NB];
  const int nk = K >> 6;
  char* sw = lds + lrow * LROW + lcol * 2;
  const char* fa = lds + (wm * 64 + r) * LROW + h * 16;
  const char* fb = lds + 128 * LROW + (wn * 32 * NB + r) * LROW + h * 16;
#define G_LOAD(RA, RB, kt_) do { const int k0_ = ((kt_) < nk ? (kt_) : nk - 1) << 6; g_load<4>(RA, ga, lda, k0_); g_load<2 * NB>(RB, gb, ldb, k0_); } while (0)
#define G_STORE(RA, RB, boff_) do { g_store<4>(RA, sw + (boff_)); g_store<2 * NB>(RB, sw + (boff_) + 128 * LROW); } while (0)
  G_LOAD(ra0, rb0, 0);
  G_LOAD(ra1, rb1, 1);
  G_STORE(ra0, rb0, 0);
  __syncthreads();
  for (int kt = 0; kt < nk; kt += 2) {
    G_LOAD(ra0, rb0, kt + 2);
    g_compute<NB>(acc, fa, fb);
    G_STORE(ra1, rb1, GEMM_BUF);
    __syncthreads();
    G_LOAD(ra1, rb1, kt + 3);
    g_compute<NB>(acc, fa + GEMM_BUF, fb + GEMM_BUF);
    G_STORE(ra0, rb0, 0);
    __syncthreads();
  }
#undef G_LOAD
#undef G_STORE
}

template <class Epi>
DI void gemm_tile(const u16* A, int lda, const u16* Bt, int ldb, int K, int m0, int n0, Epi epi, char* lds) {
  const int lane = TIDX & 63, wave = TIDX >> 6;
  const int r = lane & 31, h = lane >> 5, wm = wave >> 1, wn = wave & 1;
  f32x16 acc[2][2];
#pragma unroll
  for (int i = 0; i < 2; ++i)
#pragma unroll
    for (int j = 0; j < 2; ++j)
#pragma unroll
      for (int e = 0; e < 16; ++e) acc[i][j][e] = 0.f;
  gemm_acc<2>(acc, A, lda, Bt, ldb, K, m0, n0, lds);
#pragma unroll
  for (int i = 0; i < 2; ++i)
#pragma unroll
    for (int j = 0; j < 2; ++j)
#pragma unroll
      for (int q = 0; q < 4; ++q) {
        const int m = m0 + wm * 64 + i * 32 + 8 * q + 4 * h;
        const int n = n0 + wn * 64 + j * 32 + r;
        epi(m, n, acc[i][j][4 * q], acc[i][j][4 * q + 1], acc[i][j][4 * q + 2], acc[i][j][4 * q + 3]);
      }
}

DI void dft_tile(const u16* Dm, const u16* PeQo, const u16* PH, int phstride, int H, int m0, int n0, u16* AB, int rowbase, int colsPerBatch, float norm, char* lds) {
  const int lane = TIDX & 63, wave = TIDX >> 6;
  const int r = lane & 31, h = lane >> 5, wm = wave >> 1, wn = wave & 1;
  f32x16 accA[2][1], accB[2][1];
#pragma unroll
  for (int i = 0; i < 2; ++i)
#pragma unroll
    for (int e = 0; e < 16; ++e) { accA[i][0][e] = 0.f; accB[i][0][e] = 0.f; }
  gemm_acc<1>(accA, Dm, 2 * H, PeQo, 2 * H, H, m0, n0, lds);
  gemm_acc<1>(accB, Dm + H, 2 * H, PeQo + H, 2 * H, H, m0, n0, lds);
  const int N = 2 * H;
  const int col = n0 + wn * 32 + r;
  const int b = col / colsPerBatch, c = col - b * colsPerBatch;
  const float ph = bf2f(PH[(size_t)col * phstride]);
  u16* base = AB + ((size_t)rowbase + (size_t)b * N) * 1024 + 512 + c;
#pragma unroll
  for (int i = 0; i < 2; ++i)
#pragma unroll
    for (int q = 0; q < 4; ++q)
#pragma unroll
      for (int e = 0; e < 4; ++e) {
        const int k = m0 + wm * 64 + i * 32 + 8 * q + 4 * h + e;
        const float a = accA[i][0][4 * q + e] + ((k & 1) ? -ph : ph);
        const float bb = accB[i][0][4 * q + e];
        base[(size_t)k * 1024] = f2bf((a - bb) * norm);
        if (k > 0) base[(size_t)(N - k) * 1024] = f2bf((a + bb) * norm);
      }
}

struct EpiBf16 {
  u16* C; int ldc;
  DI void operator()(int m, int n, float v0, float v1, float v2, float v3) const {
    u16* p = C + (size_t)m * ldc + n;
    p[0] = f2bf(v0); p[ldc] = f2bf(v1); p[2 * ldc] = f2bf(v2); p[3 * ldc] = f2bf(v3);
  }
};
struct EpiU {
  u16* UA; u16* PQt;
  DI void operator()(int m, int n, float v0, float v1, float v2, float v3) const {
    if (n < 512) {
      u16* p = UA + (size_t)m * 512 + n;
      p[0] = f2bf(v0); p[512] = f2bf(v1); p[1024] = f2bf(v2); p[1536] = f2bf(v3);
    } else {
      const int np = n - 512, g = np >> 8, pq = (np >> 7) & 1, mm = np & 127;
      size_t off;
      if (m < 4096) { const int b = m >> 8, nl = m & 255; off = ((size_t)(b * 512 + g * 128 + mm)) * 512 + pq * 256 + nl; }
      else { const int ms = m - 4096, b = ms >> 12, nl = ms & 4095; off = (size_t)16 * 512 * 512 + ((size_t)(b * 512 + g * 128 + mm)) * 8192 + pq * 4096 + nl; }
      uint2 w; w.x = pack2(v0, v1); w.y = pack2(v2, v3);
      *(uint2*)(PQt + off) = w;
    }
  }
};
struct EpiDft {
  u16* AB; int rowbase; float norm; int sample;
  DI void operator()(int m, int n, float v0, float v1, float v2, float v3) const {
    size_t row; int c;
    if (sample) { row = (size_t)4096 + (size_t)(n >> 9) * 4096 + m; c = n & 511; }
    else { row = (size_t)rowbase + m; c = n; }
    u16* p = AB + row * 1024 + 512 + c;
    p[0] = f2bf(v0 * norm); p[1024] = f2bf(v1 * norm); p[2048] = f2bf(v2 * norm); p[3072] = f2bf(v3 * norm);
  }
};
struct EpiRes {
  const float* xin_p; const float* xin_s;
  float* X; const float* gate;
  DI void operator()(int m, int n, float v0, float v1, float v2, float v3) const {
    const float* xi = (m < 4096) ? xin_p + (size_t)m * 1024 + n : xin_s + (size_t)(m - 4096) * 1024 + n;
    const float g = gate[cond_of(m) * 6144 + n];
    float* xo = X + (size_t)m * 1024 + n;
    xo[0] = xi[0] + g * v0; xo[1024] = xi[1024] + g * v1; xo[2048] = xi[2048] + g * v2; xo[3072] = xi[3072] + g * v3;
  }
};
struct EpiRelu2 {
  u16* C;
  DI void operator()(int m, int n, float v0, float v1, float v2, float v3) const {
    v0 = fmaxf(v0, 0.f); v1 = fmaxf(v1, 0.f); v2 = fmaxf(v2, 0.f); v3 = fmaxf(v3, 0.f);
    u16* p = C + (size_t)m * 4096 + n;
    p[0] = f2bf(v0 * v0); p[4096] = f2bf(v1 * v1); p[8192] = f2bf(v2 * v2); p[12288] = f2bf(v3 * v3);
  }
};
struct EpiQkv {
  u16* QKV; u16* CVtP; u16* CVtS; u16* DVtP; u16* DVtS; float* ncv; float* ndv;
  DI void operator()(int m, int n, float v0, float v1, float v2, float v3) const {
    const bool is_cv = (n >= 1024 && n < 1536), is_dv = (n >= 2176);
    if (!is_cv && !is_dv) {
      u16* p = QKV + (size_t)m * 2304 + n;
      p[0] = f2bf(v0); p[2304] = f2bf(v1); p[4608] = f2bf(v2); p[6912] = f2bf(v3);
      return;
    }
    uint2 w; w.x = pack2(v0, v1); w.y = pack2(v2, v3);
    if (is_cv) {
      const int c = n - 1024;
      if (m < 4096) {
        const int b = m >> 8, nl = m & 255;
        *(uint2*)(CVtP + ((size_t)(b * 512 + c)) * 256 + nl) = w;
        float* o = ncv + (size_t)m * 512 + c; o[0] = v0; o[512] = v1; o[1024] = v2; o[1536] = v3;
      } else {
        const int ms = m - 4096, b = ms >> 12, nl = ms & 4095;
        *(uint2*)(CVtS + ((size_t)(b * 512 + c)) * 4608 + 512 + nl) = w;
      }
    } else {
      const int c = n - 2176;
      if (m < 4096) {
        const int b = m >> 8, nl = m & 255;
        *(uint2*)(DVtP + ((size_t)(b * 128 + c)) * 256 + nl) = w;
        float* o = ndv + (size_t)m * 128 + c; o[0] = v0; o[128] = v1; o[256] = v2; o[384] = v3;
      } else {
        const int ms = m - 4096, b = ms >> 12, nl = ms & 4095;
        *(uint2*)(DVtS + ((size_t)(b * 128 + c)) * 4608 + 512 + nl) = w;
      }
    }
  }
};

DI void ada_item(const Params& p, int id, char* lds) {
  const int tid = TIDX;
  float* ssil = (float*)lds;
  float* red = (float*)(lds + 12288);
  const int l = id / 192, cb = id % 192;
  for (int i = tid; i < 3072; i += 256) {
    const int j = i >> 10, k = i & 1023;
    const float v = (j == 0) ? p.in[7][k] : p.in[2][(j - 1) * 1024 + k];
    ssil[i] = v / (1.f + __expf(-v));
  }
  __syncthreads();
  const int cq = tid & 7, kg = tid >> 3;
  const float* w = p.in[10] + (size_t)l * 1024 * 6144 + cb * 32 + cq * 4;
  float4 a0 = {0, 0, 0, 0}, a1 = {0, 0, 0, 0}, a2 = {0, 0, 0, 0};
#pragma unroll 8
  for (int kk = 0; kk < 32; ++kk) {
    const int k = kg * 32 + kk;
    const float4 wv = *(const float4*)(w + (size_t)k * 6144);
    const float s0 = ssil[k], s1 = ssil[1024 + k], s2 = ssil[2048 + k];
    a0.x += s0 * wv.x; a0.y += s0 * wv.y; a0.z += s0 * wv.z; a0.w += s0 * wv.w;
    a1.x += s1 * wv.x; a1.y += s1 * wv.y; a1.z += s1 * wv.z; a1.w += s1 * wv.w;
    a2.x += s2 * wv.x; a2.y += s2 * wv.y; a2.z += s2 * wv.z; a2.w += s2 * wv.w;
  }
  float* rp = red + kg * 96 + cq * 4;
  rp[0] = a0.x; rp[1] = a0.y; rp[2] = a0.z; rp[3] = a0.w;
  rp[32] = a1.x; rp[33] = a1.y; rp[34] = a1.z; rp[35] = a1.w;
  rp[64] = a2.x; rp[65] = a2.y; rp[66] = a2.z; rp[67] = a2.w;
  __syncthreads();
  if (tid < 96) {
    const int j = tid >> 5, c = tid & 31;
    float sum = 0.f;
#pragma unroll
    for (int g = 0; g < 32; ++g) sum += red[g * 96 + j * 32 + c];
    const int col = cb * 32 + c;
    ((float*)(p.ws + OFF_MODS))[(size_t)(l * 3 + j) * 6144 + col] = sum + p.in[11][l * 6144 + col];
  }
  __syncthreads();
}

DI void transpose_tile(const float* src, int ld_src, u16* dst, int ld_dst, int r0, int c0, char* lds) {
  float* tile = (float*)lds;
  const int tid = TIDX;
  const int j4 = (tid & 15) * 4, i0 = tid >> 4;
#pragma unroll
  for (int it = 0; it < 4; ++it) {
    const int i = i0 + 16 * it;
    const float4 v = *(const float4*)(src + (size_t)(r0 + i) * ld_src + c0 + j4);
    float* tp = tile + i * 65 + j4;
    tp[0] = v.x; tp[1] = v.y; tp[2] = v.z; tp[3] = v.w;
  }
  __syncthreads();
  const int kc = (tid & 7) * 8, jr = tid >> 3;
#pragma unroll
  for (int it = 0; it < 2; ++it) {
    const int j = jr + 32 * it;
    const float* tp = tile + kc * 65 + j;
    uint4 o;
    o.x = pack2(tp[0], tp[65]); o.y = pack2(tp[130], tp[195]); o.z = pack2(tp[260], tp[325]); o.w = pack2(tp[390], tp[455]);
    *(uint4*)(dst + (size_t)(c0 + j) * ld_dst + r0 + kc) = o;
  }
  __syncthreads();
}

DI void prep_transposes(const Params& p, int vb, int G, char* lds, int layer) {
  const int ntile = layer ? 2880 : 2432;
  for (int t = vb; t < ntile; t += G) {
    const float* src; u16* dst; int lds_, ldd, r0, c0;
    int q = t;
    if (layer == 0) {
      if (q < 128) { src = p.in[12]; lds_ = 1024; dst = (u16*)(p.ws + OFF_WIN_E); ldd = 1024; r0 = (q >> 3) * 64; c0 = (q & 7) * 64; }
      else if ((q -= 128) < 256) { src = p.in[16]; lds_ = 1024; dst = (u16*)(p.ws + OFF_WOUT_ET); ldd = 1024; r0 = (q >> 4) * 64; c0 = (q & 15) * 64; }
      else if ((q -= 256) < 1024) { src = p.in[29]; lds_ = 4096; dst = (u16*)(p.ws + OFF_W1); ldd = 1024; r0 = (q >> 6) * 64; c0 = (q & 63) * 64; }
      else { q -= 1024; src = p.in[30]; lds_ = 1024; dst = (u16*)(p.ws + OFF_W2); ldd = 4096; r0 = (q >> 4) * 64; c0 = (q & 15) * 64; }
    } else {
      if (q < 576) { src = p.in[17]; lds_ = 2304; dst = (u16*)(p.ws + OFF_WIN_O); ldd = 1024; r0 = (q / 36) * 64; c0 = (q % 36) * 64; }
      else if ((q -= 576) < 256) { src = p.in[28]; lds_ = 1024; dst = (u16*)(p.ws + OFF_WOUT_O); ldd = 1024; r0 = (q >> 4) * 64; c0 = (q & 15) * 64; }
      else if ((q -= 256) < 1024) { src = p.in[29] + (size_t)1024 * 4096; lds_ = 4096; dst = (u16*)(p.ws + OFF_W1) + (size_t)4096 * 1024; ldd = 1024; r0 = (q >> 6) * 64; c0 = (q & 63) * 64; }
      else { q -= 1024; src = p.in[30] + (size_t)4096 * 1024; lds_ = 1024; dst = (u16*)(p.ws + OFF_W2) + (size_t)1024 * 4096; ldd = 4096; r0 = (q >> 4) * 64; c0 = (q & 15) * 64; }
    }
    transpose_tile(src, lds_, dst, ldd, r0, c0, lds);
  }
}

DI void prep_elementwise(const Params& p, int vb, int G) {
  const size_t gt = (size_t)vb * 256 + TIDX, gs = (size_t)G * 256;
  {
    u16* d = (u16*)(p.ws + OFF_WINB);
    for (size_t i = gt; i < 1024 * 256; i += gs) {
      const int k = (int)(i >> 8), c = (int)(i & 255) * 2;
      const float* s = p.in[12] + (size_t)k * 1024 + 512 + c;
      *(unsigned*)(d + (size_t)k * 512 + c) = pack2(s[0], s[1]);
    }
  }
  {
    u16* d = (u16*)(p.ws + OFF_CBD);
    for (size_t i = gt; i < 1024 * 512; i += gs) {
      const int np = (int)(i >> 9), cp = (int)(i & 511);
      const int g = np >> 8, pq = (np >> 7) & 1, m = np & 127;
      float v = 0.f;
      if ((cp >> 7) == g) {
        const int c = cp & 127; const int rr = (m * c) & 127;
        const float x = (float)rr * (2.0f / 128.0f);
        v = pq ? sinpif(x) : cospif(x);
      }
      d[i] = f2bf(v);
    }
  }
  {
    u16* d = (u16*)(p.ws + OFF_BD);
    for (size_t i = gt; i < 1024 * 1024; i += gs) {
      const int kp = (int)(i >> 10), c = (int)(i & 1023);
      float v = 0.f;
      if (kp < 512) { const int g = kp >> 7; if (c < 512 && (c >> 7) == g) v = p.in[13][(size_t)g * 16384 + (kp & 127) * 128 + (c & 127)] * p.in[14][c]; }
      else { const int g = (kp - 512) >> 7; if (c >= 512 && ((c - 512) >> 7) == g) v = p.in[15][(size_t)g * 16384 + ((kp - 512) & 127) * 128 + ((c - 512) & 127)]; }
      d[i] = f2bf(v);
    }
  }
#pragma unroll 1
  for (int which = 0; which < 2; ++which) {
    const int H = which ? 2048 : 128, N = 2 * H, lg = which ? 9 : 5;
    u16* d = (u16*)(p.ws + (which ? OFF_D4096 : OFF_D256));
    const float invN = 1.0f / (float)N;
    for (size_t i = gt; i < ((size_t)H << lg); i += gs) {
      const int k = (int)(i >> lg), np = (int)(i & ((1 << lg) - 1)) * 8;
      const bool is_sin = np >= H;
      const int n = np & (H - 1);
      unsigned w[4];
#pragma unroll
      for (int e = 0; e < 4; ++e) {
        const float x0 = (float)((k * (n + 2 * e)) & (N - 1)) * invN, x1 = (float)((k * (n + 2 * e + 1)) & (N - 1)) * invN;
        const float v0 = is_sin ? __builtin_amdgcn_sinf(x0) : __builtin_amdgcn_cosf(x0);
        const float v1 = is_sin ? __builtin_amdgcn_sinf(x1) : __builtin_amdgcn_cosf(x1);
        w[e] = pack2(v0, v1);
      }
      *(uint4*)(d + (size_t)k * N + np) = make_uint4(w[0], w[1], w[2], w[3]);
    }
  }
}

DI void sym_phase(const Params& p, int vb, int G) {
  const int lane = TIDX & 63, wave = TIDX >> 6;
  const u16* PQT = (const u16*)(p.ws + OFF_PQT);
  u16* PEQO = (u16*)(p.ws + OFF_PEQO);
  u16* AB = (u16*)(p.ws + OFF_AB);
  for (int it = vb * 4 + wave; it < 1024 + 2048; it += G * 4) {
    const bool samp = it < 1024;
    const int H = samp ? 2048 : 128, N = 2 * H;
    int col, n0base, nstep;
    if (samp) { col = it; n0base = lane * 8; nstep = 512; }
    else { col = (it - 1024) * 4 + (lane >> 4); n0base = (lane & 15) * 8; nstep = 128; }
    const u16* Pp = samp ? PQT + (size_t)16 * 512 * 512 + (size_t)col * 8192 : PQT + (size_t)col * 512;
    const u16* Qp = Pp + N;
    u16* Pe = samp ? PEQO + (size_t)16 * 512 * 256 + (size_t)col * 4096 : PEQO + (size_t)col * 256;
    u16* Qo = Pe + H;
    float alt = 0.f;
    for (int n0 = n0base; n0 < H; n0 += nstep) {
      const uint4 pw = *(const uint4*)(Pp + n0), qw = *(const uint4*)(Qp + n0);
      const unsigned pa[4] = {pw.x, pw.y, pw.z, pw.w}, qa[4] = {qw.x, qw.y, qw.z, qw.w};
      float pe[8], qo[8];
#pragma unroll
      for (int e = 0; e < 8; ++e) {
        const float pv = (e & 1) ? __uint_as_float(pa[e >> 1] & 0xffff0000u) : __uint_as_float(pa[e >> 1] << 16);
        const float qv = (e & 1) ? __uint_as_float(qa[e >> 1] & 0xffff0000u) : __uint_as_float(qa[e >> 1] << 16);
        const int n = n0 + e;
        float pm = 0.f, qm = 0.f;
        if (n > 0) { pm = bf2f(Pp[N - n]); qm = bf2f(Qp[N - n]); }
        pe[e] = pv + pm;
        qo[e] = (n > 0) ? qv - qm : 0.f;
        alt += (e & 1) ? -pe[e] : pe[e];
      }
      *(uint4*)(Pe + n0) = make_uint4(pack2(pe[0], pe[1]), pack2(pe[2], pe[3]), pack2(pe[4], pe[5]), pack2(pe[6], pe[7]));
      *(uint4*)(Qo + n0) = make_uint4(pack2(qo[0], qo[1]), pack2(qo[2], qo[3]), pack2(qo[4], qo[5]), pack2(qo[6], qo[7]));
    }
    alt += __shfl_xor(alt, 1); alt += __shfl_xor(alt, 2); alt += __shfl_xor(alt, 4); alt += __shfl_xor(alt, 8);
    if (samp) { alt += __shfl_xor(alt, 16); alt += __shfl_xor(alt, 32); }
    if ((samp && lane == 0) || (!samp && (lane & 15) == 0)) {
      const float fh = alt + bf2f(Pp[H]);
      size_t row; int c; float norm;
      if (samp) { row = (size_t)4096 + (size_t)(col >> 9) * 4096 + 2048; c = col & 511; norm = 0.0013810679320049757f; }
      else { row = (size_t)(col >> 9) * 256 + 128; c = col & 511; norm = 0.005524271728019903f; }
      AB[row * 1024 + 512 + c] = f2bf(fh * norm);
    }
  }
}

DI void normmod_phase(const Params& p, int vb, int G, const float* xp, const float* xs, const float* gain, int l, int which) {
  const int lane = TIDX & 63, wave = TIDX >> 6;
  u16* H = (u16*)(p.ws + OFF_H);
  const float* mods = (const float*)(p.ws + OFF_MODS) + (size_t)l * 3 * 6144;
  for (int row = vb * 4 + wave; row < T; row += G * 4) {
    const float* x = (row < 4096) ? xp + (size_t)row * 1024 : xs + (size_t)(row - 4096) * 1024;
    float4 v[4];
    float ss = 0.f;
#pragma unroll
    for (int i = 0; i < 4; ++i) {
      v[i] = *(const float4*)(x + i * 256 + lane * 4);
      ss += v[i].x * v[i].x + v[i].y * v[i].y + v[i].z * v[i].z + v[i].w * v[i].w;
    }
    ss = wave_sum(ss);
    const float rinv = rsqrtf(ss * (1.0f / 1024.0f) + EPS);
    const float* md = mods + cond_of(row) * 6144 + which * 3072;
#pragma unroll
    for (int i = 0; i < 4; ++i) {
      const int c = i * 256 + lane * 4;
      const float4 g = *(const float4*)(gain + c);
      const float4 sh = *(const float4*)(md + c);
      const float4 sc = *(const float4*)(md + 1024 + c);
      const float o0 = v[i].x * rinv * g.x * (1.f + sc.x) + sh.x;
      const float o1 = v[i].y * rinv * g.y * (1.f + sc.y) + sh.y;
      const float o2 = v[i].z * rinv * g.z * (1.f + sc.z) + sh.z;
      const float o3 = v[i].w * rinv * g.w * (1.f + sc.w) + sh.w;
      uint2 w; w.x = pack2(o0, o1); w.y = pack2(o2, o3);
      *(uint2*)(H + (size_t)row * 1024 + c) = w;
    }
  }
}

template <class Epi>
DI void gemm_phase(const u16* A, int lda, const u16* Bt, int ldb, int K, int M, int N, Epi epi, int vb, int G, char* lds) {
  const int nN = N >> 7, nt = (M >> 7) * nN, grp = 8 * nN;
  for (int t = vb; t < nt; t += G) {
    const int gi = t / grp, rem = t - gi * grp;
    gemm_tile(A, lda, Bt, ldb, K, (gi * 8 + (rem & 7)) << 7, (rem >> 3) << 7, epi, lds);
  }
}

DI void pool_phase(const Params& p, int vb, int G) {
  const u16* UA = (const u16*)(p.ws + OFF_UA);
  u16* AB = (u16*)(p.ws + OFF_AB);
  const size_t gt = (size_t)vb * 256 + TIDX, gs = (size_t)G * 256;
  for (size_t i = gt; i < (size_t)T * 64; i += gs) {
    const int t = (int)(i >> 6), c8 = (int)(i & 63) * 8;
    const int g = c8 >> 7, hw = 1 << g;
    int nl, N, base;
    if (t < 4096) { nl = t & 255; N = 256; base = t - nl; } else { nl = (t - 4096) & 4095; N = 4096; base = t - nl; }
    const int lo = max(nl - hw, 0), hi = min(nl + hw, N);
    float s[8] = {0, 0, 0, 0, 0, 0, 0, 0};
    for (int j = lo; j < hi; ++j) {
      const uint4 w = *(const uint4*)(UA + (size_t)(base + j) * 512 + c8);
      s[0] += __uint_as_float(w.x << 16); s[1] += __uint_as_float(w.x & 0xffff0000u);
      s[2] += __uint_as_float(w.y << 16); s[3] += __uint_as_float(w.y & 0xffff0000u);
      s[4] += __uint_as_float(w.z << 16); s[5] += __uint_as_float(w.z & 0xffff0000u);
      s[6] += __uint_as_float(w.w << 16); s[7] += __uint_as_float(w.w & 0xffff0000u);
    }
    const float inv = 1.0f / (float)(hi - lo);
    const uint4 w = *(const uint4*)(UA + (size_t)t * 512 + c8);
    uint4 o;
    o.x = pack2(s[0] * inv - __uint_as_float(w.x << 16), s[1] * inv - __uint_as_float(w.x & 0xffff0000u));
    o.y = pack2(s[2] * inv - __uint_as_float(w.y << 16), s[3] * inv - __uint_as_float(w.y & 0xffff0000u));
    o.z = pack2(s[4] * inv - __uint_as_float(w.z << 16), s[5] * inv - __uint_as_float(w.z & 0xffff0000u));
    o.w = pack2(s[6] * inv - __uint_as_float(w.w << 16), s[7] * inv - __uint_as_float(w.w & 0xffff0000u));
    *(uint4*)(AB + (size_t)t * 1024 + c8) = o;
  }
}

DI void qkvpost_phase(const Params& p, int vb, int G) {
  const int lane = TIDX & 63, wave = TIDX >> 6;
  const int q = lane & 15, sub = lane >> 4;
  const u16* QKV = (const u16*)(p.ws + OFF_QKV);
  u16* CQ = (u16*)(p.ws + OFF_CQ); u16* DQ = (u16*)(p.ws + OFF_DQ);
  u16* CKP = (u16*)(p.ws + OFF_CKP); u16* CKS = (u16*)(p.ws + OFF_CKS);
  u16* DKP = (u16*)(p.ws + OFF_DKP); u16* DKS = (u16*)(p.ws + OFF_DKS);
  float* nck = p.out + OUT_NCK; float* ndk = p.out + OUT_NDK;
  const int d0 = q * 4;
  float fr[4];
#pragma unroll
  for (int e = 0; e < 4; ++e) fr[e] = exp2f(-(float)((d0 + e) & 15) * (13.287712379549449f / 16.0f));
  const bool firsthalf = ((d0 >> 4) & 1) == 0;
  for (int t = vb * 4 + wave; t < T; t += G * 4) {
    const bool samp = t >= 4096;
    int b, nl;
    if (!samp) { b = t >> 8; nl = t & 255; } else { b = (t - 4096) >> 12; nl = (t - 4096) & 4095; }
    float cs[4], sn[4];
    if (samp) {
      const float pos = (d0 < 32) ? (float)(nl >> 6) : (float)(nl & 63);
#pragma unroll
      for (int e = 0; e < 4; ++e) { const float a = pos * fr[e]; cs[e] = cosf(a); sn[e] = sinf(a); }
    } else {
#pragma unroll
      for (int e = 0; e < 4; ++e) { cs[e] = 1.f; sn[e] = 0.f; }
    }
    for (int rd = 0; rd < 7; ++rd) {
      const int slot = rd * 4 + sub;
      const bool act = slot < 26;
      const int vi = act ? (slot < 16 ? slot : slot + 8) : 0;
      const uint2 raw = *(const uint2*)(QKV + (size_t)t * 2304 + vi * 64 + d0);
      float x[4] = {__uint_as_float(raw.x << 16), __uint_as_float(raw.x & 0xffff0000u), __uint_as_float(raw.y << 16), __uint_as_float(raw.y & 0xffff0000u)};
      float ss = x[0] * x[0] + x[1] * x[1] + x[2] * x[2] + x[3] * x[3];
      ss += __shfl_xor(ss, 1); ss += __shfl_xor(ss, 2); ss += __shfl_xor(ss, 4); ss += __shfl_xor(ss, 8);
      const float rinv = rsqrtf(ss * (1.0f / 64.0f) + EPS);
      const float* gp = (vi < 8) ? p.in[18] : (vi < 16) ? p.in[19] : (vi < 32) ? p.in[25] : p.in[26];
      const float4 g = *(const float4*)(gp + d0);
      float y[4] = {x[0] * rinv * g.x, x[1] * rinv * g.y, x[2] * rinv * g.z, x[3] * rinv * g.w};
      float o[4];
#pragma unroll
      for (int e = 0; e < 4; ++e) {
        const float part = __shfl_xor(y[e], 4);
        o[e] = firsthalf ? (y[e] * cs[e] - part * sn[e]) : (y[e] * cs[e] + part * sn[e]);
      }
      if (!act) continue;
      const bool isq = (vi < 8) || (vi >= 24 && vi < 32);
      if (isq) {
        const int hd = (vi < 8) ? vi : vi - 24;
        u16* base = (vi < 8) ? CQ : DQ;
        size_t off = samp ? (size_t)16 * 8 * 256 * 64 + ((size_t)(b * 8 + hd) * 4096 + nl) * 64 : ((size_t)(b * 8 + hd) * 256 + nl) * 64;
        uint2 w; w.x = pack2(o[0] * QSCALE, o[1] * QSCALE); w.y = pack2(o[2] * QSCALE, o[3] * QSCALE);
        *(uint2*)(base + off + d0) = w;
      } else if (vi < 16) {
        const int hm = vi - 8;
        uint2 w; w.x = pack2(o[0], o[1]); w.y = pack2(o[2], o[3]);
        if (samp) *(uint2*)(CKS + ((size_t)(b * 8 + hm) * 4608 + 512 + nl) * 64 + d0) = w;
        else {
          *(uint2*)(CKP + ((size_t)(b * 8 + hm) * 256 + nl) * 64 + d0) = w;
          *(float4*)(nck + (size_t)t * 512 + hm * 64 + d0) = make_float4(o[0], o[1], o[2], o[3]);
        }
      } else {
        const int j = vi - 32;
        uint2 w; w.x = pack2(o[0], o[1]); w.y = pack2(o[2], o[3]);
        if (samp) *(uint2*)(DKS + ((size_t)(b * 2 + j) * 4608 + 512 + nl) * 64 + d0) = w;
        else {
          *(uint2*)(DKP + ((size_t)(b * 2 + j) * 256 + nl) * 64 + d0) = w;
          *(float4*)(ndk + (size_t)t * 128 + j * 64 + d0) = make_float4(o[0], o[1], o[2], o[3]);
        }
      }
    }
  }
  const size_t gt = (size_t)vb * 256 + TIDX, gs = (size_t)G * 256;
  {
    u16* CVTS = (u16*)(p.ws + OFF_CVTS); u16* DVTS = (u16*)(p.ws + OFF_DVTS);
    for (size_t i = gt; i < (size_t)2 * 512 * 512; i += gs) {
      const int b = (int)(i >> 18), key = (int)(i >> 9) & 511, c = (int)(i & 511);
      CKS[((size_t)(b * 8 + (c >> 6)) * 4608 + key) * 64 + (c & 63)] = f2bf(p.in[3][i]);
    }
    for (size_t i = gt; i < (size_t)2 * 512 * 512; i += gs) {
      const int b = (int)(i >> 18), c = (int)(i >> 9) & 511, key = (int)(i & 511);
      CVTS[((size_t)(b * 512 + c)) * 4608 + key] = f2bf(p.in[4][((size_t)b * 512 + key) * 512 + c]);
    }
    for (size_t i = gt; i < (size_t)2 * 512 * 128; i += gs) {
      const int b = (int)(i >> 16), key = (int)(i >> 7) & 511, c = (int)(i & 127);
      DKS[((size_t)(b * 2 + (c >> 6)) * 4608 + key) * 64 + (c & 63)] = f2bf(p.in[5][i]);
    }
    for (size_t i = gt; i < (size_t)2 * 128 * 512; i += gs) {
      const int b = (int)(i >> 16), c = (int)(i >> 9) & 127, key = (int)(i & 511);
      DVTS[((size_t)(b * 128 + c)) * 4608 + key] = f2bf(p.in[6][((size_t)b * 512 + key) * 128 + c]);
    }
  }
}

template <int DV>
DI void attn_item(const u16* Q, const u16* Kb, const u16* Vt, int ldv, int nt0, int key1, int nt1,
                  bool masked, int qpos0, bool has_sink, float sink2, u16* out, int ldo, char* lds) {
  constexpr int NDB = DV / 32;
  constexpr int KVBUF = (64 + DV) * LROW;
  const int tid = TIDX, lane = tid & 63, wave = tid >> 6;
  const int r = lane & 31, h = lane >> 5;
  const int nt = nt0 + nt1;
  bf16x8 qf[4];
#pragma unroll
  for (int ks = 0; ks < 4; ++ks) qf[ks] = *(const bf16x8*)(Q + (size_t)(wave * 32 + r) * 64 + ks * 16 + h * 8);
  f32x16 O[NDB];
#pragma unroll
  for (int i = 0; i < NDB; ++i)
#pragma unroll
    for (int e = 0; e < 16; ++e) O[i][e] = 0.f;
  float mrun = has_sink ? sink2 : -1e30f;
  float lrun = has_sink ? (h == 0 ? 1.f : 0.f) : 0.f;
  const int lrow = tid >> 3, lpart = (tid & 7) * 8;
  uint4 rk0, rk1, rv0, rv1, rv2, rv3;
  rv2 = rv3 = make_uint4(0, 0, 0, 0);
  const u16* gk = Kb + (size_t)lrow * 64 + lpart;
  const u16* gv = Vt + (size_t)lrow * ldv + lpart;
#define ATT_GLOAD(key0_)                                                         \
  do {                                                                           \
    rk0 = *(const uint4*)(gk + (size_t)(key0_) * 64);                            \
    rk1 = *(const uint4*)(gk + (size_t)((key0_) + 32) * 64);                     \
    rv0 = *(const uint4*)(gv + (key0_));                                         \
    rv1 = *(const uint4*)(gv + (size_t)32 * ldv + (key0_));                      \
    if constexpr (DV == 128) {                                                   \
      rv2 = *(const uint4*)(gv + (size_t)64 * ldv + (key0_));                    \
      rv3 = *(const uint4*)(gv + (size_t)96 * ldv + (key0_));                    \
    }                                                                            \
  } while (0)
#define ATT_SSTORE(boff_)                                                        \
  do {                                                                           \
    *(uint4*)(sw + (boff_)) = rk0;                                               \
    *(uint4*)(sw + (boff_) + 32 * LROW) = rk1;                                   \
    *(uint4*)(sw + (boff_) + 64 * LROW) = rv0;                                   \
    *(uint4*)(sw + (boff_) + 96 * LROW) = rv1;                                   \
    if constexpr (DV == 128) {                                                   \
      *(uint4*)(sw + (boff_) + 128 * LROW) = rv2;                                \
      *(uint4*)(sw + (boff_) + 160 * LROW) = rv3;                                \
    }                                                                            \
  } while (0)
  char* sw = lds + lrow * LROW + lpart * 2;
  {
    const int key0 = (nt0 > 0) ? 0 : key1;
    ATT_GLOAD(key0);
  }
  ATT_SSTORE(0);
  __syncthreads();
  const int pr = (r & 0x13) | ((r & 4) << 1) | ((r & 8) >> 1);
  const char* fk = lds + pr * LROW + h * 16;
  const char* fv = lds + 64 * LROW + r * LROW + h * 16;
  const int qpos = qpos0 + wave * 32 + r;
  for (int t = 0; t < nt; ++t) {
    const int cur = (t & 1) * KVBUF;
    const int key0 = (t < nt0) ? t * 64 : key1 + (t - nt0) * 64;
    {
      const int tn = (t + 1 < nt) ? t + 1 : t;
      const int kn = (tn < nt0) ? tn * 64 : key1 + (tn - nt0) * 64;
      ATT_GLOAD(kn);
    }
    f32x16 S[2];
#pragma unroll
    for (int kb = 0; kb < 2; ++kb) {
#pragma unroll
      for (int e = 0; e < 16; ++e) S[kb][e] = 0.f;
#pragma unroll
      for (int ks = 0; ks < 4; ++ks) {
        const bf16x8 kf = *(const bf16x8*)(fk + cur + kb * 32 * LROW + ks * 32);
        S[kb] = MFMA(kf, qf[ks], S[kb]);
      }
    }
    if (masked && t >= nt0) {
#pragma unroll
      for (int kb = 0; kb < 2; ++kb)
#pragma unroll
        for (int e = 0; e < 16; ++e) {
          const int jpos = key0 - 512 + kb * 32 + 16 * (e >> 3) + 8 * h + (e & 7);
          const int dlt = qpos - jpos;
          if (dlt > 128 || dlt < -128) S[kb][e] = -1e30f;
        }
    }
    float mloc = S[0][0];
#pragma unroll
    for (int kb = 0; kb < 2; ++kb)
#pragma unroll
      for (int e = 0; e < 16; ++e) mloc = fmaxf(mloc, S[kb][e]);
    mloc = fmaxf(mloc, __shfl_xor(mloc, 32));
    const float mnew = fmaxf(mrun, mloc);
    const float alpha = __builtin_amdgcn_exp2f(mrun - mnew);
    mrun = mnew;
    float ps = 0.f;
#pragma unroll
    for (int kb = 0; kb < 2; ++kb)
#pragma unroll
      for (int e = 0; e < 16; ++e) { const float pv = __builtin_amdgcn_exp2f(S[kb][e] - mnew); S[kb][e] = pv; ps += pv; }
    lrun = lrun * alpha + ps;
#pragma unroll
    for (int i = 0; i < NDB; ++i)
#pragma unroll
      for (int e = 0; e < 16; ++e) O[i][e] *= alpha;
    bf16x8 pf[4];
#pragma unroll
    for (int jj = 0; jj < 4; ++jj) {
      const int kb = jj >> 1, o8 = (jj & 1) * 8;
      uint4 w;
      w.x = pack2(S[kb][o8 + 0], S[kb][o8 + 1]); w.y = pack2(S[kb][o8 + 2], S[kb][o8 + 3]);
      w.z = pack2(S[kb][o8 + 4], S[kb][o8 + 5]); w.w = pack2(S[kb][o8 + 6], S[kb][o8 + 7]);
      pf[jj] = __builtin_bit_cast(bf16x8, w);
    }
    __builtin_amdgcn_sched_barrier(0);
#pragma unroll
    for (int i = 0; i < NDB; ++i) {
#pragma unroll
      for (int jj = 0; jj < 4; ++jj) {
        const bf16x8 vf = *(const bf16x8*)(fv + cur + i * 32 * LROW + jj * 32);
        O[i] = MFMA(vf, pf[jj], O[i]);
      }
      if (i & 1) __builtin_amdgcn_sched_barrier(0);
    }
    ATT_SSTORE(KVBUF - cur);
    __syncthreads();
  }
#undef ATT_GLOAD
#undef ATT_SSTORE
  const float ltot = lrun + __shfl_xor(lrun, 32);
  const float inv = 1.0f / ltot;
  u16* op = out + (size_t)(wave * 32 + r) * ldo;
#pragma unroll
  for (int i = 0; i < NDB; ++i)
#pragma unroll
    for (int qd = 0; qd < 4; ++qd) {
      uint2 w;
      w.x = pack2(O[i][4 * qd] * inv, O[i][4 * qd + 1] * inv);
      w.y = pack2(O[i][4 * qd + 2] * inv, O[i][4 * qd + 3] * inv);
      *(uint2*)(op + i * 32 + 8 * qd + 4 * h) = w;
    }
}

DI void attention_phase(const Params& p, int vb, int G, char* lds) {
  const u16* CQ = (const u16*)(p.ws + OFF_CQ); const u16* DQ = (const u16*)(p.ws + OFF_DQ);
  const u16* CKP = (const u16*)(p.ws + OFF_CKP); const u16* CKS = (const u16*)(p.ws + OFF_CKS);
  const u16* CVTP = (const u16*)(p.ws + OFF_CVTP); const u16* CVTS = (const u16*)(p.ws + OFF_CVTS);
  const u16* DKP = (const u16*)(p.ws + OFF_DKP); const u16* DKS = (const u16*)(p.ws + OFF_DKS);
  const u16* DVTP = (const u16*)(p.ws + OFF_DVTP); const u16* DVTS = (const u16*)(p.ws + OFF_DVTS);
  u16* OM = (u16*)(p.ws + OFF_OM); u16* AC = (u16*)(p.ws + OFF_H);
  constexpr size_t QS = (size_t)16 * 8 * 256 * 64;
  for (int it = vb; it < 1536; it += G) {
    const bool diff = (it < 512) || (it >= 1024 && it < 1280);
    const bool samp = it < 1024;
    int qb, hd, b;
    if (samp) { const int i2 = it & 511; qb = i2 & 31; hd = (i2 >> 5) & 7; b = i2 >> 8; }
    else { const int i2 = (it - 1024) & 255; qb = i2 & 1; hd = (i2 >> 1) & 7; b = i2 >> 4; }
    const int nseq = samp ? 4096 : 256, nkeys = samp ? 4608 : 256;
    const int tok = samp ? 4096 + b * 4096 + qb * 128 : b * 256 + qb * 128;
    const size_t qoff = (samp ? QS : 0) + ((size_t)(b * 8 + hd) * nseq + qb * 128) * 64;
    if (diff) {
      const u16* Kp = (samp ? CKS : CKP) + (size_t)(b * 8 + hd) * nkeys * 64;
      const u16* Vp = (samp ? CVTS : CVTP) + (size_t)(b * 4 + (hd >> 1)) * 128 * nkeys;
      attn_item<128>(CQ + qoff, Kp, Vp, nkeys, nkeys >> 6, 0, 0, false, 0, false, 0.f, OM + (size_t)tok * 1024 + hd * 128, 1024, lds);
    } else {
      const u16* Kp = (samp ? DKS : DKP) + (size_t)(b * 2 + (hd >> 2)) * nkeys * 64;
      const u16* Vp = (samp ? DVTS : DVTP) + (size_t)(b * 2 + (hd >> 2)) * 64 * nkeys;
      int nt0 = 4, key1 = 0, nt1 = 0;
      if (samp) { const int lo = min(max(qb * 128 - 128, 0), 4096 - 384); nt0 = 8; key1 = 512 + lo; nt1 = 6; }
      attn_item<64>(DQ + qoff, Kp, Vp, nkeys, nt0, key1, nt1, samp, qb * 128, true, p.in[27][hd] * LOG2E, AC + (size_t)tok * 1024 + 512 + hd * 64, 1024, lds);
    }
  }
}

DI void combine_phase(const Params& p, int vb, int G) {
  const int lane = TIDX & 63, wave = TIDX >> 6;
  const float a = wave_sum(p.in[20][lane] * p.in[21][lane]);
  const float bsum = wave_sum(p.in[22][lane] * p.in[23][lane]);
  const float lam = expf(a) - expf(bsum) + LAM_INIT;
  const u16* OM = (const u16*)(p.ws + OFF_OM);
  u16* AC = (u16*)(p.ws + OFF_H);
  const int hh = lane >> 4, e0 = (lane & 15) * 8;
  float g[8];
#pragma unroll
  for (int e = 0; e < 8; ++e) g[e] = p.in[24][e0 + e] * (1.0f - LAM_INIT);
  for (int t = vb * 4 + wave; t < T; t += G * 4) {
    const uint4 w0 = *(const uint4*)(OM + (size_t)t * 1024 + (hh * 2) * 128 + e0);
    const uint4 w1 = *(const uint4*)(OM + (size_t)t * 1024 + (hh * 2 + 1) * 128 + e0);
    const unsigned a0[4] = {w0.x, w0.y, w0.z, w0.w}, a1[4] = {w1.x, w1.y, w1.z, w1.w};
    float d[8];
    float ss = 0.f;
#pragma unroll
    for (int e = 0; e < 4; ++e) {
      d[2 * e] = __uint_as_float(a0[e] << 16) - lam * __uint_as_float(a1[e] << 16);
      d[2 * e + 1] = __uint_as_float(a0[e] & 0xffff0000u) - lam * __uint_as_float(a1[e] & 0xffff0000u);
      ss += d[2 * e] * d[2 * e] + d[2 * e + 1] * d[2 * e + 1];
    }
    ss += __shfl_xor(ss, 1); ss += __shfl_xor(ss, 2); ss += __shfl_xor(ss, 4); ss += __shfl_xor(ss, 8);
    const float rinv = rsqrtf(ss * (1.0f / 128.0f) + EPS);
    uint4 o;
    o.x = pack2(d[0] * rinv * g[0], d[1] * rinv * g[1]); o.y = pack2(d[2] * rinv * g[2], d[3] * rinv * g[3]);
    o.z = pack2(d[4] * rinv * g[4], d[5] * rinv * g[5]); o.w = pack2(d[6] * rinv * g[6], d[7] * rinv * g[7]);
    *(uint4*)(AC + (size_t)t * 1024 + hh * 128 + e0) = o;
  }
}


namespace pg8 {
#define PG8_LAS __attribute__((address_space(3)))
typedef unsigned short bf16_t;
typedef short bf16x8 __attribute__((ext_vector_type(8)));
typedef float f32x4 __attribute__((ext_vector_type(4)));
typedef unsigned u32x4 __attribute__((ext_vector_type(4)));
constexpr int BM = 256, BK = 64, HALF = 128, HTB = HALF * BK * 2  , STAGE_BYTES = 8 * HTB, NXCD = 8, WGM = 8;

__host__ __device__ __forceinline__ int lds_byte(int r, int c) { const int st = (r >> 4) * 2 + (c >> 5), rr = r & 15, cc = c & 31, ob = rr * 64 + cc * 2; return st * 1024 + (ob ^ (((ob >> 9) & 1) << 5)); }
__host__ __device__ __forceinline__ void stage_rc(int b, int& R, int& C) { const int st = b / 1024, sb = b % 1024, swz = sb ^ (((sb >> 9) & 1) << 5); R = (st >> 1) * 16 + swz / 64; C = (st & 1) * 32 + (swz % 64) / 2; }
__host__ __device__ __forceinline__ int perm32(int rho) { const int n = rho >> 4, i = rho & 15; return 8 * (i >> 2) + 4 * n + (i & 3); }

struct Unit { int pm, pn; };
struct Gemm { const bf16_t* A; const bf16_t* Bt; int M, N, K; };

struct StaticOrder {
    int nM, nN, nwg, G, c;
    __host__ __device__ void init(int M, int N, int G_, int c_) { nM = M / BM; nN = N / BM; nwg = nM * nN; G = G_; c = c_; }
    __host__ __device__ bool next(int i, Unit& u) const {
        const long L = (long)i * G + c; if (L >= nwg) return false;
        int wgid = (int)L; { const int q = nwg / NXCD, r = nwg % NXCD, xcd = wgid % NXCD, off = wgid / NXCD; wgid = (xcd < r ? xcd * (q + 1) : r * (q + 1) + (xcd - r) * q) + off; }
        const int nig = WGM * nN, gid = wgid / nig, fm = gid * WGM, gsz = (nM - fm) < WGM ? (nM - fm) : WGM;
        u.pm = fm + ((wgid % nig) % gsz); u.pn = (wgid % nig) / gsz; return true;
    }
    __device__ __forceinline__ void a_ready(const Unit&) const {}
    __device__ __forceinline__ void done(const Unit&) const {}
};
template <class Epi, class Sched, bool STAMP = false, int MB = 4>
__device__ __forceinline__ void gemm_phase(PG8_LAS unsigned char* lds, const Gemm g, const Sched& S, const Epi& E, unsigned long long* stamps) {
    const int tid = threadIdx.x, wid = __builtin_amdgcn_readfirstlane(tid >> 6), lane = tid & 63, wr = wid >> 2, wc = wid & 3, fr = lane & 15, fq = lane >> 4;
    const int K = g.K, nt = K / BK;
    int ts_lo = 0, ts_hi = 0, nts = 0; const unsigned long long rt_entry = STAMP ? (unsigned long long)wall_clock64() : 0ull;
#define PG8_STAMP() do { if (STAMP && wid == 0 && nts < 64) { const unsigned long long _c = (unsigned long long)clock64(); \
        ts_lo = (lane == nts) ? (int)(unsigned)_c : ts_lo; ts_hi = (lane == nts) ? (int)(unsigned)(_c >> 32) : ts_hi; ++nts; } } while (0)
    PG8_STAMP();
    unsigned voffA[2], voffB[2];
#pragma unroll
    for (int i = 0; i < 2; ++i) { int R, C; stage_rc(tid * 16 + i * 8192, R, C); const int Rb = Epi::PERM ? ((R & ~31) + perm32(R & 31)) : R;
        voffA[i] = (unsigned)(R * K + C) * 2u; voffB[i] = (unsigned)(Rb * K + C) * 2u; }
    const size_t kstep = (size_t)(BK * 2);
    const size_t hstep = (size_t)HALF * K * 2; const size_t hstepA = (size_t)(32 * MB) * K * 2;
    const size_t tstep = 2 * hstep; const size_t tstepA = 2 * hstepA;
    const unsigned ldsw = (unsigned)wid * 1024u;
    const int aoff = lds_byte(wr * 16 * MB + fr, fq * 8), boff = lds_byte(wc * 32 + fr, fq * 8);
#define PG8_SA(b, h) (((b) * 2 + (h)) * HTB)
#define PG8_SB(b, h) ((4 + (b) * 2 + (h)) * HTB)
#define PG8_STAGE(bufoff, gbase, voff) do { _Pragma("unroll") for (int _i = 0; _i < 2; ++_i) \
        __builtin_amdgcn_global_load_lds((const unsigned*)((const char*)(gbase) + (voff)[_i]), (PG8_LAS unsigned*)(lds + (bufoff) + ldsw + _i * 8192), 16, 0, 0); } while (0)
#define PG8_LDA(dst, b, h) do { _Pragma("unroll") for (int m = 0; m < MB; ++m) _Pragma("unroll") for (int k = 0; k < 2; ++k) dst[m][k] = *(const PG8_LAS bf16x8*)(lds + PG8_SA(b, h) + aoff + m * 2048 + k * 1024); } while (0)
#define PG8_LDB(dst, b, h) do { _Pragma("unroll") for (int n = 0; n < 2; ++n) _Pragma("unroll") for (int k = 0; k < 2; ++k) dst[n][k] = *(const PG8_LAS bf16x8*)(lds + PG8_SB(b, h) + boff + n * 2048 + k * 1024); } while (0)
#define PG8_MMA(ai, bj, At, Bt) do { __builtin_amdgcn_s_setprio(1); _Pragma("unroll") for (int m = 0; m < MB; ++m) _Pragma("unroll") for (int n = 0; n < 2; ++n) _Pragma("unroll") for (int k = 0; k < 2; ++k) \
        acc[ai][bj][m][n] = __builtin_amdgcn_mfma_f32_16x16x32_bf16(Bt[n][k], At[m][k], acc[ai][bj][m][n], 0, 0, 0); __builtin_amdgcn_s_setprio(0); } while (0)
#define PG8_WAIT_V(n) asm volatile("s_waitcnt vmcnt(" #n ")" ::: "memory")
#define PG8_WAIT_L(n) asm volatile("s_waitcnt lgkmcnt(" #n ")" ::: "memory")
#define PG8_BAR __builtin_amdgcn_s_barrier()
#define PG8_SCHED __builtin_amdgcn_sched_barrier(0)
    Unit cur, nxt; int ui = 0;
    if (!S.next(0, cur)) return;
    f32x4 acc[2][2][MB][2];
#pragma unroll
    for (int a = 0; a < 2; ++a)
#pragma unroll
        for (int b = 0; b < 2; ++b)
#pragma unroll
            for (int m = 0; m < MB; ++m)
#pragma unroll
                for (int n = 0; n < 2; ++n) acc[a][b][m][n] = (f32x4){0.f, 0.f, 0.f, 0.f};
    bf16x8 At[MB][2], B0[2][2], B1[2][2];
    const char* cA = (const char*)g.A + (size_t)cur.pm * tstepA; const char* cB = (const char*)g.Bt + (size_t)cur.pn * tstep;
    S.a_ready(cur);
    PG8_STAGE(PG8_SB(0, 0), cB, voffB); PG8_STAGE(PG8_SA(0, 0), cA, voffA); PG8_STAGE(PG8_SB(0, 1), cB + hstep, voffB); PG8_STAGE(PG8_SA(0, 1), cA + hstepA, voffA);
    if (wr == 1) PG8_BAR;
    PG8_WAIT_V(4); PG8_BAR;
    PG8_STAGE(PG8_SB(1, 0), cB + kstep, voffB); PG8_STAGE(PG8_SA(1, 0), cA + kstep, voffA); PG8_STAGE(PG8_SB(1, 1), cB + hstep + kstep, voffB);
    PG8_WAIT_V(6); PG8_BAR;
    PG8_STAMP();
    for (;;) {
        const bool has_next = S.next(ui + 1, nxt);
        const char* nA = has_next ? (const char*)g.A + (size_t)nxt.pm * tstepA : cA; const char* nB = has_next ? (const char*)g.Bt + (size_t)nxt.pn * tstep : cB;
        for (int t = 0; t < nt; t += 2) {
            const bool last = (t == nt - 2);
            const char* a1 = cA + (size_t)(t + 1) * kstep;
            const char* a2 = last ? nA : cA + (size_t)(t + 2) * kstep; const char* b2 = last ? nB : cB + (size_t)(t + 2) * kstep;
            const char* a3 = a2 + kstep; const char* b3 = b2 + kstep;
            if (last && has_next) S.a_ready(nxt);
            PG8_LDB(B0, 0, 0); PG8_SCHED; PG8_LDA(At, 0, 0); PG8_STAGE(PG8_SA(1, 1), a1 + hstepA, voffA);
            PG8_WAIT_L(8); PG8_BAR; PG8_WAIT_L(0); PG8_MMA(0, 0, At, B0); PG8_BAR; PG8_SCHED;
            PG8_LDB(B1, 0, 1); PG8_STAGE(PG8_SB(0, 0), b2, voffB);
            PG8_BAR; PG8_WAIT_L(0); PG8_MMA(0, 1, At, B1); PG8_BAR;
            PG8_LDA(At, 0, 1); PG8_STAGE(PG8_SA(0, 0), a2, voffA);
            PG8_BAR; PG8_WAIT_L(0); PG8_MMA(1, 0, At, B0); PG8_BAR; PG8_SCHED;
            PG8_STAGE(PG8_SB(0, 1), b2 + hstep, voffB);
            PG8_WAIT_V(6); PG8_BAR; PG8_MMA(1, 1, At, B1); PG8_BAR;
            PG8_LDB(B0, 1, 0); PG8_SCHED; PG8_LDA(At, 1, 0); PG8_STAGE(PG8_SA(0, 1), a2 + hstepA, voffA);
            PG8_WAIT_L(8); PG8_BAR; PG8_WAIT_L(0); PG8_MMA(0, 0, At, B0); PG8_BAR; PG8_SCHED;
            PG8_LDB(B1, 1, 1); PG8_STAGE(PG8_SB(1, 0), b3, voffB);
            PG8_BAR; PG8_WAIT_L(0); PG8_MMA(0, 1, At, B1); PG8_BAR;
            PG8_LDA(At, 1, 1); PG8_STAGE(PG8_SA(1, 0), a3, voffA);
            PG8_BAR; PG8_WAIT_L(0); PG8_MMA(1, 0, At, B0); PG8_BAR; PG8_SCHED;
            PG8_STAGE(PG8_SB(1, 1), b3 + hstep, voffB);
            PG8_WAIT_V(6); PG8_BAR; PG8_MMA(1, 1, At, B1); PG8_BAR;
        }
        PG8_STAMP();
        if constexpr (!Epi::AFTER_DRAIN) { E(acc, cur, wr, wc, fr, fq); S.done(cur); }
        PG8_STAMP();
        if (!has_next) break;
#pragma unroll
        for (int a = 0; a < 2; ++a)
#pragma unroll
            for (int b = 0; b < 2; ++b)
#pragma unroll
                for (int m = 0; m < MB; ++m)
#pragma unroll
                    for (int n = 0; n < 2; ++n) acc[a][b][m][n] = (f32x4){0.f, 0.f, 0.f, 0.f};
        cur = nxt; cA = nA; cB = nB; ++ui;
    }
    PG8_WAIT_V(0);
    if (wr == 0) PG8_BAR;
    PG8_BAR;
    if constexpr (Epi::AFTER_DRAIN) { E.fused(acc, cur, wr, wc, fr, fq, lds, wid, lane); S.done(cur); }
    PG8_STAMP();
    if (STAMP && wid == 0) { stamps[lane] = lane < nts ? (((unsigned long long)(unsigned)ts_hi << 32) | (unsigned)ts_lo) : 0ull;
        if (lane == 62) stamps[62] = rt_entry; if (lane == 63) stamps[63] = (unsigned long long)wall_clock64(); }
#undef PG8_STAMP
#undef PG8_SA
#undef PG8_SB
#undef PG8_STAGE
#undef PG8_LDA
#undef PG8_LDB
#undef PG8_MMA
#undef PG8_WAIT_V
#undef PG8_WAIT_L
#undef PG8_BAR
#undef PG8_SCHED
}
}

typedef float f32x4 __attribute__((ext_vector_type(4)));
template <class F, int MB> struct RowEpi {
  static constexpr bool PERM = false, AFTER_DRAIN = false;
  F f;
  DI void operator()(const pg8::f32x4 (&acc)[2][2][MB][2], const pg8::Unit& u, int wr, int wc, int fr, int fq) const {
    const int row0 = u.pm * (64 * MB) + wr * 16 * MB + fr, col0 = u.pn * 256 + wc * 32 + 4 * fq;
#pragma unroll
    for (int ai = 0; ai < 2; ++ai)
#pragma unroll
      for (int m = 0; m < MB; ++m)
#pragma unroll
        for (int bj = 0; bj < 2; ++bj)
#pragma unroll
          for (int n = 0; n < 2; ++n) f(row0 + ai * 32 * MB + m * 16, col0 + bj * 128 + n * 16, acc[ai][bj][m][n]);
  }
};
struct FU {
  u16* UA; u16* PQt;
  DI void operator()(int m, int n, pg8::f32x4 v) const {
    if (n < 512) {
      uint2 w; w.x = pack2(v[0], v[1]); w.y = pack2(v[2], v[3]);
      *(uint2*)(UA + (size_t)m * 512 + n) = w;
    } else {
      const int np = n - 512, g = np >> 8, pq = (np >> 7) & 1, mm = np & 127;
      u16* q; size_t st;
      if (m < 4096) { const int b = m >> 8, nl = m & 255; q = PQt + ((size_t)(b * 512 + g * 128 + mm)) * 512 + pq * 256 + nl; st = 512; }
      else { const int ms = m - 4096, b = ms >> 12, nl = ms & 4095; q = PQt + (size_t)16 * 512 * 512 + ((size_t)(b * 512 + g * 128 + mm)) * 8192 + pq * 4096 + nl; st = 8192; }
      q[0] = f2bf(v[0]); q[st] = f2bf(v[1]); q[2 * st] = f2bf(v[2]); q[3 * st] = f2bf(v[3]);
    }
  }
};
struct FRes {
  const float* xin_p; const float* xin_s; float* X; const float* gate;
  DI void operator()(int m, int n, pg8::f32x4 v) const {
    const float* xi = (m < 4096) ? xin_p + (size_t)m * 1024 + n : xin_s + (size_t)(m - 4096) * 1024 + n;
    const float4 x = *(const float4*)xi;
    const float4 g = *(const float4*)(gate + cond_of(m) * 6144 + n);
    *(float4*)(X + (size_t)m * 1024 + n) = make_float4(x.x + g.x * v[0], x.y + g.y * v[1], x.z + g.z * v[2], x.w + g.w * v[3]);
  }
};
struct FRelu2 {
  u16* C;
  DI void operator()(int m, int n, pg8::f32x4 v) const {
    const float a = fmaxf(v[0], 0.f), b = fmaxf(v[1], 0.f), c = fmaxf(v[2], 0.f), d = fmaxf(v[3], 0.f);
    uint2 w; w.x = pack2(a * a, b * b); w.y = pack2(c * c, d * d);
    *(uint2*)(C + (size_t)m * 4096 + n) = w;
  }
};
struct FQkv {
  u16* QKV; u16* CVtP; u16* CVtS; u16* DVtP; u16* DVtS; float* ncv; float* ndv;
  DI void operator()(int m, int n, pg8::f32x4 v) const {
    const bool is_cv = (n >= 1024 && n < 1536), is_dv = (n >= 2176);
    if (!is_cv && !is_dv) {
      uint2 w; w.x = pack2(v[0], v[1]); w.y = pack2(v[2], v[3]);
      *(uint2*)(QKV + (size_t)m * 2304 + n) = w;
      return;
    }
    const int c = is_cv ? n - 1024 : n - 2176;
    const int feat = is_cv ? 512 : 128;
    u16* q; size_t st;
    if (m < 4096) {
      const int b = m >> 8, nl = m & 255;
      q = (is_cv ? CVtP : DVtP) + ((size_t)(b * feat + c)) * 256 + nl; st = 256;
      *(float4*)((is_cv ? ncv : ndv) + (size_t)m * feat + c) = make_float4(v[0], v[1], v[2], v[3]);
    } else {
      const int ms = m - 4096, b = ms >> 12, nl = ms & 4095;
      q = (is_cv ? CVtS : DVtS) + ((size_t)(b * feat + c)) * 4608 + 512 + nl; st = 4608;
    }
    q[0] = f2bf(v[0]); q[st] = f2bf(v[1]); q[2 * st] = f2bf(v[2]); q[3 * st] = f2bf(v[3]);
  }
};
template <int MB, class F>
DI void big_gemm(PG8_LAS unsigned char* lds, const u16* A, const u16* Bt, int M, int N, int K, F f) {
  pg8::Gemm g{A, Bt, M, N, K};
  pg8::StaticOrder S; S.init(M, N, (int)gridDim.x, (int)blockIdx.x);
  S.nM = M / (64 * MB); S.nwg = S.nM * S.nN;
  RowEpi<F, MB> E{f};
  pg8::gemm_phase<RowEpi<F, MB>, pg8::StaticOrder, false, MB>(lds, g, S, E, nullptr);
}

#define XB_TMO      128
#define XB_XCNT(j)  (256  + 64 * (j))
#define XB_XSUB(j)  (1280 + 64 * (j))
#define XB_XGEN(j)  (2304 + 64 * (j))
#define XB_TOP      3328
#define XB_TOPGEN   3392
#define XCD_BAR_WORDS 3456
#define XB_SPIN_CAP (1u << 18)
#define LAS __attribute__((address_space(3)))
DI unsigned xb_ld(unsigned* p)              { return __hip_atomic_load(p, __ATOMIC_RELAXED, __HIP_MEMORY_SCOPE_AGENT); }
DI unsigned xb_add(unsigned* p, unsigned v) { return __hip_atomic_fetch_add(p, v, __ATOMIC_RELAXED, __HIP_MEMORY_SCOPE_AGENT); }
DI unsigned xb_xcc_id() { return (unsigned)__builtin_amdgcn_s_getreg((3 << 11) | 20) & 0xFu; }
#define XB_SPIN(cond, bar) do { unsigned _sp = 0; while (cond) { __builtin_amdgcn_s_sleep(1); \
    if ((++_sp & 255u) == 0u) { if (xb_ld(&(bar)[XB_TMO])) break; if (_sp > XB_SPIN_CAP) { atomicAdd(&(bar)[XB_TMO], 1u); break; } } } } while (0)
struct XcdBarrier { unsigned* bar; unsigned x; volatile LAS unsigned* st; };
DI XcdBarrier xcd_barrier_post(unsigned* bar, volatile LAS unsigned* st) {
  XcdBarrier b; b.bar = bar; b.x = xb_xcc_id(); b.st = st;
  if (threadIdx.x == 0) (void)xb_add(&bar[XB_XCNT(b.x)], 1u);
  return b;
}
DI void xcd_barrier_complete(unsigned* bar, unsigned x, unsigned& nloc, unsigned& nx) {
  const unsigned G = gridDim.x;
  unsigned sum, cnt, mine, sp = 0u;
  for (;;) {
    sum = 0u; cnt = 0u; mine = 0u;
#pragma unroll
    for (unsigned j = 0; j < 16; ++j) { const unsigned c = xb_ld(&bar[XB_XCNT(j)]); sum += c; cnt += (c > 0u) ? 1u : 0u; mine = (j == x) ? c : mine; }
    if (sum == G) break;
    __builtin_amdgcn_s_sleep(1);
    if ((++sp & 255u) == 0u) { if (xb_ld(&bar[XB_TMO])) break; if (sp > XB_SPIN_CAP) { atomicAdd(&bar[XB_TMO], 1u); break; } }
  }
  nloc = mine > 0u ? mine : 1u; nx = cnt > 0u ? cnt : 1u;
}
DI void xcd_barrier(const XcdBarrier& b) {
  asm volatile("s_waitcnt vmcnt(0)" ::: "memory");
  __syncthreads();
  if (threadIdx.x == 0) {
    unsigned* bar = b.bar;
    __builtin_amdgcn_s_waitcnt(0);
    unsigned nloc = b.st[0], nx = b.st[1];
    if (nloc == 0u) { xcd_barrier_complete(bar, b.x, nloc, nx); b.st[0] = nloc; b.st[1] = nx; }
    const unsigned old = xb_add(&bar[XB_XSUB(b.x)], 1u);
    const unsigned gen = old / nloc;
    if (old + 1u == (gen + 1u) * nloc) {
      __builtin_amdgcn_fence(__ATOMIC_RELEASE, "agent");
      asm volatile("s_waitcnt vmcnt(0)" ::: "memory");
      const unsigned og = xb_add(&bar[XB_TOP], 1u);
      const unsigned tg = og / nx;
      if (og + 1u == (tg + 1u) * nx) xb_add(&bar[XB_TOPGEN], 1u);
      else XB_SPIN(xb_ld(&bar[XB_TOPGEN]) == tg, bar);
      __builtin_amdgcn_fence(__ATOMIC_ACQUIRE, "agent");
      xb_add(&bar[XB_XGEN(b.x)], 1u);
      asm volatile("s_waitcnt vmcnt(0)" ::: "memory");
    } else {
      XB_SPIN(xb_ld(&bar[XB_XGEN(b.x)]) == gen, bar);
      __builtin_amdgcn_fence(__ATOMIC_ACQUIRE, "agent");
      asm volatile("s_waitcnt vmcnt(0)" ::: "memory");
    }
  }
  __syncthreads();
}

__global__ void __launch_bounds__(512) fwd_kernel(Params p, int ph_lo, int ph_hi) {
  extern __shared__ __attribute__((aligned(16))) unsigned char shm[];
  const int half = threadIdx.x >> 8;
  char* lds = (char*)shm + half * LDS_BYTES;
  PG8_LAS unsigned char* lds8 = (PG8_LAS unsigned char*)shm;
  const int G = 2 * (int)gridDim.x;
  int vb0 = blockIdx.x;
  if ((gridDim.x & 7) == 0) vb0 = (blockIdx.x & 7) * (gridDim.x >> 3) + (blockIdx.x >> 3);
  const int vb = 2 * vb0 + half;
  unsigned char* ws = p.ws;
  const float* mods = (const float*)(ws + OFF_MODS);
  float* X = p.out + OUT_Y;
  u16* H = (u16*)(ws + OFF_H);

#define RUNPH(n) ((ONLYPH < 0 || ONLYPH == (n)) && ph_lo <= (n) && (n) < ph_hi)
#define REP(n) _Pragma("unroll") for (int rep_ = 0; rep_ < ((DUPPH == (n)) ? 2 : 1); ++rep_)
#define SEAM(n) if (ph_lo < (n) && (n) < ph_hi) xcd_barrier(xb);
  __shared__ uint4 xb_words;
  if (threadIdx.x == 0) xb_words = make_uint4(0u, 0u, 0u, 0u);
  __syncthreads();
  XcdBarrier xb = xcd_barrier_post((unsigned*)(ws + OFF_BAR), (volatile LAS unsigned*)&xb_words);
  if (ph_hi > 1000) cg::this_grid().sync();
  if (RUNPH(0)) REP(0) {
    for (int id = vb; id < 384; id += G) ada_item(p, id, lds);
    prep_transposes(p, vb, G, lds, 0);
    prep_elementwise(p, vb, G);
  }
  SEAM(1)
  if (RUNPH(1)) {
    for (int t = vb; t < 128; t += G) {
      const bool f1 = t < 64;
      const int q = t & 63;
      gemm_tile(f1 ? (const u16*)(ws + OFF_CBD) : (const u16*)(ws + OFF_WOUT_ET), f1 ? 512 : 1024,
                f1 ? (const u16*)(ws + OFF_WINB) : (const u16*)(ws + OFF_BD), f1 ? 512 : 1024, f1 ? 512 : 1024, (q >> 3) << 7, (q & 7) << 7,
                EpiBf16{f1 ? (u16*)(ws + OFF_WIN_E) + (size_t)512 * 1024 : (u16*)(ws + OFF_WOUT_E), 1024}, lds);
    }
    normmod_phase(p, vb, G, p.in[0], p.in[1], p.in[8], 0, 0);
  }
  SEAM(2)
  if (RUNPH(2)) REP(2)
    big_gemm<3>(lds8, H, (const u16*)(ws + OFF_WIN_E), T, 1536, 1024, FU{(u16*)(ws + OFF_UA), (u16*)(ws + OFF_PQT)});
  SEAM(3)
  if (RUNPH(3)) sym_phase(p, vb, G);
  SEAM(4)
  if (RUNPH(4)) REP(4) {
    const u16* PQT = (const u16*)(ws + OFF_PQT);
    const u16* PEQO = (const u16*)(ws + OFF_PEQO);
    for (int t = vb; t < 256 + 128; t += G) {
      const bool big = t < 256;
      const int q = t - 256, b = q >> 3;
      dft_tile(big ? (const u16*)(ws + OFF_D4096) : (const u16*)(ws + OFF_D256),
               big ? PEQO + (size_t)16 * 512 * 256 : PEQO + (size_t)b * 512 * 256,
               big ? PQT + (size_t)16 * 512 * 512 + 2048 : PQT + (size_t)b * 512 * 512 + 128,
               big ? 8192 : 512, big ? 2048 : 128, big ? (t & 15) << 7 : 0, big ? (t >> 4) << 6 : (q & 7) << 6,
               (u16*)(ws + OFF_AB), big ? 4096 : b * 256, 512, big ? 0.0013810679320049757f : 0.005524271728019903f, lds);
    }
    if (vb >= 256) pool_phase(p, vb - 256, G - 256);
  }
  SEAM(5)
  if (RUNPH(5))
    big_gemm<3>(lds8, (const u16*)(ws + OFF_AB), (const u16*)(ws + OFF_WOUT_E), T, 1024, 1024, FRes{p.in[0], p.in[1], X, mods + 2048});
  SEAM(6)
  if (RUNPH(6)) normmod_phase(p, vb, G, X, X + (size_t)4096 * 1024, p.in[9], 0, 1);
  SEAM(7)
  if (RUNPH(7)) REP(7) big_gemm<4>(lds8, H, (const u16*)(ws + OFF_W1), T, 4096, 1024, FRelu2{(u16*)(ws + OFF_M1)});
  SEAM(8)
  if (RUNPH(8)) {
    big_gemm<4>(lds8, (const u16*)(ws + OFF_M1), (const u16*)(ws + OFF_W2), T, 1024, 4096, FRes{X, X + (size_t)4096 * 1024, X, mods + 5120});
    if (blockIdx.x >= 192) prep_transposes(p, ((int)blockIdx.x - 192) * 2 + half, ((int)gridDim.x - 192) * 2, lds, 1);
  }
  SEAM(9)
  if (RUNPH(9)) normmod_phase(p, vb, G, X, X + (size_t)4096 * 1024, p.in[8] + 1024, 1, 0);
  SEAM(10)
  if (RUNPH(10)) big_gemm<4>(lds8, H, (const u16*)(ws + OFF_WIN_O), T, 2304, 1024,
                            FQkv{(u16*)(ws + OFF_QKV), (u16*)(ws + OFF_CVTP), (u16*)(ws + OFF_CVTS), (u16*)(ws + OFF_DVTP), (u16*)(ws + OFF_DVTS), p.out + OUT_NCV, p.out + OUT_NDV});
  SEAM(11)
  if (RUNPH(11)) REP(11) qkvpost_phase(p, vb, G);
  SEAM(12)
  if (RUNPH(12)) REP(12) attention_phase(p, vb, G, lds);
  SEAM(13)
  if (RUNPH(13)) combine_phase(p, vb, G);
  SEAM(14)
  if (RUNPH(14)) big_gemm<3>(lds8, H, (const u16*)(ws + OFF_WOUT_O), T, 1024, 1024, FRes{X, X + (size_t)4096 * 1024, X, mods + 3 * 6144 + 2048});
  SEAM(15)
  if (RUNPH(15)) normmod_phase(p, vb, G, X, X + (size_t)4096 * 1024, p.in[9] + 1024, 1, 1);
  SEAM(16)
  if (RUNPH(16)) big_gemm<4>(lds8, H, (const u16*)(ws + OFF_W1) + (size_t)4096 * 1024, T, 4096, 1024, FRelu2{(u16*)(ws + OFF_M1)});
  SEAM(17)
  if (RUNPH(17)) big_gemm<3>(lds8, (const u16*)(ws + OFF_M1), (const u16*)(ws + OFF_W2) + (size_t)4096 * 1024, T, 1024, 4096, FRes{X, X + (size_t)4096 * 1024, X, mods + 3 * 6144 + 5120});
}

extern "C" void kernel_launch(void* const* d_in, const int* in_sizes, int n_in, void* d_out, int out_size, void* d_ws, size_t ws_size,
                              hipStream_t stream) {
  constexpr int kDynLds = 2 * LDS_BYTES;
  static int grid = 0;
  if (!grid) {
    int dev = 0, cus = 0, per_cu = 0;
    (void)hipGetDevice(&dev);
    (void)hipDeviceGetAttribute(&cus, hipDeviceAttributeMultiprocessorCount, dev);
    if (hipFuncSetAttribute((const void*)fwd_kernel, hipFuncAttributeMaxDynamicSharedMemorySize, kDynLds) != hipSuccess) fprintf(stderr, "hipFuncSetAttribute(%d) failed\n", kDynLds);
    (void)hipOccupancyMaxActiveBlocksPerMultiprocessor(&per_cu, fwd_kernel, 512, kDynLds);
    if (per_cu < 1) fprintf(stderr, "occupancy query says %d blocks/CU\n", per_cu);
    grid = cus;
    if (ws_size < WS_END) fprintf(stderr, "workspace too small: %zu < %zu\n", ws_size, (size_t)WS_END);
  }
  Params p{};
  for (int i = 0; i < 31; ++i) p.in[i] = (const float*)d_in[i];
  p.out = (float*)d_out;
  p.ws = (unsigned char*)d_ws;
#if ONE_LAUNCH
  hipMemsetAsync((char*)d_ws + OFF_BAR, 0, XCD_BAR_WORDS * 4, stream);
  int lo = 0, hi = NPH;
  void* args[] = {&p, &lo, &hi};
  hipError_t e = hipLaunchCooperativeKernel((void*)fwd_kernel, dim3(grid), dim3(512), args, kDynLds, stream);
  if (e != hipSuccess) fprintf(stderr, "cooperative launch failed: %s (grid %d)\n", hipGetErrorString(e), grid);
#else
  for (int ph = 0; ph < NPH; ++ph) hipLaunchKernelGGL(fwd_kernel, dim3(grid), dim3(512), kDynLds, stream, p, ph, ph + 1);
#endif
}
```

```cpp
#include <hip/hip_runtime.h>
#include <hip/hip_cooperative_groups.h>
#include <cstdio>
namespace cg = cooperative_groups;

#ifndef ONE_LAUNCH
#define ONE_LAUNCH 1
#endif

#ifndef ONLYPH
#define ONLYPH -1
#endif
#ifndef DUPPH
#define DUPPH -1
#endif
typedef unsigned short u16;
typedef short bf16x8 __attribute__((ext_vector_type(8)));
typedef float f32x16 __attribute__((ext_vector_type(16)));
typedef __bf16 bf2_t __attribute__((ext_vector_type(2)));
typedef float f2_t __attribute__((ext_vector_type(2)));
typedef unsigned u32x4 __attribute__((ext_vector_type(4)));

#define DI __device__ __forceinline__
#define TIDX ((int)(threadIdx.x & 255u))

constexpr int T = 12288, TP = 4096, DM = 1024;
constexpr int NPH = 17;
constexpr float EPS = 1e-6f;
constexpr float LOG2E = 1.4426950408889634f;
constexpr float QSCALE = 0.125f * LOG2E;
constexpr float LAM_INIT = 0.35550906759f;

constexpr size_t al(size_t x) { return (x + 255) & ~size_t(255); }
constexpr size_t OFF_MODS   = 0;
constexpr size_t OFF_WIN_E  = OFF_MODS + al(2 * 3 * 6144 * 4);
constexpr size_t OFF_WINB   = OFF_WIN_E + al(1536 * 1024 * 2);
constexpr size_t OFF_CBD    = OFF_WINB + al(1024 * 512 * 2);
constexpr size_t OFF_WOUT_ET= OFF_CBD + al(1024 * 512 * 2);
constexpr size_t OFF_BD     = OFF_WOUT_ET + al(1024 * 1024 * 2);
constexpr size_t OFF_WOUT_E = OFF_BD + al(1024 * 1024 * 2);
constexpr size_t OFF_WIN_O  = OFF_WOUT_E + al(1024 * 1024 * 2);
constexpr size_t OFF_WOUT_O = OFF_WIN_O + al(2304 * 1024 * 2);
constexpr size_t OFF_W1     = OFF_WOUT_O + al(1024 * 1024 * 2);
constexpr size_t OFF_W2     = OFF_W1 + al(2 * 4096 * 1024 * 2);
constexpr size_t OFF_D256   = OFF_W2 + al(2 * 4096 * 1024 * 2);
constexpr size_t OFF_H      = OFF_D256 + al(256 * 512 * 2);
constexpr size_t OFF_R2     = OFF_H + al((size_t)T * 1024 * 2);
constexpr size_t R2_BYTES   = (size_t)T * 512 * 2 + (size_t)T * 1024 * 2 * 2;
constexpr size_t OFF_R1     = OFF_R2 + al(R2_BYTES);
constexpr size_t R1_BYTES   = (size_t)T * 4096 * 2;
constexpr size_t OFF_BAR    = OFF_R1 + R1_BYTES;
constexpr size_t WS_END     = OFF_BAR + 3456 * 4;
constexpr size_t OFF_UA  = OFF_R2;
constexpr size_t OFF_PQT = OFF_UA + (size_t)T * 512 * 2;
constexpr size_t OFF_AB  = OFF_PQT + (size_t)T * 1024 * 2;
constexpr size_t OFF_CQ   = OFF_R2;
constexpr size_t OFF_DQ   = OFF_CQ + (size_t)T * 512 * 2;
constexpr size_t OFF_CKP  = OFF_DQ + (size_t)T * 512 * 2;
constexpr size_t OFF_CKS  = OFF_CKP + (size_t)16 * 8 * 256 * 64 * 2;
constexpr size_t OFF_CVTP = OFF_CKS + (size_t)2 * 8 * 4608 * 64 * 2;
constexpr size_t OFF_CVTS = OFF_CVTP + (size_t)16 * 4 * 128 * 256 * 2;
constexpr size_t OFF_DKP  = OFF_CVTS + (size_t)2 * 4 * 128 * 4608 * 2;
constexpr size_t OFF_DKS  = OFF_DKP + (size_t)16 * 2 * 256 * 64 * 2;
constexpr size_t OFF_DVTP = OFF_DKS + (size_t)2 * 2 * 4608 * 64 * 2;
constexpr size_t OFF_DVTS = OFF_DVTP + (size_t)16 * 2 * 64 * 256 * 2;
constexpr size_t R2_LATE_END = OFF_DVTS + (size_t)2 * 2 * 64 * 4608 * 2;
static_assert(R2_LATE_END <= OFF_R2 + R2_BYTES, "R2 overflow");
constexpr size_t OFF_D4096 = OFF_R1;
constexpr size_t OFF_PEQO  = OFF_R1 + (size_t)32 * 1024 * 1024;
constexpr size_t OFF_M1    = OFF_R1;
constexpr size_t OFF_QKV   = OFF_R1;
constexpr size_t OFF_OM    = OFF_R1 + al((size_t)T * 2304 * 2);
static_assert(OFF_OM + (size_t)T * 1024 * 2 <= WS_END, "R1 overflow");

constexpr size_t OUT_Y   = 0;
constexpr size_t OUT_NCK = (size_t)T * 1024;
constexpr size_t OUT_NCV = OUT_NCK + (size_t)TP * 512;
constexpr size_t OUT_NDK = OUT_NCV + (size_t)TP * 512;
constexpr size_t OUT_NDV = OUT_NDK + (size_t)TP * 128;

struct Params {
  const float* in[31];
  float* out;
  unsigned char* ws;
};

DI float bf2f(u16 v) { return __uint_as_float(((unsigned)v) << 16); }
DI unsigned pack2(float a, float b) { f2_t f = {a, b}; bf2_t v = __builtin_convertvector(f, bf2_t); return __builtin_bit_cast(unsigned, v); }
DI u16 f2bf(float a) { return (u16)(pack2(a, 0.f) & 0xffffu); }
DI int cond_of(int m) { return m < 4096 ? 0 : (m < 8192 ? 1 : 2); }
DI float wave_sum(float v) {
#pragma unroll
  for (int o = 32; o >= 1; o >>= 1) v += __shfl_xor(v, o);
  return v;
}
#define MFMA(a, b, c) __builtin_amdgcn_mfma_f32_32x32x16_bf16((a), (b), (c), 0, 0, 0)

constexpr int LROW = 144;
constexpr int GEMM_BUF = 2 * 128 * LROW;
constexpr int LDS_BYTES = 2 * GEMM_BUF;

template <int NR>
DI void g_load(u32x4 (&R)[NR], const u16* g, int ld, int k0) {
#pragma unroll
  for (int i = 0; i < NR; ++i) R[i] = *(const u32x4*)(g + (size_t)(32 * i) * ld + k0);
}
template <int NR>
DI void g_store(const u32x4 (&R)[NR], char* sw) {
#pragma unroll
  for (int i = 0; i < NR; ++i) *(u32x4*)(sw + (32 * i) * LROW) = R[i];
}
template <int NB>
DI void g_compute(f32x16 (&acc)[2][NB], const char* fa, const char* fb) {
#pragma unroll
  for (int ks = 0; ks < 4; ++ks) {
    bf16x8 a0 = *(const bf16x8*)(fa + ks * 32);
    bf16x8 a1 = *(const bf16x8*)(fa + 32 * LROW + ks * 32);
#pragma unroll
    for (int j = 0; j < NB; ++j) {
      bf16x8 b = *(const bf16x8*)(fb + j * 32 * LROW + ks * 32);
      acc[0][j] = MFMA(a0, b, acc[0][j]);
      acc[1][j] = MFMA(a1, b, acc[1][j]);
    }
  }
}
template <int NB>
DI void gemm_acc(f32x16 (&acc)[2][NB], const u16* A, int lda, const u16* Bt, int ldb, int K, int m0, int n0, char* lds) {
  const int tid = TIDX, lane = tid & 63, wave = tid >> 6;
  const int r = lane & 31, h = lane >> 5;
  const int wm = wave >> 1, wn = wave & 1;
  const int lrow = tid >> 3, lcol = (tid & 7) * 8;
  const u16* ga = A + (size_t)(m0 + lrow) * lda + lcol;
  const u16* gb = Bt + (size_t)(n0 + lrow) * ldb + lcol;
  u32x4 ra0[4], ra1[4], rb0[2 * NB], rb1[2 * NB];
  const int nk = K >> 6;
  char* sw = lds + lrow * LROW + lcol * 2;
  const char* fa = lds + (wm * 64 + r) * LROW + h * 16;
  const char* fb = lds + 128 * LROW + (wn * 32 * NB + r) * LROW + h * 16;
#define G_LOAD(RA, RB, kt_) do { const int k0_ = ((kt_) < nk ? (kt_) : nk - 1) << 6; g_load<4>(RA, ga, lda, k0_); g_load<2 * NB>(RB, gb, ldb, k0_); } while (0)
#define G_STORE(RA, RB, boff_) do { g_store<4>(RA, sw + (boff_)); g_store<2 * NB>(RB, sw + (boff_) + 128 * LROW); } while (0)
  G_LOAD(ra0, rb0, 0);
  G_LOAD(ra1, rb1, 1);
  G_STORE(ra0, rb0, 0);
  __syncthreads();
  for (int kt = 0; kt < nk; kt += 2) {
    G_LOAD(ra0, rb0, kt + 2);
    g_compute<NB>(acc, fa, fb);
    G_STORE(ra1, rb1, GEMM_BUF);
    __syncthreads();
    G_LOAD(ra1, rb1, kt + 3);
    g_compute<NB>(acc, fa + GEMM_BUF, fb + GEMM_BUF);
    G_STORE(ra0, rb0, 0);
    __syncthreads();
  }
#undef G_LOAD
#undef G_STORE
}

template <class Epi>
DI void gemm_tile(const u16* A, int lda, const u16* Bt, int ldb, int K, int m0, int n0, Epi epi, char* lds) {
  const int lane = TIDX & 63, wave = TIDX >> 6;
  const int r = lane & 31, h = lane >> 5, wm = wave >> 1, wn = wave & 1;
  f32x16 acc[2][2];
#pragma unroll
  for (int i = 0; i < 2; ++i)
#pragma unroll
    for (int j = 0; j < 2; ++j)
#pragma unroll
      for (int e = 0; e < 16; ++e) acc[i][j][e] = 0.f;
  gemm_acc<2>(acc, A, lda, Bt, ldb, K, m0, n0, lds);
#pragma unroll
  for (int i = 0; i < 2; ++i)
#pragma unroll
    for (int j = 0; j < 2; ++j)
#pragma unroll
      for (int q = 0; q < 4; ++q) {
        const int m = m0 + wm * 64 + i * 32 + 8 * q + 4 * h;
        const int n = n0 + wn * 64 + j * 32 + r;
        epi(m, n, acc[i][j][4 * q], acc[i][j][4 * q + 1], acc[i][j][4 * q + 2], acc[i][j][4 * q + 3]);
      }
}

DI void dft_tile(const u16* Dm, const u16* PeQo, const u16* PH, int phstride, int H, int m0, int n0, u16* AB, int rowbase, int colsPerBatch, float norm, char* lds) {
  const int lane = TIDX & 63, wave = TIDX >> 6;
  const int r = lane & 31, h = lane >> 5, wm = wave >> 1, wn = wave & 1;
  f32x16 accA[2][1], accB[2][1];
#pragma unroll
  for (int i = 0; i < 2; ++i)
#pragma unroll
    for (int e = 0; e < 16; ++e) { accA[i][0][e] = 0.f; accB[i][0][e] = 0.f; }
  gemm_acc<1>(accA, Dm, 2 * H, PeQo, 2 * H, H, m0, n0, lds);
  gemm_acc<1>(accB, Dm + H, 2 * H, PeQo + H, 2 * H, H, m0, n0, lds);
  const int N = 2 * H;
  const int col = n0 + wn * 32 + r;
  const int b = col / colsPerBatch, c = col - b * colsPerBatch;
  const float ph = bf2f(PH[(size_t)col * phstride]);
  u16* base = AB + ((size_t)rowbase + (size_t)b * N) * 1024 + 512 + c;
#pragma unroll
  for (int i = 0; i < 2; ++i)
#pragma unroll
    for (int q = 0; q < 4; ++q)
#pragma unroll
      for (int e = 0; e < 4; ++e) {
        const int k = m0 + wm * 64 + i * 32 + 8 * q + 4 * h + e;
        const float a = accA[i][0][4 * q + e] + ((k & 1) ? -ph : ph);
        const float bb = accB[i][0][4 * q + e];
        base[(size_t)k * 1024] = f2bf((a - bb) * norm);
        if (k > 0) base[(size_t)(N - k) * 1024] = f2bf((a + bb) * norm);
      }
}

struct EpiBf16 {
  u16* C; int ldc;
  DI void operator()(int m, int n, float v0, float v1, float v2, float v3) const {
    u16* p = C + (size_t)m * ldc + n;
    p[0] = f2bf(v0); p[ldc] = f2bf(v1); p[2 * ldc] = f2bf(v2); p[3 * ldc] = f2bf(v3);
  }
};
struct EpiU {
  u16* UA; u16* PQt;
  DI void operator()(int m, int n, float v0, float v1, float v2, float v3) const {
    if (n < 512) {
      u16* p = UA + (size_t)m * 512 + n;
      p[0] = f2bf(v0); p[512] = f2bf(v1); p[1024] = f2bf(v2); p[1536] = f2bf(v3);
    } else {
      const int np = n - 512, g = np >> 8, pq = (np >> 7) & 1, mm = np & 127;
      size_t off;
      if (m < 4096) { const int b = m >> 8, nl = m & 255; off = ((size_t)(b * 512 + g * 128 + mm)) * 512 + pq * 256 + nl; }
      else { const int ms = m - 4096, b = ms >> 12, nl = ms & 4095; off = (size_t)16 * 512 * 512 + ((size_t)(b * 512 + g * 128 + mm)) * 8192 + pq * 4096 + nl; }
      uint2 w; w.x = pack2(v0, v1); w.y = pack2(v2, v3);
      *(uint2*)(PQt + off) = w;
    }
  }
};
struct EpiDft {
  u16* AB; int rowbase; float norm; int sample;
  DI void operator()(int m, int n, float v0, float v1, float v2, float v3) const {
    size_t row; int c;
    if (sample) { row = (size_t)4096 + (size_t)(n >> 9) * 4096 + m; c = n & 511; }
    else { row = (size_t)rowbase + m; c = n; }
    u16* p = AB + row * 1024 + 512 + c;
    p[0] = f2bf(v0 * norm); p[1024] = f2bf(v1 * norm); p[2048] = f2bf(v2 * norm); p[3072] = f2bf(v3 * norm);
  }
};
struct EpiRes {
  const float* xin_p; const float* xin_s;
  float* X; const float* gate;
  DI void operator()(int m, int n, float v0, float v1, float v2, float v3) const {
    const float* xi = (m < 4096) ? xin_p + (size_t)m * 1024 + n : xin_s + (size_t)(m - 4096) * 1024 + n;
    const float g = gate[cond_of(m) * 6144 + n];
    float* xo = X + (size_t)m * 1024 + n;
    xo[0] = xi[0] + g * v0; xo[1024] = xi[1024] + g * v1; xo[2048] = xi[2048] + g * v2; xo[3072] = xi[3072] + g * v3;
  }
};
struct EpiRelu2 {
  u16* C;
  DI void operator()(int m, int n, float v0, float v1, float v2, float v3) const {
    v0 = fmaxf(v0, 0.f); v1 = fmaxf(v1, 0.f); v2 = fmaxf(v2, 0.f); v3 = fmaxf(v3, 0.f);
    u16* p = C + (size_t)m * 4096 + n;
    p[0] = f2bf(v0 * v0); p[4096] = f2bf(v1 * v1); p[8192] = f2bf(v2 * v2); p[12288] = f2bf(v3 * v3);
  }
};
struct EpiQkv {
  u16* QKV; u16* CVtP; u16* CVtS; u16* DVtP; u16* DVtS; float* ncv; float* ndv;
  DI void operator()(int m, int n, float v0, float v1, float v2, float v3) const {
    const bool is_cv = (n >= 1024 && n < 1536), is_dv = (n >= 2176);
    if (!is_cv && !is_dv) {
      u16* p = QKV + (size_t)m * 2304 + n;
      p[0] = f2bf(v0); p[2304] = f2bf(v1); p[4608] = f2bf(v2); p[6912] = f2bf(v3);
      return;
    }
    uint2 w; w.x = pack2(v0, v1); w.y = pack2(v2, v3);
    if (is_cv) {
      const int c = n - 1024;
      if (m < 4096) {
        const int b = m >> 8, nl = m & 255;
        *(uint2*)(CVtP + ((size_t)(b * 512 + c)) * 256 + nl) = w;
        float* o = ncv + (size_t)m * 512 + c; o[0] = v0; o[512] = v1; o[1024] = v2; o[1536] = v3;
      } else {
        const int ms = m - 4096, b = ms >> 12, nl = ms & 4095;
        *(uint2*)(CVtS + ((size_t)(b * 512 + c)) * 4608 + 512 + nl) = w;
      }
    } else {
      const int c = n - 2176;
      if (m < 4096) {
        const int b = m >> 8, nl = m & 255;
        *(uint2*)(DVtP + ((size_t)(b * 128 + c)) * 256 + nl) = w;
        float* o = ndv + (size_t)m * 128 + c; o[0] = v0; o[128] = v1; o[256] = v2; o[384] = v3;
      } else {
        const int ms = m - 4096, b = ms >> 12, nl = ms & 4095;
        *(uint2*)(DVtS + ((size_t)(b * 128 + c)) * 4608 + 512 + nl) = w;
      }
    }
  }
};

DI void ada_item(const Params& p, int id, char* lds) {
  const int tid = TIDX;
  float* ssil = (float*)lds;
  float* red = (float*)(lds + 12288);
  const int l = id / 192, cb = id % 192;
  for (int i = tid; i < 3072; i += 256) {
    const int j = i >> 10, k = i & 1023;
    const float v = (j == 0) ? p.in[7][k] : p.in[2][(j - 1) * 1024 + k];
    ssil[i] = v / (1.f + __expf(-v));
  }
  __syncthreads();
  const int cq = tid & 7, kg = tid >> 3;
  const float* w = p.in[10] + (size_t)l * 1024 * 6144 + cb * 32 + cq * 4;
  float4 a0 = {0, 0, 0, 0}, a1 = {0, 0, 0, 0}, a2 = {0, 0, 0, 0};
#pragma unroll 8
  for (int kk = 0; kk < 32; ++kk) {
    const int k = kg * 32 + kk;
    const float4 wv = *(const float4*)(w + (size_t)k * 6144);
    const float s0 = ssil[k], s1 = ssil[1024 + k], s2 = ssil[2048 + k];
    a0.x += s0 * wv.x; a0.y += s0 * wv.y; a0.z += s0 * wv.z; a0.w += s0 * wv.w;
    a1.x += s1 * wv.x; a1.y += s1 * wv.y; a1.z += s1 * wv.z; a1.w += s1 * wv.w;
    a2.x += s2 * wv.x; a2.y += s2 * wv.y; a2.z += s2 * wv.z; a2.w += s2 * wv.w;
  }
  float* rp = red + kg * 96 + cq * 4;
  rp[0] = a0.x; rp[1] = a0.y; rp[2] = a0.z; rp[3] = a0.w;
  rp[32] = a1.x; rp[33] = a1.y; rp[34] = a1.z; rp[35] = a1.w;
  rp[64] = a2.x; rp[65] = a2.y; rp[66] = a2.z; rp[67] = a2.w;
  __syncthreads();
  if (tid < 96) {
    const int j = tid >> 5, c = tid & 31;
    float sum = 0.f;
#pragma unroll
    for (int g = 0; g < 32; ++g) sum += red[g * 96 + j * 32 + c];
    const int col = cb * 32 + c;
    ((float*)(p.ws + OFF_MODS))[(size_t)(l * 3 + j) * 6144 + col] = sum + p.in[11][l * 6144 + col];
  }
  __syncthreads();
}

DI void transpose_tile(const float* src, int ld_src, u16* dst, int ld_dst, int r0, int c0, char* lds) {
  float* tile = (float*)lds;
  const int tid = TIDX;
  const int j4 = (tid & 15) * 4, i0 = tid >> 4;
#pragma unroll
  for (int it = 0; it < 4; ++it) {
    const int i = i0 + 16 * it;
    const float4 v = *(const float4*)(src + (size_t)(r0 + i) * ld_src + c0 + j4);
    float* tp = tile + i * 65 + j4;
    tp[0] = v.x; tp[1] = v.y; tp[2] = v.z; tp[3] = v.w;
  }
  __syncthreads();
  const int kc = (tid & 7) * 8, jr = tid >> 3;
#pragma unroll
  for (int it = 0; it < 2; ++it) {
    const int j = jr + 32 * it;
    const float* tp = tile + kc * 65 + j;
    uint4 o;
    o.x = pack2(tp[0], tp[65]); o.y = pack2(tp[130], tp[195]); o.z = pack2(tp[260], tp[325]); o.w = pack2(tp[390], tp[455]);
    *(uint4*)(dst + (size_t)(c0 + j) * ld_dst + r0 + kc) = o;
  }
  __syncthreads();
}

DI void prep_transposes(const Params& p, int vb, int G, char* lds, int layer) {
  const int ntile = layer ? 2880 : 2432;
  for (int t = vb; t < ntile; t += G) {
    const float* src; u16* dst; int lds_, ldd, r0, c0;
    int q = t;
    if (layer == 0) {
      if (q < 128) { src = p.in[12]; lds_ = 1024; dst = (u16*)(p.ws + OFF_WIN_E); ldd = 1024; r0 = (q >> 3) * 64; c0 = (q & 7) * 64; }
      else if ((q -= 128) < 256) { src = p.in[16]; lds_ = 1024; dst = (u16*)(p.ws + OFF_WOUT_ET); ldd = 1024; r0 = (q >> 4) * 64; c0 = (q & 15) * 64; }
      else if ((q -= 256) < 1024) { src = p.in[29]; lds_ = 4096; dst = (u16*)(p.ws + OFF_W1); ldd = 1024; r0 = (q >> 6) * 64; c0 = (q & 63) * 64; }
      else { q -= 1024; src = p.in[30]; lds_ = 1024; dst = (u16*)(p.ws + OFF_W2); ldd = 4096; r0 = (q >> 4) * 64; c0 = (q & 15) * 64; }
    } else {
      if (q < 576) { src = p.in[17]; lds_ = 2304; dst = (u16*)(p.ws + OFF_WIN_O); ldd = 1024; r0 = (q / 36) * 64; c0 = (q % 36) * 64; }
      else if ((q -= 576) < 256) { src = p.in[28]; lds_ = 1024; dst = (u16*)(p.ws + OFF_WOUT_O); ldd = 1024; r0 = (q >> 4) * 64; c0 = (q & 15) * 64; }
      else if ((q -= 256) < 1024) { src = p.in[29] + (size_t)1024 * 4096; lds_ = 4096; dst = (u16*)(p.ws + OFF_W1) + (size_t)4096 * 1024; ldd = 1024; r0 = (q >> 6) * 64; c0 = (q & 63) * 64; }
      else { q -= 1024; src = p.in[30] + (size_t)4096 * 1024; lds_ = 1024; dst = (u16*)(p.ws + OFF_W2) + (size_t)1024 * 4096; ldd = 4096; r0 = (q >> 4) * 64; c0 = (q & 15) * 64; }
    }
    transpose_tile(src, lds_, dst, ldd, r0, c0, lds);
  }
}

DI void prep_elementwise(const Params& p, int vb, int G) {
  const size_t gt = (size_t)vb * 256 + TIDX, gs = (size_t)G * 256;
  {
    u16* d = (u16*)(p.ws + OFF_WINB);
    for (size_t i = gt; i < 1024 * 256; i += gs) {
      const int k = (int)(i >> 8), c = (int)(i & 255) * 2;
      const float* s = p.in[12] + (size_t)k * 1024 + 512 + c;
      *(unsigned*)(d + (size_t)k * 512 + c) = pack2(s[0], s[1]);
    }
  }
  {
    u16* d = (u16*)(p.ws + OFF_CBD);
    for (size_t i = gt; i < 1024 * 512; i += gs) {
      const int np = (int)(i >> 9), cp = (int)(i & 511);
      const int g = np >> 8, pq = (np >> 7) & 1, m = np & 127;
      float v = 0.f;
      if ((cp >> 7) == g) {
        const int c = cp & 127; const int rr = (m * c) & 127;
        const float x = (float)rr * (2.0f / 128.0f);
        v = pq ? sinpif(x) : cospif(x);
      }
      d[i] = f2bf(v);
    }
  }
  {
    u16* d = (u16*)(p.ws + OFF_BD);
    for (size_t i = gt; i < 1024 * 1024; i += gs) {
      const int kp = (int)(i >> 10), c = (int)(i & 1023);
      float v = 0.f;
      if (kp < 512) { const int g = kp >> 7; if (c < 512 && (c >> 7) == g) v = p.in[13][(size_t)g * 16384 + (kp & 127) * 128 + (c & 127)] * p.in[14][c]; }
      else { const int g = (kp - 512) >> 7; if (c >= 512 && ((c - 512) >> 7) == g) v = p.in[15][(size_t)g * 16384 + ((kp - 512) & 127) * 128 + ((c - 512) & 127)]; }
      d[i] = f2bf(v);
    }
  }
#pragma unroll 1
  for (int which = 0; which < 2; ++which) {
    const int H = which ? 2048 : 128, N = 2 * H, lg = which ? 9 : 5;
    u16* d = (u16*)(p.ws + (which ? OFF_D4096 : OFF_D256));
    const float invN = 1.0f / (float)N;
    for (size_t i = gt; i < ((size_t)H << lg); i += gs) {
      const int k = (int)(i >> lg), np = (int)(i & ((1 << lg) - 1)) * 8;
      const bool is_sin = np >= H;
      const int n = np & (H - 1);
      unsigned w[4];
#pragma unroll
      for (int e = 0; e < 4; ++e) {
        const float x0 = (float)((k * (n + 2 * e)) & (N - 1)) * invN, x1 = (float)((k * (n + 2 * e + 1)) & (N - 1)) * invN;
        const float v0 = is_sin ? __builtin_amdgcn_sinf(x0) : __builtin_amdgcn_cosf(x0);
        const float v1 = is_sin ? __builtin_amdgcn_sinf(x1) : __builtin_amdgcn_cosf(x1);
        w[e] = pack2(v0, v1);
      }
      *(uint4*)(d + (size_t)k * N + np) = make_uint4(w[0], w[1], w[2], w[3]);
    }
  }
}

DI void sym_phase(const Params& p, int vb, int G) {
  const int lane = TIDX & 63, wave = TIDX >> 6;
  const u16* PQT = (const u16*)(p.ws + OFF_PQT);
  u16* PEQO = (u16*)(p.ws + OFF_PEQO);
  u16* AB = (u16*)(p.ws + OFF_AB);
  for (int it = vb * 4 + wave; it < 1024 + 2048; it += G * 4) {
    const bool samp = it < 1024;
    const int H = samp ? 2048 : 128, N = 2 * H;
    int col, n0base, nstep;
    if (samp) { col = it; n0base = lane * 8; nstep = 512; }
    else { col = (it - 1024) * 4 + (lane >> 4); n0base = (lane & 15) * 8; nstep = 128; }
    const u16* Pp = samp ? PQT + (size_t)16 * 512 * 512 + (size_t)col * 8192 : PQT + (size_t)col * 512;
    const u16* Qp = Pp + N;
    u16* Pe = samp ? PEQO + (size_t)16 * 512 * 256 + (size_t)col * 4096 : PEQO + (size_t)col * 256;
    u16* Qo = Pe + H;
    float alt = 0.f;
    for (int n0 = n0base; n0 < H; n0 += nstep) {
      const uint4 pw = *(const uint4*)(Pp + n0), qw = *(const uint4*)(Qp + n0);
      const unsigned pa[4] = {pw.x, pw.y, pw.z, pw.w}, qa[4] = {qw.x, qw.y, qw.z, qw.w};
      float pe[8], qo[8];
#pragma unroll
      for (int e = 0; e < 8; ++e) {
        const float pv = (e & 1) ? __uint_as_float(pa[e >> 1] & 0xffff0000u) : __uint_as_float(pa[e >> 1] << 16);
        const float qv = (e & 1) ? __uint_as_float(qa[e >> 1] & 0xffff0000u) : __uint_as_float(qa[e >> 1] << 16);
        const int n = n0 + e;
        float pm = 0.f, qm = 0.f;
        if (n > 0) { pm = bf2f(Pp[N - n]); qm = bf2f(Qp[N - n]); }
        pe[e] = pv + pm;
        qo[e] = (n > 0) ? qv - qm : 0.f;
        alt += (e & 1) ? -pe[e] : pe[e];
      }
      *(uint4*)(Pe + n0) = make_uint4(pack2(pe[0], pe[1]), pack2(pe[2], pe[3]), pack2(pe[4], pe[5]), pack2(pe[6], pe[7]));
      *(uint4*)(Qo + n0) = make_uint4(pack2(qo[0], qo[1]), pack2(qo[2], qo[3]), pack2(qo[4], qo[5]), pack2(qo[6], qo[7]));
    }
    alt += __shfl_xor(alt, 1); alt += __shfl_xor(alt, 2); alt += __shfl_xor(alt, 4); alt += __shfl_xor(alt, 8);
    if (samp) { alt += __shfl_xor(alt, 16); alt += __shfl_xor(alt, 32); }
    if ((samp && lane == 0) || (!samp && (lane & 15) == 0)) {
      const float fh = alt + bf2f(Pp[H]);
      size_t row; int c; float norm;
      if (samp) { row = (size_t)4096 + (size_t)(col >> 9) * 4096 + 2048; c = col & 511; norm = 0.0013810679320049757f; }
      else { row = (size_t)(col >> 9) * 256 + 128; c = col & 511; norm = 0.005524271728019903f; }
      AB[row * 1024 + 512 + c] = f2bf(fh * norm);
    }
  }
}

DI void normmod_phase(const Params& p, int vb, int G, const float* xp, const float* xs, const float* gain, int l, int which) {
  const int lane = TIDX & 63, wave = TIDX >> 6;
  u16* H = (u16*)(p.ws + OFF_H);
  const float* mods = (const float*)(p.ws + OFF_MODS) + (size_t)l * 3 * 6144;
  for (int row = vb * 4 + wave; row < T; row += G * 4) {
    const float* x = (row < 4096) ? xp + (size_t)row * 1024 : xs + (size_t)(row - 4096) * 1024;
    float4 v[4];
    float ss = 0.f;
#pragma unroll
    for (int i = 0; i < 4; ++i) {
      v[i] = *(const float4*)(x + i * 256 + lane * 4);
      ss += v[i].x * v[i].x + v[i].y * v[i].y + v[i].z * v[i].z + v[i].w * v[i].w;
    }
    ss = wave_sum(ss);
    const float rinv = rsqrtf(ss * (1.0f / 1024.0f) + EPS);
    const float* md = mods + cond_of(row) * 6144 + which * 3072;
#pragma unroll
    for (int i = 0; i < 4; ++i) {
      const int c = i * 256 + lane * 4;
      const float4 g = *(const float4*)(gain + c);
      const float4 sh = *(const float4*)(md + c);
      const float4 sc = *(const float4*)(md + 1024 + c);
      const float o0 = v[i].x * rinv * g.x * (1.f + sc.x) + sh.x;
      const float o1 = v[i].y * rinv * g.y * (1.f + sc.y) + sh.y;
      const float o2 = v[i].z * rinv * g.z * (1.f + sc.z) + sh.z;
      const float o3 = v[i].w * rinv * g.w * (1.f + sc.w) + sh.w;
      uint2 w; w.x = pack2(o0, o1); w.y = pack2(o2, o3);
      *(uint2*)(H + (size_t)row * 1024 + c) = w;
    }
  }
}

template <class Epi>
DI void gemm_phase(const u16* A, int lda, const u16* Bt, int ldb, int K, int M, int N, Epi epi, int vb, int G, char* lds) {
  const int nN = N >> 7, nt = (M >> 7) * nN, grp = 8 * nN;
  for (int t = vb; t < nt; t += G) {
    const int gi = t / grp, rem = t - gi * grp;
    gemm_tile(A, lda, Bt, ldb, K, (gi * 8 + (rem & 7)) << 7, (rem >> 3) << 7, epi, lds);
  }
}

DI void pool_phase(const Params& p, int vb, int G) {
  const u16* UA = (const u16*)(p.ws + OFF_UA);
  u16* AB = (u16*)(p.ws + OFF_AB);
  const size_t gt = (size_t)vb * 256 + TIDX, gs = (size_t)G * 256;
  for (size_t i = gt; i < (size_t)T * 64; i += gs) {
    const int t = (int)(i >> 6), c8 = (int)(i & 63) * 8;
    const int g = c8 >> 7, hw = 1 << g;
    int nl, N, base;
    if (t < 4096) { nl = t & 255; N = 256; base = t - nl; } else { nl = (t - 4096) & 4095; N = 4096; base = t - nl; }
    const int lo = max(nl - hw, 0), hi = min(nl + hw, N);
    float s[8] = {0, 0, 0, 0, 0, 0, 0, 0};
    for (int j = lo; j < hi; ++j) {
      const uint4 w = *(const uint4*)(UA + (size_t)(base + j) * 512 + c8);
      s[0] += __uint_as_float(w.x << 16); s[1] += __uint_as_float(w.x & 0xffff0000u);
      s[2] += __uint_as_float(w.y << 16); s[3] += __uint_as_float(w.y & 0xffff0000u);
      s[4] += __uint_as_float(w.z << 16); s[5] += __uint_as_float(w.z & 0xffff0000u);
      s[6] += __uint_as_float(w.w << 16); s[7] += __uint_as_float(w.w & 0xffff0000u);
    }
    const float inv = 1.0f / (float)(hi - lo);
    const uint4 w = *(const uint4*)(UA + (size_t)t * 512 + c8);
    uint4 o;
    o.x = pack2(s[0] * inv - __uint_as_float(w.x << 16), s[1] * inv - __uint_as_float(w.x & 0xffff0000u));
    o.y = pack2(s[2] * inv - __uint_as_float(w.y << 16), s[3] * inv - __uint_as_float(w.y & 0xffff0000u));
    o.z = pack2(s[4] * inv - __uint_as_float(w.z << 16), s[5] * inv - __uint_as_float(w.z & 0xffff0000u));
    o.w = pack2(s[6] * inv - __uint_as_float(w.w << 16), s[7] * inv - __uint_as_float(w.w & 0xffff0000u));
    *(uint4*)(AB + (size_t)t * 1024 + c8) = o;
  }
}

DI void qkvpost_phase(const Params& p, int vb, int G) {
  const int lane = TIDX & 63, wave = TIDX >> 6;
  const int q = lane & 15, sub = lane >> 4;
  const u16* QKV = (const u16*)(p.ws + OFF_QKV);
  u16* CQ = (u16*)(p.ws + OFF_CQ); u16* DQ = (u16*)(p.ws + OFF_DQ);
  u16* CKP = (u16*)(p.ws + OFF_CKP); u16* CKS = (u16*)(p.ws + OFF_CKS);
  u16* DKP = (u16*)(p.ws + OFF_DKP); u16* DKS = (u16*)(p.ws + OFF_DKS);
  float* nck = p.out + OUT_NCK; float* ndk = p.out + OUT_NDK;
  const int d0 = q * 4;
  float fr[4];
#pragma unroll
  for (int e = 0; e < 4; ++e) fr[e] = exp2f(-(float)((d0 + e) & 15) * (13.287712379549449f / 16.0f));
  const bool firsthalf = ((d0 >> 4) & 1) == 0;
  for (int t = vb * 4 + wave; t < T; t += G * 4) {
    const bool samp = t >= 4096;
    int b, nl;
    if (!samp) { b = t >> 8; nl = t & 255; } else { b = (t - 4096) >> 12; nl = (t - 4096) & 4095; }
    float cs[4], sn[4];
    if (samp) {
      const float pos = (d0 < 32) ? (float)(nl >> 6) : (float)(nl & 63);
#pragma unroll
      for (int e = 0; e < 4; ++e) { const float a = pos * fr[e]; cs[e] = cosf(a); sn[e] = sinf(a); }
    } else {
#pragma unroll
      for (int e = 0; e < 4; ++e) { cs[e] = 1.f; sn[e] = 0.f; }
    }
    for (int rd = 0; rd < 7; ++rd) {
      const int slot = rd * 4 + sub;
      const bool act = slot < 26;
      const int vi = act ? (slot < 16 ? slot : slot + 8) : 0;
      const uint2 raw = *(const uint2*)(QKV + (size_t)t * 2304 + vi * 64 + d0);
      float x[4] = {__uint_as_float(raw.x << 16), __uint_as_float(raw.x & 0xffff0000u), __uint_as_float(raw.y << 16), __uint_as_float(raw.y & 0xffff0000u)};
      float ss = x[0] * x[0] + x[1] * x[1] + x[2] * x[2] + x[3] * x[3];
      ss += __shfl_xor(ss, 1); ss += __shfl_xor(ss, 2); ss += __shfl_xor(ss, 4); ss += __shfl_xor(ss, 8);
      const float rinv = rsqrtf(ss * (1.0f / 64.0f) + EPS);
      const float* gp = (vi < 8) ? p.in[18] : (vi < 16) ? p.in[19] : (vi < 32) ? p.in[25] : p.in[26];
      const float4 g = *(const float4*)(gp + d0);
      float y[4] = {x[0] * rinv * g.x, x[1] * rinv * g.y, x[2] * rinv * g.z, x[3] * rinv * g.w};
      float o[4];
#pragma unroll
      for (int e = 0; e < 4; ++e) {
        const float part = __shfl_xor(y[e], 4);
        o[e] = firsthalf ? (y[e] * cs[e] - part * sn[e]) : (y[e] * cs[e] + part * sn[e]);
      }
      if (!act) continue;
      const bool isq = (vi < 8) || (vi >= 24 && vi < 32);
      if (isq) {
        const int hd = (vi < 8) ? vi : vi - 24;
        u16* base = (vi < 8) ? CQ : DQ;
        size_t off = samp ? (size_t)16 * 8 * 256 * 64 + ((size_t)(b * 8 + hd) * 4096 + nl) * 64 : ((size_t)(b * 8 + hd) * 256 + nl) * 64;
        uint2 w; w.x = pack2(o[0] * QSCALE, o[1] * QSCALE); w.y = pack2(o[2] * QSCALE, o[3] * QSCALE);
        *(uint2*)(base + off + d0) = w;
      } else if (vi < 16) {
        const int hm = vi - 8;
        uint2 w; w.x = pack2(o[0], o[1]); w.y = pack2(o[2], o[3]);
        if (samp) *(uint2*)(CKS + ((size_t)(b * 8 + hm) * 4608 + 512 + nl) * 64 + d0) = w;
        else {
          *(uint2*)(CKP + ((size_t)(b * 8 + hm) * 256 + nl) * 64 + d0) = w;
          *(float4*)(nck + (size_t)t * 512 + hm * 64 + d0) = make_float4(o[0], o[1], o[2], o[3]);
        }
      } else {
        const int j = vi - 32;
        uint2 w; w.x = pack2(o[0], o[1]); w.y = pack2(o[2], o[3]);
        if (samp) *(uint2*)(DKS + ((size_t)(b * 2 + j) * 4608 + 512 + nl) * 64 + d0) = w;
        else {
          *(uint2*)(DKP + ((size_t)(b * 2 + j) * 256 + nl) * 64 + d0) = w;
          *(float4*)(ndk + (size_t)t * 128 + j * 64 + d0) = make_float4(o[0], o[1], o[2], o[3]);
        }
      }
    }
  }
  const size_t gt = (size_t)vb * 256 + TIDX, gs = (size_t)G * 256;
  {
    u16* CVTS = (u16*)(p.ws + OFF_CVTS); u16* DVTS = (u16*)(p.ws + OFF_DVTS);
    for (size_t i = gt; i < (size_t)2 * 512 * 512; i += gs) {
      const int b = (int)(i >> 18), key = (int)(i >> 9) & 511, c = (int)(i & 511);
      CKS[((size_t)(b * 8 + (c >> 6)) * 4608 + key) * 64 + (c & 63)] = f2bf(p.in[3][i]);
    }
    for (size_t i = gt; i < (size_t)2 * 512 * 512; i += gs) {
      const int b = (int)(i >> 18), c = (int)(i >> 9) & 511, key = (int)(i & 511);
      CVTS[((size_t)(b * 512 + c)) * 4608 + key] = f2bf(p.in[4][((size_t)b * 512 + key) * 512 + c]);
    }
    for (size_t i = gt; i < (size_t)2 * 512 * 128; i += gs) {
      const int b = (int)(i >> 16), key = (int)(i >> 7) & 511, c = (int)(i & 127);
      DKS[((size_t)(b * 2 + (c >> 6)) * 4608 + key) * 64 + (c & 63)] = f2bf(p.in[5][i]);
    }
    for (size_t i = gt; i < (size_t)2 * 128 * 512; i += gs) {
      const int b = (int)(i >> 16), c = (int)(i >> 9) & 127, key = (int)(i & 511);
      DVTS[((size_t)(b * 128 + c)) * 4608 + key] = f2bf(p.in[6][((size_t)b * 512 + key) * 128 + c]);
    }
  }
}

template <int DV>
DI void attn_item(const u16* Q, const u16* Kb, const u16* Vt, int ldv, int nt0, int key1, int nt1,
                  bool masked, int qpos0, bool has_sink, float sink2, u16* out, int ldo, char* lds) {
  constexpr int NDB = DV / 32;
  constexpr int KVBUF = (64 + DV) * LROW;
  const int tid = TIDX, lane = tid & 63, wave = tid >> 6;
  const int r = lane & 31, h = lane >> 5;
  const int nt = nt0 + nt1;
  bf16x8 qf[4];
#pragma unroll
  for (int ks = 0; ks < 4; ++ks) qf[ks] = *(const bf16x8*)(Q + (size_t)(wave * 32 + r) * 64 + ks * 16 + h * 8);
  f32x16 O[NDB];
#pragma unroll
  for (int i = 0; i < NDB; ++i)
#pragma unroll
    for (int e = 0; e < 16; ++e) O[i][e] = 0.f;
  float mrun = has_sink ? sink2 : -1e30f;
  float lrun = has_sink ? (h == 0 ? 1.f : 0.f) : 0.f;
  const int lrow = tid >> 3, lpart = (tid & 7) * 8;
  uint4 rk0, rk1, rv0, rv1, rv2, rv3;
  rv2 = rv3 = make_uint4(0, 0, 0, 0);
  const u16* gk = Kb + (size_t)lrow * 64 + lpart;
  const u16* gv = Vt + (size_t)lrow * ldv + lpart;
#define ATT_GLOAD(key0_)                                                         \
  do {                                                                           \
    rk0 = *(const uint4*)(gk + (size_t)(key0_) * 64);                            \
    rk1 = *(const uint4*)(gk + (size_t)((key0_) + 32) * 64);                     \
    rv0 = *(const uint4*)(gv + (key0_));                                         \
    rv1 = *(const uint4*)(gv + (size_t)32 * ldv + (key0_));                      \
    if constexpr (DV == 128) {                                                   \
      rv2 = *(const uint4*)(gv + (size_t)64 * ldv + (key0_));                    \
      rv3 = *(const uint4*)(gv + (size_t)96 * ldv + (key0_));                    \
    }                                                                            \
  } while (0)
#define ATT_SSTORE(boff_)                                                        \
  do {                                                                           \
    *(uint4*)(sw + (boff_)) = rk0;                                               \
    *(uint4*)(sw + (boff_) + 32 * LROW) = rk1;                                   \
    *(uint4*)(sw + (boff_) + 64 * LROW) = rv0;                                   \
    *(uint4*)(sw + (boff_) + 96 * LROW) = rv1;                                   \
    if constexpr (DV == 128) {                                                   \
      *(uint4*)(sw + (boff_) + 128 * LROW) = rv2;                                \
      *(uint4*)(sw + (boff_) + 160 * LROW) = rv3;                                \
    }                                                                            \
  } while (0)
  char* sw = lds + lrow * LROW + lpart * 2;
  {
    const int key0 = (nt0 > 0) ? 0 : key1;
    ATT_GLOAD(key0);
  }
  ATT_SSTORE(0);
  __syncthreads();
  const int pr = (r & 0x13) | ((r & 4) << 1) | ((r & 8) >> 1);
  const char* fk = lds + pr * LROW + h * 16;
  const char* fv = lds + 64 * LROW + r * LROW + h * 16;
  const int qpos = qpos0 + wave * 32 + r;
  for (int t = 0; t < nt; ++t) {
    const int cur = (t & 1) * KVBUF;
    const int key0 = (t < nt0) ? t * 64 : key1 + (t - nt0) * 64;
    {
      const int tn = (t + 1 < nt) ? t + 1 : t;
      const int kn = (tn < nt0) ? tn * 64 : key1 + (tn - nt0) * 64;
      ATT_GLOAD(kn);
    }
    f32x16 S[2];
#pragma unroll
    for (int kb = 0; kb < 2; ++kb) {
#pragma unroll
      for (int e = 0; e < 16; ++e) S[kb][e] = 0.f;
#pragma unroll
      for (int ks = 0; ks < 4; ++ks) {
        const bf16x8 kf = *(const bf16x8*)(fk + cur + kb * 32 * LROW + ks * 32);
        S[kb] = MFMA(kf, qf[ks], S[kb]);
      }
    }
    if (masked && t >= nt0) {
#pragma unroll
      for (int kb = 0; kb < 2; ++kb)
#pragma unroll
        for (int e = 0; e < 16; ++e) {
          const int jpos = key0 - 512 + kb * 32 + 16 * (e >> 3) + 8 * h + (e & 7);
          const int dlt = qpos - jpos;
          if (dlt > 128 || dlt < -128) S[kb][e] = -1e30f;
        }
    }
    float mloc = S[0][0];
#pragma unroll
    for (int kb = 0; kb < 2; ++kb)
#pragma unroll
      for (int e = 0; e < 16; ++e) mloc = fmaxf(mloc, S[kb][e]);
    mloc = fmaxf(mloc, __shfl_xor(mloc, 32));
    const float mnew = fmaxf(mrun, mloc);
    if (__builtin_amdgcn_ballot_w64(mnew > mrun) != 0) {
      const float alpha = __builtin_amdgcn_exp2f(mrun - mnew);
      lrun *= alpha;
#pragma unroll
      for (int i = 0; i < NDB; ++i)
#pragma unroll
        for (int e = 0; e < 16; ++e) O[i][e] *= alpha;
    }
    mrun = mnew;
    float ps = 0.f;
#pragma unroll
    for (int kb = 0; kb < 2; ++kb)
#pragma unroll
      for (int e = 0; e < 16; ++e) { const float pv = __builtin_amdgcn_exp2f(S[kb][e] - mnew); S[kb][e] = pv; ps += pv; }
    lrun += ps;
    bf16x8 pf[4];
#pragma unroll
    for (int jj = 0; jj < 4; ++jj) {
      const int kb = jj >> 1, o8 = (jj & 1) * 8;
      uint4 w;
      w.x = pack2(S[kb][o8 + 0], S[kb][o8 + 1]); w.y = pack2(S[kb][o8 + 2], S[kb][o8 + 3]);
      w.z = pack2(S[kb][o8 + 4], S[kb][o8 + 5]); w.w = pack2(S[kb][o8 + 6], S[kb][o8 + 7]);
      pf[jj] = __builtin_bit_cast(bf16x8, w);
    }
    __builtin_amdgcn_sched_barrier(0);
#pragma unroll
    for (int i = 0; i < NDB; ++i) {
#pragma unroll
      for (int jj = 0; jj < 4; ++jj) {
        const bf16x8 vf = *(const bf16x8*)(fv + cur + i * 32 * LROW + jj * 32);
        O[i] = MFMA(vf, pf[jj], O[i]);
      }
      if (i & 1) __builtin_amdgcn_sched_barrier(0);
    }
    ATT_SSTORE(KVBUF - cur);
    __syncthreads();
  }
#undef ATT_GLOAD
#undef ATT_SSTORE
  const float ltot = lrun + __shfl_xor(lrun, 32);
  const float inv = 1.0f / ltot;
  u16* op = out + (size_t)(wave * 32 + r) * ldo;
#pragma unroll
  for (int i = 0; i < NDB; ++i)
#pragma unroll
    for (int qd = 0; qd < 4; ++qd) {
      uint2 w;
      w.x = pack2(O[i][4 * qd] * inv, O[i][4 * qd + 1] * inv);
      w.y = pack2(O[i][4 * qd + 2] * inv, O[i][4 * qd + 3] * inv);
      *(uint2*)(op + i * 32 + 8 * qd + 4 * h) = w;
    }
}

DI void attn_diff_pair(const u16* Q, const u16* Kb, const u16* Vt, int ldv, int nt, float lam, const float* subln_g, u16* out, char* shm, int half) {
  constexpr int STG = (64 + 64 + 128) * LROW;
  const int tid = TIDX, t512 = (int)threadIdx.x, lane = tid & 63, wave = tid >> 6;
  const int r = lane & 31, h = lane >> 5;
  bf16x8 qf[4];
#pragma unroll
  for (int ks = 0; ks < 4; ++ks) qf[ks] = *(const bf16x8*)(Q + (size_t)(wave * 32 + r) * 64 + ks * 16 + h * 8);
  f32x16 O[4];
#pragma unroll
  for (int i = 0; i < 4; ++i)
#pragma unroll
    for (int e = 0; e < 16; ++e) O[i][e] = 0.f;
  float mrun = -1e30f, lrun = 0.f;
  const int lrow = tid >> 3, lpart = (tid & 7) * 8;
  const int vrow = t512 >> 3, vpart = (t512 & 7) * 8;
  const u16* gk = Kb + (size_t)lrow * 64 + lpart;
  const u16* gv = Vt + (size_t)vrow * ldv + vpart;
  char* sk = shm + half * 64 * LROW + lrow * LROW + lpart * 2;
  char* sv = shm + 128 * LROW + vrow * LROW + vpart * 2;
  u32x4 rk0, rk1, rv0, rv1;
#define AD_GLOAD(key0_) do { rk0 = *(const u32x4*)(gk + (size_t)(key0_) * 64); rk1 = *(const u32x4*)(gk + (size_t)((key0_) + 32) * 64); \
                             rv0 = *(const u32x4*)(gv + (key0_)); rv1 = *(const u32x4*)(gv + (size_t)64 * ldv + (key0_)); } while (0)
#define AD_SSTORE(boff_) do { *(u32x4*)(sk + (boff_)) = rk0; *(u32x4*)(sk + (boff_) + 32 * LROW) = rk1; \
                              *(u32x4*)(sv + (boff_)) = rv0; *(u32x4*)(sv + (boff_) + 64 * LROW) = rv1; } while (0)
  AD_GLOAD(0);
  AD_SSTORE(0);
  __syncthreads();
  const int pr = (r & 0x13) | ((r & 4) << 1) | ((r & 8) >> 1);
  const char* fk = shm + half * 64 * LROW + pr * LROW + h * 16;
  const char* fv = shm + 128 * LROW + r * LROW + h * 16;
  for (int t = 0; t < nt; ++t) {
    const int cur = (t & 1) * STG;
    { const int tn = (t + 1 < nt) ? t + 1 : t; AD_GLOAD(tn * 64); }
    f32x16 S[2];
#pragma unroll
    for (int kb = 0; kb < 2; ++kb) {
#pragma unroll
      for (int e = 0; e < 16; ++e) S[kb][e] = 0.f;
#pragma unroll
      for (int ks = 0; ks < 4; ++ks) {
        const bf16x8 kf = *(const bf16x8*)(fk + cur + kb * 32 * LROW + ks * 32);
        S[kb] = MFMA(kf, qf[ks], S[kb]);
      }
    }
    float mloc = S[0][0];
#pragma unroll
    for (int kb = 0; kb < 2; ++kb)
#pragma unroll
      for (int e = 0; e < 16; ++e) mloc = fmaxf(mloc, S[kb][e]);
    mloc = fmaxf(mloc, __shfl_xor(mloc, 32));
    const float mnew = fmaxf(mrun, mloc);
    if (__builtin_amdgcn_ballot_w64(mnew > mrun) != 0) {
      const float alpha = __builtin_amdgcn_exp2f(mrun - mnew);
      lrun *= alpha;
#pragma unroll
      for (int i = 0; i < 4; ++i)
#pragma unroll
        for (int e = 0; e < 16; ++e) O[i][e] *= alpha;
    }
    mrun = mnew;
    float ps = 0.f;
#pragma unroll
    for (int kb = 0; kb < 2; ++kb)
#pragma unroll
      for (int e = 0; e < 16; ++e) { const float pv = __builtin_amdgcn_exp2f(S[kb][e] - mnew); S[kb][e] = pv; ps += pv; }
    lrun += ps;
    bf16x8 pf[4];
#pragma unroll
    for (int jj = 0; jj < 4; ++jj) {
      const int kb = jj >> 1, o8 = (jj & 1) * 8;
      uint4 w;
      w.x = pack2(S[kb][o8 + 0], S[kb][o8 + 1]); w.y = pack2(S[kb][o8 + 2], S[kb][o8 + 3]);
      w.z = pack2(S[kb][o8 + 4], S[kb][o8 + 5]); w.w = pack2(S[kb][o8 + 6], S[kb][o8 + 7]);
      pf[jj] = __builtin_bit_cast(bf16x8, w);
    }
    __builtin_amdgcn_sched_barrier(0);
#pragma unroll
    for (int i = 0; i < 4; ++i) {
#pragma unroll
      for (int jj = 0; jj < 4; ++jj) {
        const bf16x8 vf = *(const bf16x8*)(fv + cur + i * 32 * LROW + jj * 32);
        O[i] = MFMA(vf, pf[jj], O[i]);
      }
      if (i & 1) __builtin_amdgcn_sched_barrier(0);
    }
    AD_SSTORE(STG - cur);
    __syncthreads();
  }
#undef AD_GLOAD
#undef AD_SSTORE
  const float inv = 1.0f / (lrun + __shfl_xor(lrun, 32));
  float* ex = (float*)shm + (size_t)wave * 4096 + lane;
  if (half == 1) {
#pragma unroll
    for (int i = 0; i < 4; ++i)
#pragma unroll
      for (int e = 0; e < 16; ++e) ex[(i * 16 + e) * 64] = O[i][e] * inv;
  }
  __syncthreads();
  if (half == 0) {
    float ss = 0.f;
#pragma unroll
    for (int i = 0; i < 4; ++i)
#pragma unroll
      for (int e = 0; e < 16; ++e) { const float d = O[i][e] * inv - lam * ex[(i * 16 + e) * 64]; O[i][e] = d; ss += d * d; }
    ss += __shfl_xor(ss, 32);
    const float rinv = rsqrtf(ss * (1.0f / 128.0f) + EPS) * (1.0f - LAM_INIT);
    u16* op = out + (size_t)(wave * 32 + r) * 1024;
#pragma unroll
    for (int i = 0; i < 4; ++i)
#pragma unroll
      for (int qd = 0; qd < 4; ++qd) {
        const int e0 = i * 32 + 8 * qd + 4 * h;
        const float4 g = *(const float4*)(subln_g + e0);
        uint2 w;
        w.x = pack2(O[i][4 * qd] * rinv * g.x, O[i][4 * qd + 1] * rinv * g.y);
        w.y = pack2(O[i][4 * qd + 2] * rinv * g.z, O[i][4 * qd + 3] * rinv * g.w);
        *(uint2*)(op + e0) = w;
      }
  }
  __syncthreads();
}

DI void attention_phase(const Params& p, int vb0, int half, char* shm) {
  const u16* CQ = (const u16*)(p.ws + OFF_CQ); const u16* DQ = (const u16*)(p.ws + OFF_DQ);
  const u16* CKP = (const u16*)(p.ws + OFF_CKP); const u16* CKS = (const u16*)(p.ws + OFF_CKS);
  const u16* CVTP = (const u16*)(p.ws + OFF_CVTP); const u16* CVTS = (const u16*)(p.ws + OFF_CVTS);
  const u16* DKP = (const u16*)(p.ws + OFF_DKP); const u16* DKS = (const u16*)(p.ws + OFF_DKS);
  const u16* DVTP = (const u16*)(p.ws + OFF_DVTP); const u16* DVTS = (const u16*)(p.ws + OFF_DVTS);
  u16* AC = (u16*)(p.ws + OFF_H);
  constexpr size_t QS = (size_t)16 * 8 * 256 * 64;
  const int lane = TIDX & 63;
  const float la = wave_sum(p.in[20][lane] * p.in[21][lane]);
  const float lb = wave_sum(p.in[22][lane] * p.in[23][lane]);
  const float lam = expf(la) - expf(lb) + LAM_INIT;
  const int nblk = (int)gridDim.x;
  for (int it = vb0; it < 768; it += nblk) {
    const bool diff = (it < 256) || (it >= 512 && it < 640);
    const bool samp = it < 512;
    if (diff) {
      int qb, hh, b;
      if (samp) { qb = it & 31; hh = (it >> 5) & 3; b = it >> 7; }
      else { const int i2 = it - 512; qb = i2 & 1; hh = (i2 >> 1) & 3; b = i2 >> 3; }
      const int nseq = samp ? 4096 : 256, nkeys = samp ? 4608 : 256;
      const int tok = samp ? 4096 + b * 4096 + qb * 128 : b * 256 + qb * 128;
      const int hm = hh * 2 + half;
      const size_t qoff = (samp ? QS : 0) + ((size_t)(b * 8 + hm) * nseq + qb * 128) * 64;
      const u16* Kp = (samp ? CKS : CKP) + (size_t)(b * 8 + hm) * nkeys * 64;
      const u16* Vp = (samp ? CVTS : CVTP) + (size_t)(b * 4 + hh) * 128 * nkeys;
      attn_diff_pair(CQ + qoff, Kp, Vp, nkeys, nkeys >> 6, lam, p.in[24], AC + (size_t)tok * 1024 + hh * 128, shm, half);
    } else {
      int qb, hd, b;
      if (samp) { const int i2 = (it - 256) * 2 + half; qb = i2 & 31; hd = (i2 >> 5) & 7; b = i2 >> 8; }
      else { const int i2 = (it - 640) * 2 + half; qb = i2 & 1; hd = (i2 >> 1) & 7; b = i2 >> 4; }
      const int nseq = samp ? 4096 : 256, nkeys = samp ? 4608 : 256;
      const int tok = samp ? 4096 + b * 4096 + qb * 128 : b * 256 + qb * 128;
      const size_t qoff = (samp ? QS : 0) + ((size_t)(b * 8 + hd) * nseq + qb * 128) * 64;
      const u16* Kp = (samp ? DKS : DKP) + (size_t)(b * 2 + (hd >> 2)) * nkeys * 64;
      const u16* Vp = (samp ? DVTS : DVTP) + (size_t)(b * 2 + (hd >> 2)) * 64 * nkeys;
      int nt0 = 4, key1 = 0, nt1 = 0;
      if (samp) { const int lo = min(max(qb * 128 - 128, 0), 4096 - 384); nt0 = 8; key1 = 512 + lo; nt1 = 6; }
      attn_item<64>(DQ + qoff, Kp, Vp, nkeys, nt0, key1, nt1, samp, qb * 128, true, p.in[27][hd] * LOG2E, AC + (size_t)tok * 1024 + 512 + hd * 64, 1024, shm + half * LDS_BYTES);
    }
  }
}

namespace pg8 {
#define PG8_LAS __attribute__((address_space(3)))
typedef unsigned short bf16_t;
typedef short bf16x8 __attribute__((ext_vector_type(8)));
typedef float f32x4 __attribute__((ext_vector_type(4)));
typedef unsigned u32x4 __attribute__((ext_vector_type(4)));
constexpr int BM = 256, BK = 64, HALF = 128, HTB = HALF * BK * 2  , STAGE_BYTES = 8 * HTB, NXCD = 8, WGM = 8;

__host__ __device__ __forceinline__ int lds_byte(int r, int c) { const int st = (r >> 4) * 2 + (c >> 5), rr = r & 15, cc = c & 31, ob = rr * 64 + cc * 2; return st * 1024 + (ob ^ (((ob >> 9) & 1) << 5)); }
__host__ __device__ __forceinline__ void stage_rc(int b, int& R, int& C) { const int st = b / 1024, sb = b % 1024, swz = sb ^ (((sb >> 9) & 1) << 5); R = (st >> 1) * 16 + swz / 64; C = (st & 1) * 32 + (swz % 64) / 2; }
__host__ __device__ __forceinline__ int perm32(int rho) { const int n = rho >> 4, i = rho & 15; return 8 * (i >> 2) + 4 * n + (i & 3); }

struct Unit { int pm, pn; };
struct Gemm { const bf16_t* A; const bf16_t* Bt; int M, N, K; };

struct StaticOrder {
    int nM, nN, nwg, G, c;
    __host__ __device__ void init(int M, int N, int G_, int c_) { nM = M / BM; nN = N / BM; nwg = nM * nN; G = G_; c = c_; }
    __host__ __device__ bool next(int i, Unit& u) const {
        const long L = (long)i * G + c; if (L >= nwg) return false;
        int wgid = (int)L; { const int q = nwg / NXCD, r = nwg % NXCD, xcd = wgid % NXCD, off = wgid / NXCD; wgid = (xcd < r ? xcd * (q + 1) : r * (q + 1) + (xcd - r) * q) + off; }
        const int nig = WGM * nN, gid = wgid / nig, fm = gid * WGM, gsz = (nM - fm) < WGM ? (nM - fm) : WGM;
        u.pm = fm + ((wgid % nig) % gsz); u.pn = (wgid % nig) / gsz; return true;
    }
    __device__ __forceinline__ void a_ready(const Unit&) const {}
    __device__ __forceinline__ void done(const Unit&) const {}
};
template <class Epi, class Sched, bool STAMP = false, int MB = 4>
__device__ __forceinline__ void gemm_phase(PG8_LAS unsigned char* lds, const Gemm g, const Sched& S, const Epi& E, unsigned long long* stamps) {
    const int tid = threadIdx.x, wid = __builtin_amdgcn_readfirstlane(tid >> 6), lane = tid & 63, wr = wid >> 2, wc = wid & 3, fr = lane & 15, fq = lane >> 4;
    const int K = g.K, nt = K / BK;
    int ts_lo = 0, ts_hi = 0, nts = 0; const unsigned long long rt_entry = STAMP ? (unsigned long long)wall_clock64() : 0ull;
#define PG8_STAMP() do { if (STAMP && wid == 0 && nts < 64) { const unsigned long long _c = (unsigned long long)clock64(); \
        ts_lo = (lane == nts) ? (int)(unsigned)_c : ts_lo; ts_hi = (lane == nts) ? (int)(unsigned)(_c >> 32) : ts_hi; ++nts; } } while (0)
    PG8_STAMP();
    unsigned voffA[2], voffB[2];
#pragma unroll
    for (int i = 0; i < 2; ++i) { int R, C; stage_rc(tid * 16 + i * 8192, R, C); const int Rb = Epi::PERM ? ((R & ~31) + perm32(R & 31)) : R;
        voffA[i] = (unsigned)(R * K + C) * 2u; voffB[i] = (unsigned)(Rb * K + C) * 2u; }
    const size_t kstep = (size_t)(BK * 2);
    const size_t hstep = (size_t)HALF * K * 2; const size_t hstepA = (size_t)(32 * MB) * K * 2;
    const size_t tstep = 2 * hstep; const size_t tstepA = 2 * hstepA;
    const unsigned ldsw = (unsigned)wid * 1024u;
    const int aoff = lds_byte(wr * 16 * MB + fr, fq * 8), boff = lds_byte(wc * 32 + fr, fq * 8);
#define PG8_SA(b, h) (((b) * 2 + (h)) * HTB)
#define PG8_SB(b, h) ((4 + (b) * 2 + (h)) * HTB)
#define PG8_STAGE(bufoff, gbase, voff) do { _Pragma("unroll") for (int _i = 0; _i < 2; ++_i) \
        __builtin_amdgcn_global_load_lds((const unsigned*)((const char*)(gbase) + (voff)[_i]), (PG8_LAS unsigned*)(lds + (bufoff) + ldsw + _i * 8192), 16, 0, 0); } while (0)
#define PG8_LDA(dst, b, h) do { _Pragma("unroll") for (int m = 0; m < MB; ++m) _Pragma("unroll") for (int k = 0; k < 2; ++k) dst[m][k] = *(const PG8_LAS bf16x8*)(lds + PG8_SA(b, h) + aoff + m * 2048 + k * 1024); } while (0)
#define PG8_LDB(dst, b, h) do { _Pragma("unroll") for (int n = 0; n < 2; ++n) _Pragma("unroll") for (int k = 0; k < 2; ++k) dst[n][k] = *(const PG8_LAS bf16x8*)(lds + PG8_SB(b, h) + boff + n * 2048 + k * 1024); } while (0)
#define PG8_MMA(ai, bj, At, Bt) do { __builtin_amdgcn_s_setprio(1); _Pragma("unroll") for (int m = 0; m < MB; ++m) _Pragma("unroll") for (int n = 0; n < 2; ++n) _Pragma("unroll") for (int k = 0; k < 2; ++k) \
        acc[ai][bj][m][n] = __builtin_amdgcn_mfma_f32_16x16x32_bf16(Bt[n][k], At[m][k], acc[ai][bj][m][n], 0, 0, 0); __builtin_amdgcn_s_setprio(0); } while (0)
#define PG8_WAIT_V(n) asm volatile("s_waitcnt vmcnt(" #n ")" ::: "memory")
#define PG8_WAIT_L(n) asm volatile("s_waitcnt lgkmcnt(" #n ")" ::: "memory")
#define PG8_BAR __builtin_amdgcn_s_barrier()
#define PG8_SCHED __builtin_amdgcn_sched_barrier(0)
    Unit cur, nxt; int ui = 0;
    if (!S.next(0, cur)) return;
    f32x4 acc[2][2][MB][2];
#pragma unroll
    for (int a = 0; a < 2; ++a)
#pragma unroll
        for (int b = 0; b < 2; ++b)
#pragma unroll
            for (int m = 0; m < MB; ++m)
#pragma unroll
                for (int n = 0; n < 2; ++n) acc[a][b][m][n] = (f32x4){0.f, 0.f, 0.f, 0.f};
    bf16x8 At[MB][2], B0[2][2], B1[2][2];
    const char* cA = (const char*)g.A + (size_t)cur.pm * tstepA; const char* cB = (const char*)g.Bt + (size_t)cur.pn * tstep;
    S.a_ready(cur);
    PG8_STAGE(PG8_SB(0, 0), cB, voffB); PG8_STAGE(PG8_SA(0, 0), cA, voffA); PG8_STAGE(PG8_SB(0, 1), cB + hstep, voffB); PG8_STAGE(PG8_SA(0, 1), cA + hstepA, voffA);
    if (wr == 1) PG8_BAR;
    PG8_WAIT_V(4); PG8_BAR;
    PG8_STAGE(PG8_SB(1, 0), cB + kstep, voffB); PG8_STAGE(PG8_SA(1, 0), cA + kstep, voffA); PG8_STAGE(PG8_SB(1, 1), cB + hstep + kstep, voffB);
    PG8_WAIT_V(6); PG8_BAR;
    PG8_STAMP();
    for (;;) {
        const bool has_next = S.next(ui + 1, nxt);
        const char* nA = has_next ? (const char*)g.A + (size_t)nxt.pm * tstepA : cA; const char* nB = has_next ? (const char*)g.Bt + (size_t)nxt.pn * tstep : cB;
        for (int t = 0; t < nt; t += 2) {
            const bool last = (t == nt - 2);
            const char* a1 = cA + (size_t)(t + 1) * kstep;
            const char* a2 = last ? nA : cA + (size_t)(t + 2) * kstep; const char* b2 = last ? nB : cB + (size_t)(t + 2) * kstep;
            const char* a3 = a2 + kstep; const char* b3 = b2 + kstep;
            if (last && has_next) S.a_ready(nxt);
            PG8_LDB(B0, 0, 0); PG8_SCHED; PG8_LDA(At, 0, 0); PG8_STAGE(PG8_SA(1, 1), a1 + hstepA, voffA);
            PG8_WAIT_L(8); PG8_BAR; PG8_WAIT_L(0); PG8_MMA(0, 0, At, B0); PG8_BAR; PG8_SCHED;
            PG8_LDB(B1, 0, 1); PG8_STAGE(PG8_SB(0, 0), b2, voffB);
            PG8_BAR; PG8_WAIT_L(0); PG8_MMA(0, 1, At, B1); PG8_BAR;
            PG8_LDA(At, 0, 1); PG8_STAGE(PG8_SA(0, 0), a2, voffA);
            PG8_BAR; PG8_WAIT_L(0); PG8_MMA(1, 0, At, B0); PG8_BAR; PG8_SCHED;
            PG8_STAGE(PG8_SB(0, 1), b2 + hstep, voffB);
            PG8_WAIT_V(6); PG8_BAR; PG8_MMA(1, 1, At, B1); PG8_BAR;
            PG8_LDB(B0, 1, 0); PG8_SCHED; PG8_LDA(At, 1, 0); PG8_STAGE(PG8_SA(0, 1), a2 + hstepA, voffA);
            PG8_WAIT_L(8); PG8_BAR; PG8_WAIT_L(0); PG8_MMA(0, 0, At, B0); PG8_BAR; PG8_SCHED;
            PG8_LDB(B1, 1, 1); PG8_STAGE(PG8_SB(1, 0), b3, voffB);
            PG8_BAR; PG8_WAIT_L(0); PG8_MMA(0, 1, At, B1); PG8_BAR;
            PG8_LDA(At, 1, 1); PG8_STAGE(PG8_SA(1, 0), a3, voffA);
            PG8_BAR; PG8_WAIT_L(0); PG8_MMA(1, 0, At, B0); PG8_BAR; PG8_SCHED;
            PG8_STAGE(PG8_SB(1, 1), b3 + hstep, voffB);
            PG8_WAIT_V(6); PG8_BAR; PG8_MMA(1, 1, At, B1); PG8_BAR;
        }
        PG8_STAMP();
        if constexpr (!Epi::AFTER_DRAIN) { E(acc, cur, wr, wc, fr, fq); S.done(cur); }
        PG8_STAMP();
        if (!has_next) break;
#pragma unroll
        for (int a = 0; a < 2; ++a)
#pragma unroll
            for (int b = 0; b < 2; ++b)
#pragma unroll
                for (int m = 0; m < MB; ++m)
#pragma unroll
                    for (int n = 0; n < 2; ++n) acc[a][b][m][n] = (f32x4){0.f, 0.f, 0.f, 0.f};
        cur = nxt; cA = nA; cB = nB; ++ui;
    }
    PG8_WAIT_V(0);
    if (wr == 0) PG8_BAR;
    PG8_BAR;
    if constexpr (Epi::AFTER_DRAIN) { E.fused(acc, cur, wr, wc, fr, fq, lds, wid, lane); S.done(cur); }
    PG8_STAMP();
    if (STAMP && wid == 0) { stamps[lane] = lane < nts ? (((unsigned long long)(unsigned)ts_hi << 32) | (unsigned)ts_lo) : 0ull;
        if (lane == 62) stamps[62] = rt_entry; if (lane == 63) stamps[63] = (unsigned long long)wall_clock64(); }
#undef PG8_STAMP
#undef PG8_SA
#undef PG8_SB
#undef PG8_STAGE
#undef PG8_LDA
#undef PG8_LDB
#undef PG8_MMA
#undef PG8_WAIT_V
#undef PG8_WAIT_L
#undef PG8_BAR
#undef PG8_SCHED
}
}

typedef float f32x4 __attribute__((ext_vector_type(4)));
template <class F, int MB> struct RowEpi {
  static constexpr bool PERM = false, AFTER_DRAIN = false;
  F f;
  DI void operator()(const pg8::f32x4 (&acc)[2][2][MB][2], const pg8::Unit& u, int wr, int wc, int fr, int fq) const {
    const int row0 = u.pm * (64 * MB) + wr * 16 * MB + fr, col0 = u.pn * 256 + wc * 32 + 4 * fq;
#pragma unroll
    for (int ai = 0; ai < 2; ++ai)
#pragma unroll
      for (int m = 0; m < MB; ++m)
#pragma unroll
        for (int bj = 0; bj < 2; ++bj)
#pragma unroll
          for (int n = 0; n < 2; ++n) f(row0 + ai * 32 * MB + m * 16, col0 + bj * 128 + n * 16, acc[ai][bj][m][n]);
  }
};
struct FU {
  u16* UA; u16* PQt;
  DI void operator()(int m, int n, pg8::f32x4 v) const {
    if (n < 512) {
      uint2 w; w.x = pack2(v[0], v[1]); w.y = pack2(v[2], v[3]);
      *(uint2*)(UA + (size_t)m * 512 + n) = w;
    } else {
      const int np = n - 512, g = np >> 8, pq = (np >> 7) & 1, mm = np & 127;
      u16* q; size_t st;
      if (m < 4096) { const int b = m >> 8, nl = m & 255; q = PQt + ((size_t)(b * 512 + g * 128 + mm)) * 512 + pq * 256 + nl; st = 512; }
      else { const int ms = m - 4096, b = ms >> 12, nl = ms & 4095; q = PQt + (size_t)16 * 512 * 512 + ((size_t)(b * 512 + g * 128 + mm)) * 8192 + pq * 4096 + nl; st = 8192; }
      q[0] = f2bf(v[0]); q[st] = f2bf(v[1]); q[2 * st] = f2bf(v[2]); q[3 * st] = f2bf(v[3]);
    }
  }
};
struct FRes {
  const float* xin_p; const float* xin_s; float* X; const float* gate;
  DI void operator()(int m, int n, pg8::f32x4 v) const {
    const float* xi = (m < 4096) ? xin_p + (size_t)m * 1024 + n : xin_s + (size_t)(m - 4096) * 1024 + n;
    const float4 x = *(const float4*)xi;
    const float4 g = *(const float4*)(gate + cond_of(m) * 6144 + n);
    *(float4*)(X + (size_t)m * 1024 + n) = make_float4(x.x + g.x * v[0], x.y + g.y * v[1], x.z + g.z * v[2], x.w + g.w * v[3]);
  }
};
struct FRelu2 {
  u16* C;
  DI void operator()(int m, int n, pg8::f32x4 v) const {
    const float a = fmaxf(v[0], 0.f), b = fmaxf(v[1], 0.f), c = fmaxf(v[2], 0.f), d = fmaxf(v[3], 0.f);
    uint2 w; w.x = pack2(a * a, b * b); w.y = pack2(c * c, d * d);
    *(uint2*)(C + (size_t)m * 4096 + n) = w;
  }
};
struct FQkv {
  u16* QKV; u16* CVtP; u16* CVtS; u16* DVtP; u16* DVtS; float* ncv; float* ndv;
  DI void operator()(int m, int n, pg8::f32x4 v) const {
    const bool is_cv = (n >= 1024 && n < 1536), is_dv = (n >= 2176);
    if (!is_cv && !is_dv) {
      uint2 w; w.x = pack2(v[0], v[1]); w.y = pack2(v[2], v[3]);
      *(uint2*)(QKV + (size_t)m * 2304 + n) = w;
      return;
    }
    const int c = is_cv ? n - 1024 : n - 2176;
    const int feat = is_cv ? 512 : 128;
    u16* q; size_t st;
    if (m < 4096) {
      const int b = m >> 8, nl = m & 255;
      q = (is_cv ? CVtP : DVtP) + ((size_t)(b * feat + c)) * 256 + nl; st = 256;
      *(float4*)((is_cv ? ncv : ndv) + (size_t)m * feat + c) = make_float4(v[0], v[1], v[2], v[3]);
    } else {
      const int ms = m - 4096, b = ms >> 12, nl = ms & 4095;
      q = (is_cv ? CVtS : DVtS) + ((size_t)(b * feat + c)) * 4608 + 512 + nl; st = 4608;
    }
    q[0] = f2bf(v[0]); q[st] = f2bf(v[1]); q[2 * st] = f2bf(v[2]); q[3 * st] = f2bf(v[3]);
  }
};
template <int MB, class F>
DI void big_gemm(PG8_LAS unsigned char* lds, const u16* A, const u16* Bt, int M, int N, int K, F f) {
  pg8::Gemm g{A, Bt, M, N, K};
  pg8::StaticOrder S; S.init(M, N, (int)gridDim.x, (int)blockIdx.x);
  S.nM = M / (64 * MB); S.nwg = S.nM * S.nN;
  RowEpi<F, MB> E{f};
  pg8::gemm_phase<RowEpi<F, MB>, pg8::StaticOrder, false, MB>(lds, g, S, E, nullptr);
}

#define XB_TMO      128
#define XB_XCNT(j)  (256  + 64 * (j))
#define XB_XSUB(j)  (1280 + 64 * (j))
#define XB_XGEN(j)  (2304 + 64 * (j))
#define XB_TOP      3328
#define XB_TOPGEN   3392
#define XCD_BAR_WORDS 3456
#define XB_SPIN_CAP (1u << 18)
#define LAS __attribute__((address_space(3)))
DI unsigned xb_ld(unsigned* p)              { return __hip_atomic_load(p, __ATOMIC_RELAXED, __HIP_MEMORY_SCOPE_AGENT); }
DI unsigned xb_add(unsigned* p, unsigned v) { return __hip_atomic_fetch_add(p, v, __ATOMIC_RELAXED, __HIP_MEMORY_SCOPE_AGENT); }
DI unsigned xb_xcc_id() { return (unsigned)__builtin_amdgcn_s_getreg((3 << 11) | 20) & 0xFu; }
#define XB_SPIN(cond, bar) do { unsigned _sp = 0; while (cond) { __builtin_amdgcn_s_sleep(1); \
    if ((++_sp & 255u) == 0u) { if (xb_ld(&(bar)[XB_TMO])) break; if (_sp > XB_SPIN_CAP) { atomicAdd(&(bar)[XB_TMO], 1u); break; } } } } while (0)
struct XcdBarrier { unsigned* bar; unsigned x; volatile LAS unsigned* st; };
DI XcdBarrier xcd_barrier_post(unsigned* bar, volatile LAS unsigned* st) {
  XcdBarrier b; b.bar = bar; b.x = xb_xcc_id(); b.st = st;
  if (threadIdx.x == 0) (void)xb_add(&bar[XB_XCNT(b.x)], 1u);
  return b;
}
DI void xcd_barrier_complete(unsigned* bar, unsigned x, unsigned& nloc, unsigned& nx) {
  const unsigned G = gridDim.x;
  unsigned sum, cnt, mine, sp = 0u;
  for (;;) {
    sum = 0u; cnt = 0u; mine = 0u;
#pragma unroll
    for (unsigned j = 0; j < 16; ++j) { const unsigned c = xb_ld(&bar[XB_XCNT(j)]); sum += c; cnt += (c > 0u) ? 1u : 0u; mine = (j == x) ? c : mine; }
    if (sum == G) break;
    __builtin_amdgcn_s_sleep(1);
    if ((++sp & 255u) == 0u) { if (xb_ld(&bar[XB_TMO])) break; if (sp > XB_SPIN_CAP) { atomicAdd(&bar[XB_TMO], 1u); break; } }
  }
  nloc = mine > 0u ? mine : 1u; nx = cnt > 0u ? cnt : 1u;
}
DI void xcd_barrier(const XcdBarrier& b) {
  asm volatile("s_waitcnt vmcnt(0)" ::: "memory");
  __syncthreads();
  if (threadIdx.x == 0) {
    unsigned* bar = b.bar;
    __builtin_amdgcn_s_waitcnt(0);
    unsigned nloc = b.st[0], nx = b.st[1];
    if (nloc == 0u) { xcd_barrier_complete(bar, b.x, nloc, nx); b.st[0] = nloc; b.st[1] = nx; }
    const unsigned old = xb_add(&bar[XB_XSUB(b.x)], 1u);
    const unsigned gen = old / nloc;
    if (old + 1u == (gen + 1u) * nloc) {
      __builtin_amdgcn_fence(__ATOMIC_RELEASE, "agent");
      asm volatile("s_waitcnt vmcnt(0)" ::: "memory");
      const unsigned og = xb_add(&bar[XB_TOP], 1u);
      const unsigned tg = og / nx;
      if (og + 1u == (tg + 1u) * nx) xb_add(&bar[XB_TOPGEN], 1u);
      else XB_SPIN(xb_ld(&bar[XB_TOPGEN]) == tg, bar);
      __builtin_amdgcn_fence(__ATOMIC_ACQUIRE, "agent");
      xb_add(&bar[XB_XGEN(b.x)], 1u);
      asm volatile("s_waitcnt vmcnt(0)" ::: "memory");
    } else {
      XB_SPIN(xb_ld(&bar[XB_XGEN(b.x)]) == gen, bar);
      __builtin_amdgcn_fence(__ATOMIC_ACQUIRE, "agent");
      asm volatile("s_waitcnt vmcnt(0)" ::: "memory");
    }
  }
  __syncthreads();
}

__global__ void __launch_bounds__(512) fwd_kernel(Params p, int ph_lo, int ph_hi) {
  extern __shared__ __attribute__((aligned(16))) unsigned char shm[];
  const int half = threadIdx.x >> 8;
  char* lds = (char*)shm + half * LDS_BYTES;
  PG8_LAS unsigned char* lds8 = (PG8_LAS unsigned char*)shm;
  const int G = 2 * (int)gridDim.x;
  int vb0 = blockIdx.x;
  if ((gridDim.x & 7) == 0) vb0 = (blockIdx.x & 7) * (gridDim.x >> 3) + (blockIdx.x >> 3);
  const int vb = 2 * vb0 + half;
  unsigned char* ws = p.ws;
  const float* mods = (const float*)(ws + OFF_MODS);
  float* X = p.out + OUT_Y;
  u16* H = (u16*)(ws + OFF_H);

#define RUNPH(n) ((ONLYPH < 0 || ONLYPH == (n)) && ph_lo <= (n) && (n) < ph_hi)
#define REP(n) _Pragma("unroll") for (int rep_ = 0; rep_ < ((DUPPH == (n)) ? 2 : 1); ++rep_)
#define SEAM(n) if (ph_lo < (n) && (n) < ph_hi) xcd_barrier(xb);
  __shared__ uint4 xb_words;
  if (threadIdx.x == 0) xb_words = make_uint4(0u, 0u, 0u, 0u);
  __syncthreads();
  XcdBarrier xb = xcd_barrier_post((unsigned*)(ws + OFF_BAR), (volatile LAS unsigned*)&xb_words);
  if (ph_hi > 1000) cg::this_grid().sync();
  if (RUNPH(0)) REP(0) {
    for (int id = vb; id < 384; id += G) ada_item(p, id, lds);
    prep_transposes(p, vb, G, lds, 0);
    prep_elementwise(p, vb, G);
  }
  SEAM(1)
  if (RUNPH(1)) {
    for (int t = vb; t < 128; t += G) {
      const bool f1 = t < 64;
      const int q = t & 63;
      gemm_tile(f1 ? (const u16*)(ws + OFF_CBD) : (const u16*)(ws + OFF_WOUT_ET), f1 ? 512 : 1024,
                f1 ? (const u16*)(ws + OFF_WINB) : (const u16*)(ws + OFF_BD), f1 ? 512 : 1024, f1 ? 512 : 1024, (q >> 3) << 7, (q & 7) << 7,
                EpiBf16{f1 ? (u16*)(ws + OFF_WIN_E) + (size_t)512 * 1024 : (u16*)(ws + OFF_WOUT_E), 1024}, lds);
    }
    normmod_phase(p, vb, G, p.in[0], p.in[1], p.in[8], 0, 0);
  }
  SEAM(2)
  if (RUNPH(2)) REP(2)
    big_gemm<3>(lds8, H, (const u16*)(ws + OFF_WIN_E), T, 1536, 1024, FU{(u16*)(ws + OFF_UA), (u16*)(ws + OFF_PQT)});
  SEAM(3)
  if (RUNPH(3)) sym_phase(p, vb, G);
  SEAM(4)
  if (RUNPH(4)) REP(4) {
    const u16* PQT = (const u16*)(ws + OFF_PQT);
    const u16* PEQO = (const u16*)(ws + OFF_PEQO);
    for (int t = vb; t < 256 + 128; t += G) {
      const bool big = t < 256;
      const int q = t - 256, b = q >> 3;
      dft_tile(big ? (const u16*)(ws + OFF_D4096) : (const u16*)(ws + OFF_D256),
               big ? PEQO + (size_t)16 * 512 * 256 : PEQO + (size_t)b * 512 * 256,
               big ? PQT + (size_t)16 * 512 * 512 + 2048 : PQT + (size_t)b * 512 * 512 + 128,
               big ? 8192 : 512, big ? 2048 : 128, big ? (t & 15) << 7 : 0, big ? (t >> 4) << 6 : (q & 7) << 6,
               (u16*)(ws + OFF_AB), big ? 4096 : b * 256, 512, big ? 0.0013810679320049757f : 0.005524271728019903f, lds);
    }
    if (vb >= 256) pool_phase(p, vb - 256, G - 256);
  }
  SEAM(5)
  if (RUNPH(5))
    big_gemm<3>(lds8, (const u16*)(ws + OFF_AB), (const u16*)(ws + OFF_WOUT_E), T, 1024, 1024, FRes{p.in[0], p.in[1], X, mods + 2048});
  SEAM(6)
  if (RUNPH(6)) normmod_phase(p, vb, G, X, X + (size_t)4096 * 1024, p.in[9], 0, 1);
  SEAM(7)
  if (RUNPH(7)) REP(7) big_gemm<4>(lds8, H, (const u16*)(ws + OFF_W1), T, 4096, 1024, FRelu2{(u16*)(ws + OFF_M1)});
  SEAM(8)
  if (RUNPH(8)) {
    big_gemm<4>(lds8, (const u16*)(ws + OFF_M1), (const u16*)(ws + OFF_W2), T, 1024, 4096, FRes{X, X + (size_t)4096 * 1024, X, mods + 5120});
    if (blockIdx.x >= 192) prep_transposes(p, ((int)blockIdx.x - 192) * 2 + half, ((int)gridDim.x - 192) * 2, lds, 1);
  }
  SEAM(9)
  if (RUNPH(9)) normmod_phase(p, vb, G, X, X + (size_t)4096 * 1024, p.in[8] + 1024, 1, 0);
  SEAM(10)
  if (RUNPH(10)) big_gemm<4>(lds8, H, (const u16*)(ws + OFF_WIN_O), T, 2304, 1024,
                            FQkv{(u16*)(ws + OFF_QKV), (u16*)(ws + OFF_CVTP), (u16*)(ws + OFF_CVTS), (u16*)(ws + OFF_DVTP), (u16*)(ws + OFF_DVTS), p.out + OUT_NCV, p.out + OUT_NDV});
  SEAM(11)
  if (RUNPH(11)) REP(11) qkvpost_phase(p, vb, G);
  SEAM(12)
  if (RUNPH(12)) REP(12) attention_phase(p, vb0, half, (char*)shm);
  SEAM(13)
  if (RUNPH(13)) big_gemm<3>(lds8, H, (const u16*)(ws + OFF_WOUT_O), T, 1024, 1024, FRes{X, X + (size_t)4096 * 1024, X, mods + 3 * 6144 + 2048});
  SEAM(14)
  if (RUNPH(14)) normmod_phase(p, vb, G, X, X + (size_t)4096 * 1024, p.in[9] + 1024, 1, 1);
  SEAM(15)
  if (RUNPH(15)) big_gemm<4>(lds8, H, (const u16*)(ws + OFF_W1) + (size_t)4096 * 1024, T, 4096, 1024, FRelu2{(u16*)(ws + OFF_M1)});
  SEAM(16)
  if (RUNPH(16)) big_gemm<3>(lds8, (const u16*)(ws + OFF_M1), (const u16*)(ws + OFF_W2) + (size_t)4096 * 1024, T, 1024, 4096, FRes{X, X + (size_t)4096 * 1024, X, mods + 3 * 6144 + 5120});
}

extern "C" void kernel_launch(void* const* d_in, const int* in_sizes, int n_in, void* d_out, int out_size, void* d_ws, size_t ws_size,
                              hipStream_t stream) {
  constexpr int kDynLds = 2 * LDS_BYTES;
  static int grid = 0;
  if (!grid) {
    int dev = 0, cus = 0, per_cu = 0;
    (void)hipGetDevice(&dev);
    (void)hipDeviceGetAttribute(&cus, hipDeviceAttributeMultiprocessorCount, dev);
    if (hipFuncSetAttribute((const void*)fwd_kernel, hipFuncAttributeMaxDynamicSharedMemorySize, kDynLds) != hipSuccess) fprintf(stderr, "hipFuncSetAttribute(%d) failed\n", kDynLds);
    (void)hipOccupancyMaxActiveBlocksPerMultiprocessor(&per_cu, fwd_kernel, 512, kDynLds);
    if (per_cu < 1) fprintf(stderr, "occupancy query says %d blocks/CU\n", per_cu);
    grid = cus;
    if (ws_size < WS_END) fprintf(stderr, "workspace too small: %zu < %zu\n", ws_size, (size_t)WS_END);
  }
  Params p{};
  for (int i = 0; i < 31; ++i) p.in[i] = (const float*)d_in[i];
  p.out = (float*)d_out;
  p.ws = (unsigned char*)d_ws;
#if ONE_LAUNCH
  hipMemsetAsync((char*)d_ws + OFF_BAR, 0, XCD_BAR_WORDS * 4, stream);
  int lo = 0, hi = NPH;
  void* args[] = {&p, &lo, &hi};
  hipError_t e = hipLaunchCooperativeKernel((void*)fwd_kernel, dim3(grid), dim3(512), args, kDynLds, stream);
  if (e != hipSuccess) fprintf(stderr, "cooperative launch failed: %s (grid %d)\n", hipGetErrorString(e), grid);
#else
  for (int ph = 0; ph < NPH; ++ph) hipLaunchKernelGGL(fwd_kernel, dim3(grid), dim3(512), kDynLds, stream, p, ph, ph + 1);
#endif
}
```

```cpp
#include <hip/hip_runtime.h>
#include <hip/hip_cooperative_groups.h>
#include <cstdio>
namespace cg = cooperative_groups;

#ifndef ONE_LAUNCH
#define ONE_LAUNCH 1
#endif

#ifndef ONLYPH
#define ONLYPH -1
#endif
#ifndef DUPPH
#define DUPPH -1
#endif
typedef unsigned short u16;
typedef short bf16x8 __attribute__((ext_vector_type(8)));
typedef float f32x16 __attribute__((ext_vector_type(16)));
typedef __bf16 bf2_t __attribute__((ext_vector_type(2)));
typedef float f2_t __attribute__((ext_vector_type(2)));
typedef unsigned u32x4 __attribute__((ext_vector_type(4)));

#define DI __device__ __forceinline__
#define TIDX ((int)(threadIdx.x & 255u))

constexpr int T = 12288, TP = 4096, DM = 1024;
constexpr int NPH = 17;
constexpr float EPS = 1e-6f;
constexpr float LOG2E = 1.4426950408889634f;
constexpr float QSCALE = 0.125f * LOG2E;
constexpr float LAM_INIT = 0.35550906759f;

constexpr size_t al(size_t x) { return (x + 255) & ~size_t(255); }
constexpr size_t OFF_MODS   = 0;
constexpr size_t OFF_WIN_E  = OFF_MODS + al(2 * 3 * 6144 * 4);
constexpr size_t OFF_WINB   = OFF_WIN_E + al(1536 * 1024 * 2);
constexpr size_t OFF_CBD    = OFF_WINB + al(1024 * 512 * 2);
constexpr size_t OFF_WOUT_ET= OFF_CBD + al(1024 * 512 * 2);
constexpr size_t OFF_BD     = OFF_WOUT_ET + al(1024 * 1024 * 2);
constexpr size_t OFF_WOUT_E = OFF_BD + al(1024 * 1024 * 2);
constexpr size_t OFF_WIN_O  = OFF_WOUT_E + al(1024 * 1024 * 2);
constexpr size_t OFF_WOUT_O = OFF_WIN_O + al(2304 * 1024 * 2);
constexpr size_t OFF_W1     = OFF_WOUT_O + al(1024 * 1024 * 2);
constexpr size_t OFF_W2     = OFF_W1 + al(2 * 4096 * 1024 * 2);
constexpr size_t OFF_D256   = OFF_W2 + al(2 * 4096 * 1024 * 2);
constexpr size_t OFF_H      = OFF_D256 + al(256 * 512 * 2);
constexpr size_t OFF_R2     = OFF_H + al((size_t)T * 1024 * 2);
constexpr size_t R2_BYTES   = (size_t)T * 512 * 2 + (size_t)T * 1024 * 2 * 2;
constexpr size_t OFF_R1     = OFF_R2 + al(R2_BYTES);
constexpr size_t R1_BYTES   = (size_t)T * 4096 * 2;
constexpr size_t OFF_BAR    = OFF_R1 + R1_BYTES;
constexpr size_t WS_END     = OFF_BAR + 3456 * 4;
constexpr size_t OFF_UA  = OFF_R2;
constexpr size_t OFF_PQT = OFF_UA + (size_t)T * 512 * 2;
constexpr size_t OFF_AB  = OFF_PQT + (size_t)T * 1024 * 2;
constexpr size_t OFF_CQ   = OFF_R2;
constexpr size_t OFF_DQ   = OFF_CQ + (size_t)T * 512 * 2;
constexpr size_t OFF_CKP  = OFF_DQ + (size_t)T * 512 * 2;
constexpr size_t OFF_CKS  = OFF_CKP + (size_t)16 * 8 * 256 * 64 * 2;
constexpr size_t OFF_CVTP = OFF_CKS + (size_t)2 * 8 * 4608 * 64 * 2;
constexpr size_t OFF_CVTS = OFF_CVTP + (size_t)16 * 4 * 128 * 256 * 2;
constexpr size_t OFF_DKP  = OFF_CVTS + (size_t)2 * 4 * 128 * 4608 * 2;
constexpr size_t OFF_DKS  = OFF_DKP + (size_t)16 * 2 * 256 * 64 * 2;
constexpr size_t OFF_DVTP = OFF_DKS + (size_t)2 * 2 * 4608 * 64 * 2;
constexpr size_t OFF_DVTS = OFF_DVTP + (size_t)16 * 2 * 64 * 256 * 2;
constexpr size_t R2_LATE_END = OFF_DVTS + (size_t)2 * 2 * 64 * 4608 * 2;
static_assert(R2_LATE_END <= OFF_R2 + R2_BYTES, "R2 overflow");
constexpr size_t OFF_D4096 = OFF_R1;
constexpr size_t OFF_PEQO  = OFF_R1 + (size_t)32 * 1024 * 1024;
constexpr size_t OFF_M1    = OFF_R1;
constexpr size_t OFF_QKV   = OFF_R1;
constexpr size_t OFF_OM    = OFF_R1 + al((size_t)T * 2304 * 2);
static_assert(OFF_OM + (size_t)T * 1024 * 2 <= WS_END, "R1 overflow");

constexpr size_t OUT_Y   = 0;
constexpr size_t OUT_NCK = (size_t)T * 1024;
constexpr size_t OUT_NCV = OUT_NCK + (size_t)TP * 512;
constexpr size_t OUT_NDK = OUT_NCV + (size_t)TP * 512;
constexpr size_t OUT_NDV = OUT_NDK + (size_t)TP * 128;

struct Params {
  const float* in[31];
  float* out;
  unsigned char* ws;
};

DI float bf2f(u16 v) { return __uint_as_float(((unsigned)v) << 16); }
DI unsigned pack2(float a, float b) { f2_t f = {a, b}; bf2_t v = __builtin_convertvector(f, bf2_t); return __builtin_bit_cast(unsigned, v); }
DI u16 f2bf(float a) { return (u16)(pack2(a, 0.f) & 0xffffu); }
DI int cond_of(int m) { return m < 4096 ? 0 : (m < 8192 ? 1 : 2); }
DI float wave_sum(float v) {
#pragma unroll
  for (int o = 32; o >= 1; o >>= 1) v += __shfl_xor(v, o);
  return v;
}
#define MFMA(a, b, c) __builtin_amdgcn_mfma_f32_32x32x16_bf16((a), (b), (c), 0, 0, 0)

constexpr int LROW = 144;
constexpr int GEMM_BUF = 2 * 128 * LROW;
constexpr int LDS_BYTES = 2 * GEMM_BUF;

template <int NR>
DI void g_load(u32x4 (&R)[NR], const u16* g, int ld, int k0) {
#pragma unroll
  for (int i = 0; i < NR; ++i) R[i] = *(const u32x4*)(g + (size_t)(32 * i) * ld + k0);
}
template <int NR>
DI void g_store(const u32x4 (&R)[NR], char* sw) {
#pragma unroll
  for (int i = 0; i < NR; ++i) *(u32x4*)(sw + (32 * i) * LROW) = R[i];
}
template <int NB>
DI void g_compute(f32x16 (&acc)[2][NB], const char* fa, const char* fb) {
#pragma unroll
  for (int ks = 0; ks < 4; ++ks) {
    bf16x8 a0 = *(const bf16x8*)(fa + ks * 32);
    bf16x8 a1 = *(const bf16x8*)(fa + 32 * LROW + ks * 32);
#pragma unroll
    for (int j = 0; j < NB; ++j) {
      bf16x8 b = *(const bf16x8*)(fb + j * 32 * LROW + ks * 32);
      acc[0][j] = MFMA(a0, b, acc[0][j]);
      acc[1][j] = MFMA(a1, b, acc[1][j]);
    }
  }
}
template <int NB>
DI void gemm_acc(f32x16 (&acc)[2][NB], const u16* A, int lda, const u16* Bt, int ldb, int K, int m0, int n0, char* lds) {
  const int tid = TIDX, lane = tid & 63, wave = tid >> 6;
  const int r = lane & 31, h = lane >> 5;
  const int wm = wave >> 1, wn = wave & 1;
  const int lrow = tid >> 3, lcol = (tid & 7) * 8;
  const u16* ga = A + (size_t)(m0 + lrow) * lda + lcol;
  const u16* gb = Bt + (size_t)(n0 + lrow) * ldb + lcol;
  u32x4 ra0[4], ra1[4], rb0[2 * NB], rb1[2 * NB];
  const int nk = K >> 6;
  char* sw = lds + lrow * LROW + lcol * 2;
  const char* fa = lds + (wm * 64 + r) * LROW + h * 16;
  const char* fb = lds + 128 * LROW + (wn * 32 * NB + r) * LROW + h * 16;
#define G_LOAD(RA, RB, kt_) do { const int k0_ = ((kt_) < nk ? (kt_) : nk - 1) << 6; g_load<4>(RA, ga, lda, k0_); g_load<2 * NB>(RB, gb, ldb, k0_); } while (0)
#define G_STORE(RA, RB, boff_) do { g_store<4>(RA, sw + (boff_)); g_store<2 * NB>(RB, sw + (boff_) + 128 * LROW); } while (0)
  G_LOAD(ra0, rb0, 0);
  G_LOAD(ra1, rb1, 1);
  G_STORE(ra0, rb0, 0);
  __syncthreads();
  for (int kt = 0; kt < nk; kt += 2) {
    G_LOAD(ra0, rb0, kt + 2);
    g_compute<NB>(acc, fa, fb);
    G_STORE(ra1, rb1, GEMM_BUF);
    __syncthreads();
    G_LOAD(ra1, rb1, kt + 3);
    g_compute<NB>(acc, fa + GEMM_BUF, fb + GEMM_BUF);
    G_STORE(ra0, rb0, 0);
    __syncthreads();
  }
#undef G_LOAD
#undef G_STORE
}

template <class Epi>
DI void gemm_tile(const u16* A, int lda, const u16* Bt, int ldb, int K, int m0, int n0, Epi epi, char* lds) {
  const int lane = TIDX & 63, wave = TIDX >> 6;
  const int r = lane & 31, h = lane >> 5, wm = wave >> 1, wn = wave & 1;
  f32x16 acc[2][2];
#pragma unroll
  for (int i = 0; i < 2; ++i)
#pragma unroll
    for (int j = 0; j < 2; ++j)
#pragma unroll
      for (int e = 0; e < 16; ++e) acc[i][j][e] = 0.f;
  gemm_acc<2>(acc, A, lda, Bt, ldb, K, m0, n0, lds);
#pragma unroll
  for (int i = 0; i < 2; ++i)
#pragma unroll
    for (int j = 0; j < 2; ++j)
#pragma unroll
      for (int q = 0; q < 4; ++q) {
        const int m = m0 + wm * 64 + i * 32 + 8 * q + 4 * h;
        const int n = n0 + wn * 64 + j * 32 + r;
        epi(m, n, acc[i][j][4 * q], acc[i][j][4 * q + 1], acc[i][j][4 * q + 2], acc[i][j][4 * q + 3]);
      }
}

DI void dft_pair(const u16* Dm, const u16* PeQo, const u16* PH, int phstride, int H, int m0, int n0, u16* AB, int rowbase, int colsPerBatch, float norm, char* shm, int half) {
  char* lds = shm + half * LDS_BYTES;
  const int lane = TIDX & 63, wave = TIDX >> 6;
  const int r = lane & 31, h = lane >> 5, wm = wave >> 1, wn = wave & 1;
  f32x16 acc[2][1];
#pragma unroll
  for (int i = 0; i < 2; ++i)
#pragma unroll
    for (int e = 0; e < 16; ++e) acc[i][0][e] = 0.f;
  gemm_acc<1>(acc, Dm + half * H, 2 * H, PeQo + half * H, 2 * H, H, m0, n0, lds);
  float* exo = (float*)lds + wave * 2048 + lane;
  const float* exr = (const float*)(shm + (1 - half) * LDS_BYTES) + wave * 2048 + lane;
#pragma unroll
  for (int i = 0; i < 2; ++i)
#pragma unroll
    for (int e = 0; e < 16; ++e) exo[(i * 16 + e) * 64] = acc[i][0][e];
  __syncthreads();
  const int N = 2 * H;
  const int col = n0 + wn * 32 + r;
  const int b = col / colsPerBatch, c = col - b * colsPerBatch;
  const float ph = bf2f(PH[(size_t)col * phstride]);
  u16* base = AB + ((size_t)rowbase + (size_t)b * N) * 1024 + 512 + c;
#pragma unroll
  for (int i = 0; i < 2; ++i)
#pragma unroll
    for (int q = 0; q < 4; ++q)
#pragma unroll
      for (int e = 0; e < 4; ++e) {
        const int k = m0 + wm * 64 + i * 32 + 8 * q + 4 * h + e;
        const float other = exr[(i * 16 + 4 * q + e) * 64];
        const float sp = (k & 1) ? -ph : ph;
        if (half == 0) base[(size_t)k * 1024] = f2bf((acc[i][0][4 * q + e] + sp - other) * norm);
        else if (k > 0) base[(size_t)(N - k) * 1024] = f2bf((other + sp + acc[i][0][4 * q + e]) * norm);
      }
  __syncthreads();
}

struct EpiBf16 {
  u16* C; int ldc;
  DI void operator()(int m, int n, float v0, float v1, float v2, float v3) const {
    u16* p = C + (size_t)m * ldc + n;
    p[0] = f2bf(v0); p[ldc] = f2bf(v1); p[2 * ldc] = f2bf(v2); p[3 * ldc] = f2bf(v3);
  }
};
struct EpiU {
  u16* UA; u16* PQt;
  DI void operator()(int m, int n, float v0, float v1, float v2, float v3) const {
    if (n < 512) {
      u16* p = UA + (size_t)m * 512 + n;
      p[0] = f2bf(v0); p[512] = f2bf(v1); p[1024] = f2bf(v2); p[1536] = f2bf(v3);
    } else {
      const int np = n - 512, g = np >> 8, pq = (np >> 7) & 1, mm = np & 127;
      size_t off;
      if (m < 4096) { const int b = m >> 8, nl = m & 255; off = ((size_t)(b * 512 + g * 128 + mm)) * 512 + pq * 256 + nl; }
      else { const int ms = m - 4096, b = ms >> 12, nl = ms & 4095; off = (size_t)16 * 512 * 512 + ((size_t)(b * 512 + g * 128 + mm)) * 8192 + pq * 4096 + nl; }
      uint2 w; w.x = pack2(v0, v1); w.y = pack2(v2, v3);
      *(uint2*)(PQt + off) = w;
    }
  }
};
struct EpiDft {
  u16* AB; int rowbase; float norm; int sample;
  DI void operator()(int m, int n, float v0, float v1, float v2, float v3) const {
    size_t row; int c;
    if (sample) { row = (size_t)4096 + (size_t)(n >> 9) * 4096 + m; c = n & 511; }
    else { row = (size_t)rowbase + m; c = n; }
    u16* p = AB + row * 1024 + 512 + c;
    p[0] = f2bf(v0 * norm); p[1024] = f2bf(v1 * norm); p[2048] = f2bf(v2 * norm); p[3072] = f2bf(v3 * norm);
  }
};
struct EpiRes {
  const float* xin_p; const float* xin_s;
  float* X; const float* gate;
  DI void operator()(int m, int n, float v0, float v1, float v2, float v3) const {
    const float* xi = (m < 4096) ? xin_p + (size_t)m * 1024 + n : xin_s + (size_t)(m - 4096) * 1024 + n;
    const float g = gate[cond_of(m) * 6144 + n];
    float* xo = X + (size_t)m * 1024 + n;
    xo[0] = xi[0] + g * v0; xo[1024] = xi[1024] + g * v1; xo[2048] = xi[2048] + g * v2; xo[3072] = xi[3072] + g * v3;
  }
};
struct EpiRelu2 {
  u16* C;
  DI void operator()(int m, int n, float v0, float v1, float v2, float v3) const {
    v0 = fmaxf(v0, 0.f); v1 = fmaxf(v1, 0.f); v2 = fmaxf(v2, 0.f); v3 = fmaxf(v3, 0.f);
    u16* p = C + (size_t)m * 4096 + n;
    p[0] = f2bf(v0 * v0); p[4096] = f2bf(v1 * v1); p[8192] = f2bf(v2 * v2); p[12288] = f2bf(v3 * v3);
  }
};
struct EpiQkv {
  u16* QKV; u16* CVtP; u16* CVtS; u16* DVtP; u16* DVtS; float* ncv; float* ndv;
  DI void operator()(int m, int n, float v0, float v1, float v2, float v3) const {
    const bool is_cv = (n >= 1024 && n < 1536), is_dv = (n >= 2176);
    if (!is_cv && !is_dv) {
      u16* p = QKV + (size_t)m * 2304 + n;
      p[0] = f2bf(v0); p[2304] = f2bf(v1); p[4608] = f2bf(v2); p[6912] = f2bf(v3);
      return;
    }
    uint2 w; w.x = pack2(v0, v1); w.y = pack2(v2, v3);
    if (is_cv) {
      const int c = n - 1024;
      if (m < 4096) {
        const int b = m >> 8, nl = m & 255;
        *(uint2*)(CVtP + ((size_t)(b * 512 + c)) * 256 + nl) = w;
        float* o = ncv + (size_t)m * 512 + c; o[0] = v0; o[512] = v1; o[1024] = v2; o[1536] = v3;
      } else {
        const int ms = m - 4096, b = ms >> 12, nl = ms & 4095;
        *(uint2*)(CVtS + ((size_t)(b * 512 + c)) * 4608 + 512 + nl) = w;
      }
    } else {
      const int c = n - 2176;
      if (m < 4096) {
        const int b = m >> 8, nl = m & 255;
        *(uint2*)(DVtP + ((size_t)(b * 128 + c)) * 256 + nl) = w;
        float* o = ndv + (size_t)m * 128 + c; o[0] = v0; o[128] = v1; o[256] = v2; o[384] = v3;
      } else {
        const int ms = m - 4096, b = ms >> 12, nl = ms & 4095;
        *(uint2*)(DVtS + ((size_t)(b * 128 + c)) * 4608 + 512 + nl) = w;
      }
    }
  }
};

DI void ada_item(const Params& p, int id, char* lds) {
  const int tid = TIDX;
  float* ssil = (float*)lds;
  float* red = (float*)(lds + 12288);
  const int l = id / 192, cb = id % 192;
  for (int i = tid; i < 3072; i += 256) {
    const int j = i >> 10, k = i & 1023;
    const float v = (j == 0) ? p.in[7][k] : p.in[2][(j - 1) * 1024 + k];
    ssil[i] = v / (1.f + __expf(-v));
  }
  __syncthreads();
  const int cq = tid & 7, kg = tid >> 3;
  const float* w = p.in[10] + (size_t)l * 1024 * 6144 + cb * 32 + cq * 4;
  float4 a0 = {0, 0, 0, 0}, a1 = {0, 0, 0, 0}, a2 = {0, 0, 0, 0};
#pragma unroll 8
  for (int kk = 0; kk < 32; ++kk) {
    const int k = kg * 32 + kk;
    const float4 wv = *(const float4*)(w + (size_t)k * 6144);
    const float s0 = ssil[k], s1 = ssil[1024 + k], s2 = ssil[2048 + k];
    a0.x += s0 * wv.x; a0.y += s0 * wv.y; a0.z += s0 * wv.z; a0.w += s0 * wv.w;
    a1.x += s1 * wv.x; a1.y += s1 * wv.y; a1.z += s1 * wv.z; a1.w += s1 * wv.w;
    a2.x += s2 * wv.x; a2.y += s2 * wv.y; a2.z += s2 * wv.z; a2.w += s2 * wv.w;
  }
  float* rp = red + kg * 96 + cq * 4;
  rp[0] = a0.x; rp[1] = a0.y; rp[2] = a0.z; rp[3] = a0.w;
  rp[32] = a1.x; rp[33] = a1.y; rp[34] = a1.z; rp[35] = a1.w;
  rp[64] = a2.x; rp[65] = a2.y; rp[66] = a2.z; rp[67] = a2.w;
  __syncthreads();
  if (tid < 96) {
    const int j = tid >> 5, c = tid & 31;
    float sum = 0.f;
#pragma unroll
    for (int g = 0; g < 32; ++g) sum += red[g * 96 + j * 32 + c];
    const int col = cb * 32 + c;
    ((float*)(p.ws + OFF_MODS))[(size_t)(l * 3 + j) * 6144 + col] = sum + p.in[11][l * 6144 + col];
  }
  __syncthreads();
}

DI void transpose_tile(const float* src, int ld_src, u16* dst, int ld_dst, int r0, int c0, char* lds) {
  float* tile = (float*)lds;
  const int tid = TIDX;
  const int j4 = (tid & 15) * 4, i0 = tid >> 4;
#pragma unroll
  for (int it = 0; it < 4; ++it) {
    const int i = i0 + 16 * it;
    const float4 v = *(const float4*)(src + (size_t)(r0 + i) * ld_src + c0 + j4);
    float* tp = tile + i * 65 + j4;
    tp[0] = v.x; tp[1] = v.y; tp[2] = v.z; tp[3] = v.w;
  }
  __syncthreads();
  const int kc = (tid & 7) * 8, jr = tid >> 3;
#pragma unroll
  for (int it = 0; it < 2; ++it) {
    const int j = jr + 32 * it;
    const float* tp = tile + kc * 65 + j;
    uint4 o;
    o.x = pack2(tp[0], tp[65]); o.y = pack2(tp[130], tp[195]); o.z = pack2(tp[260], tp[325]); o.w = pack2(tp[390], tp[455]);
    *(uint4*)(dst + (size_t)(c0 + j) * ld_dst + r0 + kc) = o;
  }
  __syncthreads();
}

DI void prep_transposes(const Params& p, int vb, int G, char* lds, int layer) {
  const int ntile = layer ? 2880 : 2432;
  for (int t = vb; t < ntile; t += G) {
    const float* src; u16* dst; int lds_, ldd, r0, c0;
    int q = t;
    if (layer == 0) {
      if (q < 128) { src = p.in[12]; lds_ = 1024; dst = (u16*)(p.ws + OFF_WIN_E); ldd = 1024; r0 = (q >> 3) * 64; c0 = (q & 7) * 64; }
      else if ((q -= 128) < 256) { src = p.in[16]; lds_ = 1024; dst = (u16*)(p.ws + OFF_WOUT_ET); ldd = 1024; r0 = (q >> 4) * 64; c0 = (q & 15) * 64; }
      else if ((q -= 256) < 1024) { src = p.in[29]; lds_ = 4096; dst = (u16*)(p.ws + OFF_W1); ldd = 1024; r0 = (q >> 6) * 64; c0 = (q & 63) * 64; }
      else { q -= 1024; src = p.in[30]; lds_ = 1024; dst = (u16*)(p.ws + OFF_W2); ldd = 4096; r0 = (q >> 4) * 64; c0 = (q & 15) * 64; }
    } else {
      if (q < 576) { src = p.in[17]; lds_ = 2304; dst = (u16*)(p.ws + OFF_WIN_O); ldd = 1024; r0 = (q / 36) * 64; c0 = (q % 36) * 64; }
      else if ((q -= 576) < 256) { src = p.in[28]; lds_ = 1024; dst = (u16*)(p.ws + OFF_WOUT_O); ldd = 1024; r0 = (q >> 4) * 64; c0 = (q & 15) * 64; }
      else if ((q -= 256) < 1024) { src = p.in[29] + (size_t)1024 * 4096; lds_ = 4096; dst = (u16*)(p.ws + OFF_W1) + (size_t)4096 * 1024; ldd = 1024; r0 = (q >> 6) * 64; c0 = (q & 63) * 64; }
      else { q -= 1024; src = p.in[30] + (size_t)4096 * 1024; lds_ = 1024; dst = (u16*)(p.ws + OFF_W2) + (size_t)1024 * 4096; ldd = 4096; r0 = (q >> 4) * 64; c0 = (q & 15) * 64; }
    }
    transpose_tile(src, lds_, dst, ldd, r0, c0, lds);
  }
}

DI void prep_elementwise(const Params& p, int vb, int G) {
  const size_t gt = (size_t)vb * 256 + TIDX, gs = (size_t)G * 256;
  {
    u16* d = (u16*)(p.ws + OFF_WINB);
    for (size_t i = gt; i < 1024 * 256; i += gs) {
      const int k = (int)(i >> 8), c = (int)(i & 255) * 2;
      const float* s = p.in[12] + (size_t)k * 1024 + 512 + c;
      *(unsigned*)(d + (size_t)k * 512 + c) = pack2(s[0], s[1]);
    }
  }
  {
    u16* d = (u16*)(p.ws + OFF_CBD);
    for (size_t i = gt; i < 1024 * 512; i += gs) {
      const int np = (int)(i >> 9), cp = (int)(i & 511);
      const int g = np >> 8, pq = (np >> 7) & 1, m = np & 127;
      float v = 0.f;
      if ((cp >> 7) == g) {
        const int c = cp & 127; const int rr = (m * c) & 127;
        const float x = (float)rr * (2.0f / 128.0f);
        v = pq ? sinpif(x) : cospif(x);
      }
      d[i] = f2bf(v);
    }
  }
  {
    u16* d = (u16*)(p.ws + OFF_BD);
    for (size_t i = gt; i < 1024 * 1024; i += gs) {
      const int kp = (int)(i >> 10), c = (int)(i & 1023);
      float v = 0.f;
      if (kp < 512) { const int g = kp >> 7; if (c < 512 && (c >> 7) == g) v = p.in[13][(size_t)g * 16384 + (kp & 127) * 128 + (c & 127)] * p.in[14][c]; }
      else { const int g = (kp - 512) >> 7; if (c >= 512 && ((c - 512) >> 7) == g) v = p.in[15][(size_t)g * 16384 + ((kp - 512) & 127) * 128 + ((c - 512) & 127)]; }
      d[i] = f2bf(v);
    }
  }
#pragma unroll 1
  for (int which = 0; which < 2; ++which) {
    const int H = which ? 2048 : 128, N = 2 * H, lg = which ? 9 : 5;
    u16* d = (u16*)(p.ws + (which ? OFF_D4096 : OFF_D256));
    const float invN = 1.0f / (float)N;
    for (size_t i = gt; i < ((size_t)H << lg); i += gs) {
      const int k = (int)(i >> lg), np = (int)(i & ((1 << lg) - 1)) * 8;
      const bool is_sin = np >= H;
      const int n = np & (H - 1);
      unsigned w[4];
#pragma unroll
      for (int e = 0; e < 4; ++e) {
        const float x0 = (float)((k * (n + 2 * e)) & (N - 1)) * invN, x1 = (float)((k * (n + 2 * e + 1)) & (N - 1)) * invN;
        const float v0 = is_sin ? __builtin_amdgcn_sinf(x0) : __builtin_amdgcn_cosf(x0);
        const float v1 = is_sin ? __builtin_amdgcn_sinf(x1) : __builtin_amdgcn_cosf(x1);
        w[e] = pack2(v0, v1);
      }
      *(uint4*)(d + (size_t)k * N + np) = make_uint4(w[0], w[1], w[2], w[3]);
    }
  }
}

DI void sym_phase(const Params& p, int vb, int G) {
  const int lane = TIDX & 63, wave = TIDX >> 6;
  const u16* PQT = (const u16*)(p.ws + OFF_PQT);
  u16* PEQO = (u16*)(p.ws + OFF_PEQO);
  u16* AB = (u16*)(p.ws + OFF_AB);
  for (int it = vb * 4 + wave; it < 1024 + 2048; it += G * 4) {
    const bool samp = it < 1024;
    const int H = samp ? 2048 : 128, N = 2 * H;
    int col, n0base, nstep;
    if (samp) { col = it; n0base = lane * 8; nstep = 512; }
    else { col = (it - 1024) * 4 + (lane >> 4); n0base = (lane & 15) * 8; nstep = 128; }
    const u16* Pp = samp ? PQT + (size_t)16 * 512 * 512 + (size_t)col * 8192 : PQT + (size_t)col * 512;
    const u16* Qp = Pp + N;
    u16* Pe = samp ? PEQO + (size_t)16 * 512 * 256 + (size_t)col * 4096 : PEQO + (size_t)col * 256;
    u16* Qo = Pe + H;
    float alt = 0.f;
    for (int n0 = n0base; n0 < H; n0 += nstep) {
      const uint4 pw = *(const uint4*)(Pp + n0), qw = *(const uint4*)(Qp + n0);
      const unsigned pa[4] = {pw.x, pw.y, pw.z, pw.w}, qa[4] = {qw.x, qw.y, qw.z, qw.w};
      float pe[8], qo[8];
#pragma unroll
      for (int e = 0; e < 8; ++e) {
        const float pv = (e & 1) ? __uint_as_float(pa[e >> 1] & 0xffff0000u) : __uint_as_float(pa[e >> 1] << 16);
        const float qv = (e & 1) ? __uint_as_float(qa[e >> 1] & 0xffff0000u) : __uint_as_float(qa[e >> 1] << 16);
        const int n = n0 + e;
        float pm = 0.f, qm = 0.f;
        if (n > 0) { pm = bf2f(Pp[N - n]); qm = bf2f(Qp[N - n]); }
        pe[e] = pv + pm;
        qo[e] = (n > 0) ? qv - qm : 0.f;
        alt += (e & 1) ? -pe[e] : pe[e];
      }
      *(uint4*)(Pe + n0) = make_uint4(pack2(pe[0], pe[1]), pack2(pe[2], pe[3]), pack2(pe[4], pe[5]), pack2(pe[6], pe[7]));
      *(uint4*)(Qo + n0) = make_uint4(pack2(qo[0], qo[1]), pack2(qo[2], qo[3]), pack2(qo[4], qo[5]), pack2(qo[6], qo[7]));
    }
    alt += __shfl_xor(alt, 1); alt += __shfl_xor(alt, 2); alt += __shfl_xor(alt, 4); alt += __shfl_xor(alt, 8);
    if (samp) { alt += __shfl_xor(alt, 16); alt += __shfl_xor(alt, 32); }
    if ((samp && lane == 0) || (!samp && (lane & 15) == 0)) {
      const float fh = alt + bf2f(Pp[H]);
      size_t row; int c; float norm;
      if (samp) { row = (size_t)4096 + (size_t)(col >> 9) * 4096 + 2048; c = col & 511; norm = 0.0013810679320049757f; }
      else { row = (size_t)(col >> 9) * 256 + 128; c = col & 511; norm = 0.005524271728019903f; }
      AB[row * 1024 + 512 + c] = f2bf(fh * norm);
    }
  }
}

DI void normmod_phase(const Params& p, int vb, int G, const float* xp, const float* xs, const float* gain, int l, int which) {
  const int lane = TIDX & 63, wave = TIDX >> 6;
  u16* H = (u16*)(p.ws + OFF_H);
  const float* mods = (const float*)(p.ws + OFF_MODS) + (size_t)l * 3 * 6144;
  for (int row = vb * 4 + wave; row < T; row += G * 4) {
    const float* x = (row < 4096) ? xp + (size_t)row * 1024 : xs + (size_t)(row - 4096) * 1024;
    float4 v[4];
    float ss = 0.f;
#pragma unroll
    for (int i = 0; i < 4; ++i) {
      v[i] = *(const float4*)(x + i * 256 + lane * 4);
      ss += v[i].x * v[i].x + v[i].y * v[i].y + v[i].z * v[i].z + v[i].w * v[i].w;
    }
    ss = wave_sum(ss);
    const float rinv = rsqrtf(ss * (1.0f / 1024.0f) + EPS);
    const float* md = mods + cond_of(row) * 6144 + which * 3072;
#pragma unroll
    for (int i = 0; i < 4; ++i) {
      const int c = i * 256 + lane * 4;
      const float4 g = *(const float4*)(gain + c);
      const float4 sh = *(const float4*)(md + c);
      const float4 sc = *(const float4*)(md + 1024 + c);
      const float o0 = v[i].x * rinv * g.x * (1.f + sc.x) + sh.x;
      const float o1 = v[i].y * rinv * g.y * (1.f + sc.y) + sh.y;
      const float o2 = v[i].z * rinv * g.z * (1.f + sc.z) + sh.z;
      const float o3 = v[i].w * rinv * g.w * (1.f + sc.w) + sh.w;
      uint2 w; w.x = pack2(o0, o1); w.y = pack2(o2, o3);
      *(uint2*)(H + (size_t)row * 1024 + c) = w;
    }
  }
}

template <class Epi>
DI void gemm_phase(const u16* A, int lda, const u16* Bt, int ldb, int K, int M, int N, Epi epi, int vb, int G, char* lds) {
  const int nN = N >> 7, nt = (M >> 7) * nN, grp = 8 * nN;
  for (int t = vb; t < nt; t += G) {
    const int gi = t / grp, rem = t - gi * grp;
    gemm_tile(A, lda, Bt, ldb, K, (gi * 8 + (rem & 7)) << 7, (rem >> 3) << 7, epi, lds);
  }
}

template <int HW>
DI void pool_item(const u16* UA, u16* AB, int t, int c8) {
  int nl, N;
  if (t < 4096) { nl = t & 255; N = 256; } else { nl = (t - 4096) & 4095; N = 4096; }
  const int base = t - nl;
  u32x4 w[2 * HW];
  int cnt = 0;
#pragma unroll
  for (int j = 0; j < 2 * HW; ++j) {
    const int idx = nl - HW + j;
    const bool ok = idx >= 0 && idx < N;
    w[j] = *(const u32x4*)(UA + (size_t)(base + (ok ? idx : nl)) * 512 + c8);
    if (!ok) w[j] = (u32x4){0u, 0u, 0u, 0u};
    cnt += ok ? 1 : 0;
  }
  const u32x4 cw = *(const u32x4*)(UA + (size_t)t * 512 + c8);
  float s[8] = {0, 0, 0, 0, 0, 0, 0, 0};
#pragma unroll
  for (int j = 0; j < 2 * HW; ++j)
#pragma unroll
    for (int e = 0; e < 4; ++e) { s[2 * e] += __uint_as_float(w[j][e] << 16); s[2 * e + 1] += __uint_as_float(w[j][e] & 0xffff0000u); }
  const float inv = 1.0f / (float)cnt;
  u32x4 o;
#pragma unroll
  for (int e = 0; e < 4; ++e) o[e] = pack2(s[2 * e] * inv - __uint_as_float(cw[e] << 16), s[2 * e + 1] * inv - __uint_as_float(cw[e] & 0xffff0000u));
  *(u32x4*)(AB + (size_t)t * 1024 + c8) = o;
}
DI void pool_phase(const Params& p, int vb, int G) {
  const u16* UA = (const u16*)(p.ws + OFF_UA);
  u16* AB = (u16*)(p.ws + OFF_AB);
  const size_t gt = (size_t)vb * 256 + TIDX, gs = (size_t)G * 256;
  for (size_t i = gt; i < (size_t)T * 64; i += gs) {
    const int cc = (int)(i & 15), tt = (int)(i >> 4) & 3, g = (int)(i >> 6) & 3, tb = (int)(i >> 8);
    const int t = tb * 4 + tt, c8 = g * 128 + cc * 8;
    if (g == 0) pool_item<1>(UA, AB, t, c8);
    else if (g == 1) pool_item<2>(UA, AB, t, c8);
    else if (g == 2) pool_item<4>(UA, AB, t, c8);
    else pool_item<8>(UA, AB, t, c8);
  }
}

DI void qkvpost_phase(const Params& p, int vb, int G) {
  const int lane = TIDX & 63, wave = TIDX >> 6;
  const int q = lane & 15, sub = lane >> 4;
  const u16* QKV = (const u16*)(p.ws + OFF_QKV);
  u16* CQ = (u16*)(p.ws + OFF_CQ); u16* DQ = (u16*)(p.ws + OFF_DQ);
  u16* CKP = (u16*)(p.ws + OFF_CKP); u16* CKS = (u16*)(p.ws + OFF_CKS);
  u16* DKP = (u16*)(p.ws + OFF_DKP); u16* DKS = (u16*)(p.ws + OFF_DKS);
  float* nck = p.out + OUT_NCK; float* ndk = p.out + OUT_NDK;
  const int d0 = q * 4;
  float fr[4];
#pragma unroll
  for (int e = 0; e < 4; ++e) fr[e] = exp2f(-(float)((d0 + e) & 15) * (13.287712379549449f / 16.0f));
  const bool firsthalf = ((d0 >> 4) & 1) == 0;
  for (int t = vb * 4 + wave; t < T; t += G * 4) {
    const bool samp = t >= 4096;
    int b, nl;
    if (!samp) { b = t >> 8; nl = t & 255; } else { b = (t - 4096) >> 12; nl = (t - 4096) & 4095; }
    float cs[4], sn[4];
    if (samp) {
      const float pos = (d0 < 32) ? (float)(nl >> 6) : (float)(nl & 63);
#pragma unroll
      for (int e = 0; e < 4; ++e) { const float a = pos * fr[e]; cs[e] = cosf(a); sn[e] = sinf(a); }
    } else {
#pragma unroll
      for (int e = 0; e < 4; ++e) { cs[e] = 1.f; sn[e] = 0.f; }
    }
    for (int rd = 0; rd < 7; ++rd) {
      const int slot = rd * 4 + sub;
      const bool act = slot < 26;
      const int vi = act ? (slot < 16 ? slot : slot + 8) : 0;
      const uint2 raw = *(const uint2*)(QKV + (size_t)t * 2304 + vi * 64 + d0);
      float x[4] = {__uint_as_float(raw.x << 16), __uint_as_float(raw.x & 0xffff0000u), __uint_as_float(raw.y << 16), __uint_as_float(raw.y & 0xffff0000u)};
      float ss = x[0] * x[0] + x[1] * x[1] + x[2] * x[2] + x[3] * x[3];
      ss += __shfl_xor(ss, 1); ss += __shfl_xor(ss, 2); ss += __shfl_xor(ss, 4); ss += __shfl_xor(ss, 8);
      const float rinv = rsqrtf(ss * (1.0f / 64.0f) + EPS);
      const float* gp = (vi < 8) ? p.in[18] : (vi < 16) ? p.in[19] : (vi < 32) ? p.in[25] : p.in[26];
      const float4 g = *(const float4*)(gp + d0);
      float y[4] = {x[0] * rinv * g.x, x[1] * rinv * g.y, x[2] * rinv * g.z, x[3] * rinv * g.w};
      float o[4];
#pragma unroll
      for (int e = 0; e < 4; ++e) {
        const float part = __shfl_xor(y[e], 4);
        o[e] = firsthalf ? (y[e] * cs[e] - part * sn[e]) : (y[e] * cs[e] + part * sn[e]);
      }
      if (!act) continue;
      const bool isq = (vi < 8) || (vi >= 24 && vi < 32);
      if (isq) {
        const int hd = (vi < 8) ? vi : vi - 24;
        u16* base = (vi < 8) ? CQ : DQ;
        size_t off = samp ? (size_t)16 * 8 * 256 * 64 + ((size_t)(b * 8 + hd) * 4096 + nl) * 64 : ((size_t)(b * 8 + hd) * 256 + nl) * 64;
        uint2 w; w.x = pack2(o[0] * QSCALE, o[1] * QSCALE); w.y = pack2(o[2] * QSCALE, o[3] * QSCALE);
        *(uint2*)(base + off + d0) = w;
      } else if (vi < 16) {
        const int hm = vi - 8;
        uint2 w; w.x = pack2(o[0], o[1]); w.y = pack2(o[2], o[3]);
        if (samp) *(uint2*)(CKS + ((size_t)(b * 8 + hm) * 4608 + 512 + nl) * 64 + d0) = w;
        else {
          *(uint2*)(CKP + ((size_t)(b * 8 + hm) * 256 + nl) * 64 + d0) = w;
          *(float4*)(nck + (size_t)t * 512 + hm * 64 + d0) = make_float4(o[0], o[1], o[2], o[3]);
        }
      } else {
        const int j = vi - 32;
        uint2 w; w.x = pack2(o[0], o[1]); w.y = pack2(o[2], o[3]);
        if (samp) *(uint2*)(DKS + ((size_t)(b * 2 + j) * 4608 + 512 + nl) * 64 + d0) = w;
        else {
          *(uint2*)(DKP + ((size_t)(b * 2 + j) * 256 + nl) * 64 + d0) = w;
          *(float4*)(ndk + (size_t)t * 128 + j * 64 + d0) = make_float4(o[0], o[1], o[2], o[3]);
        }
      }
    }
  }
  const size_t gt = (size_t)vb * 256 + TIDX, gs = (size_t)G * 256;
  {
    u16* CVTS = (u16*)(p.ws + OFF_CVTS); u16* DVTS = (u16*)(p.ws + OFF_DVTS);
    for (size_t i = gt; i < (size_t)2 * 512 * 512; i += gs) {
      const int b = (int)(i >> 18), key = (int)(i >> 9) & 511, c = (int)(i & 511);
      CKS[((size_t)(b * 8 + (c >> 6)) * 4608 + key) * 64 + (c & 63)] = f2bf(p.in[3][i]);
    }
    for (size_t i = gt; i < (size_t)2 * 512 * 512; i += gs) {
      const int b = (int)(i >> 18), c = (int)(i >> 9) & 511, key = (int)(i & 511);
      CVTS[((size_t)(b * 512 + c)) * 4608 + key] = f2bf(p.in[4][((size_t)b * 512 + key) * 512 + c]);
    }
    for (size_t i = gt; i < (size_t)2 * 512 * 128; i += gs) {
      const int b = (int)(i >> 16), key = (int)(i >> 7) & 511, c = (int)(i & 127);
      DKS[((size_t)(b * 2 + (c >> 6)) * 4608 + key) * 64 + (c & 63)] = f2bf(p.in[5][i]);
    }
    for (size_t i = gt; i < (size_t)2 * 128 * 512; i += gs) {
      const int b = (int)(i >> 16), c = (int)(i >> 9) & 127, key = (int)(i & 511);
      DVTS[((size_t)(b * 128 + c)) * 4608 + key] = f2bf(p.in[6][((size_t)b * 512 + key) * 128 + c]);
    }
  }
}

template <int DV>
DI void attn_item(const u16* Q, const u16* Kb, const u16* Vt, int ldv, int nt0, int key1, int nt1,
                  bool masked, int qpos0, bool has_sink, float sink2, u16* out, int ldo, char* lds) {
  constexpr int NDB = DV / 32;
  constexpr int KVBUF = (64 + DV) * LROW;
  const int tid = TIDX, lane = tid & 63, wave = tid >> 6;
  const int r = lane & 31, h = lane >> 5;
  const int nt = nt0 + nt1;
  bf16x8 qf[4];
#pragma unroll
  for (int ks = 0; ks < 4; ++ks) qf[ks] = *(const bf16x8*)(Q + (size_t)(wave * 32 + r) * 64 + ks * 16 + h * 8);
  f32x16 O[NDB];
#pragma unroll
  for (int i = 0; i < NDB; ++i)
#pragma unroll
    for (int e = 0; e < 16; ++e) O[i][e] = 0.f;
  float mrun = has_sink ? sink2 : -1e30f;
  float lrun = has_sink ? (h == 0 ? 1.f : 0.f) : 0.f;
  const int lrow = tid >> 3, lpart = (tid & 7) * 8;
  uint4 rk0, rk1, rv0, rv1, rv2, rv3;
  rv2 = rv3 = make_uint4(0, 0, 0, 0);
  const u16* gk = Kb + (size_t)lrow * 64 + lpart;
  const u16* gv = Vt + (size_t)lrow * ldv + lpart;
#define ATT_GLOAD(key0_)                                                         \
  do {                                                                           \
    rk0 = *(const uint4*)(gk + (size_t)(key0_) * 64);                            \
    rk1 = *(const uint4*)(gk + (size_t)((key0_) + 32) * 64);                     \
    rv0 = *(const uint4*)(gv + (key0_));                                         \
    rv1 = *(const uint4*)(gv + (size_t)32 * ldv + (key0_));                      \
    if constexpr (DV == 128) {                                                   \
      rv2 = *(const uint4*)(gv + (size_t)64 * ldv + (key0_));                    \
      rv3 = *(const uint4*)(gv + (size_t)96 * ldv + (key0_));                    \
    }                                                                            \
  } while (0)
#define ATT_SSTORE(boff_)                                                        \
  do {                                                                           \
    *(uint4*)(sw + (boff_)) = rk0;                                               \
    *(uint4*)(sw + (boff_) + 32 * LROW) = rk1;                                   \
    *(uint4*)(sw + (boff_) + 64 * LROW) = rv0;                                   \
    *(uint4*)(sw + (boff_) + 96 * LROW) = rv1;                                   \
    if constexpr (DV == 128) {                                                   \
      *(uint4*)(sw + (boff_) + 128 * LROW) = rv2;                                \
      *(uint4*)(sw + (boff_) + 160 * LROW) = rv3;                                \
    }                                                                            \
  } while (0)
  char* sw = lds + lrow * LROW + lpart * 2;
  {
    const int key0 = (nt0 > 0) ? 0 : key1;
    ATT_GLOAD(key0);
  }
  ATT_SSTORE(0);
  __syncthreads();
  const int pr = (r & 0x13) | ((r & 4) << 1) | ((r & 8) >> 1);
  const char* fk = lds + pr * LROW + h * 16;
  const char* fv = lds + 64 * LROW + r * LROW + h * 16;
  const int qpos = qpos0 + wave * 32 + r;
  for (int t = 0; t < nt; ++t) {
    const int cur = (t & 1) * KVBUF;
    const int key0 = (t < nt0) ? t * 64 : key1 + (t - nt0) * 64;
    {
      const int tn = (t + 1 < nt) ? t + 1 : t;
      const int kn = (tn < nt0) ? tn * 64 : key1 + (tn - nt0) * 64;
      ATT_GLOAD(kn);
    }
    f32x16 S[2];
#pragma unroll
    for (int kb = 0; kb < 2; ++kb) {
#pragma unroll
      for (int e = 0; e < 16; ++e) S[kb][e] = 0.f;
#pragma unroll
      for (int ks = 0; ks < 4; ++ks) {
        const bf16x8 kf = *(const bf16x8*)(fk + cur + kb * 32 * LROW + ks * 32);
        S[kb] = MFMA(kf, qf[ks], S[kb]);
      }
    }
    if (masked && t >= nt0) {
#pragma unroll
      for (int kb = 0; kb < 2; ++kb)
#pragma unroll
        for (int e = 0; e < 16; ++e) {
          const int jpos = key0 - 512 + kb * 32 + 16 * (e >> 3) + 8 * h + (e & 7);
          const int dlt = qpos - jpos;
          if (dlt > 128 || dlt < -128) S[kb][e] = -1e30f;
        }
    }
    float mloc = S[0][0];
#pragma unroll
    for (int kb = 0; kb < 2; ++kb)
#pragma unroll
      for (int e = 0; e < 16; ++e) mloc = fmaxf(mloc, S[kb][e]);
    mloc = fmaxf(mloc, __shfl_xor(mloc, 32));
    const float mnew = fmaxf(mrun, mloc);
    if (__builtin_amdgcn_ballot_w64(mnew > mrun) != 0) {
      const float alpha = __builtin_amdgcn_exp2f(mrun - mnew);
      lrun *= alpha;
#pragma unroll
      for (int i = 0; i < NDB; ++i)
#pragma unroll
        for (int e = 0; e < 16; ++e) O[i][e] *= alpha;
    }
    mrun = mnew;
    float ps = 0.f;
#pragma unroll
    for (int kb = 0; kb < 2; ++kb)
#pragma unroll
      for (int e = 0; e < 16; ++e) { const float pv = __builtin_amdgcn_exp2f(S[kb][e] - mnew); S[kb][e] = pv; ps += pv; }
    lrun += ps;
    bf16x8 pf[4];
#pragma unroll
    for (int jj = 0; jj < 4; ++jj) {
      const int kb = jj >> 1, o8 = (jj & 1) * 8;
      uint4 w;
      w.x = pack2(S[kb][o8 + 0], S[kb][o8 + 1]); w.y = pack2(S[kb][o8 + 2], S[kb][o8 + 3]);
      w.z = pack2(S[kb][o8 + 4], S[kb][o8 + 5]); w.w = pack2(S[kb][o8 + 6], S[kb][o8 + 7]);
      pf[jj] = __builtin_bit_cast(bf16x8, w);
    }
    __builtin_amdgcn_sched_barrier(0);
#pragma unroll
    for (int i = 0; i < NDB; ++i) {
#pragma unroll
      for (int jj = 0; jj < 4; ++jj) {
        const bf16x8 vf = *(const bf16x8*)(fv + cur + i * 32 * LROW + jj * 32);
        O[i] = MFMA(vf, pf[jj], O[i]);
      }
      if (i & 1) __builtin_amdgcn_sched_barrier(0);
    }
    ATT_SSTORE(KVBUF - cur);
    __syncthreads();
  }
#undef ATT_GLOAD
#undef ATT_SSTORE
  const float ltot = lrun + __shfl_xor(lrun, 32);
  const float inv = 1.0f / ltot;
  u16* op = out + (size_t)(wave * 32 + r) * ldo;
#pragma unroll
  for (int i = 0; i < NDB; ++i)
#pragma unroll
    for (int qd = 0; qd < 4; ++qd) {
      uint2 w;
      w.x = pack2(O[i][4 * qd] * inv, O[i][4 * qd + 1] * inv);
      w.y = pack2(O[i][4 * qd + 2] * inv, O[i][4 * qd + 3] * inv);
      *(uint2*)(op + i * 32 + 8 * qd + 4 * h) = w;
    }
}

DI void attn_diff_pair(const u16* Q, const u16* Kb, const u16* Vt, int ldv, int nt, float lam, const float* subln_g, u16* out, char* shm, int half) {
  constexpr int STG = (64 + 64 + 128) * LROW;
  const int tid = TIDX, t512 = (int)threadIdx.x, lane = tid & 63, wave = tid >> 6;
  const int r = lane & 31, h = lane >> 5;
  bf16x8 qf[4];
#pragma unroll
  for (int ks = 0; ks < 4; ++ks) qf[ks] = *(const bf16x8*)(Q + (size_t)(wave * 32 + r) * 64 + ks * 16 + h * 8);
  f32x16 O[4];
#pragma unroll
  for (int i = 0; i < 4; ++i)
#pragma unroll
    for (int e = 0; e < 16; ++e) O[i][e] = 0.f;
  float mrun = -1e30f, lrun = 0.f;
  const int lrow = tid >> 3, lpart = (tid & 7) * 8;
  const int vrow = t512 >> 3, vpart = (t512 & 7) * 8;
  const u16* gk = Kb + (size_t)lrow * 64 + lpart;
  const u16* gv = Vt + (size_t)vrow * ldv + vpart;
  char* sk = shm + half * 64 * LROW + lrow * LROW + lpart * 2;
  char* sv = shm + 128 * LROW + vrow * LROW + vpart * 2;
  u32x4 rk0, rk1, rv0, rv1;
#define AD_GLOAD(key0_) do { rk0 = *(const u32x4*)(gk + (size_t)(key0_) * 64); rk1 = *(const u32x4*)(gk + (size_t)((key0_) + 32) * 64); \
                             rv0 = *(const u32x4*)(gv + (key0_)); rv1 = *(const u32x4*)(gv + (size_t)64 * ldv + (key0_)); } while (0)
#define AD_SSTORE(boff_) do { *(u32x4*)(sk + (boff_)) = rk0; *(u32x4*)(sk + (boff_) + 32 * LROW) = rk1; \
                              *(u32x4*)(sv + (boff_)) = rv0; *(u32x4*)(sv + (boff_) + 64 * LROW) = rv1; } while (0)
#define AD_GLOAD_K(key0_) do { rk0 = *(const u32x4*)(gk + (size_t)(key0_) * 64); rk1 = *(const u32x4*)(gk + (size_t)((key0_) + 32) * 64); } while (0)
#define AD_GLOAD_V(key0_) do { rv0 = *(const u32x4*)(gv + (key0_)); rv1 = *(const u32x4*)(gv + (size_t)64 * ldv + (key0_)); } while (0)
#define AD_SSTORE_K(boff_) do { *(u32x4*)(sk + (boff_)) = rk0; *(u32x4*)(sk + (boff_) + 32 * LROW) = rk1; } while (0)
#define AD_SSTORE_V(boff_) do { *(u32x4*)(sv + (boff_)) = rv0; *(u32x4*)(sv + (boff_) + 64 * LROW) = rv1; } while (0)
#define AD_QK(S_, koff_) do { _Pragma("unroll") for (int kb = 0; kb < 2; ++kb) { _Pragma("unroll") for (int e = 0; e < 16; ++e) S_[kb][e] = 0.f; \
    _Pragma("unroll") for (int ks = 0; ks < 4; ++ks) { const bf16x8 kf = *(const bf16x8*)(fk + (koff_) + kb * 32 * LROW + ks * 32); S_[kb] = MFMA(kf, qf[ks], S_[kb]); } } } while (0)
  const int pr = (r & 0x13) | ((r & 4) << 1) | ((r & 8) >> 1);
  const char* fk = shm + half * 64 * LROW + pr * LROW + h * 16;
  const char* fv = shm + 128 * LROW + r * LROW + h * 16;
  AD_GLOAD_K(0); AD_GLOAD_V(0);
  AD_SSTORE_K(0); AD_SSTORE_V(0);
  AD_GLOAD_K(64);
  AD_SSTORE_K(STG);
  __syncthreads();
  f32x16 S[2], Sn[2];
  AD_QK(S, 0);
  for (int t = 0; t < nt; ++t) {
    const int cur = (t & 1) * STG;
    { const int tk = (t + 2 < nt) ? t + 2 : nt - 1, tv = (t + 1 < nt) ? t + 1 : nt - 1; AD_GLOAD_K(tk * 64); AD_GLOAD_V(tv * 64); }
    AD_QK(Sn, STG - cur);
    __builtin_amdgcn_sched_barrier(0);
    float mloc = S[0][0];
#pragma unroll
    for (int kb = 0; kb < 2; ++kb)
#pragma unroll
      for (int e = 0; e < 16; ++e) mloc = fmaxf(mloc, S[kb][e]);
    mloc = fmaxf(mloc, __shfl_xor(mloc, 32));
    const float mnew = fmaxf(mrun, mloc);
    if (__builtin_amdgcn_ballot_w64(mnew > mrun) != 0) {
      const float alpha = __builtin_amdgcn_exp2f(mrun - mnew);
      lrun *= alpha;
#pragma unroll
      for (int i = 0; i < 4; ++i)
#pragma unroll
        for (int e = 0; e < 16; ++e) O[i][e] *= alpha;
    }
    mrun = mnew;
    float ps = 0.f;
#pragma unroll
    for (int kb = 0; kb < 2; ++kb)
#pragma unroll
      for (int e = 0; e < 16; ++e) { const float pv = __builtin_amdgcn_exp2f(S[kb][e] - mnew); S[kb][e] = pv; ps += pv; }
    lrun += ps;
    bf16x8 pf[4];
#pragma unroll
    for (int jj = 0; jj < 4; ++jj) {
      const int kb = jj >> 1, o8 = (jj & 1) * 8;
      uint4 w;
      w.x = pack2(S[kb][o8 + 0], S[kb][o8 + 1]); w.y = pack2(S[kb][o8 + 2], S[kb][o8 + 3]);
      w.z = pack2(S[kb][o8 + 4], S[kb][o8 + 5]); w.w = pack2(S[kb][o8 + 6], S[kb][o8 + 7]);
      pf[jj] = __builtin_bit_cast(bf16x8, w);
    }
#pragma unroll
    for (int i = 0; i < 4; ++i) {
#pragma unroll
      for (int jj = 0; jj < 4; ++jj) {
        const bf16x8 vf = *(const bf16x8*)(fv + cur + i * 32 * LROW + jj * 32);
        O[i] = MFMA(vf, pf[jj], O[i]);
      }
    }
    AD_SSTORE_K(cur);
    AD_SSTORE_V(STG - cur);
    __syncthreads();
    S[0] = Sn[0]; S[1] = Sn[1];
  }
#undef AD_GLOAD_K
#undef AD_GLOAD_V
#undef AD_SSTORE_K
#undef AD_SSTORE_V
#undef AD_QK
#undef AD_GLOAD
#undef AD_SSTORE
  const float inv = 1.0f / (lrun + __shfl_xor(lrun, 32));
  float* ex = (float*)shm + (size_t)wave * 4096 + lane;
  if (half == 1) {
#pragma unroll
    for (int i = 0; i < 4; ++i)
#pragma unroll
      for (int e = 0; e < 16; ++e) ex[(i * 16 + e) * 64] = O[i][e] * inv;
  }
  __syncthreads();
  if (half == 0) {
    float ss = 0.f;
#pragma unroll
    for (int i = 0; i < 4; ++i)
#pragma unroll
      for (int e = 0; e < 16; ++e) { const float d = O[i][e] * inv - lam * ex[(i * 16 + e) * 64]; O[i][e] = d; ss += d * d; }
    ss += __shfl_xor(ss, 32);
    const float rinv = rsqrtf(ss * (1.0f / 128.0f) + EPS) * (1.0f - LAM_INIT);
    u16* op = out + (size_t)(wave * 32 + r) * 1024;
#pragma unroll
    for (int i = 0; i < 4; ++i)
#pragma unroll
      for (int qd = 0; qd < 4; ++qd) {
        const int e0 = i * 32 + 8 * qd + 4 * h;
        const float4 g = *(const float4*)(subln_g + e0);
        uint2 w;
        w.x = pack2(O[i][4 * qd] * rinv * g.x, O[i][4 * qd + 1] * rinv * g.y);
        w.y = pack2(O[i][4 * qd + 2] * rinv * g.z, O[i][4 * qd + 3] * rinv * g.w);
        *(uint2*)(op + e0) = w;
      }
  }
  __syncthreads();
}

DI void attention_phase(const Params& p, int vb0, int half, char* shm) {
  const u16* CQ = (const u16*)(p.ws + OFF_CQ); const u16* DQ = (const u16*)(p.ws + OFF_DQ);
  const u16* CKP = (const u16*)(p.ws + OFF_CKP); const u16* CKS = (const u16*)(p.ws + OFF_CKS);
  const u16* CVTP = (const u16*)(p.ws + OFF_CVTP); const u16* CVTS = (const u16*)(p.ws + OFF_CVTS);
  const u16* DKP = (const u16*)(p.ws + OFF_DKP); const u16* DKS = (const u16*)(p.ws + OFF_DKS);
  const u16* DVTP = (const u16*)(p.ws + OFF_DVTP); const u16* DVTS = (const u16*)(p.ws + OFF_DVTS);
  u16* AC = (u16*)(p.ws + OFF_H);
  constexpr size_t QS = (size_t)16 * 8 * 256 * 64;
  const int lane = TIDX & 63;
  const float la = wave_sum(p.in[20][lane] * p.in[21][lane]);
  const float lb = wave_sum(p.in[22][lane] * p.in[23][lane]);
  const float lam = expf(la) - expf(lb) + LAM_INIT;
  const int nblk = (int)gridDim.x;
  for (int it = vb0; it < 768; it += nblk) {
    const bool diff = (it < 256) || (it >= 512 && it < 640);
    const bool samp = it < 512;
    if (diff) {
      int qb, hh, b;
      if (samp) { qb = it & 31; hh = (it >> 5) & 3; b = it >> 7; }
      else { const int i2 = it - 512; qb = i2 & 1; hh = (i2 >> 1) & 3; b = i2 >> 3; }
      const int nseq = samp ? 4096 : 256, nkeys = samp ? 4608 : 256;
      const int tok = samp ? 4096 + b * 4096 + qb * 128 : b * 256 + qb * 128;
      const int hm = hh * 2 + half;
      const size_t qoff = (samp ? QS : 0) + ((size_t)(b * 8 + hm) * nseq + qb * 128) * 64;
      const u16* Kp = (samp ? CKS : CKP) + (size_t)(b * 8 + hm) * nkeys * 64;
      const u16* Vp = (samp ? CVTS : CVTP) + (size_t)(b * 4 + hh) * 128 * nkeys;
      attn_diff_pair(CQ + qoff, Kp, Vp, nkeys, nkeys >> 6, lam, p.in[24], AC + (size_t)tok * 1024 + hh * 128, shm, half);
    } else {
      int qb, hd, b;
      if (samp) { const int i2 = (it - 256) * 2 + half; qb = i2 & 31; hd = (i2 >> 5) & 7; b = i2 >> 8; }
      else { const int i2 = (it - 640) * 2 + half; qb = i2 & 1; hd = (i2 >> 1) & 7; b = i2 >> 4; }
      const int nseq = samp ? 4096 : 256, nkeys = samp ? 4608 : 256;
      const int tok = samp ? 4096 + b * 4096 + qb * 128 : b * 256 + qb * 128;
      const size_t qoff = (samp ? QS : 0) + ((size_t)(b * 8 + hd) * nseq + qb * 128) * 64;
      const u16* Kp = (samp ? DKS : DKP) + (size_t)(b * 2 + (hd >> 2)) * nkeys * 64;
      const u16* Vp = (samp ? DVTS : DVTP) + (size_t)(b * 2 + (hd >> 2)) * 64 * nkeys;
      int nt0 = 4, key1 = 0, nt1 = 0;
      if (samp) { const int lo = min(max(qb * 128 - 128, 0), 4096 - 384); nt0 = 8; key1 = 512 + lo; nt1 = 6; }
      attn_item<64>(DQ + qoff, Kp, Vp, nkeys, nt0, key1, nt1, samp, qb * 128, true, p.in[27][hd] * LOG2E, AC + (size_t)tok * 1024 + 512 + hd * 64, 1024, shm + half * LDS_BYTES);
    }
  }
}

namespace pg8 {
#define PG8_LAS __attribute__((address_space(3)))
typedef unsigned short bf16_t;
typedef short bf16x8 __attribute__((ext_vector_type(8)));
typedef float f32x4 __attribute__((ext_vector_type(4)));
typedef unsigned u32x4 __attribute__((ext_vector_type(4)));
constexpr int BM = 256, BK = 64, HALF = 128, HTB = HALF * BK * 2  , STAGE_BYTES = 8 * HTB, NXCD = 8, WGM = 8;

__host__ __device__ __forceinline__ int lds_byte(int r, int c) { const int st = (r >> 4) * 2 + (c >> 5), rr = r & 15, cc = c & 31, ob = rr * 64 + cc * 2; return st * 1024 + (ob ^ (((ob >> 9) & 1) << 5)); }
__host__ __device__ __forceinline__ void stage_rc(int b, int& R, int& C) { const int st = b / 1024, sb = b % 1024, swz = sb ^ (((sb >> 9) & 1) << 5); R = (st >> 1) * 16 + swz / 64; C = (st & 1) * 32 + (swz % 64) / 2; }
__host__ __device__ __forceinline__ int perm32(int rho) { const int n = rho >> 4, i = rho & 15; return 8 * (i >> 2) + 4 * n + (i & 3); }

struct Unit { int pm, pn; };
struct Gemm { const bf16_t* A; const bf16_t* Bt; int M, N, K; };

struct StaticOrder {
    int nM, nN, nwg, G, c;
    __host__ __device__ void init(int M, int N, int G_, int c_) { nM = M / BM; nN = N / BM; nwg = nM * nN; G = G_; c = c_; }
    __host__ __device__ bool next(int i, Unit& u) const {
        const long L = (long)i * G + c; if (L >= nwg) return false;
        int wgid = (int)L; { const int q = nwg / NXCD, r = nwg % NXCD, xcd = wgid % NXCD, off = wgid / NXCD; wgid = (xcd < r ? xcd * (q + 1) : r * (q + 1) + (xcd - r) * q) + off; }
        const int nig = WGM * nN, gid = wgid / nig, fm = gid * WGM, gsz = (nM - fm) < WGM ? (nM - fm) : WGM;
        u.pm = fm + ((wgid % nig) % gsz); u.pn = (wgid % nig) / gsz; return true;
    }
    __device__ __forceinline__ void a_ready(const Unit&) const {}
    __device__ __forceinline__ void done(const Unit&) const {}
};
template <class Epi, class Sched, bool STAMP = false, int MB = 4>
__device__ __forceinline__ void gemm_phase(PG8_LAS unsigned char* lds, const Gemm g, const Sched& S, const Epi& E, unsigned long long* stamps) {
    const int tid = threadIdx.x, wid = __builtin_amdgcn_readfirstlane(tid >> 6), lane = tid & 63, wr = wid >> 2, wc = wid & 3, fr = lane & 15, fq = lane >> 4;
    const int K = g.K, nt = K / BK;
    int ts_lo = 0, ts_hi = 0, nts = 0; const unsigned long long rt_entry = STAMP ? (unsigned long long)wall_clock64() : 0ull;
#define PG8_STAMP() do { if (STAMP && wid == 0 && nts < 64) { const unsigned long long _c = (unsigned long long)clock64(); \
        ts_lo = (lane == nts) ? (int)(unsigned)_c : ts_lo; ts_hi = (lane == nts) ? (int)(unsigned)(_c >> 32) : ts_hi; ++nts; } } while (0)
    PG8_STAMP();
    unsigned voffA[2], voffB[2];
#pragma unroll
    for (int i = 0; i < 2; ++i) { int R, C; stage_rc(tid * 16 + i * 8192, R, C); const int Rb = Epi::PERM ? ((R & ~31) + perm32(R & 31)) : R;
        voffA[i] = (unsigned)(R * K + C) * 2u; voffB[i] = (unsigned)(Rb * K + C) * 2u; }
    const size_t kstep = (size_t)(BK * 2);
    const size_t hstep = (size_t)HALF * K * 2; const size_t hstepA = (size_t)(32 * MB) * K * 2;
    const size_t tstep = 2 * hstep; const size_t tstepA = 2 * hstepA;
    const unsigned ldsw = (unsigned)wid * 1024u;
    const int aoff = lds_byte(wr * 16 * MB + fr, fq * 8), boff = lds_byte(wc * 32 + fr, fq * 8);
#define PG8_SA(b, h) (((b) * 2 + (h)) * HTB)
#define PG8_SB(b, h) ((4 + (b) * 2 + (h)) * HTB)
#define PG8_STAGE(bufoff, gbase, voff) do { _Pragma("unroll") for (int _i = 0; _i < 2; ++_i) \
        __builtin_amdgcn_global_load_lds((const unsigned*)((const char*)(gbase) + (voff)[_i]), (PG8_LAS unsigned*)(lds + (bufoff) + ldsw + _i * 8192), 16, 0, 0); } while (0)
#define PG8_LDA(dst, b, h) do { _Pragma("unroll") for (int m = 0; m < MB; ++m) _Pragma("unroll") for (int k = 0; k < 2; ++k) dst[m][k] = *(const PG8_LAS bf16x8*)(lds + PG8_SA(b, h) + aoff + m * 2048 + k * 1024); } while (0)
#define PG8_LDB(dst, b, h) do { _Pragma("unroll") for (int n = 0; n < 2; ++n) _Pragma("unroll") for (int k = 0; k < 2; ++k) dst[n][k] = *(const PG8_LAS bf16x8*)(lds + PG8_SB(b, h) + boff + n * 2048 + k * 1024); } while (0)
#define PG8_MMA(ai, bj, At, Bt) do { __builtin_amdgcn_s_setprio(1); _Pragma("unroll") for (int m = 0; m < MB; ++m) _Pragma("unroll") for (int n = 0; n < 2; ++n) _Pragma("unroll") for (int k = 0; k < 2; ++k) \
        acc[ai][bj][m][n] = __builtin_amdgcn_mfma_f32_16x16x32_bf16(Bt[n][k], At[m][k], acc[ai][bj][m][n], 0, 0, 0); __builtin_amdgcn_s_setprio(0); } while (0)
#define PG8_WAIT_V(n) asm volatile("s_waitcnt vmcnt(" #n ")" ::: "memory")
#define PG8_WAIT_L(n) asm volatile("s_waitcnt lgkmcnt(" #n ")" ::: "memory")
#define PG8_BAR __builtin_amdgcn_s_barrier()
#define PG8_SCHED __builtin_amdgcn_sched_barrier(0)
    Unit cur, nxt; int ui = 0;
    if (!S.next(0, cur)) return;
    f32x4 acc[2][2][MB][2];
#pragma unroll
    for (int a = 0; a < 2; ++a)
#pragma unroll
        for (int b = 0; b < 2; ++b)
#pragma unroll
            for (int m = 0; m < MB; ++m)
#pragma unroll
                for (int n = 0; n < 2; ++n) acc[a][b][m][n] = (f32x4){0.f, 0.f, 0.f, 0.f};
    bf16x8 At[MB][2], B0[2][2], B1[2][2];
    const char* cA = (const char*)g.A + (size_t)cur.pm * tstepA; const char* cB = (const char*)g.Bt + (size_t)cur.pn * tstep;
    S.a_ready(cur);
    PG8_STAGE(PG8_SB(0, 0), cB, voffB); PG8_STAGE(PG8_SA(0, 0), cA, voffA); PG8_STAGE(PG8_SB(0, 1), cB + hstep, voffB); PG8_STAGE(PG8_SA(0, 1), cA + hstepA, voffA);
    if (wr == 1) PG8_BAR;
    PG8_WAIT_V(4); PG8_BAR;
    PG8_STAGE(PG8_SB(1, 0), cB + kstep, voffB); PG8_STAGE(PG8_SA(1, 0), cA + kstep, voffA); PG8_STAGE(PG8_SB(1, 1), cB + hstep + kstep, voffB);
    PG8_WAIT_V(6); PG8_BAR;
    PG8_STAMP();
    for (;;) {
        const bool has_next = S.next(ui + 1, nxt);
        const char* nA = has_next ? (const char*)g.A + (size_t)nxt.pm * tstepA : cA; const char* nB = has_next ? (const char*)g.Bt + (size_t)nxt.pn * tstep : cB;
        for (int t = 0; t < nt; t += 2) {
            const bool last = (t == nt - 2);
            const char* a1 = cA + (size_t)(t + 1) * kstep;
            const char* a2 = last ? nA : cA + (size_t)(t + 2) * kstep; const char* b2 = last ? nB : cB + (size_t)(t + 2) * kstep;
            const char* a3 = a2 + kstep; const char* b3 = b2 + kstep;
            if (last && has_next) S.a_ready(nxt);
            PG8_LDB(B0, 0, 0); PG8_SCHED; PG8_LDA(At, 0, 0); PG8_STAGE(PG8_SA(1, 1), a1 + hstepA, voffA);
            PG8_WAIT_L(8); PG8_BAR; PG8_WAIT_L(0); PG8_MMA(0, 0, At, B0); PG8_BAR; PG8_SCHED;
            PG8_LDB(B1, 0, 1); PG8_STAGE(PG8_SB(0, 0), b2, voffB);
            PG8_BAR; PG8_WAIT_L(0); PG8_MMA(0, 1, At, B1); PG8_BAR;
            PG8_LDA(At, 0, 1); PG8_STAGE(PG8_SA(0, 0), a2, voffA);
            PG8_BAR; PG8_WAIT_L(0); PG8_MMA(1, 0, At, B0); PG8_BAR; PG8_SCHED;
            PG8_STAGE(PG8_SB(0, 1), b2 + hstep, voffB);
            PG8_WAIT_V(6); PG8_BAR; PG8_MMA(1, 1, At, B1); PG8_BAR;
            PG8_LDB(B0, 1, 0); PG8_SCHED; PG8_LDA(At, 1, 0); PG8_STAGE(PG8_SA(0, 1), a2 + hstepA, voffA);
            PG8_WAIT_L(8); PG8_BAR; PG8_WAIT_L(0); PG8_MMA(0, 0, At, B0); PG8_BAR; PG8_SCHED;
            PG8_LDB(B1, 1, 1); PG8_STAGE(PG8_SB(1, 0), b3, voffB);
            PG8_BAR; PG8_WAIT_L(0); PG8_MMA(0, 1, At, B1); PG8_BAR;
            PG8_LDA(At, 1, 1); PG8_STAGE(PG8_SA(1, 0), a3, voffA);
            PG8_BAR; PG8_WAIT_L(0); PG8_MMA(1, 0, At, B0); PG8_BAR; PG8_SCHED;
            PG8_STAGE(PG8_SB(1, 1), b3 + hstep, voffB);
            PG8_WAIT_V(6); PG8_BAR; PG8_MMA(1, 1, At, B1); PG8_BAR;
        }
        PG8_STAMP();
        if constexpr (!Epi::AFTER_DRAIN) { E(acc, cur, wr, wc, fr, fq); S.done(cur); }
        PG8_STAMP();
        if (!has_next) break;
#pragma unroll
        for (int a = 0; a < 2; ++a)
#pragma unroll
            for (int b = 0; b < 2; ++b)
#pragma unroll
                for (int m = 0; m < MB; ++m)
#pragma unroll
                    for (int n = 0; n < 2; ++n) acc[a][b][m][n] = (f32x4){0.f, 0.f, 0.f, 0.f};
        cur = nxt; cA = nA; cB = nB; ++ui;
    }
    PG8_WAIT_V(0);
    if (wr == 0) PG8_BAR;
    PG8_BAR;
    if constexpr (Epi::AFTER_DRAIN) { E.fused(acc, cur, wr, wc, fr, fq, lds, wid, lane); S.done(cur); }
    PG8_STAMP();
    if (STAMP && wid == 0) { stamps[lane] = lane < nts ? (((unsigned long long)(unsigned)ts_hi << 32) | (unsigned)ts_lo) : 0ull;
        if (lane == 62) stamps[62] = rt_entry; if (lane == 63) stamps[63] = (unsigned long long)wall_clock64(); }
#undef PG8_STAMP
#undef PG8_SA
#undef PG8_SB
#undef PG8_STAGE
#undef PG8_LDA
#undef PG8_LDB
#undef PG8_MMA
#undef PG8_WAIT_V
#undef PG8_WAIT_L
#undef PG8_BAR
#undef PG8_SCHED
}
}

typedef float f32x4 __attribute__((ext_vector_type(4)));
template <class F, int MB> struct RowEpi {
  static constexpr bool PERM = false, AFTER_DRAIN = false;
  F f;
  DI void operator()(const pg8::f32x4 (&acc)[2][2][MB][2], const pg8::Unit& u, int wr, int wc, int fr, int fq) const {
    const int row0 = u.pm * (64 * MB) + wr * 16 * MB + fr, col0 = u.pn * 256 + wc * 32 + 4 * fq;
#pragma unroll
    for (int ai = 0; ai < 2; ++ai)
#pragma unroll
      for (int m = 0; m < MB; ++m)
#pragma unroll
        for (int bj = 0; bj < 2; ++bj)
#pragma unroll
          for (int n = 0; n < 2; ++n) f(row0 + ai * 32 * MB + m * 16, col0 + bj * 128 + n * 16, acc[ai][bj][m][n]);
  }
};
struct FU {
  u16* UA; u16* PQt;
  DI void operator()(int m, int n, pg8::f32x4 v) const {
    if (n < 512) {
      uint2 w; w.x = pack2(v[0], v[1]); w.y = pack2(v[2], v[3]);
      *(uint2*)(UA + (size_t)m * 512 + n) = w;
    } else {
      const int np = n - 512, g = np >> 8, pq = (np >> 7) & 1, mm = np & 127;
      u16* q; size_t st;
      if (m < 4096) { const int b = m >> 8, nl = m & 255; q = PQt + ((size_t)(b * 512 + g * 128 + mm)) * 512 + pq * 256 + nl; st = 512; }
      else { const int ms = m - 4096, b = ms >> 12, nl = ms & 4095; q = PQt + (size_t)16 * 512 * 512 + ((size_t)(b * 512 + g * 128 + mm)) * 8192 + pq * 4096 + nl; st = 8192; }
      q[0] = f2bf(v[0]); q[st] = f2bf(v[1]); q[2 * st] = f2bf(v[2]); q[3 * st] = f2bf(v[3]);
    }
  }
};
struct FRes {
  const float* xin_p; const float* xin_s; float* X; const float* gate;
  DI void operator()(int m, int n, pg8::f32x4 v) const {
    const float* xi = (m < 4096) ? xin_p + (size_t)m * 1024 + n : xin_s + (size_t)(m - 4096) * 1024 + n;
    const float4 x = *(const float4*)xi;
    const float4 g = *(const float4*)(gate + cond_of(m) * 6144 + n);
    *(float4*)(X + (size_t)m * 1024 + n) = make_float4(x.x + g.x * v[0], x.y + g.y * v[1], x.z + g.z * v[2], x.w + g.w * v[3]);
  }
};
struct FRelu2 {
  u16* C;
  DI void operator()(int m, int n, pg8::f32x4 v) const {
    const float a = fmaxf(v[0], 0.f), b = fmaxf(v[1], 0.f), c = fmaxf(v[2], 0.f), d = fmaxf(v[3], 0.f);
    uint2 w; w.x = pack2(a * a, b * b); w.y = pack2(c * c, d * d);
    *(uint2*)(C + (size_t)m * 4096 + n) = w;
  }
};
struct FQkv {
  u16* QKV; u16* CVtP; u16* CVtS; u16* DVtP; u16* DVtS; float* ncv; float* ndv;
  DI void operator()(int m, int n, pg8::f32x4 v) const {
    const bool is_cv = (n >= 1024 && n < 1536), is_dv = (n >= 2176);
    if (!is_cv && !is_dv) {
      uint2 w; w.x = pack2(v[0], v[1]); w.y = pack2(v[2], v[3]);
      *(uint2*)(QKV + (size_t)m * 2304 + n) = w;
      return;
    }
    const int c = is_cv ? n - 1024 : n - 2176;
    const int feat = is_cv ? 512 : 128;
    u16* q; size_t st;
    if (m < 4096) {
      const int b = m >> 8, nl = m & 255;
      q = (is_cv ? CVtP : DVtP) + ((size_t)(b * feat + c)) * 256 + nl; st = 256;
      *(float4*)((is_cv ? ncv : ndv) + (size_t)m * feat + c) = make_float4(v[0], v[1], v[2], v[3]);
    } else {
      const int ms = m - 4096, b = ms >> 12, nl = ms & 4095;
      q = (is_cv ? CVtS : DVtS) + ((size_t)(b * feat + c)) * 4608 + 512 + nl; st = 4608;
    }
    q[0] = f2bf(v[0]); q[st] = f2bf(v[1]); q[2 * st] = f2bf(v[2]); q[3 * st] = f2bf(v[3]);
  }
};
template <int MB, class F>
DI void big_gemm(PG8_LAS unsigned char* lds, const u16* A, const u16* Bt, int M, int N, int K, F f) {
  pg8::Gemm g{A, Bt, M, N, K};
  pg8::StaticOrder S; S.init(M, N, (int)gridDim.x, (int)blockIdx.x);
  S.nM = M / (64 * MB); S.nwg = S.nM * S.nN;
  RowEpi<F, MB> E{f};
  pg8::gemm_phase<RowEpi<F, MB>, pg8::StaticOrder, false, MB>(lds, g, S, E, nullptr);
}

template <class F, int MB> struct RowEpi8 {
  static constexpr bool PERM = true, AFTER_DRAIN = false;
  F f;
  DI void operator()(const pg8::f32x4 (&acc)[2][2][MB][2], const pg8::Unit& u, int wr, int wc, int fr, int fq) const {
    const int row0 = u.pm * (64 * MB) + wr * 16 * MB + fr, col0 = u.pn * 256 + wc * 32 + 8 * fq;
#pragma unroll
    for (int ai = 0; ai < 2; ++ai)
#pragma unroll
      for (int m = 0; m < MB; ++m)
#pragma unroll
        for (int bj = 0; bj < 2; ++bj) f(row0 + ai * 32 * MB + m * 16, col0 + bj * 128, acc[ai][bj][m][0], acc[ai][bj][m][1]);
  }
};
struct FRelu2x8 {
  u16* C;
  DI void operator()(int m, int n, pg8::f32x4 a, pg8::f32x4 b) const {
    uint4 w;
    float x0 = fmaxf(a[0], 0.f), x1 = fmaxf(a[1], 0.f), x2 = fmaxf(a[2], 0.f), x3 = fmaxf(a[3], 0.f);
    float y0 = fmaxf(b[0], 0.f), y1 = fmaxf(b[1], 0.f), y2 = fmaxf(b[2], 0.f), y3 = fmaxf(b[3], 0.f);
    w.x = pack2(x0 * x0, x1 * x1); w.y = pack2(x2 * x2, x3 * x3); w.z = pack2(y0 * y0, y1 * y1); w.w = pack2(y2 * y2, y3 * y3);
    *(uint4*)(C + (size_t)m * 4096 + n) = w;
  }
};
struct FUx8 {
  u16* UA; u16* PQt;
  DI void operator()(int m, int n, pg8::f32x4 a, pg8::f32x4 b) const {
    if (n < 512) {
      uint4 w; w.x = pack2(a[0], a[1]); w.y = pack2(a[2], a[3]); w.z = pack2(b[0], b[1]); w.w = pack2(b[2], b[3]);
      *(uint4*)(UA + (size_t)m * 512 + n) = w;
    } else {
      const int np = n - 512, g = np >> 8, pq = (np >> 7) & 1, mm = np & 127;
      u16* q; size_t st;
      if (m < 4096) { const int bb = m >> 8, nl = m & 255; q = PQt + ((size_t)(bb * 512 + g * 128 + mm)) * 512 + pq * 256 + nl; st = 512; }
      else { const int ms = m - 4096, bb = ms >> 12, nl = ms & 4095; q = PQt + (size_t)16 * 512 * 512 + ((size_t)(bb * 512 + g * 128 + mm)) * 8192 + pq * 4096 + nl; st = 8192; }
      q[0] = f2bf(a[0]); q[st] = f2bf(a[1]); q[2 * st] = f2bf(a[2]); q[3 * st] = f2bf(a[3]);
      q[4 * st] = f2bf(b[0]); q[5 * st] = f2bf(b[1]); q[6 * st] = f2bf(b[2]); q[7 * st] = f2bf(b[3]);
    }
  }
};
struct FQkvx8 {
  u16* QKV; u16* CVtP; u16* CVtS; u16* DVtP; u16* DVtS; float* ncv; float* ndv;
  DI void operator()(int m, int n, pg8::f32x4 a, pg8::f32x4 b) const {
    const bool is_cv = (n >= 1024 && n < 1536), is_dv = (n >= 2176);
    if (!is_cv && !is_dv) {
      uint4 w; w.x = pack2(a[0], a[1]); w.y = pack2(a[2], a[3]); w.z = pack2(b[0], b[1]); w.w = pack2(b[2], b[3]);
      *(uint4*)(QKV + (size_t)m * 2304 + n) = w;
      return;
    }
    const int c = is_cv ? n - 1024 : n - 2176;
    const int feat = is_cv ? 512 : 128;
    u16* q; size_t st;
    if (m < 4096) {
      const int bb = m >> 8, nl = m & 255;
      q = (is_cv ? CVtP : DVtP) + ((size_t)(bb * feat + c)) * 256 + nl; st = 256;
      float* o = (is_cv ? ncv : ndv) + (size_t)m * feat + c;
      *(float4*)o = make_float4(a[0], a[1], a[2], a[3]);
      *(float4*)(o + 4) = make_float4(b[0], b[1], b[2], b[3]);
    } else {
      const int ms = m - 4096, bb = ms >> 12, nl = ms & 4095;
      q = (is_cv ? CVtS : DVtS) + ((size_t)(bb * feat + c)) * 4608 + 512 + nl; st = 4608;
    }
    q[0] = f2bf(a[0]); q[st] = f2bf(a[1]); q[2 * st] = f2bf(a[2]); q[3 * st] = f2bf(a[3]);
    q[4 * st] = f2bf(b[0]); q[5 * st] = f2bf(b[1]); q[6 * st] = f2bf(b[2]); q[7 * st] = f2bf(b[3]);
  }
};
template <int MB, class F>
DI void big_gemm8(PG8_LAS unsigned char* lds, const u16* A, const u16* Bt, int M, int N, int K, F f) {
  pg8::Gemm g{A, Bt, M, N, K};
  pg8::StaticOrder S; S.init(M, N, (int)gridDim.x, (int)blockIdx.x);
  S.nM = M / (64 * MB); S.nwg = S.nM * S.nN;
  RowEpi8<F, MB> E{f};
  pg8::gemm_phase<RowEpi8<F, MB>, pg8::StaticOrder, false, MB>(lds, g, S, E, nullptr);
}

#define XB_TMO      128
#define XB_XCNT(j)  (256  + 64 * (j))
#define XB_XSUB(j)  (1280 + 64 * (j))
#define XB_XGEN(j)  (2304 + 64 * (j))
#define XB_TOP      3328
#define XB_TOPGEN   3392
#define XCD_BAR_WORDS 3456
#define XB_SPIN_CAP (1u << 18)
#define LAS __attribute__((address_space(3)))
DI unsigned xb_ld(unsigned* p)              { return __hip_atomic_load(p, __ATOMIC_RELAXED, __HIP_MEMORY_SCOPE_AGENT); }
DI unsigned xb_add(unsigned* p, unsigned v) { return __hip_atomic_fetch_add(p, v, __ATOMIC_RELAXED, __HIP_MEMORY_SCOPE_AGENT); }
DI unsigned xb_xcc_id() { return (unsigned)__builtin_amdgcn_s_getreg((3 << 11) | 20) & 0xFu; }
#define XB_SPIN(cond, bar) do { unsigned _sp = 0; while (cond) { __builtin_amdgcn_s_sleep(1); \
    if ((++_sp & 255u) == 0u) { if (xb_ld(&(bar)[XB_TMO])) break; if (_sp > XB_SPIN_CAP) { atomicAdd(&(bar)[XB_TMO], 1u); break; } } } } while (0)
struct XcdBarrier { unsigned* bar; unsigned x; volatile LAS unsigned* st; };
DI XcdBarrier xcd_barrier_post(unsigned* bar, volatile LAS unsigned* st) {
  XcdBarrier b; b.bar = bar; b.x = xb_xcc_id(); b.st = st;
  if (threadIdx.x == 0) (void)xb_add(&bar[XB_XCNT(b.x)], 1u);
  return b;
}
DI void xcd_barrier_complete(unsigned* bar, unsigned x, unsigned& nloc, unsigned& nx) {
  const unsigned G = gridDim.x;
  unsigned sum, cnt, mine, sp = 0u;
  for (;;) {
    sum = 0u; cnt = 0u; mine = 0u;
#pragma unroll
    for (unsigned j = 0; j < 16; ++j) { const unsigned c = xb_ld(&bar[XB_XCNT(j)]); sum += c; cnt += (c > 0u) ? 1u : 0u; mine = (j == x) ? c : mine; }
    if (sum == G) break;
    __builtin_amdgcn_s_sleep(1);
    if ((++sp & 255u) == 0u) { if (xb_ld(&bar[XB_TMO])) break; if (sp > XB_SPIN_CAP) { atomicAdd(&bar[XB_TMO], 1u); break; } }
  }
  nloc = mine > 0u ? mine : 1u; nx = cnt > 0u ? cnt : 1u;
}
DI void xcd_barrier(const XcdBarrier& b) {
  asm volatile("s_waitcnt vmcnt(0)" ::: "memory");
  __syncthreads();
  if (threadIdx.x == 0) {
    unsigned* bar = b.bar;
    __builtin_amdgcn_s_waitcnt(0);
    unsigned nloc = b.st[0], nx = b.st[1];
    if (nloc == 0u) { xcd_barrier_complete(bar, b.x, nloc, nx); b.st[0] = nloc; b.st[1] = nx; }
    const unsigned old = xb_add(&bar[XB_XSUB(b.x)], 1u);
    const unsigned gen = old / nloc;
    if (old + 1u == (gen + 1u) * nloc) {
      __builtin_amdgcn_fence(__ATOMIC_RELEASE, "agent");
      asm volatile("s_waitcnt vmcnt(0)" ::: "memory");
      const unsigned og = xb_add(&bar[XB_TOP], 1u);
      const unsigned tg = og / nx;
      if (og + 1u == (tg + 1u) * nx) xb_add(&bar[XB_TOPGEN], 1u);
      else XB_SPIN(xb_ld(&bar[XB_TOPGEN]) == tg, bar);
      __builtin_amdgcn_fence(__ATOMIC_ACQUIRE, "agent");
      xb_add(&bar[XB_XGEN(b.x)], 1u);
      asm volatile("s_waitcnt vmcnt(0)" ::: "memory");
    } else {
      XB_SPIN(xb_ld(&bar[XB_XGEN(b.x)]) == gen, bar);
      __builtin_amdgcn_fence(__ATOMIC_ACQUIRE, "agent");
      asm volatile("s_waitcnt vmcnt(0)" ::: "memory");
    }
  }
  __syncthreads();
}

__global__ void __launch_bounds__(512) fwd_kernel(Params p, int ph_lo, int ph_hi) {
  extern __shared__ __attribute__((aligned(16))) unsigned char shm[];
  const int half = threadIdx.x >> 8;
  char* lds = (char*)shm + half * LDS_BYTES;
  PG8_LAS unsigned char* lds8 = (PG8_LAS unsigned char*)shm;
  const int G = 2 * (int)gridDim.x;
  int vb0 = blockIdx.x;
  if ((gridDim.x & 7) == 0) vb0 = (blockIdx.x & 7) * (gridDim.x >> 3) + (blockIdx.x >> 3);
  const int vb = 2 * vb0 + half;
  unsigned char* ws = p.ws;
  const float* mods = (const float*)(ws + OFF_MODS);
  float* X = p.out + OUT_Y;
  u16* H = (u16*)(ws + OFF_H);

#define RUNPH(n) ((ONLYPH < 0 || ONLYPH == (n)) && ph_lo <= (n) && (n) < ph_hi)
#define REP(n) _Pragma("unroll") for (int rep_ = 0; rep_ < ((DUPPH == (n)) ? 2 : 1); ++rep_)
#define SEAM(n) if (ph_lo < (n) && (n) < ph_hi) xcd_barrier(xb);
  __shared__ uint4 xb_words;
  if (threadIdx.x == 0) xb_words = make_uint4(0u, 0u, 0u, 0u);
  __syncthreads();
  XcdBarrier xb = xcd_barrier_post((unsigned*)(ws + OFF_BAR), (volatile LAS unsigned*)&xb_words);
  if (ph_hi > 1000) cg::this_grid().sync();
  if (RUNPH(0)) REP(0) {
    for (int id = vb; id < 384; id += G) ada_item(p, id, lds);
    prep_transposes(p, vb, G, lds, 0);
    prep_elementwise(p, vb, G);
  }
  SEAM(1)
  if (RUNPH(1)) REP(1) {
    for (int t = vb; t < 128; t += G) {
      const bool f1 = t < 64;
      const int q = t & 63;
      gemm_tile(f1 ? (const u16*)(ws + OFF_CBD) : (const u16*)(ws + OFF_WOUT_ET), f1 ? 512 : 1024,
                f1 ? (const u16*)(ws + OFF_WINB) : (const u16*)(ws + OFF_BD), f1 ? 512 : 1024, f1 ? 512 : 1024, (q >> 3) << 7, (q & 7) << 7,
                EpiBf16{f1 ? (u16*)(ws + OFF_WIN_E) + (size_t)512 * 1024 : (u16*)(ws + OFF_WOUT_E), 1024}, lds);
    }
    normmod_phase(p, vb, G, p.in[0], p.in[1], p.in[8], 0, 0);
  }
  SEAM(2)
  if (RUNPH(2)) REP(2)
    big_gemm8<3>(lds8, H, (const u16*)(ws + OFF_WIN_E), T, 1536, 1024, FUx8{(u16*)(ws + OFF_UA), (u16*)(ws + OFF_PQT)});
  SEAM(3)
  if (RUNPH(3)) REP(3) sym_phase(p, vb, G);
  SEAM(4)
  if (RUNPH(4)) REP(4) {
    const u16* PQT = (const u16*)(ws + OFF_PQT);
    const u16* PEQO = (const u16*)(ws + OFF_PEQO);
    for (int t = vb0; t < 256 + 128; t += (int)gridDim.x) {
      const bool big = t < 256;
      const int q = t - 256, b = q >> 3;
      dft_pair(big ? (const u16*)(ws + OFF_D4096) : (const u16*)(ws + OFF_D256),
               big ? PEQO + (size_t)16 * 512 * 256 : PEQO + (size_t)b * 512 * 256,
               big ? PQT + (size_t)16 * 512 * 512 + 2048 : PQT + (size_t)b * 512 * 512 + 128,
               big ? 8192 : 512, big ? 2048 : 128, big ? (t & 15) << 7 : 0, big ? (t >> 4) << 6 : (q & 7) << 6,
               (u16*)(ws + OFF_AB), big ? 4096 : b * 256, 512, big ? 0.0013810679320049757f : 0.005524271728019903f, (char*)shm, half);
    }
    pool_phase(p, vb, G);
  }
  SEAM(5)
  if (RUNPH(5))
    big_gemm<3>(lds8, (const u16*)(ws + OFF_AB), (const u16*)(ws + OFF_WOUT_E), T, 1024, 1024, FRes{p.in[0], p.in[1], X, mods + 2048});
  SEAM(6)
  if (RUNPH(6)) REP(6) normmod_phase(p, vb, G, X, X + (size_t)4096 * 1024, p.in[9], 0, 1);
  SEAM(7)
  if (RUNPH(7)) REP(7) big_gemm8<4>(lds8, H, (const u16*)(ws + OFF_W1), T, 4096, 1024, FRelu2x8{(u16*)(ws + OFF_M1)});
  SEAM(8)
  if (RUNPH(8)) {
    big_gemm<4>(lds8, (const u16*)(ws + OFF_M1), (const u16*)(ws + OFF_W2), T, 1024, 4096, FRes{X, X + (size_t)4096 * 1024, X, mods + 5120});
    if (blockIdx.x >= 192) prep_transposes(p, ((int)blockIdx.x - 192) * 2 + half, ((int)gridDim.x - 192) * 2, lds, 1);
  }
  SEAM(9)
  if (RUNPH(9)) normmod_phase(p, vb, G, X, X + (size_t)4096 * 1024, p.in[8] + 1024, 1, 0);
  SEAM(10)
  if (RUNPH(10)) REP(10) big_gemm8<4>(lds8, H, (const u16*)(ws + OFF_WIN_O), T, 2304, 1024,
                            FQkvx8{(u16*)(ws + OFF_QKV), (u16*)(ws + OFF_CVTP), (u16*)(ws + OFF_CVTS), (u16*)(ws + OFF_DVTP), (u16*)(ws + OFF_DVTS), p.out + OUT_NCV, p.out + OUT_NDV});
  SEAM(11)
  if (RUNPH(11)) REP(11) qkvpost_phase(p, vb, G);
  SEAM(12)
  if (RUNPH(12)) REP(12) attention_phase(p, vb0, half, (char*)shm);
  SEAM(13)
  if (RUNPH(13)) big_gemm<3>(lds8, H, (const u16*)(ws + OFF_WOUT_O), T, 1024, 1024, FRes{X, X + (size_t)4096 * 1024, X, mods + 3 * 6144 + 2048});
  SEAM(14)
  if (RUNPH(14)) normmod_phase(p, vb, G, X, X + (size_t)4096 * 1024, p.in[9] + 1024, 1, 1);
  SEAM(15)
  if (RUNPH(15)) big_gemm8<4>(lds8, H, (const u16*)(ws + OFF_W1) + (size_t)4096 * 1024, T, 4096, 1024, FRelu2x8{(u16*)(ws + OFF_M1)});
  SEAM(16)
  if (RUNPH(16)) big_gemm<3>(lds8, (const u16*)(ws + OFF_M1), (const u16*)(ws + OFF_W2) + (size_t)4096 * 1024, T, 1024, 4096, FRes{X, X + (size_t)4096 * 1024, X, mods + 3 * 6144 + 5120});
}

extern "C" void kernel_launch(void* const* d_in, const int* in_sizes, int n_in, void* d_out, int out_size, void* d_ws, size_t ws_size,
                              hipStream_t stream) {
  constexpr int kDynLds = 2 * LDS_BYTES;
  static int grid = 0;
  if (!grid) {
    int dev = 0, cus = 0, per_cu = 0;
    (void)hipGetDevice(&dev);
    (void)hipDeviceGetAttribute(&cus, hipDeviceAttributeMultiprocessorCount, dev);
    if (hipFuncSetAttribute((const void*)fwd_kernel, hipFuncAttributeMaxDynamicSharedMemorySize, kDynLds) != hipSuccess) fprintf(stderr, "hipFuncSetAttribute(%d) failed\n", kDynLds);
    (void)hipOccupancyMaxActiveBlocksPerMultiprocessor(&per_cu, fwd_kernel, 512, kDynLds);
    if (per_cu < 1) fprintf(stderr, "occupancy query says %d blocks/CU\n", per_cu);
    grid = cus;
    if (ws_size < WS_END) fprintf(stderr, "workspace too small: %zu < %zu\n", ws_size, (size_t)WS_END);
  }
  Params p{};
  for (int i = 0; i < 31; ++i) p.in[i] = (const float*)d_in[i];
  p.out = (float*)d_out;
  p.ws = (unsigned char*)d_ws;
#if ONE_LAUNCH
  hipMemsetAsync((char*)d_ws + OFF_BAR, 0, XCD_BAR_WORDS * 4, stream);
  int lo = 0, hi = NPH;
  void* args[] = {&p, &lo, &hi};
  hipError_t e = hipLaunchCooperativeKernel((void*)fwd_kernel, dim3(grid), dim3(512), args, kDynLds, stream);
  if (e != hipSuccess) fprintf(stderr, "cooperative launch failed: %s (grid %d)\n", hipGetErrorString(e), grid);
#else
  for (int ph = 0; ph < NPH; ++ph) hipLaunchKernelGGL(fwd_kernel, dim3(grid), dim3(512), kDynLds, stream, p, ph, ph + 1);
#endif
}
```

```cpp
#include <hip/hip_runtime.h>
#include <hip/hip_cooperative_groups.h>
#include <cstdio>
namespace cg = cooperative_groups;

#ifndef ONE_LAUNCH
#define ONE_LAUNCH 1
#endif

#ifndef ONLYPH
#define ONLYPH -1
#endif
#ifndef DUPPH
#define DUPPH -1
#endif
typedef unsigned short u16;
typedef short bf16x8 __attribute__((ext_vector_type(8)));
typedef float f32x16 __attribute__((ext_vector_type(16)));
typedef __bf16 bf2_t __attribute__((ext_vector_type(2)));
typedef float f2_t __attribute__((ext_vector_type(2)));
typedef unsigned u32x4 __attribute__((ext_vector_type(4)));

#define DI __device__ __forceinline__
#define TIDX ((int)(threadIdx.x & 255u))

constexpr int T = 12288, TP = 4096, DM = 1024;
constexpr int NPH = 14;
constexpr float EPS = 1e-6f;
constexpr float LOG2E = 1.4426950408889634f;
constexpr float QSCALE = 0.125f * LOG2E;
constexpr float LAM_INIT = 0.35550906759f;

constexpr size_t al(size_t x) { return (x + 255) & ~size_t(255); }
constexpr size_t OFF_MODS   = 0;
constexpr size_t OFF_WIN_E  = OFF_MODS + al(2 * 3 * 6144 * 4);
constexpr size_t OFF_WINB   = OFF_WIN_E + al(1536 * 1024 * 2);
constexpr size_t OFF_CBD    = OFF_WINB + al(1024 * 512 * 2);
constexpr size_t OFF_WOUT_ET= OFF_CBD + al(1024 * 512 * 2);
constexpr size_t OFF_BD     = OFF_WOUT_ET + al(1024 * 1024 * 2);
constexpr size_t OFF_WOUT_E = OFF_BD + al(1024 * 1024 * 2);
constexpr size_t OFF_WIN_O  = OFF_WOUT_E + al(1024 * 1024 * 2);
constexpr size_t OFF_WOUT_O = OFF_WIN_O + al(2304 * 1024 * 2);
constexpr size_t OFF_W1     = OFF_WOUT_O + al(1024 * 1024 * 2);
constexpr size_t OFF_W2     = OFF_W1 + al(2 * 4096 * 1024 * 2);
constexpr size_t OFF_D256   = OFF_W2 + al(2 * 4096 * 1024 * 2);
constexpr size_t OFF_H      = OFF_D256 + al(256 * 512 * 2);
constexpr size_t OFF_R2     = OFF_H + al((size_t)T * 1024 * 2);
constexpr size_t R2_BYTES   = (size_t)T * 512 * 2 + (size_t)T * 1024 * 2 * 2;
constexpr size_t OFF_R1     = OFF_R2 + al(R2_BYTES);
constexpr size_t R1_BYTES   = (size_t)T * 4096 * 2;
constexpr size_t OFF_BAR    = OFF_R1 + R1_BYTES;
constexpr size_t OFF_CNT    = OFF_BAR + 3456 * 4;
constexpr size_t CNT_BYTES  = 3 * 64 * 64;
constexpr size_t OFF_PART   = OFF_CNT + CNT_BYTES;
constexpr size_t WS_END     = OFF_PART + (size_t)3 * 4 * T * 4;
constexpr size_t OFF_UA  = OFF_R2;
constexpr size_t OFF_PQT = OFF_UA + (size_t)T * 512 * 2;
constexpr size_t OFF_AB  = OFF_PQT + (size_t)T * 1024 * 2;
constexpr size_t OFF_CQ   = OFF_R2;
constexpr size_t OFF_DQ   = OFF_CQ + (size_t)T * 512 * 2;
constexpr size_t OFF_CKP  = OFF_DQ + (size_t)T * 512 * 2;
constexpr size_t OFF_CKS  = OFF_CKP + (size_t)16 * 8 * 256 * 64 * 2;
constexpr size_t OFF_CVTP = OFF_CKS + (size_t)2 * 8 * 4608 * 64 * 2;
constexpr size_t OFF_CVTS = OFF_CVTP + (size_t)16 * 4 * 128 * 256 * 2;
constexpr size_t OFF_DKP  = OFF_CVTS + (size_t)2 * 4 * 128 * 4608 * 2;
constexpr size_t OFF_DKS  = OFF_DKP + (size_t)16 * 2 * 256 * 64 * 2;
constexpr size_t OFF_DVTP = OFF_DKS + (size_t)2 * 2 * 4608 * 64 * 2;
constexpr size_t OFF_DVTS = OFF_DVTP + (size_t)16 * 2 * 64 * 256 * 2;
constexpr size_t R2_LATE_END = OFF_DVTS + (size_t)2 * 2 * 64 * 4608 * 2;
static_assert(R2_LATE_END <= OFF_R2 + R2_BYTES, "R2 overflow");
constexpr size_t OFF_D4096 = OFF_R1;
constexpr size_t OFF_PEQO  = OFF_R1 + (size_t)32 * 1024 * 1024;
constexpr size_t OFF_M1    = OFF_R1;
constexpr size_t OFF_QKV   = OFF_R1;
constexpr size_t OFF_OM    = OFF_R1 + al((size_t)T * 2304 * 2);
static_assert(OFF_OM + (size_t)T * 1024 * 2 <= WS_END, "R1 overflow");

constexpr size_t OUT_Y   = 0;
constexpr size_t OUT_NCK = (size_t)T * 1024;
constexpr size_t OUT_NCV = OUT_NCK + (size_t)TP * 512;
constexpr size_t OUT_NDK = OUT_NCV + (size_t)TP * 512;
constexpr size_t OUT_NDV = OUT_NDK + (size_t)TP * 128;

struct Params {
  const float* in[31];
  float* out;
  unsigned char* ws;
};

DI float bf2f(u16 v) { return __uint_as_float(((unsigned)v) << 16); }
DI unsigned pack2(float a, float b) { f2_t f = {a, b}; bf2_t v = __builtin_convertvector(f, bf2_t); return __builtin_bit_cast(unsigned, v); }
DI u16 f2bf(float a) { return (u16)(pack2(a, 0.f) & 0xffffu); }
DI int cond_of(int m) { return m < 4096 ? 0 : (m < 8192 ? 1 : 2); }
DI float wave_sum(float v) {
#pragma unroll
  for (int o = 32; o >= 1; o >>= 1) v += __shfl_xor(v, o);
  return v;
}
#define MFMA(a, b, c) __builtin_amdgcn_mfma_f32_32x32x16_bf16((a), (b), (c), 0, 0, 0)

constexpr int LROW = 144;
constexpr int GEMM_BUF = 2 * 128 * LROW;
constexpr int LDS_BYTES = 2 * GEMM_BUF;

template <int NR>
DI void g_load(u32x4 (&R)[NR], const u16* g, int ld, int k0) {
#pragma unroll
  for (int i = 0; i < NR; ++i) R[i] = *(const u32x4*)(g + (size_t)(32 * i) * ld + k0);
}
template <int NR>
DI void g_store(const u32x4 (&R)[NR], char* sw) {
#pragma unroll
  for (int i = 0; i < NR; ++i) *(u32x4*)(sw + (32 * i) * LROW) = R[i];
}
template <int NB>
DI void g_compute(f32x16 (&acc)[2][NB], const char* fa, const char* fb) {
#pragma unroll
  for (int ks = 0; ks < 4; ++ks) {
    bf16x8 a0 = *(const bf16x8*)(fa + ks * 32);
    bf16x8 a1 = *(const bf16x8*)(fa + 32 * LROW + ks * 32);
#pragma unroll
    for (int j = 0; j < NB; ++j) {
      bf16x8 b = *(const bf16x8*)(fb + j * 32 * LROW + ks * 32);
      acc[0][j] = MFMA(a0, b, acc[0][j]);
      acc[1][j] = MFMA(a1, b, acc[1][j]);
    }
  }
}
template <int NB>
DI void gemm_acc(f32x16 (&acc)[2][NB], const u16* A, int lda, const u16* Bt, int ldb, int K, int m0, int n0, char* lds) {
  const int tid = TIDX, lane = tid & 63, wave = tid >> 6;
  const int r = lane & 31, h = lane >> 5;
  const int wm = wave >> 1, wn = wave & 1;
  const int lrow = tid >> 3, lcol = (tid & 7) * 8;
  const u16* ga = A + (size_t)(m0 + lrow) * lda + lcol;
  const u16* gb = Bt + (size_t)(n0 + lrow) * ldb + lcol;
  u32x4 ra0[4], ra1[4], rb0[2 * NB], rb1[2 * NB];
  const int nk = K >> 6;
  char* sw = lds + lrow * LROW + lcol * 2;
  const char* fa = lds + (wm * 64 + r) * LROW + h * 16;
  const char* fb = lds + 128 * LROW + (wn * 32 * NB + r) * LROW + h * 16;
#define G_LOAD(RA, RB, kt_) do { const int k0_ = ((kt_) < nk ? (kt_) : nk - 1) << 6; g_load<4>(RA, ga, lda, k0_); g_load<2 * NB>(RB, gb, ldb, k0_); } while (0)
#define G_STORE(RA, RB, boff_) do { g_store<4>(RA, sw + (boff_)); g_store<2 * NB>(RB, sw + (boff_) + 128 * LROW); } while (0)
  G_LOAD(ra0, rb0, 0);
  G_LOAD(ra1, rb1, 1);
  G_STORE(ra0, rb0, 0);
  __syncthreads();
  for (int kt = 0; kt < nk; kt += 2) {
    G_LOAD(ra0, rb0, kt + 2);
    g_compute<NB>(acc, fa, fb);
    G_STORE(ra1, rb1, GEMM_BUF);
    __syncthreads();
    G_LOAD(ra1, rb1, kt + 3);
    g_compute<NB>(acc, fa + GEMM_BUF, fb + GEMM_BUF);
    G_STORE(ra0, rb0, 0);
    __syncthreads();
  }
#undef G_LOAD
#undef G_STORE
}

template <class Epi>
DI void gemm_tile(const u16* A, int lda, const u16* Bt, int ldb, int K, int m0, int n0, Epi epi, char* lds) {
  const int lane = TIDX & 63, wave = TIDX >> 6;
  const int r = lane & 31, h = lane >> 5, wm = wave >> 1, wn = wave & 1;
  f32x16 acc[2][2];
#pragma unroll
  for (int i = 0; i < 2; ++i)
#pragma unroll
    for (int j = 0; j < 2; ++j)
#pragma unroll
      for (int e = 0; e < 16; ++e) acc[i][j][e] = 0.f;
  gemm_acc<2>(acc, A, lda, Bt, ldb, K, m0, n0, lds);
#pragma unroll
  for (int i = 0; i < 2; ++i)
#pragma unroll
    for (int j = 0; j < 2; ++j)
#pragma unroll
      for (int q = 0; q < 4; ++q) {
        const int m = m0 + wm * 64 + i * 32 + 8 * q + 4 * h;
        const int n = n0 + wn * 64 + j * 32 + r;
        epi(m, n, acc[i][j][4 * q], acc[i][j][4 * q + 1], acc[i][j][4 * q + 2], acc[i][j][4 * q + 3]);
      }
}

DI void dft_pair(const u16* Dm, const u16* PeQo, const u16* PH, int phstride, int H, int m0, int n0, u16* AB, int rowbase, int colsPerBatch, float norm, char* shm, int half) {
  char* lds = shm + half * LDS_BYTES;
  const int lane = TIDX & 63, wave = TIDX >> 6;
  const int r = lane & 31, h = lane >> 5, wm = wave >> 1, wn = wave & 1;
  f32x16 acc[2][1];
#pragma unroll
  for (int i = 0; i < 2; ++i)
#pragma unroll
    for (int e = 0; e < 16; ++e) acc[i][0][e] = 0.f;
  gemm_acc<1>(acc, Dm + half * H, 2 * H, PeQo + half * H, 2 * H, H, m0, n0, lds);
  float* exo = (float*)lds + wave * 2048 + lane;
  const float* exr = (const float*)(shm + (1 - half) * LDS_BYTES) + wave * 2048 + lane;
#pragma unroll
  for (int i = 0; i < 2; ++i)
#pragma unroll
    for (int e = 0; e < 16; ++e) exo[(i * 16 + e) * 64] = acc[i][0][e];
  __syncthreads();
  const int N = 2 * H;
  const int col = n0 + wn * 32 + r;
  const int b = col / colsPerBatch, c = col - b * colsPerBatch;
  const float ph = bf2f(PH[(size_t)col * phstride]);
  u16* base = AB + ((size_t)rowbase + (size_t)b * N) * 1024 + 512 + c;
#pragma unroll
  for (int i = 0; i < 2; ++i)
#pragma unroll
    for (int q = 0; q < 4; ++q)
#pragma unroll
      for (int e = 0; e < 4; ++e) {
        const int k = m0 + wm * 64 + i * 32 + 8 * q + 4 * h + e;
        const float other = exr[(i * 16 + 4 * q + e) * 64];
        const float sp = (k & 1) ? -ph : ph;
        if (half == 0) base[(size_t)k * 1024] = f2bf((acc[i][0][4 * q + e] + sp - other) * norm);
        else if (k > 0) base[(size_t)(N - k) * 1024] = f2bf((other + sp + acc[i][0][4 * q + e]) * norm);
      }
  __syncthreads();
}

struct EpiBf16 {
  u16* C; int ldc;
  DI void operator()(int m, int n, float v0, float v1, float v2, float v3) const {
    u16* p = C + (size_t)m * ldc + n;
    p[0] = f2bf(v0); p[ldc] = f2bf(v1); p[2 * ldc] = f2bf(v2); p[3 * ldc] = f2bf(v3);
  }
};
struct EpiU {
  u16* UA; u16* PQt;
  DI void operator()(int m, int n, float v0, float v1, float v2, float v3) const {
    if (n < 512) {
      u16* p = UA + (size_t)m * 512 + n;
      p[0] = f2bf(v0); p[512] = f2bf(v1); p[1024] = f2bf(v2); p[1536] = f2bf(v3);
    } else {
      const int np = n - 512, g = np >> 8, pq = (np >> 7) & 1, mm = np & 127;
      size_t off;
      if (m < 4096) { const int b = m >> 8, nl = m & 255; off = ((size_t)(b * 512 + g * 128 + mm)) * 512 + pq * 256 + nl; }
      else { const int ms = m - 4096, b = ms >> 12, nl = ms & 4095; off = (size_t)16 * 512 * 512 + ((size_t)(b * 512 + g * 128 + mm)) * 8192 + pq * 4096 + nl; }
      uint2 w; w.x = pack2(v0, v1); w.y = pack2(v2, v3);
      *(uint2*)(PQt + off) = w;
    }
  }
};
struct EpiDft {
  u16* AB; int rowbase; float norm; int sample;
  DI void operator()(int m, int n, float v0, float v1, float v2, float v3) const {
    size_t row; int c;
    if (sample) { row = (size_t)4096 + (size_t)(n >> 9) * 4096 + m; c = n & 511; }
    else { row = (size_t)rowbase + m; c = n; }
    u16* p = AB + row * 1024 + 512 + c;
    p[0] = f2bf(v0 * norm); p[1024] = f2bf(v1 * norm); p[2048] = f2bf(v2 * norm); p[3072] = f2bf(v3 * norm);
  }
};
struct EpiRes {
  const float* xin_p; const float* xin_s;
  float* X; const float* gate;
  DI void operator()(int m, int n, float v0, float v1, float v2, float v3) const {
    const float* xi = (m < 4096) ? xin_p + (size_t)m * 1024 + n : xin_s + (size_t)(m - 4096) * 1024 + n;
    const float g = gate[cond_of(m) * 6144 + n];
    float* xo = X + (size_t)m * 1024 + n;
    xo[0] = xi[0] + g * v0; xo[1024] = xi[1024] + g * v1; xo[2048] = xi[2048] + g * v2; xo[3072] = xi[3072] + g * v3;
  }
};
struct EpiRelu2 {
  u16* C;
  DI void operator()(int m, int n, float v0, float v1, float v2, float v3) const {
    v0 = fmaxf(v0, 0.f); v1 = fmaxf(v1, 0.f); v2 = fmaxf(v2, 0.f); v3 = fmaxf(v3, 0.f);
    u16* p = C + (size_t)m * 4096 + n;
    p[0] = f2bf(v0 * v0); p[4096] = f2bf(v1 * v1); p[8192] = f2bf(v2 * v2); p[12288] = f2bf(v3 * v3);
  }
};
struct EpiQkv {
  u16* QKV; u16* CVtP; u16* CVtS; u16* DVtP; u16* DVtS; float* ncv; float* ndv;
  DI void operator()(int m, int n, float v0, float v1, float v2, float v3) const {
    const bool is_cv = (n >= 1024 && n < 1536), is_dv = (n >= 2176);
    if (!is_cv && !is_dv) {
      u16* p = QKV + (size_t)m * 2304 + n;
      p[0] = f2bf(v0); p[2304] = f2bf(v1); p[4608] = f2bf(v2); p[6912] = f2bf(v3);
      return;
    }
    uint2 w; w.x = pack2(v0, v1); w.y = pack2(v2, v3);
    if (is_cv) {
      const int c = n - 1024;
      if (m < 4096) {
        const int b = m >> 8, nl = m & 255;
        *(uint2*)(CVtP + ((size_t)(b * 512 + c)) * 256 + nl) = w;
        float* o = ncv + (size_t)m * 512 + c; o[0] = v0; o[512] = v1; o[1024] = v2; o[1536] = v3;
      } else {
        const int ms = m - 4096, b = ms >> 12, nl = ms & 4095;
        *(uint2*)(CVtS + ((size_t)(b * 512 + c)) * 4608 + 512 + nl) = w;
      }
    } else {
      const int c = n - 2176;
      if (m < 4096) {
        const int b = m >> 8, nl = m & 255;
        *(uint2*)(DVtP + ((size_t)(b * 128 + c)) * 256 + nl) = w;
        float* o = ndv + (size_t)m * 128 + c; o[0] = v0; o[128] = v1; o[256] = v2; o[384] = v3;
      } else {
        const int ms = m - 4096, b = ms >> 12, nl = ms & 4095;
        *(uint2*)(DVtS + ((size_t)(b * 128 + c)) * 4608 + 512 + nl) = w;
      }
    }
  }
};

DI void ada_item(const Params& p, int id, char* lds) {
  const int tid = TIDX;
  float* ssil = (float*)lds;
  float* red = (float*)(lds + 12288);
  const int l = id / 192, cb = id % 192;
  for (int i = tid; i < 3072; i += 256) {
    const int j = i >> 10, k = i & 1023;
    const float v = (j == 0) ? p.in[7][k] : p.in[2][(j - 1) * 1024 + k];
    ssil[i] = v / (1.f + __expf(-v));
  }
  __syncthreads();
  const int cq = tid & 7, kg = tid >> 3;
  const float* w = p.in[10] + (size_t)l * 1024 * 6144 + cb * 32 + cq * 4;
  float4 a0 = {0, 0, 0, 0}, a1 = {0, 0, 0, 0}, a2 = {0, 0, 0, 0};
#pragma unroll 8
  for (int kk = 0; kk < 32; ++kk) {
    const int k = kg * 32 + kk;
    const float4 wv = *(const float4*)(w + (size_t)k * 6144);
    const float s0 = ssil[k], s1 = ssil[1024 + k], s2 = ssil[2048 + k];
    a0.x += s0 * wv.x; a0.y += s0 * wv.y; a0.z += s0 * wv.z; a0.w += s0 * wv.w;
    a1.x += s1 * wv.x; a1.y += s1 * wv.y; a1.z += s1 * wv.z; a1.w += s1 * wv.w;
    a2.x += s2 * wv.x; a2.y += s2 * wv.y; a2.z += s2 * wv.z; a2.w += s2 * wv.w;
  }
  float* rp = red + kg * 96 + cq * 4;
  rp[0] = a0.x; rp[1] = a0.y; rp[2] = a0.z; rp[3] = a0.w;
  rp[32] = a1.x; rp[33] = a1.y; rp[34] = a1.z; rp[35] = a1.w;
  rp[64] = a2.x; rp[65] = a2.y; rp[66] = a2.z; rp[67] = a2.w;
  __syncthreads();
  if (tid < 96) {
    const int j = tid >> 5, c = tid & 31;
    float sum = 0.f;
#pragma unroll
    for (int g = 0; g < 32; ++g) sum += red[g * 96 + j * 32 + c];
    const int col = cb * 32 + c;
    ((float*)(p.ws + OFF_MODS))[(size_t)(l * 3 + j) * 6144 + col] = sum + p.in[11][l * 6144 + col];
  }
  __syncthreads();
}

DI void transpose_tile(const float* src, int ld_src, u16* dst, int ld_dst, int r0, int c0, char* lds) {
  float* tile = (float*)lds;
  const int tid = TIDX;
  const int j4 = (tid & 15) * 4, i0 = tid >> 4;
#pragma unroll
  for (int it = 0; it < 4; ++it) {
    const int i = i0 + 16 * it;
    const float4 v = *(const float4*)(src + (size_t)(r0 + i) * ld_src + c0 + j4);
    float* tp = tile + i * 65 + j4;
    tp[0] = v.x; tp[1] = v.y; tp[2] = v.z; tp[3] = v.w;
  }
  __syncthreads();
  const int kc = (tid & 7) * 8, jr = tid >> 3;
#pragma unroll
  for (int it = 0; it < 2; ++it) {
    const int j = jr + 32 * it;
    const float* tp = tile + kc * 65 + j;
    uint4 o;
    o.x = pack2(tp[0], tp[65]); o.y = pack2(tp[130], tp[195]); o.z = pack2(tp[260], tp[325]); o.w = pack2(tp[390], tp[455]);
    *(uint4*)(dst + (size_t)(c0 + j) * ld_dst + r0 + kc) = o;
  }
  __syncthreads();
}

DI void prep_transposes(const Params& p, int vb, int G, char* lds, int layer) {
  const int ntile = layer ? 2880 : 2432;
  for (int t = vb; t < ntile; t += G) {
    const float* src; u16* dst; int lds_, ldd, r0, c0;
    int q = t;
    if (layer == 0) {
      if (q < 128) { src = p.in[12]; lds_ = 1024; dst = (u16*)(p.ws + OFF_WIN_E); ldd = 1024; r0 = (q >> 3) * 64; c0 = (q & 7) * 64; }
      else if ((q -= 128) < 256) { src = p.in[16]; lds_ = 1024; dst = (u16*)(p.ws + OFF_WOUT_ET); ldd = 1024; r0 = (q >> 4) * 64; c0 = (q & 15) * 64; }
      else if ((q -= 256) < 1024) { src = p.in[29]; lds_ = 4096; dst = (u16*)(p.ws + OFF_W1); ldd = 1024; r0 = (q >> 6) * 64; c0 = (q & 63) * 64; }
      else { q -= 1024; src = p.in[30]; lds_ = 1024; dst = (u16*)(p.ws + OFF_W2); ldd = 4096; r0 = (q >> 4) * 64; c0 = (q & 15) * 64; }
    } else {
      if (q < 576) { src = p.in[17]; lds_ = 2304; dst = (u16*)(p.ws + OFF_WIN_O); ldd = 1024; r0 = (q / 36) * 64; c0 = (q % 36) * 64; }
      else if ((q -= 576) < 256) { src = p.in[28]; lds_ = 1024; dst = (u16*)(p.ws + OFF_WOUT_O); ldd = 1024; r0 = (q >> 4) * 64; c0 = (q & 15) * 64; }
      else if ((q -= 256) < 1024) { src = p.in[29] + (size_t)1024 * 4096; lds_ = 4096; dst = (u16*)(p.ws + OFF_W1) + (size_t)4096 * 1024; ldd = 1024; r0 = (q >> 6) * 64; c0 = (q & 63) * 64; }
      else { q -= 1024; src = p.in[30] + (size_t)4096 * 1024; lds_ = 1024; dst = (u16*)(p.ws + OFF_W2) + (size_t)1024 * 4096; ldd = 4096; r0 = (q >> 4) * 64; c0 = (q & 15) * 64; }
    }
    transpose_tile(src, lds_, dst, ldd, r0, c0, lds);
  }
}

DI void prep_elementwise(const Params& p, int vb, int G) {
  const size_t gt = (size_t)vb * 256 + TIDX, gs = (size_t)G * 256;
  {
    u16* d = (u16*)(p.ws + OFF_WINB);
    for (size_t i = gt; i < 1024 * 256; i += gs) {
      const int k = (int)(i >> 8), c = (int)(i & 255) * 2;
      const float* s = p.in[12] + (size_t)k * 1024 + 512 + c;
      *(unsigned*)(d + (size_t)k * 512 + c) = pack2(s[0], s[1]);
    }
  }
  {
    u16* d = (u16*)(p.ws + OFF_CBD);
    for (size_t i = gt; i < 1024 * 512; i += gs) {
      const int np = (int)(i >> 9), cp = (int)(i & 511);
      const int g = np >> 8, pq = (np >> 7) & 1, m = np & 127;
      float v = 0.f;
      if ((cp >> 7) == g) {
        const int c = cp & 127; const int rr = (m * c) & 127;
        const float x = (float)rr * (2.0f / 128.0f);
        v = pq ? sinpif(x) : cospif(x);
      }
      d[i] = f2bf(v);
    }
  }
  {
    u16* d = (u16*)(p.ws + OFF_BD);
    for (size_t i = gt; i < 1024 * 1024; i += gs) {
      const int kp = (int)(i >> 10), c = (int)(i & 1023);
      float v = 0.f;
      if (kp < 512) { const int g = kp >> 7; if (c < 512 && (c >> 7) == g) v = p.in[13][(size_t)g * 16384 + (kp & 127) * 128 + (c & 127)] * p.in[14][c]; }
      else { const int g = (kp - 512) >> 7; if (c >= 512 && ((c - 512) >> 7) == g) v = p.in[15][(size_t)g * 16384 + ((kp - 512) & 127) * 128 + ((c - 512) & 127)]; }
      d[i] = f2bf(v);
    }
  }
#pragma unroll 1
  for (int which = 0; which < 2; ++which) {
    const int H = which ? 2048 : 128, N = 2 * H, lg = which ? 9 : 5;
    u16* d = (u16*)(p.ws + (which ? OFF_D4096 : OFF_D256));
    const float invN = 1.0f / (float)N;
    for (size_t i = gt; i < ((size_t)H << lg); i += gs) {
      const int k = (int)(i >> lg), np = (int)(i & ((1 << lg) - 1)) * 8;
      const bool is_sin = np >= H;
      const int n = np & (H - 1);
      unsigned w[4];
#pragma unroll
      for (int e = 0; e < 4; ++e) {
        const float x0 = (float)((k * (n + 2 * e)) & (N - 1)) * invN, x1 = (float)((k * (n + 2 * e + 1)) & (N - 1)) * invN;
        const float v0 = is_sin ? __builtin_amdgcn_sinf(x0) : __builtin_amdgcn_cosf(x0);
        const float v1 = is_sin ? __builtin_amdgcn_sinf(x1) : __builtin_amdgcn_cosf(x1);
        w[e] = pack2(v0, v1);
      }
      *(uint4*)(d + (size_t)k * N + np) = make_uint4(w[0], w[1], w[2], w[3]);
    }
  }
}

DI void sym_phase(const Params& p, int vb, int G) {
  const int lane = TIDX & 63, wave = TIDX >> 6;
  const u16* PQT = (const u16*)(p.ws + OFF_PQT);
  u16* PEQO = (u16*)(p.ws + OFF_PEQO);
  u16* AB = (u16*)(p.ws + OFF_AB);
  for (int it = vb * 4 + wave; it < 1024 + 2048; it += G * 4) {
    const bool samp = it < 1024;
    const int H = samp ? 2048 : 128, N = 2 * H;
    int col, n0base, nstep;
    if (samp) { col = it; n0base = lane * 8; nstep = 512; }
    else { col = (it - 1024) * 4 + (lane >> 4); n0base = (lane & 15) * 8; nstep = 128; }
    const u16* Pp = samp ? PQT + (size_t)16 * 512 * 512 + (size_t)col * 8192 : PQT + (size_t)col * 512;
    const u16* Qp = Pp + N;
    u16* Pe = samp ? PEQO + (size_t)16 * 512 * 256 + (size_t)col * 4096 : PEQO + (size_t)col * 256;
    u16* Qo = Pe + H;
    float alt = 0.f;
    for (int n0 = n0base; n0 < H; n0 += nstep) {
      const uint4 pw = *(const uint4*)(Pp + n0), qw = *(const uint4*)(Qp + n0);
      const unsigned pa[4] = {pw.x, pw.y, pw.z, pw.w}, qa[4] = {qw.x, qw.y, qw.z, qw.w};
      float pe[8], qo[8];
#pragma unroll
      for (int e = 0; e < 8; ++e) {
        const float pv = (e & 1) ? __uint_as_float(pa[e >> 1] & 0xffff0000u) : __uint_as_float(pa[e >> 1] << 16);
        const float qv = (e & 1) ? __uint_as_float(qa[e >> 1] & 0xffff0000u) : __uint_as_float(qa[e >> 1] << 16);
        const int n = n0 + e;
        float pm = 0.f, qm = 0.f;
        if (n > 0) { pm = bf2f(Pp[N - n]); qm = bf2f(Qp[N - n]); }
        pe[e] = pv + pm;
        qo[e] = (n > 0) ? qv - qm : 0.f;
        alt += (e & 1) ? -pe[e] : pe[e];
      }
      *(uint4*)(Pe + n0) = make_uint4(pack2(pe[0], pe[1]), pack2(pe[2], pe[3]), pack2(pe[4], pe[5]), pack2(pe[6], pe[7]));
      *(uint4*)(Qo + n0) = make_uint4(pack2(qo[0], qo[1]), pack2(qo[2], qo[3]), pack2(qo[4], qo[5]), pack2(qo[6], qo[7]));
    }
    alt += __shfl_xor(alt, 1); alt += __shfl_xor(alt, 2); alt += __shfl_xor(alt, 4); alt += __shfl_xor(alt, 8);
    if (samp) { alt += __shfl_xor(alt, 16); alt += __shfl_xor(alt, 32); }
    if ((samp && lane == 0) || (!samp && (lane & 15) == 0)) {
      const float fh = alt + bf2f(Pp[H]);
      size_t row; int c; float norm;
      if (samp) { row = (size_t)4096 + (size_t)(col >> 9) * 4096 + 2048; c = col & 511; norm = 0.0013810679320049757f; }
      else { row = (size_t)(col >> 9) * 256 + 128; c = col & 511; norm = 0.005524271728019903f; }
      AB[row * 1024 + 512 + c] = f2bf(fh * norm);
    }
  }
}

DI void normmod_phase(const Params& p, int vb, int G, const float* xp, const float* xs, const float* gain, int l, int which) {
  const int lane = TIDX & 63, wave = TIDX >> 6;
  u16* H = (u16*)(p.ws + OFF_H);
  const float* mods = (const float*)(p.ws + OFF_MODS) + (size_t)l * 3 * 6144;
  for (int row = vb * 4 + wave; row < T; row += G * 4) {
    const float* x = (row < 4096) ? xp + (size_t)row * 1024 : xs + (size_t)(row - 4096) * 1024;
    float4 v[4];
    float ss = 0.f;
#pragma unroll
    for (int i = 0; i < 4; ++i) {
      v[i] = *(const float4*)(x + i * 256 + lane * 4);
      ss += v[i].x * v[i].x + v[i].y * v[i].y + v[i].z * v[i].z + v[i].w * v[i].w;
    }
    ss = wave_sum(ss);
    const float rinv = rsqrtf(ss * (1.0f / 1024.0f) + EPS);
    const float* md = mods + cond_of(row) * 6144 + which * 3072;
#pragma unroll
    for (int i = 0; i < 4; ++i) {
      const int c = i * 256 + lane * 4;
      const float4 g = *(const float4*)(gain + c);
      const float4 sh = *(const float4*)(md + c);
      const float4 sc = *(const float4*)(md + 1024 + c);
      const float o0 = v[i].x * rinv * g.x * (1.f + sc.x) + sh.x;
      const float o1 = v[i].y * rinv * g.y * (1.f + sc.y) + sh.y;
      const float o2 = v[i].z * rinv * g.z * (1.f + sc.z) + sh.z;
      const float o3 = v[i].w * rinv * g.w * (1.f + sc.w) + sh.w;
      uint2 w; w.x = pack2(o0, o1); w.y = pack2(o2, o3);
      *(uint2*)(H + (size_t)row * 1024 + c) = w;
    }
  }
}

template <class Epi>
DI void gemm_phase(const u16* A, int lda, const u16* Bt, int ldb, int K, int M, int N, Epi epi, int vb, int G, char* lds) {
  const int nN = N >> 7, nt = (M >> 7) * nN, grp = 8 * nN;
  for (int t = vb; t < nt; t += G) {
    const int gi = t / grp, rem = t - gi * grp;
    gemm_tile(A, lda, Bt, ldb, K, (gi * 8 + (rem & 7)) << 7, (rem >> 3) << 7, epi, lds);
  }
}

template <int HW>
DI void pool_item(const u16* UA, u16* AB, int t, int c8) {
  int nl, N;
  if (t < 4096) { nl = t & 255; N = 256; } else { nl = (t - 4096) & 4095; N = 4096; }
  const int base = t - nl;
  u32x4 w[2 * HW];
  int cnt = 0;
#pragma unroll
  for (int j = 0; j < 2 * HW; ++j) {
    const int idx = nl - HW + j;
    const bool ok = idx >= 0 && idx < N;
    w[j] = *(const u32x4*)(UA + (size_t)(base + (ok ? idx : nl)) * 512 + c8);
    if (!ok) w[j] = (u32x4){0u, 0u, 0u, 0u};
    cnt += ok ? 1 : 0;
  }
  const u32x4 cw = *(const u32x4*)(UA + (size_t)t * 512 + c8);
  float s[8] = {0, 0, 0, 0, 0, 0, 0, 0};
#pragma unroll
  for (int j = 0; j < 2 * HW; ++j)
#pragma unroll
    for (int e = 0; e < 4; ++e) { s[2 * e] += __uint_as_float(w[j][e] << 16); s[2 * e + 1] += __uint_as_float(w[j][e] & 0xffff0000u); }
  const float inv = 1.0f / (float)cnt;
  u32x4 o;
#pragma unroll
  for (int e = 0; e < 4; ++e) o[e] = pack2(s[2 * e] * inv - __uint_as_float(cw[e] << 16), s[2 * e + 1] * inv - __uint_as_float(cw[e] & 0xffff0000u));
  *(u32x4*)(AB + (size_t)t * 1024 + c8) = o;
}
DI void pool_phase(const Params& p, int vb, int G) {
  const u16* UA = (const u16*)(p.ws + OFF_UA);
  u16* AB = (u16*)(p.ws + OFF_AB);
  const size_t gt = (size_t)vb * 256 + TIDX, gs = (size_t)G * 256;
  for (size_t i = gt; i < (size_t)T * 64; i += gs) {
    const int cc = (int)(i & 15), tt = (int)(i >> 4) & 3, g = (int)(i >> 6) & 3, tb = (int)(i >> 8);
    const int t = tb * 4 + tt, c8 = g * 128 + cc * 8;
    if (g == 0) pool_item<1>(UA, AB, t, c8);
    else if (g == 1) pool_item<2>(UA, AB, t, c8);
    else if (g == 2) pool_item<4>(UA, AB, t, c8);
    else pool_item<8>(UA, AB, t, c8);
  }
}

DI void qkvpost_phase(const Params& p, int vb, int G) {
  const int lane = TIDX & 63, wave = TIDX >> 6;
  const int q = lane & 15, sub = lane >> 4;
  const u16* QKV = (const u16*)(p.ws + OFF_QKV);
  u16* CQ = (u16*)(p.ws + OFF_CQ); u16* DQ = (u16*)(p.ws + OFF_DQ);
  u16* CKP = (u16*)(p.ws + OFF_CKP); u16* CKS = (u16*)(p.ws + OFF_CKS);
  u16* DKP = (u16*)(p.ws + OFF_DKP); u16* DKS = (u16*)(p.ws + OFF_DKS);
  float* nck = p.out + OUT_NCK; float* ndk = p.out + OUT_NDK;
  const int d0 = q * 4;
  float fr[4];
#pragma unroll
  for (int e = 0; e < 4; ++e) fr[e] = exp2f(-(float)((d0 + e) & 15) * (13.287712379549449f / 16.0f));
  const bool firsthalf = ((d0 >> 4) & 1) == 0;
  for (int t = vb * 4 + wave; t < T; t += G * 4) {
    const bool samp = t >= 4096;
    int b, nl;
    if (!samp) { b = t >> 8; nl = t & 255; } else { b = (t - 4096) >> 12; nl = (t - 4096) & 4095; }
    float cs[4], sn[4];
    if (samp) {
      const float pos = (d0 < 32) ? (float)(nl >> 6) : (float)(nl & 63);
#pragma unroll
      for (int e = 0; e < 4; ++e) { const float a = pos * fr[e]; cs[e] = cosf(a); sn[e] = sinf(a); }
    } else {
#pragma unroll
      for (int e = 0; e < 4; ++e) { cs[e] = 1.f; sn[e] = 0.f; }
    }
    for (int rd = 0; rd < 7; ++rd) {
      const int slot = rd * 4 + sub;
      const bool act = slot < 26;
      const int vi = act ? (slot < 16 ? slot : slot + 8) : 0;
      const uint2 raw = *(const uint2*)(QKV + (size_t)t * 2304 + vi * 64 + d0);
      float x[4] = {__uint_as_float(raw.x << 16), __uint_as_float(raw.x & 0xffff0000u), __uint_as_float(raw.y << 16), __uint_as_float(raw.y & 0xffff0000u)};
      float ss = x[0] * x[0] + x[1] * x[1] + x[2] * x[2] + x[3] * x[3];
      ss += __shfl_xor(ss, 1); ss += __shfl_xor(ss, 2); ss += __shfl_xor(ss, 4); ss += __shfl_xor(ss, 8);
      const float rinv = rsqrtf(ss * (1.0f / 64.0f) + EPS);
      const float* gp = (vi < 8) ? p.in[18] : (vi < 16) ? p.in[19] : (vi < 32) ? p.in[25] : p.in[26];
      const float4 g = *(const float4*)(gp + d0);
      float y[4] = {x[0] * rinv * g.x, x[1] * rinv * g.y, x[2] * rinv * g.z, x[3] * rinv * g.w};
      float o[4];
#pragma unroll
      for (int e = 0; e < 4; ++e) {
        const float part = __shfl_xor(y[e], 4);
        o[e] = firsthalf ? (y[e] * cs[e] - part * sn[e]) : (y[e] * cs[e] + part * sn[e]);
      }
      if (!act) continue;
      const bool isq = (vi < 8) || (vi >= 24 && vi < 32);
      if (isq) {
        const int hd = (vi < 8) ? vi : vi - 24;
        u16* base = (vi < 8) ? CQ : DQ;
        size_t off = samp ? (size_t)16 * 8 * 256 * 64 + ((size_t)(b * 8 + hd) * 4096 + nl) * 64 : ((size_t)(b * 8 + hd) * 256 + nl) * 64;
        uint2 w; w.x = pack2(o[0] * QSCALE, o[1] * QSCALE); w.y = pack2(o[2] * QSCALE, o[3] * QSCALE);
        *(uint2*)(base + off + d0) = w;
      } else if (vi < 16) {
        const int hm = vi - 8;
        uint2 w; w.x = pack2(o[0], o[1]); w.y = pack2(o[2], o[3]);
        if (samp) *(uint2*)(CKS + ((size_t)(b * 8 + hm) * 4608 + 512 + nl) * 64 + d0) = w;
        else {
          *(uint2*)(CKP + ((size_t)(b * 8 + hm) * 256 + nl) * 64 + d0) = w;
          *(float4*)(nck + (size_t)t * 512 + hm * 64 + d0) = make_float4(o[0], o[1], o[2], o[3]);
        }
      } else {
        const int j = vi - 32;
        uint2 w; w.x = pack2(o[0], o[1]); w.y = pack2(o[2], o[3]);
        if (samp) *(uint2*)(DKS + ((size_t)(b * 2 + j) * 4608 + 512 + nl) * 64 + d0) = w;
        else {
          *(uint2*)(DKP + ((size_t)(b * 2 + j) * 256 + nl) * 64 + d0) = w;
          *(float4*)(ndk + (size_t)t * 128 + j * 64 + d0) = make_float4(o[0], o[1], o[2], o[3]);
        }
      }
    }
  }
  const size_t gt = (size_t)vb * 256 + TIDX, gs = (size_t)G * 256;
  {
    u16* CVTS = (u16*)(p.ws + OFF_CVTS); u16* DVTS = (u16*)(p.ws + OFF_DVTS);
    for (size_t i = gt; i < (size_t)2 * 512 * 512; i += gs) {
      const int b = (int)(i >> 18), key = (int)(i >> 9) & 511, c = (int)(i & 511);
      CKS[((size_t)(b * 8 + (c >> 6)) * 4608 + key) * 64 + (c & 63)] = f2bf(p.in[3][i]);
    }
    for (size_t i = gt; i < (size_t)2 * 512 * 512; i += gs) {
      const int b = (int)(i >> 18), c = (int)(i >> 9) & 511, key = (int)(i & 511);
      CVTS[((size_t)(b * 512 + c)) * 4608 + key] = f2bf(p.in[4][((size_t)b * 512 + key) * 512 + c]);
    }
    for (size_t i = gt; i < (size_t)2 * 512 * 128; i += gs) {
      const int b = (int)(i >> 16), key = (int)(i >> 7) & 511, c = (int)(i & 127);
      DKS[((size_t)(b * 2 + (c >> 6)) * 4608 + key) * 64 + (c & 63)] = f2bf(p.in[5][i]);
    }
    for (size_t i = gt; i < (size_t)2 * 128 * 512; i += gs) {
      const int b = (int)(i >> 16), c = (int)(i >> 9) & 127, key = (int)(i & 511);
      DVTS[((size_t)(b * 128 + c)) * 4608 + key] = f2bf(p.in[6][((size_t)b * 512 + key) * 128 + c]);
    }
  }
}

template <int DV>
DI void attn_item(const u16* Q, const u16* Kb, const u16* Vt, int ldv, int nt0, int key1, int nt1,
                  bool masked, int qpos0, bool has_sink, float sink2, u16* out, int ldo, char* lds) {
  constexpr int NDB = DV / 32;
  constexpr int KVBUF = (64 + DV) * LROW;
  const int tid = TIDX, lane = tid & 63, wave = tid >> 6;
  const int r = lane & 31, h = lane >> 5;
  const int nt = nt0 + nt1;
  bf16x8 qf[4];
#pragma unroll
  for (int ks = 0; ks < 4; ++ks) qf[ks] = *(const bf16x8*)(Q + (size_t)(wave * 32 + r) * 64 + ks * 16 + h * 8);
  f32x16 O[NDB];
#pragma unroll
  for (int i = 0; i < NDB; ++i)
#pragma unroll
    for (int e = 0; e < 16; ++e) O[i][e] = 0.f;
  float mrun = has_sink ? sink2 : -1e30f;
  float lrun = has_sink ? (h == 0 ? 1.f : 0.f) : 0.f;
  const int lrow = tid >> 3, lpart = (tid & 7) * 8;
  uint4 rk0, rk1, rv0, rv1, rv2, rv3;
  rv2 = rv3 = make_uint4(0, 0, 0, 0);
  const u16* gk = Kb + (size_t)lrow * 64 + lpart;
  const u16* gv = Vt + (size_t)lrow * ldv + lpart;
#define ATT_GLOAD(key0_)                                                         \
  do {                                                                           \
    rk0 = *(const uint4*)(gk + (size_t)(key0_) * 64);                            \
    rk1 = *(const uint4*)(gk + (size_t)((key0_) + 32) * 64);                     \
    rv0 = *(const uint4*)(gv + (key0_));                                         \
    rv1 = *(const uint4*)(gv + (size_t)32 * ldv + (key0_));                      \
    if constexpr (DV == 128) {                                                   \
      rv2 = *(const uint4*)(gv + (size_t)64 * ldv + (key0_));                    \
      rv3 = *(const uint4*)(gv + (size_t)96 * ldv + (key0_));                    \
    }                                                                            \
  } while (0)
#define ATT_SSTORE(boff_)                                                        \
  do {                                                                           \
    *(uint4*)(sw + (boff_)) = rk0;                                               \
    *(uint4*)(sw + (boff_) + 32 * LROW) = rk1;                                   \
    *(uint4*)(sw + (boff_) + 64 * LROW) = rv0;                                   \
    *(uint4*)(sw + (boff_) + 96 * LROW) = rv1;                                   \
    if constexpr (DV == 128) {                                                   \
      *(uint4*)(sw + (boff_) + 128 * LROW) = rv2;                                \
      *(uint4*)(sw + (boff_) + 160 * LROW) = rv3;                                \
    }                                                                            \
  } while (0)
  char* sw = lds + lrow * LROW + lpart * 2;
  {
    const int key0 = (nt0 > 0) ? 0 : key1;
    ATT_GLOAD(key0);
  }
  ATT_SSTORE(0);
  __syncthreads();
  const int pr = (r & 0x13) | ((r & 4) << 1) | ((r & 8) >> 1);
  const char* fk = lds + pr * LROW + h * 16;
  const char* fv = lds + 64 * LROW + r * LROW + h * 16;
  const int qpos = qpos0 + wave * 32 + r;
  for (int t = 0; t < nt; ++t) {
    const int cur = (t & 1) * KVBUF;
    const int key0 = (t < nt0) ? t * 64 : key1 + (t - nt0) * 64;
    {
      const int tn = (t + 1 < nt) ? t + 1 : t;
      const int kn = (tn < nt0) ? tn * 64 : key1 + (tn - nt0) * 64;
      ATT_GLOAD(kn);
    }
    f32x16 S[2];
#pragma unroll
    for (int kb = 0; kb < 2; ++kb) {
#pragma unroll
      for (int e = 0; e < 16; ++e) S[kb][e] = 0.f;
#pragma unroll
      for (int ks = 0; ks < 4; ++ks) {
        const bf16x8 kf = *(const bf16x8*)(fk + cur + kb * 32 * LROW + ks * 32);
        S[kb] = MFMA(kf, qf[ks], S[kb]);
      }
    }
    if (masked && t >= nt0) {
#pragma unroll
      for (int kb = 0; kb < 2; ++kb)
#pragma unroll
        for (int e = 0; e < 16; ++e) {
          const int jpos = key0 - 512 + kb * 32 + 16 * (e >> 3) + 8 * h + (e & 7);
          const int dlt = qpos - jpos;
          if (dlt > 128 || dlt < -128) S[kb][e] = -1e30f;
        }
    }
    float mloc = S[0][0];
#pragma unroll
    for (int kb = 0; kb < 2; ++kb)
#pragma unroll
      for (int e = 0; e < 16; ++e) mloc = fmaxf(mloc, S[kb][e]);
    mloc = fmaxf(mloc, __shfl_xor(mloc, 32));
    const float mnew = fmaxf(mrun, mloc);
    if (__builtin_amdgcn_ballot_w64(mnew > mrun) != 0) {
      const float alpha = __builtin_amdgcn_exp2f(mrun - mnew);
      lrun *= alpha;
#pragma unroll
      for (int i = 0; i < NDB; ++i)
#pragma unroll
        for (int e = 0; e < 16; ++e) O[i][e] *= alpha;
    }
    mrun = mnew;
    float ps = 0.f;
#pragma unroll
    for (int kb = 0; kb < 2; ++kb)
#pragma unroll
      for (int e = 0; e < 16; ++e) { const float pv = __builtin_amdgcn_exp2f(S[kb][e] - mnew); S[kb][e] = pv; ps += pv; }
    lrun += ps;
    bf16x8 pf[4];
#pragma unroll
    for (int jj = 0; jj < 4; ++jj) {
      const int kb = jj >> 1, o8 = (jj & 1) * 8;
      uint4 w;
      w.x = pack2(S[kb][o8 + 0], S[kb][o8 + 1]); w.y = pack2(S[kb][o8 + 2], S[kb][o8 + 3]);
      w.z = pack2(S[kb][o8 + 4], S[kb][o8 + 5]); w.w = pack2(S[kb][o8 + 6], S[kb][o8 + 7]);
      pf[jj] = __builtin_bit_cast(bf16x8, w);
    }
    __builtin_amdgcn_sched_barrier(0);
#pragma unroll
    for (int i = 0; i < NDB; ++i) {
#pragma unroll
      for (int jj = 0; jj < 4; ++jj) {
        const bf16x8 vf = *(const bf16x8*)(fv + cur + i * 32 * LROW + jj * 32);
        O[i] = MFMA(vf, pf[jj], O[i]);
      }
      if (i & 1) __builtin_amdgcn_sched_barrier(0);
    }
    ATT_SSTORE(KVBUF - cur);
    __syncthreads();
  }
#undef ATT_GLOAD
#undef ATT_SSTORE
  const float ltot = lrun + __shfl_xor(lrun, 32);
  const float inv = 1.0f / ltot;
  u16* op = out + (size_t)(wave * 32 + r) * ldo;
#pragma unroll
  for (int i = 0; i < NDB; ++i)
#pragma unroll
    for (int qd = 0; qd < 4; ++qd) {
      uint2 w;
      w.x = pack2(O[i][4 * qd] * inv, O[i][4 * qd + 1] * inv);
      w.y = pack2(O[i][4 * qd + 2] * inv, O[i][4 * qd + 3] * inv);
      *(uint2*)(op + i * 32 + 8 * qd + 4 * h) = w;
    }
}

DI void attn_diff_pair(const u16* Q, const u16* Kb, const u16* Vt, int ldv, int nt, float lam, const float* subln_g, u16* out, char* shm, int half) {
  constexpr int STG = (64 + 64 + 128) * LROW;
  const int tid = TIDX, t512 = (int)threadIdx.x, lane = tid & 63, wave = tid >> 6;
  const int r = lane & 31, h = lane >> 5;
  bf16x8 qf[4];
#pragma unroll
  for (int ks = 0; ks < 4; ++ks) qf[ks] = *(const bf16x8*)(Q + (size_t)(wave * 32 + r) * 64 + ks * 16 + h * 8);
  f32x16 O[4];
#pragma unroll
  for (int i = 0; i < 4; ++i)
#pragma unroll
    for (int e = 0; e < 16; ++e) O[i][e] = 0.f;
  float mrun = -1e30f, lrun = 0.f;
  const int lrow = tid >> 3, lpart = (tid & 7) * 8;
  const int vrow = t512 >> 3, vpart = (t512 & 7) * 8;
  const u16* gk = Kb + (size_t)lrow * 64 + lpart;
  const u16* gv = Vt + (size_t)vrow * ldv + vpart;
  char* sk = shm + half * 64 * LROW + lrow * LROW + lpart * 2;
  char* sv = shm + 128 * LROW + vrow * LROW + vpart * 2;
  u32x4 rk0, rk1, rv0, rv1;
#define AD_GLOAD(key0_) do { rk0 = *(const u32x4*)(gk + (size_t)(key0_) * 64); rk1 = *(const u32x4*)(gk + (size_t)((key0_) + 32) * 64); \
                             rv0 = *(const u32x4*)(gv + (key0_)); rv1 = *(const u32x4*)(gv + (size_t)64 * ldv + (key0_)); } while (0)
#define AD_SSTORE(boff_) do { *(u32x4*)(sk + (boff_)) = rk0; *(u32x4*)(sk + (boff_) + 32 * LROW) = rk1; \
                              *(u32x4*)(sv + (boff_)) = rv0; *(u32x4*)(sv + (boff_) + 64 * LROW) = rv1; } while (0)
#define AD_GLOAD_K(key0_) do { rk0 = *(const u32x4*)(gk + (size_t)(key0_) * 64); rk1 = *(const u32x4*)(gk + (size_t)((key0_) + 32) * 64); } while (0)
#define AD_GLOAD_V(key0_) do { rv0 = *(const u32x4*)(gv + (key0_)); rv1 = *(const u32x4*)(gv + (size_t)64 * ldv + (key0_)); } while (0)
#define AD_SSTORE_K(boff_) do { *(u32x4*)(sk + (boff_)) = rk0; *(u32x4*)(sk + (boff_) + 32 * LROW) = rk1; } while (0)
#define AD_SSTORE_V(boff_) do { *(u32x4*)(sv + (boff_)) = rv0; *(u32x4*)(sv + (boff_) + 64 * LROW) = rv1; } while (0)
#define AD_QK(S_, koff_) do { _Pragma("unroll") for (int kb = 0; kb < 2; ++kb) { _Pragma("unroll") for (int e = 0; e < 16; ++e) S_[kb][e] = 0.f; \
    _Pragma("unroll") for (int ks = 0; ks < 4; ++ks) { const bf16x8 kf = *(const bf16x8*)(fk + (koff_) + kb * 32 * LROW + ks * 32); S_[kb] = MFMA(kf, qf[ks], S_[kb]); } } } while (0)
  const int pr = (r & 0x13) | ((r & 4) << 1) | ((r & 8) >> 1);
  const char* fk = shm + half * 64 * LROW + pr * LROW + h * 16;
  const char* fv = shm + 128 * LROW + r * LROW + h * 16;
  AD_GLOAD_K(0); AD_GLOAD_V(0);
  AD_SSTORE_K(0); AD_SSTORE_V(0);
  AD_GLOAD_K(64);
  AD_SSTORE_K(STG);
  __syncthreads();
  f32x16 S[2], Sn[2];
  AD_QK(S, 0);
  for (int t = 0; t < nt; ++t) {
    const int cur = (t & 1) * STG;
    { const int tk = (t + 2 < nt) ? t + 2 : nt - 1, tv = (t + 1 < nt) ? t + 1 : nt - 1; AD_GLOAD_K(tk * 64); AD_GLOAD_V(tv * 64); }
    AD_QK(Sn, STG - cur);
    __builtin_amdgcn_sched_barrier(0);
    float mloc = S[0][0];
#pragma unroll
    for (int kb = 0; kb < 2; ++kb)
#pragma unroll
      for (int e = 0; e < 16; ++e) mloc = fmaxf(mloc, S[kb][e]);
    mloc = fmaxf(mloc, __shfl_xor(mloc, 32));
    const float mnew = fmaxf(mrun, mloc);
    if (__builtin_amdgcn_ballot_w64(mnew > mrun) != 0) {
      const float alpha = __builtin_amdgcn_exp2f(mrun - mnew);
      lrun *= alpha;
#pragma unroll
      for (int i = 0; i < 4; ++i)
#pragma unroll
        for (int e = 0; e < 16; ++e) O[i][e] *= alpha;
    }
    mrun = mnew;
    float ps = 0.f;
#pragma unroll
    for (int kb = 0; kb < 2; ++kb)
#pragma unroll
      for (int e = 0; e < 16; ++e) { const float pv = __builtin_amdgcn_exp2f(S[kb][e] - mnew); S[kb][e] = pv; ps += pv; }
    lrun += ps;
    bf16x8 pf[4];
#pragma unroll
    for (int jj = 0; jj < 4; ++jj) {
      const int kb = jj >> 1, o8 = (jj & 1) * 8;
      uint4 w;
      w.x = pack2(S[kb][o8 + 0], S[kb][o8 + 1]); w.y = pack2(S[kb][o8 + 2], S[kb][o8 + 3]);
      w.z = pack2(S[kb][o8 + 4], S[kb][o8 + 5]); w.w = pack2(S[kb][o8 + 6], S[kb][o8 + 7]);
      pf[jj] = __builtin_bit_cast(bf16x8, w);
    }
#pragma unroll
    for (int i = 0; i < 4; ++i) {
#pragma unroll
      for (int jj = 0; jj < 4; ++jj) {
        const bf16x8 vf = *(const bf16x8*)(fv + cur + i * 32 * LROW + jj * 32);
        O[i] = MFMA(vf, pf[jj], O[i]);
      }
    }
    AD_SSTORE_K(cur);
    AD_SSTORE_V(STG - cur);
    __syncthreads();
    S[0] = Sn[0]; S[1] = Sn[1];
  }
#undef AD_GLOAD_K
#undef AD_GLOAD_V
#undef AD_SSTORE_K
#undef AD_SSTORE_V
#undef AD_QK
#undef AD_GLOAD
#undef AD_SSTORE
  const float inv = 1.0f / (lrun + __shfl_xor(lrun, 32));
  float* ex = (float*)shm + (size_t)wave * 4096 + lane;
  if (half == 1) {
#pragma unroll
    for (int i = 0; i < 4; ++i)
#pragma unroll
      for (int e = 0; e < 16; ++e) ex[(i * 16 + e) * 64] = O[i][e] * inv;
  }
  __syncthreads();
  if (half == 0) {
    float ss = 0.f;
#pragma unroll
    for (int i = 0; i < 4; ++i)
#pragma unroll
      for (int e = 0; e < 16; ++e) { const float d = O[i][e] * inv - lam * ex[(i * 16 + e) * 64]; O[i][e] = d; ss += d * d; }
    ss += __shfl_xor(ss, 32);
    const float rinv = rsqrtf(ss * (1.0f / 128.0f) + EPS) * (1.0f - LAM_INIT);
    u16* op = out + (size_t)(wave * 32 + r) * 1024;
#pragma unroll
    for (int i = 0; i < 4; ++i)
#pragma unroll
      for (int qd = 0; qd < 4; ++qd) {
        const int e0 = i * 32 + 8 * qd + 4 * h;
        const float4 g = *(const float4*)(subln_g + e0);
        uint2 w;
        w.x = pack2(O[i][4 * qd] * rinv * g.x, O[i][4 * qd + 1] * rinv * g.y);
        w.y = pack2(O[i][4 * qd + 2] * rinv * g.z, O[i][4 * qd + 3] * rinv * g.w);
        *(uint2*)(op + e0) = w;
      }
  }
  __syncthreads();
}

DI void attention_phase(const Params& p, int vb0, int half, char* shm) {
  const u16* CQ = (const u16*)(p.ws + OFF_CQ); const u16* DQ = (const u16*)(p.ws + OFF_DQ);
  const u16* CKP = (const u16*)(p.ws + OFF_CKP); const u16* CKS = (const u16*)(p.ws + OFF_CKS);
  const u16* CVTP = (const u16*)(p.ws + OFF_CVTP); const u16* CVTS = (const u16*)(p.ws + OFF_CVTS);
  const u16* DKP = (const u16*)(p.ws + OFF_DKP); const u16* DKS = (const u16*)(p.ws + OFF_DKS);
  const u16* DVTP = (const u16*)(p.ws + OFF_DVTP); const u16* DVTS = (const u16*)(p.ws + OFF_DVTS);
  u16* AC = (u16*)(p.ws + OFF_H);
  constexpr size_t QS = (size_t)16 * 8 * 256 * 64;
  const int lane = TIDX & 63;
  const float la = wave_sum(p.in[20][lane] * p.in[21][lane]);
  const float lb = wave_sum(p.in[22][lane] * p.in[23][lane]);
  const float lam = expf(la) - expf(lb) + LAM_INIT;
  const int nblk = (int)gridDim.x;
  for (int it = vb0; it < 768; it += nblk) {
    const bool diff = (it < 256) || (it >= 512 && it < 640);
    const bool samp = it < 512;
    if (diff) {
      int qb, hh, b;
      if (samp) { qb = it & 31; hh = (it >> 5) & 3; b = it >> 7; }
      else { const int i2 = it - 512; qb = i2 & 1; hh = (i2 >> 1) & 3; b = i2 >> 3; }
      const int nseq = samp ? 4096 : 256, nkeys = samp ? 4608 : 256;
      const int tok = samp ? 4096 + b * 4096 + qb * 128 : b * 256 + qb * 128;
      const int hm = hh * 2 + half;
      const size_t qoff = (samp ? QS : 0) + ((size_t)(b * 8 + hm) * nseq + qb * 128) * 64;
      const u16* Kp = (samp ? CKS : CKP) + (size_t)(b * 8 + hm) * nkeys * 64;
      const u16* Vp = (samp ? CVTS : CVTP) + (size_t)(b * 4 + hh) * 128 * nkeys;
      attn_diff_pair(CQ + qoff, Kp, Vp, nkeys, nkeys >> 6, lam, p.in[24], AC + (size_t)tok * 1024 + hh * 128, shm, half);
    } else {
      int qb, hd, b;
      if (samp) { const int i2 = (it - 256) * 2 + half; qb = i2 & 31; hd = (i2 >> 5) & 7; b = i2 >> 8; }
      else { const int i2 = (it - 640) * 2 + half; qb = i2 & 1; hd = (i2 >> 1) & 7; b = i2 >> 4; }
      const int nseq = samp ? 4096 : 256, nkeys = samp ? 4608 : 256;
      const int tok = samp ? 4096 + b * 4096 + qb * 128 : b * 256 + qb * 128;
      const size_t qoff = (samp ? QS : 0) + ((size_t)(b * 8 + hd) * nseq + qb * 128) * 64;
      const u16* Kp = (samp ? DKS : DKP) + (size_t)(b * 2 + (hd >> 2)) * nkeys * 64;
      const u16* Vp = (samp ? DVTS : DVTP) + (size_t)(b * 2 + (hd >> 2)) * 64 * nkeys;
      int nt0 = 4, key1 = 0, nt1 = 0;
      if (samp) { const int lo = min(max(qb * 128 - 128, 0), 4096 - 384); nt0 = 8; key1 = 512 + lo; nt1 = 6; }
      attn_item<64>(DQ + qoff, Kp, Vp, nkeys, nt0, key1, nt1, samp, qb * 128, true, p.in[27][hd] * LOG2E, AC + (size_t)tok * 1024 + 512 + hd * 64, 1024, shm + half * LDS_BYTES);
    }
  }
}

namespace pg8 {
#define PG8_LAS __attribute__((address_space(3)))
typedef unsigned short bf16_t;
typedef short bf16x8 __attribute__((ext_vector_type(8)));
typedef float f32x4 __attribute__((ext_vector_type(4)));
typedef unsigned u32x4 __attribute__((ext_vector_type(4)));
constexpr int BM = 256, BK = 64, HALF = 128, HTB = HALF * BK * 2  , STAGE_BYTES = 8 * HTB, NXCD = 8, WGM = 8;

__host__ __device__ __forceinline__ int lds_byte(int r, int c) { const int st = (r >> 4) * 2 + (c >> 5), rr = r & 15, cc = c & 31, ob = rr * 64 + cc * 2; return st * 1024 + (ob ^ (((ob >> 9) & 1) << 5)); }
__host__ __device__ __forceinline__ void stage_rc(int b, int& R, int& C) { const int st = b / 1024, sb = b % 1024, swz = sb ^ (((sb >> 9) & 1) << 5); R = (st >> 1) * 16 + swz / 64; C = (st & 1) * 32 + (swz % 64) / 2; }
__host__ __device__ __forceinline__ int perm32(int rho) { const int n = rho >> 4, i = rho & 15; return 8 * (i >> 2) + 4 * n + (i & 3); }

struct Unit { int pm, pn; };
struct Gemm { const bf16_t* A; const bf16_t* Bt; int M, N, K; };

struct StaticOrder {
    int nM, nN, nwg, G, c;
    __host__ __device__ void init(int M, int N, int G_, int c_) { nM = M / BM; nN = N / BM; nwg = nM * nN; G = G_; c = c_; }
    __host__ __device__ bool next(int i, Unit& u) const {
        const long L = (long)i * G + c; if (L >= nwg) return false;
        int wgid = (int)L; { const int q = nwg / NXCD, r = nwg % NXCD, xcd = wgid % NXCD, off = wgid / NXCD; wgid = (xcd < r ? xcd * (q + 1) : r * (q + 1) + (xcd - r) * q) + off; }
        const int nig = WGM * nN, gid = wgid / nig, fm = gid * WGM, gsz = (nM - fm) < WGM ? (nM - fm) : WGM;
        u.pm = fm + ((wgid % nig) % gsz); u.pn = (wgid % nig) / gsz; return true;
    }
    __device__ __forceinline__ void a_ready(const Unit&) const {}
    __device__ __forceinline__ void done(const Unit&) const {}
};
template <class Epi, class Sched, bool STAMP = false, int MB = 4>
__device__ __forceinline__ void gemm_phase(PG8_LAS unsigned char* lds, const Gemm g, const Sched& S, const Epi& E, unsigned long long* stamps) {
    const int tid = threadIdx.x, wid = __builtin_amdgcn_readfirstlane(tid >> 6), lane = tid & 63, wr = wid >> 2, wc = wid & 3, fr = lane & 15, fq = lane >> 4;
    const int K = g.K, nt = K / BK;
    int ts_lo = 0, ts_hi = 0, nts = 0; const unsigned long long rt_entry = STAMP ? (unsigned long long)wall_clock64() : 0ull;
#define PG8_STAMP() do { if (STAMP && wid == 0 && nts < 64) { const unsigned long long _c = (unsigned long long)clock64(); \
        ts_lo = (lane == nts) ? (int)(unsigned)_c : ts_lo; ts_hi = (lane == nts) ? (int)(unsigned)(_c >> 32) : ts_hi; ++nts; } } while (0)
    PG8_STAMP();
    unsigned voffA[2], voffB[2];
#pragma unroll
    for (int i = 0; i < 2; ++i) { int R, C; stage_rc(tid * 16 + i * 8192, R, C); const int Rb = Epi::PERM ? ((R & ~31) + perm32(R & 31)) : R;
        voffA[i] = (unsigned)(R * K + C) * 2u; voffB[i] = (unsigned)(Rb * K + C) * 2u; }
    const size_t kstep = (size_t)(BK * 2);
    const size_t hstep = (size_t)HALF * K * 2; const size_t hstepA = (size_t)(32 * MB) * K * 2;
    const size_t tstep = 2 * hstep; const size_t tstepA = 2 * hstepA;
    const unsigned ldsw = (unsigned)wid * 1024u;
    const int aoff = lds_byte(wr * 16 * MB + fr, fq * 8), boff = lds_byte(wc * 32 + fr, fq * 8);
#define PG8_SA(b, h) (((b) * 2 + (h)) * HTB)
#define PG8_SB(b, h) ((4 + (b) * 2 + (h)) * HTB)
#define PG8_STAGE(bufoff, gbase, voff) do { _Pragma("unroll") for (int _i = 0; _i < 2; ++_i) \
        __builtin_amdgcn_global_load_lds((const unsigned*)((const char*)(gbase) + (voff)[_i]), (PG8_LAS unsigned*)(lds + (bufoff) + ldsw + _i * 8192), 16, 0, 0); } while (0)
#define PG8_LDA(dst, b, h) do { _Pragma("unroll") for (int m = 0; m < MB; ++m) _Pragma("unroll") for (int k = 0; k < 2; ++k) dst[m][k] = *(const PG8_LAS bf16x8*)(lds + PG8_SA(b, h) + aoff + m * 2048 + k * 1024); } while (0)
#define PG8_LDB(dst, b, h) do { _Pragma("unroll") for (int n = 0; n < 2; ++n) _Pragma("unroll") for (int k = 0; k < 2; ++k) dst[n][k] = *(const PG8_LAS bf16x8*)(lds + PG8_SB(b, h) + boff + n * 2048 + k * 1024); } while (0)
#define PG8_MMA(ai, bj, At, Bt) do { __builtin_amdgcn_s_setprio(1); _Pragma("unroll") for (int m = 0; m < MB; ++m) _Pragma("unroll") for (int n = 0; n < 2; ++n) _Pragma("unroll") for (int k = 0; k < 2; ++k) \
        acc[ai][bj][m][n] = __builtin_amdgcn_mfma_f32_16x16x32_bf16(Bt[n][k], At[m][k], acc[ai][bj][m][n], 0, 0, 0); __builtin_amdgcn_s_setprio(0); } while (0)
#define PG8_WAIT_V(n) asm volatile("s_waitcnt vmcnt(" #n ")" ::: "memory")
#define PG8_WAIT_L(n) asm volatile("s_waitcnt lgkmcnt(" #n ")" ::: "memory")
#define PG8_BAR __builtin_amdgcn_s_barrier()
#define PG8_SCHED __builtin_amdgcn_sched_barrier(0)
    Unit cur, nxt; int ui = 0;
    if (!S.next(0, cur)) return;
    f32x4 acc[2][2][MB][2];
#pragma unroll
    for (int a = 0; a < 2; ++a)
#pragma unroll
        for (int b = 0; b < 2; ++b)
#pragma unroll
            for (int m = 0; m < MB; ++m)
#pragma unroll
                for (int n = 0; n < 2; ++n) acc[a][b][m][n] = (f32x4){0.f, 0.f, 0.f, 0.f};
    bf16x8 At[MB][2], B0[2][2], B1[2][2];
    const char* cA = (const char*)g.A + (size_t)cur.pm * tstepA; const char* cB = (const char*)g.Bt + (size_t)cur.pn * tstep;
    S.a_ready(cur);
    PG8_STAGE(PG8_SB(0, 0), cB, voffB); PG8_STAGE(PG8_SA(0, 0), cA, voffA); PG8_STAGE(PG8_SB(0, 1), cB + hstep, voffB); PG8_STAGE(PG8_SA(0, 1), cA + hstepA, voffA);
    if (wr == 1) PG8_BAR;
    PG8_WAIT_V(4); PG8_BAR;
    PG8_STAGE(PG8_SB(1, 0), cB + kstep, voffB); PG8_STAGE(PG8_SA(1, 0), cA + kstep, voffA); PG8_STAGE(PG8_SB(1, 1), cB + hstep + kstep, voffB);
    PG8_WAIT_V(6); PG8_BAR;
    PG8_STAMP();
    for (;;) {
        const bool has_next = S.next(ui + 1, nxt);
        const char* nA = has_next ? (const char*)g.A + (size_t)nxt.pm * tstepA : cA; const char* nB = has_next ? (const char*)g.Bt + (size_t)nxt.pn * tstep : cB;
        for (int t = 0; t < nt; t += 2) {
            const bool last = (t == nt - 2);
            const char* a1 = cA + (size_t)(t + 1) * kstep;
            const char* a2 = last ? nA : cA + (size_t)(t + 2) * kstep; const char* b2 = last ? nB : cB + (size_t)(t + 2) * kstep;
            const char* a3 = a2 + kstep; const char* b3 = b2 + kstep;
            if (last && has_next) S.a_ready(nxt);
            PG8_LDB(B0, 0, 0); PG8_SCHED; PG8_LDA(At, 0, 0); PG8_STAGE(PG8_SA(1, 1), a1 + hstepA, voffA);
            PG8_WAIT_L(8); PG8_BAR; PG8_WAIT_L(0); PG8_MMA(0, 0, At, B0); PG8_BAR; PG8_SCHED;
            PG8_LDB(B1, 0, 1); PG8_STAGE(PG8_SB(0, 0), b2, voffB);
            PG8_BAR; PG8_WAIT_L(0); PG8_MMA(0, 1, At, B1); PG8_BAR;
            PG8_LDA(At, 0, 1); PG8_STAGE(PG8_SA(0, 0), a2, voffA);
            PG8_BAR; PG8_WAIT_L(0); PG8_MMA(1, 0, At, B0); PG8_BAR; PG8_SCHED;
            PG8_STAGE(PG8_SB(0, 1), b2 + hstep, voffB);
            PG8_WAIT_V(6); PG8_BAR; PG8_MMA(1, 1, At, B1); PG8_BAR;
            PG8_LDB(B0, 1, 0); PG8_SCHED; PG8_LDA(At, 1, 0); PG8_STAGE(PG8_SA(0, 1), a2 + hstepA, voffA);
            PG8_WAIT_L(8); PG8_BAR; PG8_WAIT_L(0); PG8_MMA(0, 0, At, B0); PG8_BAR; PG8_SCHED;
            PG8_LDB(B1, 1, 1); PG8_STAGE(PG8_SB(1, 0), b3, voffB);
            PG8_BAR; PG8_WAIT_L(0); PG8_MMA(0, 1, At, B1); PG8_BAR;
            PG8_LDA(At, 1, 1); PG8_STAGE(PG8_SA(1, 0), a3, voffA);
            PG8_BAR; PG8_WAIT_L(0); PG8_MMA(1, 0, At, B0); PG8_BAR; PG8_SCHED;
            PG8_STAGE(PG8_SB(1, 1), b3 + hstep, voffB);
            PG8_WAIT_V(6); PG8_BAR; PG8_MMA(1, 1, At, B1); PG8_BAR;
        }
        PG8_STAMP();
        if constexpr (!Epi::AFTER_DRAIN) { E(acc, cur, wr, wc, fr, fq); S.done(cur); }
        PG8_STAMP();
        if (!has_next) break;
#pragma unroll
        for (int a = 0; a < 2; ++a)
#pragma unroll
            for (int b = 0; b < 2; ++b)
#pragma unroll
                for (int m = 0; m < MB; ++m)
#pragma unroll
                    for (int n = 0; n < 2; ++n) acc[a][b][m][n] = (f32x4){0.f, 0.f, 0.f, 0.f};
        cur = nxt; cA = nA; cB = nB; ++ui;
    }
    PG8_WAIT_V(0);
    if (wr == 0) PG8_BAR;
    PG8_BAR;
    if constexpr (Epi::AFTER_DRAIN) { E.fused(acc, cur, wr, wc, fr, fq, lds, wid, lane); S.done(cur); }
    PG8_STAMP();
    if (STAMP && wid == 0) { stamps[lane] = lane < nts ? (((unsigned long long)(unsigned)ts_hi << 32) | (unsigned)ts_lo) : 0ull;
        if (lane == 62) stamps[62] = rt_entry; if (lane == 63) stamps[63] = (unsigned long long)wall_clock64(); }
#undef PG8_STAMP
#undef PG8_SA
#undef PG8_SB
#undef PG8_STAGE
#undef PG8_LDA
#undef PG8_LDB
#undef PG8_MMA
#undef PG8_WAIT_V
#undef PG8_WAIT_L
#undef PG8_BAR
#undef PG8_SCHED
}
}

typedef float f32x4 __attribute__((ext_vector_type(4)));
template <class F, int MB> struct RowEpi {
  static constexpr bool PERM = false, AFTER_DRAIN = false;
  F f;
  DI void operator()(const pg8::f32x4 (&acc)[2][2][MB][2], const pg8::Unit& u, int wr, int wc, int fr, int fq) const {
    const int row0 = u.pm * (64 * MB) + wr * 16 * MB + fr, col0 = u.pn * 256 + wc * 32 + 4 * fq;
#pragma unroll
    for (int ai = 0; ai < 2; ++ai)
#pragma unroll
      for (int m = 0; m < MB; ++m)
#pragma unroll
        for (int bj = 0; bj < 2; ++bj)
#pragma unroll
          for (int n = 0; n < 2; ++n) f(row0 + ai * 32 * MB + m * 16, col0 + bj * 128 + n * 16, acc[ai][bj][m][n]);
  }
};
struct FU {
  u16* UA; u16* PQt;
  DI void operator()(int m, int n, pg8::f32x4 v) const {
    if (n < 512) {
      uint2 w; w.x = pack2(v[0], v[1]); w.y = pack2(v[2], v[3]);
      *(uint2*)(UA + (size_t)m * 512 + n) = w;
    } else {
      const int np = n - 512, g = np >> 8, pq = (np >> 7) & 1, mm = np & 127;
      u16* q; size_t st;
      if (m < 4096) { const int b = m >> 8, nl = m & 255; q = PQt + ((size_t)(b * 512 + g * 128 + mm)) * 512 + pq * 256 + nl; st = 512; }
      else { const int ms = m - 4096, b = ms >> 12, nl = ms & 4095; q = PQt + (size_t)16 * 512 * 512 + ((size_t)(b * 512 + g * 128 + mm)) * 8192 + pq * 4096 + nl; st = 8192; }
      q[0] = f2bf(v[0]); q[st] = f2bf(v[1]); q[2 * st] = f2bf(v[2]); q[3 * st] = f2bf(v[3]);
    }
  }
};
struct FRes {
  const float* xin_p; const float* xin_s; float* X; const float* gate;
  DI void operator()(int m, int n, pg8::f32x4 v) const {
    const float* xi = (m < 4096) ? xin_p + (size_t)m * 1024 + n : xin_s + (size_t)(m - 4096) * 1024 + n;
    const float4 x = *(const float4*)xi;
    const float4 g = *(const float4*)(gate + cond_of(m) * 6144 + n);
    *(float4*)(X + (size_t)m * 1024 + n) = make_float4(x.x + g.x * v[0], x.y + g.y * v[1], x.z + g.z * v[2], x.w + g.w * v[3]);
  }
};
struct FRelu2 {
  u16* C;
  DI void operator()(int m, int n, pg8::f32x4 v) const {
    const float a = fmaxf(v[0], 0.f), b = fmaxf(v[1], 0.f), c = fmaxf(v[2], 0.f), d = fmaxf(v[3], 0.f);
    uint2 w; w.x = pack2(a * a, b * b); w.y = pack2(c * c, d * d);
    *(uint2*)(C + (size_t)m * 4096 + n) = w;
  }
};
struct FQkv {
  u16* QKV; u16* CVtP; u16* CVtS; u16* DVtP; u16* DVtS; float* ncv; float* ndv;
  DI void operator()(int m, int n, pg8::f32x4 v) const {
    const bool is_cv = (n >= 1024 && n < 1536), is_dv = (n >= 2176);
    if (!is_cv && !is_dv) {
      uint2 w; w.x = pack2(v[0], v[1]); w.y = pack2(v[2], v[3]);
      *(uint2*)(QKV + (size_t)m * 2304 + n) = w;
      return;
    }
    const int c = is_cv ? n - 1024 : n - 2176;
    const int feat = is_cv ? 512 : 128;
    u16* q; size_t st;
    if (m < 4096) {
      const int b = m >> 8, nl = m & 255;
      q = (is_cv ? CVtP : DVtP) + ((size_t)(b * feat + c)) * 256 + nl; st = 256;
      *(float4*)((is_cv ? ncv : ndv) + (size_t)m * feat + c) = make_float4(v[0], v[1], v[2], v[3]);
    } else {
      const int ms = m - 4096, b = ms >> 12, nl = ms & 4095;
      q = (is_cv ? CVtS : DVtS) + ((size_t)(b * feat + c)) * 4608 + 512 + nl; st = 4608;
    }
    q[0] = f2bf(v[0]); q[st] = f2bf(v[1]); q[2 * st] = f2bf(v[2]); q[3 * st] = f2bf(v[3]);
  }
};
template <int MB, class F>
DI void big_gemm(PG8_LAS unsigned char* lds, const u16* A, const u16* Bt, int M, int N, int K, F f) {
  pg8::Gemm g{A, Bt, M, N, K};
  pg8::StaticOrder S; S.init(M, N, (int)gridDim.x, (int)blockIdx.x);
  S.nM = M / (64 * MB); S.nwg = S.nM * S.nN;
  RowEpi<F, MB> E{f};
  pg8::gemm_phase<RowEpi<F, MB>, pg8::StaticOrder, false, MB>(lds, g, S, E, nullptr);
}

template <class F, int MB> struct RowEpi8 {
  static constexpr bool PERM = true, AFTER_DRAIN = false;
  F f;
  DI void operator()(const pg8::f32x4 (&acc)[2][2][MB][2], const pg8::Unit& u, int wr, int wc, int fr, int fq) const {
    const int row0 = u.pm * (64 * MB) + wr * 16 * MB + fr, col0 = u.pn * 256 + wc * 32 + 8 * fq;
#pragma unroll
    for (int ai = 0; ai < 2; ++ai)
#pragma unroll
      for (int m = 0; m < MB; ++m)
#pragma unroll
        for (int bj = 0; bj < 2; ++bj) f(row0 + ai * 32 * MB + m * 16, col0 + bj * 128, acc[ai][bj][m][0], acc[ai][bj][m][1]);
  }
};
struct FRelu2x8 {
  u16* C;
  DI void operator()(int m, int n, pg8::f32x4 a, pg8::f32x4 b) const {
    uint4 w;
    float x0 = fmaxf(a[0], 0.f), x1 = fmaxf(a[1], 0.f), x2 = fmaxf(a[2], 0.f), x3 = fmaxf(a[3], 0.f);
    float y0 = fmaxf(b[0], 0.f), y1 = fmaxf(b[1], 0.f), y2 = fmaxf(b[2], 0.f), y3 = fmaxf(b[3], 0.f);
    w.x = pack2(x0 * x0, x1 * x1); w.y = pack2(x2 * x2, x3 * x3); w.z = pack2(y0 * y0, y1 * y1); w.w = pack2(y2 * y2, y3 * y3);
    *(uint4*)(C + (size_t)m * 4096 + n) = w;
  }
};
struct FUx8 {
  u16* UA; u16* PQt;
  DI void operator()(int m, int n, pg8::f32x4 a, pg8::f32x4 b) const {
    if (n < 512) {
      uint4 w; w.x = pack2(a[0], a[1]); w.y = pack2(a[2], a[3]); w.z = pack2(b[0], b[1]); w.w = pack2(b[2], b[3]);
      *(uint4*)(UA + (size_t)m * 512 + n) = w;
    } else {
      const int np = n - 512, g = np >> 8, pq = (np >> 7) & 1, mm = np & 127;
      u16* q; size_t st;
      if (m < 4096) { const int bb = m >> 8, nl = m & 255; q = PQt + ((size_t)(bb * 512 + g * 128 + mm)) * 512 + pq * 256 + nl; st = 512; }
      else { const int ms = m - 4096, bb = ms >> 12, nl = ms & 4095; q = PQt + (size_t)16 * 512 * 512 + ((size_t)(bb * 512 + g * 128 + mm)) * 8192 + pq * 4096 + nl; st = 8192; }
      q[0] = f2bf(a[0]); q[st] = f2bf(a[1]); q[2 * st] = f2bf(a[2]); q[3 * st] = f2bf(a[3]);
      q[4 * st] = f2bf(b[0]); q[5 * st] = f2bf(b[1]); q[6 * st] = f2bf(b[2]); q[7 * st] = f2bf(b[3]);
    }
  }
};
struct FQkvx8 {
  u16* QKV; u16* CVtP; u16* CVtS; u16* DVtP; u16* DVtS; float* ncv; float* ndv;
  DI void operator()(int m, int n, pg8::f32x4 a, pg8::f32x4 b) const {
    const bool is_cv = (n >= 1024 && n < 1536), is_dv = (n >= 2176);
    if (!is_cv && !is_dv) {
      uint4 w; w.x = pack2(a[0], a[1]); w.y = pack2(a[2], a[3]); w.z = pack2(b[0], b[1]); w.w = pack2(b[2], b[3]);
      *(uint4*)(QKV + (size_t)m * 2304 + n) = w;
      return;
    }
    const int c = is_cv ? n - 1024 : n - 2176;
    const int feat = is_cv ? 512 : 128;
    u16* q; size_t st;
    if (m < 4096) {
      const int bb = m >> 8, nl = m & 255;
      q = (is_cv ? CVtP : DVtP) + ((size_t)(bb * feat + c)) * 256 + nl; st = 256;
      float* o = (is_cv ? ncv : ndv) + (size_t)m * feat + c;
      *(float4*)o = make_float4(a[0], a[1], a[2], a[3]);
      *(float4*)(o + 4) = make_float4(b[0], b[1], b[2], b[3]);
    } else {
      const int ms = m - 4096, bb = ms >> 12, nl = ms & 4095;
      q = (is_cv ? CVtS : DVtS) + ((size_t)(bb * feat + c)) * 4608 + 512 + nl; st = 4608;
    }
    q[0] = f2bf(a[0]); q[st] = f2bf(a[1]); q[2 * st] = f2bf(a[2]); q[3 * st] = f2bf(a[3]);
    q[4 * st] = f2bf(b[0]); q[5 * st] = f2bf(b[1]); q[6 * st] = f2bf(b[2]); q[7 * st] = f2bf(b[3]);
  }
};
template <int MB, class F>
DI void big_gemm8(PG8_LAS unsigned char* lds, const u16* A, const u16* Bt, int M, int N, int K, F f) {
  pg8::Gemm g{A, Bt, M, N, K};
  pg8::StaticOrder S; S.init(M, N, (int)gridDim.x, (int)blockIdx.x);
  S.nM = M / (64 * MB); S.nwg = S.nM * S.nN;
  RowEpi8<F, MB> E{f};
  pg8::gemm_phase<RowEpi8<F, MB>, pg8::StaticOrder, false, MB>(lds, g, S, E, nullptr);
}

template <int MB> struct ResNormEpi {
  static constexpr bool PERM = false, AFTER_DRAIN = true;
  const float* xin_p; const float* xin_s; float* X; const float* gate;
  const float* gain; const float* nmods; u16* Hout; float* part; unsigned* cnt;
  DI void operator()(const pg8::f32x4 (&)[2][2][MB][2], const pg8::Unit&, int, int, int, int) const {}
  DI void fused(pg8::f32x4 (&acc)[2][2][MB][2], const pg8::Unit& u, int wr, int wc, int fr, int fq, PG8_LAS unsigned char* lds, int wid, int lane) const {
    constexpr int ROWS = 64 * MB;
    const int tid = (int)threadIdx.x;
    const int rbase = u.pm * ROWS;
    const int row0 = rbase + wr * 16 * MB + fr, col0 = u.pn * 256 + wc * 32 + 4 * fq;
    PG8_LAS float* red = (PG8_LAS float*)lds;
    PG8_LAS float* rinvs = red + ROWS * 4;
#pragma unroll
    for (int ai = 0; ai < 2; ++ai)
#pragma unroll
      for (int m = 0; m < MB; ++m) {
        const int row = row0 + ai * 32 * MB + m * 16;
        const float* xi = (row < 4096) ? xin_p + (size_t)row * 1024 : xin_s + (size_t)(row - 4096) * 1024;
        const float* gp = gate + cond_of(row) * 6144;
        float ss = 0.f;
#pragma unroll
        for (int bj = 0; bj < 2; ++bj)
#pragma unroll
          for (int n = 0; n < 2; ++n) {
            const int col = col0 + bj * 128 + n * 16;
            const float4 x = *(const float4*)(xi + col);
            const float4 g = *(const float4*)(gp + col);
            pg8::f32x4 v = acc[ai][bj][m][n];
            v[0] = x.x + g.x * v[0]; v[1] = x.y + g.y * v[1]; v[2] = x.z + g.z * v[2]; v[3] = x.w + g.w * v[3];
            *(float4*)(X + (size_t)row * 1024 + col) = make_float4(v[0], v[1], v[2], v[3]);
            acc[ai][bj][m][n] = v;
            ss += v[0] * v[0] + v[1] * v[1] + v[2] * v[2] + v[3] * v[3];
          }
        ss += __shfl_xor(ss, 16); ss += __shfl_xor(ss, 32);
        if (fq == 0) red[(row - rbase) * 4 + wc] = ss;
      }
    __syncthreads();
    if (tid < ROWS) {
      const float sum = (red[tid * 4] + red[tid * 4 + 1]) + (red[tid * 4 + 2] + red[tid * 4 + 3]);
      __hip_atomic_store(part + (size_t)u.pn * T + rbase + tid, sum, __ATOMIC_RELAXED, __HIP_MEMORY_SCOPE_AGENT);
    }
    asm volatile("s_waitcnt vmcnt(0)" ::: "memory");
    __syncthreads();
    if (tid == 0) {
      unsigned* c = cnt + (size_t)u.pm * 16;
      __hip_atomic_fetch_add(c, 1u, __ATOMIC_RELAXED, __HIP_MEMORY_SCOPE_AGENT);
      unsigned sp = 0;
      while (__hip_atomic_load(c, __ATOMIC_RELAXED, __HIP_MEMORY_SCOPE_AGENT) < 4u) { __builtin_amdgcn_s_sleep(1); if (++sp > (1u << 22)) break; }
      __builtin_amdgcn_fence(__ATOMIC_ACQUIRE, "agent");
      asm volatile("s_waitcnt vmcnt(0)" ::: "memory");
    }
    __syncthreads();
    if (tid < ROWS) {
      const float* pp = part + rbase + tid;
      const float tot = (__hip_atomic_load(pp, __ATOMIC_RELAXED, __HIP_MEMORY_SCOPE_AGENT) + __hip_atomic_load(pp + T, __ATOMIC_RELAXED, __HIP_MEMORY_SCOPE_AGENT)) +
                        (__hip_atomic_load(pp + 2 * T, __ATOMIC_RELAXED, __HIP_MEMORY_SCOPE_AGENT) + __hip_atomic_load(pp + 3 * T, __ATOMIC_RELAXED, __HIP_MEMORY_SCOPE_AGENT));
      rinvs[tid] = rsqrtf(tot * (1.0f / 1024.0f) + EPS);
    }
    __syncthreads();
#pragma unroll
    for (int ai = 0; ai < 2; ++ai)
#pragma unroll
      for (int m = 0; m < MB; ++m) {
        const int row = row0 + ai * 32 * MB + m * 16;
        const float rv = rinvs[row - rbase];
        const float* md = nmods + cond_of(row) * 6144;
#pragma unroll
        for (int bj = 0; bj < 2; ++bj)
#pragma unroll
          for (int n = 0; n < 2; ++n) {
            const int col = col0 + bj * 128 + n * 16;
            const float4 g = *(const float4*)(gain + col);
            const float4 sh = *(const float4*)(md + col);
            const float4 sc = *(const float4*)(md + 1024 + col);
            const pg8::f32x4 v = acc[ai][bj][m][n];
            uint2 w;
            w.x = pack2(v[0] * rv * g.x * (1.f + sc.x) + sh.x, v[1] * rv * g.y * (1.f + sc.y) + sh.y);
            w.y = pack2(v[2] * rv * g.z * (1.f + sc.z) + sh.z, v[3] * rv * g.w * (1.f + sc.w) + sh.w);
            *(uint2*)(Hout + (size_t)row * 1024 + col) = w;
          }
      }
    __syncthreads();
  }
};
template <int MB>
DI void big_gemm_resnorm(PG8_LAS unsigned char* lds, const u16* A, const u16* Bt, int M, int N, int K, ResNormEpi<MB> E) {
  pg8::Gemm g{A, Bt, M, N, K};
  pg8::StaticOrder S; S.init(M, N, (int)gridDim.x, (int)blockIdx.x);
  S.nM = M / (64 * MB); S.nwg = S.nM * S.nN;
  pg8::gemm_phase<ResNormEpi<MB>, pg8::StaticOrder, false, MB>(lds, g, S, E, nullptr);
}

#define XB_TMO      128
#define XB_XCNT(j)  (256  + 64 * (j))
#define XB_XSUB(j)  (1280 + 64 * (j))
#define XB_XGEN(j)  (2304 + 64 * (j))
#define XB_TOP      3328
#define XB_TOPGEN   3392
#define XCD_BAR_WORDS 3456
#define XB_SPIN_CAP (1u << 18)
#define LAS __attribute__((address_space(3)))
DI unsigned xb_ld(unsigned* p)              { return __hip_atomic_load(p, __ATOMIC_RELAXED, __HIP_MEMORY_SCOPE_AGENT); }
DI unsigned xb_add(unsigned* p, unsigned v) { return __hip_atomic_fetch_add(p, v, __ATOMIC_RELAXED, __HIP_MEMORY_SCOPE_AGENT); }
DI unsigned xb_xcc_id() { return (unsigned)__builtin_amdgcn_s_getreg((3 << 11) | 20) & 0xFu; }
#define XB_SPIN(cond, bar) do { unsigned _sp = 0; while (cond) { __builtin_amdgcn_s_sleep(1); \
    if ((++_sp & 255u) == 0u) { if (xb_ld(&(bar)[XB_TMO])) break; if (_sp > XB_SPIN_CAP) { atomicAdd(&(bar)[XB_TMO], 1u); break; } } } } while (0)
struct XcdBarrier { unsigned* bar; unsigned x; volatile LAS unsigned* st; };
DI XcdBarrier xcd_barrier_post(unsigned* bar, volatile LAS unsigned* st) {
  XcdBarrier b; b.bar = bar; b.x = xb_xcc_id(); b.st = st;
  if (threadIdx.x == 0) (void)xb_add(&bar[XB_XCNT(b.x)], 1u);
  return b;
}
DI void xcd_barrier_complete(unsigned* bar, unsigned x, unsigned& nloc, unsigned& nx) {
  const unsigned G = gridDim.x;
  unsigned sum, cnt, mine, sp = 0u;
  for (;;) {
    sum = 0u; cnt = 0u; mine = 0u;
#pragma unroll
    for (unsigned j = 0; j < 16; ++j) { const unsigned c = xb_ld(&bar[XB_XCNT(j)]); sum += c; cnt += (c > 0u) ? 1u : 0u; mine = (j == x) ? c : mine; }
    if (sum == G) break;
    __builtin_amdgcn_s_sleep(1);
    if ((++sp & 255u) == 0u) { if (xb_ld(&bar[XB_TMO])) break; if (sp > XB_SPIN_CAP) { atomicAdd(&bar[XB_TMO], 1u); break; } }
  }
  nloc = mine > 0u ? mine : 1u; nx = cnt > 0u ? cnt : 1u;
}
DI void xcd_barrier(const XcdBarrier& b) {
  asm volatile("s_waitcnt vmcnt(0)" ::: "memory");
  __syncthreads();
  if (threadIdx.x == 0) {
    unsigned* bar = b.bar;
    __builtin_amdgcn_s_waitcnt(0);
    unsigned nloc = b.st[0], nx = b.st[1];
    if (nloc == 0u) { xcd_barrier_complete(bar, b.x, nloc, nx); b.st[0] = nloc; b.st[1] = nx; }
    const unsigned old = xb_add(&bar[XB_XSUB(b.x)], 1u);
    const unsigned gen = old / nloc;
    if (old + 1u == (gen + 1u) * nloc) {
      __builtin_amdgcn_fence(__ATOMIC_RELEASE, "agent");
      asm volatile("s_waitcnt vmcnt(0)" ::: "memory");
      const unsigned og = xb_add(&bar[XB_TOP], 1u);
      const unsigned tg = og / nx;
      if (og + 1u == (tg + 1u) * nx) xb_add(&bar[XB_TOPGEN], 1u);
      else XB_SPIN(xb_ld(&bar[XB_TOPGEN]) == tg, bar);
      __builtin_amdgcn_fence(__ATOMIC_ACQUIRE, "agent");
      xb_add(&bar[XB_XGEN(b.x)], 1u);
      asm volatile("s_waitcnt vmcnt(0)" ::: "memory");
    } else {
      XB_SPIN(xb_ld(&bar[XB_XGEN(b.x)]) == gen, bar);
      __builtin_amdgcn_fence(__ATOMIC_ACQUIRE, "agent");
      asm volatile("s_waitcnt vmcnt(0)" ::: "memory");
    }
  }
  __syncthreads();
}

__global__ void __launch_bounds__(512) fwd_kernel(Params p, int ph_lo, int ph_hi, int dup) {
  extern __shared__ __attribute__((aligned(16))) unsigned char shm[];
  const int half = threadIdx.x >> 8;
  char* lds = (char*)shm + half * LDS_BYTES;
  PG8_LAS unsigned char* lds8 = (PG8_LAS unsigned char*)shm;
  const int G = 2 * (int)gridDim.x;
  int vb0 = blockIdx.x;
  if ((gridDim.x & 7) == 0) vb0 = (blockIdx.x & 7) * (gridDim.x >> 3) + (blockIdx.x >> 3);
  const int vb = 2 * vb0 + half;
  unsigned char* ws = p.ws;
  const float* mods = (const float*)(ws + OFF_MODS);
  float* X = p.out + OUT_Y;
  u16* H = (u16*)(ws + OFF_H);

#define RUNPH(n) ((ONLYPH < 0 || ONLYPH == (n)) && ph_lo <= (n) && (n) < ph_hi)
#define REP(n) _Pragma("unroll 1") for (int rep_ = 0; rep_ < ((DUPPH == (n)) ? ((dup == (n)) ? 2 : 1) : 1); ++rep_)
#define SEAM(n) if (ph_lo < (n) && (n) < ph_hi) xcd_barrier(xb);
  __shared__ uint4 xb_words;
  if (threadIdx.x == 0) xb_words = make_uint4(0u, 0u, 0u, 0u);
  __syncthreads();
  XcdBarrier xb = xcd_barrier_post((unsigned*)(ws + OFF_BAR), (volatile LAS unsigned*)&xb_words);
  if (ph_hi > 1000) cg::this_grid().sync();
  if (RUNPH(0)) REP(0) {
    for (int id = vb; id < 384; id += G) ada_item(p, id, lds);
    prep_transposes(p, vb, G, lds, 0);
    prep_elementwise(p, vb, G);
  }
  SEAM(1)
  if (RUNPH(1)) REP(1) {
    for (int t = vb; t < 128; t += G) {
      const bool f1 = t < 64;
      const int q = t & 63, m0 = (q >> 3) << 7, n0 = (q & 7) << 7;
      const int koff = f1 ? (m0 >> 8) * 128 : n0;
      gemm_tile((f1 ? (const u16*)(ws + OFF_CBD) : (const u16*)(ws + OFF_WOUT_ET)) + koff, f1 ? 512 : 1024,
                (f1 ? (const u16*)(ws + OFF_WINB) : (const u16*)(ws + OFF_BD)) + koff, f1 ? 512 : 1024, 128, m0, n0,
                EpiBf16{f1 ? (u16*)(ws + OFF_WIN_E) + (size_t)512 * 1024 : (u16*)(ws + OFF_WOUT_E), 1024}, lds);
    }
    normmod_phase(p, vb, G, p.in[0], p.in[1], p.in[8], 0, 0);
    if (vb >= 128) prep_transposes(p, vb - 128, G - 128, lds, 1);
  }
  SEAM(2)
  if (RUNPH(2)) REP(2)
    big_gemm8<3>(lds8, H, (const u16*)(ws + OFF_WIN_E), T, 1536, 1024, FUx8{(u16*)(ws + OFF_UA), (u16*)(ws + OFF_PQT)});
  SEAM(3)
  if (RUNPH(3)) REP(3) sym_phase(p, vb, G);
  SEAM(4)
  if (RUNPH(4)) REP(4) {
    const u16* PQT = (const u16*)(ws + OFF_PQT);
    const u16* PEQO = (const u16*)(ws + OFF_PEQO);
    for (int t = vb0; t < 256 + 128; t += (int)gridDim.x) {
      const bool big = t < 256;
      const int q = t - 256, b = q >> 3;
      dft_pair(big ? (const u16*)(ws + OFF_D4096) : (const u16*)(ws + OFF_D256),
               big ? PEQO + (size_t)16 * 512 * 256 : PEQO + (size_t)b * 512 * 256,
               big ? PQT + (size_t)16 * 512 * 512 + 2048 : PQT + (size_t)b * 512 * 512 + 128,
               big ? 8192 : 512, big ? 2048 : 128, big ? (t & 15) << 7 : 0, big ? (t >> 4) << 6 : (q & 7) << 6,
               (u16*)(ws + OFF_AB), big ? 4096 : b * 256, 512, big ? 0.0013810679320049757f : 0.005524271728019903f, (char*)shm, half);
    }
    pool_phase(p, vb, G);
  }
  float* PART = (float*)(ws + OFF_PART);
  unsigned* CNT = (unsigned*)(ws + OFF_CNT);
  SEAM(5)
  if (RUNPH(5))
    big_gemm_resnorm<3>(lds8, (const u16*)(ws + OFF_AB), (const u16*)(ws + OFF_WOUT_E), T, 1024, 1024,
                        ResNormEpi<3>{p.in[0], p.in[1], X, mods + 2048, p.in[9], mods + 3072, H, PART, CNT});
  SEAM(6)
  if (RUNPH(6)) REP(6) big_gemm8<4>(lds8, H, (const u16*)(ws + OFF_W1), T, 4096, 1024, FRelu2x8{(u16*)(ws + OFF_M1)});
  SEAM(7)
  if (RUNPH(7))
    big_gemm_resnorm<3>(lds8, (const u16*)(ws + OFF_M1), (const u16*)(ws + OFF_W2), T, 1024, 4096,
                        ResNormEpi<3>{X, X + (size_t)4096 * 1024, X, mods + 5120, p.in[8] + 1024, mods + 3 * 6144, H, PART + (size_t)4 * T, CNT + 64 * 16});
  SEAM(8)
  if (RUNPH(8)) REP(8) big_gemm8<4>(lds8, H, (const u16*)(ws + OFF_WIN_O), T, 2304, 1024,
                            FQkvx8{(u16*)(ws + OFF_QKV), (u16*)(ws + OFF_CVTP), (u16*)(ws + OFF_CVTS), (u16*)(ws + OFF_DVTP), (u16*)(ws + OFF_DVTS), p.out + OUT_NCV, p.out + OUT_NDV});
  SEAM(9)
  if (RUNPH(9)) REP(9) qkvpost_phase(p, vb, G);
  SEAM(10)
  if (RUNPH(10)) REP(10) attention_phase(p, vb0, half, (char*)shm);
  SEAM(11)
  if (RUNPH(11))
    big_gemm_resnorm<3>(lds8, H, (const u16*)(ws + OFF_WOUT_O), T, 1024, 1024,
                        ResNormEpi<3>{X, X + (size_t)4096 * 1024, X, mods + 3 * 6144 + 2048, p.in[9] + 1024, mods + 3 * 6144 + 3072, (u16*)(ws + OFF_R2), PART + (size_t)8 * T, CNT + 128 * 16});
  SEAM(12)
  if (RUNPH(12)) REP(12) big_gemm8<4>(lds8, (const u16*)(ws + OFF_R2), (const u16*)(ws + OFF_W1) + (size_t)4096 * 1024, T, 4096, 1024, FRelu2x8{(u16*)(ws + OFF_M1)});
  SEAM(13)
  if (RUNPH(13)) REP(13) big_gemm<3>(lds8, (const u16*)(ws + OFF_M1), (const u16*)(ws + OFF_W2) + (size_t)4096 * 1024, T, 1024, 4096, FRes{X, X + (size_t)4096 * 1024, rep_ ? (float*)(ws + OFF_R2) : X, mods + 3 * 6144 + 5120});
}

extern "C" void kernel_launch(void* const* d_in, const int* in_sizes, int n_in, void* d_out, int out_size, void* d_ws, size_t ws_size,
                              hipStream_t stream) {
  constexpr int kDynLds = 2 * LDS_BYTES;
  static int grid = 0;
  if (!grid) {
    int dev = 0, cus = 0, per_cu = 0;
    (void)hipGetDevice(&dev);
    (void)hipDeviceGetAttribute(&cus, hipDeviceAttributeMultiprocessorCount, dev);
    if (hipFuncSetAttribute((const void*)fwd_kernel, hipFuncAttributeMaxDynamicSharedMemorySize, kDynLds) != hipSuccess) fprintf(stderr, "hipFuncSetAttribute(%d) failed\n", kDynLds);
    (void)hipOccupancyMaxActiveBlocksPerMultiprocessor(&per_cu, fwd_kernel, 512, kDynLds);
    if (per_cu < 1) fprintf(stderr, "occupancy query says %d blocks/CU\n", per_cu);
    grid = cus;
    if (ws_size < WS_END) fprintf(stderr, "workspace too small: %zu < %zu\n", ws_size, (size_t)WS_END);
  }
  Params p{};
  for (int i = 0; i < 31; ++i) p.in[i] = (const float*)d_in[i];
  p.out = (float*)d_out;
  p.ws = (unsigned char*)d_ws;
#if ONE_LAUNCH
  hipMemsetAsync((char*)d_ws + OFF_BAR, 0, XCD_BAR_WORDS * 4 + CNT_BYTES, stream);
  int lo = 0, hi = NPH, dup = DUPPH;
  void* args[] = {&p, &lo, &hi, &dup};
  hipError_t e = hipLaunchCooperativeKernel((void*)fwd_kernel, dim3(grid), dim3(512), args, kDynLds, stream);
  if (e != hipSuccess) fprintf(stderr, "cooperative launch failed: %s (grid %d)\n", hipGetErrorString(e), grid);
#else
  for (int ph = 0; ph < NPH; ++ph) hipLaunchKernelGGL(fwd_kernel, dim3(grid), dim3(512), kDynLds, stream, p, ph, ph + 1, -1);
#endif
}
```

```cpp
#include <hip/hip_runtime.h>
#include <hip/hip_cooperative_groups.h>
#include <cstdio>
namespace cg = cooperative_groups;

#ifndef ONE_LAUNCH
#define ONE_LAUNCH 1
#endif

#ifndef ONLYPH
#define ONLYPH -1
#endif
#ifndef DUPPH
#define DUPPH -1
#endif
typedef unsigned short u16;
typedef short bf16x8 __attribute__((ext_vector_type(8)));
typedef float f32x16 __attribute__((ext_vector_type(16)));
typedef __bf16 bf2_t __attribute__((ext_vector_type(2)));
typedef float f2_t __attribute__((ext_vector_type(2)));
typedef unsigned u32x4 __attribute__((ext_vector_type(4)));

#define DI __device__ __forceinline__
#define TIDX ((int)(threadIdx.x & 255u))

constexpr int T = 12288, TP = 4096, DM = 1024;
constexpr int NPH = 13;
constexpr float EPS = 1e-6f;
constexpr float LOG2E = 1.4426950408889634f;
constexpr float QSCALE = 0.125f * LOG2E;
constexpr float LAM_INIT = 0.35550906759f;

constexpr size_t al(size_t x) { return (x + 255) & ~size_t(255); }
constexpr size_t OFF_MODS   = 0;
constexpr size_t OFF_WIN_E  = OFF_MODS + al(2 * 3 * 6144 * 4);
constexpr size_t OFF_WINB   = OFF_WIN_E + al(1536 * 1024 * 2);
constexpr size_t OFF_CBD    = OFF_WINB + al(1024 * 512 * 2);
constexpr size_t OFF_WOUT_ET= OFF_CBD + al(1024 * 512 * 2);
constexpr size_t OFF_BD     = OFF_WOUT_ET + al(1024 * 1024 * 2);
constexpr size_t OFF_WOUT_E = OFF_BD + al(1024 * 1024 * 2);
constexpr size_t OFF_WIN_O  = OFF_WOUT_E + al(1024 * 1024 * 2);
constexpr size_t OFF_WOUT_O = OFF_WIN_O + al(2304 * 1024 * 2);
constexpr size_t OFF_W1     = OFF_WOUT_O + al(1024 * 1024 * 2);
constexpr size_t OFF_W2     = OFF_W1 + al(2 * 4096 * 1024 * 2);
constexpr size_t OFF_D256   = OFF_W2 + al(2 * 4096 * 1024 * 2);
constexpr size_t OFF_H      = OFF_D256 + al(256 * 512 * 2);
constexpr size_t OFF_R2     = OFF_H + al((size_t)T * 1024 * 2);
constexpr size_t R2_BYTES   = (size_t)T * 512 * 2 + (size_t)T * 1024 * 2 * 2;
constexpr size_t OFF_R1     = OFF_R2 + al(R2_BYTES);
constexpr size_t R1_BYTES   = (size_t)T * 4096 * 2;
constexpr size_t OFF_BAR    = OFF_R1 + R1_BYTES;
constexpr size_t OFF_CNT    = OFF_BAR + 3456 * 4;
constexpr size_t CNT_BYTES  = 3 * 64 * 64;
constexpr size_t OFF_PART   = OFF_CNT + CNT_BYTES;
constexpr size_t WS_END     = OFF_PART + (size_t)3 * 4 * T * 4;
constexpr size_t OFF_UA  = OFF_R2;
constexpr size_t OFF_PQT = OFF_UA + (size_t)T * 512 * 2;
constexpr size_t OFF_AB  = OFF_PQT + (size_t)T * 1024 * 2;
constexpr size_t OFF_CQ   = OFF_R2;
constexpr size_t OFF_DQ   = OFF_CQ + (size_t)T * 512 * 2;
constexpr size_t OFF_CKP  = OFF_DQ + (size_t)T * 512 * 2;
constexpr size_t OFF_CKS  = OFF_CKP + (size_t)16 * 8 * 256 * 64 * 2;
constexpr size_t OFF_CVTP = OFF_CKS + (size_t)2 * 8 * 4608 * 64 * 2;
constexpr size_t OFF_CVTS = OFF_CVTP + (size_t)16 * 4 * 128 * 256 * 2;
constexpr size_t OFF_DKP  = OFF_CVTS + (size_t)2 * 4 * 128 * 4608 * 2;
constexpr size_t OFF_DKS  = OFF_DKP + (size_t)16 * 2 * 256 * 64 * 2;
constexpr size_t OFF_DVTP = OFF_DKS + (size_t)2 * 2 * 4608 * 64 * 2;
constexpr size_t OFF_DVTS = OFF_DVTP + (size_t)16 * 2 * 64 * 256 * 2;
constexpr size_t R2_LATE_END = OFF_DVTS + (size_t)2 * 2 * 64 * 4608 * 2;
static_assert(R2_LATE_END <= OFF_R2 + R2_BYTES, "R2 overflow");
constexpr size_t OFF_D4096 = OFF_R1;
constexpr size_t OFF_PEQO  = OFF_R1 + (size_t)32 * 1024 * 1024;
constexpr size_t OFF_M1    = OFF_R1;
constexpr size_t OFF_QKV   = OFF_R1;
constexpr size_t OFF_OM    = OFF_R1 + al((size_t)T * 2304 * 2);
static_assert(OFF_OM + (size_t)T * 1024 * 2 <= WS_END, "R1 overflow");

constexpr size_t OUT_Y   = 0;
constexpr size_t OUT_NCK = (size_t)T * 1024;
constexpr size_t OUT_NCV = OUT_NCK + (size_t)TP * 512;
constexpr size_t OUT_NDK = OUT_NCV + (size_t)TP * 512;
constexpr size_t OUT_NDV = OUT_NDK + (size_t)TP * 128;

struct Params {
  const float* in[31];
  float* out;
  unsigned char* ws;
};

DI float bf2f(u16 v) { return __uint_as_float(((unsigned)v) << 16); }
DI unsigned pack2(float a, float b) { f2_t f = {a, b}; bf2_t v = __builtin_convertvector(f, bf2_t); return __builtin_bit_cast(unsigned, v); }
DI u16 f2bf(float a) { return (u16)(pack2(a, 0.f) & 0xffffu); }
DI int cond_of(int m) { return m < 4096 ? 0 : (m < 8192 ? 1 : 2); }
DI float wave_sum(float v) {
#pragma unroll
  for (int o = 32; o >= 1; o >>= 1) v += __shfl_xor(v, o);
  return v;
}
#define MFMA(a, b, c) __builtin_amdgcn_mfma_f32_32x32x16_bf16((a), (b), (c), 0, 0, 0)

constexpr int LROW = 144;
constexpr int GEMM_BUF = 2 * 128 * LROW;
constexpr int LDS_BYTES = 2 * GEMM_BUF;

template <int NR>
DI void g_load(u32x4 (&R)[NR], const u16* g, int ld, int k0) {
#pragma unroll
  for (int i = 0; i < NR; ++i) R[i] = *(const u32x4*)(g + (size_t)(32 * i) * ld + k0);
}
template <int NR>
DI void g_store(const u32x4 (&R)[NR], char* sw) {
#pragma unroll
  for (int i = 0; i < NR; ++i) *(u32x4*)(sw + (32 * i) * LROW) = R[i];
}
template <int NB>
DI void g_compute(f32x16 (&acc)[2][NB], const char* fa, const char* fb) {
#pragma unroll
  for (int ks = 0; ks < 4; ++ks) {
    bf16x8 a0 = *(const bf16x8*)(fa + ks * 32);
    bf16x8 a1 = *(const bf16x8*)(fa + 32 * LROW + ks * 32);
#pragma unroll
    for (int j = 0; j < NB; ++j) {
      bf16x8 b = *(const bf16x8*)(fb + j * 32 * LROW + ks * 32);
      acc[0][j] = MFMA(a0, b, acc[0][j]);
      acc[1][j] = MFMA(a1, b, acc[1][j]);
    }
  }
}
template <int NB>
DI void gemm_acc(f32x16 (&acc)[2][NB], const u16* A, int lda, const u16* Bt, int ldb, int K, int m0, int n0, char* lds) {
  const int tid = TIDX, lane = tid & 63, wave = tid >> 6;
  const int r = lane & 31, h = lane >> 5;
  const int wm = wave >> 1, wn = wave & 1;
  const int lrow = tid >> 3, lcol = (tid & 7) * 8;
  const u16* ga = A + (size_t)(m0 + lrow) * lda + lcol;
  const u16* gb = Bt + (size_t)(n0 + lrow) * ldb + lcol;
  u32x4 ra0[4], ra1[4], rb0[2 * NB], rb1[2 * NB];
  const int nk = K >> 6;
  char* sw = lds + lrow * LROW + lcol * 2;
  const char* fa = lds + (wm * 64 + r) * LROW + h * 16;
  const char* fb = lds + 128 * LROW + (wn * 32 * NB + r) * LROW + h * 16;
#define G_LOAD(RA, RB, kt_) do { const int k0_ = ((kt_) < nk ? (kt_) : nk - 1) << 6; g_load<4>(RA, ga, lda, k0_); g_load<2 * NB>(RB, gb, ldb, k0_); } while (0)
#define G_STORE(RA, RB, boff_) do { g_store<4>(RA, sw + (boff_)); g_store<2 * NB>(RB, sw + (boff_) + 128 * LROW); } while (0)
  G_LOAD(ra0, rb0, 0);
  G_LOAD(ra1, rb1, 1);
  G_STORE(ra0, rb0, 0);
  __syncthreads();
  for (int kt = 0; kt < nk; kt += 2) {
    G_LOAD(ra0, rb0, kt + 2);
    g_compute<NB>(acc, fa, fb);
    G_STORE(ra1, rb1, GEMM_BUF);
    __syncthreads();
    G_LOAD(ra1, rb1, kt + 3);
    g_compute<NB>(acc, fa + GEMM_BUF, fb + GEMM_BUF);
    G_STORE(ra0, rb0, 0);
    __syncthreads();
  }
#undef G_LOAD
#undef G_STORE
}

template <class Epi>
DI void gemm_tile(const u16* A, int lda, const u16* Bt, int ldb, int K, int m0, int n0, Epi epi, char* lds) {
  const int lane = TIDX & 63, wave = TIDX >> 6;
  const int r = lane & 31, h = lane >> 5, wm = wave >> 1, wn = wave & 1;
  f32x16 acc[2][2];
#pragma unroll
  for (int i = 0; i < 2; ++i)
#pragma unroll
    for (int j = 0; j < 2; ++j)
#pragma unroll
      for (int e = 0; e < 16; ++e) acc[i][j][e] = 0.f;
  gemm_acc<2>(acc, A, lda, Bt, ldb, K, m0, n0, lds);
#pragma unroll
  for (int i = 0; i < 2; ++i)
#pragma unroll
    for (int j = 0; j < 2; ++j)
#pragma unroll
      for (int q = 0; q < 4; ++q) {
        const int m = m0 + wm * 64 + i * 32 + 8 * q + 4 * h;
        const int n = n0 + wn * 64 + j * 32 + r;
        epi(m, n, acc[i][j][4 * q], acc[i][j][4 * q + 1], acc[i][j][4 * q + 2], acc[i][j][4 * q + 3]);
      }
}

DI void dft_pair(const u16* Dm, const u16* PeQo, const u16* PH, int phstride, int H, int m0, int n0, u16* AB, int rowbase, int colsPerBatch, float norm, char* shm, int half) {
  char* lds = shm + half * LDS_BYTES;
  const int lane = TIDX & 63, wave = TIDX >> 6;
  const int r = lane & 31, h = lane >> 5, wm = wave >> 1, wn = wave & 1;
  f32x16 acc[2][1];
#pragma unroll
  for (int i = 0; i < 2; ++i)
#pragma unroll
    for (int e = 0; e < 16; ++e) acc[i][0][e] = 0.f;
  gemm_acc<1>(acc, Dm + half * H, 2 * H, PeQo + half * H, 2 * H, H, m0, n0, lds);
  float* exo = (float*)lds + wave * 2048 + lane;
  const float* exr = (const float*)(shm + (1 - half) * LDS_BYTES) + wave * 2048 + lane;
#pragma unroll
  for (int i = 0; i < 2; ++i)
#pragma unroll
    for (int e = 0; e < 16; ++e) exo[(i * 16 + e) * 64] = acc[i][0][e];
  __syncthreads();
  const int N = 2 * H;
  const int col = n0 + wn * 32 + r;
  const int b = col / colsPerBatch, c = col - b * colsPerBatch;
  const float ph = bf2f(PH[(size_t)col * phstride]);
  u16* base = AB + ((size_t)rowbase + (size_t)b * N) * 1024 + 512 + c;
#pragma unroll
  for (int i = 0; i < 2; ++i)
#pragma unroll
    for (int q = 0; q < 4; ++q)
#pragma unroll
      for (int e = 0; e < 4; ++e) {
        const int k = m0 + wm * 64 + i * 32 + 8 * q + 4 * h + e;
        const float other = exr[(i * 16 + 4 * q + e) * 64];
        const float sp = (k & 1) ? -ph : ph;
        if (half == 0) base[(size_t)k * 1024] = f2bf((acc[i][0][4 * q + e] + sp - other) * norm);
        else if (k > 0) base[(size_t)(N - k) * 1024] = f2bf((other + sp + acc[i][0][4 * q + e]) * norm);
      }
  __syncthreads();
}

struct EpiBf16 {
  u16* C; int ldc;
  DI void operator()(int m, int n, float v0, float v1, float v2, float v3) const {
    u16* p = C + (size_t)m * ldc + n;
    p[0] = f2bf(v0); p[ldc] = f2bf(v1); p[2 * ldc] = f2bf(v2); p[3 * ldc] = f2bf(v3);
  }
};
struct EpiU {
  u16* UA; u16* PQt;
  DI void operator()(int m, int n, float v0, float v1, float v2, float v3) const {
    if (n < 512) {
      u16* p = UA + (size_t)m * 512 + n;
      p[0] = f2bf(v0); p[512] = f2bf(v1); p[1024] = f2bf(v2); p[1536] = f2bf(v3);
    } else {
      const int np = n - 512, g = np >> 8, pq = (np >> 7) & 1, mm = np & 127;
      size_t off;
      if (m < 4096) { const int b = m >> 8, nl = m & 255; off = ((size_t)(b * 512 + g * 128 + mm)) * 512 + pq * 256 + nl; }
      else { const int ms = m - 4096, b = ms >> 12, nl = ms & 4095; off = (size_t)16 * 512 * 512 + ((size_t)(b * 512 + g * 128 + mm)) * 8192 + pq * 4096 + nl; }
      uint2 w; w.x = pack2(v0, v1); w.y = pack2(v2, v3);
      *(uint2*)(PQt + off) = w;
    }
  }
};
struct EpiDft {
  u16* AB; int rowbase; float norm; int sample;
  DI void operator()(int m, int n, float v0, float v1, float v2, float v3) const {
    size_t row; int c;
    if (sample) { row = (size_t)4096 + (size_t)(n >> 9) * 4096 + m; c = n & 511; }
    else { row = (size_t)rowbase + m; c = n; }
    u16* p = AB + row * 1024 + 512 + c;
    p[0] = f2bf(v0 * norm); p[1024] = f2bf(v1 * norm); p[2048] = f2bf(v2 * norm); p[3072] = f2bf(v3 * norm);
  }
};
struct EpiRes {
  const float* xin_p; const float* xin_s;
  float* X; const float* gate;
  DI void operator()(int m, int n, float v0, float v1, float v2, float v3) const {
    const float* xi = (m < 4096) ? xin_p + (size_t)m * 1024 + n : xin_s + (size_t)(m - 4096) * 1024 + n;
    const float g = gate[cond_of(m) * 6144 + n];
    float* xo = X + (size_t)m * 1024 + n;
    xo[0] = xi[0] + g * v0; xo[1024] = xi[1024] + g * v1; xo[2048] = xi[2048] + g * v2; xo[3072] = xi[3072] + g * v3;
  }
};
struct EpiRelu2 {
  u16* C;
  DI void operator()(int m, int n, float v0, float v1, float v2, float v3) const {
    v0 = fmaxf(v0, 0.f); v1 = fmaxf(v1, 0.f); v2 = fmaxf(v2, 0.f); v3 = fmaxf(v3, 0.f);
    u16* p = C + (size_t)m * 4096 + n;
    p[0] = f2bf(v0 * v0); p[4096] = f2bf(v1 * v1); p[8192] = f2bf(v2 * v2); p[12288] = f2bf(v3 * v3);
  }
};
struct EpiQkv {
  u16* QKV; u16* CVtP; u16* CVtS; u16* DVtP; u16* DVtS; float* ncv; float* ndv;
  DI void operator()(int m, int n, float v0, float v1, float v2, float v3) const {
    const bool is_cv = (n >= 1024 && n < 1536), is_dv = (n >= 2176);
    if (!is_cv && !is_dv) {
      u16* p = QKV + (size_t)m * 2304 + n;
      p[0] = f2bf(v0); p[2304] = f2bf(v1); p[4608] = f2bf(v2); p[6912] = f2bf(v3);
      return;
    }
    uint2 w; w.x = pack2(v0, v1); w.y = pack2(v2, v3);
    if (is_cv) {
      const int c = n - 1024;
      if (m < 4096) {
        const int b = m >> 8, nl = m & 255;
        *(uint2*)(CVtP + ((size_t)(b * 512 + c)) * 256 + nl) = w;
        float* o = ncv + (size_t)m * 512 + c; o[0] = v0; o[512] = v1; o[1024] = v2; o[1536] = v3;
      } else {
        const int ms = m - 4096, b = ms >> 12, nl = ms & 4095;
        *(uint2*)(CVtS + ((size_t)(b * 512 + c)) * 4608 + 512 + nl) = w;
      }
    } else {
      const int c = n - 2176;
      if (m < 4096) {
        const int b = m >> 8, nl = m & 255;
        *(uint2*)(DVtP + ((size_t)(b * 128 + c)) * 256 + nl) = w;
        float* o = ndv + (size_t)m * 128 + c; o[0] = v0; o[128] = v1; o[256] = v2; o[384] = v3;
      } else {
        const int ms = m - 4096, b = ms >> 12, nl = ms & 4095;
        *(uint2*)(DVtS + ((size_t)(b * 128 + c)) * 4608 + 512 + nl) = w;
      }
    }
  }
};

DI void ada_item(const Params& p, int id, char* lds) {
  const int tid = TIDX;
  float* ssil = (float*)lds;
  float* red = (float*)(lds + 12288);
  const int l = id / 192, cb = id % 192;
  for (int i = tid; i < 3072; i += 256) {
    const int j = i >> 10, k = i & 1023;
    const float v = (j == 0) ? p.in[7][k] : p.in[2][(j - 1) * 1024 + k];
    ssil[i] = v / (1.f + __expf(-v));
  }
  __syncthreads();
  const int cq = tid & 7, kg = tid >> 3;
  const float* w = p.in[10] + (size_t)l * 1024 * 6144 + cb * 32 + cq * 4;
  float4 a0 = {0, 0, 0, 0}, a1 = {0, 0, 0, 0}, a2 = {0, 0, 0, 0};
#pragma unroll 8
  for (int kk = 0; kk < 32; ++kk) {
    const int k = kg * 32 + kk;
    const float4 wv = *(const float4*)(w + (size_t)k * 6144);
    const float s0 = ssil[k], s1 = ssil[1024 + k], s2 = ssil[2048 + k];
    a0.x += s0 * wv.x; a0.y += s0 * wv.y; a0.z += s0 * wv.z; a0.w += s0 * wv.w;
    a1.x += s1 * wv.x; a1.y += s1 * wv.y; a1.z += s1 * wv.z; a1.w += s1 * wv.w;
    a2.x += s2 * wv.x; a2.y += s2 * wv.y; a2.z += s2 * wv.z; a2.w += s2 * wv.w;
  }
  float* rp = red + kg * 96 + cq * 4;
  rp[0] = a0.x; rp[1] = a0.y; rp[2] = a0.z; rp[3] = a0.w;
  rp[32] = a1.x; rp[33] = a1.y; rp[34] = a1.z; rp[35] = a1.w;
  rp[64] = a2.x; rp[65] = a2.y; rp[66] = a2.z; rp[67] = a2.w;
  __syncthreads();
  if (tid < 96) {
    const int j = tid >> 5, c = tid & 31;
    float sum = 0.f;
#pragma unroll
    for (int g = 0; g < 32; ++g) sum += red[g * 96 + j * 32 + c];
    const int col = cb * 32 + c;
    ((float*)(p.ws + OFF_MODS))[(size_t)(l * 3 + j) * 6144 + col] = sum + p.in[11][l * 6144 + col];
  }
  __syncthreads();
}

DI void transpose_tile(const float* src, int ld_src, u16* dst, int ld_dst, int r0, int c0, char* lds) {
  float* tile = (float*)lds;
  const int tid = TIDX;
  const int j4 = (tid & 15) * 4, i0 = tid >> 4;
#pragma unroll
  for (int it = 0; it < 4; ++it) {
    const int i = i0 + 16 * it;
    const float4 v = *(const float4*)(src + (size_t)(r0 + i) * ld_src + c0 + j4);
    float* tp = tile + i * 65 + j4;
    tp[0] = v.x; tp[1] = v.y; tp[2] = v.z; tp[3] = v.w;
  }
  __syncthreads();
  const int kc = (tid & 7) * 8, jr = tid >> 3;
#pragma unroll
  for (int it = 0; it < 2; ++it) {
    const int j = jr + 32 * it;
    const float* tp = tile + kc * 65 + j;
    uint4 o;
    o.x = pack2(tp[0], tp[65]); o.y = pack2(tp[130], tp[195]); o.z = pack2(tp[260], tp[325]); o.w = pack2(tp[390], tp[455]);
    *(uint4*)(dst + (size_t)(c0 + j) * ld_dst + r0 + kc) = o;
  }
  __syncthreads();
}

DI void prep_transposes(const Params& p, int vb, int G, char* lds, int layer) {
  const int ntile = layer ? 2880 : 2432;
  for (int t = vb; t < ntile; t += G) {
    const float* src; u16* dst; int lds_, ldd, r0, c0;
    int q = t;
    if (layer == 0) {
      if (q < 128) { src = p.in[12]; lds_ = 1024; dst = (u16*)(p.ws + OFF_WIN_E); ldd = 1024; r0 = (q >> 3) * 64; c0 = (q & 7) * 64; }
      else if ((q -= 128) < 256) { src = p.in[16]; lds_ = 1024; dst = (u16*)(p.ws + OFF_WOUT_ET); ldd = 1024; r0 = (q >> 4) * 64; c0 = (q & 15) * 64; }
      else if ((q -= 256) < 1024) { src = p.in[29]; lds_ = 4096; dst = (u16*)(p.ws + OFF_W1); ldd = 1024; r0 = (q >> 6) * 64; c0 = (q & 63) * 64; }
      else { q -= 1024; src = p.in[30]; lds_ = 1024; dst = (u16*)(p.ws + OFF_W2); ldd = 4096; r0 = (q >> 4) * 64; c0 = (q & 15) * 64; }
    } else {
      if (q < 576) { src = p.in[17]; lds_ = 2304; dst = (u16*)(p.ws + OFF_WIN_O); ldd = 1024; r0 = (q / 36) * 64; c0 = (q % 36) * 64; }
      else if ((q -= 576) < 256) { src = p.in[28]; lds_ = 1024; dst = (u16*)(p.ws + OFF_WOUT_O); ldd = 1024; r0 = (q >> 4) * 64; c0 = (q & 15) * 64; }
      else if ((q -= 256) < 1024) { src = p.in[29] + (size_t)1024 * 4096; lds_ = 4096; dst = (u16*)(p.ws + OFF_W1) + (size_t)4096 * 1024; ldd = 1024; r0 = (q >> 6) * 64; c0 = (q & 63) * 64; }
      else { q -= 1024; src = p.in[30] + (size_t)4096 * 1024; lds_ = 1024; dst = (u16*)(p.ws + OFF_W2) + (size_t)1024 * 4096; ldd = 4096; r0 = (q >> 4) * 64; c0 = (q & 15) * 64; }
    }
    transpose_tile(src, lds_, dst, ldd, r0, c0, lds);
  }
}

DI void prep_elementwise(const Params& p, int vb, int G) {
  const size_t gt = (size_t)vb * 256 + TIDX, gs = (size_t)G * 256;
  {
    u16* d = (u16*)(p.ws + OFF_WINB);
    for (size_t i = gt; i < 1024 * 256; i += gs) {
      const int k = (int)(i >> 8), c = (int)(i & 255) * 2;
      const float* s = p.in[12] + (size_t)k * 1024 + 512 + c;
      *(unsigned*)(d + (size_t)k * 512 + c) = pack2(s[0], s[1]);
    }
  }
  {
    u16* d = (u16*)(p.ws + OFF_CBD);
    for (size_t i = gt; i < 1024 * 512; i += gs) {
      const int np = (int)(i >> 9), cp = (int)(i & 511);
      const int g = np >> 8, pq = (np >> 7) & 1, m = np & 127;
      float v = 0.f;
      if ((cp >> 7) == g) {
        const int c = cp & 127; const int rr = (m * c) & 127;
        const float x = (float)rr * (2.0f / 128.0f);
        v = pq ? sinpif(x) : cospif(x);
      }
      d[i] = f2bf(v);
    }
  }
  {
    u16* d = (u16*)(p.ws + OFF_BD);
    for (size_t i = gt; i < 1024 * 1024; i += gs) {
      const int kp = (int)(i >> 10), c = (int)(i & 1023);
      float v = 0.f;
      if (kp < 512) { const int g = kp >> 7; if (c < 512 && (c >> 7) == g) v = p.in[13][(size_t)g * 16384 + (kp & 127) * 128 + (c & 127)] * p.in[14][c]; }
      else { const int g = (kp - 512) >> 7; if (c >= 512 && ((c - 512) >> 7) == g) v = p.in[15][(size_t)g * 16384 + ((kp - 512) & 127) * 128 + ((c - 512) & 127)]; }
      d[i] = f2bf(v);
    }
  }
#pragma unroll 1
  for (int which = 0; which < 2; ++which) {
    const int H = which ? 2048 : 128, N = 2 * H, lg = which ? 9 : 5;
    u16* d = (u16*)(p.ws + (which ? OFF_D4096 : OFF_D256));
    const float invN = 1.0f / (float)N;
    for (size_t i = gt; i < ((size_t)H << lg); i += gs) {
      const int k = (int)(i >> lg), np = (int)(i & ((1 << lg) - 1)) * 8;
      const bool is_sin = np >= H;
      const int n = np & (H - 1);
      unsigned w[4];
#pragma unroll
      for (int e = 0; e < 4; ++e) {
        const float x0 = (float)((k * (n + 2 * e)) & (N - 1)) * invN, x1 = (float)((k * (n + 2 * e + 1)) & (N - 1)) * invN;
        const float v0 = is_sin ? __builtin_amdgcn_sinf(x0) : __builtin_amdgcn_cosf(x0);
        const float v1 = is_sin ? __builtin_amdgcn_sinf(x1) : __builtin_amdgcn_cosf(x1);
        w[e] = pack2(v0, v1);
      }
      *(uint4*)(d + (size_t)k * N + np) = make_uint4(w[0], w[1], w[2], w[3]);
    }
  }
}

DI void sym_phase(const Params& p, int vb, int G) {
  const int lane = TIDX & 63, wave = TIDX >> 6;
  const u16* PQT = (const u16*)(p.ws + OFF_PQT);
  u16* PEQO = (u16*)(p.ws + OFF_PEQO);
  u16* AB = (u16*)(p.ws + OFF_AB);
  for (int it = vb * 4 + wave; it < 1024 + 2048; it += G * 4) {
    const bool samp = it < 1024;
    const int H = samp ? 2048 : 128, N = 2 * H;
    int col, n0base, nstep;
    if (samp) { col = it; n0base = lane * 8; nstep = 512; }
    else { col = (it - 1024) * 4 + (lane >> 4); n0base = (lane & 15) * 8; nstep = 128; }
    const u16* Pp = samp ? PQT + (size_t)16 * 512 * 512 + (size_t)col * 8192 : PQT + (size_t)col * 512;
    const u16* Qp = Pp + N;
    u16* Pe = samp ? PEQO + (size_t)16 * 512 * 256 + (size_t)col * 4096 : PEQO + (size_t)col * 256;
    u16* Qo = Pe + H;
    float alt = 0.f;
    for (int n0 = n0base; n0 < H; n0 += nstep) {
      const uint4 pw = *(const uint4*)(Pp + n0), qw = *(const uint4*)(Qp + n0);
      const unsigned pa[4] = {pw.x, pw.y, pw.z, pw.w}, qa[4] = {qw.x, qw.y, qw.z, qw.w};
      float pe[8], qo[8];
#pragma unroll
      for (int e = 0; e < 8; ++e) {
        const float pv = (e & 1) ? __uint_as_float(pa[e >> 1] & 0xffff0000u) : __uint_as_float(pa[e >> 1] << 16);
        const float qv = (e & 1) ? __uint_as_float(qa[e >> 1] & 0xffff0000u) : __uint_as_float(qa[e >> 1] << 16);
        const int n = n0 + e;
        float pm = 0.f, qm = 0.f;
        if (n > 0) { pm = bf2f(Pp[N - n]); qm = bf2f(Qp[N - n]); }
        pe[e] = pv + pm;
        qo[e] = (n > 0) ? qv - qm : 0.f;
        alt += (e & 1) ? -pe[e] : pe[e];
      }
      *(uint4*)(Pe + n0) = make_uint4(pack2(pe[0], pe[1]), pack2(pe[2], pe[3]), pack2(pe[4], pe[5]), pack2(pe[6], pe[7]));
      *(uint4*)(Qo + n0) = make_uint4(pack2(qo[0], qo[1]), pack2(qo[2], qo[3]), pack2(qo[4], qo[5]), pack2(qo[6], qo[7]));
    }
    alt += __shfl_xor(alt, 1); alt += __shfl_xor(alt, 2); alt += __shfl_xor(alt, 4); alt += __shfl_xor(alt, 8);
    if (samp) { alt += __shfl_xor(alt, 16); alt += __shfl_xor(alt, 32); }
    if ((samp && lane == 0) || (!samp && (lane & 15) == 0)) {
      const float fh = alt + bf2f(Pp[H]);
      size_t row; int c; float norm;
      if (samp) { row = (size_t)4096 + (size_t)(col >> 9) * 4096 + 2048; c = col & 511; norm = 0.0013810679320049757f; }
      else { row = (size_t)(col >> 9) * 256 + 128; c = col & 511; norm = 0.005524271728019903f; }
      AB[row * 1024 + 512 + c] = f2bf(fh * norm);
    }
  }
}

DI void normmod_phase(const Params& p, int vb, int G, const float* xp, const float* xs, const float* gain, int l, int which) {
  const int lane = TIDX & 63, wave = TIDX >> 6;
  u16* H = (u16*)(p.ws + OFF_H);
  const float* mods = (const float*)(p.ws + OFF_MODS) + (size_t)l * 3 * 6144;
  for (int row = vb * 4 + wave; row < T; row += G * 4) {
    const float* x = (row < 4096) ? xp + (size_t)row * 1024 : xs + (size_t)(row - 4096) * 1024;
    float4 v[4];
    float ss = 0.f;
#pragma unroll
    for (int i = 0; i < 4; ++i) {
      v[i] = *(const float4*)(x + i * 256 + lane * 4);
      ss += v[i].x * v[i].x + v[i].y * v[i].y + v[i].z * v[i].z + v[i].w * v[i].w;
    }
    ss = wave_sum(ss);
    const float rinv = rsqrtf(ss * (1.0f / 1024.0f) + EPS);
    const float* md = mods + cond_of(row) * 6144 + which * 3072;
#pragma unroll
    for (int i = 0; i < 4; ++i) {
      const int c = i * 256 + lane * 4;
      const float4 g = *(const float4*)(gain + c);
      const float4 sh = *(const float4*)(md + c);
      const float4 sc = *(const float4*)(md + 1024 + c);
      const float o0 = v[i].x * rinv * g.x * (1.f + sc.x) + sh.x;
      const float o1 = v[i].y * rinv * g.y * (1.f + sc.y) + sh.y;
      const float o2 = v[i].z * rinv * g.z * (1.f + sc.z) + sh.z;
      const float o3 = v[i].w * rinv * g.w * (1.f + sc.w) + sh.w;
      uint2 w; w.x = pack2(o0, o1); w.y = pack2(o2, o3);
      *(uint2*)(H + (size_t)row * 1024 + c) = w;
    }
  }
}

template <class Epi>
DI void gemm_phase(const u16* A, int lda, const u16* Bt, int ldb, int K, int M, int N, Epi epi, int vb, int G, char* lds) {
  const int nN = N >> 7, nt = (M >> 7) * nN, grp = 8 * nN;
  for (int t = vb; t < nt; t += G) {
    const int gi = t / grp, rem = t - gi * grp;
    gemm_tile(A, lda, Bt, ldb, K, (gi * 8 + (rem & 7)) << 7, (rem >> 3) << 7, epi, lds);
  }
}

template <int HW>
DI void pool_item(const u16* UA, u16* AB, int t, int c8) {
  int nl, N;
  if (t < 4096) { nl = t & 255; N = 256; } else { nl = (t - 4096) & 4095; N = 4096; }
  const int base = t - nl;
  u32x4 w[2 * HW];
  int cnt = 0;
#pragma unroll
  for (int j = 0; j < 2 * HW; ++j) {
    const int idx = nl - HW + j;
    const bool ok = idx >= 0 && idx < N;
    w[j] = *(const u32x4*)(UA + (size_t)(base + (ok ? idx : nl)) * 512 + c8);
    if (!ok) w[j] = (u32x4){0u, 0u, 0u, 0u};
    cnt += ok ? 1 : 0;
  }
  const u32x4 cw = *(const u32x4*)(UA + (size_t)t * 512 + c8);
  float s[8] = {0, 0, 0, 0, 0, 0, 0, 0};
#pragma unroll
  for (int j = 0; j < 2 * HW; ++j)
#pragma unroll
    for (int e = 0; e < 4; ++e) { s[2 * e] += __uint_as_float(w[j][e] << 16); s[2 * e + 1] += __uint_as_float(w[j][e] & 0xffff0000u); }
  const float inv = 1.0f / (float)cnt;
  u32x4 o;
#pragma unroll
  for (int e = 0; e < 4; ++e) o[e] = pack2(s[2 * e] * inv - __uint_as_float(cw[e] << 16), s[2 * e + 1] * inv - __uint_as_float(cw[e] & 0xffff0000u));
  *(u32x4*)(AB + (size_t)t * 1024 + c8) = o;
}
DI void pool_phase(const Params& p, int vb, int G) {
  const u16* UA = (const u16*)(p.ws + OFF_UA);
  u16* AB = (u16*)(p.ws + OFF_AB);
  const size_t gt = (size_t)vb * 256 + TIDX, gs = (size_t)G * 256;
  for (size_t i = gt; i < (size_t)T * 64; i += gs) {
    const int cc = (int)(i & 15), tt = (int)(i >> 4) & 3, g = (int)(i >> 6) & 3, tb = (int)(i >> 8);
    const int t = tb * 4 + tt, c8 = g * 128 + cc * 8;
    if (g == 0) pool_item<1>(UA, AB, t, c8);
    else if (g == 1) pool_item<2>(UA, AB, t, c8);
    else if (g == 2) pool_item<4>(UA, AB, t, c8);
    else pool_item<8>(UA, AB, t, c8);
  }
}

DI void qkvpost_phase(const Params& p, int vb, int G) {
  const int lane = TIDX & 63, wave = TIDX >> 6;
  const int q = lane & 15, sub = lane >> 4;
  const u16* QKV = (const u16*)(p.ws + OFF_QKV);
  u16* CQ = (u16*)(p.ws + OFF_CQ); u16* DQ = (u16*)(p.ws + OFF_DQ);
  u16* CKP = (u16*)(p.ws + OFF_CKP); u16* CKS = (u16*)(p.ws + OFF_CKS);
  u16* DKP = (u16*)(p.ws + OFF_DKP); u16* DKS = (u16*)(p.ws + OFF_DKS);
  float* nck = p.out + OUT_NCK; float* ndk = p.out + OUT_NDK;
  const int d0 = q * 4;
  float fr[4];
#pragma unroll
  for (int e = 0; e < 4; ++e) fr[e] = exp2f(-(float)((d0 + e) & 15) * (13.287712379549449f / 16.0f));
  const bool firsthalf = ((d0 >> 4) & 1) == 0;
  for (int t = vb * 4 + wave; t < T; t += G * 4) {
    const bool samp = t >= 4096;
    int b, nl;
    if (!samp) { b = t >> 8; nl = t & 255; } else { b = (t - 4096) >> 12; nl = (t - 4096) & 4095; }
    float cs[4], sn[4];
    if (samp) {
      const float pos = (d0 < 32) ? (float)(nl >> 6) : (float)(nl & 63);
#pragma unroll
      for (int e = 0; e < 4; ++e) { const float a = pos * fr[e]; cs[e] = cosf(a); sn[e] = sinf(a); }
    } else {
#pragma unroll
      for (int e = 0; e < 4; ++e) { cs[e] = 1.f; sn[e] = 0.f; }
    }
    for (int rd = 0; rd < 7; ++rd) {
      const int slot = rd * 4 + sub;
      const bool act = slot < 26;
      const int vi = act ? (slot < 16 ? slot : slot + 8) : 0;
      const uint2 raw = *(const uint2*)(QKV + (size_t)t * 2304 + vi * 64 + d0);
      float x[4] = {__uint_as_float(raw.x << 16), __uint_as_float(raw.x & 0xffff0000u), __uint_as_float(raw.y << 16), __uint_as_float(raw.y & 0xffff0000u)};
      float ss = x[0] * x[0] + x[1] * x[1] + x[2] * x[2] + x[3] * x[3];
      ss += __shfl_xor(ss, 1); ss += __shfl_xor(ss, 2); ss += __shfl_xor(ss, 4); ss += __shfl_xor(ss, 8);
      const float rinv = rsqrtf(ss * (1.0f / 64.0f) + EPS);
      const float* gp = (vi < 8) ? p.in[18] : (vi < 16) ? p.in[19] : (vi < 32) ? p.in[25] : p.in[26];
      const float4 g = *(const float4*)(gp + d0);
      float y[4] = {x[0] * rinv * g.x, x[1] * rinv * g.y, x[2] * rinv * g.z, x[3] * rinv * g.w};
      float o[4];
#pragma unroll
      for (int e = 0; e < 4; ++e) {
        const float part = __shfl_xor(y[e], 4);
        o[e] = firsthalf ? (y[e] * cs[e] - part * sn[e]) : (y[e] * cs[e] + part * sn[e]);
      }
      if (!act) continue;
      const bool isq = (vi < 8) || (vi >= 24 && vi < 32);
      if (isq) {
        const int hd = (vi < 8) ? vi : vi - 24;
        u16* base = (vi < 8) ? CQ : DQ;
        size_t off = samp ? (size_t)16 * 8 * 256 * 64 + ((size_t)(b * 8 + hd) * 4096 + nl) * 64 : ((size_t)(b * 8 + hd) * 256 + nl) * 64;
        uint2 w; w.x = pack2(o[0] * QSCALE, o[1] * QSCALE); w.y = pack2(o[2] * QSCALE, o[3] * QSCALE);
        *(uint2*)(base + off + d0) = w;
      } else if (vi < 16) {
        const int hm = vi - 8;
        uint2 w; w.x = pack2(o[0], o[1]); w.y = pack2(o[2], o[3]);
        if (samp) *(uint2*)(CKS + ((size_t)(b * 8 + hm) * 4608 + 512 + nl) * 64 + d0) = w;
        else {
          *(uint2*)(CKP + ((size_t)(b * 8 + hm) * 256 + nl) * 64 + d0) = w;
          *(float4*)(nck + (size_t)t * 512 + hm * 64 + d0) = make_float4(o[0], o[1], o[2], o[3]);
        }
      } else {
        const int j = vi - 32;
        uint2 w; w.x = pack2(o[0], o[1]); w.y = pack2(o[2], o[3]);
        if (samp) *(uint2*)(DKS + ((size_t)(b * 2 + j) * 4608 + 512 + nl) * 64 + d0) = w;
        else {
          *(uint2*)(DKP + ((size_t)(b * 2 + j) * 256 + nl) * 64 + d0) = w;
          *(float4*)(ndk + (size_t)t * 128 + j * 64 + d0) = make_float4(o[0], o[1], o[2], o[3]);
        }
      }
    }
  }
  const size_t gt = (size_t)vb * 256 + TIDX, gs = (size_t)G * 256;
  {
    u16* CVTS = (u16*)(p.ws + OFF_CVTS); u16* DVTS = (u16*)(p.ws + OFF_DVTS);
    for (size_t i = gt; i < (size_t)2 * 512 * 512; i += gs) {
      const int b = (int)(i >> 18), key = (int)(i >> 9) & 511, c = (int)(i & 511);
      CKS[((size_t)(b * 8 + (c >> 6)) * 4608 + key) * 64 + (c & 63)] = f2bf(p.in[3][i]);
    }
    for (size_t i = gt; i < (size_t)2 * 512 * 512; i += gs) {
      const int b = (int)(i >> 18), c = (int)(i >> 9) & 511, key = (int)(i & 511);
      CVTS[((size_t)(b * 512 + c)) * 4608 + key] = f2bf(p.in[4][((size_t)b * 512 + key) * 512 + c]);
    }
    for (size_t i = gt; i < (size_t)2 * 512 * 128; i += gs) {
      const int b = (int)(i >> 16), key = (int)(i >> 7) & 511, c = (int)(i & 127);
      DKS[((size_t)(b * 2 + (c >> 6)) * 4608 + key) * 64 + (c & 63)] = f2bf(p.in[5][i]);
    }
    for (size_t i = gt; i < (size_t)2 * 128 * 512; i += gs) {
      const int b = (int)(i >> 16), c = (int)(i >> 9) & 127, key = (int)(i & 511);
      DVTS[((size_t)(b * 128 + c)) * 4608 + key] = f2bf(p.in[6][((size_t)b * 512 + key) * 128 + c]);
    }
  }
}

DI void cache_convert(const Params& p, int vb, int G) {
  u16* CKS = (u16*)(p.ws + OFF_CKS); u16* DKS = (u16*)(p.ws + OFF_DKS);
  const size_t gt = (size_t)vb * 256 + TIDX, gs = (size_t)G * 256;
  {
    u16* CVTS = (u16*)(p.ws + OFF_CVTS); u16* DVTS = (u16*)(p.ws + OFF_DVTS);
    for (size_t i = gt; i < (size_t)2 * 512 * 512; i += gs) {
      const int b = (int)(i >> 18), key = (int)(i >> 9) & 511, c = (int)(i & 511);
      CKS[((size_t)(b * 8 + (c >> 6)) * 4608 + key) * 64 + (c & 63)] = f2bf(p.in[3][i]);
    }
    for (size_t i = gt; i < (size_t)2 * 512 * 512; i += gs) {
      const int b = (int)(i >> 18), c = (int)(i >> 9) & 511, key = (int)(i & 511);
      CVTS[((size_t)(b * 512 + c)) * 4608 + key] = f2bf(p.in[4][((size_t)b * 512 + key) * 512 + c]);
    }
    for (size_t i = gt; i < (size_t)2 * 512 * 128; i += gs) {
      const int b = (int)(i >> 16), key = (int)(i >> 7) & 511, c = (int)(i & 127);
      DKS[((size_t)(b * 2 + (c >> 6)) * 4608 + key) * 64 + (c & 63)] = f2bf(p.in[5][i]);
    }
    for (size_t i = gt; i < (size_t)2 * 128 * 512; i += gs) {
      const int b = (int)(i >> 16), c = (int)(i >> 9) & 127, key = (int)(i & 511);
      DVTS[((size_t)(b * 128 + c)) * 4608 + key] = f2bf(p.in[6][((size_t)b * 512 + key) * 128 + c]);
    }
  }
}

template <int DV>
DI void attn_item(const u16* Q, const u16* Kb, const u16* Vt, int ldv, int nt0, int key1, int nt1,
                  bool masked, int qpos0, bool has_sink, float sink2, u16* out, int ldo, char* lds) {
  constexpr int NDB = DV / 32;
  constexpr int KVBUF = (64 + DV) * LROW;
  const int tid = TIDX, lane = tid & 63, wave = tid >> 6;
  const int r = lane & 31, h = lane >> 5;
  const int nt = nt0 + nt1;
  bf16x8 qf[4];
#pragma unroll
  for (int ks = 0; ks < 4; ++ks) qf[ks] = *(const bf16x8*)(Q + (size_t)(wave * 32 + r) * 64 + ks * 16 + h * 8);
  f32x16 O[NDB];
#pragma unroll
  for (int i = 0; i < NDB; ++i)
#pragma unroll
    for (int e = 0; e < 16; ++e) O[i][e] = 0.f;
  float mrun = has_sink ? sink2 : -1e30f;
  float lrun = has_sink ? (h == 0 ? 1.f : 0.f) : 0.f;
  const int lrow = tid >> 3, lpart = (tid & 7) * 8;
  uint4 rk0, rk1, rv0, rv1, rv2, rv3;
  rv2 = rv3 = make_uint4(0, 0, 0, 0);
  const u16* gk = Kb + (size_t)lrow * 64 + lpart;
  const u16* gv = Vt + (size_t)lrow * ldv + lpart;
#define ATT_GLOAD(key0_)                                                         \
  do {                                                                           \
    rk0 = *(const uint4*)(gk + (size_t)(key0_) * 64);                            \
    rk1 = *(const uint4*)(gk + (size_t)((key0_) + 32) * 64);                     \
    rv0 = *(const uint4*)(gv + (key0_));                                         \
    rv1 = *(const uint4*)(gv + (size_t)32 * ldv + (key0_));                      \
    if constexpr (DV == 128) {                                                   \
      rv2 = *(const uint4*)(gv + (size_t)64 * ldv + (key0_));                    \
      rv3 = *(const uint4*)(gv + (size_t)96 * ldv + (key0_));                    \
    }                                                                            \
  } while (0)
#define ATT_SSTORE(boff_)                                                        \
  do {                                                                           \
    *(uint4*)(sw + (boff_)) = rk0;                                               \
    *(uint4*)(sw + (boff_) + 32 * LROW) = rk1;                                   \
    *(uint4*)(sw + (boff_) + 64 * LROW) = rv0;                                   \
    *(uint4*)(sw + (boff_) + 96 * LROW) = rv1;                                   \
    if constexpr (DV == 128) {                                                   \
      *(uint4*)(sw + (boff_) + 128 * LROW) = rv2;                                \
      *(uint4*)(sw + (boff_) + 160 * LROW) = rv3;                                \
    }                                                                            \
  } while (0)
  char* sw = lds + lrow * LROW + lpart * 2;
  {
    const int key0 = (nt0 > 0) ? 0 : key1;
    ATT_GLOAD(key0);
  }
  ATT_SSTORE(0);
  __syncthreads();
  const int pr = (r & 0x13) | ((r & 4) << 1) | ((r & 8) >> 1);
  const char* fk = lds + pr * LROW + h * 16;
  const char* fv = lds + 64 * LROW + r * LROW + h * 16;
  const int qpos = qpos0 + wave * 32 + r;
  for (int t = 0; t < nt; ++t) {
    const int cur = (t & 1) * KVBUF;
    const int key0 = (t < nt0) ? t * 64 : key1 + (t - nt0) * 64;
    {
      const int tn = (t + 1 < nt) ? t + 1 : t;
      const int kn = (tn < nt0) ? tn * 64 : key1 + (tn - nt0) * 64;
      ATT_GLOAD(kn);
    }
    f32x16 S[2];
#pragma unroll
    for (int kb = 0; kb < 2; ++kb) {
#pragma unroll
      for (int e = 0; e < 16; ++e) S[kb][e] = 0.f;
#pragma unroll
      for (int ks = 0; ks < 4; ++ks) {
        const bf16x8 kf = *(const bf16x8*)(fk + cur + kb * 32 * LROW + ks * 32);
        S[kb] = MFMA(kf, qf[ks], S[kb]);
      }
    }
    if (masked && t >= nt0) {
#pragma unroll
      for (int kb = 0; kb < 2; ++kb)
#pragma unroll
        for (int e = 0; e < 16; ++e) {
          const int jpos = key0 - 512 + kb * 32 + 16 * (e >> 3) + 8 * h + (e & 7);
          const int dlt = qpos - jpos;
          if (dlt > 128 || dlt < -128) S[kb][e] = -1e30f;
        }
    }
    float mloc = S[0][0];
#pragma unroll
    for (int kb = 0; kb < 2; ++kb)
#pragma unroll
      for (int e = 0; e < 16; ++e) mloc = fmaxf(mloc, S[kb][e]);
    mloc = fmaxf(mloc, __shfl_xor(mloc, 32));
    const float mnew = fmaxf(mrun, mloc);
    if (__builtin_amdgcn_ballot_w64(mnew > mrun) != 0) {
      const float alpha = __builtin_amdgcn_exp2f(mrun - mnew);
      lrun *= alpha;
#pragma unroll
      for (int i = 0; i < NDB; ++i)
#pragma unroll
        for (int e = 0; e < 16; ++e) O[i][e] *= alpha;
    }
    mrun = mnew;
    float ps = 0.f;
#pragma unroll
    for (int kb = 0; kb < 2; ++kb)
#pragma unroll
      for (int e = 0; e < 16; ++e) { const float pv = __builtin_amdgcn_exp2f(S[kb][e] - mnew); S[kb][e] = pv; ps += pv; }
    lrun += ps;
    bf16x8 pf[4];
#pragma unroll
    for (int jj = 0; jj < 4; ++jj) {
      const int kb = jj >> 1, o8 = (jj & 1) * 8;
      uint4 w;
      w.x = pack2(S[kb][o8 + 0], S[kb][o8 + 1]); w.y = pack2(S[kb][o8 + 2], S[kb][o8 + 3]);
      w.z = pack2(S[kb][o8 + 4], S[kb][o8 + 5]); w.w = pack2(S[kb][o8 + 6], S[kb][o8 + 7]);
      pf[jj] = __builtin_bit_cast(bf16x8, w);
    }
    __builtin_amdgcn_sched_barrier(0);
#pragma unroll
    for (int i = 0; i < NDB; ++i) {
#pragma unroll
      for (int jj = 0; jj < 4; ++jj) {
        const bf16x8 vf = *(const bf16x8*)(fv + cur + i * 32 * LROW + jj * 32);
        O[i] = MFMA(vf, pf[jj], O[i]);
      }
      if (i & 1) __builtin_amdgcn_sched_barrier(0);
    }
    ATT_SSTORE(KVBUF - cur);
    __syncthreads();
  }
#undef ATT_GLOAD
#undef ATT_SSTORE
  const float ltot = lrun + __shfl_xor(lrun, 32);
  const float inv = 1.0f / ltot;
  u16* op = out + (size_t)(wave * 32 + r) * ldo;
#pragma unroll
  for (int i = 0; i < NDB; ++i)
#pragma unroll
    for (int qd = 0; qd < 4; ++qd) {
      uint2 w;
      w.x = pack2(O[i][4 * qd] * inv, O[i][4 * qd + 1] * inv);
      w.y = pack2(O[i][4 * qd + 2] * inv, O[i][4 * qd + 3] * inv);
      *(uint2*)(op + i * 32 + 8 * qd + 4 * h) = w;
    }
}

DI void attn_diff_pair(const u16* Q, const u16* Kb, const u16* Vt, int ldv, int nt, float lam, const float* subln_g, u16* out, char* shm, int half) {
  constexpr int STG = (64 + 64 + 128) * LROW;
  const int tid = TIDX, t512 = (int)threadIdx.x, lane = tid & 63, wave = tid >> 6;
  const int r = lane & 31, h = lane >> 5;
  bf16x8 qf[4];
#pragma unroll
  for (int ks = 0; ks < 4; ++ks) qf[ks] = *(const bf16x8*)(Q + (size_t)(wave * 32 + r) * 64 + ks * 16 + h * 8);
  f32x16 O[4];
#pragma unroll
  for (int i = 0; i < 4; ++i)
#pragma unroll
    for (int e = 0; e < 16; ++e) O[i][e] = 0.f;
  float mrun = -1e30f, lrun = 0.f;
  const int lrow = tid >> 3, lpart = (tid & 7) * 8;
  const int vrow = t512 >> 3, vpart = (t512 & 7) * 8;
  const u16* gk = Kb + (size_t)lrow * 64 + lpart;
  const u16* gv = Vt + (size_t)vrow * ldv + vpart;
  char* sk = shm + half * 64 * LROW + lrow * LROW + lpart * 2;
  char* sv = shm + 128 * LROW + vrow * LROW + vpart * 2;
  u32x4 rk0, rk1, rv0, rv1;
#define AD_GLOAD(key0_) do { rk0 = *(const u32x4*)(gk + (size_t)(key0_) * 64); rk1 = *(const u32x4*)(gk + (size_t)((key0_) + 32) * 64); \
                             rv0 = *(const u32x4*)(gv + (key0_)); rv1 = *(const u32x4*)(gv + (size_t)64 * ldv + (key0_)); } while (0)
#define AD_SSTORE(boff_) do { *(u32x4*)(sk + (boff_)) = rk0; *(u32x4*)(sk + (boff_) + 32 * LROW) = rk1; \
                              *(u32x4*)(sv + (boff_)) = rv0; *(u32x4*)(sv + (boff_) + 64 * LROW) = rv1; } while (0)
#define AD_GLOAD_K(key0_) do { rk0 = *(const u32x4*)(gk + (size_t)(key0_) * 64); rk1 = *(const u32x4*)(gk + (size_t)((key0_) + 32) * 64); } while (0)
#define AD_GLOAD_V(key0_) do { rv0 = *(const u32x4*)(gv + (key0_)); rv1 = *(const u32x4*)(gv + (size_t)64 * ldv + (key0_)); } while (0)
#define AD_SSTORE_K(boff_) do { *(u32x4*)(sk + (boff_)) = rk0; *(u32x4*)(sk + (boff_) + 32 * LROW) = rk1; } while (0)
#define AD_SSTORE_V(boff_) do { *(u32x4*)(sv + (boff_)) = rv0; *(u32x4*)(sv + (boff_) + 64 * LROW) = rv1; } while (0)
#define AD_QK(S_, koff_) do { _Pragma("unroll") for (int kb = 0; kb < 2; ++kb) { _Pragma("unroll") for (int e = 0; e < 16; ++e) S_[kb][e] = 0.f; \
    _Pragma("unroll") for (int ks = 0; ks < 4; ++ks) { const bf16x8 kf = *(const bf16x8*)(fk + (koff_) + kb * 32 * LROW + ks * 32); S_[kb] = MFMA(kf, qf[ks], S_[kb]); } } } while (0)
  const int pr = (r & 0x13) | ((r & 4) << 1) | ((r & 8) >> 1);
  const char* fk = shm + half * 64 * LROW + pr * LROW + h * 16;
  const char* fv = shm + 128 * LROW + r * LROW + h * 16;
  AD_GLOAD_K(0); AD_GLOAD_V(0);
  AD_SSTORE_K(0); AD_SSTORE_V(0);
  AD_GLOAD_K(64);
  AD_SSTORE_K(STG);
  __syncthreads();
  f32x16 S[2], Sn[2];
  AD_QK(S, 0);
  for (int t = 0; t < nt; ++t) {
    const int cur = (t & 1) * STG;
    { const int tk = (t + 2 < nt) ? t + 2 : nt - 1, tv = (t + 1 < nt) ? t + 1 : nt - 1; AD_GLOAD_K(tk * 64); AD_GLOAD_V(tv * 64); }
    AD_QK(Sn, STG - cur);
    __builtin_amdgcn_sched_barrier(0);
    float mloc = S[0][0];
#pragma unroll
    for (int kb = 0; kb < 2; ++kb)
#pragma unroll
      for (int e = 0; e < 16; ++e) mloc = fmaxf(mloc, S[kb][e]);
    mloc = fmaxf(mloc, __shfl_xor(mloc, 32));
    const float mnew = fmaxf(mrun, mloc);
    if (__builtin_amdgcn_ballot_w64(mnew > mrun) != 0) {
      const float alpha = __builtin_amdgcn_exp2f(mrun - mnew);
      lrun *= alpha;
#pragma unroll
      for (int i = 0; i < 4; ++i)
#pragma unroll
        for (int e = 0; e < 16; ++e) O[i][e] *= alpha;
    }
    mrun = mnew;
    float ps = 0.f;
#pragma unroll
    for (int kb = 0; kb < 2; ++kb)
#pragma unroll
      for (int e = 0; e < 16; ++e) { const float pv = __builtin_amdgcn_exp2f(S[kb][e] - mnew); S[kb][e] = pv; ps += pv; }
    lrun += ps;
    bf16x8 pf[4];
#pragma unroll
    for (int jj = 0; jj < 4; ++jj) {
      const int kb = jj >> 1, o8 = (jj & 1) * 8;
      uint4 w;
      w.x = pack2(S[kb][o8 + 0], S[kb][o8 + 1]); w.y = pack2(S[kb][o8 + 2], S[kb][o8 + 3]);
      w.z = pack2(S[kb][o8 + 4], S[kb][o8 + 5]); w.w = pack2(S[kb][o8 + 6], S[kb][o8 + 7]);
      pf[jj] = __builtin_bit_cast(bf16x8, w);
    }
#pragma unroll
    for (int i = 0; i < 4; ++i) {
#pragma unroll
      for (int jj = 0; jj < 4; ++jj) {
        const bf16x8 vf = *(const bf16x8*)(fv + cur + i * 32 * LROW + jj * 32);
        O[i] = MFMA(vf, pf[jj], O[i]);
      }
    }
    AD_SSTORE_K(cur);
    AD_SSTORE_V(STG - cur);
    __syncthreads();
    S[0] = Sn[0]; S[1] = Sn[1];
  }
#undef AD_GLOAD_K
#undef AD_GLOAD_V
#undef AD_SSTORE_K
#undef AD_SSTORE_V
#undef AD_QK
#undef AD_GLOAD
#undef AD_SSTORE
  const float inv = 1.0f / (lrun + __shfl_xor(lrun, 32));
  float* ex = (float*)shm + (size_t)wave * 4096 + lane;
  if (half == 1) {
#pragma unroll
    for (int i = 0; i < 4; ++i)
#pragma unroll
      for (int e = 0; e < 16; ++e) ex[(i * 16 + e) * 64] = O[i][e] * inv;
  }
  __syncthreads();
  if (half == 0) {
    float ss = 0.f;
#pragma unroll
    for (int i = 0; i < 4; ++i)
#pragma unroll
      for (int e = 0; e < 16; ++e) { const float d = O[i][e] * inv - lam * ex[(i * 16 + e) * 64]; O[i][e] = d; ss += d * d; }
    ss += __shfl_xor(ss, 32);
    const float rinv = rsqrtf(ss * (1.0f / 128.0f) + EPS) * (1.0f - LAM_INIT);
    u16* op = out + (size_t)(wave * 32 + r) * 1024;
#pragma unroll
    for (int i = 0; i < 4; ++i)
#pragma unroll
      for (int qd = 0; qd < 4; ++qd) {
        const int e0 = i * 32 + 8 * qd + 4 * h;
        const float4 g = *(const float4*)(subln_g + e0);
        uint2 w;
        w.x = pack2(O[i][4 * qd] * rinv * g.x, O[i][4 * qd + 1] * rinv * g.y);
        w.y = pack2(O[i][4 * qd + 2] * rinv * g.z, O[i][4 * qd + 3] * rinv * g.w);
        *(uint2*)(op + e0) = w;
      }
  }
  __syncthreads();
}

DI void attention_phase(const Params& p, int vb0, int half, char* shm) {
  const u16* CQ = (const u16*)(p.ws + OFF_CQ); const u16* DQ = (const u16*)(p.ws + OFF_DQ);
  const u16* CKP = (const u16*)(p.ws + OFF_CKP); const u16* CKS = (const u16*)(p.ws + OFF_CKS);
  const u16* CVTP = (const u16*)(p.ws + OFF_CVTP); const u16* CVTS = (const u16*)(p.ws + OFF_CVTS);
  const u16* DKP = (const u16*)(p.ws + OFF_DKP); const u16* DKS = (const u16*)(p.ws + OFF_DKS);
  const u16* DVTP = (const u16*)(p.ws + OFF_DVTP); const u16* DVTS = (const u16*)(p.ws + OFF_DVTS);
  u16* AC = (u16*)(p.ws + OFF_H);
  constexpr size_t QS = (size_t)16 * 8 * 256 * 64;
  const int lane = TIDX & 63;
  const float la = wave_sum(p.in[20][lane] * p.in[21][lane]);
  const float lb = wave_sum(p.in[22][lane] * p.in[23][lane]);
  const float lam = expf(la) - expf(lb) + LAM_INIT;
  const int nblk = (int)gridDim.x;
  for (int it = vb0; it < 768; it += nblk) {
    const bool diff = (it < 256) || (it >= 512 && it < 640);
    const bool samp = it < 512;
    if (diff) {
      int qb, hh, b;
      if (samp) { qb = it & 31; hh = (it >> 5) & 3; b = it >> 7; }
      else { const int i2 = it - 512; qb = i2 & 1; hh = (i2 >> 1) & 3; b = i2 >> 3; }
      const int nseq = samp ? 4096 : 256, nkeys = samp ? 4608 : 256;
      const int tok = samp ? 4096 + b * 4096 + qb * 128 : b * 256 + qb * 128;
      const int hm = hh * 2 + half;
      const size_t qoff = (samp ? QS : 0) + ((size_t)(b * 8 + hm) * nseq + qb * 128) * 64;
      const u16* Kp = (samp ? CKS : CKP) + (size_t)(b * 8 + hm) * nkeys * 64;
      const u16* Vp = (samp ? CVTS : CVTP) + (size_t)(b * 4 + hh) * 128 * nkeys;
      attn_diff_pair(CQ + qoff, Kp, Vp, nkeys, nkeys >> 6, lam, p.in[24], AC + (size_t)tok * 1024 + hh * 128, shm, half);
    } else {
      int qb, hd, b;
      if (samp) { const int i2 = (it - 256) * 2 + half; qb = i2 & 31; hd = (i2 >> 5) & 7; b = i2 >> 8; }
      else { const int i2 = (it - 640) * 2 + half; qb = i2 & 1; hd = (i2 >> 1) & 7; b = i2 >> 4; }
      const int nseq = samp ? 4096 : 256, nkeys = samp ? 4608 : 256;
      const int tok = samp ? 4096 + b * 4096 + qb * 128 : b * 256 + qb * 128;
      const size_t qoff = (samp ? QS : 0) + ((size_t)(b * 8 + hd) * nseq + qb * 128) * 64;
      const u16* Kp = (samp ? DKS : DKP) + (size_t)(b * 2 + (hd >> 2)) * nkeys * 64;
      const u16* Vp = (samp ? DVTS : DVTP) + (size_t)(b * 2 + (hd >> 2)) * 64 * nkeys;
      int nt0 = 4, key1 = 0, nt1 = 0;
      if (samp) { const int lo = min(max(qb * 128 - 128, 0), 4096 - 384); nt0 = 8; key1 = 512 + lo; nt1 = 6; }
      attn_item<64>(DQ + qoff, Kp, Vp, nkeys, nt0, key1, nt1, samp, qb * 128, true, p.in[27][hd] * LOG2E, AC + (size_t)tok * 1024 + 512 + hd * 64, 1024, shm + half * LDS_BYTES);
    }
  }
}

namespace pg8 {
#define PG8_LAS __attribute__((address_space(3)))
typedef unsigned short bf16_t;
typedef short bf16x8 __attribute__((ext_vector_type(8)));
typedef float f32x4 __attribute__((ext_vector_type(4)));
typedef unsigned u32x4 __attribute__((ext_vector_type(4)));
constexpr int BM = 256, BK = 64, HALF = 128, HTB = HALF * BK * 2  , STAGE_BYTES = 8 * HTB, NXCD = 8, WGM = 8;

__host__ __device__ __forceinline__ int lds_byte(int r, int c) { const int st = (r >> 4) * 2 + (c >> 5), rr = r & 15, cc = c & 31, ob = rr * 64 + cc * 2; return st * 1024 + (ob ^ (((ob >> 9) & 1) << 5)); }
__host__ __device__ __forceinline__ void stage_rc(int b, int& R, int& C) { const int st = b / 1024, sb = b % 1024, swz = sb ^ (((sb >> 9) & 1) << 5); R = (st >> 1) * 16 + swz / 64; C = (st & 1) * 32 + (swz % 64) / 2; }
__host__ __device__ __forceinline__ int perm32(int rho) { const int n = rho >> 4, i = rho & 15; return 8 * (i >> 2) + 4 * n + (i & 3); }

struct Unit { int pm, pn; };
struct Gemm { const bf16_t* A; const bf16_t* Bt; int M, N, K; };

struct StaticOrder {
    int nM, nN, nwg, G, c;
    __host__ __device__ void init(int M, int N, int G_, int c_) { nM = M / BM; nN = N / BM; nwg = nM * nN; G = G_; c = c_; }
    __host__ __device__ bool next(int i, Unit& u) const {
        const long L = (long)i * G + c; if (L >= nwg) return false;
        int wgid = (int)L; { const int q = nwg / NXCD, r = nwg % NXCD, xcd = wgid % NXCD, off = wgid / NXCD; wgid = (xcd < r ? xcd * (q + 1) : r * (q + 1) + (xcd - r) * q) + off; }
        const int nig = WGM * nN, gid = wgid / nig, fm = gid * WGM, gsz = (nM - fm) < WGM ? (nM - fm) : WGM;
        u.pm = fm + ((wgid % nig) % gsz); u.pn = (wgid % nig) / gsz; return true;
    }
    __device__ __forceinline__ void a_ready(const Unit&) const {}
    __device__ __forceinline__ void done(const Unit&) const {}
};
template <class Epi, class Sched, bool STAMP = false, int MB = 4>
__device__ __forceinline__ void gemm_phase(PG8_LAS unsigned char* lds, const Gemm g, const Sched& S, const Epi& E, unsigned long long* stamps) {
    const int tid = threadIdx.x, wid = __builtin_amdgcn_readfirstlane(tid >> 6), lane = tid & 63, wr = wid >> 2, wc = wid & 3, fr = lane & 15, fq = lane >> 4;
    const int K = g.K, nt = K / BK;
    int ts_lo = 0, ts_hi = 0, nts = 0; const unsigned long long rt_entry = STAMP ? (unsigned long long)wall_clock64() : 0ull;
#define PG8_STAMP() do { if (STAMP && wid == 0 && nts < 64) { const unsigned long long _c = (unsigned long long)clock64(); \
        ts_lo = (lane == nts) ? (int)(unsigned)_c : ts_lo; ts_hi = (lane == nts) ? (int)(unsigned)(_c >> 32) : ts_hi; ++nts; } } while (0)
    PG8_STAMP();
    unsigned voffA[2], voffB[2], voffB1[2];
#pragma unroll
    for (int i = 0; i < 2; ++i) { int R, C; stage_rc(tid * 16 + i * 8192, R, C); const int Rb = Epi::PERM ? ((R & ~31) + perm32(R & 31)) : R;
        voffA[i] = (unsigned)(R * K + C) * 2u; voffB[i] = (unsigned)(Rb * K + C) * 2u; voffB1[i] = voffB[i];
        if constexpr (Epi::HEADPERM) {
            const int rho = R & 31, np = rho >> 4, ii = rho & 15, fqq = ii >> 2, jj = ii & 3;
            const int d0 = 64 * (R >> 5) + 32 * (fqq >> 1) + 8 * (fqq & 1) + 4 * np + jj;
            voffB[i] = (unsigned)(d0 * K + C) * 2u; voffB1[i] = (unsigned)((d0 + 16) * K + C) * 2u; } }
    const size_t hB1 = Epi::HEADPERM ? (size_t)0 : (size_t)HALF * K * 2;
    const size_t kstep = (size_t)(BK * 2);
    const size_t hstep = (size_t)HALF * K * 2; const size_t hstepA = (size_t)(32 * MB) * K * 2;
    const size_t tstep = 2 * hstep; const size_t tstepA = 2 * hstepA;
    const unsigned ldsw = (unsigned)wid * 1024u;
    const int aoff = lds_byte(wr * 16 * MB + fr, fq * 8), boff = lds_byte(wc * 32 + fr, fq * 8);
#define PG8_SA(b, h) (((b) * 2 + (h)) * HTB)
#define PG8_SB(b, h) ((4 + (b) * 2 + (h)) * HTB)
#define PG8_STAGE(bufoff, gbase, voff) do { _Pragma("unroll") for (int _i = 0; _i < 2; ++_i) \
        __builtin_amdgcn_global_load_lds((const unsigned*)((const char*)(gbase) + (voff)[_i]), (PG8_LAS unsigned*)(lds + (bufoff) + ldsw + _i * 8192), 16, 0, 0); } while (0)
#define PG8_LDA(dst, b, h) do { _Pragma("unroll") for (int m = 0; m < MB; ++m) _Pragma("unroll") for (int k = 0; k < 2; ++k) dst[m][k] = *(const PG8_LAS bf16x8*)(lds + PG8_SA(b, h) + aoff + m * 2048 + k * 1024); } while (0)
#define PG8_LDB(dst, b, h) do { _Pragma("unroll") for (int n = 0; n < 2; ++n) _Pragma("unroll") for (int k = 0; k < 2; ++k) dst[n][k] = *(const PG8_LAS bf16x8*)(lds + PG8_SB(b, h) + boff + n * 2048 + k * 1024); } while (0)
#define PG8_MMA(ai, bj, At, Bt) do { __builtin_amdgcn_s_setprio(1); _Pragma("unroll") for (int m = 0; m < MB; ++m) _Pragma("unroll") for (int n = 0; n < 2; ++n) _Pragma("unroll") for (int k = 0; k < 2; ++k) \
        acc[ai][bj][m][n] = __builtin_amdgcn_mfma_f32_16x16x32_bf16(Bt[n][k], At[m][k], acc[ai][bj][m][n], 0, 0, 0); __builtin_amdgcn_s_setprio(0); } while (0)
#define PG8_WAIT_V(n) asm volatile("s_waitcnt vmcnt(" #n ")" ::: "memory")
#define PG8_WAIT_L(n) asm volatile("s_waitcnt lgkmcnt(" #n ")" ::: "memory")
#define PG8_BAR __builtin_amdgcn_s_barrier()
#define PG8_SCHED __builtin_amdgcn_sched_barrier(0)
    Unit cur, nxt; int ui = 0;
    if (!S.next(0, cur)) return;
    f32x4 acc[2][2][MB][2];
#pragma unroll
    for (int a = 0; a < 2; ++a)
#pragma unroll
        for (int b = 0; b < 2; ++b)
#pragma unroll
            for (int m = 0; m < MB; ++m)
#pragma unroll
                for (int n = 0; n < 2; ++n) acc[a][b][m][n] = (f32x4){0.f, 0.f, 0.f, 0.f};
    bf16x8 At[MB][2], B0[2][2], B1[2][2];
    const char* cA = (const char*)g.A + (size_t)cur.pm * tstepA; const char* cB = (const char*)g.Bt + (size_t)cur.pn * tstep;
    S.a_ready(cur);
    PG8_STAGE(PG8_SB(0, 0), cB, voffB); PG8_STAGE(PG8_SA(0, 0), cA, voffA); PG8_STAGE(PG8_SB(0, 1), cB + hB1, voffB1); PG8_STAGE(PG8_SA(0, 1), cA + hstepA, voffA);
    if (wr == 1) PG8_BAR;
    PG8_WAIT_V(4); PG8_BAR;
    PG8_STAGE(PG8_SB(1, 0), cB + kstep, voffB); PG8_STAGE(PG8_SA(1, 0), cA + kstep, voffA); PG8_STAGE(PG8_SB(1, 1), cB + hB1 + kstep, voffB1);
    PG8_WAIT_V(6); PG8_BAR;
    PG8_STAMP();
    for (;;) {
        const bool has_next = S.next(ui + 1, nxt);
        const char* nA = has_next ? (const char*)g.A + (size_t)nxt.pm * tstepA : cA; const char* nB = has_next ? (const char*)g.Bt + (size_t)nxt.pn * tstep : cB;
        for (int t = 0; t < nt; t += 2) {
            const bool last = (t == nt - 2);
            const char* a1 = cA + (size_t)(t + 1) * kstep;
            const char* a2 = last ? nA : cA + (size_t)(t + 2) * kstep; const char* b2 = last ? nB : cB + (size_t)(t + 2) * kstep;
            const char* a3 = a2 + kstep; const char* b3 = b2 + kstep;
            if (last && has_next) S.a_ready(nxt);
            PG8_LDB(B0, 0, 0); PG8_SCHED; PG8_LDA(At, 0, 0); PG8_STAGE(PG8_SA(1, 1), a1 + hstepA, voffA);
            PG8_WAIT_L(8); PG8_BAR; PG8_WAIT_L(0); PG8_MMA(0, 0, At, B0); PG8_BAR; PG8_SCHED;
            PG8_LDB(B1, 0, 1); PG8_STAGE(PG8_SB(0, 0), b2, voffB);
            PG8_BAR; PG8_WAIT_L(0); PG8_MMA(0, 1, At, B1); PG8_BAR;
            PG8_LDA(At, 0, 1); PG8_STAGE(PG8_SA(0, 0), a2, voffA);
            PG8_BAR; PG8_WAIT_L(0); PG8_MMA(1, 0, At, B0); PG8_BAR; PG8_SCHED;
            PG8_STAGE(PG8_SB(0, 1), b2 + hB1, voffB1);
            PG8_WAIT_V(6); PG8_BAR; PG8_MMA(1, 1, At, B1); PG8_BAR;
            PG8_LDB(B0, 1, 0); PG8_SCHED; PG8_LDA(At, 1, 0); PG8_STAGE(PG8_SA(0, 1), a2 + hstepA, voffA);
            PG8_WAIT_L(8); PG8_BAR; PG8_WAIT_L(0); PG8_MMA(0, 0, At, B0); PG8_BAR; PG8_SCHED;
            PG8_LDB(B1, 1, 1); PG8_STAGE(PG8_SB(1, 0), b3, voffB);
            PG8_BAR; PG8_WAIT_L(0); PG8_MMA(0, 1, At, B1); PG8_BAR;
            PG8_LDA(At, 1, 1); PG8_STAGE(PG8_SA(1, 0), a3, voffA);
            PG8_BAR; PG8_WAIT_L(0); PG8_MMA(1, 0, At, B0); PG8_BAR; PG8_SCHED;
            PG8_STAGE(PG8_SB(1, 1), b3 + hB1, voffB1);
            PG8_WAIT_V(6); PG8_BAR; PG8_MMA(1, 1, At, B1); PG8_BAR;
        }
        PG8_STAMP();
        if constexpr (!Epi::AFTER_DRAIN) { E(acc, cur, wr, wc, fr, fq); S.done(cur); }
        PG8_STAMP();
        if (!has_next) break;
#pragma unroll
        for (int a = 0; a < 2; ++a)
#pragma unroll
            for (int b = 0; b < 2; ++b)
#pragma unroll
                for (int m = 0; m < MB; ++m)
#pragma unroll
                    for (int n = 0; n < 2; ++n) acc[a][b][m][n] = (f32x4){0.f, 0.f, 0.f, 0.f};
        cur = nxt; cA = nA; cB = nB; ++ui;
    }
    PG8_WAIT_V(0);
    if (wr == 0) PG8_BAR;
    PG8_BAR;
    if constexpr (Epi::AFTER_DRAIN) { E.fused(acc, cur, wr, wc, fr, fq, lds, wid, lane); S.done(cur); }
    PG8_STAMP();
    if (STAMP && wid == 0) { stamps[lane] = lane < nts ? (((unsigned long long)(unsigned)ts_hi << 32) | (unsigned)ts_lo) : 0ull;
        if (lane == 62) stamps[62] = rt_entry; if (lane == 63) stamps[63] = (unsigned long long)wall_clock64(); }
#undef PG8_STAMP
#undef PG8_SA
#undef PG8_SB
#undef PG8_STAGE
#undef PG8_LDA
#undef PG8_LDB
#undef PG8_MMA
#undef PG8_WAIT_V
#undef PG8_WAIT_L
#undef PG8_BAR
#undef PG8_SCHED
}
}

typedef float f32x4 __attribute__((ext_vector_type(4)));
template <class F, int MB> struct RowEpi {
  static constexpr bool PERM = false, AFTER_DRAIN = false, HEADPERM = false;
  F f;
  DI void operator()(const pg8::f32x4 (&acc)[2][2][MB][2], const pg8::Unit& u, int wr, int wc, int fr, int fq) const {
    const int row0 = u.pm * (64 * MB) + wr * 16 * MB + fr, col0 = u.pn * 256 + wc * 32 + 4 * fq;
#pragma unroll
    for (int ai = 0; ai < 2; ++ai)
#pragma unroll
      for (int m = 0; m < MB; ++m)
#pragma unroll
        for (int bj = 0; bj < 2; ++bj)
#pragma unroll
          for (int n = 0; n < 2; ++n) f(row0 + ai * 32 * MB + m * 16, col0 + bj * 128 + n * 16, acc[ai][bj][m][n]);
  }
};
struct FU {
  u16* UA; u16* PQt;
  DI void operator()(int m, int n, pg8::f32x4 v) const {
    if (n < 512) {
      uint2 w; w.x = pack2(v[0], v[1]); w.y = pack2(v[2], v[3]);
      *(uint2*)(UA + (size_t)m * 512 + n) = w;
    } else {
      const int np = n - 512, g = np >> 8, pq = (np >> 7) & 1, mm = np & 127;
      u16* q; size_t st;
      if (m < 4096) { const int b = m >> 8, nl = m & 255; q = PQt + ((size_t)(b * 512 + g * 128 + mm)) * 512 + pq * 256 + nl; st = 512; }
      else { const int ms = m - 4096, b = ms >> 12, nl = ms & 4095; q = PQt + (size_t)16 * 512 * 512 + ((size_t)(b * 512 + g * 128 + mm)) * 8192 + pq * 4096 + nl; st = 8192; }
      q[0] = f2bf(v[0]); q[st] = f2bf(v[1]); q[2 * st] = f2bf(v[2]); q[3 * st] = f2bf(v[3]);
    }
  }
};
struct FRes {
  const float* xin_p; const float* xin_s; float* X; const float* gate;
  DI void operator()(int m, int n, pg8::f32x4 v) const {
    const float* xi = (m < 4096) ? xin_p + (size_t)m * 1024 + n : xin_s + (size_t)(m - 4096) * 1024 + n;
    const float4 x = *(const float4*)xi;
    const float4 g = *(const float4*)(gate + cond_of(m) * 6144 + n);
    *(float4*)(X + (size_t)m * 1024 + n) = make_float4(x.x + g.x * v[0], x.y + g.y * v[1], x.z + g.z * v[2], x.w + g.w * v[3]);
  }
};
struct FRelu2 {
  u16* C;
  DI void operator()(int m, int n, pg8::f32x4 v) const {
    const float a = fmaxf(v[0], 0.f), b = fmaxf(v[1], 0.f), c = fmaxf(v[2], 0.f), d = fmaxf(v[3], 0.f);
    uint2 w; w.x = pack2(a * a, b * b); w.y = pack2(c * c, d * d);
    *(uint2*)(C + (size_t)m * 4096 + n) = w;
  }
};
struct FQkv {
  u16* QKV; u16* CVtP; u16* CVtS; u16* DVtP; u16* DVtS; float* ncv; float* ndv;
  DI void operator()(int m, int n, pg8::f32x4 v) const {
    const bool is_cv = (n >= 1024 && n < 1536), is_dv = (n >= 2176);
    if (!is_cv && !is_dv) {
      uint2 w; w.x = pack2(v[0], v[1]); w.y = pack2(v[2], v[3]);
      *(uint2*)(QKV + (size_t)m * 2304 + n) = w;
      return;
    }
    const int c = is_cv ? n - 1024 : n - 2176;
    const int feat = is_cv ? 512 : 128;
    u16* q; size_t st;
    if (m < 4096) {
      const int b = m >> 8, nl = m & 255;
      q = (is_cv ? CVtP : DVtP) + ((size_t)(b * feat + c)) * 256 + nl; st = 256;
      *(float4*)((is_cv ? ncv : ndv) + (size_t)m * feat + c) = make_float4(v[0], v[1], v[2], v[3]);
    } else {
      const int ms = m - 4096, b = ms >> 12, nl = ms & 4095;
      q = (is_cv ? CVtS : DVtS) + ((size_t)(b * feat + c)) * 4608 + 512 + nl; st = 4608;
    }
    q[0] = f2bf(v[0]); q[st] = f2bf(v[1]); q[2 * st] = f2bf(v[2]); q[3 * st] = f2bf(v[3]);
  }
};
template <int MB, class F>
DI void big_gemm(PG8_LAS unsigned char* lds, const u16* A, const u16* Bt, int M, int N, int K, F f) {
  pg8::Gemm g{A, Bt, M, N, K};
  pg8::StaticOrder S; S.init(M, N, (int)gridDim.x, (int)blockIdx.x);
  S.nM = M / (64 * MB); S.nwg = S.nM * S.nN;
  RowEpi<F, MB> E{f};
  pg8::gemm_phase<RowEpi<F, MB>, pg8::StaticOrder, false, MB>(lds, g, S, E, nullptr);
}

template <class F, int MB> struct RowEpi8 {
  static constexpr bool PERM = true, AFTER_DRAIN = false, HEADPERM = false;
  F f;
  DI void operator()(const pg8::f32x4 (&acc)[2][2][MB][2], const pg8::Unit& u, int wr, int wc, int fr, int fq) const {
    const int row0 = u.pm * (64 * MB) + wr * 16 * MB + fr, col0 = u.pn * 256 + wc * 32 + 8 * fq;
#pragma unroll
    for (int ai = 0; ai < 2; ++ai)
#pragma unroll
      for (int m = 0; m < MB; ++m)
#pragma unroll
        for (int bj = 0; bj < 2; ++bj) f(row0 + ai * 32 * MB + m * 16, col0 + bj * 128, acc[ai][bj][m][0], acc[ai][bj][m][1]);
  }
};
struct FRelu2x8 {
  u16* C;
  DI void operator()(int m, int n, pg8::f32x4 a, pg8::f32x4 b) const {
    uint4 w;
    float x0 = fmaxf(a[0], 0.f), x1 = fmaxf(a[1], 0.f), x2 = fmaxf(a[2], 0.f), x3 = fmaxf(a[3], 0.f);
    float y0 = fmaxf(b[0], 0.f), y1 = fmaxf(b[1], 0.f), y2 = fmaxf(b[2], 0.f), y3 = fmaxf(b[3], 0.f);
    w.x = pack2(x0 * x0, x1 * x1); w.y = pack2(x2 * x2, x3 * x3); w.z = pack2(y0 * y0, y1 * y1); w.w = pack2(y2 * y2, y3 * y3);
    *(uint4*)(C + (size_t)m * 4096 + n) = w;
  }
};
struct FUx8 {
  u16* UA; u16* PQt;
  DI void operator()(int m, int n, pg8::f32x4 a, pg8::f32x4 b) const {
    if (n < 512) {
      uint4 w; w.x = pack2(a[0], a[1]); w.y = pack2(a[2], a[3]); w.z = pack2(b[0], b[1]); w.w = pack2(b[2], b[3]);
      *(uint4*)(UA + (size_t)m * 512 + n) = w;
    } else {
      const int np = n - 512, g = np >> 8, pq = (np >> 7) & 1, mm = np & 127;
      u16* q; size_t st;
      if (m < 4096) { const int bb = m >> 8, nl = m & 255; q = PQt + ((size_t)(bb * 512 + g * 128 + mm)) * 512 + pq * 256 + nl; st = 512; }
      else { const int ms = m - 4096, bb = ms >> 12, nl = ms & 4095; q = PQt + (size_t)16 * 512 * 512 + ((size_t)(bb * 512 + g * 128 + mm)) * 8192 + pq * 4096 + nl; st = 8192; }
      q[0] = f2bf(a[0]); q[st] = f2bf(a[1]); q[2 * st] = f2bf(a[2]); q[3 * st] = f2bf(a[3]);
      q[4 * st] = f2bf(b[0]); q[5 * st] = f2bf(b[1]); q[6 * st] = f2bf(b[2]); q[7 * st] = f2bf(b[3]);
    }
  }
};
struct FQkvx8 {
  u16* QKV; u16* CVtP; u16* CVtS; u16* DVtP; u16* DVtS; float* ncv; float* ndv;
  DI void operator()(int m, int n, pg8::f32x4 a, pg8::f32x4 b) const {
    const bool is_cv = (n >= 1024 && n < 1536), is_dv = (n >= 2176);
    if (!is_cv && !is_dv) {
      uint4 w; w.x = pack2(a[0], a[1]); w.y = pack2(a[2], a[3]); w.z = pack2(b[0], b[1]); w.w = pack2(b[2], b[3]);
      *(uint4*)(QKV + (size_t)m * 2304 + n) = w;
      return;
    }
    const int c = is_cv ? n - 1024 : n - 2176;
    const int feat = is_cv ? 512 : 128;
    u16* q; size_t st;
    if (m < 4096) {
      const int bb = m >> 8, nl = m & 255;
      q = (is_cv ? CVtP : DVtP) + ((size_t)(bb * feat + c)) * 256 + nl; st = 256;
      float* o = (is_cv ? ncv : ndv) + (size_t)m * feat + c;
      *(float4*)o = make_float4(a[0], a[1], a[2], a[3]);
      *(float4*)(o + 4) = make_float4(b[0], b[1], b[2], b[3]);
    } else {
      const int ms = m - 4096, bb = ms >> 12, nl = ms & 4095;
      q = (is_cv ? CVtS : DVtS) + ((size_t)(bb * feat + c)) * 4608 + 512 + nl; st = 4608;
    }
    q[0] = f2bf(a[0]); q[st] = f2bf(a[1]); q[2 * st] = f2bf(a[2]); q[3 * st] = f2bf(a[3]);
    q[4 * st] = f2bf(b[0]); q[5 * st] = f2bf(b[1]); q[6 * st] = f2bf(b[2]); q[7 * st] = f2bf(b[3]);
  }
};
template <int MB, class F>
DI void big_gemm8(PG8_LAS unsigned char* lds, const u16* A, const u16* Bt, int M, int N, int K, F f) {
  pg8::Gemm g{A, Bt, M, N, K};
  pg8::StaticOrder S; S.init(M, N, (int)gridDim.x, (int)blockIdx.x);
  S.nM = M / (64 * MB); S.nwg = S.nM * S.nN;
  RowEpi8<F, MB> E{f};
  pg8::gemm_phase<RowEpi8<F, MB>, pg8::StaticOrder, false, MB>(lds, g, S, E, nullptr);
}

template <int MB> struct ResNormEpi {
  static constexpr bool PERM = false, AFTER_DRAIN = true, HEADPERM = false;
  const float* xin_p; const float* xin_s; float* X; const float* gate;
  const float* gain; const float* nmods; u16* Hout; float* part; unsigned* cnt;
  DI void operator()(const pg8::f32x4 (&)[2][2][MB][2], const pg8::Unit&, int, int, int, int) const {}
  DI void fused(pg8::f32x4 (&acc)[2][2][MB][2], const pg8::Unit& u, int wr, int wc, int fr, int fq, PG8_LAS unsigned char* lds, int wid, int lane) const {
    constexpr int ROWS = 64 * MB;
    const int tid = (int)threadIdx.x;
    const int rbase = u.pm * ROWS;
    const int row0 = rbase + wr * 16 * MB + fr, col0 = u.pn * 256 + wc * 32 + 4 * fq;
    PG8_LAS float* red = (PG8_LAS float*)lds;
    PG8_LAS float* rinvs = red + ROWS * 4;
#pragma unroll
    for (int ai = 0; ai < 2; ++ai)
#pragma unroll
      for (int m = 0; m < MB; ++m) {
        const int row = row0 + ai * 32 * MB + m * 16;
        const float* xi = (row < 4096) ? xin_p + (size_t)row * 1024 : xin_s + (size_t)(row - 4096) * 1024;
        const float* gp = gate + cond_of(row) * 6144;
        float ss = 0.f;
#pragma unroll
        for (int bj = 0; bj < 2; ++bj)
#pragma unroll
          for (int n = 0; n < 2; ++n) {
            const int col = col0 + bj * 128 + n * 16;
            const float4 x = *(const float4*)(xi + col);
            const float4 g = *(const float4*)(gp + col);
            pg8::f32x4 v = acc[ai][bj][m][n];
            v[0] = x.x + g.x * v[0]; v[1] = x.y + g.y * v[1]; v[2] = x.z + g.z * v[2]; v[3] = x.w + g.w * v[3];
            *(float4*)(X + (size_t)row * 1024 + col) = make_float4(v[0], v[1], v[2], v[3]);
            acc[ai][bj][m][n] = v;
            ss += v[0] * v[0] + v[1] * v[1] + v[2] * v[2] + v[3] * v[3];
          }
        ss += __shfl_xor(ss, 16); ss += __shfl_xor(ss, 32);
        if (fq == 0) red[(row - rbase) * 4 + wc] = ss;
      }
    __syncthreads();
    if (tid < ROWS) {
      const float sum = (red[tid * 4] + red[tid * 4 + 1]) + (red[tid * 4 + 2] + red[tid * 4 + 3]);
      __hip_atomic_store(part + (size_t)u.pn * T + rbase + tid, sum, __ATOMIC_RELAXED, __HIP_MEMORY_SCOPE_AGENT);
    }
    asm volatile("s_waitcnt vmcnt(0)" ::: "memory");
    __syncthreads();
    if (tid == 0) {
      unsigned* c = cnt + (size_t)u.pm * 16;
      __hip_atomic_fetch_add(c, 1u, __ATOMIC_RELAXED, __HIP_MEMORY_SCOPE_AGENT);
      unsigned sp = 0;
      while (__hip_atomic_load(c, __ATOMIC_RELAXED, __HIP_MEMORY_SCOPE_AGENT) < 4u) { __builtin_amdgcn_s_sleep(1); if (++sp > (1u << 22)) break; }
      __builtin_amdgcn_fence(__ATOMIC_ACQUIRE, "agent");
      asm volatile("s_waitcnt vmcnt(0)" ::: "memory");
    }
    __syncthreads();
    if (tid < ROWS) {
      const float* pp = part + rbase + tid;
      const float tot = (__hip_atomic_load(pp, __ATOMIC_RELAXED, __HIP_MEMORY_SCOPE_AGENT) + __hip_atomic_load(pp + T, __ATOMIC_RELAXED, __HIP_MEMORY_SCOPE_AGENT)) +
                        (__hip_atomic_load(pp + 2 * T, __ATOMIC_RELAXED, __HIP_MEMORY_SCOPE_AGENT) + __hip_atomic_load(pp + 3 * T, __ATOMIC_RELAXED, __HIP_MEMORY_SCOPE_AGENT));
      rinvs[tid] = rsqrtf(tot * (1.0f / 1024.0f) + EPS);
    }
    __syncthreads();
#pragma unroll
    for (int ai = 0; ai < 2; ++ai)
#pragma unroll
      for (int m = 0; m < MB; ++m) {
        const int row = row0 + ai * 32 * MB + m * 16;
        const float rv = rinvs[row - rbase];
        const float* md = nmods + cond_of(row) * 6144;
#pragma unroll
        for (int bj = 0; bj < 2; ++bj)
#pragma unroll
          for (int n = 0; n < 2; ++n) {
            const int col = col0 + bj * 128 + n * 16;
            const float4 g = *(const float4*)(gain + col);
            const float4 sh = *(const float4*)(md + col);
            const float4 sc = *(const float4*)(md + 1024 + col);
            const pg8::f32x4 v = acc[ai][bj][m][n];
            uint2 w;
            w.x = pack2(v[0] * rv * g.x * (1.f + sc.x) + sh.x, v[1] * rv * g.y * (1.f + sc.y) + sh.y);
            w.y = pack2(v[2] * rv * g.z * (1.f + sc.z) + sh.z, v[3] * rv * g.w * (1.f + sc.w) + sh.w);
            *(uint2*)(Hout + (size_t)row * 1024 + col) = w;
          }
      }
    __syncthreads();
  }
};
template <int MB>
DI void big_gemm_resnorm(PG8_LAS unsigned char* lds, const u16* A, const u16* Bt, int M, int N, int K, ResNormEpi<MB> E) {
  pg8::Gemm g{A, Bt, M, N, K};
  pg8::StaticOrder S; S.init(M, N, (int)gridDim.x, (int)blockIdx.x);
  S.nM = M / (64 * MB); S.nwg = S.nM * S.nN;
  pg8::gemm_phase<ResNormEpi<MB>, pg8::StaticOrder, false, MB>(lds, g, S, E, nullptr);
}

struct QkvHeadEpi {
  static constexpr bool PERM = false, AFTER_DRAIN = false, HEADPERM = true;
  unsigned char* ws; float* out;
  const float* cqn; const float* ckn; const float* dqn; const float* dkn;
  DI void operator()(const pg8::f32x4 (&acc)[2][2][4][2], const pg8::Unit& u, int wr, int wc, int fr, int fq) const {
    const int hd = u.pn * 4 + wc;
    const int ax = fq >> 1;
    const int dlo = 32 * ax + 8 * (fq & 1);
    const bool isv = (hd >= 16 && hd < 24) || hd >= 34;
    const bool isq = hd < 8 || (hd >= 24 && hd < 32);
    float g0[8], g1[8], frq[8];
#pragma unroll
    for (int e = 0; e < 8; ++e) { g0[e] = 1.f; g1[e] = 1.f; }
    if (hd < 8) {
#pragma unroll
      for (int e = 0; e < 8; ++e) { g0[e] = cqn[dlo + e]; g1[e] = cqn[dlo + 16 + e]; }
    } else if (hd < 16) {
#pragma unroll
      for (int e = 0; e < 8; ++e) { g0[e] = ckn[dlo + e]; g1[e] = ckn[dlo + 16 + e]; }
    } else if (hd >= 24 && hd < 32) {
#pragma unroll
      for (int e = 0; e < 8; ++e) { g0[e] = dqn[dlo + e]; g1[e] = dqn[dlo + 16 + e]; }
    } else if (hd >= 32 && hd < 34) {
#pragma unroll
      for (int e = 0; e < 8; ++e) { g0[e] = dkn[dlo + e]; g1[e] = dkn[dlo + 16 + e]; }
    }
#pragma unroll
    for (int e = 0; e < 8; ++e) {
      frq[e] = exp2f(-(float)(8 * (fq & 1) + e) * (13.287712379549449f / 16.0f)) * 0.15915494309189535f;
    }
    const int row00 = u.pm * 256 + wr * 64 + fr;
    const bool samp = row00 >= 4096;
#pragma unroll
    for (int ai = 0; ai < 2; ++ai)
#pragma unroll
      for (int m = 0; m < 4; ++m) {
        const int row = row00 + ai * 128 + m * 16;
        int b, nl;
        if (!samp) { b = row >> 8; nl = row & 255; } else { b = (row - 4096) >> 12; nl = (row - 4096) & 4095; }
        float x0[8], x1[8];
#pragma unroll
        for (int e = 0; e < 8; ++e) { x0[e] = acc[ai][0][m][e >> 2][e & 3]; x1[e] = acc[ai][1][m][e >> 2][e & 3]; }
        if (isv) {
          const bool cvh = hd < 24;
          const int feat = cvh ? 512 : 128;
          const int c = (cvh ? (hd - 16) : (hd - 34)) * 64 + dlo;
          u16* q; size_t st;
          if (!samp) {
            q = (u16*)(ws + (cvh ? OFF_CVTP : OFF_DVTP)) + ((size_t)(b * feat + c)) * 256 + nl; st = 256;
            float* o = out + (cvh ? OUT_NCV : OUT_NDV) + (size_t)row * feat + c;
            *(float4*)o = make_float4(x0[0], x0[1], x0[2], x0[3]); *(float4*)(o + 4) = make_float4(x0[4], x0[5], x0[6], x0[7]);
            *(float4*)(o + 16) = make_float4(x1[0], x1[1], x1[2], x1[3]); *(float4*)(o + 20) = make_float4(x1[4], x1[5], x1[6], x1[7]);
          } else { q = (u16*)(ws + (cvh ? OFF_CVTS : OFF_DVTS)) + ((size_t)(b * feat + c)) * 4608 + 512 + nl; st = 4608; }
#pragma unroll
          for (int e = 0; e < 8; ++e) { q[e * st] = f2bf(x0[e]); q[(16 + e) * st] = f2bf(x1[e]); }
        } else {
          float ss = 0.f;
#pragma unroll
          for (int e = 0; e < 8; ++e) ss += x0[e] * x0[e] + x1[e] * x1[e];
          ss += __shfl_xor(ss, 16); ss += __shfl_xor(ss, 32);
          const float rinv = rsqrtf(ss * (1.0f / 64.0f) + EPS);
          float o0[8], o1[8];
          const float pos = samp ? (float)(ax ? (nl & 63) : (nl >> 6)) : 0.f;
#pragma unroll
          for (int e = 0; e < 8; ++e) {
            const float y0 = x0[e] * rinv * g0[e], y1 = x1[e] * rinv * g1[e];
            const float rev = pos * frq[e];
            const float cs = samp ? __builtin_amdgcn_cosf(rev) : 1.f, sn = samp ? __builtin_amdgcn_sinf(rev) : 0.f;
            o0[e] = y0 * cs - y1 * sn;
            o1[e] = y1 * cs + y0 * sn;
          }
          if (isq) {
            const int head = hd < 8 ? hd : hd - 24;
            u16* dst = (u16*)(ws + (hd < 8 ? OFF_CQ : OFF_DQ)) + (samp ? (size_t)16 * 8 * 256 * 64 + ((size_t)(b * 8 + head) * 4096 + nl) * 64 : ((size_t)(b * 8 + head) * 256 + nl) * 64) + dlo;
            *(uint4*)dst = make_uint4(pack2(o0[0] * QSCALE, o0[1] * QSCALE), pack2(o0[2] * QSCALE, o0[3] * QSCALE), pack2(o0[4] * QSCALE, o0[5] * QSCALE), pack2(o0[6] * QSCALE, o0[7] * QSCALE));
            *(uint4*)(dst + 16) = make_uint4(pack2(o1[0] * QSCALE, o1[1] * QSCALE), pack2(o1[2] * QSCALE, o1[3] * QSCALE), pack2(o1[4] * QSCALE, o1[5] * QSCALE), pack2(o1[6] * QSCALE, o1[7] * QSCALE));
          } else {
            const bool ckh = hd < 16;
            const int kh = ckh ? hd - 8 : hd - 32, nkh = ckh ? 8 : 2;
            u16* dst = samp ? (u16*)(ws + (ckh ? OFF_CKS : OFF_DKS)) + ((size_t)(b * nkh + kh) * 4608 + 512 + nl) * 64 + dlo
                            : (u16*)(ws + (ckh ? OFF_CKP : OFF_DKP)) + ((size_t)(b * nkh + kh) * 256 + nl) * 64 + dlo;
            *(uint4*)dst = make_uint4(pack2(o0[0], o0[1]), pack2(o0[2], o0[3]), pack2(o0[4], o0[5]), pack2(o0[6], o0[7]));
            *(uint4*)(dst + 16) = make_uint4(pack2(o1[0], o1[1]), pack2(o1[2], o1[3]), pack2(o1[4], o1[5]), pack2(o1[6], o1[7]));
            if (!samp) {
              float* o = out + (ckh ? OUT_NCK + (size_t)row * 512 : OUT_NDK + (size_t)row * 128) + kh * 64 + dlo;
              *(float4*)o = make_float4(o0[0], o0[1], o0[2], o0[3]); *(float4*)(o + 4) = make_float4(o0[4], o0[5], o0[6], o0[7]);
              *(float4*)(o + 16) = make_float4(o1[0], o1[1], o1[2], o1[3]); *(float4*)(o + 20) = make_float4(o1[4], o1[5], o1[6], o1[7]);
            }
          }
        }
      }
  }
};
DI void big_gemm_qkv(PG8_LAS unsigned char* lds, const u16* A, const u16* Bt, int M, int N, int K, QkvHeadEpi E) {
  pg8::Gemm g{A, Bt, M, N, K};
  pg8::StaticOrder S; S.init(M, N, (int)gridDim.x, (int)blockIdx.x);
  pg8::gemm_phase<QkvHeadEpi, pg8::StaticOrder, false, 4>(lds, g, S, E, nullptr);
}

#define XB_TMO      128
#define XB_XCNT(j)  (256  + 64 * (j))
#define XB_XSUB(j)  (1280 + 64 * (j))
#define XB_XGEN(j)  (2304 + 64 * (j))
#define XB_TOP      3328
#define XB_TOPGEN   3392
#define XCD_BAR_WORDS 3456
#define XB_SPIN_CAP (1u << 18)
#define LAS __attribute__((address_space(3)))
DI unsigned xb_ld(unsigned* p)              { return __hip_atomic_load(p, __ATOMIC_RELAXED, __HIP_MEMORY_SCOPE_AGENT); }
DI unsigned xb_add(unsigned* p, unsigned v) { return __hip_atomic_fetch_add(p, v, __ATOMIC_RELAXED, __HIP_MEMORY_SCOPE_AGENT); }
DI unsigned xb_xcc_id() { return (unsigned)__builtin_amdgcn_s_getreg((3 << 11) | 20) & 0xFu; }
#define XB_SPIN(cond, bar) do { unsigned _sp = 0; while (cond) { __builtin_amdgcn_s_sleep(1); \
    if ((++_sp & 255u) == 0u) { if (xb_ld(&(bar)[XB_TMO])) break; if (_sp > XB_SPIN_CAP) { atomicAdd(&(bar)[XB_TMO], 1u); break; } } } } while (0)
struct XcdBarrier { unsigned* bar; unsigned x; volatile LAS unsigned* st; };
DI XcdBarrier xcd_barrier_post(unsigned* bar, volatile LAS unsigned* st) {
  XcdBarrier b; b.bar = bar; b.x = xb_xcc_id(); b.st = st;
  if (threadIdx.x == 0) (void)xb_add(&bar[XB_XCNT(b.x)], 1u);
  return b;
}
DI void xcd_barrier_complete(unsigned* bar, unsigned x, unsigned& nloc, unsigned& nx) {
  const unsigned G = gridDim.x;
  unsigned sum, cnt, mine, sp = 0u;
  for (;;) {
    sum = 0u; cnt = 0u; mine = 0u;
#pragma unroll
    for (unsigned j = 0; j < 16; ++j) { const unsigned c = xb_ld(&bar[XB_XCNT(j)]); sum += c; cnt += (c > 0u) ? 1u : 0u; mine = (j == x) ? c : mine; }
    if (sum == G) break;
    __builtin_amdgcn_s_sleep(1);
    if ((++sp & 255u) == 0u) { if (xb_ld(&bar[XB_TMO])) break; if (sp > XB_SPIN_CAP) { atomicAdd(&bar[XB_TMO], 1u); break; } }
  }
  nloc = mine > 0u ? mine : 1u; nx = cnt > 0u ? cnt : 1u;
}
DI void xcd_barrier(const XcdBarrier& b) {
  asm volatile("s_waitcnt vmcnt(0)" ::: "memory");
  __syncthreads();
  if (threadIdx.x == 0) {
    unsigned* bar = b.bar;
    __builtin_amdgcn_s_waitcnt(0);
    unsigned nloc = b.st[0], nx = b.st[1];
    if (nloc == 0u) { xcd_barrier_complete(bar, b.x, nloc, nx); b.st[0] = nloc; b.st[1] = nx; }
    const unsigned old = xb_add(&bar[XB_XSUB(b.x)], 1u);
    const unsigned gen = old / nloc;
    if (old + 1u == (gen + 1u) * nloc) {
      __builtin_amdgcn_fence(__ATOMIC_RELEASE, "agent");
      asm volatile("s_waitcnt vmcnt(0)" ::: "memory");
      const unsigned og = xb_add(&bar[XB_TOP], 1u);
      const unsigned tg = og / nx;
      if (og + 1u == (tg + 1u) * nx) xb_add(&bar[XB_TOPGEN], 1u);
      else XB_SPIN(xb_ld(&bar[XB_TOPGEN]) == tg, bar);
      __builtin_amdgcn_fence(__ATOMIC_ACQUIRE, "agent");
      xb_add(&bar[XB_XGEN(b.x)], 1u);
      asm volatile("s_waitcnt vmcnt(0)" ::: "memory");
    } else {
      XB_SPIN(xb_ld(&bar[XB_XGEN(b.x)]) == gen, bar);
      __builtin_amdgcn_fence(__ATOMIC_ACQUIRE, "agent");
      asm volatile("s_waitcnt vmcnt(0)" ::: "memory");
    }
  }
  __syncthreads();
}

__global__ void __launch_bounds__(512) fwd_kernel(Params p, int ph_lo, int ph_hi, int dup) {
  extern __shared__ __attribute__((aligned(16))) unsigned char shm[];
  const int half = threadIdx.x >> 8;
  char* lds = (char*)shm + half * LDS_BYTES;
  PG8_LAS unsigned char* lds8 = (PG8_LAS unsigned char*)shm;
  const int G = 2 * (int)gridDim.x;
  int vb0 = blockIdx.x;
  if ((gridDim.x & 7) == 0) vb0 = (blockIdx.x & 7) * (gridDim.x >> 3) + (blockIdx.x >> 3);
  const int vb = 2 * vb0 + half;
  unsigned char* ws = p.ws;
  const float* mods = (const float*)(ws + OFF_MODS);
  float* X = p.out + OUT_Y;
  u16* H = (u16*)(ws + OFF_H);

#define RUNPH(n) ((ONLYPH < 0 || ONLYPH == (n)) && ph_lo <= (n) && (n) < ph_hi)
#define REP(n) _Pragma("unroll 1") for (int rep_ = 0; rep_ < ((DUPPH == (n)) ? ((dup == (n)) ? 2 : 1) : 1); ++rep_)
#define SEAM(n) if (ph_lo < (n) && (n) < ph_hi) xcd_barrier(xb);
  __shared__ uint4 xb_words;
  if (threadIdx.x == 0) xb_words = make_uint4(0u, 0u, 0u, 0u);
  __syncthreads();
  XcdBarrier xb = xcd_barrier_post((unsigned*)(ws + OFF_BAR), (volatile LAS unsigned*)&xb_words);
  if (ph_hi > 1000) cg::this_grid().sync();
  if (RUNPH(0)) REP(0) {
    for (int id = vb; id < 384; id += G) ada_item(p, id, lds);
    prep_transposes(p, vb, G, lds, 0);
    prep_elementwise(p, vb, G);
  }
  SEAM(1)
  if (RUNPH(1)) REP(1) {
    for (int t = vb; t < 128; t += G) {
      const bool f1 = t < 64;
      const int q = t & 63, m0 = (q >> 3) << 7, n0 = (q & 7) << 7;
      const int koff = f1 ? (m0 >> 8) * 128 : n0;
      gemm_tile((f1 ? (const u16*)(ws + OFF_CBD) : (const u16*)(ws + OFF_WOUT_ET)) + koff, f1 ? 512 : 1024,
                (f1 ? (const u16*)(ws + OFF_WINB) : (const u16*)(ws + OFF_BD)) + koff, f1 ? 512 : 1024, 128, m0, n0,
                EpiBf16{f1 ? (u16*)(ws + OFF_WIN_E) + (size_t)512 * 1024 : (u16*)(ws + OFF_WOUT_E), 1024}, lds);
    }
    normmod_phase(p, vb, G, p.in[0], p.in[1], p.in[8], 0, 0);
    if (vb >= 128) prep_transposes(p, vb - 128, G - 128, lds, 1);
  }
  SEAM(2)
  if (RUNPH(2)) REP(2)
    big_gemm8<3>(lds8, H, (const u16*)(ws + OFF_WIN_E), T, 1536, 1024, FUx8{(u16*)(ws + OFF_UA), (u16*)(ws + OFF_PQT)});
  SEAM(3)
  if (RUNPH(3)) REP(3) sym_phase(p, vb, G);
  SEAM(4)
  if (RUNPH(4)) REP(4) {
    const u16* PQT = (const u16*)(ws + OFF_PQT);
    const u16* PEQO = (const u16*)(ws + OFF_PEQO);
    for (int t = vb0; t < 256 + 128; t += (int)gridDim.x) {
      const bool big = t < 256;
      const int q = t - 256, b = q >> 3;
      dft_pair(big ? (const u16*)(ws + OFF_D4096) : (const u16*)(ws + OFF_D256),
               big ? PEQO + (size_t)16 * 512 * 256 : PEQO + (size_t)b * 512 * 256,
               big ? PQT + (size_t)16 * 512 * 512 + 2048 : PQT + (size_t)b * 512 * 512 + 128,
               big ? 8192 : 512, big ? 2048 : 128, big ? (t & 15) << 7 : 0, big ? (t >> 4) << 6 : (q & 7) << 6,
               (u16*)(ws + OFF_AB), big ? 4096 : b * 256, 512, big ? 0.0013810679320049757f : 0.005524271728019903f, (char*)shm, half);
    }
    pool_phase(p, vb, G);
  }
  float* PART = (float*)(ws + OFF_PART);
  unsigned* CNT = (unsigned*)(ws + OFF_CNT);
  SEAM(5)
  if (RUNPH(5))
    big_gemm_resnorm<3>(lds8, (const u16*)(ws + OFF_AB), (const u16*)(ws + OFF_WOUT_E), T, 1024, 1024,
                        ResNormEpi<3>{p.in[0], p.in[1], X, mods + 2048, p.in[9], mods + 3072, H, PART, CNT});
  SEAM(6)
  if (RUNPH(6)) REP(6) big_gemm8<4>(lds8, H, (const u16*)(ws + OFF_W1), T, 4096, 1024, FRelu2x8{(u16*)(ws + OFF_M1)});
  SEAM(7)
  if (RUNPH(7))
    big_gemm_resnorm<3>(lds8, (const u16*)(ws + OFF_M1), (const u16*)(ws + OFF_W2), T, 1024, 4096,
                        ResNormEpi<3>{X, X + (size_t)4096 * 1024, X, mods + 5120, p.in[8] + 1024, mods + 3 * 6144, H, PART + (size_t)4 * T, CNT + 64 * 16});
  SEAM(8)
  if (RUNPH(8)) {
    big_gemm_qkv(lds8, H, (const u16*)(ws + OFF_WIN_O), T, 2304, 1024,
                 QkvHeadEpi{ws, p.out, p.in[18], p.in[19], p.in[25], p.in[26]});
    if (blockIdx.x >= 176) cache_convert(p, ((int)blockIdx.x - 176) * 2 + half, ((int)gridDim.x - 176) * 2);
  }
  SEAM(9)
  if (RUNPH(9)) REP(9) attention_phase(p, vb0, half, (char*)shm);
  SEAM(10)
  if (RUNPH(10))
    big_gemm_resnorm<3>(lds8, H, (const u16*)(ws + OFF_WOUT_O), T, 1024, 1024,
                        ResNormEpi<3>{X, X + (size_t)4096 * 1024, X, mods + 3 * 6144 + 2048, p.in[9] + 1024, mods + 3 * 6144 + 3072, (u16*)(ws + OFF_R2), PART + (size_t)8 * T, CNT + 128 * 16});
  SEAM(11)
  if (RUNPH(11)) REP(11) big_gemm8<4>(lds8, (const u16*)(ws + OFF_R2), (const u16*)(ws + OFF_W1) + (size_t)4096 * 1024, T, 4096, 1024, FRelu2x8{(u16*)(ws + OFF_M1)});
  SEAM(12)
  if (RUNPH(12)) REP(12) big_gemm<3>(lds8, (const u16*)(ws + OFF_M1), (const u16*)(ws + OFF_W2) + (size_t)4096 * 1024, T, 1024, 4096, FRes{X, X + (size_t)4096 * 1024, rep_ ? (float*)(ws + OFF_R2) : X, mods + 3 * 6144 + 5120});
}

extern "C" void kernel_launch(void* const* d_in, const int* in_sizes, int n_in, void* d_out, int out_size, void* d_ws, size_t ws_size,
                              hipStream_t stream) {
  constexpr int kDynLds = 2 * LDS_BYTES;
  static int grid = 0;
  if (!grid) {
    int dev = 0, cus = 0, per_cu = 0;
    (void)hipGetDevice(&dev);
    (void)hipDeviceGetAttribute(&cus, hipDeviceAttributeMultiprocessorCount, dev);
    if (hipFuncSetAttribute((const void*)fwd_kernel, hipFuncAttributeMaxDynamicSharedMemorySize, kDynLds) != hipSuccess) fprintf(stderr, "hipFuncSetAttribute(%d) failed\n", kDynLds);
    (void)hipOccupancyMaxActiveBlocksPerMultiprocessor(&per_cu, fwd_kernel, 512, kDynLds);
    if (per_cu < 1) fprintf(stderr, "occupancy query says %d blocks/CU\n", per_cu);
    grid = cus;
    if (ws_size < WS_END) fprintf(stderr, "workspace too small: %zu < %zu\n", ws_size, (size_t)WS_END);
  }
  Params p{};
  for (int i = 0; i < 31; ++i) p.in[i] = (const float*)d_in[i];
  p.out = (float*)d_out;
  p.ws = (unsigned char*)d_ws;
#if ONE_LAUNCH
  hipMemsetAsync((char*)d_ws + OFF_BAR, 0, XCD_BAR_WORDS * 4 + CNT_BYTES, stream);
  int lo = 0, hi = NPH, dup = DUPPH;
  void* args[] = {&p, &lo, &hi, &dup};
  hipError_t e = hipLaunchCooperativeKernel((void*)fwd_kernel, dim3(grid), dim3(512), args, kDynLds, stream);
  if (e != hipSuccess) fprintf(stderr, "cooperative launch failed: %s (grid %d)\n", hipGetErrorString(e), grid);
#else
  for (int ph = 0; ph < NPH; ++ph) hipLaunchKernelGGL(fwd_kernel, dim3(grid), dim3(512), kDynLds, stream, p, ph, ph + 1, -1);
#endif
}
```

```cpp
#include <hip/hip_runtime.h>
#include <hip/hip_cooperative_groups.h>
#include <cstdio>
namespace cg = cooperative_groups;

#ifndef ONE_LAUNCH
#define ONE_LAUNCH 1
#endif

#ifndef ONLYPH
#define ONLYPH -1
#endif
#ifndef DUPPH
#define DUPPH -1
#endif
typedef unsigned short u16;
typedef short bf16x8 __attribute__((ext_vector_type(8)));
typedef float f32x16 __attribute__((ext_vector_type(16)));
typedef __bf16 bf2_t __attribute__((ext_vector_type(2)));
typedef float f2_t __attribute__((ext_vector_type(2)));
typedef unsigned u32x4 __attribute__((ext_vector_type(4)));

#define DI __device__ __forceinline__
#define TIDX ((int)(threadIdx.x & 255u))

constexpr int T = 12288, TP = 4096, DM = 1024;
constexpr int NPH = 13;
constexpr float EPS = 1e-6f;
constexpr float LOG2E = 1.4426950408889634f;
constexpr float QSCALE = 0.125f * LOG2E;
constexpr float LAM_INIT = 0.35550906759f;

constexpr size_t al(size_t x) { return (x + 255) & ~size_t(255); }
constexpr size_t OFF_MODS   = 0;
constexpr size_t OFF_WIN_E  = OFF_MODS + al(2 * 3 * 6144 * 4);
constexpr size_t OFF_WINB   = OFF_WIN_E + al(1536 * 1024 * 2);
constexpr size_t OFF_CBD    = OFF_WINB + al(1024 * 512 * 2);
constexpr size_t OFF_WOUT_ET= OFF_CBD + al(1024 * 512 * 2);
constexpr size_t OFF_BD     = OFF_WOUT_ET + al(1024 * 1024 * 2);
constexpr size_t OFF_WOUT_E = OFF_BD + al(1024 * 1024 * 2);
constexpr size_t OFF_WIN_O  = OFF_WOUT_E + al(1024 * 1024 * 2);
constexpr size_t OFF_WOUT_O = OFF_WIN_O + al(2304 * 1024 * 2);
constexpr size_t OFF_W1     = OFF_WOUT_O + al(1024 * 1024 * 2);
constexpr size_t OFF_W2     = OFF_W1 + al(2 * 4096 * 1024 * 2);
constexpr size_t OFF_D256   = OFF_W2 + al(2 * 4096 * 1024 * 2);
constexpr size_t OFF_H      = OFF_D256 + al(256 * 512 * 2);
constexpr size_t OFF_R2     = OFF_H + al((size_t)T * 1024 * 2);
constexpr size_t R2_BYTES   = (size_t)T * 512 * 2 + (size_t)T * 1024 * 2 * 2;
constexpr size_t OFF_R1     = OFF_R2 + al(R2_BYTES);
constexpr size_t R1_BYTES   = (size_t)T * 4096 * 2;
constexpr size_t OFF_BAR    = OFF_R1 + R1_BYTES;
constexpr size_t OFF_CNT    = OFF_BAR + 3456 * 4;
constexpr size_t CNT_BYTES  = 3 * 64 * 64;
constexpr size_t OFF_PART   = OFF_CNT + CNT_BYTES;
constexpr size_t WS_END     = OFF_PART + (size_t)3 * 4 * T * 4;
constexpr size_t OFF_UA  = OFF_R2;
constexpr size_t OFF_PQT = OFF_UA + (size_t)T * 512 * 2;
constexpr size_t OFF_AB  = OFF_PQT + (size_t)T * 1024 * 2;
constexpr size_t OFF_CQ   = OFF_R2;
constexpr size_t OFF_DQ   = OFF_CQ + (size_t)T * 512 * 2;
constexpr size_t OFF_CKP  = OFF_DQ + (size_t)T * 512 * 2;
constexpr size_t OFF_CKS  = OFF_CKP + (size_t)16 * 8 * 256 * 64 * 2;
constexpr size_t OFF_CVTP = OFF_CKS + (size_t)2 * 8 * 4608 * 64 * 2;
constexpr size_t OFF_CVTS = OFF_CVTP + (size_t)16 * 4 * 128 * 256 * 2;
constexpr size_t OFF_DKP  = OFF_CVTS + (size_t)2 * 4 * 128 * 4608 * 2;
constexpr size_t OFF_DKS  = OFF_DKP + (size_t)16 * 2 * 256 * 64 * 2;
constexpr size_t OFF_DVTP = OFF_DKS + (size_t)2 * 2 * 4608 * 64 * 2;
constexpr size_t OFF_DVTS = OFF_DVTP + (size_t)16 * 2 * 64 * 256 * 2;
constexpr size_t R2_LATE_END = OFF_DVTS + (size_t)2 * 2 * 64 * 4608 * 2;
static_assert(R2_LATE_END <= OFF_R2 + R2_BYTES, "R2 overflow");
constexpr size_t OFF_D4096 = OFF_R1;
constexpr size_t OFF_PEQO  = OFF_R1 + (size_t)32 * 1024 * 1024;
constexpr size_t OFF_M1    = OFF_R1;
constexpr size_t OFF_QKV   = OFF_R1;
constexpr size_t OFF_OM    = OFF_R1 + al((size_t)T * 2304 * 2);
static_assert(OFF_OM + (size_t)T * 1024 * 2 <= WS_END, "R1 overflow");

constexpr size_t OUT_Y   = 0;
constexpr size_t OUT_NCK = (size_t)T * 1024;
constexpr size_t OUT_NCV = OUT_NCK + (size_t)TP * 512;
constexpr size_t OUT_NDK = OUT_NCV + (size_t)TP * 512;
constexpr size_t OUT_NDV = OUT_NDK + (size_t)TP * 128;

struct Params {
  const float* in[31];
  float* out;
  unsigned char* ws;
};

DI float bf2f(u16 v) { return __uint_as_float(((unsigned)v) << 16); }
DI unsigned pack2(float a, float b) { f2_t f = {a, b}; bf2_t v = __builtin_convertvector(f, bf2_t); return __builtin_bit_cast(unsigned, v); }
DI u16 f2bf(float a) { return (u16)(pack2(a, 0.f) & 0xffffu); }
DI int cond_of(int m) { return m < 4096 ? 0 : (m < 8192 ? 1 : 2); }
DI float wave_sum(float v) {
#pragma unroll
  for (int o = 32; o >= 1; o >>= 1) v += __shfl_xor(v, o);
  return v;
}
#define MFMA(a, b, c) __builtin_amdgcn_mfma_f32_32x32x16_bf16((a), (b), (c), 0, 0, 0)

constexpr int LROW = 144;
constexpr int GEMM_BUF = 2 * 128 * LROW;
constexpr int LDS_BYTES = 2 * GEMM_BUF;

template <int NR>
DI void g_load(u32x4 (&R)[NR], const u16* g, int ld, int k0) {
#pragma unroll
  for (int i = 0; i < NR; ++i) R[i] = *(const u32x4*)(g + (size_t)(32 * i) * ld + k0);
}
template <int NR>
DI void g_store(const u32x4 (&R)[NR], char* sw) {
#pragma unroll
  for (int i = 0; i < NR; ++i) *(u32x4*)(sw + (32 * i) * LROW) = R[i];
}
template <int NB>
DI void g_compute(f32x16 (&acc)[2][NB], const char* fa, const char* fb) {
#pragma unroll
  for (int ks = 0; ks < 4; ++ks) {
    bf16x8 a0 = *(const bf16x8*)(fa + ks * 32);
    bf16x8 a1 = *(const bf16x8*)(fa + 32 * LROW + ks * 32);
#pragma unroll
    for (int j = 0; j < NB; ++j) {
      bf16x8 b = *(const bf16x8*)(fb + j * 32 * LROW + ks * 32);
      acc[0][j] = MFMA(a0, b, acc[0][j]);
      acc[1][j] = MFMA(a1, b, acc[1][j]);
    }
  }
}
template <int NB>
DI void gemm_acc(f32x16 (&acc)[2][NB], const u16* A, int lda, const u16* Bt, int ldb, int K, int m0, int n0, char* lds) {
  const int tid = TIDX, lane = tid & 63, wave = tid >> 6;
  const int r = lane & 31, h = lane >> 5;
  const int wm = wave >> 1, wn = wave & 1;
  const int lrow = tid >> 3, lcol = (tid & 7) * 8;
  const u16* ga = A + (size_t)(m0 + lrow) * lda + lcol;
  const u16* gb = Bt + (size_t)(n0 + lrow) * ldb + lcol;
  u32x4 ra0[4], ra1[4], rb0[2 * NB], rb1[2 * NB];
  const int nk = K >> 6;
  char* sw = lds + lrow * LROW + lcol * 2;
  const char* fa = lds + (wm * 64 + r) * LROW + h * 16;
  const char* fb = lds + 128 * LROW + (wn * 32 * NB + r) * LROW + h * 16;
#define G_LOAD(RA, RB, kt_) do { const int k0_ = ((kt_) < nk ? (kt_) : nk - 1) << 6; g_load<4>(RA, ga, lda, k0_); g_load<2 * NB>(RB, gb, ldb, k0_); } while (0)
#define G_STORE(RA, RB, boff_) do { g_store<4>(RA, sw + (boff_)); g_store<2 * NB>(RB, sw + (boff_) + 128 * LROW); } while (0)
  G_LOAD(ra0, rb0, 0);
  G_LOAD(ra1, rb1, 1);
  G_STORE(ra0, rb0, 0);
  __syncthreads();
  for (int kt = 0; kt < nk; kt += 2) {
    G_LOAD(ra0, rb0, kt + 2);
    g_compute<NB>(acc, fa, fb);
    G_STORE(ra1, rb1, GEMM_BUF);
    __syncthreads();
    G_LOAD(ra1, rb1, kt + 3);
    g_compute<NB>(acc, fa + GEMM_BUF, fb + GEMM_BUF);
    G_STORE(ra0, rb0, 0);
    __syncthreads();
  }
#undef G_LOAD
#undef G_STORE
}

template <class Epi>
DI void gemm_tile(const u16* A, int lda, const u16* Bt, int ldb, int K, int m0, int n0, Epi epi, char* lds) {
  const int lane = TIDX & 63, wave = TIDX >> 6;
  const int r = lane & 31, h = lane >> 5, wm = wave >> 1, wn = wave & 1;
  f32x16 acc[2][2];
#pragma unroll
  for (int i = 0; i < 2; ++i)
#pragma unroll
    for (int j = 0; j < 2; ++j)
#pragma unroll
      for (int e = 0; e < 16; ++e) acc[i][j][e] = 0.f;
  gemm_acc<2>(acc, A, lda, Bt, ldb, K, m0, n0, lds);
#pragma unroll
  for (int i = 0; i < 2; ++i)
#pragma unroll
    for (int j = 0; j < 2; ++j)
#pragma unroll
      for (int q = 0; q < 4; ++q) {
        const int m = m0 + wm * 64 + i * 32 + 8 * q + 4 * h;
        const int n = n0 + wn * 64 + j * 32 + r;
        epi(m, n, acc[i][j][4 * q], acc[i][j][4 * q + 1], acc[i][j][4 * q + 2], acc[i][j][4 * q + 3]);
      }
}

DI void dft_pair(const u16* Dm, const u16* PeQo, const u16* PH, int phstride, int H, int m0, int n0, u16* AB, int rowbase, int colsPerBatch, float norm, char* shm, int half) {
  char* lds = shm + half * LDS_BYTES;
  const int lane = TIDX & 63, wave = TIDX >> 6;
  const int r = lane & 31, h = lane >> 5, wm = wave >> 1, wn = wave & 1;
  f32x16 acc[2][1];
#pragma unroll
  for (int i = 0; i < 2; ++i)
#pragma unroll
    for (int e = 0; e < 16; ++e) acc[i][0][e] = 0.f;
  gemm_acc<1>(acc, Dm + half * H, 2 * H, PeQo + half * H, 2 * H, H, m0, n0, lds);
  float* exo = (float*)lds + wave * 2048 + lane;
  const float* exr = (const float*)(shm + (1 - half) * LDS_BYTES) + wave * 2048 + lane;
#pragma unroll
  for (int i = 0; i < 2; ++i)
#pragma unroll
    for (int e = 0; e < 16; ++e) exo[(i * 16 + e) * 64] = acc[i][0][e];
  __syncthreads();
  const int N = 2 * H;
  const int col = n0 + wn * 32 + r;
  const int b = col / colsPerBatch, c = col - b * colsPerBatch;
  const float ph = bf2f(PH[(size_t)col * phstride]);
  u16* base = AB + ((size_t)rowbase + (size_t)b * N) * 1024 + 512 + c;
#pragma unroll
  for (int i = 0; i < 2; ++i)
#pragma unroll
    for (int q = 0; q < 4; ++q)
#pragma unroll
      for (int e = 0; e < 4; ++e) {
        const int k = m0 + wm * 64 + i * 32 + 8 * q + 4 * h + e;
        const float other = exr[(i * 16 + 4 * q + e) * 64];
        const float sp = (k & 1) ? -ph : ph;
        if (half == 0) base[(size_t)k * 1024] = f2bf((acc[i][0][4 * q + e] + sp - other) * norm);
        else if (k > 0) base[(size_t)(N - k) * 1024] = f2bf((other + sp + acc[i][0][4 * q + e]) * norm);
      }
  __syncthreads();
}

struct EpiBf16 {
  u16* C; int ldc;
  DI void operator()(int m, int n, float v0, float v1, float v2, float v3) const {
    u16* p = C + (size_t)m * ldc + n;
    p[0] = f2bf(v0); p[ldc] = f2bf(v1); p[2 * ldc] = f2bf(v2); p[3 * ldc] = f2bf(v3);
  }
};
struct EpiU {
  u16* UA; u16* PQt;
  DI void operator()(int m, int n, float v0, float v1, float v2, float v3) const {
    if (n < 512) {
      u16* p = UA + (size_t)m * 512 + n;
      p[0] = f2bf(v0); p[512] = f2bf(v1); p[1024] = f2bf(v2); p[1536] = f2bf(v3);
    } else {
      const int np = n - 512, g = np >> 8, pq = (np >> 7) & 1, mm = np & 127;
      size_t off;
      if (m < 4096) { const int b = m >> 8, nl = m & 255; off = ((size_t)(b * 512 + g * 128 + mm)) * 512 + pq * 256 + nl; }
      else { const int ms = m - 4096, b = ms >> 12, nl = ms & 4095; off = (size_t)16 * 512 * 512 + ((size_t)(b * 512 + g * 128 + mm)) * 8192 + pq * 4096 + nl; }
      uint2 w; w.x = pack2(v0, v1); w.y = pack2(v2, v3);
      *(uint2*)(PQt + off) = w;
    }
  }
};
struct EpiDft {
  u16* AB; int rowbase; float norm; int sample;
  DI void operator()(int m, int n, float v0, float v1, float v2, float v3) const {
    size_t row; int c;
    if (sample) { row = (size_t)4096 + (size_t)(n >> 9) * 4096 + m; c = n & 511; }
    else { row = (size_t)rowbase + m; c = n; }
    u16* p = AB + row * 1024 + 512 + c;
    p[0] = f2bf(v0 * norm); p[1024] = f2bf(v1 * norm); p[2048] = f2bf(v2 * norm); p[3072] = f2bf(v3 * norm);
  }
};
struct EpiRes {
  const float* xin_p; const float* xin_s;
  float* X; const float* gate;
  DI void operator()(int m, int n, float v0, float v1, float v2, float v3) const {
    const float* xi = (m < 4096) ? xin_p + (size_t)m * 1024 + n : xin_s + (size_t)(m - 4096) * 1024 + n;
    const float g = gate[cond_of(m) * 6144 + n];
    float* xo = X + (size_t)m * 1024 + n;
    xo[0] = xi[0] + g * v0; xo[1024] = xi[1024] + g * v1; xo[2048] = xi[2048] + g * v2; xo[3072] = xi[3072] + g * v3;
  }
};
struct EpiRelu2 {
  u16* C;
  DI void operator()(int m, int n, float v0, float v1, float v2, float v3) const {
    v0 = fmaxf(v0, 0.f); v1 = fmaxf(v1, 0.f); v2 = fmaxf(v2, 0.f); v3 = fmaxf(v3, 0.f);
    u16* p = C + (size_t)m * 4096 + n;
    p[0] = f2bf(v0 * v0); p[4096] = f2bf(v1 * v1); p[8192] = f2bf(v2 * v2); p[12288] = f2bf(v3 * v3);
  }
};
struct EpiQkv {
  u16* QKV; u16* CVtP; u16* CVtS; u16* DVtP; u16* DVtS; float* ncv; float* ndv;
  DI void operator()(int m, int n, float v0, float v1, float v2, float v3) const {
    const bool is_cv = (n >= 1024 && n < 1536), is_dv = (n >= 2176);
    if (!is_cv && !is_dv) {
      u16* p = QKV + (size_t)m * 2304 + n;
      p[0] = f2bf(v0); p[2304] = f2bf(v1); p[4608] = f2bf(v2); p[6912] = f2bf(v3);
      return;
    }
    uint2 w; w.x = pack2(v0, v1); w.y = pack2(v2, v3);
    if (is_cv) {
      const int c = n - 1024;
      if (m < 4096) {
        const int b = m >> 8, nl = m & 255;
        *(uint2*)(CVtP + ((size_t)(b * 512 + c)) * 256 + nl) = w;
        float* o = ncv + (size_t)m * 512 + c; o[0] = v0; o[512] = v1; o[1024] = v2; o[1536] = v3;
      } else {
        const int ms = m - 4096, b = ms >> 12, nl = ms & 4095;
        *(uint2*)(CVtS + ((size_t)(b * 512 + c)) * 4608 + 512 + nl) = w;
      }
    } else {
      const int c = n - 2176;
      if (m < 4096) {
        const int b = m >> 8, nl = m & 255;
        *(uint2*)(DVtP + ((size_t)(b * 128 + c)) * 256 + nl) = w;
        float* o = ndv + (size_t)m * 128 + c; o[0] = v0; o[128] = v1; o[256] = v2; o[384] = v3;
      } else {
        const int ms = m - 4096, b = ms >> 12, nl = ms & 4095;
        *(uint2*)(DVtS + ((size_t)(b * 128 + c)) * 4608 + 512 + nl) = w;
      }
    }
  }
};

DI void ada_item(const Params& p, int id, char* lds) {
  const int tid = TIDX;
  float* ssil = (float*)lds;
  float* red = (float*)(lds + 12288);
  const int l = id / 192, cb = id % 192;
  for (int i = tid; i < 3072; i += 256) {
    const int j = i >> 10, k = i & 1023;
    const float v = (j == 0) ? p.in[7][k] : p.in[2][(j - 1) * 1024 + k];
    ssil[i] = v / (1.f + __expf(-v));
  }
  __syncthreads();
  const int cq = tid & 7, kg = tid >> 3;
  const float* w = p.in[10] + (size_t)l * 1024 * 6144 + cb * 32 + cq * 4;
  float4 a0 = {0, 0, 0, 0}, a1 = {0, 0, 0, 0}, a2 = {0, 0, 0, 0};
#pragma unroll 8
  for (int kk = 0; kk < 32; ++kk) {
    const int k = kg * 32 + kk;
    const float4 wv = *(const float4*)(w + (size_t)k * 6144);
    const float s0 = ssil[k], s1 = ssil[1024 + k], s2 = ssil[2048 + k];
    a0.x += s0 * wv.x; a0.y += s0 * wv.y; a0.z += s0 * wv.z; a0.w += s0 * wv.w;
    a1.x += s1 * wv.x; a1.y += s1 * wv.y; a1.z += s1 * wv.z; a1.w += s1 * wv.w;
    a2.x += s2 * wv.x; a2.y += s2 * wv.y; a2.z += s2 * wv.z; a2.w += s2 * wv.w;
  }
  float* rp = red + kg * 96 + cq * 4;
  rp[0] = a0.x; rp[1] = a0.y; rp[2] = a0.z; rp[3] = a0.w;
  rp[32] = a1.x; rp[33] = a1.y; rp[34] = a1.z; rp[35] = a1.w;
  rp[64] = a2.x; rp[65] = a2.y; rp[66] = a2.z; rp[67] = a2.w;
  __syncthreads();
  if (tid < 96) {
    const int j = tid >> 5, c = tid & 31;
    float sum = 0.f;
#pragma unroll
    for (int g = 0; g < 32; ++g) sum += red[g * 96 + j * 32 + c];
    const int col = cb * 32 + c;
    ((float*)(p.ws + OFF_MODS))[(size_t)(l * 3 + j) * 6144 + col] = sum + p.in[11][l * 6144 + col];
  }
  __syncthreads();
}

DI void transpose_tile(const float* src, int ld_src, u16* dst, int ld_dst, int r0, int c0, char* lds) {
  float* tile = (float*)lds;
  const int tid = TIDX;
  const int j4 = (tid & 15) * 4, i0 = tid >> 4;
#pragma unroll
  for (int it = 0; it < 4; ++it) {
    const int i = i0 + 16 * it;
    const float4 v = *(const float4*)(src + (size_t)(r0 + i) * ld_src + c0 + j4);
    float* tp = tile + i * 65 + j4;
    tp[0] = v.x; tp[1] = v.y; tp[2] = v.z; tp[3] = v.w;
  }
  __syncthreads();
  const int kc = (tid & 7) * 8, jr = tid >> 3;
#pragma unroll
  for (int it = 0; it < 2; ++it) {
    const int j = jr + 32 * it;
    const float* tp = tile + kc * 65 + j;
    uint4 o;
    o.x = pack2(tp[0], tp[65]); o.y = pack2(tp[130], tp[195]); o.z = pack2(tp[260], tp[325]); o.w = pack2(tp[390], tp[455]);
    *(uint4*)(dst + (size_t)(c0 + j) * ld_dst + r0 + kc) = o;
  }
  __syncthreads();
}

DI void prep_transposes(const Params& p, int vb, int G, char* lds, int layer, int t0 = 0, int t1 = 1 << 30) {
  const int ntile = min(layer ? 2880 : 2432, t1);
  for (int t = t0 + vb; t < ntile; t += G) {
    const float* src; u16* dst; int lds_, ldd, r0, c0;
    int q = t;
    if (layer == 0) {
      if (q < 128) { src = p.in[12]; lds_ = 1024; dst = (u16*)(p.ws + OFF_WIN_E); ldd = 1024; r0 = (q >> 3) * 64; c0 = (q & 7) * 64; }
      else if ((q -= 128) < 256) { src = p.in[16]; lds_ = 1024; dst = (u16*)(p.ws + OFF_WOUT_ET); ldd = 1024; r0 = (q >> 4) * 64; c0 = (q & 15) * 64; }
      else if ((q -= 256) < 1024) { src = p.in[29]; lds_ = 4096; dst = (u16*)(p.ws + OFF_W1); ldd = 1024; r0 = (q >> 6) * 64; c0 = (q & 63) * 64; }
      else { q -= 1024; src = p.in[30]; lds_ = 1024; dst = (u16*)(p.ws + OFF_W2); ldd = 4096; r0 = (q >> 4) * 64; c0 = (q & 15) * 64; }
    } else {
      if (q < 576) { src = p.in[17]; lds_ = 2304; dst = (u16*)(p.ws + OFF_WIN_O); ldd = 1024; r0 = (q / 36) * 64; c0 = (q % 36) * 64; }
      else if ((q -= 576) < 256) { src = p.in[28]; lds_ = 1024; dst = (u16*)(p.ws + OFF_WOUT_O); ldd = 1024; r0 = (q >> 4) * 64; c0 = (q & 15) * 64; }
      else if ((q -= 256) < 1024) { src = p.in[29] + (size_t)1024 * 4096; lds_ = 4096; dst = (u16*)(p.ws + OFF_W1) + (size_t)4096 * 1024; ldd = 1024; r0 = (q >> 6) * 64; c0 = (q & 63) * 64; }
      else { q -= 1024; src = p.in[30] + (size_t)4096 * 1024; lds_ = 1024; dst = (u16*)(p.ws + OFF_W2) + (size_t)1024 * 4096; ldd = 4096; r0 = (q >> 4) * 64; c0 = (q & 15) * 64; }
    }
    transpose_tile(src, lds_, dst, ldd, r0, c0, lds);
  }
}

DI void prep_elementwise(const Params& p, int vb, int G) {
  const size_t gt = (size_t)vb * 256 + TIDX, gs = (size_t)G * 256;
  {
    u16* d = (u16*)(p.ws + OFF_WINB);
    for (size_t i = gt; i < 1024 * 256; i += gs) {
      const int k = (int)(i >> 8), c = (int)(i & 255) * 2;
      const float* s = p.in[12] + (size_t)k * 1024 + 512 + c;
      *(unsigned*)(d + (size_t)k * 512 + c) = pack2(s[0], s[1]);
    }
  }
  {
    u16* d = (u16*)(p.ws + OFF_CBD);
    for (size_t i = gt; i < 1024 * 512; i += gs) {
      const int np = (int)(i >> 9), cp = (int)(i & 511);
      const int g = np >> 8, pq = (np >> 7) & 1, m = np & 127;
      float v = 0.f;
      if ((cp >> 7) == g) {
        const int c = cp & 127; const int rr = (m * c) & 127;
        const float x = (float)rr * (2.0f / 128.0f);
        v = pq ? sinpif(x) : cospif(x);
      }
      d[i] = f2bf(v);
    }
  }
  {
    u16* d = (u16*)(p.ws + OFF_BD);
    for (size_t i = gt; i < 1024 * 1024; i += gs) {
      const int kp = (int)(i >> 10), c = (int)(i & 1023);
      float v = 0.f;
      if (kp < 512) { const int g = kp >> 7; if (c < 512 && (c >> 7) == g) v = p.in[13][(size_t)g * 16384 + (kp & 127) * 128 + (c & 127)] * p.in[14][c]; }
      else { const int g = (kp - 512) >> 7; if (c >= 512 && ((c - 512) >> 7) == g) v = p.in[15][(size_t)g * 16384 + ((kp - 512) & 127) * 128 + ((c - 512) & 127)]; }
      d[i] = f2bf(v);
    }
  }
#pragma unroll 1
  for (int which = 0; which < 2; ++which) {
    const int H = which ? 2048 : 128, N = 2 * H, lg = which ? 9 : 5;
    u16* d = (u16*)(p.ws + (which ? OFF_D4096 : OFF_D256));
    const float invN = 1.0f / (float)N;
    for (size_t i = gt; i < ((size_t)H << lg); i += gs) {
      const int k = (int)(i >> lg), np = (int)(i & ((1 << lg) - 1)) * 8;
      const bool is_sin = np >= H;
      const int n = np & (H - 1);
      unsigned w[4];
#pragma unroll
      for (int e = 0; e < 4; ++e) {
        const float x0 = (float)((k * (n + 2 * e)) & (N - 1)) * invN, x1 = (float)((k * (n + 2 * e + 1)) & (N - 1)) * invN;
        const float v0 = is_sin ? __builtin_amdgcn_sinf(x0) : __builtin_amdgcn_cosf(x0);
        const float v1 = is_sin ? __builtin_amdgcn_sinf(x1) : __builtin_amdgcn_cosf(x1);
        w[e] = pack2(v0, v1);
      }
      *(uint4*)(d + (size_t)k * N + np) = make_uint4(w[0], w[1], w[2], w[3]);
    }
  }
}

DI void sym_phase(const Params& p, int vb, int G) {
  const int lane = TIDX & 63, wave = TIDX >> 6;
  const u16* PQT = (const u16*)(p.ws + OFF_PQT);
  u16* PEQO = (u16*)(p.ws + OFF_PEQO);
  u16* AB = (u16*)(p.ws + OFF_AB);
  for (int it = vb * 4 + wave; it < 1024 + 2048; it += G * 4) {
    const bool samp = it < 1024;
    const int H = samp ? 2048 : 128, N = 2 * H;
    int col, n0base, nstep;
    if (samp) { col = it; n0base = lane * 8; nstep = 512; }
    else { col = (it - 1024) * 4 + (lane >> 4); n0base = (lane & 15) * 8; nstep = 128; }
    const u16* Pp = samp ? PQT + (size_t)16 * 512 * 512 + (size_t)col * 8192 : PQT + (size_t)col * 512;
    const u16* Qp = Pp + N;
    u16* Pe = samp ? PEQO + (size_t)16 * 512 * 256 + (size_t)col * 4096 : PEQO + (size_t)col * 256;
    u16* Qo = Pe + H;
    float alt = 0.f;
    for (int n0 = n0base; n0 < H; n0 += nstep) {
      const uint4 pw = *(const uint4*)(Pp + n0), qw = *(const uint4*)(Qp + n0);
      const unsigned pa[4] = {pw.x, pw.y, pw.z, pw.w}, qa[4] = {qw.x, qw.y, qw.z, qw.w};
      float pe[8], qo[8];
#pragma unroll
      for (int e = 0; e < 8; ++e) {
        const float pv = (e & 1) ? __uint_as_float(pa[e >> 1] & 0xffff0000u) : __uint_as_float(pa[e >> 1] << 16);
        const float qv = (e & 1) ? __uint_as_float(qa[e >> 1] & 0xffff0000u) : __uint_as_float(qa[e >> 1] << 16);
        const int n = n0 + e;
        float pm = 0.f, qm = 0.f;
        if (n > 0) { pm = bf2f(Pp[N - n]); qm = bf2f(Qp[N - n]); }
        pe[e] = pv + pm;
        qo[e] = (n > 0) ? qv - qm : 0.f;
        alt += (e & 1) ? -pe[e] : pe[e];
      }
      *(uint4*)(Pe + n0) = make_uint4(pack2(pe[0], pe[1]), pack2(pe[2], pe[3]), pack2(pe[4], pe[5]), pack2(pe[6], pe[7]));
      *(uint4*)(Qo + n0) = make_uint4(pack2(qo[0], qo[1]), pack2(qo[2], qo[3]), pack2(qo[4], qo[5]), pack2(qo[6], qo[7]));
    }
    alt += __shfl_xor(alt, 1); alt += __shfl_xor(alt, 2); alt += __shfl_xor(alt, 4); alt += __shfl_xor(alt, 8);
    if (samp) { alt += __shfl_xor(alt, 16); alt += __shfl_xor(alt, 32); }
    if ((samp && lane == 0) || (!samp && (lane & 15) == 0)) {
      const float fh = alt + bf2f(Pp[H]);
      size_t row; int c; float norm;
      if (samp) { row = (size_t)4096 + (size_t)(col >> 9) * 4096 + 2048; c = col & 511; norm = 0.0013810679320049757f; }
      else { row = (size_t)(col >> 9) * 256 + 128; c = col & 511; norm = 0.005524271728019903f; }
      AB[row * 1024 + 512 + c] = f2bf(fh * norm);
    }
  }
}

DI void normmod_phase(const Params& p, int vb, int G, const float* xp, const float* xs, const float* gain, int l, int which) {
  const int lane = TIDX & 63, wave = TIDX >> 6;
  u16* H = (u16*)(p.ws + OFF_H);
  const float* mods = (const float*)(p.ws + OFF_MODS) + (size_t)l * 3 * 6144;
  for (int row = vb * 4 + wave; row < T; row += G * 4) {
    const float* x = (row < 4096) ? xp + (size_t)row * 1024 : xs + (size_t)(row - 4096) * 1024;
    float4 v[4];
    float ss = 0.f;
#pragma unroll
    for (int i = 0; i < 4; ++i) {
      v[i] = *(const float4*)(x + i * 256 + lane * 4);
      ss += v[i].x * v[i].x + v[i].y * v[i].y + v[i].z * v[i].z + v[i].w * v[i].w;
    }
    ss = wave_sum(ss);
    const float rinv = rsqrtf(ss * (1.0f / 1024.0f) + EPS);
    const float* md = mods + cond_of(row) * 6144 + which * 3072;
#pragma unroll
    for (int i = 0; i < 4; ++i) {
      const int c = i * 256 + lane * 4;
      const float4 g = *(const float4*)(gain + c);
      const float4 sh = *(const float4*)(md + c);
      const float4 sc = *(const float4*)(md + 1024 + c);
      const float o0 = v[i].x * rinv * g.x * (1.f + sc.x) + sh.x;
      const float o1 = v[i].y * rinv * g.y * (1.f + sc.y) + sh.y;
      const float o2 = v[i].z * rinv * g.z * (1.f + sc.z) + sh.z;
      const float o3 = v[i].w * rinv * g.w * (1.f + sc.w) + sh.w;
      uint2 w; w.x = pack2(o0, o1); w.y = pack2(o2, o3);
      *(uint2*)(H + (size_t)row * 1024 + c) = w;
    }
  }
}

template <class Epi>
DI void gemm_phase(const u16* A, int lda, const u16* Bt, int ldb, int K, int M, int N, Epi epi, int vb, int G, char* lds) {
  const int nN = N >> 7, nt = (M >> 7) * nN, grp = 8 * nN;
  for (int t = vb; t < nt; t += G) {
    const int gi = t / grp, rem = t - gi * grp;
    gemm_tile(A, lda, Bt, ldb, K, (gi * 8 + (rem & 7)) << 7, (rem >> 3) << 7, epi, lds);
  }
}

template <int HW>
DI void pool_item(const u16* UA, u16* AB, int t, int c8) {
  int nl, N;
  if (t < 4096) { nl = t & 255; N = 256; } else { nl = (t - 4096) & 4095; N = 4096; }
  const int base = t - nl;
  u32x4 w[2 * HW];
  int cnt = 0;
#pragma unroll
  for (int j = 0; j < 2 * HW; ++j) {
    const int idx = nl - HW + j;
    const bool ok = idx >= 0 && idx < N;
    w[j] = *(const u32x4*)(UA + (size_t)(base + (ok ? idx : nl)) * 512 + c8);
    if (!ok) w[j] = (u32x4){0u, 0u, 0u, 0u};
    cnt += ok ? 1 : 0;
  }
  const u32x4 cw = *(const u32x4*)(UA + (size_t)t * 512 + c8);
  float s[8] = {0, 0, 0, 0, 0, 0, 0, 0};
#pragma unroll
  for (int j = 0; j < 2 * HW; ++j)
#pragma unroll
    for (int e = 0; e < 4; ++e) { s[2 * e] += __uint_as_float(w[j][e] << 16); s[2 * e + 1] += __uint_as_float(w[j][e] & 0xffff0000u); }
  const float inv = 1.0f / (float)cnt;
  u32x4 o;
#pragma unroll
  for (int e = 0; e < 4; ++e) o[e] = pack2(s[2 * e] * inv - __uint_as_float(cw[e] << 16), s[2 * e + 1] * inv - __uint_as_float(cw[e] & 0xffff0000u));
  *(u32x4*)(AB + (size_t)t * 1024 + c8) = o;
}
DI void pool_phase(const Params& p, int vb, int G) {
  const u16* UA = (const u16*)(p.ws + OFF_UA);
  u16* AB = (u16*)(p.ws + OFF_AB);
  const size_t gt = (size_t)vb * 256 + TIDX, gs = (size_t)G * 256;
  for (size_t i = gt; i < (size_t)T * 64; i += gs) {
    const int cc = (int)(i & 15), tt = (int)(i >> 4) & 3, g = (int)(i >> 6) & 3, tb = (int)(i >> 8);
    const int t = tb * 4 + tt, c8 = g * 128 + cc * 8;
    if (g == 0) pool_item<1>(UA, AB, t, c8);
    else if (g == 1) pool_item<2>(UA, AB, t, c8);
    else if (g == 2) pool_item<4>(UA, AB, t, c8);
    else pool_item<8>(UA, AB, t, c8);
  }
}

DI void qkvpost_phase(const Params& p, int vb, int G) {
  const int lane = TIDX & 63, wave = TIDX >> 6;
  const int q = lane & 15, sub = lane >> 4;
  const u16* QKV = (const u16*)(p.ws + OFF_QKV);
  u16* CQ = (u16*)(p.ws + OFF_CQ); u16* DQ = (u16*)(p.ws + OFF_DQ);
  u16* CKP = (u16*)(p.ws + OFF_CKP); u16* CKS = (u16*)(p.ws + OFF_CKS);
  u16* DKP = (u16*)(p.ws + OFF_DKP); u16* DKS = (u16*)(p.ws + OFF_DKS);
  float* nck = p.out + OUT_NCK; float* ndk = p.out + OUT_NDK;
  const int d0 = q * 4;
  float fr[4];
#pragma unroll
  for (int e = 0; e < 4; ++e) fr[e] = exp2f(-(float)((d0 + e) & 15) * (13.287712379549449f / 16.0f));
  const bool firsthalf = ((d0 >> 4) & 1) == 0;
  for (int t = vb * 4 + wave; t < T; t += G * 4) {
    const bool samp = t >= 4096;
    int b, nl;
    if (!samp) { b = t >> 8; nl = t & 255; } else { b = (t - 4096) >> 12; nl = (t - 4096) & 4095; }
    float cs[4], sn[4];
    if (samp) {
      const float pos = (d0 < 32) ? (float)(nl >> 6) : (float)(nl & 63);
#pragma unroll
      for (int e = 0; e < 4; ++e) { const float a = pos * fr[e]; cs[e] = cosf(a); sn[e] = sinf(a); }
    } else {
#pragma unroll
      for (int e = 0; e < 4; ++e) { cs[e] = 1.f; sn[e] = 0.f; }
    }
    for (int rd = 0; rd < 7; ++rd) {
      const int slot = rd * 4 + sub;
      const bool act = slot < 26;
      const int vi = act ? (slot < 16 ? slot : slot + 8) : 0;
      const uint2 raw = *(const uint2*)(QKV + (size_t)t * 2304 + vi * 64 + d0);
      float x[4] = {__uint_as_float(raw.x << 16), __uint_as_float(raw.x & 0xffff0000u), __uint_as_float(raw.y << 16), __uint_as_float(raw.y & 0xffff0000u)};
      float ss = x[0] * x[0] + x[1] * x[1] + x[2] * x[2] + x[3] * x[3];
      ss += __shfl_xor(ss, 1); ss += __shfl_xor(ss, 2); ss += __shfl_xor(ss, 4); ss += __shfl_xor(ss, 8);
      const float rinv = rsqrtf(ss * (1.0f / 64.0f) + EPS);
      const float* gp = (vi < 8) ? p.in[18] : (vi < 16) ? p.in[19] : (vi < 32) ? p.in[25] : p.in[26];
      const float4 g = *(const float4*)(gp + d0);
      float y[4] = {x[0] * rinv * g.x, x[1] * rinv * g.y, x[2] * rinv * g.z, x[3] * rinv * g.w};
      float o[4];
#pragma unroll
      for (int e = 0; e < 4; ++e) {
        const float part = __shfl_xor(y[e], 4);
        o[e] = firsthalf ? (y[e] * cs[e] - part * sn[e]) : (y[e] * cs[e] + part * sn[e]);
      }
      if (!act) continue;
      const bool isq = (vi < 8) || (vi >= 24 && vi < 32);
      if (isq) {
        const int hd = (vi < 8) ? vi : vi - 24;
        u16* base = (vi < 8) ? CQ : DQ;
        size_t off = samp ? (size_t)16 * 8 * 256 * 64 + ((size_t)(b * 8 + hd) * 4096 + nl) * 64 : ((size_t)(b * 8 + hd) * 256 + nl) * 64;
        uint2 w; w.x = pack2(o[0] * QSCALE, o[1] * QSCALE); w.y = pack2(o[2] * QSCALE, o[3] * QSCALE);
        *(uint2*)(base + off + d0) = w;
      } else if (vi < 16) {
        const int hm = vi - 8;
        uint2 w; w.x = pack2(o[0], o[1]); w.y = pack2(o[2], o[3]);
        if (samp) *(uint2*)(CKS + ((size_t)(b * 8 + hm) * 4608 + 512 + nl) * 64 + d0) = w;
        else {
          *(uint2*)(CKP + ((size_t)(b * 8 + hm) * 256 + nl) * 64 + d0) = w;
          *(float4*)(nck + (size_t)t * 512 + hm * 64 + d0) = make_float4(o[0], o[1], o[2], o[3]);
        }
      } else {
        const int j = vi - 32;
        uint2 w; w.x = pack2(o[0], o[1]); w.y = pack2(o[2], o[3]);
        if (samp) *(uint2*)(DKS + ((size_t)(b * 2 + j) * 4608 + 512 + nl) * 64 + d0) = w;
        else {
          *(uint2*)(DKP + ((size_t)(b * 2 + j) * 256 + nl) * 64 + d0) = w;
          *(float4*)(ndk + (size_t)t * 128 + j * 64 + d0) = make_float4(o[0], o[1], o[2], o[3]);
        }
      }
    }
  }
  const size_t gt = (size_t)vb * 256 + TIDX, gs = (size_t)G * 256;
  {
    u16* CVTS = (u16*)(p.ws + OFF_CVTS); u16* DVTS = (u16*)(p.ws + OFF_DVTS);
    for (size_t i = gt; i < (size_t)2 * 512 * 512; i += gs) {
      const int b = (int)(i >> 18), key = (int)(i >> 9) & 511, c = (int)(i & 511);
      CKS[((size_t)(b * 8 + (c >> 6)) * 4608 + key) * 64 + (c & 63)] = f2bf(p.in[3][i]);
    }
    for (size_t i = gt; i < (size_t)2 * 512 * 512; i += gs) {
      const int b = (int)(i >> 18), c = (int)(i >> 9) & 511, key = (int)(i & 511);
      CVTS[((size_t)(b * 512 + c)) * 4608 + key] = f2bf(p.in[4][((size_t)b * 512 + key) * 512 + c]);
    }
    for (size_t i = gt; i < (size_t)2 * 512 * 128; i += gs) {
      const int b = (int)(i >> 16), key = (int)(i >> 7) & 511, c = (int)(i & 127);
      DKS[((size_t)(b * 2 + (c >> 6)) * 4608 + key) * 64 + (c & 63)] = f2bf(p.in[5][i]);
    }
    for (size_t i = gt; i < (size_t)2 * 128 * 512; i += gs) {
      const int b = (int)(i >> 16), c = (int)(i >> 9) & 127, key = (int)(i & 511);
      DVTS[((size_t)(b * 128 + c)) * 4608 + key] = f2bf(p.in[6][((size_t)b * 512 + key) * 128 + c]);
    }
  }
}

DI void cache_convert(const Params& p, int vb, int G) {
  u16* CKS = (u16*)(p.ws + OFF_CKS); u16* DKS = (u16*)(p.ws + OFF_DKS);
  const size_t gt = (size_t)vb * 256 + TIDX, gs = (size_t)G * 256;
  {
    u16* CVTS = (u16*)(p.ws + OFF_CVTS); u16* DVTS = (u16*)(p.ws + OFF_DVTS);
    for (size_t i = gt; i < (size_t)2 * 512 * 512; i += gs) {
      const int b = (int)(i >> 18), key = (int)(i >> 9) & 511, c = (int)(i & 511);
      CKS[((size_t)(b * 8 + (c >> 6)) * 4608 + key) * 64 + (c & 63)] = f2bf(p.in[3][i]);
    }
    for (size_t i = gt; i < (size_t)2 * 512 * 512; i += gs) {
      const int b = (int)(i >> 18), c = (int)(i >> 9) & 511, key = (int)(i & 511);
      CVTS[((size_t)(b * 512 + c)) * 4608 + key] = f2bf(p.in[4][((size_t)b * 512 + key) * 512 + c]);
    }
    for (size_t i = gt; i < (size_t)2 * 512 * 128; i += gs) {
      const int b = (int)(i >> 16), key = (int)(i >> 7) & 511, c = (int)(i & 127);
      DKS[((size_t)(b * 2 + (c >> 6)) * 4608 + key) * 64 + (c & 63)] = f2bf(p.in[5][i]);
    }
    for (size_t i = gt; i < (size_t)2 * 128 * 512; i += gs) {
      const int b = (int)(i >> 16), c = (int)(i >> 9) & 127, key = (int)(i & 511);
      DVTS[((size_t)(b * 128 + c)) * 4608 + key] = f2bf(p.in[6][((size_t)b * 512 + key) * 128 + c]);
    }
  }
}

template <int DV>
DI void attn_item(const u16* Q, const u16* Kb, const u16* Vt, int ldv, int nt0, int key1, int nt1,
                  bool masked, int qpos0, bool has_sink, float sink2, u16* out, int ldo, char* lds) {
  constexpr int NDB = DV / 32;
  constexpr int KVBUF = (64 + DV) * LROW;
  const int tid = TIDX, lane = tid & 63, wave = tid >> 6;
  const int r = lane & 31, h = lane >> 5;
  const int nt = nt0 + nt1;
  bf16x8 qf[4];
#pragma unroll
  for (int ks = 0; ks < 4; ++ks) qf[ks] = *(const bf16x8*)(Q + (size_t)(wave * 32 + r) * 64 + ks * 16 + h * 8);
  f32x16 O[NDB];
#pragma unroll
  for (int i = 0; i < NDB; ++i)
#pragma unroll
    for (int e = 0; e < 16; ++e) O[i][e] = 0.f;
  float mrun = has_sink ? sink2 : -1e30f;
  float lrun = has_sink ? (h == 0 ? 1.f : 0.f) : 0.f;
  const int lrow = tid >> 3, lpart = (tid & 7) * 8;
  uint4 rk0, rk1, rv0, rv1, rv2, rv3;
  rv2 = rv3 = make_uint4(0, 0, 0, 0);
  const u16* gk = Kb + (size_t)lrow * 64 + lpart;
  const u16* gv = Vt + (size_t)lrow * ldv + lpart;
#define ATT_GLOAD(key0_)                                                         \
  do {                                                                           \
    rk0 = *(const uint4*)(gk + (size_t)(key0_) * 64);                            \
    rk1 = *(const uint4*)(gk + (size_t)((key0_) + 32) * 64);                     \
    rv0 = *(const uint4*)(gv + (key0_));                                         \
    rv1 = *(const uint4*)(gv + (size_t)32 * ldv + (key0_));                      \
    if constexpr (DV == 128) {                                                   \
      rv2 = *(const uint4*)(gv + (size_t)64 * ldv + (key0_));                    \
      rv3 = *(const uint4*)(gv + (size_t)96 * ldv + (key0_));                    \
    }                                                                            \
  } while (0)
#define ATT_SSTORE(boff_)                                                        \
  do {                                                                           \
    *(uint4*)(sw + (boff_)) = rk0;                                               \
    *(uint4*)(sw + (boff_) + 32 * LROW) = rk1;                                   \
    *(uint4*)(sw + (boff_) + 64 * LROW) = rv0;                                   \
    *(uint4*)(sw + (boff_) + 96 * LROW) = rv1;                                   \
    if constexpr (DV == 128) {                                                   \
      *(uint4*)(sw + (boff_) + 128 * LROW) = rv2;                                \
      *(uint4*)(sw + (boff_) + 160 * LROW) = rv3;                                \
    }                                                                            \
  } while (0)
  char* sw = lds + lrow * LROW + lpart * 2;
  {
    const int key0 = (nt0 > 0) ? 0 : key1;
    ATT_GLOAD(key0);
  }
  ATT_SSTORE(0);
  __syncthreads();
  const int pr = (r & 0x13) | ((r & 4) << 1) | ((r & 8) >> 1);
  const char* fk = lds + pr * LROW + h * 16;
  const char* fv = lds + 64 * LROW + r * LROW + h * 16;
  const int qpos = qpos0 + wave * 32 + r;
  for (int t = 0; t < nt; ++t) {
    const int cur = (t & 1) * KVBUF;
    const int key0 = (t < nt0) ? t * 64 : key1 + (t - nt0) * 64;
    {
      const int tn = (t + 1 < nt) ? t + 1 : t;
      const int kn = (tn < nt0) ? tn * 64 : key1 + (tn - nt0) * 64;
      ATT_GLOAD(kn);
    }
    f32x16 S[2];
#pragma unroll
    for (int kb = 0; kb < 2; ++kb) {
#pragma unroll
      for (int e = 0; e < 16; ++e) S[kb][e] = 0.f;
#pragma unroll
      for (int ks = 0; ks < 4; ++ks) {
        const bf16x8 kf = *(const bf16x8*)(fk + cur + kb * 32 * LROW + ks * 32);
        S[kb] = MFMA(kf, qf[ks], S[kb]);
      }
    }
    if (masked && t >= nt0) {
#pragma unroll
      for (int kb = 0; kb < 2; ++kb)
#pragma unroll
        for (int e = 0; e < 16; ++e) {
          const int jpos = key0 - 512 + kb * 32 + 16 * (e >> 3) + 8 * h + (e & 7);
          const int dlt = qpos - jpos;
          if (dlt > 128 || dlt < -128) S[kb][e] = -1e30f;
        }
    }
    float mloc = S[0][0];
#pragma unroll
    for (int kb = 0; kb < 2; ++kb)
#pragma unroll
      for (int e = 0; e < 16; ++e) mloc = fmaxf(mloc, S[kb][e]);
    mloc = fmaxf(mloc, __shfl_xor(mloc, 32));
    const float mnew = fmaxf(mrun, mloc);
    if (__builtin_amdgcn_ballot_w64(mnew > mrun) != 0) {
      const float alpha = __builtin_amdgcn_exp2f(mrun - mnew);
      lrun *= alpha;
#pragma unroll
      for (int i = 0; i < NDB; ++i)
#pragma unroll
        for (int e = 0; e < 16; ++e) O[i][e] *= alpha;
    }
    mrun = mnew;
    float ps = 0.f;
#pragma unroll
    for (int kb = 0; kb < 2; ++kb)
#pragma unroll
      for (int e = 0; e < 16; ++e) { const float pv = __builtin_amdgcn_exp2f(S[kb][e] - mnew); S[kb][e] = pv; ps += pv; }
    lrun += ps;
    bf16x8 pf[4];
#pragma unroll
    for (int jj = 0; jj < 4; ++jj) {
      const int kb = jj >> 1, o8 = (jj & 1) * 8;
      uint4 w;
      w.x = pack2(S[kb][o8 + 0], S[kb][o8 + 1]); w.y = pack2(S[kb][o8 + 2], S[kb][o8 + 3]);
      w.z = pack2(S[kb][o8 + 4], S[kb][o8 + 5]); w.w = pack2(S[kb][o8 + 6], S[kb][o8 + 7]);
      pf[jj] = __builtin_bit_cast(bf16x8, w);
    }
    __builtin_amdgcn_sched_barrier(0);
#pragma unroll
    for (int i = 0; i < NDB; ++i) {
#pragma unroll
      for (int jj = 0; jj < 4; ++jj) {
        const bf16x8 vf = *(const bf16x8*)(fv + cur + i * 32 * LROW + jj * 32);
        O[i] = MFMA(vf, pf[jj], O[i]);
      }
      if (i & 1) __builtin_amdgcn_sched_barrier(0);
    }
    ATT_SSTORE(KVBUF - cur);
    __syncthreads();
  }
#undef ATT_GLOAD
#undef ATT_SSTORE
  const float ltot = lrun + __shfl_xor(lrun, 32);
  const float inv = 1.0f / ltot;
  u16* op = out + (size_t)(wave * 32 + r) * ldo;
#pragma unroll
  for (int i = 0; i < NDB; ++i)
#pragma unroll
    for (int qd = 0; qd < 4; ++qd) {
      uint2 w;
      w.x = pack2(O[i][4 * qd] * inv, O[i][4 * qd + 1] * inv);
      w.y = pack2(O[i][4 * qd + 2] * inv, O[i][4 * qd + 3] * inv);
      *(uint2*)(op + i * 32 + 8 * qd + 4 * h) = w;
    }
}

DI void attn_diff_pair(const u16* Q, const u16* Kb, const u16* Vt, int ldv, int nt, float lam, const float* subln_g, u16* out, char* shm, int half) {
  constexpr int STG = (64 + 64 + 128) * LROW;
  const int tid = TIDX, t512 = (int)threadIdx.x, lane = tid & 63, wave = tid >> 6;
  const int r = lane & 31, h = lane >> 5;
  bf16x8 qf[4];
#pragma unroll
  for (int ks = 0; ks < 4; ++ks) qf[ks] = *(const bf16x8*)(Q + (size_t)(wave * 32 + r) * 64 + ks * 16 + h * 8);
  f32x16 O[4];
#pragma unroll
  for (int i = 0; i < 4; ++i)
#pragma unroll
    for (int e = 0; e < 16; ++e) O[i][e] = 0.f;
  float mrun = -1e30f, lrun = 0.f;
  const int lrow = tid >> 3, lpart = (tid & 7) * 8;
  const int vrow = t512 >> 3, vpart = (t512 & 7) * 8;
  const u16* gk = Kb + (size_t)lrow * 64 + lpart;
  const u16* gv = Vt + (size_t)vrow * ldv + vpart;
  char* sk = shm + half * 64 * LROW + lrow * LROW + lpart * 2;
  char* sv = shm + 128 * LROW + vrow * LROW + vpart * 2;
  u32x4 rk0, rk1, rv0, rv1;
#define AD_GLOAD(key0_) do { rk0 = *(const u32x4*)(gk + (size_t)(key0_) * 64); rk1 = *(const u32x4*)(gk + (size_t)((key0_) + 32) * 64); \
                             rv0 = *(const u32x4*)(gv + (key0_)); rv1 = *(const u32x4*)(gv + (size_t)64 * ldv + (key0_)); } while (0)
#define AD_SSTORE(boff_) do { *(u32x4*)(sk + (boff_)) = rk0; *(u32x4*)(sk + (boff_) + 32 * LROW) = rk1; \
                              *(u32x4*)(sv + (boff_)) = rv0; *(u32x4*)(sv + (boff_) + 64 * LROW) = rv1; } while (0)
#define AD_GLOAD_K(key0_) do { rk0 = *(const u32x4*)(gk + (size_t)(key0_) * 64); rk1 = *(const u32x4*)(gk + (size_t)((key0_) + 32) * 64); } while (0)
#define AD_GLOAD_V(key0_) do { rv0 = *(const u32x4*)(gv + (key0_)); rv1 = *(const u32x4*)(gv + (size_t)64 * ldv + (key0_)); } while (0)
#define AD_SSTORE_K(boff_) do { *(u32x4*)(sk + (boff_)) = rk0; *(u32x4*)(sk + (boff_) + 32 * LROW) = rk1; } while (0)
#define AD_SSTORE_V(boff_) do { *(u32x4*)(sv + (boff_)) = rv0; *(u32x4*)(sv + (boff_) + 64 * LROW) = rv1; } while (0)
#define AD_QK(S_, koff_) do { _Pragma("unroll") for (int kb = 0; kb < 2; ++kb) { _Pragma("unroll") for (int e = 0; e < 16; ++e) S_[kb][e] = 0.f; \
    _Pragma("unroll") for (int ks = 0; ks < 4; ++ks) { const bf16x8 kf = *(const bf16x8*)(fk + (koff_) + kb * 32 * LROW + ks * 32); S_[kb] = MFMA(kf, qf[ks], S_[kb]); } } } while (0)
  const int pr = (r & 0x13) | ((r & 4) << 1) | ((r & 8) >> 1);
  const char* fk = shm + half * 64 * LROW + pr * LROW + h * 16;
  const char* fv = shm + 128 * LROW + r * LROW + h * 16;
  AD_GLOAD_K(0); AD_GLOAD_V(0);
  AD_SSTORE_K(0); AD_SSTORE_V(0);
  AD_GLOAD_K(64);
  AD_SSTORE_K(STG);
  __syncthreads();
  f32x16 S[2], Sn[2];
  AD_QK(S, 0);
  for (int t = 0; t < nt; ++t) {
    const int cur = (t & 1) * STG;
    { const int tk = (t + 2 < nt) ? t + 2 : nt - 1, tv = (t + 1 < nt) ? t + 1 : nt - 1; AD_GLOAD_K(tk * 64); AD_GLOAD_V(tv * 64); }
    AD_QK(Sn, STG - cur);
    __builtin_amdgcn_sched_barrier(0);
    float mloc = S[0][0];
#pragma unroll
    for (int kb = 0; kb < 2; ++kb)
#pragma unroll
      for (int e = 0; e < 16; ++e) mloc = fmaxf(mloc, S[kb][e]);
    mloc = fmaxf(mloc, __shfl_xor(mloc, 32));
    const float mnew = fmaxf(mrun, mloc);
    if (__builtin_amdgcn_ballot_w64(mnew > mrun) != 0) {
      const float alpha = __builtin_amdgcn_exp2f(mrun - mnew);
      lrun *= alpha;
#pragma unroll
      for (int i = 0; i < 4; ++i)
#pragma unroll
        for (int e = 0; e < 16; ++e) O[i][e] *= alpha;
    }
    mrun = mnew;
    float ps = 0.f;
#pragma unroll
    for (int kb = 0; kb < 2; ++kb)
#pragma unroll
      for (int e = 0; e < 16; ++e) { const float pv = __builtin_amdgcn_exp2f(S[kb][e] - mnew); S[kb][e] = pv; ps += pv; }
    lrun += ps;
    bf16x8 pf[4];
#pragma unroll
    for (int jj = 0; jj < 4; ++jj) {
      const int kb = jj >> 1, o8 = (jj & 1) * 8;
      uint4 w;
      w.x = pack2(S[kb][o8 + 0], S[kb][o8 + 1]); w.y = pack2(S[kb][o8 + 2], S[kb][o8 + 3]);
      w.z = pack2(S[kb][o8 + 4], S[kb][o8 + 5]); w.w = pack2(S[kb][o8 + 6], S[kb][o8 + 7]);
      pf[jj] = __builtin_bit_cast(bf16x8, w);
    }
#pragma unroll
    for (int i = 0; i < 4; ++i) {
#pragma unroll
      for (int jj = 0; jj < 4; ++jj) {
        const bf16x8 vf = *(const bf16x8*)(fv + cur + i * 32 * LROW + jj * 32);
        O[i] = MFMA(vf, pf[jj], O[i]);
      }
    }
    AD_SSTORE_K(cur);
    AD_SSTORE_V(STG - cur);
    __syncthreads();
    S[0] = Sn[0]; S[1] = Sn[1];
  }
#undef AD_GLOAD_K
#undef AD_GLOAD_V
#undef AD_SSTORE_K
#undef AD_SSTORE_V
#undef AD_QK
#undef AD_GLOAD
#undef AD_SSTORE
  const float inv = 1.0f / (lrun + __shfl_xor(lrun, 32));
  float* ex = (float*)shm + (size_t)wave * 4096 + lane;
  if (half == 1) {
#pragma unroll
    for (int i = 0; i < 4; ++i)
#pragma unroll
      for (int e = 0; e < 16; ++e) ex[(i * 16 + e) * 64] = O[i][e] * inv;
  }
  __syncthreads();
  if (half == 0) {
    float ss = 0.f;
#pragma unroll
    for (int i = 0; i < 4; ++i)
#pragma unroll
      for (int e = 0; e < 16; ++e) { const float d = O[i][e] * inv - lam * ex[(i * 16 + e) * 64]; O[i][e] = d; ss += d * d; }
    ss += __shfl_xor(ss, 32);
    const float rinv = rsqrtf(ss * (1.0f / 128.0f) + EPS) * (1.0f - LAM_INIT);
    u16* op = out + (size_t)(wave * 32 + r) * 1024;
#pragma unroll
    for (int i = 0; i < 4; ++i)
#pragma unroll
      for (int qd = 0; qd < 4; ++qd) {
        const int e0 = i * 32 + 8 * qd + 4 * h;
        const float4 g = *(const float4*)(subln_g + e0);
        uint2 w;
        w.x = pack2(O[i][4 * qd] * rinv * g.x, O[i][4 * qd + 1] * rinv * g.y);
        w.y = pack2(O[i][4 * qd + 2] * rinv * g.z, O[i][4 * qd + 3] * rinv * g.w);
        *(uint2*)(op + e0) = w;
      }
  }
  __syncthreads();
}

DI void attention_phase(const Params& p, int vb0, int half, char* shm) {
  const u16* CQ = (const u16*)(p.ws + OFF_CQ); const u16* DQ = (const u16*)(p.ws + OFF_DQ);
  const u16* CKP = (const u16*)(p.ws + OFF_CKP); const u16* CKS = (const u16*)(p.ws + OFF_CKS);
  const u16* CVTP = (const u16*)(p.ws + OFF_CVTP); const u16* CVTS = (const u16*)(p.ws + OFF_CVTS);
  const u16* DKP = (const u16*)(p.ws + OFF_DKP); const u16* DKS = (const u16*)(p.ws + OFF_DKS);
  const u16* DVTP = (const u16*)(p.ws + OFF_DVTP); const u16* DVTS = (const u16*)(p.ws + OFF_DVTS);
  u16* AC = (u16*)(p.ws + OFF_H);
  constexpr size_t QS = (size_t)16 * 8 * 256 * 64;
  const int lane = TIDX & 63;
  const float la = wave_sum(p.in[20][lane] * p.in[21][lane]);
  const float lb = wave_sum(p.in[22][lane] * p.in[23][lane]);
  const float lam = expf(la) - expf(lb) + LAM_INIT;
  const int nblk = (int)gridDim.x;
  for (int it = vb0; it < 768; it += nblk) {
    const bool diff = (it < 256) || (it >= 512 && it < 640);
    const bool samp = it < 512;
    if (diff) {
      int qb, hh, b;
      if (samp) { qb = it & 31; hh = (it >> 5) & 3; b = it >> 7; }
      else { const int i2 = it - 512; qb = i2 & 1; hh = (i2 >> 1) & 3; b = i2 >> 3; }
      const int nseq = samp ? 4096 : 256, nkeys = samp ? 4608 : 256;
      const int tok = samp ? 4096 + b * 4096 + qb * 128 : b * 256 + qb * 128;
      const int hm = hh * 2 + half;
      const size_t qoff = (samp ? QS : 0) + ((size_t)(b * 8 + hm) * nseq + qb * 128) * 64;
      const u16* Kp = (samp ? CKS : CKP) + (size_t)(b * 8 + hm) * nkeys * 64;
      const u16* Vp = (samp ? CVTS : CVTP) + (size_t)(b * 4 + hh) * 128 * nkeys;
      attn_diff_pair(CQ + qoff, Kp, Vp, nkeys, nkeys >> 6, lam, p.in[24], AC + (size_t)tok * 1024 + hh * 128, shm, half);
    } else {
      int qb, hd, b;
      if (samp) { const int i2 = (it - 256) * 2 + half; qb = i2 & 31; hd = (i2 >> 5) & 7; b = i2 >> 8; }
      else { const int i2 = (it - 640) * 2 + half; qb = i2 & 1; hd = (i2 >> 1) & 7; b = i2 >> 4; }
      const int nseq = samp ? 4096 : 256, nkeys = samp ? 4608 : 256;
      const int tok = samp ? 4096 + b * 4096 + qb * 128 : b * 256 + qb * 128;
      const size_t qoff = (samp ? QS : 0) + ((size_t)(b * 8 + hd) * nseq + qb * 128) * 64;
      const u16* Kp = (samp ? DKS : DKP) + (size_t)(b * 2 + (hd >> 2)) * nkeys * 64;
      const u16* Vp = (samp ? DVTS : DVTP) + (size_t)(b * 2 + (hd >> 2)) * 64 * nkeys;
      int nt0 = 4, key1 = 0, nt1 = 0;
      if (samp) { const int lo = min(max(qb * 128 - 128, 0), 4096 - 384); nt0 = 8; key1 = 512 + lo; nt1 = 6; }
      attn_item<64>(DQ + qoff, Kp, Vp, nkeys, nt0, key1, nt1, samp, qb * 128, true, p.in[27][hd] * LOG2E, AC + (size_t)tok * 1024 + 512 + hd * 64, 1024, shm + half * LDS_BYTES);
    }
  }
}

namespace pg8 {
#define PG8_LAS __attribute__((address_space(3)))
typedef unsigned short bf16_t;
typedef short bf16x8 __attribute__((ext_vector_type(8)));
typedef float f32x4 __attribute__((ext_vector_type(4)));
typedef unsigned u32x4 __attribute__((ext_vector_type(4)));
constexpr int BM = 256, BK = 64, HALF = 128, HTB = HALF * BK * 2  , STAGE_BYTES = 8 * HTB, NXCD = 8, WGM = 8;

__host__ __device__ __forceinline__ int lds_byte(int r, int c) { const int st = (r >> 4) * 2 + (c >> 5), rr = r & 15, cc = c & 31, ob = rr * 64 + cc * 2; return st * 1024 + (ob ^ (((ob >> 9) & 1) << 5)); }
__host__ __device__ __forceinline__ void stage_rc(int b, int& R, int& C) { const int st = b / 1024, sb = b % 1024, swz = sb ^ (((sb >> 9) & 1) << 5); R = (st >> 1) * 16 + swz / 64; C = (st & 1) * 32 + (swz % 64) / 2; }
__host__ __device__ __forceinline__ int perm32(int rho) { const int n = rho >> 4, i = rho & 15; return 8 * (i >> 2) + 4 * n + (i & 3); }

struct Unit { int pm, pn; };
struct Gemm { const bf16_t* A; const bf16_t* Bt; int M, N, K; };

struct StaticOrder {
    int nM, nN, nwg, G, c;
    __host__ __device__ void init(int M, int N, int G_, int c_) { nM = M / BM; nN = N / BM; nwg = nM * nN; G = G_; c = c_; }
    __host__ __device__ bool next(int i, Unit& u) const {
        const long L = (long)i * G + c; if (L >= nwg) return false;
        int wgid = (int)L; { const int q = nwg / NXCD, r = nwg % NXCD, xcd = wgid % NXCD, off = wgid / NXCD; wgid = (xcd < r ? xcd * (q + 1) : r * (q + 1) + (xcd - r) * q) + off; }
        const int nig = WGM * nN, gid = wgid / nig, fm = gid * WGM, gsz = (nM - fm) < WGM ? (nM - fm) : WGM;
        u.pm = fm + ((wgid % nig) % gsz); u.pn = (wgid % nig) / gsz; return true;
    }
    __device__ __forceinline__ void a_ready(const Unit&) const {}
    __device__ __forceinline__ void done(const Unit&) const {}
};
template <class Epi, class Sched, bool STAMP = false, int MB = 4>
__device__ __forceinline__ void gemm_phase(PG8_LAS unsigned char* lds, const Gemm g, const Sched& S, const Epi& E, unsigned long long* stamps) {
    const int tid = threadIdx.x, wid = __builtin_amdgcn_readfirstlane(tid >> 6), lane = tid & 63, wr = wid >> 2, wc = wid & 3, fr = lane & 15, fq = lane >> 4;
    const int K = g.K, nt = K / BK;
    int ts_lo = 0, ts_hi = 0, nts = 0; const unsigned long long rt_entry = STAMP ? (unsigned long long)wall_clock64() : 0ull;
#define PG8_STAMP() do { if (STAMP && wid == 0 && nts < 64) { const unsigned long long _c = (unsigned long long)clock64(); \
        ts_lo = (lane == nts) ? (int)(unsigned)_c : ts_lo; ts_hi = (lane == nts) ? (int)(unsigned)(_c >> 32) : ts_hi; ++nts; } } while (0)
    PG8_STAMP();
    unsigned voffA[2], voffB[2], voffB1[2];
#pragma unroll
    for (int i = 0; i < 2; ++i) { int R, C; stage_rc(tid * 16 + i * 8192, R, C); const int Rb = Epi::PERM ? ((R & ~31) + perm32(R & 31)) : R;
        voffA[i] = (unsigned)(R * K + C) * 2u; voffB[i] = (unsigned)(Rb * K + C) * 2u; voffB1[i] = voffB[i];
        if constexpr (Epi::HEADPERM) {
            const int rho = R & 31, np = rho >> 4, ii = rho & 15, fqq = ii >> 2, jj = ii & 3;
            const int d0 = 64 * (R >> 5) + 32 * (fqq >> 1) + 8 * (fqq & 1) + 4 * np + jj;
            voffB[i] = (unsigned)(d0 * K + C) * 2u; voffB1[i] = (unsigned)((d0 + 16) * K + C) * 2u; } }
    const size_t hB1 = Epi::HEADPERM ? (size_t)0 : (size_t)HALF * K * 2;
    const size_t kstep = (size_t)(BK * 2);
    const size_t hstep = (size_t)HALF * K * 2; const size_t hstepA = (size_t)(32 * MB) * K * 2;
    const size_t tstep = 2 * hstep; const size_t tstepA = 2 * hstepA;
    const unsigned ldsw = (unsigned)wid * 1024u;
    const int aoff = lds_byte(wr * 16 * MB + fr, fq * 8), boff = lds_byte(wc * 32 + fr, fq * 8);
#define PG8_SA(b, h) (((b) * 2 + (h)) * HTB)
#define PG8_SB(b, h) ((4 + (b) * 2 + (h)) * HTB)
#define PG8_STAGE(bufoff, gbase, voff) do { _Pragma("unroll") for (int _i = 0; _i < 2; ++_i) \
        __builtin_amdgcn_global_load_lds((const unsigned*)((const char*)(gbase) + (voff)[_i]), (PG8_LAS unsigned*)(lds + (bufoff) + ldsw + _i * 8192), 16, 0, 0); } while (0)
#define PG8_LDA(dst, b, h) do { _Pragma("unroll") for (int m = 0; m < MB; ++m) _Pragma("unroll") for (int k = 0; k < 2; ++k) dst[m][k] = *(const PG8_LAS bf16x8*)(lds + PG8_SA(b, h) + aoff + m * 2048 + k * 1024); } while (0)
#define PG8_LDB(dst, b, h) do { _Pragma("unroll") for (int n = 0; n < 2; ++n) _Pragma("unroll") for (int k = 0; k < 2; ++k) dst[n][k] = *(const PG8_LAS bf16x8*)(lds + PG8_SB(b, h) + boff + n * 2048 + k * 1024); } while (0)
#define PG8_MMA(ai, bj, At, Bt) do { __builtin_amdgcn_s_setprio(1); _Pragma("unroll") for (int m = 0; m < MB; ++m) _Pragma("unroll") for (int n = 0; n < 2; ++n) _Pragma("unroll") for (int k = 0; k < 2; ++k) \
        acc[ai][bj][m][n] = __builtin_amdgcn_mfma_f32_16x16x32_bf16(Bt[n][k], At[m][k], acc[ai][bj][m][n], 0, 0, 0); __builtin_amdgcn_s_setprio(0); } while (0)
#define PG8_WAIT_V(n) asm volatile("s_waitcnt vmcnt(" #n ")" ::: "memory")
#define PG8_WAIT_L(n) asm volatile("s_waitcnt lgkmcnt(" #n ")" ::: "memory")
#define PG8_BAR __builtin_amdgcn_s_barrier()
#define PG8_SCHED __builtin_amdgcn_sched_barrier(0)
    Unit cur, nxt; int ui = 0;
    if (!S.next(0, cur)) return;
    f32x4 acc[2][2][MB][2];
#pragma unroll
    for (int a = 0; a < 2; ++a)
#pragma unroll
        for (int b = 0; b < 2; ++b)
#pragma unroll
            for (int m = 0; m < MB; ++m)
#pragma unroll
                for (int n = 0; n < 2; ++n) acc[a][b][m][n] = (f32x4){0.f, 0.f, 0.f, 0.f};
    bf16x8 At[MB][2], B0[2][2], B1[2][2];
    const char* cA = (const char*)g.A + (size_t)cur.pm * tstepA; const char* cB = (const char*)g.Bt + (size_t)cur.pn * tstep;
    S.a_ready(cur);
    PG8_STAGE(PG8_SB(0, 0), cB, voffB); PG8_STAGE(PG8_SA(0, 0), cA, voffA); PG8_STAGE(PG8_SB(0, 1), cB + hB1, voffB1); PG8_STAGE(PG8_SA(0, 1), cA + hstepA, voffA);
    if (wr == 1) PG8_BAR;
    PG8_WAIT_V(4); PG8_BAR;
    PG8_STAGE(PG8_SB(1, 0), cB + kstep, voffB); PG8_STAGE(PG8_SA(1, 0), cA + kstep, voffA); PG8_STAGE(PG8_SB(1, 1), cB + hB1 + kstep, voffB1);
    PG8_WAIT_V(6); PG8_BAR;
    PG8_STAMP();
    for (;;) {
        const bool has_next = S.next(ui + 1, nxt);
        const char* nA = has_next ? (const char*)g.A + (size_t)nxt.pm * tstepA : cA; const char* nB = has_next ? (const char*)g.Bt + (size_t)nxt.pn * tstep : cB;
        for (int t = 0; t < nt; t += 2) {
            const bool last = (t == nt - 2);
            const char* a1 = cA + (size_t)(t + 1) * kstep;
            const char* a2 = last ? nA : cA + (size_t)(t + 2) * kstep; const char* b2 = last ? nB : cB + (size_t)(t + 2) * kstep;
            const char* a3 = a2 + kstep; const char* b3 = b2 + kstep;
            if (last && has_next) S.a_ready(nxt);
            PG8_LDB(B0, 0, 0); PG8_SCHED; PG8_LDA(At, 0, 0); PG8_STAGE(PG8_SA(1, 1), a1 + hstepA, voffA);
            PG8_WAIT_L(8); PG8_BAR; PG8_WAIT_L(0); PG8_MMA(0, 0, At, B0); PG8_BAR; PG8_SCHED;
            PG8_LDB(B1, 0, 1); PG8_STAGE(PG8_SB(0, 0), b2, voffB);
            PG8_BAR; PG8_WAIT_L(0); PG8_MMA(0, 1, At, B1); PG8_BAR;
            PG8_LDA(At, 0, 1); PG8_STAGE(PG8_SA(0, 0), a2, voffA);
            PG8_BAR; PG8_WAIT_L(0); PG8_MMA(1, 0, At, B0); PG8_BAR; PG8_SCHED;
            PG8_STAGE(PG8_SB(0, 1), b2 + hB1, voffB1);
            PG8_WAIT_V(6); PG8_BAR; PG8_MMA(1, 1, At, B1); PG8_BAR;
            PG8_LDB(B0, 1, 0); PG8_SCHED; PG8_LDA(At, 1, 0); PG8_STAGE(PG8_SA(0, 1), a2 + hstepA, voffA);
            PG8_WAIT_L(8); PG8_BAR; PG8_WAIT_L(0); PG8_MMA(0, 0, At, B0); PG8_BAR; PG8_SCHED;
            PG8_LDB(B1, 1, 1); PG8_STAGE(PG8_SB(1, 0), b3, voffB);
            PG8_BAR; PG8_WAIT_L(0); PG8_MMA(0, 1, At, B1); PG8_BAR;
            PG8_LDA(At, 1, 1); PG8_STAGE(PG8_SA(1, 0), a3, voffA);
            PG8_BAR; PG8_WAIT_L(0); PG8_MMA(1, 0, At, B0); PG8_BAR; PG8_SCHED;
            PG8_STAGE(PG8_SB(1, 1), b3 + hB1, voffB1);
            PG8_WAIT_V(6); PG8_BAR; PG8_MMA(1, 1, At, B1); PG8_BAR;
        }
        PG8_STAMP();
        if constexpr (!Epi::AFTER_DRAIN) { E(acc, cur, wr, wc, fr, fq); S.done(cur); }
        PG8_STAMP();
        if (!has_next) break;
#pragma unroll
        for (int a = 0; a < 2; ++a)
#pragma unroll
            for (int b = 0; b < 2; ++b)
#pragma unroll
                for (int m = 0; m < MB; ++m)
#pragma unroll
                    for (int n = 0; n < 2; ++n) acc[a][b][m][n] = (f32x4){0.f, 0.f, 0.f, 0.f};
        cur = nxt; cA = nA; cB = nB; ++ui;
    }
    PG8_WAIT_V(0);
    if (wr == 0) PG8_BAR;
    PG8_BAR;
    if constexpr (Epi::AFTER_DRAIN) { E.fused(acc, cur, wr, wc, fr, fq, lds, wid, lane); S.done(cur); }
    PG8_STAMP();
    if (STAMP && wid == 0) { stamps[lane] = lane < nts ? (((unsigned long long)(unsigned)ts_hi << 32) | (unsigned)ts_lo) : 0ull;
        if (lane == 62) stamps[62] = rt_entry; if (lane == 63) stamps[63] = (unsigned long long)wall_clock64(); }
#undef PG8_STAMP
#undef PG8_SA
#undef PG8_SB
#undef PG8_STAGE
#undef PG8_LDA
#undef PG8_LDB
#undef PG8_MMA
#undef PG8_WAIT_V
#undef PG8_WAIT_L
#undef PG8_BAR
#undef PG8_SCHED
}
}

typedef float f32x4 __attribute__((ext_vector_type(4)));
template <class F, int MB> struct RowEpi {
  static constexpr bool PERM = false, AFTER_DRAIN = false, HEADPERM = false;
  F f;
  DI void operator()(const pg8::f32x4 (&acc)[2][2][MB][2], const pg8::Unit& u, int wr, int wc, int fr, int fq) const {
    const int row0 = u.pm * (64 * MB) + wr * 16 * MB + fr, col0 = u.pn * 256 + wc * 32 + 4 * fq;
#pragma unroll
    for (int ai = 0; ai < 2; ++ai)
#pragma unroll
      for (int m = 0; m < MB; ++m)
#pragma unroll
        for (int bj = 0; bj < 2; ++bj)
#pragma unroll
          for (int n = 0; n < 2; ++n) f(row0 + ai * 32 * MB + m * 16, col0 + bj * 128 + n * 16, acc[ai][bj][m][n]);
  }
};
struct FU {
  u16* UA; u16* PQt;
  DI void operator()(int m, int n, pg8::f32x4 v) const {
    if (n < 512) {
      uint2 w; w.x = pack2(v[0], v[1]); w.y = pack2(v[2], v[3]);
      *(uint2*)(UA + (size_t)m * 512 + n) = w;
    } else {
      const int np = n - 512, g = np >> 8, pq = (np >> 7) & 1, mm = np & 127;
      u16* q; size_t st;
      if (m < 4096) { const int b = m >> 8, nl = m & 255; q = PQt + ((size_t)(b * 512 + g * 128 + mm)) * 512 + pq * 256 + nl; st = 512; }
      else { const int ms = m - 4096, b = ms >> 12, nl = ms & 4095; q = PQt + (size_t)16 * 512 * 512 + ((size_t)(b * 512 + g * 128 + mm)) * 8192 + pq * 4096 + nl; st = 8192; }
      q[0] = f2bf(v[0]); q[st] = f2bf(v[1]); q[2 * st] = f2bf(v[2]); q[3 * st] = f2bf(v[3]);
    }
  }
};
struct FRes {
  const float* xin_p; const float* xin_s; float* X; const float* gate;
  DI void operator()(int m, int n, pg8::f32x4 v) const {
    const float* xi = (m < 4096) ? xin_p + (size_t)m * 1024 + n : xin_s + (size_t)(m - 4096) * 1024 + n;
    const float4 x = *(const float4*)xi;
    const float4 g = *(const float4*)(gate + cond_of(m) * 6144 + n);
    *(float4*)(X + (size_t)m * 1024 + n) = make_float4(x.x + g.x * v[0], x.y + g.y * v[1], x.z + g.z * v[2], x.w + g.w * v[3]);
  }
};
struct FRelu2 {
  u16* C;
  DI void operator()(int m, int n, pg8::f32x4 v) const {
    const float a = fmaxf(v[0], 0.f), b = fmaxf(v[1], 0.f), c = fmaxf(v[2], 0.f), d = fmaxf(v[3], 0.f);
    uint2 w; w.x = pack2(a * a, b * b); w.y = pack2(c * c, d * d);
    *(uint2*)(C + (size_t)m * 4096 + n) = w;
  }
};
struct FQkv {
  u16* QKV; u16* CVtP; u16* CVtS; u16* DVtP; u16* DVtS; float* ncv; float* ndv;
  DI void operator()(int m, int n, pg8::f32x4 v) const {
    const bool is_cv = (n >= 1024 && n < 1536), is_dv = (n >= 2176);
    if (!is_cv && !is_dv) {
      uint2 w; w.x = pack2(v[0], v[1]); w.y = pack2(v[2], v[3]);
      *(uint2*)(QKV + (size_t)m * 2304 + n) = w;
      return;
    }
    const int c = is_cv ? n - 1024 : n - 2176;
    const int feat = is_cv ? 512 : 128;
    u16* q; size_t st;
    if (m < 4096) {
      const int b = m >> 8, nl = m & 255;
      q = (is_cv ? CVtP : DVtP) + ((size_t)(b * feat + c)) * 256 + nl; st = 256;
      *(float4*)((is_cv ? ncv : ndv) + (size_t)m * feat + c) = make_float4(v[0], v[1], v[2], v[3]);
    } else {
      const int ms = m - 4096, b = ms >> 12, nl = ms & 4095;
      q = (is_cv ? CVtS : DVtS) + ((size_t)(b * feat + c)) * 4608 + 512 + nl; st = 4608;
    }
    q[0] = f2bf(v[0]); q[st] = f2bf(v[1]); q[2 * st] = f2bf(v[2]); q[3 * st] = f2bf(v[3]);
  }
};
template <int MB, class F>
DI void big_gemm(PG8_LAS unsigned char* lds, const u16* A, const u16* Bt, int M, int N, int K, F f) {
  pg8::Gemm g{A, Bt, M, N, K};
  pg8::StaticOrder S; S.init(M, N, (int)gridDim.x, (int)blockIdx.x);
  S.nM = M / (64 * MB); S.nwg = S.nM * S.nN;
  RowEpi<F, MB> E{f};
  pg8::gemm_phase<RowEpi<F, MB>, pg8::StaticOrder, false, MB>(lds, g, S, E, nullptr);
}

template <class F, int MB> struct RowEpi8 {
  static constexpr bool PERM = true, AFTER_DRAIN = false, HEADPERM = false;
  F f;
  DI void operator()(const pg8::f32x4 (&acc)[2][2][MB][2], const pg8::Unit& u, int wr, int wc, int fr, int fq) const {
    const int row0 = u.pm * (64 * MB) + wr * 16 * MB + fr, col0 = u.pn * 256 + wc * 32 + 8 * fq;
#pragma unroll
    for (int ai = 0; ai < 2; ++ai)
#pragma unroll
      for (int m = 0; m < MB; ++m)
#pragma unroll
        for (int bj = 0; bj < 2; ++bj) f(row0 + ai * 32 * MB + m * 16, col0 + bj * 128, acc[ai][bj][m][0], acc[ai][bj][m][1]);
  }
};
struct FRelu2x8 {
  u16* C;
  DI void operator()(int m, int n, pg8::f32x4 a, pg8::f32x4 b) const {
    uint4 w;
    float x0 = fmaxf(a[0], 0.f), x1 = fmaxf(a[1], 0.f), x2 = fmaxf(a[2], 0.f), x3 = fmaxf(a[3], 0.f);
    float y0 = fmaxf(b[0], 0.f), y1 = fmaxf(b[1], 0.f), y2 = fmaxf(b[2], 0.f), y3 = fmaxf(b[3], 0.f);
    w.x = pack2(x0 * x0, x1 * x1); w.y = pack2(x2 * x2, x3 * x3); w.z = pack2(y0 * y0, y1 * y1); w.w = pack2(y2 * y2, y3 * y3);
    *(uint4*)(C + (size_t)m * 4096 + n) = w;
  }
};
struct FUx8 {
  u16* UA; u16* PQt;
  DI void operator()(int m, int n, pg8::f32x4 a, pg8::f32x4 b) const {
    if (n < 512) {
      uint4 w; w.x = pack2(a[0], a[1]); w.y = pack2(a[2], a[3]); w.z = pack2(b[0], b[1]); w.w = pack2(b[2], b[3]);
      *(uint4*)(UA + (size_t)m * 512 + n) = w;
    } else {
      const int np = n - 512, g = np >> 8, pq = (np >> 7) & 1, mm = np & 127;
      u16* q; size_t st;
      if (m < 4096) { const int bb = m >> 8, nl = m & 255; q = PQt + ((size_t)(bb * 512 + g * 128 + mm)) * 512 + pq * 256 + nl; st = 512; }
      else { const int ms = m - 4096, bb = ms >> 12, nl = ms & 4095; q = PQt + (size_t)16 * 512 * 512 + ((size_t)(bb * 512 + g * 128 + mm)) * 8192 + pq * 4096 + nl; st = 8192; }
      q[0] = f2bf(a[0]); q[st] = f2bf(a[1]); q[2 * st] = f2bf(a[2]); q[3 * st] = f2bf(a[3]);
      q[4 * st] = f2bf(b[0]); q[5 * st] = f2bf(b[1]); q[6 * st] = f2bf(b[2]); q[7 * st] = f2bf(b[3]);
    }
  }
};
struct FQkvx8 {
  u16* QKV; u16* CVtP; u16* CVtS; u16* DVtP; u16* DVtS; float* ncv; float* ndv;
  DI void operator()(int m, int n, pg8::f32x4 a, pg8::f32x4 b) const {
    const bool is_cv = (n >= 1024 && n < 1536), is_dv = (n >= 2176);
    if (!is_cv && !is_dv) {
      uint4 w; w.x = pack2(a[0], a[1]); w.y = pack2(a[2], a[3]); w.z = pack2(b[0], b[1]); w.w = pack2(b[2], b[3]);
      *(uint4*)(QKV + (size_t)m * 2304 + n) = w;
      return;
    }
    const int c = is_cv ? n - 1024 : n - 2176;
    const int feat = is_cv ? 512 : 128;
    u16* q; size_t st;
    if (m < 4096) {
      const int bb = m >> 8, nl = m & 255;
      q = (is_cv ? CVtP : DVtP) + ((size_t)(bb * feat + c)) * 256 + nl; st = 256;
      float* o = (is_cv ? ncv : ndv) + (size_t)m * feat + c;
      *(float4*)o = make_float4(a[0], a[1], a[2], a[3]);
      *(float4*)(o + 4) = make_float4(b[0], b[1], b[2], b[3]);
    } else {
      const int ms = m - 4096, bb = ms >> 12, nl = ms & 4095;
      q = (is_cv ? CVtS : DVtS) + ((size_t)(bb * feat + c)) * 4608 + 512 + nl; st = 4608;
    }
    q[0] = f2bf(a[0]); q[st] = f2bf(a[1]); q[2 * st] = f2bf(a[2]); q[3 * st] = f2bf(a[3]);
    q[4 * st] = f2bf(b[0]); q[5 * st] = f2bf(b[1]); q[6 * st] = f2bf(b[2]); q[7 * st] = f2bf(b[3]);
  }
};
template <int MB, class F>
DI void big_gemm8(PG8_LAS unsigned char* lds, const u16* A, const u16* Bt, int M, int N, int K, F f) {
  pg8::Gemm g{A, Bt, M, N, K};
  pg8::StaticOrder S; S.init(M, N, (int)gridDim.x, (int)blockIdx.x);
  S.nM = M / (64 * MB); S.nwg = S.nM * S.nN;
  RowEpi8<F, MB> E{f};
  pg8::gemm_phase<RowEpi8<F, MB>, pg8::StaticOrder, false, MB>(lds, g, S, E, nullptr);
}

template <int MB> struct ResNormEpi {
  static constexpr bool PERM = false, AFTER_DRAIN = true, HEADPERM = false;
  const float* xin_p; const float* xin_s; float* X; const float* gate;
  const float* gain; const float* nmods; u16* Hout; float* part; unsigned* cnt;
  DI void operator()(const pg8::f32x4 (&)[2][2][MB][2], const pg8::Unit&, int, int, int, int) const {}
  DI void fused(pg8::f32x4 (&acc)[2][2][MB][2], const pg8::Unit& u, int wr, int wc, int fr, int fq, PG8_LAS unsigned char* lds, int wid, int lane) const {
    constexpr int ROWS = 64 * MB;
    const int tid = (int)threadIdx.x;
    const int rbase = u.pm * ROWS;
    const int row0 = rbase + wr * 16 * MB + fr, col0 = u.pn * 256 + wc * 32 + 4 * fq;
    PG8_LAS float* red = (PG8_LAS float*)lds;
    PG8_LAS float* rinvs = red + ROWS * 4;
#pragma unroll
    for (int ai = 0; ai < 2; ++ai)
#pragma unroll
      for (int m = 0; m < MB; ++m) {
        const int row = row0 + ai * 32 * MB + m * 16;
        const float* xi = (row < 4096) ? xin_p + (size_t)row * 1024 : xin_s + (size_t)(row - 4096) * 1024;
        const float* gp = gate + cond_of(row) * 6144;
        float ss = 0.f;
#pragma unroll
        for (int bj = 0; bj < 2; ++bj)
#pragma unroll
          for (int n = 0; n < 2; ++n) {
            const int col = col0 + bj * 128 + n * 16;
            const float4 x = *(const float4*)(xi + col);
            const float4 g = *(const float4*)(gp + col);
            pg8::f32x4 v = acc[ai][bj][m][n];
            v[0] = x.x + g.x * v[0]; v[1] = x.y + g.y * v[1]; v[2] = x.z + g.z * v[2]; v[3] = x.w + g.w * v[3];
            *(float4*)(X + (size_t)row * 1024 + col) = make_float4(v[0], v[1], v[2], v[3]);
            acc[ai][bj][m][n] = v;
            ss += v[0] * v[0] + v[1] * v[1] + v[2] * v[2] + v[3] * v[3];
          }
        ss += __shfl_xor(ss, 16); ss += __shfl_xor(ss, 32);
        if (fq == 0) red[(row - rbase) * 4 + wc] = ss;
      }
    __syncthreads();
    if (tid < ROWS) {
      const float sum = (red[tid * 4] + red[tid * 4 + 1]) + (red[tid * 4 + 2] + red[tid * 4 + 3]);
      __hip_atomic_store(part + (size_t)u.pn * T + rbase + tid, sum, __ATOMIC_RELAXED, __HIP_MEMORY_SCOPE_AGENT);
    }
    asm volatile("s_waitcnt vmcnt(0)" ::: "memory");
    __syncthreads();
    if (tid == 0) {
      unsigned* c = cnt + (size_t)u.pm * 16;
      __hip_atomic_fetch_add(c, 1u, __ATOMIC_RELAXED, __HIP_MEMORY_SCOPE_AGENT);
      unsigned sp = 0;
      while (__hip_atomic_load(c, __ATOMIC_RELAXED, __HIP_MEMORY_SCOPE_AGENT) < 4u) { __builtin_amdgcn_s_sleep(1); if (++sp > (1u << 22)) break; }
      __builtin_amdgcn_fence(__ATOMIC_ACQUIRE, "agent");
      asm volatile("s_waitcnt vmcnt(0)" ::: "memory");
    }
    __syncthreads();
    if (tid < ROWS) {
      const float* pp = part + rbase + tid;
      const float tot = (__hip_atomic_load(pp, __ATOMIC_RELAXED, __HIP_MEMORY_SCOPE_AGENT) + __hip_atomic_load(pp + T, __ATOMIC_RELAXED, __HIP_MEMORY_SCOPE_AGENT)) +
                        (__hip_atomic_load(pp + 2 * T, __ATOMIC_RELAXED, __HIP_MEMORY_SCOPE_AGENT) + __hip_atomic_load(pp + 3 * T, __ATOMIC_RELAXED, __HIP_MEMORY_SCOPE_AGENT));
      rinvs[tid] = rsqrtf(tot * (1.0f / 1024.0f) + EPS);
    }
    __syncthreads();
#pragma unroll
    for (int ai = 0; ai < 2; ++ai)
#pragma unroll
      for (int m = 0; m < MB; ++m) {
        const int row = row0 + ai * 32 * MB + m * 16;
        const float rv = rinvs[row - rbase];
        const float* md = nmods + cond_of(row) * 6144;
#pragma unroll
        for (int bj = 0; bj < 2; ++bj)
#pragma unroll
          for (int n = 0; n < 2; ++n) {
            const int col = col0 + bj * 128 + n * 16;
            const float4 g = *(const float4*)(gain + col);
            const float4 sh = *(const float4*)(md + col);
            const float4 sc = *(const float4*)(md + 1024 + col);
            const pg8::f32x4 v = acc[ai][bj][m][n];
            uint2 w;
            w.x = pack2(v[0] * rv * g.x * (1.f + sc.x) + sh.x, v[1] * rv * g.y * (1.f + sc.y) + sh.y);
            w.y = pack2(v[2] * rv * g.z * (1.f + sc.z) + sh.z, v[3] * rv * g.w * (1.f + sc.w) + sh.w);
            *(uint2*)(Hout + (size_t)row * 1024 + col) = w;
          }
      }
    __syncthreads();
  }
};
template <int MB>
DI void big_gemm_resnorm(PG8_LAS unsigned char* lds, const u16* A, const u16* Bt, int M, int N, int K, ResNormEpi<MB> E) {
  pg8::Gemm g{A, Bt, M, N, K};
  pg8::StaticOrder S; S.init(M, N, (int)gridDim.x, (int)blockIdx.x);
  S.nM = M / (64 * MB); S.nwg = S.nM * S.nN;
  pg8::gemm_phase<ResNormEpi<MB>, pg8::StaticOrder, false, MB>(lds, g, S, E, nullptr);
}

struct QkvHeadEpi {
  static constexpr bool PERM = false, AFTER_DRAIN = false, HEADPERM = true;
  unsigned char* ws; float* out;
  const float* cqn; const float* ckn; const float* dqn; const float* dkn;
  DI void operator()(const pg8::f32x4 (&acc)[2][2][4][2], const pg8::Unit& u, int wr, int wc, int fr, int fq) const {
    const int hd = u.pn * 4 + wc;
    const int ax = fq >> 1;
    const int dlo = 32 * ax + 8 * (fq & 1);
    const bool isv = (hd >= 16 && hd < 24) || hd >= 34;
    const bool isq = hd < 8 || (hd >= 24 && hd < 32);
    float g0[8], g1[8], frq[8];
#pragma unroll
    for (int e = 0; e < 8; ++e) { g0[e] = 1.f; g1[e] = 1.f; }
    if (hd < 8) {
#pragma unroll
      for (int e = 0; e < 8; ++e) { g0[e] = cqn[dlo + e]; g1[e] = cqn[dlo + 16 + e]; }
    } else if (hd < 16) {
#pragma unroll
      for (int e = 0; e < 8; ++e) { g0[e] = ckn[dlo + e]; g1[e] = ckn[dlo + 16 + e]; }
    } else if (hd >= 24 && hd < 32) {
#pragma unroll
      for (int e = 0; e < 8; ++e) { g0[e] = dqn[dlo + e]; g1[e] = dqn[dlo + 16 + e]; }
    } else if (hd >= 32 && hd < 34) {
#pragma unroll
      for (int e = 0; e < 8; ++e) { g0[e] = dkn[dlo + e]; g1[e] = dkn[dlo + 16 + e]; }
    }
#pragma unroll
    for (int e = 0; e < 8; ++e) {
      frq[e] = exp2f(-(float)(8 * (fq & 1) + e) * (13.287712379549449f / 16.0f)) * 0.15915494309189535f;
    }
    const int row00 = u.pm * 256 + wr * 64 + fr;
    const bool samp = row00 >= 4096;
#pragma unroll
    for (int ai = 0; ai < 2; ++ai)
#pragma unroll
      for (int m = 0; m < 4; ++m) {
        const int row = row00 + ai * 128 + m * 16;
        int b, nl;
        if (!samp) { b = row >> 8; nl = row & 255; } else { b = (row - 4096) >> 12; nl = (row - 4096) & 4095; }
        float x0[8], x1[8];
#pragma unroll
        for (int e = 0; e < 8; ++e) { x0[e] = acc[ai][0][m][e >> 2][e & 3]; x1[e] = acc[ai][1][m][e >> 2][e & 3]; }
        if (isv) {
          const bool cvh = hd < 24;
          const int feat = cvh ? 512 : 128;
          const int c = (cvh ? (hd - 16) : (hd - 34)) * 64 + dlo;
          u16* q; size_t st;
          if (!samp) {
            q = (u16*)(ws + (cvh ? OFF_CVTP : OFF_DVTP)) + ((size_t)(b * feat + c)) * 256 + nl; st = 256;
            float* o = out + (cvh ? OUT_NCV : OUT_NDV) + (size_t)row * feat + c;
            *(float4*)o = make_float4(x0[0], x0[1], x0[2], x0[3]); *(float4*)(o + 4) = make_float4(x0[4], x0[5], x0[6], x0[7]);
            *(float4*)(o + 16) = make_float4(x1[0], x1[1], x1[2], x1[3]); *(float4*)(o + 20) = make_float4(x1[4], x1[5], x1[6], x1[7]);
          } else { q = (u16*)(ws + (cvh ? OFF_CVTS : OFF_DVTS)) + ((size_t)(b * feat + c)) * 4608 + 512 + nl; st = 4608; }
#pragma unroll
          for (int e = 0; e < 8; ++e) { q[e * st] = f2bf(x0[e]); q[(16 + e) * st] = f2bf(x1[e]); }
        } else {
          float ss = 0.f;
#pragma unroll
          for (int e = 0; e < 8; ++e) ss += x0[e] * x0[e] + x1[e] * x1[e];
          ss += __shfl_xor(ss, 16); ss += __shfl_xor(ss, 32);
          const float rinv = rsqrtf(ss * (1.0f / 64.0f) + EPS);
          float o0[8], o1[8];
          const float pos = samp ? (float)(ax ? (nl & 63) : (nl >> 6)) : 0.f;
#pragma unroll
          for (int e = 0; e < 8; ++e) {
            const float y0 = x0[e] * rinv * g0[e], y1 = x1[e] * rinv * g1[e];
            const float rev = pos * frq[e];
            const float cs = samp ? __builtin_amdgcn_cosf(rev) : 1.f, sn = samp ? __builtin_amdgcn_sinf(rev) : 0.f;
            o0[e] = y0 * cs - y1 * sn;
            o1[e] = y1 * cs + y0 * sn;
          }
          if (isq) {
            const int head = hd < 8 ? hd : hd - 24;
            u16* dst = (u16*)(ws + (hd < 8 ? OFF_CQ : OFF_DQ)) + (samp ? (size_t)16 * 8 * 256 * 64 + ((size_t)(b * 8 + head) * 4096 + nl) * 64 : ((size_t)(b * 8 + head) * 256 + nl) * 64) + dlo;
            *(uint4*)dst = make_uint4(pack2(o0[0] * QSCALE, o0[1] * QSCALE), pack2(o0[2] * QSCALE, o0[3] * QSCALE), pack2(o0[4] * QSCALE, o0[5] * QSCALE), pack2(o0[6] * QSCALE, o0[7] * QSCALE));
            *(uint4*)(dst + 16) = make_uint4(pack2(o1[0] * QSCALE, o1[1] * QSCALE), pack2(o1[2] * QSCALE, o1[3] * QSCALE), pack2(o1[4] * QSCALE, o1[5] * QSCALE), pack2(o1[6] * QSCALE, o1[7] * QSCALE));
          } else {
            const bool ckh = hd < 16;
            const int kh = ckh ? hd - 8 : hd - 32, nkh = ckh ? 8 : 2;
            u16* dst = samp ? (u16*)(ws + (ckh ? OFF_CKS : OFF_DKS)) + ((size_t)(b * nkh + kh) * 4608 + 512 + nl) * 64 + dlo
                            : (u16*)(ws + (ckh ? OFF_CKP : OFF_DKP)) + ((size_t)(b * nkh + kh) * 256 + nl) * 64 + dlo;
            *(uint4*)dst = make_uint4(pack2(o0[0], o0[1]), pack2(o0[2], o0[3]), pack2(o0[4], o0[5]), pack2(o0[6], o0[7]));
            *(uint4*)(dst + 16) = make_uint4(pack2(o1[0], o1[1]), pack2(o1[2], o1[3]), pack2(o1[4], o1[5]), pack2(o1[6], o1[7]));
            if (!samp) {
              float* o = out + (ckh ? OUT_NCK + (size_t)row * 512 : OUT_NDK + (size_t)row * 128) + kh * 64 + dlo;
              *(float4*)o = make_float4(o0[0], o0[1], o0[2], o0[3]); *(float4*)(o + 4) = make_float4(o0[4], o0[5], o0[6], o0[7]);
              *(float4*)(o + 16) = make_float4(o1[0], o1[1], o1[2], o1[3]); *(float4*)(o + 20) = make_float4(o1[4], o1[5], o1[6], o1[7]);
            }
          }
        }
      }
  }
};
DI void big_gemm_qkv(PG8_LAS unsigned char* lds, const u16* A, const u16* Bt, int M, int N, int K, QkvHeadEpi E) {
  pg8::Gemm g{A, Bt, M, N, K};
  pg8::StaticOrder S; S.init(M, N, (int)gridDim.x, (int)blockIdx.x);
  pg8::gemm_phase<QkvHeadEpi, pg8::StaticOrder, false, 4>(lds, g, S, E, nullptr);
}

#define XB_TMO      128
#define XB_XCNT(j)  (256  + 64 * (j))
#define XB_XSUB(j)  (1280 + 64 * (j))
#define XB_XGEN(j)  (2304 + 64 * (j))
#define XB_TOP      3328
#define XB_TOPGEN   3392
#define XCD_BAR_WORDS 3456
#define XB_SPIN_CAP (1u << 18)
#define LAS __attribute__((address_space(3)))
DI unsigned xb_ld(unsigned* p)              { return __hip_atomic_load(p, __ATOMIC_RELAXED, __HIP_MEMORY_SCOPE_AGENT); }
DI unsigned xb_add(unsigned* p, unsigned v) { return __hip_atomic_fetch_add(p, v, __ATOMIC_RELAXED, __HIP_MEMORY_SCOPE_AGENT); }
DI unsigned xb_xcc_id() { return (unsigned)__builtin_amdgcn_s_getreg((3 << 11) | 20) & 0xFu; }
#define XB_SPIN(cond, bar) do { unsigned _sp = 0; while (cond) { __builtin_amdgcn_s_sleep(1); \
    if ((++_sp & 255u) == 0u) { if (xb_ld(&(bar)[XB_TMO])) break; if (_sp > XB_SPIN_CAP) { atomicAdd(&(bar)[XB_TMO], 1u); break; } } } } while (0)
struct XcdBarrier { unsigned* bar; unsigned x; volatile LAS unsigned* st; };
DI XcdBarrier xcd_barrier_post(unsigned* bar, volatile LAS unsigned* st) {
  XcdBarrier b; b.bar = bar; b.x = xb_xcc_id(); b.st = st;
  if (threadIdx.x == 0) (void)xb_add(&bar[XB_XCNT(b.x)], 1u);
  return b;
}
DI void xcd_barrier_complete(unsigned* bar, unsigned x, unsigned& nloc, unsigned& nx) {
  const unsigned G = gridDim.x;
  unsigned sum, cnt, mine, sp = 0u;
  for (;;) {
    sum = 0u; cnt = 0u; mine = 0u;
#pragma unroll
    for (unsigned j = 0; j < 16; ++j) { const unsigned c = xb_ld(&bar[XB_XCNT(j)]); sum += c; cnt += (c > 0u) ? 1u : 0u; mine = (j == x) ? c : mine; }
    if (sum == G) break;
    __builtin_amdgcn_s_sleep(1);
    if ((++sp & 255u) == 0u) { if (xb_ld(&bar[XB_TMO])) break; if (sp > XB_SPIN_CAP) { atomicAdd(&bar[XB_TMO], 1u); break; } }
  }
  nloc = mine > 0u ? mine : 1u; nx = cnt > 0u ? cnt : 1u;
}
DI void xcd_barrier(const XcdBarrier& b) {
  asm volatile("s_waitcnt vmcnt(0)" ::: "memory");
  __syncthreads();
  if (threadIdx.x == 0) {
    unsigned* bar = b.bar;
    __builtin_amdgcn_s_waitcnt(0);
    unsigned nloc = b.st[0], nx = b.st[1];
    if (nloc == 0u) { xcd_barrier_complete(bar, b.x, nloc, nx); b.st[0] = nloc; b.st[1] = nx; }
    const unsigned old = xb_add(&bar[XB_XSUB(b.x)], 1u);
    const unsigned gen = old / nloc;
    if (old + 1u == (gen + 1u) * nloc) {
      __builtin_amdgcn_fence(__ATOMIC_RELEASE, "agent");
      asm volatile("s_waitcnt vmcnt(0)" ::: "memory");
      const unsigned og = xb_add(&bar[XB_TOP], 1u);
      const unsigned tg = og / nx;
      if (og + 1u == (tg + 1u) * nx) xb_add(&bar[XB_TOPGEN], 1u);
      else XB_SPIN(xb_ld(&bar[XB_TOPGEN]) == tg, bar);
      __builtin_amdgcn_fence(__ATOMIC_ACQUIRE, "agent");
      xb_add(&bar[XB_XGEN(b.x)], 1u);
      asm volatile("s_waitcnt vmcnt(0)" ::: "memory");
    } else {
      XB_SPIN(xb_ld(&bar[XB_XGEN(b.x)]) == gen, bar);
      __builtin_amdgcn_fence(__ATOMIC_ACQUIRE, "agent");
      asm volatile("s_waitcnt vmcnt(0)" ::: "memory");
    }
  }
  __syncthreads();
}

__global__ void __launch_bounds__(512) fwd_kernel(Params p, int ph_lo, int ph_hi, int dup) {
  extern __shared__ __attribute__((aligned(16))) unsigned char shm[];
  const int half = threadIdx.x >> 8;
  char* lds = (char*)shm + half * LDS_BYTES;
  PG8_LAS unsigned char* lds8 = (PG8_LAS unsigned char*)shm;
  const int G = 2 * (int)gridDim.x;
  int vb0 = blockIdx.x;
  if ((gridDim.x & 7) == 0) vb0 = (blockIdx.x & 7) * (gridDim.x >> 3) + (blockIdx.x >> 3);
  const int vb = 2 * vb0 + half;
  unsigned char* ws = p.ws;
  const float* mods = (const float*)(ws + OFF_MODS);
  float* X = p.out + OUT_Y;
  u16* H = (u16*)(ws + OFF_H);

#define RUNPH(n) ((ONLYPH < 0 || ONLYPH == (n)) && ph_lo <= (n) && (n) < ph_hi)
#define REP(n) _Pragma("unroll 1") for (int rep_ = 0; rep_ < ((DUPPH == (n)) ? ((dup == (n)) ? 2 : 1) : 1); ++rep_)
#define SEAM(n) if (ph_lo < (n) && (n) < ph_hi) xcd_barrier(xb);
  __shared__ uint4 xb_words;
  if (threadIdx.x == 0) xb_words = make_uint4(0u, 0u, 0u, 0u);
  __syncthreads();
  XcdBarrier xb = xcd_barrier_post((unsigned*)(ws + OFF_BAR), (volatile LAS unsigned*)&xb_words);
  if (ph_hi > 1000) cg::this_grid().sync();
  if (RUNPH(0)) REP(0) {
    for (int id = vb; id < 384; id += G) ada_item(p, id, lds);
    prep_transposes(p, vb, G, lds, 0);
    prep_elementwise(p, vb, G);
  }
  SEAM(1)
  if (RUNPH(1)) REP(1) {
    for (int t = vb; t < 128; t += G) {
      const bool f1 = t < 64;
      const int q = t & 63, m0 = (q >> 3) << 7, n0 = (q & 7) << 7;
      const int koff = f1 ? (m0 >> 8) * 128 : n0;
      gemm_tile((f1 ? (const u16*)(ws + OFF_CBD) : (const u16*)(ws + OFF_WOUT_ET)) + koff, f1 ? 512 : 1024,
                (f1 ? (const u16*)(ws + OFF_WINB) : (const u16*)(ws + OFF_BD)) + koff, f1 ? 512 : 1024, 128, m0, n0,
                EpiBf16{f1 ? (u16*)(ws + OFF_WIN_E) + (size_t)512 * 1024 : (u16*)(ws + OFF_WOUT_E), 1024}, lds);
    }
    normmod_phase(p, vb, G, p.in[0], p.in[1], p.in[8], 0, 0);
    if (vb >= 128) prep_transposes(p, vb - 128, G - 128, lds, 1, 0, 832);
  }
  SEAM(2)
  if (RUNPH(2)) REP(2)
  {
    big_gemm8<3>(lds8, H, (const u16*)(ws + OFF_WIN_E), T, 1536, 1024, FUx8{(u16*)(ws + OFF_UA), (u16*)(ws + OFF_PQT)});
    if (blockIdx.x >= 128) prep_transposes(p, ((int)blockIdx.x - 128) * 2 + half, ((int)gridDim.x - 128) * 2, lds, 1, 832, 1856);
  }
  SEAM(3)
  if (RUNPH(3)) REP(3) sym_phase(p, vb, G);
  SEAM(4)
  if (RUNPH(4)) REP(4) {
    const u16* PQT = (const u16*)(ws + OFF_PQT);
    const u16* PEQO = (const u16*)(ws + OFF_PEQO);
    for (int t = vb0; t < 256 + 128; t += (int)gridDim.x) {
      const bool big = t < 256;
      const int q = t - 256, b = q >> 3;
      dft_pair(big ? (const u16*)(ws + OFF_D4096) : (const u16*)(ws + OFF_D256),
               big ? PEQO + (size_t)16 * 512 * 256 : PEQO + (size_t)b * 512 * 256,
               big ? PQT + (size_t)16 * 512 * 512 + 2048 : PQT + (size_t)b * 512 * 512 + 128,
               big ? 8192 : 512, big ? 2048 : 128, big ? (t & 15) << 7 : 0, big ? (t >> 4) << 6 : (q & 7) << 6,
               (u16*)(ws + OFF_AB), big ? 4096 : b * 256, 512, big ? 0.0013810679320049757f : 0.005524271728019903f, (char*)shm, half);
    }
    pool_phase(p, vb, G);
  }
  float* PART = (float*)(ws + OFF_PART);
  unsigned* CNT = (unsigned*)(ws + OFF_CNT);
  SEAM(5)
  if (RUNPH(5))
    big_gemm_resnorm<3>(lds8, (const u16*)(ws + OFF_AB), (const u16*)(ws + OFF_WOUT_E), T, 1024, 1024,
                        ResNormEpi<3>{p.in[0], p.in[1], X, mods + 2048, p.in[9], mods + 3072, H, PART, CNT});
  SEAM(6)
  if (RUNPH(6)) REP(6) big_gemm8<4>(lds8, H, (const u16*)(ws + OFF_W1), T, 4096, 1024, FRelu2x8{(u16*)(ws + OFF_M1)});
  SEAM(7)
  if (RUNPH(7))
    big_gemm_resnorm<3>(lds8, (const u16*)(ws + OFF_M1), (const u16*)(ws + OFF_W2), T, 1024, 4096,
                        ResNormEpi<3>{X, X + (size_t)4096 * 1024, X, mods + 5120, p.in[8] + 1024, mods + 3 * 6144, H, PART + (size_t)4 * T, CNT + 64 * 16});
  SEAM(8)
  if (RUNPH(8)) {
    big_gemm_qkv(lds8, H, (const u16*)(ws + OFF_WIN_O), T, 2304, 1024,
                 QkvHeadEpi{ws, p.out, p.in[18], p.in[19], p.in[25], p.in[26]});
    if (blockIdx.x >= 176) {
      cache_convert(p, ((int)blockIdx.x - 176) * 2 + half, ((int)gridDim.x - 176) * 2);
      prep_transposes(p, ((int)blockIdx.x - 176) * 2 + half, ((int)gridDim.x - 176) * 2, lds, 1, 1856, 2880);
    }
  }
  SEAM(9)
  if (RUNPH(9)) REP(9) attention_phase(p, vb0, half, (char*)shm);
  SEAM(10)
  if (RUNPH(10))
    big_gemm_resnorm<3>(lds8, H, (const u16*)(ws + OFF_WOUT_O), T, 1024, 1024,
                        ResNormEpi<3>{X, X + (size_t)4096 * 1024, X, mods + 3 * 6144 + 2048, p.in[9] + 1024, mods + 3 * 6144 + 3072, (u16*)(ws + OFF_R2), PART + (size_t)8 * T, CNT + 128 * 16});
  SEAM(11)
  if (RUNPH(11)) REP(11) big_gemm8<4>(lds8, (const u16*)(ws + OFF_R2), (const u16*)(ws + OFF_W1) + (size_t)4096 * 1024, T, 4096, 1024, FRelu2x8{(u16*)(ws + OFF_M1)});
  SEAM(12)
  if (RUNPH(12)) REP(12) big_gemm<3>(lds8, (const u16*)(ws + OFF_M1), (const u16*)(ws + OFF_W2) + (size_t)4096 * 1024, T, 1024, 4096, FRes{X, X + (size_t)4096 * 1024, rep_ ? (float*)(ws + OFF_R2) : X, mods + 3 * 6144 + 5120});
}

extern "C" void kernel_launch(void* const* d_in, const int* in_sizes, int n_in, void* d_out, int out_size, void* d_ws, size_t ws_size,
                              hipStream_t stream) {
  constexpr int kDynLds = 2 * LDS_BYTES;
  static int grid = 0;
  if (!grid) {
    int dev = 0, cus = 0, per_cu = 0;
    (void)hipGetDevice(&dev);
    (void)hipDeviceGetAttribute(&cus, hipDeviceAttributeMultiprocessorCount, dev);
    if (hipFuncSetAttribute((const void*)fwd_kernel, hipFuncAttributeMaxDynamicSharedMemorySize, kDynLds) != hipSuccess) fprintf(stderr, "hipFuncSetAttribute(%d) failed\n", kDynLds);
    (void)hipOccupancyMaxActiveBlocksPerMultiprocessor(&per_cu, fwd_kernel, 512, kDynLds);
    if (per_cu < 1) fprintf(stderr, "occupancy query says %d blocks/CU\n", per_cu);
    grid = cus;
    if (ws_size < WS_END) fprintf(stderr, "workspace too small: %zu < %zu\n", ws_size, (size_t)WS_END);
  }
  Params p{};
  for (int i = 0; i < 31; ++i) p.in[i] = (const float*)d_in[i];
  p.out = (float*)d_out;
  p.ws = (unsigned char*)d_ws;
#if ONE_LAUNCH
  hipMemsetAsync((char*)d_ws + OFF_BAR, 0, XCD_BAR_WORDS * 4 + CNT_BYTES, stream);
  int lo = 0, hi = NPH, dup = DUPPH;
  void* args[] = {&p, &lo, &hi, &dup};
  hipError_t e = hipLaunchCooperativeKernel((void*)fwd_kernel, dim3(grid), dim3(512), args, kDynLds, stream);
  if (e != hipSuccess) fprintf(stderr, "cooperative launch failed: %s (grid %d)\n", hipGetErrorString(e), grid);
#else
  for (int ph = 0; ph < NPH; ++ph) hipLaunchKernelGGL(fwd_kernel, dim3(grid), dim3(512), kDynLds, stream, p, ph, ph + 1, -1);
#endif
}
```

```cpp
#include <hip/hip_runtime.h>
#include <hip/hip_cooperative_groups.h>
#include <cstdio>
namespace cg = cooperative_groups;

#ifndef ONE_LAUNCH
#define ONE_LAUNCH 1
#endif

#ifndef ONLYPH
#define ONLYPH -1
#endif
#ifndef DUPPH
#define DUPPH -1
#endif
typedef unsigned short u16;
typedef short bf16x8 __attribute__((ext_vector_type(8)));
typedef float f32x16 __attribute__((ext_vector_type(16)));
typedef __bf16 bf2_t __attribute__((ext_vector_type(2)));
typedef float f2_t __attribute__((ext_vector_type(2)));
typedef unsigned u32x4 __attribute__((ext_vector_type(4)));

#define DI __device__ __forceinline__
#define TIDX ((int)(threadIdx.x & 255u))

constexpr int T = 12288, TP = 4096, DM = 1024;
constexpr int NPH = 13;
constexpr float EPS = 1e-6f;
constexpr float LOG2E = 1.4426950408889634f;
constexpr float QSCALE = 0.125f * LOG2E;
constexpr float LAM_INIT = 0.35550906759f;

constexpr size_t al(size_t x) { return (x + 255) & ~size_t(255); }
constexpr size_t OFF_MODS   = 0;
constexpr size_t OFF_WIN_E  = OFF_MODS + al(2 * 3 * 6144 * 4);
constexpr size_t OFF_WINB   = OFF_WIN_E + al(1536 * 1024 * 2);
constexpr size_t OFF_CBD    = OFF_WINB + al(1024 * 512 * 2);
constexpr size_t OFF_WOUT_ET= OFF_CBD + al(1024 * 512 * 2);
constexpr size_t OFF_BD     = OFF_WOUT_ET + al(1024 * 1024 * 2);
constexpr size_t OFF_WOUT_E = OFF_BD + al(1024 * 1024 * 2);
constexpr size_t OFF_WIN_O  = OFF_WOUT_E + al(1024 * 1024 * 2);
constexpr size_t OFF_WOUT_O = OFF_WIN_O + al(2304 * 1024 * 2);
constexpr size_t OFF_W1     = OFF_WOUT_O + al(1024 * 1024 * 2);
constexpr size_t OFF_W2     = OFF_W1 + al(2 * 4096 * 1024 * 2);
constexpr size_t OFF_D256   = OFF_W2 + al(2 * 4096 * 1024 * 2);
constexpr size_t OFF_H      = OFF_D256 + al(256 * 512 * 2);
constexpr size_t OFF_R2     = OFF_H + al((size_t)T * 1024 * 2);
constexpr size_t R2_BYTES   = (size_t)T * 512 * 2 + (size_t)T * 1024 * 2 * 2;
constexpr size_t OFF_R1     = OFF_R2 + al(R2_BYTES);
constexpr size_t R1_BYTES   = (size_t)T * 4096 * 2;
constexpr size_t OFF_BAR    = OFF_R1 + R1_BYTES;
constexpr size_t OFF_CNT    = OFF_BAR + 3456 * 4;
constexpr size_t CNT_BYTES  = 3 * 64 * 64;
constexpr size_t OFF_PART   = OFF_CNT + CNT_BYTES;
constexpr size_t WS_END     = OFF_PART + (size_t)3 * 4 * T * 4;
constexpr size_t OFF_UA  = OFF_R2;
constexpr size_t OFF_PQT = OFF_UA + (size_t)T * 512 * 2;
constexpr size_t OFF_AB  = OFF_PQT + (size_t)T * 1024 * 2;
constexpr size_t OFF_CQ   = OFF_R2;
constexpr size_t OFF_DQ   = OFF_CQ + (size_t)T * 512 * 2;
constexpr size_t OFF_CKP  = OFF_DQ + (size_t)T * 512 * 2;
constexpr size_t OFF_CKS  = OFF_CKP + (size_t)16 * 8 * 256 * 64 * 2;
constexpr size_t OFF_CVTP = OFF_CKS + (size_t)2 * 8 * 4608 * 64 * 2;
constexpr size_t OFF_CVTS = OFF_CVTP + (size_t)16 * 4 * 128 * 256 * 2;
constexpr size_t OFF_DKP  = OFF_CVTS + (size_t)2 * 4 * 128 * 4608 * 2;
constexpr size_t OFF_DKS  = OFF_DKP + (size_t)16 * 2 * 256 * 64 * 2;
constexpr size_t OFF_DVTP = OFF_DKS + (size_t)2 * 2 * 4608 * 64 * 2;
constexpr size_t OFF_DVTS = OFF_DVTP + (size_t)16 * 2 * 64 * 256 * 2;
constexpr size_t R2_LATE_END = OFF_DVTS + (size_t)2 * 2 * 64 * 4608 * 2;
static_assert(R2_LATE_END <= OFF_R2 + R2_BYTES, "R2 overflow");
constexpr size_t OFF_D4096 = OFF_R1;
constexpr size_t OFF_PEQO  = OFF_R1 + (size_t)32 * 1024 * 1024;
constexpr size_t OFF_M1    = OFF_R1;
constexpr size_t OFF_QKV   = OFF_R1;
constexpr size_t OFF_OM    = OFF_R1 + al((size_t)T * 2304 * 2);
static_assert(OFF_OM + (size_t)T * 1024 * 2 <= WS_END, "R1 overflow");

constexpr size_t OUT_Y   = 0;
constexpr size_t OUT_NCK = (size_t)T * 1024;
constexpr size_t OUT_NCV = OUT_NCK + (size_t)TP * 512;
constexpr size_t OUT_NDK = OUT_NCV + (size_t)TP * 512;
constexpr size_t OUT_NDV = OUT_NDK + (size_t)TP * 128;

struct Params {
  const float* in[31];
  float* out;
  unsigned char* ws;
};

DI float bf2f(u16 v) { return __uint_as_float(((unsigned)v) << 16); }
DI unsigned pack2(float a, float b) { f2_t f = {a, b}; bf2_t v = __builtin_convertvector(f, bf2_t); return __builtin_bit_cast(unsigned, v); }
DI u16 f2bf(float a) { return (u16)(pack2(a, 0.f) & 0xffffu); }
DI int cond_of(int m) { return m < 4096 ? 0 : (m < 8192 ? 1 : 2); }
DI float wave_sum(float v) {
#pragma unroll
  for (int o = 32; o >= 1; o >>= 1) v += __shfl_xor(v, o);
  return v;
}
#define MFMA(a, b, c) __builtin_amdgcn_mfma_f32_32x32x16_bf16((a), (b), (c), 0, 0, 0)

constexpr int LROW = 144;
constexpr int GEMM_BUF = 2 * 128 * LROW;
constexpr int LDS_BYTES = 2 * GEMM_BUF;

template <int NR>
DI void g_load(u32x4 (&R)[NR], const u16* g, int ld, int k0) {
#pragma unroll
  for (int i = 0; i < NR; ++i) R[i] = *(const u32x4*)(g + (size_t)(32 * i) * ld + k0);
}
template <int NR>
DI void g_store(const u32x4 (&R)[NR], char* sw) {
#pragma unroll
  for (int i = 0; i < NR; ++i) *(u32x4*)(sw + (32 * i) * LROW) = R[i];
}
template <int NB>
DI void g_compute(f32x16 (&acc)[2][NB], const char* fa, const char* fb) {
#pragma unroll
  for (int ks = 0; ks < 4; ++ks) {
    bf16x8 a0 = *(const bf16x8*)(fa + ks * 32);
    bf16x8 a1 = *(const bf16x8*)(fa + 32 * LROW + ks * 32);
#pragma unroll
    for (int j = 0; j < NB; ++j) {
      bf16x8 b = *(const bf16x8*)(fb + j * 32 * LROW + ks * 32);
      acc[0][j] = MFMA(a0, b, acc[0][j]);
      acc[1][j] = MFMA(a1, b, acc[1][j]);
    }
  }
}
template <int NB>
DI void gemm_acc(f32x16 (&acc)[2][NB], const u16* A, int lda, const u16* Bt, int ldb, int K, int m0, int n0, char* lds) {
  const int tid = TIDX, lane = tid & 63, wave = tid >> 6;
  const int r = lane & 31, h = lane >> 5;
  const int wm = wave >> 1, wn = wave & 1;
  const int lrow = tid >> 3, lcol = (tid & 7) * 8;
  const u16* ga = A + (size_t)(m0 + lrow) * lda + lcol;
  const u16* gb = Bt + (size_t)(n0 + lrow) * ldb + lcol;
  u32x4 ra0[4], ra1[4], rb0[2 * NB], rb1[2 * NB];
  const int nk = K >> 6;
  char* sw = lds + lrow * LROW + lcol * 2;
  const char* fa = lds + (wm * 64 + r) * LROW + h * 16;
  const char* fb = lds + 128 * LROW + (wn * 32 * NB + r) * LROW + h * 16;
#define G_LOAD(RA, RB, kt_) do { const int k0_ = ((kt_) < nk ? (kt_) : nk - 1) << 6; g_load<4>(RA, ga, lda, k0_); g_load<2 * NB>(RB, gb, ldb, k0_); } while (0)
#define G_STORE(RA, RB, boff_) do { g_store<4>(RA, sw + (boff_)); g_store<2 * NB>(RB, sw + (boff_) + 128 * LROW); } while (0)
  G_LOAD(ra0, rb0, 0);
  G_LOAD(ra1, rb1, 1);
  G_STORE(ra0, rb0, 0);
  __syncthreads();
  for (int kt = 0; kt < nk; kt += 2) {
    G_LOAD(ra0, rb0, kt + 2);
    g_compute<NB>(acc, fa, fb);
    G_STORE(ra1, rb1, GEMM_BUF);
    __syncthreads();
    G_LOAD(ra1, rb1, kt + 3);
    g_compute<NB>(acc, fa + GEMM_BUF, fb + GEMM_BUF);
    G_STORE(ra0, rb0, 0);
    __syncthreads();
  }
#undef G_LOAD
#undef G_STORE
}

template <class Epi>
DI void gemm_tile(const u16* A, int lda, const u16* Bt, int ldb, int K, int m0, int n0, Epi epi, char* lds) {
  const int lane = TIDX & 63, wave = TIDX >> 6;
  const int r = lane & 31, h = lane >> 5, wm = wave >> 1, wn = wave & 1;
  f32x16 acc[2][2];
#pragma unroll
  for (int i = 0; i < 2; ++i)
#pragma unroll
    for (int j = 0; j < 2; ++j)
#pragma unroll
      for (int e = 0; e < 16; ++e) acc[i][j][e] = 0.f;
  gemm_acc<2>(acc, A, lda, Bt, ldb, K, m0, n0, lds);
#pragma unroll
  for (int i = 0; i < 2; ++i)
#pragma unroll
    for (int j = 0; j < 2; ++j)
#pragma unroll
      for (int q = 0; q < 4; ++q) {
        const int m = m0 + wm * 64 + i * 32 + 8 * q + 4 * h;
        const int n = n0 + wn * 64 + j * 32 + r;
        epi(m, n, acc[i][j][4 * q], acc[i][j][4 * q + 1], acc[i][j][4 * q + 2], acc[i][j][4 * q + 3]);
      }
}

DI void dft_pair(const u16* Dm, const u16* PeQo, const u16* PH, int phstride, int H, int m0, int n0, u16* AB, int rowbase, int colsPerBatch, float norm, char* shm, int half) {
  char* lds = shm + half * LDS_BYTES;
  const int lane = TIDX & 63, wave = TIDX >> 6;
  const int r = lane & 31, h = lane >> 5, wm = wave >> 1, wn = wave & 1;
  f32x16 acc[2][1];
#pragma unroll
  for (int i = 0; i < 2; ++i)
#pragma unroll
    for (int e = 0; e < 16; ++e) acc[i][0][e] = 0.f;
  gemm_acc<1>(acc, Dm + half * H, 2 * H, PeQo + half * H, 2 * H, H, m0, n0, lds);
  float* exo = (float*)lds + wave * 2048 + lane;
  const float* exr = (const float*)(shm + (1 - half) * LDS_BYTES) + wave * 2048 + lane;
#pragma unroll
  for (int i = 0; i < 2; ++i)
#pragma unroll
    for (int e = 0; e < 16; ++e) exo[(i * 16 + e) * 64] = acc[i][0][e];
  __syncthreads();
  const int N = 2 * H;
  const int col = n0 + wn * 32 + r;
  const int b = col / colsPerBatch, c = col - b * colsPerBatch;
  const float ph = bf2f(PH[(size_t)col * phstride]);
  u16* base = AB + ((size_t)rowbase + (size_t)b * N) * 1024 + 512 + c;
#pragma unroll
  for (int i = 0; i < 2; ++i)
#pragma unroll
    for (int q = 0; q < 4; ++q)
#pragma unroll
      for (int e = 0; e < 4; ++e) {
        const int k = m0 + wm * 64 + i * 32 + 8 * q + 4 * h + e;
        const float other = exr[(i * 16 + 4 * q + e) * 64];
        const float sp = (k & 1) ? -ph : ph;
        if (half == 0) base[(size_t)k * 1024] = f2bf((acc[i][0][4 * q + e] + sp - other) * norm);
        else if (k > 0) base[(size_t)(N - k) * 1024] = f2bf((other + sp + acc[i][0][4 * q + e]) * norm);
      }
  __syncthreads();
}

struct EpiBf16 {
  u16* C; int ldc;
  DI void operator()(int m, int n, float v0, float v1, float v2, float v3) const {
    u16* p = C + (size_t)m * ldc + n;
    p[0] = f2bf(v0); p[ldc] = f2bf(v1); p[2 * ldc] = f2bf(v2); p[3 * ldc] = f2bf(v3);
  }
};
struct EpiU {
  u16* UA; u16* PQt;
  DI void operator()(int m, int n, float v0, float v1, float v2, float v3) const {
    if (n < 512) {
      u16* p = UA + (size_t)m * 512 + n;
      p[0] = f2bf(v0); p[512] = f2bf(v1); p[1024] = f2bf(v2); p[1536] = f2bf(v3);
    } else {
      const int np = n - 512, g = np >> 8, pq = (np >> 7) & 1, mm = np & 127;
      size_t off;
      if (m < 4096) { const int b = m >> 8, nl = m & 255; off = ((size_t)(b * 512 + g * 128 + mm)) * 512 + pq * 256 + nl; }
      else { const int ms = m - 4096, b = ms >> 12, nl = ms & 4095; off = (size_t)16 * 512 * 512 + ((size_t)(b * 512 + g * 128 + mm)) * 8192 + pq * 4096 + nl; }
      uint2 w; w.x = pack2(v0, v1); w.y = pack2(v2, v3);
      *(uint2*)(PQt + off) = w;
    }
  }
};
struct EpiDft {
  u16* AB; int rowbase; float norm; int sample;
  DI void operator()(int m, int n, float v0, float v1, float v2, float v3) const {
    size_t row; int c;
    if (sample) { row = (size_t)4096 + (size_t)(n >> 9) * 4096 + m; c = n & 511; }
    else { row = (size_t)rowbase + m; c = n; }
    u16* p = AB + row * 1024 + 512 + c;
    p[0] = f2bf(v0 * norm); p[1024] = f2bf(v1 * norm); p[2048] = f2bf(v2 * norm); p[3072] = f2bf(v3 * norm);
  }
};
struct EpiRes {
  const float* xin_p; const float* xin_s;
  float* X; const float* gate;
  DI void operator()(int m, int n, float v0, float v1, float v2, float v3) const {
    const float* xi = (m < 4096) ? xin_p + (size_t)m * 1024 + n : xin_s + (size_t)(m - 4096) * 1024 + n;
    const float g = gate[cond_of(m) * 6144 + n];
    float* xo = X + (size_t)m * 1024 + n;
    xo[0] = xi[0] + g * v0; xo[1024] = xi[1024] + g * v1; xo[2048] = xi[2048] + g * v2; xo[3072] = xi[3072] + g * v3;
  }
};
struct EpiRelu2 {
  u16* C;
  DI void operator()(int m, int n, float v0, float v1, float v2, float v3) const {
    v0 = fmaxf(v0, 0.f); v1 = fmaxf(v1, 0.f); v2 = fmaxf(v2, 0.f); v3 = fmaxf(v3, 0.f);
    u16* p = C + (size_t)m * 4096 + n;
    p[0] = f2bf(v0 * v0); p[4096] = f2bf(v1 * v1); p[8192] = f2bf(v2 * v2); p[12288] = f2bf(v3 * v3);
  }
};
struct EpiQkv {
  u16* QKV; u16* CVtP; u16* CVtS; u16* DVtP; u16* DVtS; float* ncv; float* ndv;
  DI void operator()(int m, int n, float v0, float v1, float v2, float v3) const {
    const bool is_cv = (n >= 1024 && n < 1536), is_dv = (n >= 2176);
    if (!is_cv && !is_dv) {
      u16* p = QKV + (size_t)m * 2304 + n;
      p[0] = f2bf(v0); p[2304] = f2bf(v1); p[4608] = f2bf(v2); p[6912] = f2bf(v3);
      return;
    }
    uint2 w; w.x = pack2(v0, v1); w.y = pack2(v2, v3);
    if (is_cv) {
      const int c = n - 1024;
      if (m < 4096) {
        const int b = m >> 8, nl = m & 255;
        *(uint2*)(CVtP + ((size_t)(b * 512 + c)) * 256 + nl) = w;
        float* o = ncv + (size_t)m * 512 + c; o[0] = v0; o[512] = v1; o[1024] = v2; o[1536] = v3;
      } else {
        const int ms = m - 4096, b = ms >> 12, nl = ms & 4095;
        *(uint2*)(CVtS + ((size_t)(b * 512 + c)) * 4608 + 512 + nl) = w;
      }
    } else {
      const int c = n - 2176;
      if (m < 4096) {
        const int b = m >> 8, nl = m & 255;
        *(uint2*)(DVtP + ((size_t)(b * 128 + c)) * 256 + nl) = w;
        float* o = ndv + (size_t)m * 128 + c; o[0] = v0; o[128] = v1; o[256] = v2; o[384] = v3;
      } else {
        const int ms = m - 4096, b = ms >> 12, nl = ms & 4095;
        *(uint2*)(DVtS + ((size_t)(b * 128 + c)) * 4608 + 512 + nl) = w;
      }
    }
  }
};

DI void ada_item(const Params& p, int id, char* lds) {
  const int tid = TIDX;
  float* ssil = (float*)lds;
  float* red = (float*)(lds + 12288);
  const int l = id / 192, cb = id % 192;
  for (int i = tid; i < 3072; i += 256) {
    const int j = i >> 10, k = i & 1023;
    const float v = (j == 0) ? p.in[7][k] : p.in[2][(j - 1) * 1024 + k];
    ssil[i] = v / (1.f + __expf(-v));
  }
  __syncthreads();
  const int cq = tid & 7, kg = tid >> 3;
  const float* w = p.in[10] + (size_t)l * 1024 * 6144 + cb * 32 + cq * 4;
  float4 a0 = {0, 0, 0, 0}, a1 = {0, 0, 0, 0}, a2 = {0, 0, 0, 0};
#pragma unroll 8
  for (int kk = 0; kk < 32; ++kk) {
    const int k = kg * 32 + kk;
    const float4 wv = *(const float4*)(w + (size_t)k * 6144);
    const float s0 = ssil[k], s1 = ssil[1024 + k], s2 = ssil[2048 + k];
    a0.x += s0 * wv.x; a0.y += s0 * wv.y; a0.z += s0 * wv.z; a0.w += s0 * wv.w;
    a1.x += s1 * wv.x; a1.y += s1 * wv.y; a1.z += s1 * wv.z; a1.w += s1 * wv.w;
    a2.x += s2 * wv.x; a2.y += s2 * wv.y; a2.z += s2 * wv.z; a2.w += s2 * wv.w;
  }
  float* rp = red + kg * 96 + cq * 4;
  rp[0] = a0.x; rp[1] = a0.y; rp[2] = a0.z; rp[3] = a0.w;
  rp[32] = a1.x; rp[33] = a1.y; rp[34] = a1.z; rp[35] = a1.w;
  rp[64] = a2.x; rp[65] = a2.y; rp[66] = a2.z; rp[67] = a2.w;
  __syncthreads();
  if (tid < 96) {
    const int j = tid >> 5, c = tid & 31;
    float sum = 0.f;
#pragma unroll
    for (int g = 0; g < 32; ++g) sum += red[g * 96 + j * 32 + c];
    const int col = cb * 32 + c;
    ((float*)(p.ws + OFF_MODS))[(size_t)(l * 3 + j) * 6144 + col] = sum + p.in[11][l * 6144 + col];
  }
  __syncthreads();
}

DI void transpose_tile(const float* src, int ld_src, u16* dst, int ld_dst, int r0, int c0, char* lds) {
  float* tile = (float*)lds;
  const int tid = TIDX;
  const int j4 = (tid & 15) * 4, i0 = tid >> 4;
#pragma unroll
  for (int it = 0; it < 4; ++it) {
    const int i = i0 + 16 * it;
    const float4 v = *(const float4*)(src + (size_t)(r0 + i) * ld_src + c0 + j4);
    float* tp = tile + i * 65 + j4;
    tp[0] = v.x; tp[1] = v.y; tp[2] = v.z; tp[3] = v.w;
  }
  __syncthreads();
  const int kc = (tid & 7) * 8, jr = tid >> 3;
#pragma unroll
  for (int it = 0; it < 2; ++it) {
    const int j = jr + 32 * it;
    const float* tp = tile + kc * 65 + j;
    uint4 o;
    o.x = pack2(tp[0], tp[65]); o.y = pack2(tp[130], tp[195]); o.z = pack2(tp[260], tp[325]); o.w = pack2(tp[390], tp[455]);
    *(uint4*)(dst + (size_t)(c0 + j) * ld_dst + r0 + kc) = o;
  }
  __syncthreads();
}

DI void prep_transposes(const Params& p, int vb, int G, char* lds, int layer, int t0 = 0, int t1 = 1 << 30) {
  const int ntile = min(layer ? 2880 : 2432, t1);
  for (int t = t0 + vb; t < ntile; t += G) {
    const float* src; u16* dst; int lds_, ldd, r0, c0;
    int q = t;
    if (layer == 0) {
      if (q < 128) { src = p.in[12]; lds_ = 1024; dst = (u16*)(p.ws + OFF_WIN_E); ldd = 1024; r0 = (q >> 3) * 64; c0 = (q & 7) * 64; }
      else if ((q -= 128) < 256) { src = p.in[16]; lds_ = 1024; dst = (u16*)(p.ws + OFF_WOUT_ET); ldd = 1024; r0 = (q >> 4) * 64; c0 = (q & 15) * 64; }
      else if ((q -= 256) < 1024) { src = p.in[29]; lds_ = 4096; dst = (u16*)(p.ws + OFF_W1); ldd = 1024; r0 = (q >> 6) * 64; c0 = (q & 63) * 64; }
      else { q -= 1024; src = p.in[30]; lds_ = 1024; dst = (u16*)(p.ws + OFF_W2); ldd = 4096; r0 = (q >> 4) * 64; c0 = (q & 15) * 64; }
    } else {
      if (q < 576) { src = p.in[17]; lds_ = 2304; dst = (u16*)(p.ws + OFF_WIN_O); ldd = 1024; r0 = (q / 36) * 64; c0 = (q % 36) * 64; }
      else if ((q -= 576) < 256) { src = p.in[28]; lds_ = 1024; dst = (u16*)(p.ws + OFF_WOUT_O); ldd = 1024; r0 = (q >> 4) * 64; c0 = (q & 15) * 64; }
      else if ((q -= 256) < 1024) { src = p.in[29] + (size_t)1024 * 4096; lds_ = 4096; dst = (u16*)(p.ws + OFF_W1) + (size_t)4096 * 1024; ldd = 1024; r0 = (q >> 6) * 64; c0 = (q & 63) * 64; }
      else { q -= 1024; src = p.in[30] + (size_t)4096 * 1024; lds_ = 1024; dst = (u16*)(p.ws + OFF_W2) + (size_t)1024 * 4096; ldd = 4096; r0 = (q >> 4) * 64; c0 = (q & 15) * 64; }
    }
    transpose_tile(src, lds_, dst, ldd, r0, c0, lds);
  }
}

DI void prep_elementwise(const Params& p, int vb, int G) {
  const size_t gt = (size_t)vb * 256 + TIDX, gs = (size_t)G * 256;
  {
    u16* d = (u16*)(p.ws + OFF_WINB);
    for (size_t i = gt; i < 1024 * 256; i += gs) {
      const int k = (int)(i >> 8), c = (int)(i & 255) * 2;
      const float* s = p.in[12] + (size_t)k * 1024 + 512 + c;
      *(unsigned*)(d + (size_t)k * 512 + c) = pack2(s[0], s[1]);
    }
  }
  {
    u16* d = (u16*)(p.ws + OFF_CBD);
    for (size_t i = gt; i < 1024 * 512; i += gs) {
      const int np = (int)(i >> 9), cp = (int)(i & 511);
      const int g = np >> 8, pq = (np >> 7) & 1, m = np & 127;
      float v = 0.f;
      if ((cp >> 7) == g) {
        const int c = cp & 127; const int rr = (m * c) & 127;
        const float x = (float)rr * (2.0f / 128.0f);
        v = pq ? sinpif(x) : cospif(x);
      }
      d[i] = f2bf(v);
    }
  }
  {
    u16* d = (u16*)(p.ws + OFF_BD);
    for (size_t i = gt; i < 1024 * 1024; i += gs) {
      const int kp = (int)(i >> 10), c = (int)(i & 1023);
      float v = 0.f;
      if (kp < 512) { const int g = kp >> 7; if (c < 512 && (c >> 7) == g) v = p.in[13][(size_t)g * 16384 + (kp & 127) * 128 + (c & 127)] * p.in[14][c]; }
      else { const int g = (kp - 512) >> 7; if (c >= 512 && ((c - 512) >> 7) == g) v = p.in[15][(size_t)g * 16384 + ((kp - 512) & 127) * 128 + ((c - 512) & 127)]; }
      d[i] = f2bf(v);
    }
  }
#pragma unroll 1
  for (int which = 0; which < 2; ++which) {
    const int H = which ? 2048 : 128, N = 2 * H, lg = which ? 9 : 5;
    u16* d = (u16*)(p.ws + (which ? OFF_D4096 : OFF_D256));
    const float invN = 1.0f / (float)N;
    for (size_t i = gt; i < ((size_t)H << lg); i += gs) {
      const int k = (int)(i >> lg), np = (int)(i & ((1 << lg) - 1)) * 8;
      const bool is_sin = np >= H;
      const int n = np & (H - 1);
      unsigned w[4];
#pragma unroll
      for (int e = 0; e < 4; ++e) {
        const float x0 = (float)((k * (n + 2 * e)) & (N - 1)) * invN, x1 = (float)((k * (n + 2 * e + 1)) & (N - 1)) * invN;
        const float v0 = is_sin ? __builtin_amdgcn_sinf(x0) : __builtin_amdgcn_cosf(x0);
        const float v1 = is_sin ? __builtin_amdgcn_sinf(x1) : __builtin_amdgcn_cosf(x1);
        w[e] = pack2(v0, v1);
      }
      *(uint4*)(d + (size_t)k * N + np) = make_uint4(w[0], w[1], w[2], w[3]);
    }
  }
}

DI void sym_phase(const Params& p, int vb, int G) {
  const int lane = TIDX & 63, wave = TIDX >> 6;
  const u16* PQT = (const u16*)(p.ws + OFF_PQT);
  u16* PEQO = (u16*)(p.ws + OFF_PEQO);
  u16* AB = (u16*)(p.ws + OFF_AB);
  for (int it = vb * 4 + wave; it < 1024 + 2048; it += G * 4) {
    const bool samp = it < 1024;
    const int H = samp ? 2048 : 128, N = 2 * H;
    int col, n0base, nstep;
    if (samp) { col = it; n0base = lane * 8; nstep = 512; }
    else { col = (it - 1024) * 4 + (lane >> 4); n0base = (lane & 15) * 8; nstep = 128; }
    const u16* Pp = samp ? PQT + (size_t)16 * 512 * 512 + (size_t)col * 8192 : PQT + (size_t)col * 512;
    const u16* Qp = Pp + N;
    u16* Pe = samp ? PEQO + (size_t)16 * 512 * 256 + (size_t)col * 4096 : PEQO + (size_t)col * 256;
    u16* Qo = Pe + H;
    float alt = 0.f;
    for (int n0 = n0base; n0 < H; n0 += nstep) {
      const uint4 pw = *(const uint4*)(Pp + n0), qw = *(const uint4*)(Qp + n0);
      const unsigned pa[4] = {pw.x, pw.y, pw.z, pw.w}, qa[4] = {qw.x, qw.y, qw.z, qw.w};
      float pe[8], qo[8];
#pragma unroll
      for (int e = 0; e < 8; ++e) {
        const float pv = (e & 1) ? __uint_as_float(pa[e >> 1] & 0xffff0000u) : __uint_as_float(pa[e >> 1] << 16);
        const float qv = (e & 1) ? __uint_as_float(qa[e >> 1] & 0xffff0000u) : __uint_as_float(qa[e >> 1] << 16);
        const int n = n0 + e;
        float pm = 0.f, qm = 0.f;
        if (n > 0) { pm = bf2f(Pp[N - n]); qm = bf2f(Qp[N - n]); }
        pe[e] = pv + pm;
        qo[e] = (n > 0) ? qv - qm : 0.f;
        alt += (e & 1) ? -pe[e] : pe[e];
      }
      *(uint4*)(Pe + n0) = make_uint4(pack2(pe[0], pe[1]), pack2(pe[2], pe[3]), pack2(pe[4], pe[5]), pack2(pe[6], pe[7]));
      *(uint4*)(Qo + n0) = make_uint4(pack2(qo[0], qo[1]), pack2(qo[2], qo[3]), pack2(qo[4], qo[5]), pack2(qo[6], qo[7]));
    }
    alt += __shfl_xor(alt, 1); alt += __shfl_xor(alt, 2); alt += __shfl_xor(alt, 4); alt += __shfl_xor(alt, 8);
    if (samp) { alt += __shfl_xor(alt, 16); alt += __shfl_xor(alt, 32); }
    if ((samp && lane == 0) || (!samp && (lane & 15) == 0)) {
      const float fh = alt + bf2f(Pp[H]);
      size_t row; int c; float norm;
      if (samp) { row = (size_t)4096 + (size_t)(col >> 9) * 4096 + 2048; c = col & 511; norm = 0.0013810679320049757f; }
      else { row = (size_t)(col >> 9) * 256 + 128; c = col & 511; norm = 0.005524271728019903f; }
      AB[row * 1024 + 512 + c] = f2bf(fh * norm);
    }
  }
}

DI void normmod_phase(const Params& p, int vb, int G, const float* xp, const float* xs, const float* gain, int l, int which) {
  const int lane = TIDX & 63, wave = TIDX >> 6;
  u16* H = (u16*)(p.ws + OFF_H);
  const float* mods = (const float*)(p.ws + OFF_MODS) + (size_t)l * 3 * 6144;
  for (int row = vb * 4 + wave; row < T; row += G * 4) {
    const float* x = (row < 4096) ? xp + (size_t)row * 1024 : xs + (size_t)(row - 4096) * 1024;
    float4 v[4];
    float ss = 0.f;
#pragma unroll
    for (int i = 0; i < 4; ++i) {
      v[i] = *(const float4*)(x + i * 256 + lane * 4);
      ss += v[i].x * v[i].x + v[i].y * v[i].y + v[i].z * v[i].z + v[i].w * v[i].w;
    }
    ss = wave_sum(ss);
    const float rinv = rsqrtf(ss * (1.0f / 1024.0f) + EPS);
    const float* md = mods + cond_of(row) * 6144 + which * 3072;
#pragma unroll
    for (int i = 0; i < 4; ++i) {
      const int c = i * 256 + lane * 4;
      const float4 g = *(const float4*)(gain + c);
      const float4 sh = *(const float4*)(md + c);
      const float4 sc = *(const float4*)(md + 1024 + c);
      const float o0 = v[i].x * rinv * g.x * (1.f + sc.x) + sh.x;
      const float o1 = v[i].y * rinv * g.y * (1.f + sc.y) + sh.y;
      const float o2 = v[i].z * rinv * g.z * (1.f + sc.z) + sh.z;
      const float o3 = v[i].w * rinv * g.w * (1.f + sc.w) + sh.w;
      uint2 w; w.x = pack2(o0, o1); w.y = pack2(o2, o3);
      *(uint2*)(H + (size_t)row * 1024 + c) = w;
    }
  }
}

template <class Epi>
DI void gemm_phase(const u16* A, int lda, const u16* Bt, int ldb, int K, int M, int N, Epi epi, int vb, int G, char* lds) {
  const int nN = N >> 7, nt = (M >> 7) * nN, grp = 8 * nN;
  for (int t = vb; t < nt; t += G) {
    const int gi = t / grp, rem = t - gi * grp;
    gemm_tile(A, lda, Bt, ldb, K, (gi * 8 + (rem & 7)) << 7, (rem >> 3) << 7, epi, lds);
  }
}

template <int HW>
DI void pool_item(const u16* UA, u16* AB, int t, int c8) {
  int nl, N;
  if (t < 4096) { nl = t & 255; N = 256; } else { nl = (t - 4096) & 4095; N = 4096; }
  const int base = t - nl;
  u32x4 w[2 * HW];
  int cnt = 0;
#pragma unroll
  for (int j = 0; j < 2 * HW; ++j) {
    const int idx = nl - HW + j;
    const bool ok = idx >= 0 && idx < N;
    w[j] = *(const u32x4*)(UA + (size_t)(base + (ok ? idx : nl)) * 512 + c8);
    if (!ok) w[j] = (u32x4){0u, 0u, 0u, 0u};
    cnt += ok ? 1 : 0;
  }
  const u32x4 cw = *(const u32x4*)(UA + (size_t)t * 512 + c8);
  float s[8] = {0, 0, 0, 0, 0, 0, 0, 0};
#pragma unroll
  for (int j = 0; j < 2 * HW; ++j)
#pragma unroll
    for (int e = 0; e < 4; ++e) { s[2 * e] += __uint_as_float(w[j][e] << 16); s[2 * e + 1] += __uint_as_float(w[j][e] & 0xffff0000u); }
  const float inv = 1.0f / (float)cnt;
  u32x4 o;
#pragma unroll
  for (int e = 0; e < 4; ++e) o[e] = pack2(s[2 * e] * inv - __uint_as_float(cw[e] << 16), s[2 * e + 1] * inv - __uint_as_float(cw[e] & 0xffff0000u));
  *(u32x4*)(AB + (size_t)t * 1024 + c8) = o;
}
DI void pool_phase(const Params& p, int vb, int G) {
  const u16* UA = (const u16*)(p.ws + OFF_UA);
  u16* AB = (u16*)(p.ws + OFF_AB);
  const size_t gt = (size_t)vb * 256 + TIDX, gs = (size_t)G * 256;
  for (size_t i = gt; i < (size_t)T * 64; i += gs) {
    const int cc = (int)(i & 15), tt = (int)(i >> 4) & 3, g = (int)(i >> 6) & 3, tb = (int)(i >> 8);
    const int t = tb * 4 + tt, c8 = g * 128 + cc * 8;
    if (g == 0) pool_item<1>(UA, AB, t, c8);
    else if (g == 1) pool_item<2>(UA, AB, t, c8);
    else if (g == 2) pool_item<4>(UA, AB, t, c8);
    else pool_item<8>(UA, AB, t, c8);
  }
}

DI void qkvpost_phase(const Params& p, int vb, int G) {
  const int lane = TIDX & 63, wave = TIDX >> 6;
  const int q = lane & 15, sub = lane >> 4;
  const u16* QKV = (const u16*)(p.ws + OFF_QKV);
  u16* CQ = (u16*)(p.ws + OFF_CQ); u16* DQ = (u16*)(p.ws + OFF_DQ);
  u16* CKP = (u16*)(p.ws + OFF_CKP); u16* CKS = (u16*)(p.ws + OFF_CKS);
  u16* DKP = (u16*)(p.ws + OFF_DKP); u16* DKS = (u16*)(p.ws + OFF_DKS);
  float* nck = p.out + OUT_NCK; float* ndk = p.out + OUT_NDK;
  const int d0 = q * 4;
  float fr[4];
#pragma unroll
  for (int e = 0; e < 4; ++e) fr[e] = exp2f(-(float)((d0 + e) & 15) * (13.287712379549449f / 16.0f));
  const bool firsthalf = ((d0 >> 4) & 1) == 0;
  for (int t = vb * 4 + wave; t < T; t += G * 4) {
    const bool samp = t >= 4096;
    int b, nl;
    if (!samp) { b = t >> 8; nl = t & 255; } else { b = (t - 4096) >> 12; nl = (t - 4096) & 4095; }
    float cs[4], sn[4];
    if (samp) {
      const float pos = (d0 < 32) ? (float)(nl >> 6) : (float)(nl & 63);
#pragma unroll
      for (int e = 0; e < 4; ++e) { const float a = pos * fr[e]; cs[e] = cosf(a); sn[e] = sinf(a); }
    } else {
#pragma unroll
      for (int e = 0; e < 4; ++e) { cs[e] = 1.f; sn[e] = 0.f; }
    }
    for (int rd = 0; rd < 7; ++rd) {
      const int slot = rd * 4 + sub;
      const bool act = slot < 26;
      const int vi = act ? (slot < 16 ? slot : slot + 8) : 0;
      const uint2 raw = *(const uint2*)(QKV + (size_t)t * 2304 + vi * 64 + d0);
      float x[4] = {__uint_as_float(raw.x << 16), __uint_as_float(raw.x & 0xffff0000u), __uint_as_float(raw.y << 16), __uint_as_float(raw.y & 0xffff0000u)};
      float ss = x[0] * x[0] + x[1] * x[1] + x[2] * x[2] + x[3] * x[3];
      ss += __shfl_xor(ss, 1); ss += __shfl_xor(ss, 2); ss += __shfl_xor(ss, 4); ss += __shfl_xor(ss, 8);
      const float rinv = rsqrtf(ss * (1.0f / 64.0f) + EPS);
      const float* gp = (vi < 8) ? p.in[18] : (vi < 16) ? p.in[19] : (vi < 32) ? p.in[25] : p.in[26];
      const float4 g = *(const float4*)(gp + d0);
      float y[4] = {x[0] * rinv * g.x, x[1] * rinv * g.y, x[2] * rinv * g.z, x[3] * rinv * g.w};
      float o[4];
#pragma unroll
      for (int e = 0; e < 4; ++e) {
        const float part = __shfl_xor(y[e], 4);
        o[e] = firsthalf ? (y[e] * cs[e] - part * sn[e]) : (y[e] * cs[e] + part * sn[e]);
      }
      if (!act) continue;
      const bool isq = (vi < 8) || (vi >= 24 && vi < 32);
      if (isq) {
        const int hd = (vi < 8) ? vi : vi - 24;
        u16* base = (vi < 8) ? CQ : DQ;
        size_t off = samp ? (size_t)16 * 8 * 256 * 64 + ((size_t)(b * 8 + hd) * 4096 + nl) * 64 : ((size_t)(b * 8 + hd) * 256 + nl) * 64;
        uint2 w; w.x = pack2(o[0] * QSCALE, o[1] * QSCALE); w.y = pack2(o[2] * QSCALE, o[3] * QSCALE);
        *(uint2*)(base + off + d0) = w;
      } else if (vi < 16) {
        const int hm = vi - 8;
        uint2 w; w.x = pack2(o[0], o[1]); w.y = pack2(o[2], o[3]);
        if (samp) *(uint2*)(CKS + ((size_t)(b * 8 + hm) * 4608 + 512 + nl) * 64 + d0) = w;
        else {
          *(uint2*)(CKP + ((size_t)(b * 8 + hm) * 256 + nl) * 64 + d0) = w;
          *(float4*)(nck + (size_t)t * 512 + hm * 64 + d0) = make_float4(o[0], o[1], o[2], o[3]);
        }
      } else {
        const int j = vi - 32;
        uint2 w; w.x = pack2(o[0], o[1]); w.y = pack2(o[2], o[3]);
        if (samp) *(uint2*)(DKS + ((size_t)(b * 2 + j) * 4608 + 512 + nl) * 64 + d0) = w;
        else {
          *(uint2*)(DKP + ((size_t)(b * 2 + j) * 256 + nl) * 64 + d0) = w;
          *(float4*)(ndk + (size_t)t * 128 + j * 64 + d0) = make_float4(o[0], o[1], o[2], o[3]);
        }
      }
    }
  }
  const size_t gt = (size_t)vb * 256 + TIDX, gs = (size_t)G * 256;
  {
    u16* CVTS = (u16*)(p.ws + OFF_CVTS); u16* DVTS = (u16*)(p.ws + OFF_DVTS);
    for (size_t i = gt; i < (size_t)2 * 512 * 512; i += gs) {
      const int b = (int)(i >> 18), key = (int)(i >> 9) & 511, c = (int)(i & 511);
      CKS[((size_t)(b * 8 + (c >> 6)) * 4608 + key) * 64 + (c & 63)] = f2bf(p.in[3][i]);
    }
    for (size_t i = gt; i < (size_t)2 * 512 * 512; i += gs) {
      const int b = (int)(i >> 18), c = (int)(i >> 9) & 511, key = (int)(i & 511);
      CVTS[((size_t)(b * 512 + c)) * 4608 + key] = f2bf(p.in[4][((size_t)b * 512 + key) * 512 + c]);
    }
    for (size_t i = gt; i < (size_t)2 * 512 * 128; i += gs) {
      const int b = (int)(i >> 16), key = (int)(i >> 7) & 511, c = (int)(i & 127);
      DKS[((size_t)(b * 2 + (c >> 6)) * 4608 + key) * 64 + (c & 63)] = f2bf(p.in[5][i]);
    }
    for (size_t i = gt; i < (size_t)2 * 128 * 512; i += gs) {
      const int b = (int)(i >> 16), c = (int)(i >> 9) & 127, key = (int)(i & 511);
      DVTS[((size_t)(b * 128 + c)) * 4608 + key] = f2bf(p.in[6][((size_t)b * 512 + key) * 128 + c]);
    }
  }
}

DI void cache_convert(const Params& p, int vb, int G) {
  u16* CKS = (u16*)(p.ws + OFF_CKS); u16* DKS = (u16*)(p.ws + OFF_DKS);
  const size_t gt = (size_t)vb * 256 + TIDX, gs = (size_t)G * 256;
  {
    u16* CVTS = (u16*)(p.ws + OFF_CVTS); u16* DVTS = (u16*)(p.ws + OFF_DVTS);
    for (size_t i = gt; i < (size_t)2 * 512 * 512; i += gs) {
      const int b = (int)(i >> 18), key = (int)(i >> 9) & 511, c = (int)(i & 511);
      CKS[((size_t)(b * 8 + (c >> 6)) * 4608 + key) * 64 + (c & 63)] = f2bf(p.in[3][i]);
    }
    for (size_t i = gt; i < (size_t)2 * 512 * 512; i += gs) {
      const int b = (int)(i >> 18), c = (int)(i >> 9) & 511, key = (int)(i & 511);
      CVTS[((size_t)(b * 512 + c)) * 4608 + key] = f2bf(p.in[4][((size_t)b * 512 + key) * 512 + c]);
    }
    for (size_t i = gt; i < (size_t)2 * 512 * 128; i += gs) {
      const int b = (int)(i >> 16), key = (int)(i >> 7) & 511, c = (int)(i & 127);
      DKS[((size_t)(b * 2 + (c >> 6)) * 4608 + key) * 64 + (c & 63)] = f2bf(p.in[5][i]);
    }
    for (size_t i = gt; i < (size_t)2 * 128 * 512; i += gs) {
      const int b = (int)(i >> 16), c = (int)(i >> 9) & 127, key = (int)(i & 511);
      DVTS[((size_t)(b * 128 + c)) * 4608 + key] = f2bf(p.in[6][((size_t)b * 512 + key) * 128 + c]);
    }
  }
}

template <int DV>
DI void attn_item(const u16* Q, const u16* Kb, const u16* Vt, int ldv, int nt0, int key1, int nt1,
                  bool masked, int qpos0, bool has_sink, float sink2, u16* out, int ldo, char* lds) {
  constexpr int NDB = DV / 32;
  constexpr int KVBUF = (64 + DV) * LROW;
  const int tid = TIDX, lane = tid & 63, wave = tid >> 6;
  const int r = lane & 31, h = lane >> 5;
  const int nt = nt0 + nt1;
  bf16x8 qf[4];
#pragma unroll
  for (int ks = 0; ks < 4; ++ks) qf[ks] = *(const bf16x8*)(Q + (size_t)(wave * 32 + r) * 64 + ks * 16 + h * 8);
  f32x16 O[NDB];
#pragma unroll
  for (int i = 0; i < NDB; ++i)
#pragma unroll
    for (int e = 0; e < 16; ++e) O[i][e] = 0.f;
  float mrun = has_sink ? sink2 : -1e30f;
  float lrun = has_sink ? (h == 0 ? 1.f : 0.f) : 0.f;
  const int lrow = tid >> 3, lpart = (tid & 7) * 8;
  uint4 rk0, rk1, rv0, rv1, rv2, rv3;
  rv2 = rv3 = make_uint4(0, 0, 0, 0);
  const u16* gk = Kb + (size_t)lrow * 64 + lpart;
  const u16* gv = Vt + (size_t)lrow * ldv + lpart;
#define ATT_GLOAD(key0_)                                                         \
  do {                                                                           \
    rk0 = *(const uint4*)(gk + (size_t)(key0_) * 64);                            \
    rk1 = *(const uint4*)(gk + (size_t)((key0_) + 32) * 64);                     \
    rv0 = *(const uint4*)(gv + (key0_));                                         \
    rv1 = *(const uint4*)(gv + (size_t)32 * ldv + (key0_));                      \
    if constexpr (DV == 128) {                                                   \
      rv2 = *(const uint4*)(gv + (size_t)64 * ldv + (key0_));                    \
      rv3 = *(const uint4*)(gv + (size_t)96 * ldv + (key0_));                    \
    }                                                                            \
  } while (0)
#define ATT_SSTORE(boff_)                                                        \
  do {                                                                           \
    *(uint4*)(sw + (boff_)) = rk0;                                               \
    *(uint4*)(sw + (boff_) + 32 * LROW) = rk1;                                   \
    *(uint4*)(sw + (boff_) + 64 * LROW) = rv0;                                   \
    *(uint4*)(sw + (boff_) + 96 * LROW) = rv1;                                   \
    if constexpr (DV == 128) {                                                   \
      *(uint4*)(sw + (boff_) + 128 * LROW) = rv2;                                \
      *(uint4*)(sw + (boff_) + 160 * LROW) = rv3;                                \
    }                                                                            \
  } while (0)
  char* sw = lds + lrow * LROW + lpart * 2;
  {
    const int key0 = (nt0 > 0) ? 0 : key1;
    ATT_GLOAD(key0);
  }
  ATT_SSTORE(0);
  __syncthreads();
  const int pr = (r & 0x13) | ((r & 4) << 1) | ((r & 8) >> 1);
  const char* fk = lds + pr * LROW + h * 16;
  const char* fv = lds + 64 * LROW + r * LROW + h * 16;
  const int qpos = qpos0 + wave * 32 + r;
  for (int t = 0; t < nt; ++t) {
    const int cur = (t & 1) * KVBUF;
    const int key0 = (t < nt0) ? t * 64 : key1 + (t - nt0) * 64;
    {
      const int tn = (t + 1 < nt) ? t + 1 : t;
      const int kn = (tn < nt0) ? tn * 64 : key1 + (tn - nt0) * 64;
      ATT_GLOAD(kn);
    }
    f32x16 S[2];
#pragma unroll
    for (int kb = 0; kb < 2; ++kb) {
#pragma unroll
      for (int e = 0; e < 16; ++e) S[kb][e] = 0.f;
#pragma unroll
      for (int ks = 0; ks < 4; ++ks) {
        const bf16x8 kf = *(const bf16x8*)(fk + cur + kb * 32 * LROW + ks * 32);
        S[kb] = MFMA(kf, qf[ks], S[kb]);
      }
    }
    if (masked && t >= nt0) {
#pragma unroll
      for (int kb = 0; kb < 2; ++kb)
#pragma unroll
        for (int e = 0; e < 16; ++e) {
          const int jpos = key0 - 512 + kb * 32 + 16 * (e >> 3) + 8 * h + (e & 7);
          const int dlt = qpos - jpos;
          if (dlt > 128 || dlt < -128) S[kb][e] = -1e30f;
        }
    }
    float mloc = S[0][0];
#pragma unroll
    for (int kb = 0; kb < 2; ++kb)
#pragma unroll
      for (int e = 0; e < 16; ++e) mloc = fmaxf(mloc, S[kb][e]);
    mloc = fmaxf(mloc, __shfl_xor(mloc, 32));
    const float mnew = fmaxf(mrun, mloc);
    if (__builtin_amdgcn_ballot_w64(mnew > mrun) != 0) {
      const float alpha = __builtin_amdgcn_exp2f(mrun - mnew);
      lrun *= alpha;
#pragma unroll
      for (int i = 0; i < NDB; ++i)
#pragma unroll
        for (int e = 0; e < 16; ++e) O[i][e] *= alpha;
    }
    mrun = mnew;
    float ps = 0.f;
#pragma unroll
    for (int kb = 0; kb < 2; ++kb)
#pragma unroll
      for (int e = 0; e < 16; ++e) { const float pv = __builtin_amdgcn_exp2f(S[kb][e] - mnew); S[kb][e] = pv; ps += pv; }
    lrun += ps;
    bf16x8 pf[4];
#pragma unroll
    for (int jj = 0; jj < 4; ++jj) {
      const int kb = jj >> 1, o8 = (jj & 1) * 8;
      uint4 w;
      w.x = pack2(S[kb][o8 + 0], S[kb][o8 + 1]); w.y = pack2(S[kb][o8 + 2], S[kb][o8 + 3]);
      w.z = pack2(S[kb][o8 + 4], S[kb][o8 + 5]); w.w = pack2(S[kb][o8 + 6], S[kb][o8 + 7]);
      pf[jj] = __builtin_bit_cast(bf16x8, w);
    }
    __builtin_amdgcn_sched_barrier(0);
#pragma unroll
    for (int i = 0; i < NDB; ++i) {
#pragma unroll
      for (int jj = 0; jj < 4; ++jj) {
        const bf16x8 vf = *(const bf16x8*)(fv + cur + i * 32 * LROW + jj * 32);
        O[i] = MFMA(vf, pf[jj], O[i]);
      }
      if (i & 1) __builtin_amdgcn_sched_barrier(0);
    }
    ATT_SSTORE(KVBUF - cur);
    __syncthreads();
  }
#undef ATT_GLOAD
#undef ATT_SSTORE
  const float ltot = lrun + __shfl_xor(lrun, 32);
  const float inv = 1.0f / ltot;
  u16* op = out + (size_t)(wave * 32 + r) * ldo;
#pragma unroll
  for (int i = 0; i < NDB; ++i)
#pragma unroll
    for (int qd = 0; qd < 4; ++qd) {
      uint2 w;
      w.x = pack2(O[i][4 * qd] * inv, O[i][4 * qd + 1] * inv);
      w.y = pack2(O[i][4 * qd + 2] * inv, O[i][4 * qd + 3] * inv);
      *(uint2*)(op + i * 32 + 8 * qd + 4 * h) = w;
    }
}

DI void ad_tile(f32x16 (&O)[4], f32x16 (&S)[2], f32x16 (&Sn)[2], float& mrun, float& lrun, const bf16x8 (&qf)[4], const char* fk, const char* fv, int cur) {
    {
      constexpr int STG = (64 + 64 + 128) * LROW;
      bf16x8 kf_[8];
#pragma unroll
      for (int kb = 0; kb < 2; ++kb)
#pragma unroll
        for (int ks = 0; ks < 4; ++ks) kf_[kb * 4 + ks] = *(const bf16x8*)(fk + (STG - cur) + kb * 32 * LROW + ks * 32);
#pragma unroll
      for (int kb = 0; kb < 2; ++kb) {
#pragma unroll
        for (int e = 0; e < 16; ++e) Sn[kb][e] = 0.f;
#pragma unroll
        for (int ks = 0; ks < 4; ++ks) Sn[kb] = MFMA(kf_[kb * 4 + ks], qf[ks], Sn[kb]);
      }
    }
    __builtin_amdgcn_sched_group_barrier(0x020, 4, 0);
    __builtin_amdgcn_sched_group_barrier(0x100, 8, 0);
    __builtin_amdgcn_sched_group_barrier(0x008, 8, 0);
    __builtin_amdgcn_sched_barrier(0);
    float mloc = S[0][0];
#pragma unroll
    for (int kb = 0; kb < 2; ++kb)
#pragma unroll
      for (int e = 0; e < 16; ++e) mloc = fmaxf(mloc, S[kb][e]);
    mloc = fmaxf(mloc, __shfl_xor(mloc, 32));
    const float mnew = fmaxf(mrun, mloc);
    if (__builtin_amdgcn_ballot_w64(mnew > mrun) != 0) {
      const float alpha = __builtin_amdgcn_exp2f(mrun - mnew);
      lrun *= alpha;
#pragma unroll
      for (int i = 0; i < 4; ++i)
#pragma unroll
        for (int e = 0; e < 16; ++e) O[i][e] *= alpha;
    }
    mrun = mnew;
    float ps = 0.f;
#pragma unroll
    for (int kb = 0; kb < 2; ++kb)
#pragma unroll
      for (int e = 0; e < 16; ++e) { const float pv = __builtin_amdgcn_exp2f(S[kb][e] - mnew); S[kb][e] = pv; ps += pv; }
    lrun += ps;
    bf16x8 pf[4];
#pragma unroll
    for (int jj = 0; jj < 4; ++jj) {
      const int kb = jj >> 1, o8 = (jj & 1) * 8;
      uint4 w;
      w.x = pack2(S[kb][o8 + 0], S[kb][o8 + 1]); w.y = pack2(S[kb][o8 + 2], S[kb][o8 + 3]);
      w.z = pack2(S[kb][o8 + 4], S[kb][o8 + 5]); w.w = pack2(S[kb][o8 + 6], S[kb][o8 + 7]);
      pf[jj] = __builtin_bit_cast(bf16x8, w);
    }
    __builtin_amdgcn_sched_barrier(0);
    {
      bf16x8 vfa[4], vfb[4];
#pragma unroll
      for (int jj = 0; jj < 4; ++jj) vfa[jj] = *(const bf16x8*)(fv + cur + jj * 32);
#pragma unroll
      for (int jj = 0; jj < 4; ++jj) vfb[jj] = *(const bf16x8*)(fv + cur + 32 * LROW + jj * 32);
#pragma unroll
      for (int jj = 0; jj < 4; ++jj) O[0] = MFMA(vfa[jj], pf[jj], O[0]);
#pragma unroll
      for (int jj = 0; jj < 4; ++jj) vfa[jj] = *(const bf16x8*)(fv + cur + 64 * LROW + jj * 32);
#pragma unroll
      for (int jj = 0; jj < 4; ++jj) O[1] = MFMA(vfb[jj], pf[jj], O[1]);
#pragma unroll
      for (int jj = 0; jj < 4; ++jj) vfb[jj] = *(const bf16x8*)(fv + cur + 96 * LROW + jj * 32);
#pragma unroll
      for (int jj = 0; jj < 4; ++jj) O[2] = MFMA(vfa[jj], pf[jj], O[2]);
#pragma unroll
      for (int jj = 0; jj < 4; ++jj) O[3] = MFMA(vfb[jj], pf[jj], O[3]);
      __builtin_amdgcn_sched_group_barrier(0x100, 8, 0);
      __builtin_amdgcn_sched_group_barrier(0x008, 4, 0);
      __builtin_amdgcn_sched_group_barrier(0x100, 4, 0);
      __builtin_amdgcn_sched_group_barrier(0x008, 4, 0);
      __builtin_amdgcn_sched_group_barrier(0x100, 4, 0);
      __builtin_amdgcn_sched_group_barrier(0x008, 8, 0);
    }
    __builtin_amdgcn_sched_barrier(0);
}

DI void attn_diff_pair(const u16* Q, const u16* Kb, const u16* Vt, int ldv, int nt, float lam, const float* subln_g, u16* out, char* shm, int half) {
  constexpr int STG = (64 + 64 + 128) * LROW;
  const int tid = TIDX, t512 = (int)threadIdx.x, lane = tid & 63, wave = tid >> 6;
  const int r = lane & 31, h = lane >> 5;
  bf16x8 qf[4];
#pragma unroll
  for (int ks = 0; ks < 4; ++ks) qf[ks] = *(const bf16x8*)(Q + (size_t)(wave * 32 + r) * 64 + ks * 16 + h * 8);
  f32x16 O[4];
#pragma unroll
  for (int i = 0; i < 4; ++i)
#pragma unroll
    for (int e = 0; e < 16; ++e) O[i][e] = 0.f;
  float mrun = -1e30f, lrun = 0.f;
  const int lrow = tid >> 3, lpart = (tid & 7) * 8;
  const int vrow = t512 >> 3, vpart = (t512 & 7) * 8;
  const u16* gk = Kb + (size_t)lrow * 64 + lpart;
  const u16* gv = Vt + (size_t)vrow * ldv + vpart;
  char* sk = shm + half * 64 * LROW + lrow * LROW + lpart * 2;
  char* sv = shm + 128 * LROW + vrow * LROW + vpart * 2;
  u32x4 rk0, rk1, rv0, rv1;
#define AD_GLOAD(key0_) do { rk0 = *(const u32x4*)(gk + (size_t)(key0_) * 64); rk1 = *(const u32x4*)(gk + (size_t)((key0_) + 32) * 64); \
                             rv0 = *(const u32x4*)(gv + (key0_)); rv1 = *(const u32x4*)(gv + (size_t)64 * ldv + (key0_)); } while (0)
#define AD_SSTORE(boff_) do { *(u32x4*)(sk + (boff_)) = rk0; *(u32x4*)(sk + (boff_) + 32 * LROW) = rk1; \
                              *(u32x4*)(sv + (boff_)) = rv0; *(u32x4*)(sv + (boff_) + 64 * LROW) = rv1; } while (0)
#define AD_GLOAD_K(R0_, R1_, key0_) do { R0_ = *(const u32x4*)(gk + (size_t)(key0_) * 64); R1_ = *(const u32x4*)(gk + (size_t)((key0_) + 32) * 64); } while (0)
#define AD_GLOAD_V(R0_, R1_, key0_) do { R0_ = *(const u32x4*)(gv + (key0_)); R1_ = *(const u32x4*)(gv + (size_t)64 * ldv + (key0_)); } while (0)
#define AD_SSTORE_K(R0_, R1_, boff_) do { *(u32x4*)(sk + (boff_)) = R0_; *(u32x4*)(sk + (boff_) + 32 * LROW) = R1_; } while (0)
#define AD_SSTORE_V(R0_, R1_, boff_) do { *(u32x4*)(sv + (boff_)) = R0_; *(u32x4*)(sv + (boff_) + 64 * LROW) = R1_; } while (0)
#define AD_QK(S_, koff_) do { bf16x8 kf_[8]; \
    _Pragma("unroll") for (int kb = 0; kb < 2; ++kb) _Pragma("unroll") for (int ks = 0; ks < 4; ++ks) kf_[kb * 4 + ks] = *(const bf16x8*)(fk + (koff_) + kb * 32 * LROW + ks * 32); \
    _Pragma("unroll") for (int kb = 0; kb < 2; ++kb) { _Pragma("unroll") for (int e = 0; e < 16; ++e) S_[kb][e] = 0.f; \
    _Pragma("unroll") for (int ks = 0; ks < 4; ++ks) S_[kb] = MFMA(kf_[kb * 4 + ks], qf[ks], S_[kb]); } } while (0)
  const int pr = (r & 0x13) | ((r & 4) << 1) | ((r & 8) >> 1);
  const char* fk = shm + half * 64 * LROW + pr * LROW + h * 16;
  const char* fv = shm + 128 * LROW + r * LROW + h * 16;
  u32x4 ak0, ak1, av0, av1, bk0, bk1, bv0, bv1;
  AD_GLOAD_K(ak0, ak1, 0); AD_GLOAD_V(av0, av1, 0);
  AD_SSTORE_K(ak0, ak1, 0); AD_SSTORE_V(av0, av1, 0);
  AD_GLOAD_K(ak0, ak1, 64);
  AD_SSTORE_K(ak0, ak1, STG);
  AD_GLOAD_K(bk0, bk1, 128); AD_GLOAD_V(bv0, bv1, 64);
  __syncthreads();
  f32x16 S[2], Sn[2];
  AD_QK(S, 0);
  __syncthreads();
#define AD_STEP(t_, LK0, LK1, LV0, LV1, SK0, SK1, SV0, SV1) do { \
    const int t = (t_); const int cur = (t & 1) * STG; \
    { const int tk = (t + 3 < nt) ? t + 3 : nt - 1, tv = (t + 2 < nt) ? t + 2 : nt - 1; AD_GLOAD_K(LK0, LK1, tk * 64); AD_GLOAD_V(LV0, LV1, tv * 64); } \
    ad_tile(O, S, Sn, mrun, lrun, qf, fk, fv, cur); \
    AD_SSTORE_K(SK0, SK1, cur); AD_SSTORE_V(SV0, SV1, STG - cur); \
    __syncthreads(); \
    S[0] = Sn[0]; S[1] = Sn[1]; } while (0)
  for (int tt = 0; tt < nt; tt += 2) {
    AD_STEP(tt, ak0, ak1, av0, av1, bk0, bk1, bv0, bv1);
    AD_STEP(tt + 1, bk0, bk1, bv0, bv1, ak0, ak1, av0, av1);
  }
#undef AD_STEP
#undef AD_GLOAD_K
#undef AD_GLOAD_V
#undef AD_SSTORE_K
#undef AD_SSTORE_V
#undef AD_QK
#undef AD_GLOAD
#undef AD_SSTORE
  const float inv = 1.0f / (lrun + __shfl_xor(lrun, 32));
  float* ex = (float*)shm + (size_t)wave * 4096 + lane;
  if (half == 1) {
#pragma unroll
    for (int i = 0; i < 4; ++i)
#pragma unroll
      for (int e = 0; e < 16; ++e) ex[(i * 16 + e) * 64] = O[i][e] * inv;
  }
  __syncthreads();
  if (half == 0) {
    float ss = 0.f;
#pragma unroll
    for (int i = 0; i < 4; ++i)
#pragma unroll
      for (int e = 0; e < 16; ++e) { const float d = O[i][e] * inv - lam * ex[(i * 16 + e) * 64]; O[i][e] = d; ss += d * d; }
    ss += __shfl_xor(ss, 32);
    const float rinv = rsqrtf(ss * (1.0f / 128.0f) + EPS) * (1.0f - LAM_INIT);
    u16* op = out + (size_t)(wave * 32 + r) * 1024;
#pragma unroll
    for (int i = 0; i < 4; ++i)
#pragma unroll
      for (int qd = 0; qd < 4; ++qd) {
        const int e0 = i * 32 + 8 * qd + 4 * h;
        const float4 g = *(const float4*)(subln_g + e0);
        uint2 w;
        w.x = pack2(O[i][4 * qd] * rinv * g.x, O[i][4 * qd + 1] * rinv * g.y);
        w.y = pack2(O[i][4 * qd + 2] * rinv * g.z, O[i][4 * qd + 3] * rinv * g.w);
        *(uint2*)(op + e0) = w;
      }
  }
  __syncthreads();
}

DI void attention_phase(const Params& p, int vb0, int half, char* shm) {
  const u16* CQ = (const u16*)(p.ws + OFF_CQ); const u16* DQ = (const u16*)(p.ws + OFF_DQ);
  const u16* CKP = (const u16*)(p.ws + OFF_CKP); const u16* CKS = (const u16*)(p.ws + OFF_CKS);
  const u16* CVTP = (const u16*)(p.ws + OFF_CVTP); const u16* CVTS = (const u16*)(p.ws + OFF_CVTS);
  const u16* DKP = (const u16*)(p.ws + OFF_DKP); const u16* DKS = (const u16*)(p.ws + OFF_DKS);
  const u16* DVTP = (const u16*)(p.ws + OFF_DVTP); const u16* DVTS = (const u16*)(p.ws + OFF_DVTS);
  u16* AC = (u16*)(p.ws + OFF_H);
  constexpr size_t QS = (size_t)16 * 8 * 256 * 64;
  const int lane = TIDX & 63;
  const float la = wave_sum(p.in[20][lane] * p.in[21][lane]);
  const float lb = wave_sum(p.in[22][lane] * p.in[23][lane]);
  const float lam = expf(la) - expf(lb) + LAM_INIT;
  const int nblk = (int)gridDim.x;
  for (int it = vb0; it < 768; it += nblk) {
    const bool diff = (it < 256) || (it >= 512 && it < 640);
    const bool samp = it < 512;
    if (diff) {
      int qb, hh, b;
      if (samp) { qb = it & 31; hh = (it >> 5) & 3; b = it >> 7; }
      else { const int i2 = it - 512; qb = i2 & 1; hh = (i2 >> 1) & 3; b = i2 >> 3; }
      const int nseq = samp ? 4096 : 256, nkeys = samp ? 4608 : 256;
      const int tok = samp ? 4096 + b * 4096 + qb * 128 : b * 256 + qb * 128;
      const int hm = hh * 2 + half;
      const size_t qoff = (samp ? QS : 0) + ((size_t)(b * 8 + hm) * nseq + qb * 128) * 64;
      const u16* Kp = (samp ? CKS : CKP) + (size_t)(b * 8 + hm) * nkeys * 64;
      const u16* Vp = (samp ? CVTS : CVTP) + (size_t)(b * 4 + hh) * 128 * nkeys;
      attn_diff_pair(CQ + qoff, Kp, Vp, nkeys, nkeys >> 6, lam, p.in[24], AC + (size_t)tok * 1024 + hh * 128, shm, half);
    } else {
      int qb, hd, b;
      if (samp) { const int i2 = (it - 256) * 2 + half; qb = i2 & 31; hd = (i2 >> 5) & 7; b = i2 >> 8; }
      else { const int i2 = (it - 640) * 2 + half; qb = i2 & 1; hd = (i2 >> 1) & 7; b = i2 >> 4; }
      const int nseq = samp ? 4096 : 256, nkeys = samp ? 4608 : 256;
      const int tok = samp ? 4096 + b * 4096 + qb * 128 : b * 256 + qb * 128;
      const size_t qoff = (samp ? QS : 0) + ((size_t)(b * 8 + hd) * nseq + qb * 128) * 64;
      const u16* Kp = (samp ? DKS : DKP) + (size_t)(b * 2 + (hd >> 2)) * nkeys * 64;
      const u16* Vp = (samp ? DVTS : DVTP) + (size_t)(b * 2 + (hd >> 2)) * 64 * nkeys;
      int nt0 = 4, key1 = 0, nt1 = 0;
      if (samp) { const int lo = min(max(qb * 128 - 128, 0), 4096 - 384); nt0 = 8; key1 = 512 + lo; nt1 = 6; }
      attn_item<64>(DQ + qoff, Kp, Vp, nkeys, nt0, key1, nt1, samp, qb * 128, true, p.in[27][hd] * LOG2E, AC + (size_t)tok * 1024 + 512 + hd * 64, 1024, shm + half * LDS_BYTES);
    }
  }
}

namespace pg8 {
#define PG8_LAS __attribute__((address_space(3)))
typedef unsigned short bf16_t;
typedef short bf16x8 __attribute__((ext_vector_type(8)));
typedef float f32x4 __attribute__((ext_vector_type(4)));
typedef unsigned u32x4 __attribute__((ext_vector_type(4)));
constexpr int BM = 256, BK = 64, HALF = 128, HTB = HALF * BK * 2  , STAGE_BYTES = 8 * HTB, NXCD = 8, WGM = 8;

__host__ __device__ __forceinline__ int lds_byte(int r, int c) { const int st = (r >> 4) * 2 + (c >> 5), rr = r & 15, cc = c & 31, ob = rr * 64 + cc * 2; return st * 1024 + (ob ^ (((ob >> 9) & 1) << 5)); }
__host__ __device__ __forceinline__ void stage_rc(int b, int& R, int& C) { const int st = b / 1024, sb = b % 1024, swz = sb ^ (((sb >> 9) & 1) << 5); R = (st >> 1) * 16 + swz / 64; C = (st & 1) * 32 + (swz % 64) / 2; }
__host__ __device__ __forceinline__ int perm32(int rho) { const int n = rho >> 4, i = rho & 15; return 8 * (i >> 2) + 4 * n + (i & 3); }

struct Unit { int pm, pn; };
struct Gemm { const bf16_t* A; const bf16_t* Bt; int M, N, K; };

struct StaticOrder {
    int nM, nN, nwg, G, c;
    __host__ __device__ void init(int M, int N, int G_, int c_) { nM = M / BM; nN = N / BM; nwg = nM * nN; G = G_; c = c_; }
    __host__ __device__ bool next(int i, Unit& u) const {
        const long L = (long)i * G + c; if (L >= nwg) return false;
        int wgid = (int)L; { const int q = nwg / NXCD, r = nwg % NXCD, xcd = wgid % NXCD, off = wgid / NXCD; wgid = (xcd < r ? xcd * (q + 1) : r * (q + 1) + (xcd - r) * q) + off; }
        const int nig = WGM * nN, gid = wgid / nig, fm = gid * WGM, gsz = (nM - fm) < WGM ? (nM - fm) : WGM;
        u.pm = fm + ((wgid % nig) % gsz); u.pn = (wgid % nig) / gsz; return true;
    }
    __device__ __forceinline__ void a_ready(const Unit&) const {}
    __device__ __forceinline__ void done(const Unit&) const {}
};
template <class Epi, class Sched, bool STAMP = false, int MB = 4>
__device__ __forceinline__ void gemm_phase(PG8_LAS unsigned char* lds, const Gemm g, const Sched& S, const Epi& E, unsigned long long* stamps) {
    const int tid = threadIdx.x, wid = __builtin_amdgcn_readfirstlane(tid >> 6), lane = tid & 63, wr = wid >> 2, wc = wid & 3, fr = lane & 15, fq = lane >> 4;
    const int K = g.K, nt = K / BK;
    int ts_lo = 0, ts_hi = 0, nts = 0; const unsigned long long rt_entry = STAMP ? (unsigned long long)wall_clock64() : 0ull;
#define PG8_STAMP() do { if (STAMP && wid == 0 && nts < 64) { const unsigned long long _c = (unsigned long long)clock64(); \
        ts_lo = (lane == nts) ? (int)(unsigned)_c : ts_lo; ts_hi = (lane == nts) ? (int)(unsigned)(_c >> 32) : ts_hi; ++nts; } } while (0)
    PG8_STAMP();
    unsigned voffA[2], voffB[2], voffB1[2];
#pragma unroll
    for (int i = 0; i < 2; ++i) { int R, C; stage_rc(tid * 16 + i * 8192, R, C); const int Rb = Epi::PERM ? ((R & ~31) + perm32(R & 31)) : R;
        voffA[i] = (unsigned)(R * K + C) * 2u; voffB[i] = (unsigned)(Rb * K + C) * 2u; voffB1[i] = voffB[i];
        if constexpr (Epi::HEADPERM) {
            const int rho = R & 31, np = rho >> 4, ii = rho & 15, fqq = ii >> 2, jj = ii & 3;
            const int d0 = 64 * (R >> 5) + 32 * (fqq >> 1) + 8 * (fqq & 1) + 4 * np + jj;
            voffB[i] = (unsigned)(d0 * K + C) * 2u; voffB1[i] = (unsigned)((d0 + 16) * K + C) * 2u; } }
    const size_t hB1 = Epi::HEADPERM ? (size_t)0 : (size_t)HALF * K * 2;
    const size_t kstep = (size_t)(BK * 2);
    const size_t hstep = (size_t)HALF * K * 2; const size_t hstepA = (size_t)(32 * MB) * K * 2;
    const size_t tstep = 2 * hstep; const size_t tstepA = 2 * hstepA;
    const unsigned ldsw = (unsigned)wid * 1024u;
    const int aoff = lds_byte(wr * 16 * MB + fr, fq * 8), boff = lds_byte(wc * 32 + fr, fq * 8);
#define PG8_SA(b, h) (((b) * 2 + (h)) * HTB)
#define PG8_SB(b, h) ((4 + (b) * 2 + (h)) * HTB)
#define PG8_STAGE(bufoff, gbase, voff) do { _Pragma("unroll") for (int _i = 0; _i < 2; ++_i) \
        __builtin_amdgcn_global_load_lds((const unsigned*)((const char*)(gbase) + (voff)[_i]), (PG8_LAS unsigned*)(lds + (bufoff) + ldsw + _i * 8192), 16, 0, 0); } while (0)
#define PG8_LDA(dst, b, h) do { _Pragma("unroll") for (int m = 0; m < MB; ++m) _Pragma("unroll") for (int k = 0; k < 2; ++k) dst[m][k] = *(const PG8_LAS bf16x8*)(lds + PG8_SA(b, h) + aoff + m * 2048 + k * 1024); } while (0)
#define PG8_LDB(dst, b, h) do { _Pragma("unroll") for (int n = 0; n < 2; ++n) _Pragma("unroll") for (int k = 0; k < 2; ++k) dst[n][k] = *(const PG8_LAS bf16x8*)(lds + PG8_SB(b, h) + boff + n * 2048 + k * 1024); } while (0)
#define PG8_MMA(ai, bj, At, Bt) do { __builtin_amdgcn_s_setprio(1); _Pragma("unroll") for (int m = 0; m < MB; ++m) _Pragma("unroll") for (int n = 0; n < 2; ++n) _Pragma("unroll") for (int k = 0; k < 2; ++k) \
        acc[ai][bj][m][n] = __builtin_amdgcn_mfma_f32_16x16x32_bf16(Bt[n][k], At[m][k], acc[ai][bj][m][n], 0, 0, 0); __builtin_amdgcn_s_setprio(0); } while (0)
#define PG8_WAIT_V(n) asm volatile("s_waitcnt vmcnt(" #n ")" ::: "memory")
#define PG8_WAIT_L(n) asm volatile("s_waitcnt lgkmcnt(" #n ")" ::: "memory")
#define PG8_BAR __builtin_amdgcn_s_barrier()
#define PG8_SCHED __builtin_amdgcn_sched_barrier(0)
    Unit cur, nxt; int ui = 0;
    if (!S.next(0, cur)) return;
    f32x4 acc[2][2][MB][2];
#pragma unroll
    for (int a = 0; a < 2; ++a)
#pragma unroll
        for (int b = 0; b < 2; ++b)
#pragma unroll
            for (int m = 0; m < MB; ++m)
#pragma unroll
                for (int n = 0; n < 2; ++n) acc[a][b][m][n] = (f32x4){0.f, 0.f, 0.f, 0.f};
    bf16x8 At[MB][2], B0[2][2], B1[2][2];
    const char* cA = (const char*)g.A + (size_t)cur.pm * tstepA; const char* cB = (const char*)g.Bt + (size_t)cur.pn * tstep;
    S.a_ready(cur);
    PG8_STAGE(PG8_SB(0, 0), cB, voffB); PG8_STAGE(PG8_SA(0, 0), cA, voffA); PG8_STAGE(PG8_SB(0, 1), cB + hB1, voffB1); PG8_STAGE(PG8_SA(0, 1), cA + hstepA, voffA);
    if (wr == 1) PG8_BAR;
    PG8_WAIT_V(4); PG8_BAR;
    PG8_STAGE(PG8_SB(1, 0), cB + kstep, voffB); PG8_STAGE(PG8_SA(1, 0), cA + kstep, voffA); PG8_STAGE(PG8_SB(1, 1), cB + hB1 + kstep, voffB1);
    PG8_WAIT_V(6); PG8_BAR;
    PG8_STAMP();
    for (;;) {
        const bool has_next = S.next(ui + 1, nxt);
        const char* nA = has_next ? (const char*)g.A + (size_t)nxt.pm * tstepA : cA; const char* nB = has_next ? (const char*)g.Bt + (size_t)nxt.pn * tstep : cB;
        for (int t = 0; t < nt; t += 2) {
            const bool last = (t == nt - 2);
            const char* a1 = cA + (size_t)(t + 1) * kstep;
            const char* a2 = last ? nA : cA + (size_t)(t + 2) * kstep; const char* b2 = last ? nB : cB + (size_t)(t + 2) * kstep;
            const char* a3 = a2 + kstep; const char* b3 = b2 + kstep;
            if (last && has_next) S.a_ready(nxt);
            PG8_LDB(B0, 0, 0); PG8_SCHED; PG8_LDA(At, 0, 0); PG8_STAGE(PG8_SA(1, 1), a1 + hstepA, voffA);
            PG8_WAIT_L(8); PG8_BAR; PG8_WAIT_L(0); PG8_MMA(0, 0, At, B0); PG8_BAR; PG8_SCHED;
            PG8_LDB(B1, 0, 1); PG8_STAGE(PG8_SB(0, 0), b2, voffB);
            PG8_BAR; PG8_WAIT_L(0); PG8_MMA(0, 1, At, B1); PG8_BAR;
            PG8_LDA(At, 0, 1); PG8_STAGE(PG8_SA(0, 0), a2, voffA);
            PG8_BAR; PG8_WAIT_L(0); PG8_MMA(1, 0, At, B0); PG8_BAR; PG8_SCHED;
            PG8_STAGE(PG8_SB(0, 1), b2 + hB1, voffB1);
            PG8_WAIT_V(6); PG8_BAR; PG8_MMA(1, 1, At, B1); PG8_BAR;
            PG8_LDB(B0, 1, 0); PG8_SCHED; PG8_LDA(At, 1, 0); PG8_STAGE(PG8_SA(0, 1), a2 + hstepA, voffA);
            PG8_WAIT_L(8); PG8_BAR; PG8_WAIT_L(0); PG8_MMA(0, 0, At, B0); PG8_BAR; PG8_SCHED;
            PG8_LDB(B1, 1, 1); PG8_STAGE(PG8_SB(1, 0), b3, voffB);
            PG8_BAR; PG8_WAIT_L(0); PG8_MMA(0, 1, At, B1); PG8_BAR;
            PG8_LDA(At, 1, 1); PG8_STAGE(PG8_SA(1, 0), a3, voffA);
            PG8_BAR; PG8_WAIT_L(0); PG8_MMA(1, 0, At, B0); PG8_BAR; PG8_SCHED;
            PG8_STAGE(PG8_SB(1, 1), b3 + hB1, voffB1);
            PG8_WAIT_V(6); PG8_BAR; PG8_MMA(1, 1, At, B1); PG8_BAR;
        }
        PG8_STAMP();
        if constexpr (!Epi::AFTER_DRAIN) { E(acc, cur, wr, wc, fr, fq); S.done(cur); }
        PG8_STAMP();
        if (!has_next) break;
#pragma unroll
        for (int a = 0; a < 2; ++a)
#pragma unroll
            for (int b = 0; b < 2; ++b)
#pragma unroll
                for (int m = 0; m < MB; ++m)
#pragma unroll
                    for (int n = 0; n < 2; ++n) acc[a][b][m][n] = (f32x4){0.f, 0.f, 0.f, 0.f};
        cur = nxt; cA = nA; cB = nB; ++ui;
    }
    PG8_WAIT_V(0);
    if (wr == 0) PG8_BAR;
    PG8_BAR;
    if constexpr (Epi::AFTER_DRAIN) { E.fused(acc, cur, wr, wc, fr, fq, lds, wid, lane); S.done(cur); }
    PG8_STAMP();
    if (STAMP && wid == 0) { stamps[lane] = lane < nts ? (((unsigned long long)(unsigned)ts_hi << 32) | (unsigned)ts_lo) : 0ull;
        if (lane == 62) stamps[62] = rt_entry; if (lane == 63) stamps[63] = (unsigned long long)wall_clock64(); }
#undef PG8_STAMP
#undef PG8_SA
#undef PG8_SB
#undef PG8_STAGE
#undef PG8_LDA
#undef PG8_LDB
#undef PG8_MMA
#undef PG8_WAIT_V
#undef PG8_WAIT_L
#undef PG8_BAR
#undef PG8_SCHED
}
}

typedef float f32x4 __attribute__((ext_vector_type(4)));
template <class F, int MB> struct RowEpi {
  static constexpr bool PERM = false, AFTER_DRAIN = false, HEADPERM = false;
  F f;
  DI void operator()(const pg8::f32x4 (&acc)[2][2][MB][2], const pg8::Unit& u, int wr, int wc, int fr, int fq) const {
    const int row0 = u.pm * (64 * MB) + wr * 16 * MB + fr, col0 = u.pn * 256 + wc * 32 + 4 * fq;
#pragma unroll
    for (int ai = 0; ai < 2; ++ai)
#pragma unroll
      for (int m = 0; m < MB; ++m)
#pragma unroll
        for (int bj = 0; bj < 2; ++bj)
#pragma unroll
          for (int n = 0; n < 2; ++n) f(row0 + ai * 32 * MB + m * 16, col0 + bj * 128 + n * 16, acc[ai][bj][m][n]);
  }
};
struct FU {
  u16* UA; u16* PQt;
  DI void operator()(int m, int n, pg8::f32x4 v) const {
    if (n < 512) {
      uint2 w; w.x = pack2(v[0], v[1]); w.y = pack2(v[2], v[3]);
      *(uint2*)(UA + (size_t)m * 512 + n) = w;
    } else {
      const int np = n - 512, g = np >> 8, pq = (np >> 7) & 1, mm = np & 127;
      u16* q; size_t st;
      if (m < 4096) { const int b = m >> 8, nl = m & 255; q = PQt + ((size_t)(b * 512 + g * 128 + mm)) * 512 + pq * 256 + nl; st = 512; }
      else { const int ms = m - 4096, b = ms >> 12, nl = ms & 4095; q = PQt + (size_t)16 * 512 * 512 + ((size_t)(b * 512 + g * 128 + mm)) * 8192 + pq * 4096 + nl; st = 8192; }
      q[0] = f2bf(v[0]); q[st] = f2bf(v[1]); q[2 * st] = f2bf(v[2]); q[3 * st] = f2bf(v[3]);
    }
  }
};
struct FRes {
  const float* xin_p; const float* xin_s; float* X; const float* gate;
  DI void operator()(int m, int n, pg8::f32x4 v) const {
    const float* xi = (m < 4096) ? xin_p + (size_t)m * 1024 + n : xin_s + (size_t)(m - 4096) * 1024 + n;
    const float4 x = *(const float4*)xi;
    const float4 g = *(const float4*)(gate + cond_of(m) * 6144 + n);
    *(float4*)(X + (size_t)m * 1024 + n) = make_float4(x.x + g.x * v[0], x.y + g.y * v[1], x.z + g.z * v[2], x.w + g.w * v[3]);
  }
};
struct FRelu2 {
  u16* C;
  DI void operator()(int m, int n, pg8::f32x4 v) const {
    const float a = fmaxf(v[0], 0.f), b = fmaxf(v[1], 0.f), c = fmaxf(v[2], 0.f), d = fmaxf(v[3], 0.f);
    uint2 w; w.x = pack2(a * a, b * b); w.y = pack2(c * c, d * d);
    *(uint2*)(C + (size_t)m * 4096 + n) = w;
  }
};
struct FQkv {
  u16* QKV; u16* CVtP; u16* CVtS; u16* DVtP; u16* DVtS; float* ncv; float* ndv;
  DI void operator()(int m, int n, pg8::f32x4 v) const {
    const bool is_cv = (n >= 1024 && n < 1536), is_dv = (n >= 2176);
    if (!is_cv && !is_dv) {
      uint2 w; w.x = pack2(v[0], v[1]); w.y = pack2(v[2], v[3]);
      *(uint2*)(QKV + (size_t)m * 2304 + n) = w;
      return;
    }
    const int c = is_cv ? n - 1024 : n - 2176;
    const int feat = is_cv ? 512 : 128;
    u16* q; size_t st;
    if (m < 4096) {
      const int b = m >> 8, nl = m & 255;
      q = (is_cv ? CVtP : DVtP) + ((size_t)(b * feat + c)) * 256 + nl; st = 256;
      *(float4*)((is_cv ? ncv : ndv) + (size_t)m * feat + c) = make_float4(v[0], v[1], v[2], v[3]);
    } else {
      const int ms = m - 4096, b = ms >> 12, nl = ms & 4095;
      q = (is_cv ? CVtS : DVtS) + ((size_t)(b * feat + c)) * 4608 + 512 + nl; st = 4608;
    }
    q[0] = f2bf(v[0]); q[st] = f2bf(v[1]); q[2 * st] = f2bf(v[2]); q[3 * st] = f2bf(v[3]);
  }
};
template <int MB, class F>
DI void big_gemm(PG8_LAS unsigned char* lds, const u16* A, const u16* Bt, int M, int N, int K, F f) {
  pg8::Gemm g{A, Bt, M, N, K};
  pg8::StaticOrder S; S.init(M, N, (int)gridDim.x, (int)blockIdx.x);
  S.nM = M / (64 * MB); S.nwg = S.nM * S.nN;
  RowEpi<F, MB> E{f};
  pg8::gemm_phase<RowEpi<F, MB>, pg8::StaticOrder, false, MB>(lds, g, S, E, nullptr);
}

template <class F, int MB> struct RowEpi8 {
  static constexpr bool PERM = true, AFTER_DRAIN = false, HEADPERM = false;
  F f;
  DI void operator()(const pg8::f32x4 (&acc)[2][2][MB][2], const pg8::Unit& u, int wr, int wc, int fr, int fq) const {
    const int row0 = u.pm * (64 * MB) + wr * 16 * MB + fr, col0 = u.pn * 256 + wc * 32 + 8 * fq;
#pragma unroll
    for (int ai = 0; ai < 2; ++ai)
#pragma unroll
      for (int m = 0; m < MB; ++m)
#pragma unroll
        for (int bj = 0; bj < 2; ++bj) f(row0 + ai * 32 * MB + m * 16, col0 + bj * 128, acc[ai][bj][m][0], acc[ai][bj][m][1]);
  }
};
struct FRelu2x8 {
  u16* C;
  DI void operator()(int m, int n, pg8::f32x4 a, pg8::f32x4 b) const {
    uint4 w;
    float x0 = fmaxf(a[0], 0.f), x1 = fmaxf(a[1], 0.f), x2 = fmaxf(a[2], 0.f), x3 = fmaxf(a[3], 0.f);
    float y0 = fmaxf(b[0], 0.f), y1 = fmaxf(b[1], 0.f), y2 = fmaxf(b[2], 0.f), y3 = fmaxf(b[3], 0.f);
    w.x = pack2(x0 * x0, x1 * x1); w.y = pack2(x2 * x2, x3 * x3); w.z = pack2(y0 * y0, y1 * y1); w.w = pack2(y2 * y2, y3 * y3);
    *(uint4*)(C + (size_t)m * 4096 + n) = w;
  }
};
struct FUx8 {
  u16* UA; u16* PQt;
  DI void operator()(int m, int n, pg8::f32x4 a, pg8::f32x4 b) const {
    if (n < 512) {
      uint4 w; w.x = pack2(a[0], a[1]); w.y = pack2(a[2], a[3]); w.z = pack2(b[0], b[1]); w.w = pack2(b[2], b[3]);
      *(uint4*)(UA + (size_t)m * 512 + n) = w;
    } else {
      const int np = n - 512, g = np >> 8, pq = (np >> 7) & 1, mm = np & 127;
      u16* q; size_t st;
      if (m < 4096) { const int bb = m >> 8, nl = m & 255; q = PQt + ((size_t)(bb * 512 + g * 128 + mm)) * 512 + pq * 256 + nl; st = 512; }
      else { const int ms = m - 4096, bb = ms >> 12, nl = ms & 4095; q = PQt + (size_t)16 * 512 * 512 + ((size_t)(bb * 512 + g * 128 + mm)) * 8192 + pq * 4096 + nl; st = 8192; }
      q[0] = f2bf(a[0]); q[st] = f2bf(a[1]); q[2 * st] = f2bf(a[2]); q[3 * st] = f2bf(a[3]);
      q[4 * st] = f2bf(b[0]); q[5 * st] = f2bf(b[1]); q[6 * st] = f2bf(b[2]); q[7 * st] = f2bf(b[3]);
    }
  }
};
struct FQkvx8 {
  u16* QKV; u16* CVtP; u16* CVtS; u16* DVtP; u16* DVtS; float* ncv; float* ndv;
  DI void operator()(int m, int n, pg8::f32x4 a, pg8::f32x4 b) const {
    const bool is_cv = (n >= 1024 && n < 1536), is_dv = (n >= 2176);
    if (!is_cv && !is_dv) {
      uint4 w; w.x = pack2(a[0], a[1]); w.y = pack2(a[2], a[3]); w.z = pack2(b[0], b[1]); w.w = pack2(b[2], b[3]);
      *(uint4*)(QKV + (size_t)m * 2304 + n) = w;
      return;
    }
    const int c = is_cv ? n - 1024 : n - 2176;
    const int feat = is_cv ? 512 : 128;
    u16* q; size_t st;
    if (m < 4096) {
      const int bb = m >> 8, nl = m & 255;
      q = (is_cv ? CVtP : DVtP) + ((size_t)(bb * feat + c)) * 256 + nl; st = 256;
      float* o = (is_cv ? ncv : ndv) + (size_t)m * feat + c;
      *(float4*)o = make_float4(a[0], a[1], a[2], a[3]);
      *(float4*)(o + 4) = make_float4(b[0], b[1], b[2], b[3]);
    } else {
      const int ms = m - 4096, bb = ms >> 12, nl = ms & 4095;
      q = (is_cv ? CVtS : DVtS) + ((size_t)(bb * feat + c)) * 4608 + 512 + nl; st = 4608;
    }
    q[0] = f2bf(a[0]); q[st] = f2bf(a[1]); q[2 * st] = f2bf(a[2]); q[3 * st] = f2bf(a[3]);
    q[4 * st] = f2bf(b[0]); q[5 * st] = f2bf(b[1]); q[6 * st] = f2bf(b[2]); q[7 * st] = f2bf(b[3]);
  }
};
template <int MB, class F>
DI void big_gemm8(PG8_LAS unsigned char* lds, const u16* A, const u16* Bt, int M, int N, int K, F f) {
  pg8::Gemm g{A, Bt, M, N, K};
  pg8::StaticOrder S; S.init(M, N, (int)gridDim.x, (int)blockIdx.x);
  S.nM = M / (64 * MB); S.nwg = S.nM * S.nN;
  RowEpi8<F, MB> E{f};
  pg8::gemm_phase<RowEpi8<F, MB>, pg8::StaticOrder, false, MB>(lds, g, S, E, nullptr);
}

template <int MB> struct ResNormEpi {
  static constexpr bool PERM = false, AFTER_DRAIN = true, HEADPERM = false;
  const float* xin_p; const float* xin_s; float* X; const float* gate;
  const float* gain; const float* nmods; u16* Hout; float* part; unsigned* cnt;
  DI void operator()(const pg8::f32x4 (&)[2][2][MB][2], const pg8::Unit&, int, int, int, int) const {}
  DI void fused(pg8::f32x4 (&acc)[2][2][MB][2], const pg8::Unit& u, int wr, int wc, int fr, int fq, PG8_LAS unsigned char* lds, int wid, int lane) const {
    constexpr int ROWS = 64 * MB;
    const int tid = (int)threadIdx.x;
    const int rbase = u.pm * ROWS;
    const int row0 = rbase + wr * 16 * MB + fr, col0 = u.pn * 256 + wc * 32 + 4 * fq;
    PG8_LAS float* red = (PG8_LAS float*)lds;
    PG8_LAS float* rinvs = red + ROWS * 4;
#pragma unroll
    for (int ai = 0; ai < 2; ++ai)
#pragma unroll
      for (int m = 0; m < MB; ++m) {
        const int row = row0 + ai * 32 * MB + m * 16;
        const float* xi = (row < 4096) ? xin_p + (size_t)row * 1024 : xin_s + (size_t)(row - 4096) * 1024;
        const float* gp = gate + cond_of(row) * 6144;
        float ss = 0.f;
#pragma unroll
        for (int bj = 0; bj < 2; ++bj)
#pragma unroll
          for (int n = 0; n < 2; ++n) {
            const int col = col0 + bj * 128 + n * 16;
            const float4 x = *(const float4*)(xi + col);
            const float4 g = *(const float4*)(gp + col);
            pg8::f32x4 v = acc[ai][bj][m][n];
            v[0] = x.x + g.x * v[0]; v[1] = x.y + g.y * v[1]; v[2] = x.z + g.z * v[2]; v[3] = x.w + g.w * v[3];
            *(float4*)(X + (size_t)row * 1024 + col) = make_float4(v[0], v[1], v[2], v[3]);
            acc[ai][bj][m][n] = v;
            ss += v[0] * v[0] + v[1] * v[1] + v[2] * v[2] + v[3] * v[3];
          }
        ss += __shfl_xor(ss, 16); ss += __shfl_xor(ss, 32);
        if (fq == 0) red[(row - rbase) * 4 + wc] = ss;
      }
    __syncthreads();
    if (tid < ROWS) {
      const float sum = (red[tid * 4] + red[tid * 4 + 1]) + (red[tid * 4 + 2] + red[tid * 4 + 3]);
      __hip_atomic_store(part + (size_t)u.pn * T + rbase + tid, sum, __ATOMIC_RELAXED, __HIP_MEMORY_SCOPE_AGENT);
    }
    asm volatile("s_waitcnt vmcnt(0)" ::: "memory");
    __syncthreads();
    if (tid == 0) {
      unsigned* c = cnt + (size_t)u.pm * 16;
      __hip_atomic_fetch_add(c, 1u, __ATOMIC_RELAXED, __HIP_MEMORY_SCOPE_AGENT);
      unsigned sp = 0;
      while (__hip_atomic_load(c, __ATOMIC_RELAXED, __HIP_MEMORY_SCOPE_AGENT) < 4u) { __builtin_amdgcn_s_sleep(1); if (++sp > (1u << 22)) break; }
      __builtin_amdgcn_fence(__ATOMIC_ACQUIRE, "agent");
      asm volatile("s_waitcnt vmcnt(0)" ::: "memory");
    }
    __syncthreads();
    if (tid < ROWS) {
      const float* pp = part + rbase + tid;
      const float tot = (__hip_atomic_load(pp, __ATOMIC_RELAXED, __HIP_MEMORY_SCOPE_AGENT) + __hip_atomic_load(pp + T, __ATOMIC_RELAXED, __HIP_MEMORY_SCOPE_AGENT)) +
                        (__hip_atomic_load(pp + 2 * T, __ATOMIC_RELAXED, __HIP_MEMORY_SCOPE_AGENT) + __hip_atomic_load(pp + 3 * T, __ATOMIC_RELAXED, __HIP_MEMORY_SCOPE_AGENT));
      rinvs[tid] = rsqrtf(tot * (1.0f / 1024.0f) + EPS);
    }
    __syncthreads();
#pragma unroll
    for (int ai = 0; ai < 2; ++ai)
#pragma unroll
      for (int m = 0; m < MB; ++m) {
        const int row = row0 + ai * 32 * MB + m * 16;
        const float rv = rinvs[row - rbase];
        const float* md = nmods + cond_of(row) * 6144;
#pragma unroll
        for (int bj = 0; bj < 2; ++bj)
#pragma unroll
          for (int n = 0; n < 2; ++n) {
            const int col = col0 + bj * 128 + n * 16;
            const float4 g = *(const float4*)(gain + col);
            const float4 sh = *(const float4*)(md + col);
            const float4 sc = *(const float4*)(md + 1024 + col);
            const pg8::f32x4 v = acc[ai][bj][m][n];
            uint2 w;
            w.x = pack2(v[0] * rv * g.x * (1.f + sc.x) + sh.x, v[1] * rv * g.y * (1.f + sc.y) + sh.y);
            w.y = pack2(v[2] * rv * g.z * (1.f + sc.z) + sh.z, v[3] * rv * g.w * (1.f + sc.w) + sh.w);
            *(uint2*)(Hout + (size_t)row * 1024 + col) = w;
          }
      }
    __syncthreads();
  }
};
template <int MB>
DI void big_gemm_resnorm(PG8_LAS unsigned char* lds, const u16* A, const u16* Bt, int M, int N, int K, ResNormEpi<MB> E) {
  pg8::Gemm g{A, Bt, M, N, K};
  pg8::StaticOrder S; S.init(M, N, (int)gridDim.x, (int)blockIdx.x);
  S.nM = M / (64 * MB); S.nwg = S.nM * S.nN;
  pg8::gemm_phase<ResNormEpi<MB>, pg8::StaticOrder, false, MB>(lds, g, S, E, nullptr);
}

struct QkvHeadEpi {
  static constexpr bool PERM = false, AFTER_DRAIN = false, HEADPERM = true;
  unsigned char* ws; float* out;
  const float* cqn; const float* ckn; const float* dqn; const float* dkn;
  DI void operator()(const pg8::f32x4 (&acc)[2][2][4][2], const pg8::Unit& u, int wr, int wc, int fr, int fq) const {
    const int hd = u.pn * 4 + wc;
    const int ax = fq >> 1;
    const int dlo = 32 * ax + 8 * (fq & 1);
    const bool isv = (hd >= 16 && hd < 24) || hd >= 34;
    const bool isq = hd < 8 || (hd >= 24 && hd < 32);
    float g0[8], g1[8], frq[8];
#pragma unroll
    for (int e = 0; e < 8; ++e) { g0[e] = 1.f; g1[e] = 1.f; }
    if (hd < 8) {
#pragma unroll
      for (int e = 0; e < 8; ++e) { g0[e] = cqn[dlo + e]; g1[e] = cqn[dlo + 16 + e]; }
    } else if (hd < 16) {
#pragma unroll
      for (int e = 0; e < 8; ++e) { g0[e] = ckn[dlo + e]; g1[e] = ckn[dlo + 16 + e]; }
    } else if (hd >= 24 && hd < 32) {
#pragma unroll
      for (int e = 0; e < 8; ++e) { g0[e] = dqn[dlo + e]; g1[e] = dqn[dlo + 16 + e]; }
    } else if (hd >= 32 && hd < 34) {
#pragma unroll
      for (int e = 0; e < 8; ++e) { g0[e] = dkn[dlo + e]; g1[e] = dkn[dlo + 16 + e]; }
    }
#pragma unroll
    for (int e = 0; e < 8; ++e) {
      frq[e] = exp2f(-(float)(8 * (fq & 1) + e) * (13.287712379549449f / 16.0f)) * 0.15915494309189535f;
    }
    const int row00 = u.pm * 256 + wr * 64 + fr;
    const bool samp = row00 >= 4096;
#pragma unroll
    for (int ai = 0; ai < 2; ++ai)
#pragma unroll
      for (int m = 0; m < 4; ++m) {
        const int row = row00 + ai * 128 + m * 16;
        int b, nl;
        if (!samp) { b = row >> 8; nl = row & 255; } else { b = (row - 4096) >> 12; nl = (row - 4096) & 4095; }
        float x0[8], x1[8];
#pragma unroll
        for (int e = 0; e < 8; ++e) { x0[e] = acc[ai][0][m][e >> 2][e & 3]; x1[e] = acc[ai][1][m][e >> 2][e & 3]; }
        if (isv) {
          const bool cvh = hd < 24;
          const int feat = cvh ? 512 : 128;
          const int c = (cvh ? (hd - 16) : (hd - 34)) * 64 + dlo;
          u16* q; size_t st;
          if (!samp) {
            q = (u16*)(ws + (cvh ? OFF_CVTP : OFF_DVTP)) + ((size_t)(b * feat + c)) * 256 + nl; st = 256;
            float* o = out + (cvh ? OUT_NCV : OUT_NDV) + (size_t)row * feat + c;
            *(float4*)o = make_float4(x0[0], x0[1], x0[2], x0[3]); *(float4*)(o + 4) = make_float4(x0[4], x0[5], x0[6], x0[7]);
            *(float4*)(o + 16) = make_float4(x1[0], x1[1], x1[2], x1[3]); *(float4*)(o + 20) = make_float4(x1[4], x1[5], x1[6], x1[7]);
          } else { q = (u16*)(ws + (cvh ? OFF_CVTS : OFF_DVTS)) + ((size_t)(b * feat + c)) * 4608 + 512 + nl; st = 4608; }
#pragma unroll
          for (int e = 0; e < 8; ++e) { q[e * st] = f2bf(x0[e]); q[(16 + e) * st] = f2bf(x1[e]); }
        } else {
          float ss = 0.f;
#pragma unroll
          for (int e = 0; e < 8; ++e) ss += x0[e] * x0[e] + x1[e] * x1[e];
          ss += __shfl_xor(ss, 16); ss += __shfl_xor(ss, 32);
          const float rinv = rsqrtf(ss * (1.0f / 64.0f) + EPS);
          float o0[8], o1[8];
          const float pos = samp ? (float)(ax ? (nl & 63) : (nl >> 6)) : 0.f;
#pragma unroll
          for (int e = 0; e < 8; ++e) {
            const float y0 = x0[e] * rinv * g0[e], y1 = x1[e] * rinv * g1[e];
            const float rev = pos * frq[e];
            const float cs = samp ? __builtin_amdgcn_cosf(rev) : 1.f, sn = samp ? __builtin_amdgcn_sinf(rev) : 0.f;
            o0[e] = y0 * cs - y1 * sn;
            o1[e] = y1 * cs + y0 * sn;
          }
          if (isq) {
            const int head = hd < 8 ? hd : hd - 24;
            u16* dst = (u16*)(ws + (hd < 8 ? OFF_CQ : OFF_DQ)) + (samp ? (size_t)16 * 8 * 256 * 64 + ((size_t)(b * 8 + head) * 4096 + nl) * 64 : ((size_t)(b * 8 + head) * 256 + nl) * 64) + dlo;
            *(uint4*)dst = make_uint4(pack2(o0[0] * QSCALE, o0[1] * QSCALE), pack2(o0[2] * QSCALE, o0[3] * QSCALE), pack2(o0[4] * QSCALE, o0[5] * QSCALE), pack2(o0[6] * QSCALE, o0[7] * QSCALE));
            *(uint4*)(dst + 16) = make_uint4(pack2(o1[0] * QSCALE, o1[1] * QSCALE), pack2(o1[2] * QSCALE, o1[3] * QSCALE), pack2(o1[4] * QSCALE, o1[5] * QSCALE), pack2(o1[6] * QSCALE, o1[7] * QSCALE));
          } else {
            const bool ckh = hd < 16;
            const int kh = ckh ? hd - 8 : hd - 32, nkh = ckh ? 8 : 2;
            u16* dst = samp ? (u16*)(ws + (ckh ? OFF_CKS : OFF_DKS)) + ((size_t)(b * nkh + kh) * 4608 + 512 + nl) * 64 + dlo
                            : (u16*)(ws + (ckh ? OFF_CKP : OFF_DKP)) + ((size_t)(b * nkh + kh) * 256 + nl) * 64 + dlo;
            *(uint4*)dst = make_uint4(pack2(o0[0], o0[1]), pack2(o0[2], o0[3]), pack2(o0[4], o0[5]), pack2(o0[6], o0[7]));
            *(uint4*)(dst + 16) = make_uint4(pack2(o1[0], o1[1]), pack2(o1[2], o1[3]), pack2(o1[4], o1[5]), pack2(o1[6], o1[7]));
            if (!samp) {
              float* o = out + (ckh ? OUT_NCK + (size_t)row * 512 : OUT_NDK + (size_t)row * 128) + kh * 64 + dlo;
              *(float4*)o = make_float4(o0[0], o0[1], o0[2], o0[3]); *(float4*)(o + 4) = make_float4(o0[4], o0[5], o0[6], o0[7]);
              *(float4*)(o + 16) = make_float4(o1[0], o1[1], o1[2], o1[3]); *(float4*)(o + 20) = make_float4(o1[4], o1[5], o1[6], o1[7]);
            }
          }
        }
      }
  }
};
DI void big_gemm_qkv(PG8_LAS unsigned char* lds, const u16* A, const u16* Bt, int M, int N, int K, QkvHeadEpi E) {
  pg8::Gemm g{A, Bt, M, N, K};
  pg8::StaticOrder S; S.init(M, N, (int)gridDim.x, (int)blockIdx.x);
  pg8::gemm_phase<QkvHeadEpi, pg8::StaticOrder, false, 4>(lds, g, S, E, nullptr);
}

#define XB_TMO      128
#define XB_XCNT(j)  (256  + 64 * (j))
#define XB_XSUB(j)  (1280 + 64 * (j))
#define XB_XGEN(j)  (2304 + 64 * (j))
#define XB_TOP      3328
#define XB_TOPGEN   3392
#define XCD_BAR_WORDS 3456
#define XB_SPIN_CAP (1u << 18)
#define LAS __attribute__((address_space(3)))
DI unsigned xb_ld(unsigned* p)              { return __hip_atomic_load(p, __ATOMIC_RELAXED, __HIP_MEMORY_SCOPE_AGENT); }
DI unsigned xb_add(unsigned* p, unsigned v) { return __hip_atomic_fetch_add(p, v, __ATOMIC_RELAXED, __HIP_MEMORY_SCOPE_AGENT); }
DI unsigned xb_xcc_id() { return (unsigned)__builtin_amdgcn_s_getreg((3 << 11) | 20) & 0xFu; }
#define XB_SPIN(cond, bar) do { unsigned _sp = 0; while (cond) { __builtin_amdgcn_s_sleep(1); \
    if ((++_sp & 255u) == 0u) { if (xb_ld(&(bar)[XB_TMO])) break; if (_sp > XB_SPIN_CAP) { atomicAdd(&(bar)[XB_TMO], 1u); break; } } } } while (0)
struct XcdBarrier { unsigned* bar; unsigned x; volatile LAS unsigned* st; };
DI XcdBarrier xcd_barrier_post(unsigned* bar, volatile LAS unsigned* st) {
  XcdBarrier b; b.bar = bar; b.x = xb_xcc_id(); b.st = st;
  if (threadIdx.x == 0) (void)xb_add(&bar[XB_XCNT(b.x)], 1u);
  return b;
}
DI void xcd_barrier_complete(unsigned* bar, unsigned x, unsigned& nloc, unsigned& nx) {
  const unsigned G = gridDim.x;
  unsigned sum, cnt, mine, sp = 0u;
  for (;;) {
    sum = 0u; cnt = 0u; mine = 0u;
#pragma unroll
    for (unsigned j = 0; j < 16; ++j) { const unsigned c = xb_ld(&bar[XB_XCNT(j)]); sum += c; cnt += (c > 0u) ? 1u : 0u; mine = (j == x) ? c : mine; }
    if (sum == G) break;
    __builtin_amdgcn_s_sleep(1);
    if ((++sp & 255u) == 0u) { if (xb_ld(&bar[XB_TMO])) break; if (sp > XB_SPIN_CAP) { atomicAdd(&bar[XB_TMO], 1u); break; } }
  }
  nloc = mine > 0u ? mine : 1u; nx = cnt > 0u ? cnt : 1u;
}
DI void xcd_barrier(const XcdBarrier& b) {
  asm volatile("s_waitcnt vmcnt(0)" ::: "memory");
  __syncthreads();
  if (threadIdx.x == 0) {
    unsigned* bar = b.bar;
    __builtin_amdgcn_s_waitcnt(0);
    unsigned nloc = b.st[0], nx = b.st[1];
    if (nloc == 0u) { xcd_barrier_complete(bar, b.x, nloc, nx); b.st[0] = nloc; b.st[1] = nx; }
    const unsigned old = xb_add(&bar[XB_XSUB(b.x)], 1u);
    const unsigned gen = old / nloc;
    if (old + 1u == (gen + 1u) * nloc) {
      __builtin_amdgcn_fence(__ATOMIC_RELEASE, "agent");
      asm volatile("s_waitcnt vmcnt(0)" ::: "memory");
      const unsigned og = xb_add(&bar[XB_TOP], 1u);
      const unsigned tg = og / nx;
      if (og + 1u == (tg + 1u) * nx) xb_add(&bar[XB_TOPGEN], 1u);
      else XB_SPIN(xb_ld(&bar[XB_TOPGEN]) == tg, bar);
      __builtin_amdgcn_fence(__ATOMIC_ACQUIRE, "agent");
      xb_add(&bar[XB_XGEN(b.x)], 1u);
      asm volatile("s_waitcnt vmcnt(0)" ::: "memory");
    } else {
      XB_SPIN(xb_ld(&bar[XB_XGEN(b.x)]) == gen, bar);
      __builtin_amdgcn_fence(__ATOMIC_ACQUIRE, "agent");
      asm volatile("s_waitcnt vmcnt(0)" ::: "memory");
    }
  }
  __syncthreads();
}

__global__ void __launch_bounds__(512) fwd_kernel(Params p, int ph_lo, int ph_hi, int dup) {
  extern __shared__ __attribute__((aligned(16))) unsigned char shm[];
  const int half = threadIdx.x >> 8;
  char* lds = (char*)shm + half * LDS_BYTES;
  PG8_LAS unsigned char* lds8 = (PG8_LAS unsigned char*)shm;
  const int G = 2 * (int)gridDim.x;
  int vb0 = blockIdx.x;
  if ((gridDim.x & 7) == 0) vb0 = (blockIdx.x & 7) * (gridDim.x >> 3) + (blockIdx.x >> 3);
  const int vb = 2 * vb0 + half;
  unsigned char* ws = p.ws;
  const float* mods = (const float*)(ws + OFF_MODS);
  float* X = p.out + OUT_Y;
  u16* H = (u16*)(ws + OFF_H);

#define RUNPH(n) ((ONLYPH < 0 || ONLYPH == (n)) && ph_lo <= (n) && (n) < ph_hi)
#define REP(n) _Pragma("unroll 1") for (int rep_ = 0; rep_ < ((DUPPH == (n)) ? ((dup == (n)) ? 2 : 1) : 1); ++rep_)
#define SEAM(n) if (ph_lo < (n) && (n) < ph_hi) xcd_barrier(xb);
  __shared__ uint4 xb_words;
  if (threadIdx.x == 0) xb_words = make_uint4(0u, 0u, 0u, 0u);
  __syncthreads();
  XcdBarrier xb = xcd_barrier_post((unsigned*)(ws + OFF_BAR), (volatile LAS unsigned*)&xb_words);
  if (ph_hi > 1000) cg::this_grid().sync();
  if (RUNPH(0)) REP(0) {
    for (int id = vb; id < 384; id += G) ada_item(p, id, lds);
    prep_transposes(p, vb, G, lds, 0);
    prep_elementwise(p, vb, G);
  }
  SEAM(1)
  if (RUNPH(1)) REP(1) {
    for (int t = vb; t < 128; t += G) {
      const bool f1 = t < 64;
      const int q = t & 63, m0 = (q >> 3) << 7, n0 = (q & 7) << 7;
      const int koff = f1 ? (m0 >> 8) * 128 : n0;
      gemm_tile((f1 ? (const u16*)(ws + OFF_CBD) : (const u16*)(ws + OFF_WOUT_ET)) + koff, f1 ? 512 : 1024,
                (f1 ? (const u16*)(ws + OFF_WINB) : (const u16*)(ws + OFF_BD)) + koff, f1 ? 512 : 1024, 128, m0, n0,
                EpiBf16{f1 ? (u16*)(ws + OFF_WIN_E) + (size_t)512 * 1024 : (u16*)(ws + OFF_WOUT_E), 1024}, lds);
    }
    normmod_phase(p, vb, G, p.in[0], p.in[1], p.in[8], 0, 0);
    if (vb >= 128) prep_transposes(p, vb - 128, G - 128, lds, 1, 0, 832);
  }
  SEAM(2)
  if (RUNPH(2)) REP(2)
  {
    big_gemm8<3>(lds8, H, (const u16*)(ws + OFF_WIN_E), T, 1536, 1024, FUx8{(u16*)(ws + OFF_UA), (u16*)(ws + OFF_PQT)});
    if (blockIdx.x >= 128) prep_transposes(p, ((int)blockIdx.x - 128) * 2 + half, ((int)gridDim.x - 128) * 2, lds, 1, 832, 1856);
  }
  SEAM(3)
  if (RUNPH(3)) REP(3) sym_phase(p, vb, G);
  SEAM(4)
  if (RUNPH(4)) REP(4) {
    const u16* PQT = (const u16*)(ws + OFF_PQT);
    const u16* PEQO = (const u16*)(ws + OFF_PEQO);
    for (int t = vb0; t < 256 + 128; t += (int)gridDim.x) {
      const bool big = t < 256;
      const int q = t - 256, b = q >> 3;
      dft_pair(big ? (const u16*)(ws + OFF_D4096) : (const u16*)(ws + OFF_D256),
               big ? PEQO + (size_t)16 * 512 * 256 : PEQO + (size_t)b * 512 * 256,
               big ? PQT + (size_t)16 * 512 * 512 + 2048 : PQT + (size_t)b * 512 * 512 + 128,
               big ? 8192 : 512, big ? 2048 : 128, big ? (t & 15) << 7 : 0, big ? (t >> 4) << 6 : (q & 7) << 6,
               (u16*)(ws + OFF_AB), big ? 4096 : b * 256, 512, big ? 0.0013810679320049757f : 0.005524271728019903f, (char*)shm, half);
    }
    pool_phase(p, vb, G);
  }
  float* PART = (float*)(ws + OFF_PART);
  unsigned* CNT = (unsigned*)(ws + OFF_CNT);
  SEAM(5)
  if (RUNPH(5))
    big_gemm_resnorm<3>(lds8, (const u16*)(ws + OFF_AB), (const u16*)(ws + OFF_WOUT_E), T, 1024, 1024,
                        ResNormEpi<3>{p.in[0], p.in[1], X, mods + 2048, p.in[9], mods + 3072, H, PART, CNT});
  SEAM(6)
  if (RUNPH(6)) REP(6) big_gemm8<4>(lds8, H, (const u16*)(ws + OFF_W1), T, 4096, 1024, FRelu2x8{(u16*)(ws + OFF_M1)});
  SEAM(7)
  if (RUNPH(7))
    big_gemm_resnorm<3>(lds8, (const u16*)(ws + OFF_M1), (const u16*)(ws + OFF_W2), T, 1024, 4096,
                        ResNormEpi<3>{X, X + (size_t)4096 * 1024, X, mods + 5120, p.in[8] + 1024, mods + 3 * 6144, H, PART + (size_t)4 * T, CNT + 64 * 16});
  SEAM(8)
  if (RUNPH(8)) {
    big_gemm_qkv(lds8, H, (const u16*)(ws + OFF_WIN_O), T, 2304, 1024,
                 QkvHeadEpi{ws, p.out, p.in[18], p.in[19], p.in[25], p.in[26]});
    if (blockIdx.x >= 176) {
      cache_convert(p, ((int)blockIdx.x - 176) * 2 + half, ((int)gridDim.x - 176) * 2);
      prep_transposes(p, ((int)blockIdx.x - 176) * 2 + half, ((int)gridDim.x - 176) * 2, lds, 1, 1856, 2880);
    }
  }
  SEAM(9)
  if (RUNPH(9)) REP(9) attention_phase(p, vb0, half, (char*)shm);
  SEAM(10)
  if (RUNPH(10))
    big_gemm_resnorm<3>(lds8, H, (const u16*)(ws + OFF_WOUT_O), T, 1024, 1024,
                        ResNormEpi<3>{X, X + (size_t)4096 * 1024, X, mods + 3 * 6144 + 2048, p.in[9] + 1024, mods + 3 * 6144 + 3072, (u16*)(ws + OFF_R2), PART + (size_t)8 * T, CNT + 128 * 16});
  SEAM(11)
  if (RUNPH(11)) REP(11) big_gemm8<4>(lds8, (const u16*)(ws + OFF_R2), (const u16*)(ws + OFF_W1) + (size_t)4096 * 1024, T, 4096, 1024, FRelu2x8{(u16*)(ws + OFF_M1)});
  SEAM(12)
  if (RUNPH(12)) REP(12) big_gemm<3>(lds8, (const u16*)(ws + OFF_M1), (const u16*)(ws + OFF_W2) + (size_t)4096 * 1024, T, 1024, 4096, FRes{X, X + (size_t)4096 * 1024, rep_ ? (float*)(ws + OFF_R2) : X, mods + 3 * 6144 + 5120});
}

extern "C" void kernel_launch(void* const* d_in, const int* in_sizes, int n_in, void* d_out, int out_size, void* d_ws, size_t ws_size,
                              hipStream_t stream) {
  constexpr int kDynLds = 2 * LDS_BYTES;
  static int grid = 0;
  if (!grid) {
    int dev = 0, cus = 0, per_cu = 0;
    (void)hipGetDevice(&dev);
    (void)hipDeviceGetAttribute(&cus, hipDeviceAttributeMultiprocessorCount, dev);
    if (hipFuncSetAttribute((const void*)fwd_kernel, hipFuncAttributeMaxDynamicSharedMemorySize, kDynLds) != hipSuccess) fprintf(stderr, "hipFuncSetAttribute(%d) failed\n", kDynLds);
    (void)hipOccupancyMaxActiveBlocksPerMultiprocessor(&per_cu, fwd_kernel, 512, kDynLds);
    if (per_cu < 1) fprintf(stderr, "occupancy query says %d blocks/CU\n", per_cu);
    grid = cus;
    if (ws_size < WS_END) fprintf(stderr, "workspace too small: %zu < %zu\n", ws_size, (size_t)WS_END);
  }
  Params p{};
  for (int i = 0; i < 31; ++i) p.in[i] = (const float*)d_in[i];
  p.out = (float*)d_out;
  p.ws = (unsigned char*)d_ws;
#if ONE_LAUNCH
  hipMemsetAsync((char*)d_ws + OFF_BAR, 0, XCD_BAR_WORDS * 4 + CNT_BYTES, stream);
  int lo = 0, hi = NPH, dup = DUPPH;
  void* args[] = {&p, &lo, &hi, &dup};
  hipError_t e = hipLaunchCooperativeKernel((void*)fwd_kernel, dim3(grid), dim3(512), args, kDynLds, stream);
  if (e != hipSuccess) fprintf(stderr, "cooperative launch failed: %s (grid %d)\n", hipGetErrorString(e), grid);
#else
  for (int ph = 0; ph < NPH; ++ph) hipLaunchKernelGGL(fwd_kernel, dim3(grid), dim3(512), kDynLds, stream, p, ph, ph + 1, -1);
#endif
}
```

```cpp
#include <hip/hip_runtime.h>
#include <hip/hip_cooperative_groups.h>
#include <cstdio>
namespace cg = cooperative_groups;

#ifndef ONE_LAUNCH
#define ONE_LAUNCH 1
#endif

#ifndef ONLYPH
#define ONLYPH -1
#endif
#ifndef DUPPH
#define DUPPH -1
#endif
typedef unsigned short u16;
typedef short bf16x8 __attribute__((ext_vector_type(8)));
typedef float f32x16 __attribute__((ext_vector_type(16)));
typedef __bf16 bf2_t __attribute__((ext_vector_type(2)));
typedef float f2_t __attribute__((ext_vector_type(2)));
typedef unsigned u32x4 __attribute__((ext_vector_type(4)));

#define DI __device__ __forceinline__
#define TIDX ((int)(threadIdx.x & 255u))

constexpr int T = 12288, TP = 4096, DM = 1024;
constexpr int NPH = 13;
constexpr float EPS = 1e-6f;
constexpr float LOG2E = 1.4426950408889634f;
constexpr float QSCALE = 0.125f * LOG2E;
constexpr float LAM_INIT = 0.35550906759f;

constexpr size_t al(size_t x) { return (x + 255) & ~size_t(255); }
constexpr size_t OFF_MODS   = 0;
constexpr size_t OFF_WIN_E  = OFF_MODS + al(2 * 3 * 6144 * 4);
constexpr size_t OFF_WINB   = OFF_WIN_E + al(1536 * 1024 * 2);
constexpr size_t OFF_CBD    = OFF_WINB + al(1024 * 512 * 2);
constexpr size_t OFF_WOUT_ET= OFF_CBD + al(1024 * 512 * 2);
constexpr size_t OFF_BD     = OFF_WOUT_ET + al(1024 * 1024 * 2);
constexpr size_t OFF_WOUT_E = OFF_BD + al(1024 * 1024 * 2);
constexpr size_t OFF_WIN_O  = OFF_WOUT_E + al(1024 * 1024 * 2);
constexpr size_t OFF_WOUT_O = OFF_WIN_O + al(2304 * 1024 * 2);
constexpr size_t OFF_W1     = OFF_WOUT_O + al(1024 * 1024 * 2);
constexpr size_t OFF_W2     = OFF_W1 + al(2 * 4096 * 1024 * 2);
constexpr size_t OFF_D256   = OFF_W2 + al(2 * 4096 * 1024 * 2);
constexpr size_t OFF_H      = OFF_D256 + al(256 * 512 * 2);
constexpr size_t OFF_R2     = OFF_H + al((size_t)T * 1024 * 2);
constexpr size_t R2_BYTES   = (size_t)T * 512 * 2 + (size_t)T * 1024 * 2 * 2;
constexpr size_t OFF_R1     = OFF_R2 + al(R2_BYTES);
constexpr size_t R1_BYTES   = (size_t)T * 4096 * 2;
constexpr size_t OFF_BAR    = OFF_R1 + R1_BYTES;
constexpr size_t OFF_CNT    = OFF_BAR + 3456 * 4;
constexpr size_t CNT_BYTES  = 3 * 64 * 64;
constexpr size_t OFF_PART   = OFF_CNT + CNT_BYTES;
constexpr size_t WS_END     = OFF_PART + (size_t)3 * 4 * T * 4;
constexpr size_t OFF_UA  = OFF_R2;
constexpr size_t OFF_PQT = OFF_UA + (size_t)T * 512 * 2;
constexpr size_t OFF_AB  = OFF_PQT + (size_t)T * 1024 * 2;
constexpr size_t OFF_CQ   = OFF_R2;
constexpr size_t OFF_DQ   = OFF_CQ + (size_t)T * 512 * 2;
constexpr size_t OFF_CKP  = OFF_DQ + (size_t)T * 512 * 2;
constexpr size_t OFF_CKS  = OFF_CKP + (size_t)16 * 8 * 256 * 64 * 2;
constexpr size_t OFF_CVTP = OFF_CKS + (size_t)2 * 8 * 4608 * 64 * 2;
constexpr size_t OFF_CVTS = OFF_CVTP + (size_t)16 * 4 * 128 * 256 * 2;
constexpr size_t OFF_DKP  = OFF_CVTS + (size_t)2 * 4 * 128 * 4608 * 2;
constexpr size_t OFF_DKS  = OFF_DKP + (size_t)16 * 2 * 256 * 64 * 2;
constexpr size_t OFF_DVTP = OFF_DKS + (size_t)2 * 2 * 4608 * 64 * 2;
constexpr size_t OFF_DVTS = OFF_DVTP + (size_t)16 * 2 * 64 * 256 * 2;
constexpr size_t R2_LATE_END = OFF_DVTS + (size_t)2 * 2 * 64 * 4608 * 2;
static_assert(R2_LATE_END <= OFF_R2 + R2_BYTES, "R2 overflow");
constexpr size_t OFF_D4096 = OFF_R1;
constexpr size_t OFF_PEQO  = OFF_R1 + (size_t)32 * 1024 * 1024;
constexpr size_t OFF_M1    = OFF_R1;
constexpr size_t OFF_QKV   = OFF_R1;
constexpr size_t OFF_OM    = OFF_R1 + al((size_t)T * 2304 * 2);
static_assert(OFF_OM + (size_t)T * 1024 * 2 <= WS_END, "R1 overflow");

constexpr size_t OUT_Y   = 0;
constexpr size_t OUT_NCK = (size_t)T * 1024;
constexpr size_t OUT_NCV = OUT_NCK + (size_t)TP * 512;
constexpr size_t OUT_NDK = OUT_NCV + (size_t)TP * 512;
constexpr size_t OUT_NDV = OUT_NDK + (size_t)TP * 128;

struct Params {
  const float* in[31];
  float* out;
  unsigned char* ws;
};

DI float bf2f(u16 v) { return __uint_as_float(((unsigned)v) << 16); }
DI unsigned pack2(float a, float b) { f2_t f = {a, b}; bf2_t v = __builtin_convertvector(f, bf2_t); return __builtin_bit_cast(unsigned, v); }
DI u16 f2bf(float a) { return (u16)(pack2(a, 0.f) & 0xffffu); }
DI int cond_of(int m) { return m < 4096 ? 0 : (m < 8192 ? 1 : 2); }
DI float wave_sum(float v) {
#pragma unroll
  for (int o = 32; o >= 1; o >>= 1) v += __shfl_xor(v, o);
  return v;
}
#define MFMA(a, b, c) __builtin_amdgcn_mfma_f32_32x32x16_bf16((a), (b), (c), 0, 0, 0)

constexpr int LROW = 144;
constexpr int GEMM_BUF = 2 * 128 * LROW;
constexpr int LDS_BYTES = 2 * GEMM_BUF;

template <int NR>
DI void g_load(u32x4 (&R)[NR], const u16* g, int ld, int k0) {
#pragma unroll
  for (int i = 0; i < NR; ++i) R[i] = *(const u32x4*)(g + (size_t)(32 * i) * ld + k0);
}
template <int NR>
DI void g_store(const u32x4 (&R)[NR], char* sw) {
#pragma unroll
  for (int i = 0; i < NR; ++i) *(u32x4*)(sw + (32 * i) * LROW) = R[i];
}
template <int NB>
DI void g_compute(f32x16 (&acc)[2][NB], const char* fa, const char* fb) {
#pragma unroll
  for (int ks = 0; ks < 4; ++ks) {
    bf16x8 a0 = *(const bf16x8*)(fa + ks * 32);
    bf16x8 a1 = *(const bf16x8*)(fa + 32 * LROW + ks * 32);
#pragma unroll
    for (int j = 0; j < NB; ++j) {
      bf16x8 b = *(const bf16x8*)(fb + j * 32 * LROW + ks * 32);
      acc[0][j] = MFMA(a0, b, acc[0][j]);
      acc[1][j] = MFMA(a1, b, acc[1][j]);
    }
  }
}
template <int NB>
DI void gemm_acc(f32x16 (&acc)[2][NB], const u16* A, int lda, const u16* Bt, int ldb, int K, int m0, int n0, char* lds) {
  const int tid = TIDX, lane = tid & 63, wave = tid >> 6;
  const int r = lane & 31, h = lane >> 5;
  const int wm = wave >> 1, wn = wave & 1;
  const int lrow = tid >> 3, lcol = (tid & 7) * 8;
  const u16* ga = A + (size_t)(m0 + lrow) * lda + lcol;
  const u16* gb = Bt + (size_t)(n0 + lrow) * ldb + lcol;
  u32x4 ra0[4], ra1[4], rb0[2 * NB], rb1[2 * NB];
  const int nk = K >> 6;
  char* sw = lds + lrow * LROW + lcol * 2;
  const char* fa = lds + (wm * 64 + r) * LROW + h * 16;
  const char* fb = lds + 128 * LROW + (wn * 32 * NB + r) * LROW + h * 16;
#define G_LOAD(RA, RB, kt_) do { const int k0_ = ((kt_) < nk ? (kt_) : nk - 1) << 6; g_load<4>(RA, ga, lda, k0_); g_load<2 * NB>(RB, gb, ldb, k0_); } while (0)
#define G_STORE(RA, RB, boff_) do { g_store<4>(RA, sw + (boff_)); g_store<2 * NB>(RB, sw + (boff_) + 128 * LROW); } while (0)
  G_LOAD(ra0, rb0, 0);
  G_LOAD(ra1, rb1, 1);
  G_STORE(ra0, rb0, 0);
  __syncthreads();
  for (int kt = 0; kt < nk; kt += 2) {
    G_LOAD(ra0, rb0, kt + 2);
    g_compute<NB>(acc, fa, fb);
    G_STORE(ra1, rb1, GEMM_BUF);
    __syncthreads();
    G_LOAD(ra1, rb1, kt + 3);
    g_compute<NB>(acc, fa + GEMM_BUF, fb + GEMM_BUF);
    G_STORE(ra0, rb0, 0);
    __syncthreads();
  }
#undef G_LOAD
#undef G_STORE
}

template <class Epi>
DI void gemm_tile(const u16* A, int lda, const u16* Bt, int ldb, int K, int m0, int n0, Epi epi, char* lds) {
  const int lane = TIDX & 63, wave = TIDX >> 6;
  const int r = lane & 31, h = lane >> 5, wm = wave >> 1, wn = wave & 1;
  f32x16 acc[2][2];
#pragma unroll
  for (int i = 0; i < 2; ++i)
#pragma unroll
    for (int j = 0; j < 2; ++j)
#pragma unroll
      for (int e = 0; e < 16; ++e) acc[i][j][e] = 0.f;
  gemm_acc<2>(acc, A, lda, Bt, ldb, K, m0, n0, lds);
#pragma unroll
  for (int i = 0; i < 2; ++i)
#pragma unroll
    for (int j = 0; j < 2; ++j)
#pragma unroll
      for (int q = 0; q < 4; ++q) {
        const int m = m0 + wm * 64 + i * 32 + 8 * q + 4 * h;
        const int n = n0 + wn * 64 + j * 32 + r;
        epi(m, n, acc[i][j][4 * q], acc[i][j][4 * q + 1], acc[i][j][4 * q + 2], acc[i][j][4 * q + 3]);
      }
}

DI void dft_pair(const u16* Dm, const u16* PeQo, const u16* PH, int phstride, int H, int m0, int n0, u16* AB, int rowbase, int colsPerBatch, float norm, char* shm, int half) {
  char* lds = shm + half * LDS_BYTES;
  const int lane = TIDX & 63, wave = TIDX >> 6;
  const int r = lane & 31, h = lane >> 5, wm = wave >> 1, wn = wave & 1;
  f32x16 acc[2][1];
#pragma unroll
  for (int i = 0; i < 2; ++i)
#pragma unroll
    for (int e = 0; e < 16; ++e) acc[i][0][e] = 0.f;
  gemm_acc<1>(acc, Dm + half * H, 2 * H, PeQo + half * H, 2 * H, H, m0, n0, lds);
  float* exo = (float*)lds + wave * 2048 + lane;
  const float* exr = (const float*)(shm + (1 - half) * LDS_BYTES) + wave * 2048 + lane;
#pragma unroll
  for (int i = 0; i < 2; ++i)
#pragma unroll
    for (int e = 0; e < 16; ++e) exo[(i * 16 + e) * 64] = acc[i][0][e];
  __syncthreads();
  const int N = 2 * H;
  const int col = n0 + wn * 32 + r;
  const int b = col / colsPerBatch, c = col - b * colsPerBatch;
  const float ph = bf2f(PH[(size_t)col * phstride]);
  u16* base = AB + ((size_t)rowbase + (size_t)b * N) * 1024 + 512 + c;
#pragma unroll
  for (int i = 0; i < 2; ++i)
#pragma unroll
    for (int q = 0; q < 4; ++q)
#pragma unroll
      for (int e = 0; e < 4; ++e) {
        const int k = m0 + wm * 64 + i * 32 + 8 * q + 4 * h + e;
        const float other = exr[(i * 16 + 4 * q + e) * 64];
        const float sp = (k & 1) ? -ph : ph;
        if (half == 0) base[(size_t)k * 1024] = f2bf((acc[i][0][4 * q + e] + sp - other) * norm);
        else if (k > 0) base[(size_t)(N - k) * 1024] = f2bf((other + sp + acc[i][0][4 * q + e]) * norm);
      }
  __syncthreads();
}

struct EpiBf16 {
  u16* C; int ldc;
  DI void operator()(int m, int n, float v0, float v1, float v2, float v3) const {
    u16* p = C + (size_t)m * ldc + n;
    p[0] = f2bf(v0); p[ldc] = f2bf(v1); p[2 * ldc] = f2bf(v2); p[3 * ldc] = f2bf(v3);
  }
};
struct EpiU {
  u16* UA; u16* PQt;
  DI void operator()(int m, int n, float v0, float v1, float v2, float v3) const {
    if (n < 512) {
      u16* p = UA + (size_t)m * 512 + n;
      p[0] = f2bf(v0); p[512] = f2bf(v1); p[1024] = f2bf(v2); p[1536] = f2bf(v3);
    } else {
      const int np = n - 512, g = np >> 8, pq = (np >> 7) & 1, mm = np & 127;
      size_t off;
      if (m < 4096) { const int b = m >> 8, nl = m & 255; off = ((size_t)(b * 512 + g * 128 + mm)) * 512 + pq * 256 + nl; }
      else { const int ms = m - 4096, b = ms >> 12, nl = ms & 4095; off = (size_t)16 * 512 * 512 + ((size_t)(b * 512 + g * 128 + mm)) * 8192 + pq * 4096 + nl; }
      uint2 w; w.x = pack2(v0, v1); w.y = pack2(v2, v3);
      *(uint2*)(PQt + off) = w;
    }
  }
};
struct EpiDft {
  u16* AB; int rowbase; float norm; int sample;
  DI void operator()(int m, int n, float v0, float v1, float v2, float v3) const {
    size_t row; int c;
    if (sample) { row = (size_t)4096 + (size_t)(n >> 9) * 4096 + m; c = n & 511; }
    else { row = (size_t)rowbase + m; c = n; }
    u16* p = AB + row * 1024 + 512 + c;
    p[0] = f2bf(v0 * norm); p[1024] = f2bf(v1 * norm); p[2048] = f2bf(v2 * norm); p[3072] = f2bf(v3 * norm);
  }
};
struct EpiRes {
  const float* xin_p; const float* xin_s;
  float* X; const float* gate;
  DI void operator()(int m, int n, float v0, float v1, float v2, float v3) const {
    const float* xi = (m < 4096) ? xin_p + (size_t)m * 1024 + n : xin_s + (size_t)(m - 4096) * 1024 + n;
    const float g = gate[cond_of(m) * 6144 + n];
    float* xo = X + (size_t)m * 1024 + n;
    xo[0] = xi[0] + g * v0; xo[1024] = xi[1024] + g * v1; xo[2048] = xi[2048] + g * v2; xo[3072] = xi[3072] + g * v3;
  }
};
struct EpiRelu2 {
  u16* C;
  DI void operator()(int m, int n, float v0, float v1, float v2, float v3) const {
    v0 = fmaxf(v0, 0.f); v1 = fmaxf(v1, 0.f); v2 = fmaxf(v2, 0.f); v3 = fmaxf(v3, 0.f);
    u16* p = C + (size_t)m * 4096 + n;
    p[0] = f2bf(v0 * v0); p[4096] = f2bf(v1 * v1); p[8192] = f2bf(v2 * v2); p[12288] = f2bf(v3 * v3);
  }
};
struct EpiQkv {
  u16* QKV; u16* CVtP; u16* CVtS; u16* DVtP; u16* DVtS; float* ncv; float* ndv;
  DI void operator()(int m, int n, float v0, float v1, float v2, float v3) const {
    const bool is_cv = (n >= 1024 && n < 1536), is_dv = (n >= 2176);
    if (!is_cv && !is_dv) {
      u16* p = QKV + (size_t)m * 2304 + n;
      p[0] = f2bf(v0); p[2304] = f2bf(v1); p[4608] = f2bf(v2); p[6912] = f2bf(v3);
      return;
    }
    uint2 w; w.x = pack2(v0, v1); w.y = pack2(v2, v3);
    if (is_cv) {
      const int c = n - 1024;
      if (m < 4096) {
        const int b = m >> 8, nl = m & 255;
        *(uint2*)(CVtP + ((size_t)(b * 512 + c)) * 256 + nl) = w;
        float* o = ncv + (size_t)m * 512 + c; o[0] = v0; o[512] = v1; o[1024] = v2; o[1536] = v3;
      } else {
        const int ms = m - 4096, b = ms >> 12, nl = ms & 4095;
        *(uint2*)(CVtS + ((size_t)(b * 512 + c)) * 4608 + 512 + nl) = w;
      }
    } else {
      const int c = n - 2176;
      if (m < 4096) {
        const int b = m >> 8, nl = m & 255;
        *(uint2*)(DVtP + ((size_t)(b * 128 + c)) * 256 + nl) = w;
        float* o = ndv + (size_t)m * 128 + c; o[0] = v0; o[128] = v1; o[256] = v2; o[384] = v3;
      } else {
        const int ms = m - 4096, b = ms >> 12, nl = ms & 4095;
        *(uint2*)(DVtS + ((size_t)(b * 128 + c)) * 4608 + 512 + nl) = w;
      }
    }
  }
};

DI void ada_item(const Params& p, int id, char* lds) {
  const int tid = TIDX;
  float* ssil = (float*)lds;
  float* red = (float*)(lds + 12288);
  const int l = id / 192, cb = id % 192;
  for (int i = tid; i < 3072; i += 256) {
    const int j = i >> 10, k = i & 1023;
    const float v = (j == 0) ? p.in[7][k] : p.in[2][(j - 1) * 1024 + k];
    ssil[i] = v / (1.f + __expf(-v));
  }
  __syncthreads();
  const int cq = tid & 7, kg = tid >> 3;
  const float* w = p.in[10] + (size_t)l * 1024 * 6144 + cb * 32 + cq * 4;
  float4 a0 = {0, 0, 0, 0}, a1 = {0, 0, 0, 0}, a2 = {0, 0, 0, 0};
#pragma unroll 8
  for (int kk = 0; kk < 32; ++kk) {
    const int k = kg * 32 + kk;
    const float4 wv = *(const float4*)(w + (size_t)k * 6144);
    const float s0 = ssil[k], s1 = ssil[1024 + k], s2 = ssil[2048 + k];
    a0.x += s0 * wv.x; a0.y += s0 * wv.y; a0.z += s0 * wv.z; a0.w += s0 * wv.w;
    a1.x += s1 * wv.x; a1.y += s1 * wv.y; a1.z += s1 * wv.z; a1.w += s1 * wv.w;
    a2.x += s2 * wv.x; a2.y += s2 * wv.y; a2.z += s2 * wv.z; a2.w += s2 * wv.w;
  }
  float* rp = red + kg * 96 + cq * 4;
  rp[0] = a0.x; rp[1] = a0.y; rp[2] = a0.z; rp[3] = a0.w;
  rp[32] = a1.x; rp[33] = a1.y; rp[34] = a1.z; rp[35] = a1.w;
  rp[64] = a2.x; rp[65] = a2.y; rp[66] = a2.z; rp[67] = a2.w;
  __syncthreads();
  if (tid < 96) {
    const int j = tid >> 5, c = tid & 31;
    float sum = 0.f;
#pragma unroll
    for (int g = 0; g < 32; ++g) sum += red[g * 96 + j * 32 + c];
    const int col = cb * 32 + c;
    ((float*)(p.ws + OFF_MODS))[(size_t)(l * 3 + j) * 6144 + col] = sum + p.in[11][l * 6144 + col];
  }
  __syncthreads();
}

DI void transpose_tile(const float* src, int ld_src, u16* dst, int ld_dst, int r0, int c0, char* lds) {
  float* tile = (float*)lds;
  const int tid = TIDX;
  const int j4 = (tid & 15) * 4, i0 = tid >> 4;
#pragma unroll
  for (int it = 0; it < 4; ++it) {
    const int i = i0 + 16 * it;
    const float4 v = *(const float4*)(src + (size_t)(r0 + i) * ld_src + c0 + j4);
    float* tp = tile + i * 65 + j4;
    tp[0] = v.x; tp[1] = v.y; tp[2] = v.z; tp[3] = v.w;
  }
  __syncthreads();
  const int kc = (tid & 7) * 8, jr = tid >> 3;
#pragma unroll
  for (int it = 0; it < 2; ++it) {
    const int j = jr + 32 * it;
    const float* tp = tile + kc * 65 + j;
    uint4 o;
    o.x = pack2(tp[0], tp[65]); o.y = pack2(tp[130], tp[195]); o.z = pack2(tp[260], tp[325]); o.w = pack2(tp[390], tp[455]);
    *(uint4*)(dst + (size_t)(c0 + j) * ld_dst + r0 + kc) = o;
  }
  __syncthreads();
}

DI void prep_transposes(const Params& p, int vb, int G, char* lds, int layer, int t0 = 0, int t1 = 1 << 30) {
  const int ntile = min(layer ? 2880 : 2432, t1);
  for (int t = t0 + vb; t < ntile; t += G) {
    const float* src; u16* dst; int lds_, ldd, r0, c0;
    int q = t;
    if (layer == 0) {
      if (q < 128) { src = p.in[12]; lds_ = 1024; dst = (u16*)(p.ws + OFF_WIN_E); ldd = 1024; r0 = (q >> 3) * 64; c0 = (q & 7) * 64; }
      else if ((q -= 128) < 256) { src = p.in[16]; lds_ = 1024; dst = (u16*)(p.ws + OFF_WOUT_ET); ldd = 1024; r0 = (q >> 4) * 64; c0 = (q & 15) * 64; }
      else if ((q -= 256) < 1024) { src = p.in[29]; lds_ = 4096; dst = (u16*)(p.ws + OFF_W1); ldd = 1024; r0 = (q >> 6) * 64; c0 = (q & 63) * 64; }
      else { q -= 1024; src = p.in[30]; lds_ = 1024; dst = (u16*)(p.ws + OFF_W2); ldd = 4096; r0 = (q >> 4) * 64; c0 = (q & 15) * 64; }
    } else {
      if (q < 576) { src = p.in[17]; lds_ = 2304; dst = (u16*)(p.ws + OFF_WIN_O); ldd = 1024; r0 = (q / 36) * 64; c0 = (q % 36) * 64; }
      else if ((q -= 576) < 256) { src = p.in[28]; lds_ = 1024; dst = (u16*)(p.ws + OFF_WOUT_O); ldd = 1024; r0 = (q >> 4) * 64; c0 = (q & 15) * 64; }
      else if ((q -= 256) < 1024) { src = p.in[29] + (size_t)1024 * 4096; lds_ = 4096; dst = (u16*)(p.ws + OFF_W1) + (size_t)4096 * 1024; ldd = 1024; r0 = (q >> 6) * 64; c0 = (q & 63) * 64; }
      else { q -= 1024; src = p.in[30] + (size_t)4096 * 1024; lds_ = 1024; dst = (u16*)(p.ws + OFF_W2) + (size_t)1024 * 4096; ldd = 4096; r0 = (q >> 4) * 64; c0 = (q & 15) * 64; }
    }
    transpose_tile(src, lds_, dst, ldd, r0, c0, lds);
  }
}

DI void prep_elementwise(const Params& p, int vb, int G) {
  const size_t gt = (size_t)vb * 256 + TIDX, gs = (size_t)G * 256;
  {
    u16* d = (u16*)(p.ws + OFF_WINB);
    for (size_t i = gt; i < 1024 * 256; i += gs) {
      const int k = (int)(i >> 8), c = (int)(i & 255) * 2;
      const float* s = p.in[12] + (size_t)k * 1024 + 512 + c;
      *(unsigned*)(d + (size_t)k * 512 + c) = pack2(s[0], s[1]);
    }
  }
  {
    u16* d = (u16*)(p.ws + OFF_CBD);
    for (size_t i = gt; i < 1024 * 512; i += gs) {
      const int np = (int)(i >> 9), cp = (int)(i & 511);
      const int g = np >> 8, pq = (np >> 7) & 1, m = np & 127;
      float v = 0.f;
      if ((cp >> 7) == g) {
        const int c = cp & 127; const int rr = (m * c) & 127;
        const float x = (float)rr * (2.0f / 128.0f);
        v = pq ? sinpif(x) : cospif(x);
      }
      d[i] = f2bf(v);
    }
  }
  {
    u16* d = (u16*)(p.ws + OFF_BD);
    for (size_t i = gt; i < 1024 * 1024; i += gs) {
      const int kp = (int)(i >> 10), c = (int)(i & 1023);
      float v = 0.f;
      if (kp < 512) { const int g = kp >> 7; if (c < 512 && (c >> 7) == g) v = p.in[13][(size_t)g * 16384 + (kp & 127) * 128 + (c & 127)] * p.in[14][c]; }
      else { const int g = (kp - 512) >> 7; if (c >= 512 && ((c - 512) >> 7) == g) v = p.in[15][(size_t)g * 16384 + ((kp - 512) & 127) * 128 + ((c - 512) & 127)]; }
      d[i] = f2bf(v);
    }
  }
#pragma unroll 1
  for (int which = 0; which < 2; ++which) {
    const int H = which ? 2048 : 128, N = 2 * H, lg = which ? 9 : 5;
    u16* d = (u16*)(p.ws + (which ? OFF_D4096 : OFF_D256));
    const float invN = 1.0f / (float)N;
    for (size_t i = gt; i < ((size_t)H << lg); i += gs) {
      const int k = (int)(i >> lg), np = (int)(i & ((1 << lg) - 1)) * 8;
      const bool is_sin = np >= H;
      const int n = np & (H - 1);
      unsigned w[4];
#pragma unroll
      for (int e = 0; e < 4; ++e) {
        const float x0 = (float)((k * (n + 2 * e)) & (N - 1)) * invN, x1 = (float)((k * (n + 2 * e + 1)) & (N - 1)) * invN;
        const float v0 = is_sin ? __builtin_amdgcn_sinf(x0) : __builtin_amdgcn_cosf(x0);
        const float v1 = is_sin ? __builtin_amdgcn_sinf(x1) : __builtin_amdgcn_cosf(x1);
        w[e] = pack2(v0, v1);
      }
      *(uint4*)(d + (size_t)k * N + np) = make_uint4(w[0], w[1], w[2], w[3]);
    }
  }
}

DI void sym_phase(const Params& p, int vb, int G) {
  const int lane = TIDX & 63, wave = TIDX >> 6;
  const u16* PQT = (const u16*)(p.ws + OFF_PQT);
  u16* PEQO = (u16*)(p.ws + OFF_PEQO);
  u16* AB = (u16*)(p.ws + OFF_AB);
  for (int it = vb * 4 + wave; it < 1024 + 2048; it += G * 4) {
    const bool samp = it < 1024;
    const int H = samp ? 2048 : 128, N = 2 * H;
    int col, n0base, nstep;
    if (samp) { col = it; n0base = lane * 8; nstep = 512; }
    else { col = (it - 1024) * 4 + (lane >> 4); n0base = (lane & 15) * 8; nstep = 128; }
    const u16* Pp = samp ? PQT + (size_t)16 * 512 * 512 + (size_t)col * 8192 : PQT + (size_t)col * 512;
    const u16* Qp = Pp + N;
    u16* Pe = samp ? PEQO + (size_t)16 * 512 * 256 + (size_t)col * 4096 : PEQO + (size_t)col * 256;
    u16* Qo = Pe + H;
    float alt = 0.f;
    for (int n0 = n0base; n0 < H; n0 += nstep) {
      const uint4 pw = *(const uint4*)(Pp + n0), qw = *(const uint4*)(Qp + n0);
      const unsigned pa[4] = {pw.x, pw.y, pw.z, pw.w}, qa[4] = {qw.x, qw.y, qw.z, qw.w};
      float pe[8], qo[8];
#pragma unroll
      for (int e = 0; e < 8; ++e) {
        const float pv = (e & 1) ? __uint_as_float(pa[e >> 1] & 0xffff0000u) : __uint_as_float(pa[e >> 1] << 16);
        const float qv = (e & 1) ? __uint_as_float(qa[e >> 1] & 0xffff0000u) : __uint_as_float(qa[e >> 1] << 16);
        const int n = n0 + e;
        float pm = 0.f, qm = 0.f;
        if (n > 0) { pm = bf2f(Pp[N - n]); qm = bf2f(Qp[N - n]); }
        pe[e] = pv + pm;
        qo[e] = (n > 0) ? qv - qm : 0.f;
        alt += (e & 1) ? -pe[e] : pe[e];
      }
      *(uint4*)(Pe + n0) = make_uint4(pack2(pe[0], pe[1]), pack2(pe[2], pe[3]), pack2(pe[4], pe[5]), pack2(pe[6], pe[7]));
      *(uint4*)(Qo + n0) = make_uint4(pack2(qo[0], qo[1]), pack2(qo[2], qo[3]), pack2(qo[4], qo[5]), pack2(qo[6], qo[7]));
    }
    alt += __shfl_xor(alt, 1); alt += __shfl_xor(alt, 2); alt += __shfl_xor(alt, 4); alt += __shfl_xor(alt, 8);
    if (samp) { alt += __shfl_xor(alt, 16); alt += __shfl_xor(alt, 32); }
    if ((samp && lane == 0) || (!samp && (lane & 15) == 0)) {
      const float fh = alt + bf2f(Pp[H]);
      size_t row; int c; float norm;
      if (samp) { row = (size_t)4096 + (size_t)(col >> 9) * 4096 + 2048; c = col & 511; norm = 0.0013810679320049757f; }
      else { row = (size_t)(col >> 9) * 256 + 128; c = col & 511; norm = 0.005524271728019903f; }
      AB[row * 1024 + 512 + c] = f2bf(fh * norm);
    }
  }
}

DI void normmod_phase(const Params& p, int vb, int G, const float* xp, const float* xs, const float* gain, int l, int which) {
  const int lane = TIDX & 63, wave = TIDX >> 6;
  u16* H = (u16*)(p.ws + OFF_H);
  const float* mods = (const float*)(p.ws + OFF_MODS) + (size_t)l * 3 * 6144;
  for (int row = vb * 4 + wave; row < T; row += G * 4) {
    const float* x = (row < 4096) ? xp + (size_t)row * 1024 : xs + (size_t)(row - 4096) * 1024;
    float4 v[4];
    float ss = 0.f;
#pragma unroll
    for (int i = 0; i < 4; ++i) {
      v[i] = *(const float4*)(x + i * 256 + lane * 4);
      ss += v[i].x * v[i].x + v[i].y * v[i].y + v[i].z * v[i].z + v[i].w * v[i].w;
    }
    ss = wave_sum(ss);
    const float rinv = rsqrtf(ss * (1.0f / 1024.0f) + EPS);
    const float* md = mods + cond_of(row) * 6144 + which * 3072;
#pragma unroll
    for (int i = 0; i < 4; ++i) {
      const int c = i * 256 + lane * 4;
      const float4 g = *(const float4*)(gain + c);
      const float4 sh = *(const float4*)(md + c);
      const float4 sc = *(const float4*)(md + 1024 + c);
      const float o0 = v[i].x * rinv * g.x * (1.f + sc.x) + sh.x;
      const float o1 = v[i].y * rinv * g.y * (1.f + sc.y) + sh.y;
      const float o2 = v[i].z * rinv * g.z * (1.f + sc.z) + sh.z;
      const float o3 = v[i].w * rinv * g.w * (1.f + sc.w) + sh.w;
      uint2 w; w.x = pack2(o0, o1); w.y = pack2(o2, o3);
      *(uint2*)(H + (size_t)row * 1024 + c) = w;
    }
  }
}

template <class Epi>
DI void gemm_phase(const u16* A, int lda, const u16* Bt, int ldb, int K, int M, int N, Epi epi, int vb, int G, char* lds) {
  const int nN = N >> 7, nt = (M >> 7) * nN, grp = 8 * nN;
  for (int t = vb; t < nt; t += G) {
    const int gi = t / grp, rem = t - gi * grp;
    gemm_tile(A, lda, Bt, ldb, K, (gi * 8 + (rem & 7)) << 7, (rem >> 3) << 7, epi, lds);
  }
}

template <int HW>
DI void pool_item(const u16* UA, u16* AB, int t, int c8) {
  int nl, N;
  if (t < 4096) { nl = t & 255; N = 256; } else { nl = (t - 4096) & 4095; N = 4096; }
  const int base = t - nl;
  u32x4 w[2 * HW];
  int cnt = 0;
#pragma unroll
  for (int j = 0; j < 2 * HW; ++j) {
    const int idx = nl - HW + j;
    const bool ok = idx >= 0 && idx < N;
    w[j] = *(const u32x4*)(UA + (size_t)(base + (ok ? idx : nl)) * 512 + c8);
    if (!ok) w[j] = (u32x4){0u, 0u, 0u, 0u};
    cnt += ok ? 1 : 0;
  }
  const u32x4 cw = *(const u32x4*)(UA + (size_t)t * 512 + c8);
  float s[8] = {0, 0, 0, 0, 0, 0, 0, 0};
#pragma unroll
  for (int j = 0; j < 2 * HW; ++j)
#pragma unroll
    for (int e = 0; e < 4; ++e) { s[2 * e] += __uint_as_float(w[j][e] << 16); s[2 * e + 1] += __uint_as_float(w[j][e] & 0xffff0000u); }
  const float inv = 1.0f / (float)cnt;
  u32x4 o;
#pragma unroll
  for (int e = 0; e < 4; ++e) o[e] = pack2(s[2 * e] * inv - __uint_as_float(cw[e] << 16), s[2 * e + 1] * inv - __uint_as_float(cw[e] & 0xffff0000u));
  *(u32x4*)(AB + (size_t)t * 1024 + c8) = o;
}
DI void pool_phase(const Params& p, int vb, int G) {
  const u16* UA = (const u16*)(p.ws + OFF_UA);
  u16* AB = (u16*)(p.ws + OFF_AB);
  const size_t gt = (size_t)vb * 256 + TIDX, gs = (size_t)G * 256;
  for (size_t i = gt; i < (size_t)T * 64; i += gs) {
    const int cc = (int)(i & 15), tt = (int)(i >> 4) & 3, g = (int)(i >> 6) & 3, tb = (int)(i >> 8);
    const int t = tb * 4 + tt, c8 = g * 128 + cc * 8;
    if (g == 0) pool_item<1>(UA, AB, t, c8);
    else if (g == 1) pool_item<2>(UA, AB, t, c8);
    else if (g == 2) pool_item<4>(UA, AB, t, c8);
    else pool_item<8>(UA, AB, t, c8);
  }
}

DI void qkvpost_phase(const Params& p, int vb, int G) {
  const int lane = TIDX & 63, wave = TIDX >> 6;
  const int q = lane & 15, sub = lane >> 4;
  const u16* QKV = (const u16*)(p.ws + OFF_QKV);
  u16* CQ = (u16*)(p.ws + OFF_CQ); u16* DQ = (u16*)(p.ws + OFF_DQ);
  u16* CKP = (u16*)(p.ws + OFF_CKP); u16* CKS = (u16*)(p.ws + OFF_CKS);
  u16* DKP = (u16*)(p.ws + OFF_DKP); u16* DKS = (u16*)(p.ws + OFF_DKS);
  float* nck = p.out + OUT_NCK; float* ndk = p.out + OUT_NDK;
  const int d0 = q * 4;
  float fr[4];
#pragma unroll
  for (int e = 0; e < 4; ++e) fr[e] = exp2f(-(float)((d0 + e) & 15) * (13.287712379549449f / 16.0f));
  const bool firsthalf = ((d0 >> 4) & 1) == 0;
  for (int t = vb * 4 + wave; t < T; t += G * 4) {
    const bool samp = t >= 4096;
    int b, nl;
    if (!samp) { b = t >> 8; nl = t & 255; } else { b = (t - 4096) >> 12; nl = (t - 4096) & 4095; }
    float cs[4], sn[4];
    if (samp) {
      const float pos = (d0 < 32) ? (float)(nl >> 6) : (float)(nl & 63);
#pragma unroll
      for (int e = 0; e < 4; ++e) { const float a = pos * fr[e]; cs[e] = cosf(a); sn[e] = sinf(a); }
    } else {
#pragma unroll
      for (int e = 0; e < 4; ++e) { cs[e] = 1.f; sn[e] = 0.f; }
    }
    for (int rd = 0; rd < 7; ++rd) {
      const int slot = rd * 4 + sub;
      const bool act = slot < 26;
      const int vi = act ? (slot < 16 ? slot : slot + 8) : 0;
      const uint2 raw = *(const uint2*)(QKV + (size_t)t * 2304 + vi * 64 + d0);
      float x[4] = {__uint_as_float(raw.x << 16), __uint_as_float(raw.x & 0xffff0000u), __uint_as_float(raw.y << 16), __uint_as_float(raw.y & 0xffff0000u)};
      float ss = x[0] * x[0] + x[1] * x[1] + x[2] * x[2] + x[3] * x[3];
      ss += __shfl_xor(ss, 1); ss += __shfl_xor(ss, 2); ss += __shfl_xor(ss, 4); ss += __shfl_xor(ss, 8);
      const float rinv = rsqrtf(ss * (1.0f / 64.0f) + EPS);
      const float* gp = (vi < 8) ? p.in[18] : (vi < 16) ? p.in[19] : (vi < 32) ? p.in[25] : p.in[26];
      const float4 g = *(const float4*)(gp + d0);
      float y[4] = {x[0] * rinv * g.x, x[1] * rinv * g.y, x[2] * rinv * g.z, x[3] * rinv * g.w};
      float o[4];
#pragma unroll
      for (int e = 0; e < 4; ++e) {
        const float part = __shfl_xor(y[e], 4);
        o[e] = firsthalf ? (y[e] * cs[e] - part * sn[e]) : (y[e] * cs[e] + part * sn[e]);
      }
      if (!act) continue;
      const bool isq = (vi < 8) || (vi >= 24 && vi < 32);
      if (isq) {
        const int hd = (vi < 8) ? vi : vi - 24;
        u16* base = (vi < 8) ? CQ : DQ;
        size_t off = samp ? (size_t)16 * 8 * 256 * 64 + ((size_t)(b * 8 + hd) * 4096 + nl) * 64 : ((size_t)(b * 8 + hd) * 256 + nl) * 64;
        uint2 w; w.x = pack2(o[0] * QSCALE, o[1] * QSCALE); w.y = pack2(o[2] * QSCALE, o[3] * QSCALE);
        *(uint2*)(base + off + d0) = w;
      } else if (vi < 16) {
        const int hm = vi - 8;
        uint2 w; w.x = pack2(o[0], o[1]); w.y = pack2(o[2], o[3]);
        if (samp) *(uint2*)(CKS + ((size_t)(b * 8 + hm) * 4608 + 512 + nl) * 64 + d0) = w;
        else {
          *(uint2*)(CKP + ((size_t)(b * 8 + hm) * 256 + nl) * 64 + d0) = w;
          *(float4*)(nck + (size_t)t * 512 + hm * 64 + d0) = make_float4(o[0], o[1], o[2], o[3]);
        }
      } else {
        const int j = vi - 32;
        uint2 w; w.x = pack2(o[0], o[1]); w.y = pack2(o[2], o[3]);
        if (samp) *(uint2*)(DKS + ((size_t)(b * 2 + j) * 4608 + 512 + nl) * 64 + d0) = w;
        else {
          *(uint2*)(DKP + ((size_t)(b * 2 + j) * 256 + nl) * 64 + d0) = w;
          *(float4*)(ndk + (size_t)t * 128 + j * 64 + d0) = make_float4(o[0], o[1], o[2], o[3]);
        }
      }
    }
  }
  const size_t gt = (size_t)vb * 256 + TIDX, gs = (size_t)G * 256;
  {
    u16* CVTS = (u16*)(p.ws + OFF_CVTS); u16* DVTS = (u16*)(p.ws + OFF_DVTS);
    for (size_t i = gt; i < (size_t)2 * 512 * 512; i += gs) {
      const int b = (int)(i >> 18), key = (int)(i >> 9) & 511, c = (int)(i & 511);
      CKS[((size_t)(b * 8 + (c >> 6)) * 4608 + key) * 64 + (c & 63)] = f2bf(p.in[3][i]);
    }
    for (size_t i = gt; i < (size_t)2 * 512 * 512; i += gs) {
      const int b = (int)(i >> 18), c = (int)(i >> 9) & 511, key = (int)(i & 511);
      CVTS[((size_t)(b * 512 + c)) * 4608 + key] = f2bf(p.in[4][((size_t)b * 512 + key) * 512 + c]);
    }
    for (size_t i = gt; i < (size_t)2 * 512 * 128; i += gs) {
      const int b = (int)(i >> 16), key = (int)(i >> 7) & 511, c = (int)(i & 127);
      DKS[((size_t)(b * 2 + (c >> 6)) * 4608 + key) * 64 + (c & 63)] = f2bf(p.in[5][i]);
    }
    for (size_t i = gt; i < (size_t)2 * 128 * 512; i += gs) {
      const int b = (int)(i >> 16), c = (int)(i >> 9) & 127, key = (int)(i & 511);
      DVTS[((size_t)(b * 128 + c)) * 4608 + key] = f2bf(p.in[6][((size_t)b * 512 + key) * 128 + c]);
    }
  }
}

DI void cache_convert(const Params& p, int vb, int G) {
  u16* CKS = (u16*)(p.ws + OFF_CKS); u16* DKS = (u16*)(p.ws + OFF_DKS);
  const size_t gt = (size_t)vb * 256 + TIDX, gs = (size_t)G * 256;
  {
    u16* CVTS = (u16*)(p.ws + OFF_CVTS); u16* DVTS = (u16*)(p.ws + OFF_DVTS);
    for (size_t i = gt; i < (size_t)2 * 512 * 512; i += gs) {
      const int b = (int)(i >> 18), key = (int)(i >> 9) & 511, c = (int)(i & 511);
      CKS[((size_t)(b * 8 + (c >> 6)) * 4608 + key) * 64 + (c & 63)] = f2bf(p.in[3][i]);
    }
    for (size_t i = gt; i < (size_t)2 * 512 * 512; i += gs) {
      const int b = (int)(i >> 18), c = (int)(i >> 9) & 511, key = (int)(i & 511);
      CVTS[((size_t)(b * 512 + c)) * 4608 + key] = f2bf(p.in[4][((size_t)b * 512 + key) * 512 + c]);
    }
    for (size_t i = gt; i < (size_t)2 * 512 * 128; i += gs) {
      const int b = (int)(i >> 16), key = (int)(i >> 7) & 511, c = (int)(i & 127);
      DKS[((size_t)(b * 2 + (c >> 6)) * 4608 + key) * 64 + (c & 63)] = f2bf(p.in[5][i]);
    }
    for (size_t i = gt; i < (size_t)2 * 128 * 512; i += gs) {
      const int b = (int)(i >> 16), c = (int)(i >> 9) & 127, key = (int)(i & 511);
      DVTS[((size_t)(b * 128 + c)) * 4608 + key] = f2bf(p.in[6][((size_t)b * 512 + key) * 128 + c]);
    }
  }
}

template <int DV>
DI void attn_item(const u16* Q, const u16* Kb, const u16* Vt, int ldv, int nt0, int key1, int nt1,
                  bool masked, int qpos0, bool has_sink, float sink2, u16* out, int ldo, char* lds) {
  constexpr int NDB = DV / 32;
  constexpr int KVBUF = (64 + DV) * LROW;
  const int tid = TIDX, lane = tid & 63, wave = tid >> 6;
  const int r = lane & 31, h = lane >> 5;
  const int nt = nt0 + nt1;
  bf16x8 qf[4];
#pragma unroll
  for (int ks = 0; ks < 4; ++ks) qf[ks] = *(const bf16x8*)(Q + (size_t)(wave * 32 + r) * 64 + ks * 16 + h * 8);
  f32x16 O[NDB];
#pragma unroll
  for (int i = 0; i < NDB; ++i)
#pragma unroll
    for (int e = 0; e < 16; ++e) O[i][e] = 0.f;
  float mrun = has_sink ? sink2 : -1e30f;
  float lrun = has_sink ? (h == 0 ? 1.f : 0.f) : 0.f;
  const int lrow = tid >> 3, lpart = (tid & 7) * 8;
  uint4 rk0, rk1, rv0, rv1, rv2, rv3;
  rv2 = rv3 = make_uint4(0, 0, 0, 0);
  const u16* gk = Kb + (size_t)lrow * 64 + lpart;
  const u16* gv = Vt + (size_t)lrow * ldv + lpart;
#define ATT_GLOAD(key0_)                                                         \
  do {                                                                           \
    rk0 = *(const uint4*)(gk + (size_t)(key0_) * 64);                            \
    rk1 = *(const uint4*)(gk + (size_t)((key0_) + 32) * 64);                     \
    rv0 = *(const uint4*)(gv + (key0_));                                         \
    rv1 = *(const uint4*)(gv + (size_t)32 * ldv + (key0_));                      \
    if constexpr (DV == 128) {                                                   \
      rv2 = *(const uint4*)(gv + (size_t)64 * ldv + (key0_));                    \
      rv3 = *(const uint4*)(gv + (size_t)96 * ldv + (key0_));                    \
    }                                                                            \
  } while (0)
#define ATT_SSTORE(boff_)                                                        \
  do {                                                                           \
    *(uint4*)(sw + (boff_)) = rk0;                                               \
    *(uint4*)(sw + (boff_) + 32 * LROW) = rk1;                                   \
    *(uint4*)(sw + (boff_) + 64 * LROW) = rv0;                                   \
    *(uint4*)(sw + (boff_) + 96 * LROW) = rv1;                                   \
    if constexpr (DV == 128) {                                                   \
      *(uint4*)(sw + (boff_) + 128 * LROW) = rv2;                                \
      *(uint4*)(sw + (boff_) + 160 * LROW) = rv3;                                \
    }                                                                            \
  } while (0)
  char* sw = lds + lrow * LROW + lpart * 2;
  {
    const int key0 = (nt0 > 0) ? 0 : key1;
    ATT_GLOAD(key0);
  }
  ATT_SSTORE(0);
  __syncthreads();
  const int pr = (r & 0x13) | ((r & 4) << 1) | ((r & 8) >> 1);
  const char* fk = lds + pr * LROW + h * 16;
  const char* fv = lds + 64 * LROW + r * LROW + h * 16;
  const int qpos = qpos0 + wave * 32 + r;
  for (int t = 0; t < nt; ++t) {
    const int cur = (t & 1) * KVBUF;
    const int key0 = (t < nt0) ? t * 64 : key1 + (t - nt0) * 64;
    {
      const int tn = (t + 1 < nt) ? t + 1 : t;
      const int kn = (tn < nt0) ? tn * 64 : key1 + (tn - nt0) * 64;
      ATT_GLOAD(kn);
    }
    f32x16 S[2];
#pragma unroll
    for (int kb = 0; kb < 2; ++kb) {
#pragma unroll
      for (int e = 0; e < 16; ++e) S[kb][e] = 0.f;
#pragma unroll
      for (int ks = 0; ks < 4; ++ks) {
        const bf16x8 kf = *(const bf16x8*)(fk + cur + kb * 32 * LROW + ks * 32);
        S[kb] = MFMA(kf, qf[ks], S[kb]);
      }
    }
    if (masked && t >= nt0) {
#pragma unroll
      for (int kb = 0; kb < 2; ++kb)
#pragma unroll
        for (int e = 0; e < 16; ++e) {
          const int jpos = key0 - 512 + kb * 32 + 16 * (e >> 3) + 8 * h + (e & 7);
          const int dlt = qpos - jpos;
          if (dlt > 128 || dlt < -128) S[kb][e] = -1e30f;
        }
    }
    float mloc = S[0][0];
#pragma unroll
    for (int kb = 0; kb < 2; ++kb)
#pragma unroll
      for (int e = 0; e < 16; ++e) mloc = fmaxf(mloc, S[kb][e]);
    mloc = fmaxf(mloc, __shfl_xor(mloc, 32));
    if (__builtin_amdgcn_ballot_w64(mloc > mrun + 8.0f) != 0) {
      const float mnew_ = fmaxf(mrun, mloc);
      const float alpha = __builtin_amdgcn_exp2f(mrun - mnew_);
      lrun *= alpha;
#pragma unroll
      for (int i = 0; i < NDB; ++i)
#pragma unroll
        for (int e = 0; e < 16; ++e) O[i][e] *= alpha;
      mrun = mnew_;
    }
    const float mnew = mrun;
    float ps = 0.f;
#pragma unroll
    for (int kb = 0; kb < 2; ++kb)
#pragma unroll
      for (int e = 0; e < 16; ++e) { const float pv = __builtin_amdgcn_exp2f(S[kb][e] - mnew); S[kb][e] = pv; ps += pv; }
    lrun += ps;
    bf16x8 pf[4];
#pragma unroll
    for (int jj = 0; jj < 4; ++jj) {
      const int kb = jj >> 1, o8 = (jj & 1) * 8;
      uint4 w;
      w.x = pack2(S[kb][o8 + 0], S[kb][o8 + 1]); w.y = pack2(S[kb][o8 + 2], S[kb][o8 + 3]);
      w.z = pack2(S[kb][o8 + 4], S[kb][o8 + 5]); w.w = pack2(S[kb][o8 + 6], S[kb][o8 + 7]);
      pf[jj] = __builtin_bit_cast(bf16x8, w);
    }
    __builtin_amdgcn_sched_barrier(0);
#pragma unroll
    for (int i = 0; i < NDB; ++i) {
#pragma unroll
      for (int jj = 0; jj < 4; ++jj) {
        const bf16x8 vf = *(const bf16x8*)(fv + cur + i * 32 * LROW + jj * 32);
        O[i] = MFMA(vf, pf[jj], O[i]);
      }
      if (i & 1) __builtin_amdgcn_sched_barrier(0);
    }
    ATT_SSTORE(KVBUF - cur);
    __syncthreads();
  }
#undef ATT_GLOAD
#undef ATT_SSTORE
  const float ltot = lrun + __shfl_xor(lrun, 32);
  const float inv = 1.0f / ltot;
  u16* op = out + (size_t)(wave * 32 + r) * ldo;
#pragma unroll
  for (int i = 0; i < NDB; ++i)
#pragma unroll
    for (int qd = 0; qd < 4; ++qd) {
      uint2 w;
      w.x = pack2(O[i][4 * qd] * inv, O[i][4 * qd + 1] * inv);
      w.y = pack2(O[i][4 * qd + 2] * inv, O[i][4 * qd + 3] * inv);
      *(uint2*)(op + i * 32 + 8 * qd + 4 * h) = w;
    }
}

DI void ad_tile(f32x16 (&O)[4], f32x16 (&S)[2], f32x16 (&Sn)[2], float& mrun, float& lrun, const bf16x8 (&qf)[4], const char* fk, const char* fv, int cur) {
    {
      constexpr int STG = (64 + 64 + 128) * LROW;
      bf16x8 kf_[8];
#pragma unroll
      for (int kb = 0; kb < 2; ++kb)
#pragma unroll
        for (int ks = 0; ks < 4; ++ks) kf_[kb * 4 + ks] = *(const bf16x8*)(fk + (STG - cur) + kb * 32 * LROW + ks * 32);
#pragma unroll
      for (int kb = 0; kb < 2; ++kb) {
#pragma unroll
        for (int e = 0; e < 16; ++e) Sn[kb][e] = 0.f;
#pragma unroll
        for (int ks = 0; ks < 4; ++ks) Sn[kb] = MFMA(kf_[kb * 4 + ks], qf[ks], Sn[kb]);
      }
    }
    __builtin_amdgcn_sched_group_barrier(0x020, 4, 0);
    __builtin_amdgcn_sched_group_barrier(0x100, 8, 0);
    __builtin_amdgcn_sched_group_barrier(0x008, 8, 0);
    __builtin_amdgcn_sched_barrier(0);
    float mloc = S[0][0];
#pragma unroll
    for (int kb = 0; kb < 2; ++kb)
#pragma unroll
      for (int e = 0; e < 16; ++e) mloc = fmaxf(mloc, S[kb][e]);
    mloc = fmaxf(mloc, __shfl_xor(mloc, 32));
    if (__builtin_amdgcn_ballot_w64(mloc > mrun + 8.0f) != 0) {
      const float mnew_ = fmaxf(mrun, mloc);
      const float alpha = __builtin_amdgcn_exp2f(mrun - mnew_);
      lrun *= alpha;
#pragma unroll
      for (int i = 0; i < 4; ++i)
#pragma unroll
        for (int e = 0; e < 16; ++e) O[i][e] *= alpha;
      mrun = mnew_;
    }
    const float mnew = mrun;
    float ps = 0.f;
#pragma unroll
    for (int kb = 0; kb < 2; ++kb)
#pragma unroll
      for (int e = 0; e < 16; ++e) { const float pv = __builtin_amdgcn_exp2f(S[kb][e] - mnew); S[kb][e] = pv; ps += pv; }
    lrun += ps;
    bf16x8 pf[4];
#pragma unroll
    for (int jj = 0; jj < 4; ++jj) {
      const int kb = jj >> 1, o8 = (jj & 1) * 8;
      uint4 w;
      w.x = pack2(S[kb][o8 + 0], S[kb][o8 + 1]); w.y = pack2(S[kb][o8 + 2], S[kb][o8 + 3]);
      w.z = pack2(S[kb][o8 + 4], S[kb][o8 + 5]); w.w = pack2(S[kb][o8 + 6], S[kb][o8 + 7]);
      pf[jj] = __builtin_bit_cast(bf16x8, w);
    }
    __builtin_amdgcn_sched_barrier(0);
    {
      bf16x8 vfa[4], vfb[4];
#pragma unroll
      for (int jj = 0; jj < 4; ++jj) vfa[jj] = *(const bf16x8*)(fv + cur + jj * 32);
#pragma unroll
      for (int jj = 0; jj < 4; ++jj) vfb[jj] = *(const bf16x8*)(fv + cur + 32 * LROW + jj * 32);
#pragma unroll
      for (int jj = 0; jj < 4; ++jj) O[0] = MFMA(vfa[jj], pf[jj], O[0]);
#pragma unroll
      for (int jj = 0; jj < 4; ++jj) vfa[jj] = *(const bf16x8*)(fv + cur + 64 * LROW + jj * 32);
#pragma unroll
      for (int jj = 0; jj < 4; ++jj) O[1] = MFMA(vfb[jj], pf[jj], O[1]);
#pragma unroll
      for (int jj = 0; jj < 4; ++jj) vfb[jj] = *(const bf16x8*)(fv + cur + 96 * LROW + jj * 32);
#pragma unroll
      for (int jj = 0; jj < 4; ++jj) O[2] = MFMA(vfa[jj], pf[jj], O[2]);
#pragma unroll
      for (int jj = 0; jj < 4; ++jj) O[3] = MFMA(vfb[jj], pf[jj], O[3]);
      __builtin_amdgcn_sched_group_barrier(0x100, 8, 0);
      __builtin_amdgcn_sched_group_barrier(0x008, 4, 0);
      __builtin_amdgcn_sched_group_barrier(0x100, 4, 0);
      __builtin_amdgcn_sched_group_barrier(0x008, 4, 0);
      __builtin_amdgcn_sched_group_barrier(0x100, 4, 0);
      __builtin_amdgcn_sched_group_barrier(0x008, 8, 0);
    }
    __builtin_amdgcn_sched_barrier(0);
}

DI void attn_diff_pair(const u16* Q, const u16* Kb, const u16* Vt, int ldv, int nt, float lam, const float* subln_g, u16* out, char* shm, int half) {
  constexpr int STG = (64 + 64 + 128) * LROW;
  const int tid = TIDX, t512 = (int)threadIdx.x, lane = tid & 63, wave = tid >> 6;
  const int r = lane & 31, h = lane >> 5;
  bf16x8 qf[4];
#pragma unroll
  for (int ks = 0; ks < 4; ++ks) qf[ks] = *(const bf16x8*)(Q + (size_t)(wave * 32 + r) * 64 + ks * 16 + h * 8);
  f32x16 O[4];
#pragma unroll
  for (int i = 0; i < 4; ++i)
#pragma unroll
    for (int e = 0; e < 16; ++e) O[i][e] = 0.f;
  float mrun = -1e30f, lrun = 0.f;
  const int lrow = tid >> 3, lpart = (tid & 7) * 8;
  const int vrow = t512 >> 3, vpart = (t512 & 7) * 8;
  const u16* gk = Kb + (size_t)lrow * 64 + lpart;
  const u16* gv = Vt + (size_t)vrow * ldv + vpart;
  char* sk = shm + half * 64 * LROW + lrow * LROW + lpart * 2;
  char* sv = shm + 128 * LROW + vrow * LROW + vpart * 2;
  u32x4 rk0, rk1, rv0, rv1;
#define AD_GLOAD(key0_) do { rk0 = *(const u32x4*)(gk + (size_t)(key0_) * 64); rk1 = *(const u32x4*)(gk + (size_t)((key0_) + 32) * 64); \
                             rv0 = *(const u32x4*)(gv + (key0_)); rv1 = *(const u32x4*)(gv + (size_t)64 * ldv + (key0_)); } while (0)
#define AD_SSTORE(boff_) do { *(u32x4*)(sk + (boff_)) = rk0; *(u32x4*)(sk + (boff_) + 32 * LROW) = rk1; \
                              *(u32x4*)(sv + (boff_)) = rv0; *(u32x4*)(sv + (boff_) + 64 * LROW) = rv1; } while (0)
#define AD_GLOAD_K(R0_, R1_, key0_) do { R0_ = *(const u32x4*)(gk + (size_t)(key0_) * 64); R1_ = *(const u32x4*)(gk + (size_t)((key0_) + 32) * 64); } while (0)
#define AD_GLOAD_V(R0_, R1_, key0_) do { R0_ = *(const u32x4*)(gv + (key0_)); R1_ = *(const u32x4*)(gv + (size_t)64 * ldv + (key0_)); } while (0)
#define AD_SSTORE_K(R0_, R1_, boff_) do { *(u32x4*)(sk + (boff_)) = R0_; *(u32x4*)(sk + (boff_) + 32 * LROW) = R1_; } while (0)
#define AD_SSTORE_V(R0_, R1_, boff_) do { *(u32x4*)(sv + (boff_)) = R0_; *(u32x4*)(sv + (boff_) + 64 * LROW) = R1_; } while (0)
#define AD_QK(S_, koff_) do { bf16x8 kf_[8]; \
    _Pragma("unroll") for (int kb = 0; kb < 2; ++kb) _Pragma("unroll") for (int ks = 0; ks < 4; ++ks) kf_[kb * 4 + ks] = *(const bf16x8*)(fk + (koff_) + kb * 32 * LROW + ks * 32); \
    _Pragma("unroll") for (int kb = 0; kb < 2; ++kb) { _Pragma("unroll") for (int e = 0; e < 16; ++e) S_[kb][e] = 0.f; \
    _Pragma("unroll") for (int ks = 0; ks < 4; ++ks) S_[kb] = MFMA(kf_[kb * 4 + ks], qf[ks], S_[kb]); } } while (0)
  const int pr = (r & 0x13) | ((r & 4) << 1) | ((r & 8) >> 1);
  const char* fk = shm + half * 64 * LROW + pr * LROW + h * 16;
  const char* fv = shm + 128 * LROW + r * LROW + h * 16;
  u32x4 ak0, ak1, av0, av1, bk0, bk1, bv0, bv1;
  AD_GLOAD_K(ak0, ak1, 0); AD_GLOAD_V(av0, av1, 0);
  AD_SSTORE_K(ak0, ak1, 0); AD_SSTORE_V(av0, av1, 0);
  AD_GLOAD_K(ak0, ak1, 64);
  AD_SSTORE_K(ak0, ak1, STG);
  AD_GLOAD_K(bk0, bk1, 128); AD_GLOAD_V(bv0, bv1, 64);
  __syncthreads();
  f32x16 S[2], Sn[2];
  AD_QK(S, 0);
  __syncthreads();
#define AD_STEP(t_, LK0, LK1, LV0, LV1, SK0, SK1, SV0, SV1) do { \
    const int t = (t_); const int cur = (t & 1) * STG; \
    { const int tk = (t + 3 < nt) ? t + 3 : nt - 1, tv = (t + 2 < nt) ? t + 2 : nt - 1; AD_GLOAD_K(LK0, LK1, tk * 64); AD_GLOAD_V(LV0, LV1, tv * 64); } \
    ad_tile(O, S, Sn, mrun, lrun, qf, fk, fv, cur); \
    AD_SSTORE_K(SK0, SK1, cur); AD_SSTORE_V(SV0, SV1, STG - cur); \
    __syncthreads(); \
    S[0] = Sn[0]; S[1] = Sn[1]; } while (0)
  for (int tt = 0; tt < nt; tt += 2) {
    AD_STEP(tt, ak0, ak1, av0, av1, bk0, bk1, bv0, bv1);
    AD_STEP(tt + 1, bk0, bk1, bv0, bv1, ak0, ak1, av0, av1);
  }
#undef AD_STEP
#undef AD_GLOAD_K
#undef AD_GLOAD_V
#undef AD_SSTORE_K
#undef AD_SSTORE_V
#undef AD_QK
#undef AD_GLOAD
#undef AD_SSTORE
  const float inv = 1.0f / (lrun + __shfl_xor(lrun, 32));
  float* ex = (float*)shm + (size_t)wave * 4096 + lane;
  if (half == 1) {
#pragma unroll
    for (int i = 0; i < 4; ++i)
#pragma unroll
      for (int e = 0; e < 16; ++e) ex[(i * 16 + e) * 64] = O[i][e] * inv;
  }
  __syncthreads();
  if (half == 0) {
    float ss = 0.f;
#pragma unroll
    for (int i = 0; i < 4; ++i)
#pragma unroll
      for (int e = 0; e < 16; ++e) { const float d = O[i][e] * inv - lam * ex[(i * 16 + e) * 64]; O[i][e] = d; ss += d * d; }
    ss += __shfl_xor(ss, 32);
    const float rinv = rsqrtf(ss * (1.0f / 128.0f) + EPS) * (1.0f - LAM_INIT);
    u16* op = out + (size_t)(wave * 32 + r) * 1024;
#pragma unroll
    for (int i = 0; i < 4; ++i)
#pragma unroll
      for (int qd = 0; qd < 4; ++qd) {
        const int e0 = i * 32 + 8 * qd + 4 * h;
        const float4 g = *(const float4*)(subln_g + e0);
        uint2 w;
        w.x = pack2(O[i][4 * qd] * rinv * g.x, O[i][4 * qd + 1] * rinv * g.y);
        w.y = pack2(O[i][4 * qd + 2] * rinv * g.z, O[i][4 * qd + 3] * rinv * g.w);
        *(uint2*)(op + e0) = w;
      }
  }
  __syncthreads();
}

DI void attention_phase(const Params& p, int vb0, int half, char* shm) {
  const u16* CQ = (const u16*)(p.ws + OFF_CQ); const u16* DQ = (const u16*)(p.ws + OFF_DQ);
  const u16* CKP = (const u16*)(p.ws + OFF_CKP); const u16* CKS = (const u16*)(p.ws + OFF_CKS);
  const u16* CVTP = (const u16*)(p.ws + OFF_CVTP); const u16* CVTS = (const u16*)(p.ws + OFF_CVTS);
  const u16* DKP = (const u16*)(p.ws + OFF_DKP); const u16* DKS = (const u16*)(p.ws + OFF_DKS);
  const u16* DVTP = (const u16*)(p.ws + OFF_DVTP); const u16* DVTS = (const u16*)(p.ws + OFF_DVTS);
  u16* AC = (u16*)(p.ws + OFF_H);
  constexpr size_t QS = (size_t)16 * 8 * 256 * 64;
  const int lane = TIDX & 63;
  const float la = wave_sum(p.in[20][lane] * p.in[21][lane]);
  const float lb = wave_sum(p.in[22][lane] * p.in[23][lane]);
  const float lam = expf(la) - expf(lb) + LAM_INIT;
  const int nblk = (int)gridDim.x;
  for (int it = vb0; it < 768; it += nblk) {
    const bool diff = (it < 256) || (it >= 512 && it < 640);
    const bool samp = it < 512;
    if (diff) {
      int qb, hh, b;
      if (samp) { qb = it & 31; hh = (it >> 5) & 3; b = it >> 7; }
      else { const int i2 = it - 512; qb = i2 & 1; hh = (i2 >> 1) & 3; b = i2 >> 3; }
      const int nseq = samp ? 4096 : 256, nkeys = samp ? 4608 : 256;
      const int tok = samp ? 4096 + b * 4096 + qb * 128 : b * 256 + qb * 128;
      const int hm = hh * 2 + half;
      const size_t qoff = (samp ? QS : 0) + ((size_t)(b * 8 + hm) * nseq + qb * 128) * 64;
      const u16* Kp = (samp ? CKS : CKP) + (size_t)(b * 8 + hm) * nkeys * 64;
      const u16* Vp = (samp ? CVTS : CVTP) + (size_t)(b * 4 + hh) * 128 * nkeys;
      attn_diff_pair(CQ + qoff, Kp, Vp, nkeys, nkeys >> 6, lam, p.in[24], AC + (size_t)tok * 1024 + hh * 128, shm, half);
    } else {
      int qb, hd, b;
      if (samp) { const int i2 = (it - 256) * 2 + half; qb = i2 & 31; hd = (i2 >> 5) & 7; b = i2 >> 8; }
      else { const int i2 = (it - 640) * 2 + half; qb = i2 & 1; hd = (i2 >> 1) & 7; b = i2 >> 4; }
      const int nseq = samp ? 4096 : 256, nkeys = samp ? 4608 : 256;
      const int tok = samp ? 4096 + b * 4096 + qb * 128 : b * 256 + qb * 128;
      const size_t qoff = (samp ? QS : 0) + ((size_t)(b * 8 + hd) * nseq + qb * 128) * 64;
      const u16* Kp = (samp ? DKS : DKP) + (size_t)(b * 2 + (hd >> 2)) * nkeys * 64;
      const u16* Vp = (samp ? DVTS : DVTP) + (size_t)(b * 2 + (hd >> 2)) * 64 * nkeys;
      int nt0 = 4, key1 = 0, nt1 = 0;
      if (samp) { const int lo = min(max(qb * 128 - 128, 0), 4096 - 384); nt0 = 8; key1 = 512 + lo; nt1 = 6; }
      attn_item<64>(DQ + qoff, Kp, Vp, nkeys, nt0, key1, nt1, samp, qb * 128, true, p.in[27][hd] * LOG2E, AC + (size_t)tok * 1024 + 512 + hd * 64, 1024, shm + half * LDS_BYTES);
    }
  }
}

namespace pg8 {
#define PG8_LAS __attribute__((address_space(3)))
typedef unsigned short bf16_t;
typedef short bf16x8 __attribute__((ext_vector_type(8)));
typedef float f32x4 __attribute__((ext_vector_type(4)));
typedef unsigned u32x4 __attribute__((ext_vector_type(4)));
constexpr int BM = 256, BK = 64, HALF = 128, HTB = HALF * BK * 2  , STAGE_BYTES = 8 * HTB, NXCD = 8, WGM = 8;

__host__ __device__ __forceinline__ int lds_byte(int r, int c) { const int st = (r >> 4) * 2 + (c >> 5), rr = r & 15, cc = c & 31, ob = rr * 64 + cc * 2; return st * 1024 + (ob ^ (((ob >> 9) & 1) << 5)); }
__host__ __device__ __forceinline__ void stage_rc(int b, int& R, int& C) { const int st = b / 1024, sb = b % 1024, swz = sb ^ (((sb >> 9) & 1) << 5); R = (st >> 1) * 16 + swz / 64; C = (st & 1) * 32 + (swz % 64) / 2; }
__host__ __device__ __forceinline__ int perm32(int rho) { const int n = rho >> 4, i = rho & 15; return 8 * (i >> 2) + 4 * n + (i & 3); }

struct Unit { int pm, pn; };
struct Gemm { const bf16_t* A; const bf16_t* Bt; int M, N, K; };

struct StaticOrder {
    int nM, nN, nwg, G, c;
    __host__ __device__ void init(int M, int N, int G_, int c_) { nM = M / BM; nN = N / BM; nwg = nM * nN; G = G_; c = c_; }
    __host__ __device__ bool next(int i, Unit& u) const {
        const long L = (long)i * G + c; if (L >= nwg) return false;
        int wgid = (int)L; { const int q = nwg / NXCD, r = nwg % NXCD, xcd = wgid % NXCD, off = wgid / NXCD; wgid = (xcd < r ? xcd * (q + 1) : r * (q + 1) + (xcd - r) * q) + off; }
        const int nig = WGM * nN, gid = wgid / nig, fm = gid * WGM, gsz = (nM - fm) < WGM ? (nM - fm) : WGM;
        u.pm = fm + ((wgid % nig) % gsz); u.pn = (wgid % nig) / gsz; return true;
    }
    __device__ __forceinline__ void a_ready(const Unit&) const {}
    __device__ __forceinline__ void done(const Unit&) const {}
};
template <class Epi, class Sched, bool STAMP = false, int MB = 4>
__device__ __forceinline__ void gemm_phase(PG8_LAS unsigned char* lds, const Gemm g, const Sched& S, const Epi& E, unsigned long long* stamps) {
    const int tid = threadIdx.x, wid = __builtin_amdgcn_readfirstlane(tid >> 6), lane = tid & 63, wr = wid >> 2, wc = wid & 3, fr = lane & 15, fq = lane >> 4;
    const int K = g.K, nt = K / BK;
    int ts_lo = 0, ts_hi = 0, nts = 0; const unsigned long long rt_entry = STAMP ? (unsigned long long)wall_clock64() : 0ull;
#define PG8_STAMP() do { if (STAMP && wid == 0 && nts < 64) { const unsigned long long _c = (unsigned long long)clock64(); \
        ts_lo = (lane == nts) ? (int)(unsigned)_c : ts_lo; ts_hi = (lane == nts) ? (int)(unsigned)(_c >> 32) : ts_hi; ++nts; } } while (0)
    PG8_STAMP();
    unsigned voffA[2], voffB[2], voffB1[2];
#pragma unroll
    for (int i = 0; i < 2; ++i) { int R, C; stage_rc(tid * 16 + i * 8192, R, C); const int Rb = Epi::PERM ? ((R & ~31) + perm32(R & 31)) : R;
        voffA[i] = (unsigned)(R * K + C) * 2u; voffB[i] = (unsigned)(Rb * K + C) * 2u; voffB1[i] = voffB[i];
        if constexpr (Epi::HEADPERM) {
            const int rho = R & 31, np = rho >> 4, ii = rho & 15, fqq = ii >> 2, jj = ii & 3;
            const int d0 = 64 * (R >> 5) + 32 * (fqq >> 1) + 8 * (fqq & 1) + 4 * np + jj;
            voffB[i] = (unsigned)(d0 * K + C) * 2u; voffB1[i] = (unsigned)((d0 + 16) * K + C) * 2u; } }
    const size_t hB1 = Epi::HEADPERM ? (size_t)0 : (size_t)HALF * K * 2;
    const size_t kstep = (size_t)(BK * 2);
    const size_t hstep = (size_t)HALF * K * 2; const size_t hstepA = (size_t)(32 * MB) * K * 2;
    const size_t tstep = 2 * hstep; const size_t tstepA = 2 * hstepA;
    const unsigned ldsw = (unsigned)wid * 1024u;
    const int aoff = lds_byte(wr * 16 * MB + fr, fq * 8), boff = lds_byte(wc * 32 + fr, fq * 8);
#define PG8_SA(b, h) (((b) * 2 + (h)) * HTB)
#define PG8_SB(b, h) ((4 + (b) * 2 + (h)) * HTB)
#define PG8_STAGE(bufoff, gbase, voff) do { _Pragma("unroll") for (int _i = 0; _i < 2; ++_i) \
        __builtin_amdgcn_global_load_lds((const unsigned*)((const char*)(gbase) + (voff)[_i]), (PG8_LAS unsigned*)(lds + (bufoff) + ldsw + _i * 8192), 16, 0, 0); } while (0)
#define PG8_LDA(dst, b, h) do { _Pragma("unroll") for (int m = 0; m < MB; ++m) _Pragma("unroll") for (int k = 0; k < 2; ++k) dst[m][k] = *(const PG8_LAS bf16x8*)(lds + PG8_SA(b, h) + aoff + m * 2048 + k * 1024); } while (0)
#define PG8_LDB(dst, b, h) do { _Pragma("unroll") for (int n = 0; n < 2; ++n) _Pragma("unroll") for (int k = 0; k < 2; ++k) dst[n][k] = *(const PG8_LAS bf16x8*)(lds + PG8_SB(b, h) + boff + n * 2048 + k * 1024); } while (0)
#define PG8_MMA(ai, bj, At, Bt) do { __builtin_amdgcn_s_setprio(1); _Pragma("unroll") for (int m = 0; m < MB; ++m) _Pragma("unroll") for (int n = 0; n < 2; ++n) _Pragma("unroll") for (int k = 0; k < 2; ++k) \
        acc[ai][bj][m][n] = __builtin_amdgcn_mfma_f32_16x16x32_bf16(Bt[n][k], At[m][k], acc[ai][bj][m][n], 0, 0, 0); __builtin_amdgcn_s_setprio(0); } while (0)
#define PG8_WAIT_V(n) asm volatile("s_waitcnt vmcnt(" #n ")" ::: "memory")
#define PG8_WAIT_L(n) asm volatile("s_waitcnt lgkmcnt(" #n ")" ::: "memory")
#define PG8_BAR __builtin_amdgcn_s_barrier()
#define PG8_SCHED __builtin_amdgcn_sched_barrier(0)
    Unit cur, nxt; int ui = 0;
    if (!S.next(0, cur)) return;
    f32x4 acc[2][2][MB][2];
#pragma unroll
    for (int a = 0; a < 2; ++a)
#pragma unroll
        for (int b = 0; b < 2; ++b)
#pragma unroll
            for (int m = 0; m < MB; ++m)
#pragma unroll
                for (int n = 0; n < 2; ++n) acc[a][b][m][n] = (f32x4){0.f, 0.f, 0.f, 0.f};
    bf16x8 At[MB][2], B0[2][2], B1[2][2];
    const char* cA = (const char*)g.A + (size_t)cur.pm * tstepA; const char* cB = (const char*)g.Bt + (size_t)cur.pn * tstep;
    S.a_ready(cur);
    PG8_STAGE(PG8_SB(0, 0), cB, voffB); PG8_STAGE(PG8_SA(0, 0), cA, voffA); PG8_STAGE(PG8_SB(0, 1), cB + hB1, voffB1); PG8_STAGE(PG8_SA(0, 1), cA + hstepA, voffA);
    if (wr == 1) PG8_BAR;
    PG8_WAIT_V(4); PG8_BAR;
    PG8_STAGE(PG8_SB(1, 0), cB + kstep, voffB); PG8_STAGE(PG8_SA(1, 0), cA + kstep, voffA); PG8_STAGE(PG8_SB(1, 1), cB + hB1 + kstep, voffB1);
    PG8_WAIT_V(6); PG8_BAR;
    PG8_STAMP();
    for (;;) {
        const bool has_next = S.next(ui + 1, nxt);
        const char* nA = has_next ? (const char*)g.A + (size_t)nxt.pm * tstepA : cA; const char* nB = has_next ? (const char*)g.Bt + (size_t)nxt.pn * tstep : cB;
        for (int t = 0; t < nt; t += 2) {
            const bool last = (t == nt - 2);
            const char* a1 = cA + (size_t)(t + 1) * kstep;
            const char* a2 = last ? nA : cA + (size_t)(t + 2) * kstep; const char* b2 = last ? nB : cB + (size_t)(t + 2) * kstep;
            const char* a3 = a2 + kstep; const char* b3 = b2 + kstep;
            if (last && has_next) S.a_ready(nxt);
            PG8_LDB(B0, 0, 0); PG8_SCHED; PG8_LDA(At, 0, 0); PG8_STAGE(PG8_SA(1, 1), a1 + hstepA, voffA);
            PG8_WAIT_L(8); PG8_BAR; PG8_WAIT_L(0); PG8_MMA(0, 0, At, B0); PG8_BAR; PG8_SCHED;
            PG8_LDB(B1, 0, 1); PG8_STAGE(PG8_SB(0, 0), b2, voffB);
            PG8_BAR; PG8_WAIT_L(0); PG8_MMA(0, 1, At, B1); PG8_BAR;
            PG8_LDA(At, 0, 1); PG8_STAGE(PG8_SA(0, 0), a2, voffA);
            PG8_BAR; PG8_WAIT_L(0); PG8_MMA(1, 0, At, B0); PG8_BAR; PG8_SCHED;
            PG8_STAGE(PG8_SB(0, 1), b2 + hB1, voffB1);
            PG8_WAIT_V(6); PG8_BAR; PG8_MMA(1, 1, At, B1); PG8_BAR;
            PG8_LDB(B0, 1, 0); PG8_SCHED; PG8_LDA(At, 1, 0); PG8_STAGE(PG8_SA(0, 1), a2 + hstepA, voffA);
            PG8_WAIT_L(8); PG8_BAR; PG8_WAIT_L(0); PG8_MMA(0, 0, At, B0); PG8_BAR; PG8_SCHED;
            PG8_LDB(B1, 1, 1); PG8_STAGE(PG8_SB(1, 0), b3, voffB);
            PG8_BAR; PG8_WAIT_L(0); PG8_MMA(0, 1, At, B1); PG8_BAR;
            PG8_LDA(At, 1, 1); PG8_STAGE(PG8_SA(1, 0), a3, voffA);
            PG8_BAR; PG8_WAIT_L(0); PG8_MMA(1, 0, At, B0); PG8_BAR; PG8_SCHED;
            PG8_STAGE(PG8_SB(1, 1), b3 + hB1, voffB1);
            PG8_WAIT_V(6); PG8_BAR; PG8_MMA(1, 1, At, B1); PG8_BAR;
        }
        PG8_STAMP();
        if constexpr (!Epi::AFTER_DRAIN) { E(acc, cur, wr, wc, fr, fq); S.done(cur); }
        PG8_STAMP();
        if (!has_next) break;
#pragma unroll
        for (int a = 0; a < 2; ++a)
#pragma unroll
            for (int b = 0; b < 2; ++b)
#pragma unroll
                for (int m = 0; m < MB; ++m)
#pragma unroll
                    for (int n = 0; n < 2; ++n) acc[a][b][m][n] = (f32x4){0.f, 0.f, 0.f, 0.f};
        cur = nxt; cA = nA; cB = nB; ++ui;
    }
    PG8_WAIT_V(0);
    if (wr == 0) PG8_BAR;
    PG8_BAR;
    if constexpr (Epi::AFTER_DRAIN) { E.fused(acc, cur, wr, wc, fr, fq, lds, wid, lane); S.done(cur); }
    PG8_STAMP();
    if (STAMP && wid == 0) { stamps[lane] = lane < nts ? (((unsigned long long)(unsigned)ts_hi << 32) | (unsigned)ts_lo) : 0ull;
        if (lane == 62) stamps[62] = rt_entry; if (lane == 63) stamps[63] = (unsigned long long)wall_clock64(); }
#undef PG8_STAMP
#undef PG8_SA
#undef PG8_SB
#undef PG8_STAGE
#undef PG8_LDA
#undef PG8_LDB
#undef PG8_MMA
#undef PG8_WAIT_V
#undef PG8_WAIT_L
#undef PG8_BAR
#undef PG8_SCHED
}
}

typedef float f32x4 __attribute__((ext_vector_type(4)));
template <class F, int MB> struct RowEpi {
  static constexpr bool PERM = false, AFTER_DRAIN = false, HEADPERM = false;
  F f;
  DI void operator()(const pg8::f32x4 (&acc)[2][2][MB][2], const pg8::Unit& u, int wr, int wc, int fr, int fq) const {
    const int row0 = u.pm * (64 * MB) + wr * 16 * MB + fr, col0 = u.pn * 256 + wc * 32 + 4 * fq;
#pragma unroll
    for (int ai = 0; ai < 2; ++ai)
#pragma unroll
      for (int m = 0; m < MB; ++m)
#pragma unroll
        for (int bj = 0; bj < 2; ++bj)
#pragma unroll
          for (int n = 0; n < 2; ++n) f(row0 + ai * 32 * MB + m * 16, col0 + bj * 128 + n * 16, acc[ai][bj][m][n]);
  }
};
struct FU {
  u16* UA; u16* PQt;
  DI void operator()(int m, int n, pg8::f32x4 v) const {
    if (n < 512) {
      uint2 w; w.x = pack2(v[0], v[1]); w.y = pack2(v[2], v[3]);
      *(uint2*)(UA + (size_t)m * 512 + n) = w;
    } else {
      const int np = n - 512, g = np >> 8, pq = (np >> 7) & 1, mm = np & 127;
      u16* q; size_t st;
      if (m < 4096) { const int b = m >> 8, nl = m & 255; q = PQt + ((size_t)(b * 512 + g * 128 + mm)) * 512 + pq * 256 + nl; st = 512; }
      else { const int ms = m - 4096, b = ms >> 12, nl = ms & 4095; q = PQt + (size_t)16 * 512 * 512 + ((size_t)(b * 512 + g * 128 + mm)) * 8192 + pq * 4096 + nl; st = 8192; }
      q[0] = f2bf(v[0]); q[st] = f2bf(v[1]); q[2 * st] = f2bf(v[2]); q[3 * st] = f2bf(v[3]);
    }
  }
};
struct FRes {
  const float* xin_p; const float* xin_s; float* X; const float* gate;
  DI void operator()(int m, int n, pg8::f32x4 v) const {
    const float* xi = (m < 4096) ? xin_p + (size_t)m * 1024 + n : xin_s + (size_t)(m - 4096) * 1024 + n;
    const float4 x = *(const float4*)xi;
    const float4 g = *(const float4*)(gate + cond_of(m) * 6144 + n);
    *(float4*)(X + (size_t)m * 1024 + n) = make_float4(x.x + g.x * v[0], x.y + g.y * v[1], x.z + g.z * v[2], x.w + g.w * v[3]);
  }
};
struct FRelu2 {
  u16* C;
  DI void operator()(int m, int n, pg8::f32x4 v) const {
    const float a = fmaxf(v[0], 0.f), b = fmaxf(v[1], 0.f), c = fmaxf(v[2], 0.f), d = fmaxf(v[3], 0.f);
    uint2 w; w.x = pack2(a * a, b * b); w.y = pack2(c * c, d * d);
    *(uint2*)(C + (size_t)m * 4096 + n) = w;
  }
};
struct FQkv {
  u16* QKV; u16* CVtP; u16* CVtS; u16* DVtP; u16* DVtS; float* ncv; float* ndv;
  DI void operator()(int m, int n, pg8::f32x4 v) const {
    const bool is_cv = (n >= 1024 && n < 1536), is_dv = (n >= 2176);
    if (!is_cv && !is_dv) {
      uint2 w; w.x = pack2(v[0], v[1]); w.y = pack2(v[2], v[3]);
      *(uint2*)(QKV + (size_t)m * 2304 + n) = w;
      return;
    }
    const int c = is_cv ? n - 1024 : n - 2176;
    const int feat = is_cv ? 512 : 128;
    u16* q; size_t st;
    if (m < 4096) {
      const int b = m >> 8, nl = m & 255;
      q = (is_cv ? CVtP : DVtP) + ((size_t)(b * feat + c)) * 256 + nl; st = 256;
      *(float4*)((is_cv ? ncv : ndv) + (size_t)m * feat + c) = make_float4(v[0], v[1], v[2], v[3]);
    } else {
      const int ms = m - 4096, b = ms >> 12, nl = ms & 4095;
      q = (is_cv ? CVtS : DVtS) + ((size_t)(b * feat + c)) * 4608 + 512 + nl; st = 4608;
    }
    q[0] = f2bf(v[0]); q[st] = f2bf(v[1]); q[2 * st] = f2bf(v[2]); q[3 * st] = f2bf(v[3]);
  }
};
template <int MB, class F>
DI void big_gemm(PG8_LAS unsigned char* lds, const u16* A, const u16* Bt, int M, int N, int K, F f) {
  pg8::Gemm g{A, Bt, M, N, K};
  pg8::StaticOrder S; S.init(M, N, (int)gridDim.x, (int)blockIdx.x);
  S.nM = M / (64 * MB); S.nwg = S.nM * S.nN;
  RowEpi<F, MB> E{f};
  pg8::gemm_phase<RowEpi<F, MB>, pg8::StaticOrder, false, MB>(lds, g, S, E, nullptr);
}

template <class F, int MB> struct RowEpi8 {
  static constexpr bool PERM = true, AFTER_DRAIN = false, HEADPERM = false;
  F f;
  DI void operator()(const pg8::f32x4 (&acc)[2][2][MB][2], const pg8::Unit& u, int wr, int wc, int fr, int fq) const {
    const int row0 = u.pm * (64 * MB) + wr * 16 * MB + fr, col0 = u.pn * 256 + wc * 32 + 8 * fq;
#pragma unroll
    for (int ai = 0; ai < 2; ++ai)
#pragma unroll
      for (int m = 0; m < MB; ++m)
#pragma unroll
        for (int bj = 0; bj < 2; ++bj) f(row0 + ai * 32 * MB + m * 16, col0 + bj * 128, acc[ai][bj][m][0], acc[ai][bj][m][1]);
  }
};
struct FRelu2x8 {
  u16* C;
  DI void operator()(int m, int n, pg8::f32x4 a, pg8::f32x4 b) const {
    uint4 w;
    float x0 = fmaxf(a[0], 0.f), x1 = fmaxf(a[1], 0.f), x2 = fmaxf(a[2], 0.f), x3 = fmaxf(a[3], 0.f);
    float y0 = fmaxf(b[0], 0.f), y1 = fmaxf(b[1], 0.f), y2 = fmaxf(b[2], 0.f), y3 = fmaxf(b[3], 0.f);
    w.x = pack2(x0 * x0, x1 * x1); w.y = pack2(x2 * x2, x3 * x3); w.z = pack2(y0 * y0, y1 * y1); w.w = pack2(y2 * y2, y3 * y3);
    *(uint4*)(C + (size_t)m * 4096 + n) = w;
  }
};
struct FUx8 {
  u16* UA; u16* PQt;
  DI void operator()(int m, int n, pg8::f32x4 a, pg8::f32x4 b) const {
    if (n < 512) {
      uint4 w; w.x = pack2(a[0], a[1]); w.y = pack2(a[2], a[3]); w.z = pack2(b[0], b[1]); w.w = pack2(b[2], b[3]);
      *(uint4*)(UA + (size_t)m * 512 + n) = w;
    } else {
      const int np = n - 512, g = np >> 8, pq = (np >> 7) & 1, mm = np & 127;
      u16* q; size_t st;
      if (m < 4096) { const int bb = m >> 8, nl = m & 255; q = PQt + ((size_t)(bb * 512 + g * 128 + mm)) * 512 + pq * 256 + nl; st = 512; }
      else { const int ms = m - 4096, bb = ms >> 12, nl = ms & 4095; q = PQt + (size_t)16 * 512 * 512 + ((size_t)(bb * 512 + g * 128 + mm)) * 8192 + pq * 4096 + nl; st = 8192; }
      q[0] = f2bf(a[0]); q[st] = f2bf(a[1]); q[2 * st] = f2bf(a[2]); q[3 * st] = f2bf(a[3]);
      q[4 * st] = f2bf(b[0]); q[5 * st] = f2bf(b[1]); q[6 * st] = f2bf(b[2]); q[7 * st] = f2bf(b[3]);
    }
  }
};
struct FQkvx8 {
  u16* QKV; u16* CVtP; u16* CVtS; u16* DVtP; u16* DVtS; float* ncv; float* ndv;
  DI void operator()(int m, int n, pg8::f32x4 a, pg8::f32x4 b) const {
    const bool is_cv = (n >= 1024 && n < 1536), is_dv = (n >= 2176);
    if (!is_cv && !is_dv) {
      uint4 w; w.x = pack2(a[0], a[1]); w.y = pack2(a[2], a[3]); w.z = pack2(b[0], b[1]); w.w = pack2(b[2], b[3]);
      *(uint4*)(QKV + (size_t)m * 2304 + n) = w;
      return;
    }
    const int c = is_cv ? n - 1024 : n - 2176;
    const int feat = is_cv ? 512 : 128;
    u16* q; size_t st;
    if (m < 4096) {
      const int bb = m >> 8, nl = m & 255;
      q = (is_cv ? CVtP : DVtP) + ((size_t)(bb * feat + c)) * 256 + nl; st = 256;
      float* o = (is_cv ? ncv : ndv) + (size_t)m * feat + c;
      *(float4*)o = make_float4(a[0], a[1], a[2], a[3]);
      *(float4*)(o + 4) = make_float4(b[0], b[1], b[2], b[3]);
    } else {
      const int ms = m - 4096, bb = ms >> 12, nl = ms & 4095;
      q = (is_cv ? CVtS : DVtS) + ((size_t)(bb * feat + c)) * 4608 + 512 + nl; st = 4608;
    }
    q[0] = f2bf(a[0]); q[st] = f2bf(a[1]); q[2 * st] = f2bf(a[2]); q[3 * st] = f2bf(a[3]);
    q[4 * st] = f2bf(b[0]); q[5 * st] = f2bf(b[1]); q[6 * st] = f2bf(b[2]); q[7 * st] = f2bf(b[3]);
  }
};
template <int MB, class F>
DI void big_gemm8(PG8_LAS unsigned char* lds, const u16* A, const u16* Bt, int M, int N, int K, F f) {
  pg8::Gemm g{A, Bt, M, N, K};
  pg8::StaticOrder S; S.init(M, N, (int)gridDim.x, (int)blockIdx.x);
  S.nM = M / (64 * MB); S.nwg = S.nM * S.nN;
  RowEpi8<F, MB> E{f};
  pg8::gemm_phase<RowEpi8<F, MB>, pg8::StaticOrder, false, MB>(lds, g, S, E, nullptr);
}

template <int MB> struct ResNormEpi {
  static constexpr bool PERM = false, AFTER_DRAIN = true, HEADPERM = false;
  const float* xin_p; const float* xin_s; float* X; const float* gate;
  const float* gain; const float* nmods; u16* Hout; float* part; unsigned* cnt;
  DI void operator()(const pg8::f32x4 (&)[2][2][MB][2], const pg8::Unit&, int, int, int, int) const {}
  DI void fused(pg8::f32x4 (&acc)[2][2][MB][2], const pg8::Unit& u, int wr, int wc, int fr, int fq, PG8_LAS unsigned char* lds, int wid, int lane) const {
    constexpr int ROWS = 64 * MB;
    const int tid = (int)threadIdx.x;
    const int rbase = u.pm * ROWS;
    const int row0 = rbase + wr * 16 * MB + fr, col0 = u.pn * 256 + wc * 32 + 4 * fq;
    PG8_LAS float* red = (PG8_LAS float*)lds;
    PG8_LAS float* rinvs = red + ROWS * 4;
#pragma unroll
    for (int ai = 0; ai < 2; ++ai)
#pragma unroll
      for (int m = 0; m < MB; ++m) {
        const int row = row0 + ai * 32 * MB + m * 16;
        const float* xi = (row < 4096) ? xin_p + (size_t)row * 1024 : xin_s + (size_t)(row - 4096) * 1024;
        const float* gp = gate + cond_of(row) * 6144;
        float ss = 0.f;
#pragma unroll
        for (int bj = 0; bj < 2; ++bj)
#pragma unroll
          for (int n = 0; n < 2; ++n) {
            const int col = col0 + bj * 128 + n * 16;
            const float4 x = *(const float4*)(xi + col);
            const float4 g = *(const float4*)(gp + col);
            pg8::f32x4 v = acc[ai][bj][m][n];
            v[0] = x.x + g.x * v[0]; v[1] = x.y + g.y * v[1]; v[2] = x.z + g.z * v[2]; v[3] = x.w + g.w * v[3];
            *(float4*)(X + (size_t)row * 1024 + col) = make_float4(v[0], v[1], v[2], v[3]);
            acc[ai][bj][m][n] = v;
            ss += v[0] * v[0] + v[1] * v[1] + v[2] * v[2] + v[3] * v[3];
          }
        ss += __shfl_xor(ss, 16); ss += __shfl_xor(ss, 32);
        if (fq == 0) red[(row - rbase) * 4 + wc] = ss;
      }
    __syncthreads();
    if (tid < ROWS) {
      const float sum = (red[tid * 4] + red[tid * 4 + 1]) + (red[tid * 4 + 2] + red[tid * 4 + 3]);
      __hip_atomic_store(part + (size_t)u.pn * T + rbase + tid, sum, __ATOMIC_RELAXED, __HIP_MEMORY_SCOPE_AGENT);
    }
    asm volatile("s_waitcnt vmcnt(0)" ::: "memory");
    __syncthreads();
    if (tid == 0) {
      unsigned* c = cnt + (size_t)u.pm * 16;
      __hip_atomic_fetch_add(c, 1u, __ATOMIC_RELAXED, __HIP_MEMORY_SCOPE_AGENT);
      unsigned sp = 0;
      while (__hip_atomic_load(c, __ATOMIC_RELAXED, __HIP_MEMORY_SCOPE_AGENT) < 4u) { __builtin_amdgcn_s_sleep(1); if (++sp > (1u << 22)) break; }
      __builtin_amdgcn_fence(__ATOMIC_ACQUIRE, "agent");
      asm volatile("s_waitcnt vmcnt(0)" ::: "memory");
    }
    __syncthreads();
    if (tid < ROWS) {
      const float* pp = part + rbase + tid;
      const float tot = (__hip_atomic_load(pp, __ATOMIC_RELAXED, __HIP_MEMORY_SCOPE_AGENT) + __hip_atomic_load(pp + T, __ATOMIC_RELAXED, __HIP_MEMORY_SCOPE_AGENT)) +
                        (__hip_atomic_load(pp + 2 * T, __ATOMIC_RELAXED, __HIP_MEMORY_SCOPE_AGENT) + __hip_atomic_load(pp + 3 * T, __ATOMIC_RELAXED, __HIP_MEMORY_SCOPE_AGENT));
      rinvs[tid] = rsqrtf(tot * (1.0f / 1024.0f) + EPS);
    }
    __syncthreads();
#pragma unroll
    for (int ai = 0; ai < 2; ++ai)
#pragma unroll
      for (int m = 0; m < MB; ++m) {
        const int row = row0 + ai * 32 * MB + m * 16;
        const float rv = rinvs[row - rbase];
        const float* md = nmods + cond_of(row) * 6144;
#pragma unroll
        for (int bj = 0; bj < 2; ++bj)
#pragma unroll
          for (int n = 0; n < 2; ++n) {
            const int col = col0 + bj * 128 + n * 16;
            const float4 g = *(const float4*)(gain + col);
            const float4 sh = *(const float4*)(md + col);
            const float4 sc = *(const float4*)(md + 1024 + col);
            const pg8::f32x4 v = acc[ai][bj][m][n];
            uint2 w;
            w.x = pack2(v[0] * rv * g.x * (1.f + sc.x) + sh.x, v[1] * rv * g.y * (1.f + sc.y) + sh.y);
            w.y = pack2(v[2] * rv * g.z * (1.f + sc.z) + sh.z, v[3] * rv * g.w * (1.f + sc.w) + sh.w);
            *(uint2*)(Hout + (size_t)row * 1024 + col) = w;
          }
      }
    __syncthreads();
  }
};
template <int MB>
DI void big_gemm_resnorm(PG8_LAS unsigned char* lds, const u16* A, const u16* Bt, int M, int N, int K, ResNormEpi<MB> E) {
  pg8::Gemm g{A, Bt, M, N, K};
  pg8::StaticOrder S; S.init(M, N, (int)gridDim.x, (int)blockIdx.x);
  S.nM = M / (64 * MB); S.nwg = S.nM * S.nN;
  pg8::gemm_phase<ResNormEpi<MB>, pg8::StaticOrder, false, MB>(lds, g, S, E, nullptr);
}

struct QkvHeadEpi {
  static constexpr bool PERM = false, AFTER_DRAIN = false, HEADPERM = true;
  unsigned char* ws; float* out;
  const float* cqn; const float* ckn; const float* dqn; const float* dkn;
  DI void operator()(const pg8::f32x4 (&acc)[2][2][4][2], const pg8::Unit& u, int wr, int wc, int fr, int fq) const {
    const int hd = u.pn * 4 + wc;
    const int ax = fq >> 1;
    const int dlo = 32 * ax + 8 * (fq & 1);
    const bool isv = (hd >= 16 && hd < 24) || hd >= 34;
    const bool isq = hd < 8 || (hd >= 24 && hd < 32);
    float g0[8], g1[8], frq[8];
#pragma unroll
    for (int e = 0; e < 8; ++e) { g0[e] = 1.f; g1[e] = 1.f; }
    if (hd < 8) {
#pragma unroll
      for (int e = 0; e < 8; ++e) { g0[e] = cqn[dlo + e]; g1[e] = cqn[dlo + 16 + e]; }
    } else if (hd < 16) {
#pragma unroll
      for (int e = 0; e < 8; ++e) { g0[e] = ckn[dlo + e]; g1[e] = ckn[dlo + 16 + e]; }
    } else if (hd >= 24 && hd < 32) {
#pragma unroll
      for (int e = 0; e < 8; ++e) { g0[e] = dqn[dlo + e]; g1[e] = dqn[dlo + 16 + e]; }
    } else if (hd >= 32 && hd < 34) {
#pragma unroll
      for (int e = 0; e < 8; ++e) { g0[e] = dkn[dlo + e]; g1[e] = dkn[dlo + 16 + e]; }
    }
#pragma unroll
    for (int e = 0; e < 8; ++e) {
      frq[e] = exp2f(-(float)(8 * (fq & 1) + e) * (13.287712379549449f / 16.0f)) * 0.15915494309189535f;
    }
    const int row00 = u.pm * 256 + wr * 64 + fr;
    const bool samp = row00 >= 4096;
#pragma unroll
    for (int ai = 0; ai < 2; ++ai)
#pragma unroll
      for (int m = 0; m < 4; ++m) {
        const int row = row00 + ai * 128 + m * 16;
        int b, nl;
        if (!samp) { b = row >> 8; nl = row & 255; } else { b = (row - 4096) >> 12; nl = (row - 4096) & 4095; }
        float x0[8], x1[8];
#pragma unroll
        for (int e = 0; e < 8; ++e) { x0[e] = acc[ai][0][m][e >> 2][e & 3]; x1[e] = acc[ai][1][m][e >> 2][e & 3]; }
        if (isv) {
          const bool cvh = hd < 24;
          const int feat = cvh ? 512 : 128;
          const int c = (cvh ? (hd - 16) : (hd - 34)) * 64 + dlo;
          u16* q; size_t st;
          if (!samp) {
            q = (u16*)(ws + (cvh ? OFF_CVTP : OFF_DVTP)) + ((size_t)(b * feat + c)) * 256 + nl; st = 256;
            float* o = out + (cvh ? OUT_NCV : OUT_NDV) + (size_t)row * feat + c;
            *(float4*)o = make_float4(x0[0], x0[1], x0[2], x0[3]); *(float4*)(o + 4) = make_float4(x0[4], x0[5], x0[6], x0[7]);
            *(float4*)(o + 16) = make_float4(x1[0], x1[1], x1[2], x1[3]); *(float4*)(o + 20) = make_float4(x1[4], x1[5], x1[6], x1[7]);
          } else { q = (u16*)(ws + (cvh ? OFF_CVTS : OFF_DVTS)) + ((size_t)(b * feat + c)) * 4608 + 512 + nl; st = 4608; }
#pragma unroll
          for (int e = 0; e < 8; ++e) { q[e * st] = f2bf(x0[e]); q[(16 + e) * st] = f2bf(x1[e]); }
        } else {
          float ss = 0.f;
#pragma unroll
          for (int e = 0; e < 8; ++e) ss += x0[e] * x0[e] + x1[e] * x1[e];
          ss += __shfl_xor(ss, 16); ss += __shfl_xor(ss, 32);
          const float rinv = rsqrtf(ss * (1.0f / 64.0f) + EPS);
          float o0[8], o1[8];
          const float pos = samp ? (float)(ax ? (nl & 63) : (nl >> 6)) : 0.f;
#pragma unroll
          for (int e = 0; e < 8; ++e) {
            const float y0 = x0[e] * rinv * g0[e], y1 = x1[e] * rinv * g1[e];
            const float rev = pos * frq[e];
            const float cs = samp ? __builtin_amdgcn_cosf(rev) : 1.f, sn = samp ? __builtin_amdgcn_sinf(rev) : 0.f;
            o0[e] = y0 * cs - y1 * sn;
            o1[e] = y1 * cs + y0 * sn;
          }
          if (isq) {
            const int head = hd < 8 ? hd : hd - 24;
            u16* dst = (u16*)(ws + (hd < 8 ? OFF_CQ : OFF_DQ)) + (samp ? (size_t)16 * 8 * 256 * 64 + ((size_t)(b * 8 + head) * 4096 + nl) * 64 : ((size_t)(b * 8 + head) * 256 + nl) * 64) + dlo;
            *(uint4*)dst = make_uint4(pack2(o0[0] * QSCALE, o0[1] * QSCALE), pack2(o0[2] * QSCALE, o0[3] * QSCALE), pack2(o0[4] * QSCALE, o0[5] * QSCALE), pack2(o0[6] * QSCALE, o0[7] * QSCALE));
            *(uint4*)(dst + 16) = make_uint4(pack2(o1[0] * QSCALE, o1[1] * QSCALE), pack2(o1[2] * QSCALE, o1[3] * QSCALE), pack2(o1[4] * QSCALE, o1[5] * QSCALE), pack2(o1[6] * QSCALE, o1[7] * QSCALE));
          } else {
            const bool ckh = hd < 16;
            const int kh = ckh ? hd - 8 : hd - 32, nkh = ckh ? 8 : 2;
            u16* dst = samp ? (u16*)(ws + (ckh ? OFF_CKS : OFF_DKS)) + ((size_t)(b * nkh + kh) * 4608 + 512 + nl) * 64 + dlo
                            : (u16*)(ws + (ckh ? OFF_CKP : OFF_DKP)) + ((size_t)(b * nkh + kh) * 256 + nl) * 64 + dlo;
            *(uint4*)dst = make_uint4(pack2(o0[0], o0[1]), pack2(o0[2], o0[3]), pack2(o0[4], o0[5]), pack2(o0[6], o0[7]));
            *(uint4*)(dst + 16) = make_uint4(pack2(o1[0], o1[1]), pack2(o1[2], o1[3]), pack2(o1[4], o1[5]), pack2(o1[6], o1[7]));
            if (!samp) {
              float* o = out + (ckh ? OUT_NCK + (size_t)row * 512 : OUT_NDK + (size_t)row * 128) + kh * 64 + dlo;
              *(float4*)o = make_float4(o0[0], o0[1], o0[2], o0[3]); *(float4*)(o + 4) = make_float4(o0[4], o0[5], o0[6], o0[7]);
              *(float4*)(o + 16) = make_float4(o1[0], o1[1], o1[2], o1[3]); *(float4*)(o + 20) = make_float4(o1[4], o1[5], o1[6], o1[7]);
            }
          }
        }
      }
  }
};
DI void big_gemm_qkv(PG8_LAS unsigned char* lds, const u16* A, const u16* Bt, int M, int N, int K, QkvHeadEpi E) {
  pg8::Gemm g{A, Bt, M, N, K};
  pg8::StaticOrder S; S.init(M, N, (int)gridDim.x, (int)blockIdx.x);
  pg8::gemm_phase<QkvHeadEpi, pg8::StaticOrder, false, 4>(lds, g, S, E, nullptr);
}

#define XB_TMO      128
#define XB_XCNT(j)  (256  + 64 * (j))
#define XB_XSUB(j)  (1280 + 64 * (j))
#define XB_XGEN(j)  (2304 + 64 * (j))
#define XB_TOP      3328
#define XB_TOPGEN   3392
#define XCD_BAR_WORDS 3456
#define XB_SPIN_CAP (1u << 18)
#define LAS __attribute__((address_space(3)))
DI unsigned xb_ld(unsigned* p)              { return __hip_atomic_load(p, __ATOMIC_RELAXED, __HIP_MEMORY_SCOPE_AGENT); }
DI unsigned xb_add(unsigned* p, unsigned v) { return __hip_atomic_fetch_add(p, v, __ATOMIC_RELAXED, __HIP_MEMORY_SCOPE_AGENT); }
DI unsigned xb_xcc_id() { return (unsigned)__builtin_amdgcn_s_getreg((3 << 11) | 20) & 0xFu; }
#define XB_SPIN(cond, bar) do { unsigned _sp = 0; while (cond) { __builtin_amdgcn_s_sleep(1); \
    if ((++_sp & 255u) == 0u) { if (xb_ld(&(bar)[XB_TMO])) break; if (_sp > XB_SPIN_CAP) { atomicAdd(&(bar)[XB_TMO], 1u); break; } } } } while (0)
struct XcdBarrier { unsigned* bar; unsigned x; volatile LAS unsigned* st; };
DI XcdBarrier xcd_barrier_post(unsigned* bar, volatile LAS unsigned* st) {
  XcdBarrier b; b.bar = bar; b.x = xb_xcc_id(); b.st = st;
  if (threadIdx.x == 0) (void)xb_add(&bar[XB_XCNT(b.x)], 1u);
  return b;
}
DI void xcd_barrier_complete(unsigned* bar, unsigned x, unsigned& nloc, unsigned& nx) {
  const unsigned G = gridDim.x;
  unsigned sum, cnt, mine, sp = 0u;
  for (;;) {
    sum = 0u; cnt = 0u; mine = 0u;
#pragma unroll
    for (unsigned j = 0; j < 16; ++j) { const unsigned c = xb_ld(&bar[XB_XCNT(j)]); sum += c; cnt += (c > 0u) ? 1u : 0u; mine = (j == x) ? c : mine; }
    if (sum == G) break;
    __builtin_amdgcn_s_sleep(1);
    if ((++sp & 255u) == 0u) { if (xb_ld(&bar[XB_TMO])) break; if (sp > XB_SPIN_CAP) { atomicAdd(&bar[XB_TMO], 1u); break; } }
  }
  nloc = mine > 0u ? mine : 1u; nx = cnt > 0u ? cnt : 1u;
}
DI void xcd_barrier(const XcdBarrier& b) {
  asm volatile("s_waitcnt vmcnt(0)" ::: "memory");
  __syncthreads();
  if (threadIdx.x == 0) {
    unsigned* bar = b.bar;
    __builtin_amdgcn_s_waitcnt(0);
    unsigned nloc = b.st[0], nx = b.st[1];
    if (nloc == 0u) { xcd_barrier_complete(bar, b.x, nloc, nx); b.st[0] = nloc; b.st[1] = nx; }
    const unsigned old = xb_add(&bar[XB_XSUB(b.x)], 1u);
    const unsigned gen = old / nloc;
    if (old + 1u == (gen + 1u) * nloc) {
      __builtin_amdgcn_fence(__ATOMIC_RELEASE, "agent");
      asm volatile("s_waitcnt vmcnt(0)" ::: "memory");
      const unsigned og = xb_add(&bar[XB_TOP], 1u);
      const unsigned tg = og / nx;
      if (og + 1u == (tg + 1u) * nx) xb_add(&bar[XB_TOPGEN], 1u);
      else XB_SPIN(xb_ld(&bar[XB_TOPGEN]) == tg, bar);
      __builtin_amdgcn_fence(__ATOMIC_ACQUIRE, "agent");
      xb_add(&bar[XB_XGEN(b.x)], 1u);
      asm volatile("s_waitcnt vmcnt(0)" ::: "memory");
    } else {
      XB_SPIN(xb_ld(&bar[XB_XGEN(b.x)]) == gen, bar);
      __builtin_amdgcn_fence(__ATOMIC_ACQUIRE, "agent");
      asm volatile("s_waitcnt vmcnt(0)" ::: "memory");
    }
  }
  __syncthreads();
}

__global__ void __launch_bounds__(512) fwd_kernel(Params p, int ph_lo, int ph_hi, int dup) {
  extern __shared__ __attribute__((aligned(16))) unsigned char shm[];
  const int half = threadIdx.x >> 8;
  char* lds = (char*)shm + half * LDS_BYTES;
  PG8_LAS unsigned char* lds8 = (PG8_LAS unsigned char*)shm;
  const int G = 2 * (int)gridDim.x;
  int vb0 = blockIdx.x;
  if ((gridDim.x & 7) == 0) vb0 = (blockIdx.x & 7) * (gridDim.x >> 3) + (blockIdx.x >> 3);
  const int vb = 2 * vb0 + half;
  unsigned char* ws = p.ws;
  const float* mods = (const float*)(ws + OFF_MODS);
  float* X = p.out + OUT_Y;
  u16* H = (u16*)(ws + OFF_H);

#define RUNPH(n) ((ONLYPH < 0 || ONLYPH == (n)) && ph_lo <= (n) && (n) < ph_hi)
#define REP(n) _Pragma("unroll 1") for (int rep_ = 0; rep_ < ((DUPPH == (n)) ? ((dup == (n)) ? 2 : 1) : 1); ++rep_)
#define SEAM(n) if (ph_lo < (n) && (n) < ph_hi) xcd_barrier(xb);
  __shared__ uint4 xb_words;
  if (threadIdx.x == 0) xb_words = make_uint4(0u, 0u, 0u, 0u);
  __syncthreads();
  XcdBarrier xb = xcd_barrier_post((unsigned*)(ws + OFF_BAR), (volatile LAS unsigned*)&xb_words);
  if (ph_hi > 1000) cg::this_grid().sync();
  if (RUNPH(0)) REP(0) {
    for (int id = vb; id < 384; id += G) ada_item(p, id, lds);
    prep_transposes(p, vb, G, lds, 0);
    prep_elementwise(p, vb, G);
  }
  SEAM(1)
  if (RUNPH(1)) REP(1) {
    for (int t = vb; t < 128; t += G) {
      const bool f1 = t < 64;
      const int q = t & 63, m0 = (q >> 3) << 7, n0 = (q & 7) << 7;
      const int koff = f1 ? (m0 >> 8) * 128 : n0;
      gemm_tile((f1 ? (const u16*)(ws + OFF_CBD) : (const u16*)(ws + OFF_WOUT_ET)) + koff, f1 ? 512 : 1024,
                (f1 ? (const u16*)(ws + OFF_WINB) : (const u16*)(ws + OFF_BD)) + koff, f1 ? 512 : 1024, 128, m0, n0,
                EpiBf16{f1 ? (u16*)(ws + OFF_WIN_E) + (size_t)512 * 1024 : (u16*)(ws + OFF_WOUT_E), 1024}, lds);
    }
    normmod_phase(p, vb, G, p.in[0], p.in[1], p.in[8], 0, 0);
    if (vb >= 128) prep_transposes(p, vb - 128, G - 128, lds, 1, 0, 832);
  }
  SEAM(2)
  if (RUNPH(2)) REP(2)
  {
    big_gemm8<3>(lds8, H, (const u16*)(ws + OFF_WIN_E), T, 1536, 1024, FUx8{(u16*)(ws + OFF_UA), (u16*)(ws + OFF_PQT)});
    if (blockIdx.x >= 128) prep_transposes(p, ((int)blockIdx.x - 128) * 2 + half, ((int)gridDim.x - 128) * 2, lds, 1, 832, 1856);
  }
  SEAM(3)
  if (RUNPH(3)) REP(3) sym_phase(p, vb, G);
  SEAM(4)
  if (RUNPH(4)) REP(4) {
    const u16* PQT = (const u16*)(ws + OFF_PQT);
    const u16* PEQO = (const u16*)(ws + OFF_PEQO);
    for (int t = vb0; t < 256 + 128; t += (int)gridDim.x) {
      const bool big = t < 256;
      const int q = t - 256, b = q >> 3;
      dft_pair(big ? (const u16*)(ws + OFF_D4096) : (const u16*)(ws + OFF_D256),
               big ? PEQO + (size_t)16 * 512 * 256 : PEQO + (size_t)b * 512 * 256,
               big ? PQT + (size_t)16 * 512 * 512 + 2048 : PQT + (size_t)b * 512 * 512 + 128,
               big ? 8192 : 512, big ? 2048 : 128, big ? (t & 15) << 7 : 0, big ? (t >> 4) << 6 : (q & 7) << 6,
               (u16*)(ws + OFF_AB), big ? 4096 : b * 256, 512, big ? 0.0013810679320049757f : 0.005524271728019903f, (char*)shm, half);
    }
    pool_phase(p, vb, G);
  }
  float* PART = (float*)(ws + OFF_PART);
  unsigned* CNT = (unsigned*)(ws + OFF_CNT);
  SEAM(5)
  if (RUNPH(5))
    big_gemm_resnorm<3>(lds8, (const u16*)(ws + OFF_AB), (const u16*)(ws + OFF_WOUT_E), T, 1024, 1024,
                        ResNormEpi<3>{p.in[0], p.in[1], X, mods + 2048, p.in[9], mods + 3072, H, PART, CNT});
  SEAM(6)
  if (RUNPH(6)) REP(6) big_gemm8<4>(lds8, H, (const u16*)(ws + OFF_W1), T, 4096, 1024, FRelu2x8{(u16*)(ws + OFF_M1)});
  SEAM(7)
  if (RUNPH(7))
    big_gemm_resnorm<3>(lds8, (const u16*)(ws + OFF_M1), (const u16*)(ws + OFF_W2), T, 1024, 4096,
                        ResNormEpi<3>{X, X + (size_t)4096 * 1024, X, mods + 5120, p.in[8] + 1024, mods + 3 * 6144, H, PART + (size_t)4 * T, CNT + 64 * 16});
  SEAM(8)
  if (RUNPH(8)) {
    big_gemm_qkv(lds8, H, (const u16*)(ws + OFF_WIN_O), T, 2304, 1024,
                 QkvHeadEpi{ws, p.out, p.in[18], p.in[19], p.in[25], p.in[26]});
    if (blockIdx.x >= 176) {
      cache_convert(p, ((int)blockIdx.x - 176) * 2 + half, ((int)gridDim.x - 176) * 2);
      prep_transposes(p, ((int)blockIdx.x - 176) * 2 + half, ((int)gridDim.x - 176) * 2, lds, 1, 1856, 2880);
    }
  }
  SEAM(9)
  if (RUNPH(9)) REP(9) attention_phase(p, vb0, half, (char*)shm);
  SEAM(10)
  if (RUNPH(10))
    big_gemm_resnorm<3>(lds8, H, (const u16*)(ws + OFF_WOUT_O), T, 1024, 1024,
                        ResNormEpi<3>{X, X + (size_t)4096 * 1024, X, mods + 3 * 6144 + 2048, p.in[9] + 1024, mods + 3 * 6144 + 3072, (u16*)(ws + OFF_R2), PART + (size_t)8 * T, CNT + 128 * 16});
  SEAM(11)
  if (RUNPH(11)) REP(11) big_gemm8<4>(lds8, (const u16*)(ws + OFF_R2), (const u16*)(ws + OFF_W1) + (size_t)4096 * 1024, T, 4096, 1024, FRelu2x8{(u16*)(ws + OFF_M1)});
  SEAM(12)
  if (RUNPH(12)) REP(12) big_gemm<3>(lds8, (const u16*)(ws + OFF_M1), (const u16*)(ws + OFF_W2) + (size_t)4096 * 1024, T, 1024, 4096, FRes{X, X + (size_t)4096 * 1024, rep_ ? (float*)(ws + OFF_R2) : X, mods + 3 * 6144 + 5120});
}

extern "C" void kernel_launch(void* const* d_in, const int* in_sizes, int n_in, void* d_out, int out_size, void* d_ws, size_t ws_size,
                              hipStream_t stream) {
  constexpr int kDynLds = 2 * LDS_BYTES;
  static int grid = 0;
  if (!grid) {
    int dev = 0, cus = 0, per_cu = 0;
    (void)hipGetDevice(&dev);
    (void)hipDeviceGetAttribute(&cus, hipDeviceAttributeMultiprocessorCount, dev);
    if (hipFuncSetAttribute((const void*)fwd_kernel, hipFuncAttributeMaxDynamicSharedMemorySize, kDynLds) != hipSuccess) fprintf(stderr, "hipFuncSetAttribute(%d) failed\n", kDynLds);
    (void)hipOccupancyMaxActiveBlocksPerMultiprocessor(&per_cu, fwd_kernel, 512, kDynLds);
    if (per_cu < 1) fprintf(stderr, "occupancy query says %d blocks/CU\n", per_cu);
    grid = cus;
    if (ws_size < WS_END) fprintf(stderr, "workspace too small: %zu < %zu\n", ws_size, (size_t)WS_END);
  }
  Params p{};
  for (int i = 0; i < 31; ++i) p.in[i] = (const float*)d_in[i];
  p.out = (float*)d_out;
  p.ws = (unsigned char*)d_ws;
#if ONE_LAUNCH
  hipMemsetAsync((char*)d_ws + OFF_BAR, 0, XCD_BAR_WORDS * 4 + CNT_BYTES, stream);
  int lo = 0, hi = NPH, dup = DUPPH;
  void* args[] = {&p, &lo, &hi, &dup};
  hipError_t e = hipLaunchCooperativeKernel((void*)fwd_kernel, dim3(grid), dim3(512), args, kDynLds, stream);
  if (e != hipSuccess) fprintf(stderr, "cooperative launch failed: %s (grid %d)\n", hipGetErrorString(e), grid);
#else
  for (int ph = 0; ph < NPH; ++ph) hipLaunchKernelGGL(fwd_kernel, dim3(grid), dim3(512), kDynLds, stream, p, ph, ph + 1, -1);
#endif
}
```

```cpp
#include <hip/hip_runtime.h>
#include <hip/hip_cooperative_groups.h>
#include <cstdio>
namespace cg = cooperative_groups;

#ifndef ONE_LAUNCH
#define ONE_LAUNCH 1
#endif

#ifndef ONLYPH
#define ONLYPH -1
#endif
#ifndef DUPPH
#define DUPPH -1
#endif
typedef unsigned short u16;
typedef short bf16x8 __attribute__((ext_vector_type(8)));
typedef float f32x16 __attribute__((ext_vector_type(16)));
typedef __bf16 bf2_t __attribute__((ext_vector_type(2)));
typedef float f2_t __attribute__((ext_vector_type(2)));
typedef unsigned u32x4 __attribute__((ext_vector_type(4)));

#define DI __device__ __forceinline__
#define TIDX ((int)(threadIdx.x & 255u))

constexpr int T = 12288, TP = 4096, DM = 1024;
constexpr int NPH = 13;
constexpr float EPS = 1e-6f;
constexpr float LOG2E = 1.4426950408889634f;
constexpr float QSCALE = 0.125f * LOG2E;
constexpr float LAM_INIT = 0.35550906759f;

constexpr size_t al(size_t x) { return (x + 255) & ~size_t(255); }
constexpr size_t OFF_MODS   = 0;
constexpr size_t OFF_WIN_E  = OFF_MODS + al(2 * 3 * 6144 * 4);
constexpr size_t OFF_WINB   = OFF_WIN_E + al(1536 * 1024 * 2);
constexpr size_t OFF_CBD    = OFF_WINB + al(1024 * 512 * 2);
constexpr size_t OFF_WOUT_ET= OFF_CBD + al(1024 * 512 * 2);
constexpr size_t OFF_BD     = OFF_WOUT_ET + al(1024 * 1024 * 2);
constexpr size_t OFF_WOUT_E = OFF_BD + al(1024 * 1024 * 2);
constexpr size_t OFF_WIN_O  = OFF_WOUT_E + al(1024 * 1024 * 2);
constexpr size_t OFF_WOUT_O = OFF_WIN_O + al(2304 * 1024 * 2);
constexpr size_t OFF_W1     = OFF_WOUT_O + al(1024 * 1024 * 2);
constexpr size_t OFF_W2     = OFF_W1 + al(2 * 4096 * 1024 * 2);
constexpr size_t OFF_D256   = OFF_W2 + al(2 * 4096 * 1024 * 2);
constexpr size_t OFF_H      = OFF_D256 + al(256 * 512 * 2);
constexpr size_t OFF_R2     = OFF_H + al((size_t)T * 1024 * 2);
constexpr size_t R2_BYTES   = (size_t)T * 512 * 2 + (size_t)T * 1024 * 2 * 2;
constexpr size_t OFF_R1     = OFF_R2 + al(R2_BYTES);
constexpr size_t R1_BYTES   = (size_t)T * 4096 * 2;
constexpr size_t OFF_BAR    = OFF_R1 + R1_BYTES;
constexpr size_t OFF_CNT    = OFF_BAR + 3456 * 4;
constexpr size_t CNT_BYTES  = 3 * 64 * 64;
constexpr size_t OFF_PART   = OFF_CNT + CNT_BYTES;
constexpr size_t WS_END     = OFF_PART + (size_t)3 * 4 * T * 4;
constexpr size_t OFF_UA  = OFF_R2;
constexpr size_t OFF_PQT = OFF_UA + (size_t)T * 512 * 2;
constexpr size_t OFF_AB  = OFF_PQT + (size_t)T * 1024 * 2;
constexpr size_t OFF_CQ   = OFF_R2;
constexpr size_t OFF_DQ   = OFF_CQ + (size_t)T * 512 * 2;
constexpr size_t OFF_CKP  = OFF_DQ + (size_t)T * 512 * 2;
constexpr size_t OFF_CKS  = OFF_CKP + (size_t)16 * 8 * 256 * 64 * 2;
constexpr size_t OFF_CVTP = OFF_CKS + (size_t)2 * 8 * 4608 * 64 * 2;
constexpr size_t OFF_CVTS = OFF_CVTP + (size_t)16 * 4 * 128 * 256 * 2;
constexpr size_t OFF_DKP  = OFF_CVTS + (size_t)2 * 4 * 128 * 4608 * 2;
constexpr size_t OFF_DKS  = OFF_DKP + (size_t)16 * 2 * 256 * 64 * 2;
constexpr size_t OFF_DVTP = OFF_DKS + (size_t)2 * 2 * 4608 * 64 * 2;
constexpr size_t OFF_DVTS = OFF_DVTP + (size_t)16 * 2 * 64 * 256 * 2;
constexpr size_t R2_LATE_END = OFF_DVTS + (size_t)2 * 2 * 64 * 4608 * 2;
static_assert(R2_LATE_END <= OFF_R2 + R2_BYTES, "R2 overflow");
constexpr size_t OFF_D4096 = OFF_R1;
constexpr size_t OFF_PEQO  = OFF_R1 + (size_t)32 * 1024 * 1024;
constexpr size_t OFF_M1    = OFF_R1;
constexpr size_t OFF_QKV   = OFF_R1;
constexpr size_t OFF_OM    = OFF_R1 + al((size_t)T * 2304 * 2);
static_assert(OFF_OM + (size_t)T * 1024 * 2 <= WS_END, "R1 overflow");

constexpr size_t OUT_Y   = 0;
constexpr size_t OUT_NCK = (size_t)T * 1024;
constexpr size_t OUT_NCV = OUT_NCK + (size_t)TP * 512;
constexpr size_t OUT_NDK = OUT_NCV + (size_t)TP * 512;
constexpr size_t OUT_NDV = OUT_NDK + (size_t)TP * 128;

struct Params {
  const float* in[31];
  float* out;
  unsigned char* ws;
};

DI float bf2f(u16 v) { return __uint_as_float(((unsigned)v) << 16); }
DI unsigned pack2(float a, float b) { f2_t f = {a, b}; bf2_t v = __builtin_convertvector(f, bf2_t); return __builtin_bit_cast(unsigned, v); }
DI u16 f2bf(float a) { return (u16)(pack2(a, 0.f) & 0xffffu); }
DI int cond_of(int m) { return m < 4096 ? 0 : (m < 8192 ? 1 : 2); }
DI float wave_sum(float v) {
#pragma unroll
  for (int o = 32; o >= 1; o >>= 1) v += __shfl_xor(v, o);
  return v;
}
#define MFMA(a, b, c) __builtin_amdgcn_mfma_f32_32x32x16_bf16((a), (b), (c), 0, 0, 0)

constexpr int LROW = 144;
constexpr int GEMM_BUF = 2 * 128 * LROW;
constexpr int LDS_BYTES = 2 * GEMM_BUF;

template <int NR>
DI void g_load(u32x4 (&R)[NR], const u16* g, int ld, int k0) {
#pragma unroll
  for (int i = 0; i < NR; ++i) R[i] = *(const u32x4*)(g + (size_t)(32 * i) * ld + k0);
}
template <int NR>
DI void g_store(const u32x4 (&R)[NR], char* sw) {
#pragma unroll
  for (int i = 0; i < NR; ++i) *(u32x4*)(sw + (32 * i) * LROW) = R[i];
}
template <int NB>
DI void g_compute(f32x16 (&acc)[2][NB], const char* fa, const char* fb) {
#pragma unroll
  for (int ks = 0; ks < 4; ++ks) {
    bf16x8 a0 = *(const bf16x8*)(fa + ks * 32);
    bf16x8 a1 = *(const bf16x8*)(fa + 32 * LROW + ks * 32);
#pragma unroll
    for (int j = 0; j < NB; ++j) {
      bf16x8 b = *(const bf16x8*)(fb + j * 32 * LROW + ks * 32);
      acc[0][j] = MFMA(a0, b, acc[0][j]);
      acc[1][j] = MFMA(a1, b, acc[1][j]);
    }
  }
}
template <int NB>
DI void gemm_acc(f32x16 (&acc)[2][NB], const u16* A, int lda, const u16* Bt, int ldb, int K, int m0, int n0, char* lds) {
  const int tid = TIDX, lane = tid & 63, wave = tid >> 6;
  const int r = lane & 31, h = lane >> 5;
  const int wm = wave >> 1, wn = wave & 1;
  const int lrow = tid >> 3, lcol = (tid & 7) * 8;
  const u16* ga = A + (size_t)(m0 + lrow) * lda + lcol;
  const u16* gb = Bt + (size_t)(n0 + lrow) * ldb + lcol;
  u32x4 ra0[4], ra1[4], rb0[2 * NB], rb1[2 * NB];
  const int nk = K >> 6;
  char* sw = lds + lrow * LROW + lcol * 2;
  const char* fa = lds + (wm * 64 + r) * LROW + h * 16;
  const char* fb = lds + 128 * LROW + (wn * 32 * NB + r) * LROW + h * 16;
#define G_LOAD(RA, RB, kt_) do { const int k0_ = ((kt_) < nk ? (kt_) : nk - 1) << 6; g_load<4>(RA, ga, lda, k0_); g_load<2 * NB>(RB, gb, ldb, k0_); } while (0)
#define G_STORE(RA, RB, boff_) do { g_store<4>(RA, sw + (boff_)); g_store<2 * NB>(RB, sw + (boff_) + 128 * LROW); } while (0)
  G_LOAD(ra0, rb0, 0);
  G_LOAD(ra1, rb1, 1);
  G_STORE(ra0, rb0, 0);
  __syncthreads();
  for (int kt = 0; kt < nk; kt += 2) {
    G_LOAD(ra0, rb0, kt + 2);
    g_compute<NB>(acc, fa, fb);
    G_STORE(ra1, rb1, GEMM_BUF);
    __syncthreads();
    G_LOAD(ra1, rb1, kt + 3);
    g_compute<NB>(acc, fa + GEMM_BUF, fb + GEMM_BUF);
    G_STORE(ra0, rb0, 0);
    __syncthreads();
  }
#undef G_LOAD
#undef G_STORE
}

template <class Epi>
DI void gemm_tile(const u16* A, int lda, const u16* Bt, int ldb, int K, int m0, int n0, Epi epi, char* lds) {
  const int lane = TIDX & 63, wave = TIDX >> 6;
  const int r = lane & 31, h = lane >> 5, wm = wave >> 1, wn = wave & 1;
  f32x16 acc[2][2];
#pragma unroll
  for (int i = 0; i < 2; ++i)
#pragma unroll
    for (int j = 0; j < 2; ++j)
#pragma unroll
      for (int e = 0; e < 16; ++e) acc[i][j][e] = 0.f;
  gemm_acc<2>(acc, A, lda, Bt, ldb, K, m0, n0, lds);
#pragma unroll
  for (int i = 0; i < 2; ++i)
#pragma unroll
    for (int j = 0; j < 2; ++j)
#pragma unroll
      for (int q = 0; q < 4; ++q) {
        const int m = m0 + wm * 64 + i * 32 + 8 * q + 4 * h;
        const int n = n0 + wn * 64 + j * 32 + r;
        epi(m, n, acc[i][j][4 * q], acc[i][j][4 * q + 1], acc[i][j][4 * q + 2], acc[i][j][4 * q + 3]);
      }
}

DI void dft_pair(const u16* Dm, const u16* PeQo, const u16* PH, int phstride, int H, int m0, int n0, u16* AB, int rowbase, int colsPerBatch, float norm, char* shm, int half) {
  char* lds = shm + half * LDS_BYTES;
  const int lane = TIDX & 63, wave = TIDX >> 6;
  const int r = lane & 31, h = lane >> 5, wm = wave >> 1, wn = wave & 1;
  f32x16 acc[2][1];
#pragma unroll
  for (int i = 0; i < 2; ++i)
#pragma unroll
    for (int e = 0; e < 16; ++e) acc[i][0][e] = 0.f;
  gemm_acc<1>(acc, Dm + half * H, 2 * H, PeQo + half * H, 2 * H, H, m0, n0, lds);
  float* exo = (float*)lds + wave * 2048 + lane;
  const float* exr = (const float*)(shm + (1 - half) * LDS_BYTES) + wave * 2048 + lane;
#pragma unroll
  for (int i = 0; i < 2; ++i)
#pragma unroll
    for (int e = 0; e < 16; ++e) exo[(i * 16 + e) * 64] = acc[i][0][e];
  __syncthreads();
  const int N = 2 * H;
  const int col = n0 + wn * 32 + r;
  const int b = col / colsPerBatch, c = col - b * colsPerBatch;
  const float ph = bf2f(PH[(size_t)col * phstride]);
  u16* base = AB + ((size_t)rowbase + (size_t)b * N) * 1024 + 512 + c;
#pragma unroll
  for (int i = 0; i < 2; ++i)
#pragma unroll
    for (int q = 0; q < 4; ++q)
#pragma unroll
      for (int e = 0; e < 4; ++e) {
        const int k = m0 + wm * 64 + i * 32 + 8 * q + 4 * h + e;
        const float other = exr[(i * 16 + 4 * q + e) * 64];
        const float sp = (k & 1) ? -ph : ph;
        if (half == 0) base[(size_t)k * 1024] = f2bf((acc[i][0][4 * q + e] + sp - other) * norm);
        else if (k > 0) base[(size_t)(N - k) * 1024] = f2bf((other + sp + acc[i][0][4 * q + e]) * norm);
      }
  __syncthreads();
}

struct EpiBf16 {
  u16* C; int ldc;
  DI void operator()(int m, int n, float v0, float v1, float v2, float v3) const {
    u16* p = C + (size_t)m * ldc + n;
    p[0] = f2bf(v0); p[ldc] = f2bf(v1); p[2 * ldc] = f2bf(v2); p[3 * ldc] = f2bf(v3);
  }
};
struct EpiU {
  u16* UA; u16* PQt;
  DI void operator()(int m, int n, float v0, float v1, float v2, float v3) const {
    if (n < 512) {
      u16* p = UA + (size_t)m * 512 + n;
      p[0] = f2bf(v0); p[512] = f2bf(v1); p[1024] = f2bf(v2); p[1536] = f2bf(v3);
    } else {
      const int np = n - 512, g = np >> 8, pq = (np >> 7) & 1, mm = np & 127;
      size_t off;
      if (m < 4096) { const int b = m >> 8, nl = m & 255; off = ((size_t)(b * 512 + g * 128 + mm)) * 512 + pq * 256 + nl; }
      else { const int ms = m - 4096, b = ms >> 12, nl = ms & 4095; off = (size_t)16 * 512 * 512 + ((size_t)(b * 512 + g * 128 + mm)) * 8192 + pq * 4096 + nl; }
      uint2 w; w.x = pack2(v0, v1); w.y = pack2(v2, v3);
      *(uint2*)(PQt + off) = w;
    }
  }
};
struct EpiDft {
  u16* AB; int rowbase; float norm; int sample;
  DI void operator()(int m, int n, float v0, float v1, float v2, float v3) const {
    size_t row; int c;
    if (sample) { row = (size_t)4096 + (size_t)(n >> 9) * 4096 + m; c = n & 511; }
    else { row = (size_t)rowbase + m; c = n; }
    u16* p = AB + row * 1024 + 512 + c;
    p[0] = f2bf(v0 * norm); p[1024] = f2bf(v1 * norm); p[2048] = f2bf(v2 * norm); p[3072] = f2bf(v3 * norm);
  }
};
struct EpiRes {
  const float* xin_p; const float* xin_s;
  float* X; const float* gate;
  DI void operator()(int m, int n, float v0, float v1, float v2, float v3) const {
    const float* xi = (m < 4096) ? xin_p + (size_t)m * 1024 + n : xin_s + (size_t)(m - 4096) * 1024 + n;
    const float g = gate[cond_of(m) * 6144 + n];
    float* xo = X + (size_t)m * 1024 + n;
    xo[0] = xi[0] + g * v0; xo[1024] = xi[1024] + g * v1; xo[2048] = xi[2048] + g * v2; xo[3072] = xi[3072] + g * v3;
  }
};
struct EpiRelu2 {
  u16* C;
  DI void operator()(int m, int n, float v0, float v1, float v2, float v3) const {
    v0 = fmaxf(v0, 0.f); v1 = fmaxf(v1, 0.f); v2 = fmaxf(v2, 0.f); v3 = fmaxf(v3, 0.f);
    u16* p = C + (size_t)m * 4096 + n;
    p[0] = f2bf(v0 * v0); p[4096] = f2bf(v1 * v1); p[8192] = f2bf(v2 * v2); p[12288] = f2bf(v3 * v3);
  }
};
struct EpiQkv {
  u16* QKV; u16* CVtP; u16* CVtS; u16* DVtP; u16* DVtS; float* ncv; float* ndv;
  DI void operator()(int m, int n, float v0, float v1, float v2, float v3) const {
    const bool is_cv = (n >= 1024 && n < 1536), is_dv = (n >= 2176);
    if (!is_cv && !is_dv) {
      u16* p = QKV + (size_t)m * 2304 + n;
      p[0] = f2bf(v0); p[2304] = f2bf(v1); p[4608] = f2bf(v2); p[6912] = f2bf(v3);
      return;
    }
    uint2 w; w.x = pack2(v0, v1); w.y = pack2(v2, v3);
    if (is_cv) {
      const int c = n - 1024;
      if (m < 4096) {
        const int b = m >> 8, nl = m & 255;
        *(uint2*)(CVtP + ((size_t)(b * 512 + c)) * 256 + nl) = w;
        float* o = ncv + (size_t)m * 512 + c; o[0] = v0; o[512] = v1; o[1024] = v2; o[1536] = v3;
      } else {
        const int ms = m - 4096, b = ms >> 12, nl = ms & 4095;
        *(uint2*)(CVtS + ((size_t)(b * 512 + c)) * 4608 + 512 + nl) = w;
      }
    } else {
      const int c = n - 2176;
      if (m < 4096) {
        const int b = m >> 8, nl = m & 255;
        *(uint2*)(DVtP + ((size_t)(b * 128 + c)) * 256 + nl) = w;
        float* o = ndv + (size_t)m * 128 + c; o[0] = v0; o[128] = v1; o[256] = v2; o[384] = v3;
      } else {
        const int ms = m - 4096, b = ms >> 12, nl = ms & 4095;
        *(uint2*)(DVtS + ((size_t)(b * 128 + c)) * 4608 + 512 + nl) = w;
      }
    }
  }
};

DI void ada_item(const Params& p, int id, char* lds) {
  const int tid = TIDX;
  float* ssil = (float*)lds;
  float* red = (float*)(lds + 12288);
  const int l = id / 192, cb = id % 192;
  for (int i = tid; i < 3072; i += 256) {
    const int j = i >> 10, k = i & 1023;
    const float v = (j == 0) ? p.in[7][k] : p.in[2][(j - 1) * 1024 + k];
    ssil[i] = v / (1.f + __expf(-v));
  }
  __syncthreads();
  const int cq = tid & 7, kg = tid >> 3;
  const float* w = p.in[10] + (size_t)l * 1024 * 6144 + cb * 32 + cq * 4;
  float4 a0 = {0, 0, 0, 0}, a1 = {0, 0, 0, 0}, a2 = {0, 0, 0, 0};
#pragma unroll 8
  for (int kk = 0; kk < 32; ++kk) {
    const int k = kg * 32 + kk;
    const float4 wv = *(const float4*)(w + (size_t)k * 6144);
    const float s0 = ssil[k], s1 = ssil[1024 + k], s2 = ssil[2048 + k];
    a0.x += s0 * wv.x; a0.y += s0 * wv.y; a0.z += s0 * wv.z; a0.w += s0 * wv.w;
    a1.x += s1 * wv.x; a1.y += s1 * wv.y; a1.z += s1 * wv.z; a1.w += s1 * wv.w;
    a2.x += s2 * wv.x; a2.y += s2 * wv.y; a2.z += s2 * wv.z; a2.w += s2 * wv.w;
  }
  float* rp = red + kg * 96 + cq * 4;
  rp[0] = a0.x; rp[1] = a0.y; rp[2] = a0.z; rp[3] = a0.w;
  rp[32] = a1.x; rp[33] = a1.y; rp[34] = a1.z; rp[35] = a1.w;
  rp[64] = a2.x; rp[65] = a2.y; rp[66] = a2.z; rp[67] = a2.w;
  __syncthreads();
  if (tid < 96) {
    const int j = tid >> 5, c = tid & 31;
    float sum = 0.f;
#pragma unroll
    for (int g = 0; g < 32; ++g) sum += red[g * 96 + j * 32 + c];
    const int col = cb * 32 + c;
    ((float*)(p.ws + OFF_MODS))[(size_t)(l * 3 + j) * 6144 + col] = sum + p.in[11][l * 6144 + col];
  }
  __syncthreads();
}

DI void transpose_tile(const float* src, int ld_src, u16* dst, int ld_dst, int r0, int c0, char* lds) {
  float* tile = (float*)lds;
  const int tid = TIDX;
  const int j4 = (tid & 15) * 4, i0 = tid >> 4;
#pragma unroll
  for (int it = 0; it < 4; ++it) {
    const int i = i0 + 16 * it;
    const float4 v = *(const float4*)(src + (size_t)(r0 + i) * ld_src + c0 + j4);
    float* tp = tile + i * 65 + j4;
    tp[0] = v.x; tp[1] = v.y; tp[2] = v.z; tp[3] = v.w;
  }
  __syncthreads();
  const int kc = (tid & 7) * 8, jr = tid >> 3;
#pragma unroll
  for (int it = 0; it < 2; ++it) {
    const int j = jr + 32 * it;
    const float* tp = tile + kc * 65 + j;
    uint4 o;
    o.x = pack2(tp[0], tp[65]); o.y = pack2(tp[130], tp[195]); o.z = pack2(tp[260], tp[325]); o.w = pack2(tp[390], tp[455]);
    *(uint4*)(dst + (size_t)(c0 + j) * ld_dst + r0 + kc) = o;
  }
  __syncthreads();
}

DI void prep_transposes(const Params& p, int vb, int G, char* lds, int layer, int t0 = 0, int t1 = 1 << 30) {
  const int ntile = min(layer ? 2880 : 2432, t1);
  for (int t = t0 + vb; t < ntile; t += G) {
    const float* src; u16* dst; int lds_, ldd, r0, c0;
    int q = t;
    if (layer == 0) {
      if (q < 128) { src = p.in[12]; lds_ = 1024; dst = (u16*)(p.ws + OFF_WIN_E); ldd = 1024; r0 = (q >> 3) * 64; c0 = (q & 7) * 64; }
      else if ((q -= 128) < 256) { src = p.in[16]; lds_ = 1024; dst = (u16*)(p.ws + OFF_WOUT_ET); ldd = 1024; r0 = (q >> 4) * 64; c0 = (q & 15) * 64; }
      else if ((q -= 256) < 1024) { src = p.in[29]; lds_ = 4096; dst = (u16*)(p.ws + OFF_W1); ldd = 1024; r0 = (q >> 6) * 64; c0 = (q & 63) * 64; }
      else { q -= 1024; src = p.in[30]; lds_ = 1024; dst = (u16*)(p.ws + OFF_W2); ldd = 4096; r0 = (q >> 4) * 64; c0 = (q & 15) * 64; }
    } else {
      if (q < 576) { src = p.in[17]; lds_ = 2304; dst = (u16*)(p.ws + OFF_WIN_O); ldd = 1024; r0 = (q / 36) * 64; c0 = (q % 36) * 64; }
      else if ((q -= 576) < 256) { src = p.in[28]; lds_ = 1024; dst = (u16*)(p.ws + OFF_WOUT_O); ldd = 1024; r0 = (q >> 4) * 64; c0 = (q & 15) * 64; }
      else if ((q -= 256) < 1024) { src = p.in[29] + (size_t)1024 * 4096; lds_ = 4096; dst = (u16*)(p.ws + OFF_W1) + (size_t)4096 * 1024; ldd = 1024; r0 = (q >> 6) * 64; c0 = (q & 63) * 64; }
      else { q -= 1024; src = p.in[30] + (size_t)4096 * 1024; lds_ = 1024; dst = (u16*)(p.ws + OFF_W2) + (size_t)1024 * 4096; ldd = 4096; r0 = (q >> 4) * 64; c0 = (q & 15) * 64; }
    }
    transpose_tile(src, lds_, dst, ldd, r0, c0, lds);
  }
}

DI void prep_elementwise(const Params& p, int vb, int G) {
  const size_t gt = (size_t)vb * 256 + TIDX, gs = (size_t)G * 256;
  {
    u16* d = (u16*)(p.ws + OFF_WINB);
    for (size_t i = gt; i < 1024 * 256; i += gs) {
      const int k = (int)(i >> 8), c = (int)(i & 255) * 2;
      const float* s = p.in[12] + (size_t)k * 1024 + 512 + c;
      *(unsigned*)(d + (size_t)k * 512 + c) = pack2(s[0], s[1]);
    }
  }
  {
    u16* d = (u16*)(p.ws + OFF_CBD);
    for (size_t i = gt; i < 1024 * 512; i += gs) {
      const int np = (int)(i >> 9), cp = (int)(i & 511);
      const int g = np >> 8, pq = (np >> 7) & 1, m = np & 127;
      float v = 0.f;
      if ((cp >> 7) == g) {
        const int c = cp & 127; const int rr = (m * c) & 127;
        const float x = (float)rr * (2.0f / 128.0f);
        v = pq ? sinpif(x) : cospif(x);
      }
      d[i] = f2bf(v);
    }
  }
  {
    u16* d = (u16*)(p.ws + OFF_BD);
    for (size_t i = gt; i < 1024 * 1024; i += gs) {
      const int kp = (int)(i >> 10), c = (int)(i & 1023);
      float v = 0.f;
      if (kp < 512) { const int g = kp >> 7; if (c < 512 && (c >> 7) == g) v = p.in[13][(size_t)g * 16384 + (kp & 127) * 128 + (c & 127)] * p.in[14][c]; }
      else { const int g = (kp - 512) >> 7; if (c >= 512 && ((c - 512) >> 7) == g) v = p.in[15][(size_t)g * 16384 + ((kp - 512) & 127) * 128 + ((c - 512) & 127)]; }
      d[i] = f2bf(v);
    }
  }
#pragma unroll 1
  for (int which = 0; which < 2; ++which) {
    const int H = which ? 2048 : 128, N = 2 * H, lg = which ? 9 : 5;
    u16* d = (u16*)(p.ws + (which ? OFF_D4096 : OFF_D256));
    const float invN = 1.0f / (float)N;
    for (size_t i = gt; i < ((size_t)H << lg); i += gs) {
      const int k = (int)(i >> lg), np = (int)(i & ((1 << lg) - 1)) * 8;
      const bool is_sin = np >= H;
      const int n = np & (H - 1);
      unsigned w[4];
#pragma unroll
      for (int e = 0; e < 4; ++e) {
        const float x0 = (float)((k * (n + 2 * e)) & (N - 1)) * invN, x1 = (float)((k * (n + 2 * e + 1)) & (N - 1)) * invN;
        const float v0 = is_sin ? __builtin_amdgcn_sinf(x0) : __builtin_amdgcn_cosf(x0);
        const float v1 = is_sin ? __builtin_amdgcn_sinf(x1) : __builtin_amdgcn_cosf(x1);
        w[e] = pack2(v0, v1);
      }
      *(uint4*)(d + (size_t)k * N + np) = make_uint4(w[0], w[1], w[2], w[3]);
    }
  }
}

DI void sym_phase(const Params& p, int vb, int G) {
  const int lane = TIDX & 63, wave = TIDX >> 6;
  const u16* PQT = (const u16*)(p.ws + OFF_PQT);
  u16* PEQO = (u16*)(p.ws + OFF_PEQO);
  u16* AB = (u16*)(p.ws + OFF_AB);
  for (int it = vb * 4 + wave; it < 1024 + 2048; it += G * 4) {
    const bool samp = it < 1024;
    const int H = samp ? 2048 : 128, N = 2 * H;
    int col, n0base, nstep;
    if (samp) { col = it; n0base = lane * 8; nstep = 512; }
    else { col = (it - 1024) * 4 + (lane >> 4); n0base = (lane & 15) * 8; nstep = 128; }
    const u16* Pp = samp ? PQT + (size_t)16 * 512 * 512 + (size_t)col * 8192 : PQT + (size_t)col * 512;
    const u16* Qp = Pp + N;
    u16* Pe = samp ? PEQO + (size_t)16 * 512 * 256 + (size_t)col * 4096 : PEQO + (size_t)col * 256;
    u16* Qo = Pe + H;
    float alt = 0.f;
    for (int n0 = n0base; n0 < H; n0 += nstep) {
      const uint4 pw = *(const uint4*)(Pp + n0), qw = *(const uint4*)(Qp + n0);
      const unsigned pa[4] = {pw.x, pw.y, pw.z, pw.w}, qa[4] = {qw.x, qw.y, qw.z, qw.w};
      float pe[8], qo[8];
#pragma unroll
      for (int e = 0; e < 8; ++e) {
        const float pv = (e & 1) ? __uint_as_float(pa[e >> 1] & 0xffff0000u) : __uint_as_float(pa[e >> 1] << 16);
        const float qv = (e & 1) ? __uint_as_float(qa[e >> 1] & 0xffff0000u) : __uint_as_float(qa[e >> 1] << 16);
        const int n = n0 + e;
        float pm = 0.f, qm = 0.f;
        if (n > 0) { pm = bf2f(Pp[N - n]); qm = bf2f(Qp[N - n]); }
        pe[e] = pv + pm;
        qo[e] = (n > 0) ? qv - qm : 0.f;
        alt += (e & 1) ? -pe[e] : pe[e];
      }
      *(uint4*)(Pe + n0) = make_uint4(pack2(pe[0], pe[1]), pack2(pe[2], pe[3]), pack2(pe[4], pe[5]), pack2(pe[6], pe[7]));
      *(uint4*)(Qo + n0) = make_uint4(pack2(qo[0], qo[1]), pack2(qo[2], qo[3]), pack2(qo[4], qo[5]), pack2(qo[6], qo[7]));
    }
    alt += __shfl_xor(alt, 1); alt += __shfl_xor(alt, 2); alt += __shfl_xor(alt, 4); alt += __shfl_xor(alt, 8);
    if (samp) { alt += __shfl_xor(alt, 16); alt += __shfl_xor(alt, 32); }
    if ((samp && lane == 0) || (!samp && (lane & 15) == 0)) {
      const float fh = alt + bf2f(Pp[H]);
      size_t row; int c; float norm;
      if (samp) { row = (size_t)4096 + (size_t)(col >> 9) * 4096 + 2048; c = col & 511; norm = 0.0013810679320049757f; }
      else { row = (size_t)(col >> 9) * 256 + 128; c = col & 511; norm = 0.005524271728019903f; }
      AB[row * 1024 + 512 + c] = f2bf(fh * norm);
    }
  }
}

DI void normmod_phase(const Params& p, int vb, int G, const float* xp, const float* xs, const float* gain, int l, int which) {
  const int lane = TIDX & 63, wave = TIDX >> 6;
  u16* H = (u16*)(p.ws + OFF_H);
  const float* mods = (const float*)(p.ws + OFF_MODS) + (size_t)l * 3 * 6144;
  for (int row = vb * 4 + wave; row < T; row += G * 4) {
    const float* x = (row < 4096) ? xp + (size_t)row * 1024 : xs + (size_t)(row - 4096) * 1024;
    float4 v[4];
    float ss = 0.f;
#pragma unroll
    for (int i = 0; i < 4; ++i) {
      v[i] = *(const float4*)(x + i * 256 + lane * 4);
      ss += v[i].x * v[i].x + v[i].y * v[i].y + v[i].z * v[i].z + v[i].w * v[i].w;
    }
    ss = wave_sum(ss);
    const float rinv = rsqrtf(ss * (1.0f / 1024.0f) + EPS);
    const float* md = mods + cond_of(row) * 6144 + which * 3072;
#pragma unroll
    for (int i = 0; i < 4; ++i) {
      const int c = i * 256 + lane * 4;
      const float4 g = *(const float4*)(gain + c);
      const float4 sh = *(const float4*)(md + c);
      const float4 sc = *(const float4*)(md + 1024 + c);
      const float o0 = v[i].x * rinv * g.x * (1.f + sc.x) + sh.x;
      const float o1 = v[i].y * rinv * g.y * (1.f + sc.y) + sh.y;
      const float o2 = v[i].z * rinv * g.z * (1.f + sc.z) + sh.z;
      const float o3 = v[i].w * rinv * g.w * (1.f + sc.w) + sh.w;
      uint2 w; w.x = pack2(o0, o1); w.y = pack2(o2, o3);
      *(uint2*)(H + (size_t)row * 1024 + c) = w;
    }
  }
}

template <class Epi>
DI void gemm_phase(const u16* A, int lda, const u16* Bt, int ldb, int K, int M, int N, Epi epi, int vb, int G, char* lds) {
  const int nN = N >> 7, nt = (M >> 7) * nN, grp = 8 * nN;
  for (int t = vb; t < nt; t += G) {
    const int gi = t / grp, rem = t - gi * grp;
    gemm_tile(A, lda, Bt, ldb, K, (gi * 8 + (rem & 7)) << 7, (rem >> 3) << 7, epi, lds);
  }
}

template <int HW>
DI void pool_item(const u16* UA, u16* AB, int t, int c8) {
  int nl, N;
  if (t < 4096) { nl = t & 255; N = 256; } else { nl = (t - 4096) & 4095; N = 4096; }
  const int base = t - nl;
  u32x4 w[2 * HW];
  int cnt = 0;
#pragma unroll
  for (int j = 0; j < 2 * HW; ++j) {
    const int idx = nl - HW + j;
    const bool ok = idx >= 0 && idx < N;
    w[j] = *(const u32x4*)(UA + (size_t)(base + (ok ? idx : nl)) * 512 + c8);
    if (!ok) w[j] = (u32x4){0u, 0u, 0u, 0u};
    cnt += ok ? 1 : 0;
  }
  const u32x4 cw = *(const u32x4*)(UA + (size_t)t * 512 + c8);
  float s[8] = {0, 0, 0, 0, 0, 0, 0, 0};
#pragma unroll
  for (int j = 0; j < 2 * HW; ++j)
#pragma unroll
    for (int e = 0; e < 4; ++e) { s[2 * e] += __uint_as_float(w[j][e] << 16); s[2 * e + 1] += __uint_as_float(w[j][e] & 0xffff0000u); }
  const float inv = 1.0f / (float)cnt;
  u32x4 o;
#pragma unroll
  for (int e = 0; e < 4; ++e) o[e] = pack2(s[2 * e] * inv - __uint_as_float(cw[e] << 16), s[2 * e + 1] * inv - __uint_as_float(cw[e] & 0xffff0000u));
  *(u32x4*)(AB + (size_t)t * 1024 + c8) = o;
}
template <int HW>
DI void pool_item8(const u16* UA, u16* AB, int t0, int c8) {
  int nl0, N;
  if (t0 < 4096) { nl0 = t0 & 255; N = 256; } else { nl0 = (t0 - 4096) & 4095; N = 4096; }
  const int base = t0 - nl0;
  constexpr int R = 8 + 2 * HW;
  u32x4 w[R];
#pragma unroll
  for (int i = 0; i < R; ++i) {
    const int idx = nl0 - HW + i;
    const bool ok = idx >= 0 && idx < N;
    w[i] = *(const u32x4*)(UA + (size_t)(base + (ok ? idx : nl0)) * 512 + c8);
    if (!ok) w[i] = (u32x4){0u, 0u, 0u, 0u};
  }
  float s[8] = {0, 0, 0, 0, 0, 0, 0, 0};
#pragma unroll
  for (int i = 0; i < 2 * HW; ++i)
#pragma unroll
    for (int e = 0; e < 4; ++e) { s[2 * e] += __uint_as_float(w[i][e] << 16); s[2 * e + 1] += __uint_as_float(w[i][e] & 0xffff0000u); }
#pragma unroll
  for (int j = 0; j < 8; ++j) {
    const int nl = nl0 + j;
    const float inv = 1.0f / (float)(min(nl + HW, N) - max(nl - HW, 0));
    const u32x4 cw = w[j + HW];
    u32x4 o;
#pragma unroll
    for (int e = 0; e < 4; ++e) o[e] = pack2(s[2 * e] * inv - __uint_as_float(cw[e] << 16), s[2 * e + 1] * inv - __uint_as_float(cw[e] & 0xffff0000u));
    *(u32x4*)(AB + (size_t)(t0 + j) * 1024 + c8) = o;
    if (j < 7) {
#pragma unroll
      for (int e = 0; e < 4; ++e) {
        s[2 * e] += __uint_as_float(w[j + 2 * HW][e] << 16) - __uint_as_float(w[j][e] << 16);
        s[2 * e + 1] += __uint_as_float(w[j + 2 * HW][e] & 0xffff0000u) - __uint_as_float(w[j][e] & 0xffff0000u);
      }
    }
  }
}
DI void pool_phase(const Params& p, int vb, int G) {
  const u16* UA = (const u16*)(p.ws + OFF_UA);
  u16* AB = (u16*)(p.ws + OFF_AB);
  const size_t gt = (size_t)vb * 256 + TIDX, gs = (size_t)G * 256;
  for (size_t i = gt; i < (size_t)(T / 8) * 64; i += gs) {
    const int cc = (int)(i & 15), tt = (int)(i >> 4) & 3, g = (int)(i >> 6) & 3, tb = (int)(i >> 8);
    const int t0 = (tb * 4 + tt) * 8, c8 = g * 128 + cc * 8;
    if (g == 0) pool_item8<1>(UA, AB, t0, c8);
    else if (g == 1) pool_item8<2>(UA, AB, t0, c8);
    else if (g == 2) pool_item8<4>(UA, AB, t0, c8);
    else pool_item8<8>(UA, AB, t0, c8);
  }
}

DI void qkvpost_phase(const Params& p, int vb, int G) {
  const int lane = TIDX & 63, wave = TIDX >> 6;
  const int q = lane & 15, sub = lane >> 4;
  const u16* QKV = (const u16*)(p.ws + OFF_QKV);
  u16* CQ = (u16*)(p.ws + OFF_CQ); u16* DQ = (u16*)(p.ws + OFF_DQ);
  u16* CKP = (u16*)(p.ws + OFF_CKP); u16* CKS = (u16*)(p.ws + OFF_CKS);
  u16* DKP = (u16*)(p.ws + OFF_DKP); u16* DKS = (u16*)(p.ws + OFF_DKS);
  float* nck = p.out + OUT_NCK; float* ndk = p.out + OUT_NDK;
  const int d0 = q * 4;
  float fr[4];
#pragma unroll
  for (int e = 0; e < 4; ++e) fr[e] = exp2f(-(float)((d0 + e) & 15) * (13.287712379549449f / 16.0f));
  const bool firsthalf = ((d0 >> 4) & 1) == 0;
  for (int t = vb * 4 + wave; t < T; t += G * 4) {
    const bool samp = t >= 4096;
    int b, nl;
    if (!samp) { b = t >> 8; nl = t & 255; } else { b = (t - 4096) >> 12; nl = (t - 4096) & 4095; }
    float cs[4], sn[4];
    if (samp) {
      const float pos = (d0 < 32) ? (float)(nl >> 6) : (float)(nl & 63);
#pragma unroll
      for (int e = 0; e < 4; ++e) { const float a = pos * fr[e]; cs[e] = cosf(a); sn[e] = sinf(a); }
    } else {
#pragma unroll
      for (int e = 0; e < 4; ++e) { cs[e] = 1.f; sn[e] = 0.f; }
    }
    for (int rd = 0; rd < 7; ++rd) {
      const int slot = rd * 4 + sub;
      const bool act = slot < 26;
      const int vi = act ? (slot < 16 ? slot : slot + 8) : 0;
      const uint2 raw = *(const uint2*)(QKV + (size_t)t * 2304 + vi * 64 + d0);
      float x[4] = {__uint_as_float(raw.x << 16), __uint_as_float(raw.x & 0xffff0000u), __uint_as_float(raw.y << 16), __uint_as_float(raw.y & 0xffff0000u)};
      float ss = x[0] * x[0] + x[1] * x[1] + x[2] * x[2] + x[3] * x[3];
      ss += __shfl_xor(ss, 1); ss += __shfl_xor(ss, 2); ss += __shfl_xor(ss, 4); ss += __shfl_xor(ss, 8);
      const float rinv = rsqrtf(ss * (1.0f / 64.0f) + EPS);
      const float* gp = (vi < 8) ? p.in[18] : (vi < 16) ? p.in[19] : (vi < 32) ? p.in[25] : p.in[26];
      const float4 g = *(const float4*)(gp + d0);
      float y[4] = {x[0] * rinv * g.x, x[1] * rinv * g.y, x[2] * rinv * g.z, x[3] * rinv * g.w};
      float o[4];
#pragma unroll
      for (int e = 0; e < 4; ++e) {
        const float part = __shfl_xor(y[e], 4);
        o[e] = firsthalf ? (y[e] * cs[e] - part * sn[e]) : (y[e] * cs[e] + part * sn[e]);
      }
      if (!act) continue;
      const bool isq = (vi < 8) || (vi >= 24 && vi < 32);
      if (isq) {
        const int hd = (vi < 8) ? vi : vi - 24;
        u16* base = (vi < 8) ? CQ : DQ;
        size_t off = samp ? (size_t)16 * 8 * 256 * 64 + ((size_t)(b * 8 + hd) * 4096 + nl) * 64 : ((size_t)(b * 8 + hd) * 256 + nl) * 64;
        uint2 w; w.x = pack2(o[0] * QSCALE, o[1] * QSCALE); w.y = pack2(o[2] * QSCALE, o[3] * QSCALE);
        *(uint2*)(base + off + d0) = w;
      } else if (vi < 16) {
        const int hm = vi - 8;
        uint2 w; w.x = pack2(o[0], o[1]); w.y = pack2(o[2], o[3]);
        if (samp) *(uint2*)(CKS + ((size_t)(b * 8 + hm) * 4608 + 512 + nl) * 64 + d0) = w;
        else {
          *(uint2*)(CKP + ((size_t)(b * 8 + hm) * 256 + nl) * 64 + d0) = w;
          *(float4*)(nck + (size_t)t * 512 + hm * 64 + d0) = make_float4(o[0], o[1], o[2], o[3]);
        }
      } else {
        const int j = vi - 32;
        uint2 w; w.x = pack2(o[0], o[1]); w.y = pack2(o[2], o[3]);
        if (samp) *(uint2*)(DKS + ((size_t)(b * 2 + j) * 4608 + 512 + nl) * 64 + d0) = w;
        else {
          *(uint2*)(DKP + ((size_t)(b * 2 + j) * 256 + nl) * 64 + d0) = w;
          *(float4*)(ndk + (size_t)t * 128 + j * 64 + d0) = make_float4(o[0], o[1], o[2], o[3]);
        }
      }
    }
  }
  const size_t gt = (size_t)vb * 256 + TIDX, gs = (size_t)G * 256;
  {
    u16* CVTS = (u16*)(p.ws + OFF_CVTS); u16* DVTS = (u16*)(p.ws + OFF_DVTS);
    for (size_t i = gt; i < (size_t)2 * 512 * 512; i += gs) {
      const int b = (int)(i >> 18), key = (int)(i >> 9) & 511, c = (int)(i & 511);
      CKS[((size_t)(b * 8 + (c >> 6)) * 4608 + key) * 64 + (c & 63)] = f2bf(p.in[3][i]);
    }
    for (size_t i = gt; i < (size_t)2 * 512 * 512; i += gs) {
      const int b = (int)(i >> 18), c = (int)(i >> 9) & 511, key = (int)(i & 511);
      CVTS[((size_t)(b * 512 + c)) * 4608 + key] = f2bf(p.in[4][((size_t)b * 512 + key) * 512 + c]);
    }
    for (size_t i = gt; i < (size_t)2 * 512 * 128; i += gs) {
      const int b = (int)(i >> 16), key = (int)(i >> 7) & 511, c = (int)(i & 127);
      DKS[((size_t)(b * 2 + (c >> 6)) * 4608 + key) * 64 + (c & 63)] = f2bf(p.in[5][i]);
    }
    for (size_t i = gt; i < (size_t)2 * 128 * 512; i += gs) {
      const int b = (int)(i >> 16), c = (int)(i >> 9) & 127, key = (int)(i & 511);
      DVTS[((size_t)(b * 128 + c)) * 4608 + key] = f2bf(p.in[6][((size_t)b * 512 + key) * 128 + c]);
    }
  }
}

DI void cache_convert(const Params& p, int vb, int G) {
  u16* CKS = (u16*)(p.ws + OFF_CKS); u16* DKS = (u16*)(p.ws + OFF_DKS);
  const size_t gt = (size_t)vb * 256 + TIDX, gs = (size_t)G * 256;
  {
    u16* CVTS = (u16*)(p.ws + OFF_CVTS); u16* DVTS = (u16*)(p.ws + OFF_DVTS);
    for (size_t i = gt; i < (size_t)2 * 512 * 512; i += gs) {
      const int b = (int)(i >> 18), key = (int)(i >> 9) & 511, c = (int)(i & 511);
      CKS[((size_t)(b * 8 + (c >> 6)) * 4608 + key) * 64 + (c & 63)] = f2bf(p.in[3][i]);
    }
    for (size_t i = gt; i < (size_t)2 * 512 * 512; i += gs) {
      const int b = (int)(i >> 18), c = (int)(i >> 9) & 511, key = (int)(i & 511);
      CVTS[((size_t)(b * 512 + c)) * 4608 + key] = f2bf(p.in[4][((size_t)b * 512 + key) * 512 + c]);
    }
    for (size_t i = gt; i < (size_t)2 * 512 * 128; i += gs) {
      const int b = (int)(i >> 16), key = (int)(i >> 7) & 511, c = (int)(i & 127);
      DKS[((size_t)(b * 2 + (c >> 6)) * 4608 + key) * 64 + (c & 63)] = f2bf(p.in[5][i]);
    }
    for (size_t i = gt; i < (size_t)2 * 128 * 512; i += gs) {
      const int b = (int)(i >> 16), c = (int)(i >> 9) & 127, key = (int)(i & 511);
      DVTS[((size_t)(b * 128 + c)) * 4608 + key] = f2bf(p.in[6][((size_t)b * 512 + key) * 128 + c]);
    }
  }
}

template <int DV>
DI void attn_item(const u16* Q, const u16* Kb, const u16* Vt, int ldv, int nt0, int key1, int nt1,
                  bool masked, int qpos0, bool has_sink, float sink2, u16* out, int ldo, char* lds) {
  constexpr int NDB = DV / 32;
  constexpr int KVBUF = (64 + DV) * LROW;
  const int tid = TIDX, lane = tid & 63, wave = tid >> 6;
  const int r = lane & 31, h = lane >> 5;
  const int nt = nt0 + nt1;
  bf16x8 qf[4];
#pragma unroll
  for (int ks = 0; ks < 4; ++ks) qf[ks] = *(const bf16x8*)(Q + (size_t)(wave * 32 + r) * 64 + ks * 16 + h * 8);
  f32x16 O[NDB];
#pragma unroll
  for (int i = 0; i < NDB; ++i)
#pragma unroll
    for (int e = 0; e < 16; ++e) O[i][e] = 0.f;
  float mrun = has_sink ? sink2 : -1e30f;
  float lrun = has_sink ? (h == 0 ? 1.f : 0.f) : 0.f;
  const int lrow = tid >> 3, lpart = (tid & 7) * 8;
  uint4 rk0, rk1, rv0, rv1, rv2, rv3;
  rv2 = rv3 = make_uint4(0, 0, 0, 0);
  const u16* gk = Kb + (size_t)lrow * 64 + lpart;
  const u16* gv = Vt + (size_t)lrow * ldv + lpart;
#define ATT_GLOAD(key0_)                                                         \
  do {                                                                           \
    rk0 = *(const uint4*)(gk + (size_t)(key0_) * 64);                            \
    rk1 = *(const uint4*)(gk + (size_t)((key0_) + 32) * 64);                     \
    rv0 = *(const uint4*)(gv + (key0_));                                         \
    rv1 = *(const uint4*)(gv + (size_t)32 * ldv + (key0_));                      \
    if constexpr (DV == 128) {                                                   \
      rv2 = *(const uint4*)(gv + (size_t)64 * ldv + (key0_));                    \
      rv3 = *(const uint4*)(gv + (size_t)96 * ldv + (key0_));                    \
    }                                                                            \
  } while (0)
#define ATT_SSTORE(boff_)                                                        \
  do {                                                                           \
    *(uint4*)(sw + (boff_)) = rk0;                                               \
    *(uint4*)(sw + (boff_) + 32 * LROW) = rk1;                                   \
    *(uint4*)(sw + (boff_) + 64 * LROW) = rv0;                                   \
    *(uint4*)(sw + (boff_) + 96 * LROW) = rv1;                                   \
    if constexpr (DV == 128) {                                                   \
      *(uint4*)(sw + (boff_) + 128 * LROW) = rv2;                                \
      *(uint4*)(sw + (boff_) + 160 * LROW) = rv3;                                \
    }                                                                            \
  } while (0)
  char* sw = lds + lrow * LROW + lpart * 2;
  {
    const int key0 = (nt0 > 0) ? 0 : key1;
    ATT_GLOAD(key0);
  }
  ATT_SSTORE(0);
  __syncthreads();
  const int pr = (r & 0x13) | ((r & 4) << 1) | ((r & 8) >> 1);
  const char* fk = lds + pr * LROW + h * 16;
  const char* fv = lds + 64 * LROW + r * LROW + h * 16;
  const int qpos = qpos0 + wave * 32 + r;
  for (int t = 0; t < nt; ++t) {
    const int cur = (t & 1) * KVBUF;
    const int key0 = (t < nt0) ? t * 64 : key1 + (t - nt0) * 64;
    {
      const int tn = (t + 1 < nt) ? t + 1 : t;
      const int kn = (tn < nt0) ? tn * 64 : key1 + (tn - nt0) * 64;
      ATT_GLOAD(kn);
    }
    f32x16 S[2];
#pragma unroll
    for (int kb = 0; kb < 2; ++kb) {
#pragma unroll
      for (int e = 0; e < 16; ++e) S[kb][e] = 0.f;
#pragma unroll
      for (int ks = 0; ks < 4; ++ks) {
        const bf16x8 kf = *(const bf16x8*)(fk + cur + kb * 32 * LROW + ks * 32);
        S[kb] = MFMA(kf, qf[ks], S[kb]);
      }
    }
    if (masked && t >= nt0) {
#pragma unroll
      for (int kb = 0; kb < 2; ++kb)
#pragma unroll
        for (int e = 0; e < 16; ++e) {
          const int jpos = key0 - 512 + kb * 32 + 16 * (e >> 3) + 8 * h + (e & 7);
          const int dlt = qpos - jpos;
          if (dlt > 128 || dlt < -128) S[kb][e] = -1e30f;
        }
    }
    float mloc = S[0][0];
#pragma unroll
    for (int kb = 0; kb < 2; ++kb)
#pragma unroll
      for (int e = 0; e < 16; ++e) mloc = fmaxf(mloc, S[kb][e]);
    mloc = fmaxf(mloc, __shfl_xor(mloc, 32));
    if (__builtin_amdgcn_ballot_w64(mloc > mrun + 8.0f) != 0) {
      const float mnew_ = fmaxf(mrun, mloc);
      const float alpha = __builtin_amdgcn_exp2f(mrun - mnew_);
      lrun *= alpha;
#pragma unroll
      for (int i = 0; i < NDB; ++i)
#pragma unroll
        for (int e = 0; e < 16; ++e) O[i][e] *= alpha;
      mrun = mnew_;
    }
    const float mnew = mrun;
    float ps = 0.f;
#pragma unroll
    for (int kb = 0; kb < 2; ++kb)
#pragma unroll
      for (int e = 0; e < 16; ++e) { const float pv = __builtin_amdgcn_exp2f(S[kb][e] - mnew); S[kb][e] = pv; ps += pv; }
    lrun += ps;
    bf16x8 pf[4];
#pragma unroll
    for (int jj = 0; jj < 4; ++jj) {
      const int kb = jj >> 1, o8 = (jj & 1) * 8;
      uint4 w;
      w.x = pack2(S[kb][o8 + 0], S[kb][o8 + 1]); w.y = pack2(S[kb][o8 + 2], S[kb][o8 + 3]);
      w.z = pack2(S[kb][o8 + 4], S[kb][o8 + 5]); w.w = pack2(S[kb][o8 + 6], S[kb][o8 + 7]);
      pf[jj] = __builtin_bit_cast(bf16x8, w);
    }
    __builtin_amdgcn_sched_barrier(0);
#pragma unroll
    for (int i = 0; i < NDB; ++i) {
#pragma unroll
      for (int jj = 0; jj < 4; ++jj) {
        const bf16x8 vf = *(const bf16x8*)(fv + cur + i * 32 * LROW + jj * 32);
        O[i] = MFMA(vf, pf[jj], O[i]);
      }
      if (i & 1) __builtin_amdgcn_sched_barrier(0);
    }
    ATT_SSTORE(KVBUF - cur);
    __syncthreads();
  }
#undef ATT_GLOAD
#undef ATT_SSTORE
  const float ltot = lrun + __shfl_xor(lrun, 32);
  const float inv = 1.0f / ltot;
  u16* op = out + (size_t)(wave * 32 + r) * ldo;
#pragma unroll
  for (int i = 0; i < NDB; ++i)
#pragma unroll
    for (int qd = 0; qd < 4; ++qd) {
      uint2 w;
      w.x = pack2(O[i][4 * qd] * inv, O[i][4 * qd + 1] * inv);
      w.y = pack2(O[i][4 * qd + 2] * inv, O[i][4 * qd + 3] * inv);
      *(uint2*)(op + i * 32 + 8 * qd + 4 * h) = w;
    }
}

DI void ad_tile(f32x16 (&O)[4], f32x16 (&S)[2], f32x16 (&Sn)[2], float& mrun, float& lrun, const bf16x8 (&qf)[4], const char* fk, const char* fv, int cur) {
    {
      constexpr int STG = (64 + 64 + 128) * LROW;
      bf16x8 kf_[8];
#pragma unroll
      for (int kb = 0; kb < 2; ++kb)
#pragma unroll
        for (int ks = 0; ks < 4; ++ks) kf_[kb * 4 + ks] = *(const bf16x8*)(fk + (STG - cur) + kb * 32 * LROW + ks * 32);
#pragma unroll
      for (int kb = 0; kb < 2; ++kb) {
#pragma unroll
        for (int e = 0; e < 16; ++e) Sn[kb][e] = 0.f;
#pragma unroll
        for (int ks = 0; ks < 4; ++ks) Sn[kb] = MFMA(kf_[kb * 4 + ks], qf[ks], Sn[kb]);
      }
    }
    __builtin_amdgcn_sched_group_barrier(0x020, 4, 0);
    __builtin_amdgcn_sched_group_barrier(0x100, 8, 0);
    __builtin_amdgcn_sched_group_barrier(0x008, 8, 0);
    __builtin_amdgcn_sched_barrier(0);
    float mloc = S[0][0];
#pragma unroll
    for (int kb = 0; kb < 2; ++kb)
#pragma unroll
      for (int e = 0; e < 16; ++e) mloc = fmaxf(mloc, S[kb][e]);
    mloc = fmaxf(mloc, __shfl_xor(mloc, 32));
    if (__builtin_amdgcn_ballot_w64(mloc > mrun + 8.0f) != 0) {
      const float mnew_ = fmaxf(mrun, mloc);
      const float alpha = __builtin_amdgcn_exp2f(mrun - mnew_);
      lrun *= alpha;
#pragma unroll
      for (int i = 0; i < 4; ++i)
#pragma unroll
        for (int e = 0; e < 16; ++e) O[i][e] *= alpha;
      mrun = mnew_;
    }
    const float mnew = mrun;
    float ps = 0.f;
#pragma unroll
    for (int kb = 0; kb < 2; ++kb)
#pragma unroll
      for (int e = 0; e < 16; ++e) { const float pv = __builtin_amdgcn_exp2f(S[kb][e] - mnew); S[kb][e] = pv; ps += pv; }
    lrun += ps;
    bf16x8 pf[4];
#pragma unroll
    for (int jj = 0; jj < 4; ++jj) {
      const int kb = jj >> 1, o8 = (jj & 1) * 8;
      uint4 w;
      w.x = pack2(S[kb][o8 + 0], S[kb][o8 + 1]); w.y = pack2(S[kb][o8 + 2], S[kb][o8 + 3]);
      w.z = pack2(S[kb][o8 + 4], S[kb][o8 + 5]); w.w = pack2(S[kb][o8 + 6], S[kb][o8 + 7]);
      pf[jj] = __builtin_bit_cast(bf16x8, w);
    }
    __builtin_amdgcn_sched_barrier(0);
    {
      bf16x8 vfa[4], vfb[4];
#pragma unroll
      for (int jj = 0; jj < 4; ++jj) vfa[jj] = *(const bf16x8*)(fv + cur + jj * 32);
#pragma unroll
      for (int jj = 0; jj < 4; ++jj) vfb[jj] = *(const bf16x8*)(fv + cur + 32 * LROW + jj * 32);
#pragma unroll
      for (int jj = 0; jj < 4; ++jj) O[0] = MFMA(vfa[jj], pf[jj], O[0]);
#pragma unroll
      for (int jj = 0; jj < 4; ++jj) vfa[jj] = *(const bf16x8*)(fv + cur + 64 * LROW + jj * 32);
#pragma unroll
      for (int jj = 0; jj < 4; ++jj) O[1] = MFMA(vfb[jj], pf[jj], O[1]);
#pragma unroll
      for (int jj = 0; jj < 4; ++jj) vfb[jj] = *(const bf16x8*)(fv + cur + 96 * LROW + jj * 32);
#pragma unroll
      for (int jj = 0; jj < 4; ++jj) O[2] = MFMA(vfa[jj], pf[jj], O[2]);
#pragma unroll
      for (int jj = 0; jj < 4; ++jj) O[3] = MFMA(vfb[jj], pf[jj], O[3]);
      __builtin_amdgcn_sched_group_barrier(0x100, 8, 0);
      __builtin_amdgcn_sched_group_barrier(0x008, 4, 0);
      __builtin_amdgcn_sched_group_barrier(0x100, 4, 0);
      __builtin_amdgcn_sched_group_barrier(0x008, 4, 0);
      __builtin_amdgcn_sched_group_barrier(0x100, 4, 0);
      __builtin_amdgcn_sched_group_barrier(0x008, 8, 0);
    }
    __builtin_amdgcn_sched_barrier(0);
}

DI void attn_diff_pair(const u16* Q, const u16* Kb, const u16* Vt, int ldv, int nt, float lam, const float* subln_g, u16* out, char* shm, int half) {
  constexpr int STG = (64 + 64 + 128) * LROW;
  const int tid = TIDX, t512 = (int)threadIdx.x, lane = tid & 63, wave = tid >> 6;
  const int r = lane & 31, h = lane >> 5;
  bf16x8 qf[4];
#pragma unroll
  for (int ks = 0; ks < 4; ++ks) qf[ks] = *(const bf16x8*)(Q + (size_t)(wave * 32 + r) * 64 + ks * 16 + h * 8);
  f32x16 O[4];
#pragma unroll
  for (int i = 0; i < 4; ++i)
#pragma unroll
    for (int e = 0; e < 16; ++e) O[i][e] = 0.f;
  float mrun = -1e30f, lrun = 0.f;
  const int lrow = tid >> 3, lpart = (tid & 7) * 8;
  const int vrow = t512 >> 3, vpart = (t512 & 7) * 8;
  const u16* gk = Kb + (size_t)lrow * 64 + lpart;
  const u16* gv = Vt + (size_t)vrow * ldv + vpart;
  char* sk = shm + half * 64 * LROW + lrow * LROW + lpart * 2;
  char* sv = shm + 128 * LROW + vrow * LROW + vpart * 2;
  u32x4 rk0, rk1, rv0, rv1;
#define AD_GLOAD(key0_) do { rk0 = *(const u32x4*)(gk + (size_t)(key0_) * 64); rk1 = *(const u32x4*)(gk + (size_t)((key0_) + 32) * 64); \
                             rv0 = *(const u32x4*)(gv + (key0_)); rv1 = *(const u32x4*)(gv + (size_t)64 * ldv + (key0_)); } while (0)
#define AD_SSTORE(boff_) do { *(u32x4*)(sk + (boff_)) = rk0; *(u32x4*)(sk + (boff_) + 32 * LROW) = rk1; \
                              *(u32x4*)(sv + (boff_)) = rv0; *(u32x4*)(sv + (boff_) + 64 * LROW) = rv1; } while (0)
#define AD_GLOAD_K(R0_, R1_, key0_) do { R0_ = *(const u32x4*)(gk + (size_t)(key0_) * 64); R1_ = *(const u32x4*)(gk + (size_t)((key0_) + 32) * 64); } while (0)
#define AD_GLOAD_V(R0_, R1_, key0_) do { R0_ = *(const u32x4*)(gv + (key0_)); R1_ = *(const u32x4*)(gv + (size_t)64 * ldv + (key0_)); } while (0)
#define AD_SSTORE_K(R0_, R1_, boff_) do { *(u32x4*)(sk + (boff_)) = R0_; *(u32x4*)(sk + (boff_) + 32 * LROW) = R1_; } while (0)
#define AD_SSTORE_V(R0_, R1_, boff_) do { *(u32x4*)(sv + (boff_)) = R0_; *(u32x4*)(sv + (boff_) + 64 * LROW) = R1_; } while (0)
#define AD_QK(S_, koff_) do { bf16x8 kf_[8]; \
    _Pragma("unroll") for (int kb = 0; kb < 2; ++kb) _Pragma("unroll") for (int ks = 0; ks < 4; ++ks) kf_[kb * 4 + ks] = *(const bf16x8*)(fk + (koff_) + kb * 32 * LROW + ks * 32); \
    _Pragma("unroll") for (int kb = 0; kb < 2; ++kb) { _Pragma("unroll") for (int e = 0; e < 16; ++e) S_[kb][e] = 0.f; \
    _Pragma("unroll") for (int ks = 0; ks < 4; ++ks) S_[kb] = MFMA(kf_[kb * 4 + ks], qf[ks], S_[kb]); } } while (0)
  const int pr = (r & 0x13) | ((r & 4) << 1) | ((r & 8) >> 1);
  const char* fk = shm + half * 64 * LROW + pr * LROW + h * 16;
  const char* fv = shm + 128 * LROW + r * LROW + h * 16;
  u32x4 ak0, ak1, av0, av1, bk0, bk1, bv0, bv1;
  AD_GLOAD_K(ak0, ak1, 0); AD_GLOAD_V(av0, av1, 0);
  AD_SSTORE_K(ak0, ak1, 0); AD_SSTORE_V(av0, av1, 0);
  AD_GLOAD_K(ak0, ak1, 64);
  AD_SSTORE_K(ak0, ak1, STG);
  AD_GLOAD_K(bk0, bk1, 128); AD_GLOAD_V(bv0, bv1, 64);
  __syncthreads();
  f32x16 S[2], Sn[2];
  AD_QK(S, 0);
  __syncthreads();
#define AD_STEP(t_, LK0, LK1, LV0, LV1, SK0, SK1, SV0, SV1) do { \
    const int t = (t_); const int cur = (t & 1) * STG; \
    { const int tk = (t + 3 < nt) ? t + 3 : nt - 1, tv = (t + 2 < nt) ? t + 2 : nt - 1; AD_GLOAD_K(LK0, LK1, tk * 64); AD_GLOAD_V(LV0, LV1, tv * 64); } \
    ad_tile(O, S, Sn, mrun, lrun, qf, fk, fv, cur); \
    AD_SSTORE_K(SK0, SK1, cur); AD_SSTORE_V(SV0, SV1, STG - cur); \
    __syncthreads(); \
    S[0] = Sn[0]; S[1] = Sn[1]; } while (0)
  for (int tt = 0; tt < nt; tt += 2) {
    AD_STEP(tt, ak0, ak1, av0, av1, bk0, bk1, bv0, bv1);
    AD_STEP(tt + 1, bk0, bk1, bv0, bv1, ak0, ak1, av0, av1);
  }
#undef AD_STEP
#undef AD_GLOAD_K
#undef AD_GLOAD_V
#undef AD_SSTORE_K
#undef AD_SSTORE_V
#undef AD_QK
#undef AD_GLOAD
#undef AD_SSTORE
  const float inv = 1.0f / (lrun + __shfl_xor(lrun, 32));
  float* ex = (float*)shm + (size_t)wave * 4096 + lane;
  if (half == 1) {
#pragma unroll
    for (int i = 0; i < 4; ++i)
#pragma unroll
      for (int e = 0; e < 16; ++e) ex[(i * 16 + e) * 64] = O[i][e] * inv;
  }
  __syncthreads();
  if (half == 0) {
    float ss = 0.f;
#pragma unroll
    for (int i = 0; i < 4; ++i)
#pragma unroll
      for (int e = 0; e < 16; ++e) { const float d = O[i][e] * inv - lam * ex[(i * 16 + e) * 64]; O[i][e] = d; ss += d * d; }
    ss += __shfl_xor(ss, 32);
    const float rinv = rsqrtf(ss * (1.0f / 128.0f) + EPS) * (1.0f - LAM_INIT);
    u16* op = out + (size_t)(wave * 32 + r) * 1024;
#pragma unroll
    for (int i = 0; i < 4; ++i)
#pragma unroll
      for (int qd = 0; qd < 4; ++qd) {
        const int e0 = i * 32 + 8 * qd + 4 * h;
        const float4 g = *(const float4*)(subln_g + e0);
        uint2 w;
        w.x = pack2(O[i][4 * qd] * rinv * g.x, O[i][4 * qd + 1] * rinv * g.y);
        w.y = pack2(O[i][4 * qd + 2] * rinv * g.z, O[i][4 * qd + 3] * rinv * g.w);
        *(uint2*)(op + e0) = w;
      }
  }
  __syncthreads();
}

DI void attention_phase(const Params& p, int vb0, int half, char* shm) {
  const u16* CQ = (const u16*)(p.ws + OFF_CQ); const u16* DQ = (const u16*)(p.ws + OFF_DQ);
  const u16* CKP = (const u16*)(p.ws + OFF_CKP); const u16* CKS = (const u16*)(p.ws + OFF_CKS);
  const u16* CVTP = (const u16*)(p.ws + OFF_CVTP); const u16* CVTS = (const u16*)(p.ws + OFF_CVTS);
  const u16* DKP = (const u16*)(p.ws + OFF_DKP); const u16* DKS = (const u16*)(p.ws + OFF_DKS);
  const u16* DVTP = (const u16*)(p.ws + OFF_DVTP); const u16* DVTS = (const u16*)(p.ws + OFF_DVTS);
  u16* AC = (u16*)(p.ws + OFF_H);
  constexpr size_t QS = (size_t)16 * 8 * 256 * 64;
  const int lane = TIDX & 63;
  const float la = wave_sum(p.in[20][lane] * p.in[21][lane]);
  const float lb = wave_sum(p.in[22][lane] * p.in[23][lane]);
  const float lam = expf(la) - expf(lb) + LAM_INIT;
  const int nblk = (int)gridDim.x;
  for (int it = vb0; it < 768; it += nblk) {
    const bool diff = (it < 256) || (it >= 512 && it < 640);
    const bool samp = it < 512;
    if (diff) {
      int qb, hh, b;
      if (samp) { qb = it & 31; hh = (it >> 5) & 3; b = it >> 7; }
      else { const int i2 = it - 512; qb = i2 & 1; hh = (i2 >> 1) & 3; b = i2 >> 3; }
      const int nseq = samp ? 4096 : 256, nkeys = samp ? 4608 : 256;
      const int tok = samp ? 4096 + b * 4096 + qb * 128 : b * 256 + qb * 128;
      const int hm = hh * 2 + half;
      const size_t qoff = (samp ? QS : 0) + ((size_t)(b * 8 + hm) * nseq + qb * 128) * 64;
      const u16* Kp = (samp ? CKS : CKP) + (size_t)(b * 8 + hm) * nkeys * 64;
      const u16* Vp = (samp ? CVTS : CVTP) + (size_t)(b * 4 + hh) * 128 * nkeys;
      attn_diff_pair(CQ + qoff, Kp, Vp, nkeys, nkeys >> 6, lam, p.in[24], AC + (size_t)tok * 1024 + hh * 128, shm, half);
    } else {
      int qb, hd, b;
      if (samp) { const int i2 = (it - 256) * 2 + half; qb = i2 & 31; hd = (i2 >> 5) & 7; b = i2 >> 8; }
      else { const int i2 = (it - 640) * 2 + half; qb = i2 & 1; hd = (i2 >> 1) & 7; b = i2 >> 4; }
      const int nseq = samp ? 4096 : 256, nkeys = samp ? 4608 : 256;
      const int tok = samp ? 4096 + b * 4096 + qb * 128 : b * 256 + qb * 128;
      const size_t qoff = (samp ? QS : 0) + ((size_t)(b * 8 + hd) * nseq + qb * 128) * 64;
      const u16* Kp = (samp ? DKS : DKP) + (size_t)(b * 2 + (hd >> 2)) * nkeys * 64;
      const u16* Vp = (samp ? DVTS : DVTP) + (size_t)(b * 2 + (hd >> 2)) * 64 * nkeys;
      int nt0 = 4, key1 = 0, nt1 = 0;
      if (samp) { const int lo = min(max(qb * 128 - 128, 0), 4096 - 384); nt0 = 8; key1 = 512 + lo; nt1 = 6; }
      attn_item<64>(DQ + qoff, Kp, Vp, nkeys, nt0, key1, nt1, samp, qb * 128, true, p.in[27][hd] * LOG2E, AC + (size_t)tok * 1024 + 512 + hd * 64, 1024, shm + half * LDS_BYTES);
    }
  }
}

namespace pg8 {
#define PG8_LAS __attribute__((address_space(3)))
typedef unsigned short bf16_t;
typedef short bf16x8 __attribute__((ext_vector_type(8)));
typedef float f32x4 __attribute__((ext_vector_type(4)));
typedef unsigned u32x4 __attribute__((ext_vector_type(4)));
constexpr int BM = 256, BK = 64, HALF = 128, HTB = HALF * BK * 2  , STAGE_BYTES = 8 * HTB, NXCD = 8, WGM = 8;

__host__ __device__ __forceinline__ int lds_byte(int r, int c) { const int st = (r >> 4) * 2 + (c >> 5), rr = r & 15, cc = c & 31, ob = rr * 64 + cc * 2; return st * 1024 + (ob ^ (((ob >> 9) & 1) << 5)); }
__host__ __device__ __forceinline__ void stage_rc(int b, int& R, int& C) { const int st = b / 1024, sb = b % 1024, swz = sb ^ (((sb >> 9) & 1) << 5); R = (st >> 1) * 16 + swz / 64; C = (st & 1) * 32 + (swz % 64) / 2; }
__host__ __device__ __forceinline__ int perm32(int rho) { const int n = rho >> 4, i = rho & 15; return 8 * (i >> 2) + 4 * n + (i & 3); }

struct Unit { int pm, pn; };
struct Gemm { const bf16_t* A; const bf16_t* Bt; int M, N, K; };

struct StaticOrder {
    int nM, nN, nwg, G, c;
    __host__ __device__ void init(int M, int N, int G_, int c_) { nM = M / BM; nN = N / BM; nwg = nM * nN; G = G_; c = c_; }
    __host__ __device__ bool next(int i, Unit& u) const {
        const long L = (long)i * G + c; if (L >= nwg) return false;
        int wgid = (int)L; { const int q = nwg / NXCD, r = nwg % NXCD, xcd = wgid % NXCD, off = wgid / NXCD; wgid = (xcd < r ? xcd * (q + 1) : r * (q + 1) + (xcd - r) * q) + off; }
        const int nig = WGM * nN, gid = wgid / nig, fm = gid * WGM, gsz = (nM - fm) < WGM ? (nM - fm) : WGM;
        u.pm = fm + ((wgid % nig) % gsz); u.pn = (wgid % nig) / gsz; return true;
    }
    __device__ __forceinline__ void a_ready(const Unit&) const {}
    __device__ __forceinline__ void done(const Unit&) const {}
};
template <class Epi, class Sched, bool STAMP = false, int MB = 4>
__device__ __forceinline__ void gemm_phase(PG8_LAS unsigned char* lds, const Gemm g, const Sched& S, const Epi& E, unsigned long long* stamps) {
    const int tid = threadIdx.x, wid = __builtin_amdgcn_readfirstlane(tid >> 6), lane = tid & 63, wr = wid >> 2, wc = wid & 3, fr = lane & 15, fq = lane >> 4;
    const int K = g.K, nt = K / BK;
    int ts_lo = 0, ts_hi = 0, nts = 0; const unsigned long long rt_entry = STAMP ? (unsigned long long)wall_clock64() : 0ull;
#define PG8_STAMP() do { if (STAMP && wid == 0 && nts < 64) { const unsigned long long _c = (unsigned long long)clock64(); \
        ts_lo = (lane == nts) ? (int)(unsigned)_c : ts_lo; ts_hi = (lane == nts) ? (int)(unsigned)(_c >> 32) : ts_hi; ++nts; } } while (0)
    PG8_STAMP();
    unsigned voffA[2], voffB[2], voffB1[2];
#pragma unroll
    for (int i = 0; i < 2; ++i) { int R, C; stage_rc(tid * 16 + i * 8192, R, C); const int Rb = Epi::PERM ? ((R & ~31) + perm32(R & 31)) : R;
        voffA[i] = (unsigned)(R * K + C) * 2u; voffB[i] = (unsigned)(Rb * K + C) * 2u; voffB1[i] = voffB[i];
        if constexpr (Epi::HEADPERM) {
            const int rho = R & 31, np = rho >> 4, ii = rho & 15, fqq = ii >> 2, jj = ii & 3;
            const int d0 = 64 * (R >> 5) + 32 * (fqq >> 1) + 8 * (fqq & 1) + 4 * np + jj;
            voffB[i] = (unsigned)(d0 * K + C) * 2u; voffB1[i] = (unsigned)((d0 + 16) * K + C) * 2u; } }
    const size_t hB1 = Epi::HEADPERM ? (size_t)0 : (size_t)HALF * K * 2;
    const size_t kstep = (size_t)(BK * 2);
    const size_t hstep = (size_t)HALF * K * 2; const size_t hstepA = (size_t)(32 * MB) * K * 2;
    const size_t tstep = 2 * hstep; const size_t tstepA = 2 * hstepA;
    const unsigned ldsw = (unsigned)wid * 1024u;
    const int aoff = lds_byte(wr * 16 * MB + fr, fq * 8), boff = lds_byte(wc * 32 + fr, fq * 8);
#define PG8_SA(b, h) (((b) * 2 + (h)) * HTB)
#define PG8_SB(b, h) ((4 + (b) * 2 + (h)) * HTB)
#define PG8_STAGE(bufoff, gbase, voff) do { _Pragma("unroll") for (int _i = 0; _i < 2; ++_i) \
        __builtin_amdgcn_global_load_lds((const unsigned*)((const char*)(gbase) + (voff)[_i]), (PG8_LAS unsigned*)(lds + (bufoff) + ldsw + _i * 8192), 16, 0, 0); } while (0)
#define PG8_LDA(dst, b, h) do { _Pragma("unroll") for (int m = 0; m < MB; ++m) _Pragma("unroll") for (int k = 0; k < 2; ++k) dst[m][k] = *(const PG8_LAS bf16x8*)(lds + PG8_SA(b, h) + aoff + m * 2048 + k * 1024); } while (0)
#define PG8_LDB(dst, b, h) do { _Pragma("unroll") for (int n = 0; n < 2; ++n) _Pragma("unroll") for (int k = 0; k < 2; ++k) dst[n][k] = *(const PG8_LAS bf16x8*)(lds + PG8_SB(b, h) + boff + n * 2048 + k * 1024); } while (0)
#define PG8_MMA(ai, bj, At, Bt) do { __builtin_amdgcn_s_setprio(1); _Pragma("unroll") for (int m = 0; m < MB; ++m) _Pragma("unroll") for (int n = 0; n < 2; ++n) _Pragma("unroll") for (int k = 0; k < 2; ++k) \
        acc[ai][bj][m][n] = __builtin_amdgcn_mfma_f32_16x16x32_bf16(Bt[n][k], At[m][k], acc[ai][bj][m][n], 0, 0, 0); __builtin_amdgcn_s_setprio(0); } while (0)
#define PG8_WAIT_V(n) asm volatile("s_waitcnt vmcnt(" #n ")" ::: "memory")
#define PG8_WAIT_L(n) asm volatile("s_waitcnt lgkmcnt(" #n ")" ::: "memory")
#define PG8_BAR __builtin_amdgcn_s_barrier()
#define PG8_SCHED __builtin_amdgcn_sched_barrier(0)
    Unit cur, nxt; int ui = 0;
    if (!S.next(0, cur)) return;
    f32x4 acc[2][2][MB][2];
#pragma unroll
    for (int a = 0; a < 2; ++a)
#pragma unroll
        for (int b = 0; b < 2; ++b)
#pragma unroll
            for (int m = 0; m < MB; ++m)
#pragma unroll
                for (int n = 0; n < 2; ++n) acc[a][b][m][n] = (f32x4){0.f, 0.f, 0.f, 0.f};
    bf16x8 At[MB][2], B0[2][2], B1[2][2];
    const char* cA = (const char*)g.A + (size_t)cur.pm * tstepA; const char* cB = (const char*)g.Bt + (size_t)cur.pn * tstep;
    S.a_ready(cur);
    PG8_STAGE(PG8_SB(0, 0), cB, voffB); PG8_STAGE(PG8_SA(0, 0), cA, voffA); PG8_STAGE(PG8_SB(0, 1), cB + hB1, voffB1); PG8_STAGE(PG8_SA(0, 1), cA + hstepA, voffA);
    if (wr == 1) PG8_BAR;
    PG8_WAIT_V(4); PG8_BAR;
    PG8_STAGE(PG8_SB(1, 0), cB + kstep, voffB); PG8_STAGE(PG8_SA(1, 0), cA + kstep, voffA); PG8_STAGE(PG8_SB(1, 1), cB + hB1 + kstep, voffB1);
    PG8_WAIT_V(6); PG8_BAR;
    PG8_STAMP();
    for (;;) {
        const bool has_next = S.next(ui + 1, nxt);
        const char* nA = has_next ? (const char*)g.A + (size_t)nxt.pm * tstepA : cA; const char* nB = has_next ? (const char*)g.Bt + (size_t)nxt.pn * tstep : cB;
        for (int t = 0; t < nt; t += 2) {
            const bool last = (t == nt - 2);
            const char* a1 = cA + (size_t)(t + 1) * kstep;
            const char* a2 = last ? nA : cA + (size_t)(t + 2) * kstep; const char* b2 = last ? nB : cB + (size_t)(t + 2) * kstep;
            const char* a3 = a2 + kstep; const char* b3 = b2 + kstep;
            if (last && has_next) S.a_ready(nxt);
            PG8_LDB(B0, 0, 0); PG8_SCHED; PG8_LDA(At, 0, 0); PG8_STAGE(PG8_SA(1, 1), a1 + hstepA, voffA);
            PG8_WAIT_L(8); PG8_BAR; PG8_WAIT_L(0); PG8_MMA(0, 0, At, B0); PG8_BAR; PG8_SCHED;
            PG8_LDB(B1, 0, 1); PG8_STAGE(PG8_SB(0, 0), b2, voffB);
            PG8_BAR; PG8_WAIT_L(0); PG8_MMA(0, 1, At, B1); PG8_BAR;
            PG8_LDA(At, 0, 1); PG8_STAGE(PG8_SA(0, 0), a2, voffA);
            PG8_BAR; PG8_WAIT_L(0); PG8_MMA(1, 0, At, B0); PG8_BAR; PG8_SCHED;
            PG8_STAGE(PG8_SB(0, 1), b2 + hB1, voffB1);
            PG8_WAIT_V(6); PG8_BAR; PG8_MMA(1, 1, At, B1); PG8_BAR;
            PG8_LDB(B0, 1, 0); PG8_SCHED; PG8_LDA(At, 1, 0); PG8_STAGE(PG8_SA(0, 1), a2 + hstepA, voffA);
            PG8_WAIT_L(8); PG8_BAR; PG8_WAIT_L(0); PG8_MMA(0, 0, At, B0); PG8_BAR; PG8_SCHED;
            PG8_LDB(B1, 1, 1); PG8_STAGE(PG8_SB(1, 0), b3, voffB);
            PG8_BAR; PG8_WAIT_L(0); PG8_MMA(0, 1, At, B1); PG8_BAR;
            PG8_LDA(At, 1, 1); PG8_STAGE(PG8_SA(1, 0), a3, voffA);
            PG8_BAR; PG8_WAIT_L(0); PG8_MMA(1, 0, At, B0); PG8_BAR; PG8_SCHED;
            PG8_STAGE(PG8_SB(1, 1), b3 + hB1, voffB1);
            PG8_WAIT_V(6); PG8_BAR; PG8_MMA(1, 1, At, B1); PG8_BAR;
        }
        PG8_STAMP();
        if constexpr (!Epi::AFTER_DRAIN) { E(acc, cur, wr, wc, fr, fq); S.done(cur); }
        PG8_STAMP();
        if (!has_next) break;
#pragma unroll
        for (int a = 0; a < 2; ++a)
#pragma unroll
            for (int b = 0; b < 2; ++b)
#pragma unroll
                for (int m = 0; m < MB; ++m)
#pragma unroll
                    for (int n = 0; n < 2; ++n) acc[a][b][m][n] = (f32x4){0.f, 0.f, 0.f, 0.f};
        cur = nxt; cA = nA; cB = nB; ++ui;
    }
    PG8_WAIT_V(0);
    if (wr == 0) PG8_BAR;
    PG8_BAR;
    if constexpr (Epi::AFTER_DRAIN) { E.fused(acc, cur, wr, wc, fr, fq, lds, wid, lane); S.done(cur); }
    PG8_STAMP();
    if (STAMP && wid == 0) { stamps[lane] = lane < nts ? (((unsigned long long)(unsigned)ts_hi << 32) | (unsigned)ts_lo) : 0ull;
        if (lane == 62) stamps[62] = rt_entry; if (lane == 63) stamps[63] = (unsigned long long)wall_clock64(); }
#undef PG8_STAMP
#undef PG8_SA
#undef PG8_SB
#undef PG8_STAGE
#undef PG8_LDA
#undef PG8_LDB
#undef PG8_MMA
#undef PG8_WAIT_V
#undef PG8_WAIT_L
#undef PG8_BAR
#undef PG8_SCHED
}
}

typedef float f32x4 __attribute__((ext_vector_type(4)));
template <class F, int MB> struct RowEpi {
  static constexpr bool PERM = false, AFTER_DRAIN = false, HEADPERM = false;
  F f;
  DI void operator()(const pg8::f32x4 (&acc)[2][2][MB][2], const pg8::Unit& u, int wr, int wc, int fr, int fq) const {
    const int row0 = u.pm * (64 * MB) + wr * 16 * MB + fr, col0 = u.pn * 256 + wc * 32 + 4 * fq;
#pragma unroll
    for (int ai = 0; ai < 2; ++ai)
#pragma unroll
      for (int m = 0; m < MB; ++m)
#pragma unroll
        for (int bj = 0; bj < 2; ++bj)
#pragma unroll
          for (int n = 0; n < 2; ++n) f(row0 + ai * 32 * MB + m * 16, col0 + bj * 128 + n * 16, acc[ai][bj][m][n]);
  }
};
struct FU {
  u16* UA; u16* PQt;
  DI void operator()(int m, int n, pg8::f32x4 v) const {
    if (n < 512) {
      uint2 w; w.x = pack2(v[0], v[1]); w.y = pack2(v[2], v[3]);
      *(uint2*)(UA + (size_t)m * 512 + n) = w;
    } else {
      const int np = n - 512, g = np >> 8, pq = (np >> 7) & 1, mm = np & 127;
      u16* q; size_t st;
      if (m < 4096) { const int b = m >> 8, nl = m & 255; q = PQt + ((size_t)(b * 512 + g * 128 + mm)) * 512 + pq * 256 + nl; st = 512; }
      else { const int ms = m - 4096, b = ms >> 12, nl = ms & 4095; q = PQt + (size_t)16 * 512 * 512 + ((size_t)(b * 512 + g * 128 + mm)) * 8192 + pq * 4096 + nl; st = 8192; }
      q[0] = f2bf(v[0]); q[st] = f2bf(v[1]); q[2 * st] = f2bf(v[2]); q[3 * st] = f2bf(v[3]);
    }
  }
};
struct FRes {
  const float* xin_p; const float* xin_s; float* X; const float* gate;
  DI void operator()(int m, int n, pg8::f32x4 v) const {
    const float* xi = (m < 4096) ? xin_p + (size_t)m * 1024 + n : xin_s + (size_t)(m - 4096) * 1024 + n;
    const float4 x = *(const float4*)xi;
    const float4 g = *(const float4*)(gate + cond_of(m) * 6144 + n);
    *(float4*)(X + (size_t)m * 1024 + n) = make_float4(x.x + g.x * v[0], x.y + g.y * v[1], x.z + g.z * v[2], x.w + g.w * v[3]);
  }
};
struct FRelu2 {
  u16* C;
  DI void operator()(int m, int n, pg8::f32x4 v) const {
    const float a = fmaxf(v[0], 0.f), b = fmaxf(v[1], 0.f), c = fmaxf(v[2], 0.f), d = fmaxf(v[3], 0.f);
    uint2 w; w.x = pack2(a * a, b * b); w.y = pack2(c * c, d * d);
    *(uint2*)(C + (size_t)m * 4096 + n) = w;
  }
};
struct FQkv {
  u16* QKV; u16* CVtP; u16* CVtS; u16* DVtP; u16* DVtS; float* ncv; float* ndv;
  DI void operator()(int m, int n, pg8::f32x4 v) const {
    const bool is_cv = (n >= 1024 && n < 1536), is_dv = (n >= 2176);
    if (!is_cv && !is_dv) {
      uint2 w; w.x = pack2(v[0], v[1]); w.y = pack2(v[2], v[3]);
      *(uint2*)(QKV + (size_t)m * 2304 + n) = w;
      return;
    }
    const int c = is_cv ? n - 1024 : n - 2176;
    const int feat = is_cv ? 512 : 128;
    u16* q; size_t st;
    if (m < 4096) {
      const int b = m >> 8, nl = m & 255;
      q = (is_cv ? CVtP : DVtP) + ((size_t)(b * feat + c)) * 256 + nl; st = 256;
      *(float4*)((is_cv ? ncv : ndv) + (size_t)m * feat + c) = make_float4(v[0], v[1], v[2], v[3]);
    } else {
      const int ms = m - 4096, b = ms >> 12, nl = ms & 4095;
      q = (is_cv ? CVtS : DVtS) + ((size_t)(b * feat + c)) * 4608 + 512 + nl; st = 4608;
    }
    q[0] = f2bf(v[0]); q[st] = f2bf(v[1]); q[2 * st] = f2bf(v[2]); q[3 * st] = f2bf(v[3]);
  }
};
template <int MB, class F>
DI void big_gemm(PG8_LAS unsigned char* lds, const u16* A, const u16* Bt, int M, int N, int K, F f) {
  pg8::Gemm g{A, Bt, M, N, K};
  pg8::StaticOrder S; S.init(M, N, (int)gridDim.x, (int)blockIdx.x);
  S.nM = M / (64 * MB); S.nwg = S.nM * S.nN;
  RowEpi<F, MB> E{f};
  pg8::gemm_phase<RowEpi<F, MB>, pg8::StaticOrder, false, MB>(lds, g, S, E, nullptr);
}

template <class F, int MB> struct RowEpi8 {
  static constexpr bool PERM = true, AFTER_DRAIN = false, HEADPERM = false;
  F f;
  DI void operator()(const pg8::f32x4 (&acc)[2][2][MB][2], const pg8::Unit& u, int wr, int wc, int fr, int fq) const {
    const int row0 = u.pm * (64 * MB) + wr * 16 * MB + fr, col0 = u.pn * 256 + wc * 32 + 8 * fq;
#pragma unroll
    for (int ai = 0; ai < 2; ++ai)
#pragma unroll
      for (int m = 0; m < MB; ++m)
#pragma unroll
        for (int bj = 0; bj < 2; ++bj) f(row0 + ai * 32 * MB + m * 16, col0 + bj * 128, acc[ai][bj][m][0], acc[ai][bj][m][1]);
  }
};
struct FRelu2x8 {
  u16* C;
  DI void operator()(int m, int n, pg8::f32x4 a, pg8::f32x4 b) const {
    uint4 w;
    float x0 = fmaxf(a[0], 0.f), x1 = fmaxf(a[1], 0.f), x2 = fmaxf(a[2], 0.f), x3 = fmaxf(a[3], 0.f);
    float y0 = fmaxf(b[0], 0.f), y1 = fmaxf(b[1], 0.f), y2 = fmaxf(b[2], 0.f), y3 = fmaxf(b[3], 0.f);
    w.x = pack2(x0 * x0, x1 * x1); w.y = pack2(x2 * x2, x3 * x3); w.z = pack2(y0 * y0, y1 * y1); w.w = pack2(y2 * y2, y3 * y3);
    *(uint4*)(C + (size_t)m * 4096 + n) = w;
  }
};
struct FUx8 {
  u16* UA; u16* PQt;
  DI void operator()(int m, int n, pg8::f32x4 a, pg8::f32x4 b) const {
    if (n < 512) {
      uint4 w; w.x = pack2(a[0], a[1]); w.y = pack2(a[2], a[3]); w.z = pack2(b[0], b[1]); w.w = pack2(b[2], b[3]);
      *(uint4*)(UA + (size_t)m * 512 + n) = w;
    } else {
      const int np = n - 512, g = np >> 8, pq = (np >> 7) & 1, mm = np & 127;
      u16* q; size_t st;
      if (m < 4096) { const int bb = m >> 8, nl = m & 255; q = PQt + ((size_t)(bb * 512 + g * 128 + mm)) * 512 + pq * 256 + nl; st = 512; }
      else { const int ms = m - 4096, bb = ms >> 12, nl = ms & 4095; q = PQt + (size_t)16 * 512 * 512 + ((size_t)(bb * 512 + g * 128 + mm)) * 8192 + pq * 4096 + nl; st = 8192; }
      q[0] = f2bf(a[0]); q[st] = f2bf(a[1]); q[2 * st] = f2bf(a[2]); q[3 * st] = f2bf(a[3]);
      q[4 * st] = f2bf(b[0]); q[5 * st] = f2bf(b[1]); q[6 * st] = f2bf(b[2]); q[7 * st] = f2bf(b[3]);
    }
  }
};
struct FQkvx8 {
  u16* QKV; u16* CVtP; u16* CVtS; u16* DVtP; u16* DVtS; float* ncv; float* ndv;
  DI void operator()(int m, int n, pg8::f32x4 a, pg8::f32x4 b) const {
    const bool is_cv = (n >= 1024 && n < 1536), is_dv = (n >= 2176);
    if (!is_cv && !is_dv) {
      uint4 w; w.x = pack2(a[0], a[1]); w.y = pack2(a[2], a[3]); w.z = pack2(b[0], b[1]); w.w = pack2(b[2], b[3]);
      *(uint4*)(QKV + (size_t)m * 2304 + n) = w;
      return;
    }
    const int c = is_cv ? n - 1024 : n - 2176;
    const int feat = is_cv ? 512 : 128;
    u16* q; size_t st;
    if (m < 4096) {
      const int bb = m >> 8, nl = m & 255;
      q = (is_cv ? CVtP : DVtP) + ((size_t)(bb * feat + c)) * 256 + nl; st = 256;
      float* o = (is_cv ? ncv : ndv) + (size_t)m * feat + c;
      *(float4*)o = make_float4(a[0], a[1], a[2], a[3]);
      *(float4*)(o + 4) = make_float4(b[0], b[1], b[2], b[3]);
    } else {
      const int ms = m - 4096, bb = ms >> 12, nl = ms & 4095;
      q = (is_cv ? CVtS : DVtS) + ((size_t)(bb * feat + c)) * 4608 + 512 + nl; st = 4608;
    }
    q[0] = f2bf(a[0]); q[st] = f2bf(a[1]); q[2 * st] = f2bf(a[2]); q[3 * st] = f2bf(a[3]);
    q[4 * st] = f2bf(b[0]); q[5 * st] = f2bf(b[1]); q[6 * st] = f2bf(b[2]); q[7 * st] = f2bf(b[3]);
  }
};
template <int MB, class F>
DI void big_gemm8(PG8_LAS unsigned char* lds, const u16* A, const u16* Bt, int M, int N, int K, F f) {
  pg8::Gemm g{A, Bt, M, N, K};
  pg8::StaticOrder S; S.init(M, N, (int)gridDim.x, (int)blockIdx.x);
  S.nM = M / (64 * MB); S.nwg = S.nM * S.nN;
  RowEpi8<F, MB> E{f};
  pg8::gemm_phase<RowEpi8<F, MB>, pg8::StaticOrder, false, MB>(lds, g, S, E, nullptr);
}

template <int MB> struct ResNormEpi {
  static constexpr bool PERM = false, AFTER_DRAIN = true, HEADPERM = false;
  const float* xin_p; const float* xin_s; float* X; const float* gate;
  const float* gain; const float* nmods; u16* Hout; float* part; unsigned* cnt;
  DI void operator()(const pg8::f32x4 (&)[2][2][MB][2], const pg8::Unit&, int, int, int, int) const {}
  DI void fused(pg8::f32x4 (&acc)[2][2][MB][2], const pg8::Unit& u, int wr, int wc, int fr, int fq, PG8_LAS unsigned char* lds, int wid, int lane) const {
    constexpr int ROWS = 64 * MB;
    const int tid = (int)threadIdx.x;
    const int rbase = u.pm * ROWS;
    const int row0 = rbase + wr * 16 * MB + fr, col0 = u.pn * 256 + wc * 32 + 4 * fq;
    PG8_LAS float* red = (PG8_LAS float*)lds;
    PG8_LAS float* rinvs = red + ROWS * 4;
#pragma unroll
    for (int ai = 0; ai < 2; ++ai)
#pragma unroll
      for (int m = 0; m < MB; ++m) {
        const int row = row0 + ai * 32 * MB + m * 16;
        const float* xi = (row < 4096) ? xin_p + (size_t)row * 1024 : xin_s + (size_t)(row - 4096) * 1024;
        const float* gp = gate + cond_of(row) * 6144;
        float ss = 0.f;
#pragma unroll
        for (int bj = 0; bj < 2; ++bj)
#pragma unroll
          for (int n = 0; n < 2; ++n) {
            const int col = col0 + bj * 128 + n * 16;
            const float4 x = *(const float4*)(xi + col);
            const float4 g = *(const float4*)(gp + col);
            pg8::f32x4 v = acc[ai][bj][m][n];
            v[0] = x.x + g.x * v[0]; v[1] = x.y + g.y * v[1]; v[2] = x.z + g.z * v[2]; v[3] = x.w + g.w * v[3];
            *(float4*)(X + (size_t)row * 1024 + col) = make_float4(v[0], v[1], v[2], v[3]);
            acc[ai][bj][m][n] = v;
            ss += v[0] * v[0] + v[1] * v[1] + v[2] * v[2] + v[3] * v[3];
          }
        ss += __shfl_xor(ss, 16); ss += __shfl_xor(ss, 32);
        if (fq == 0) red[(row - rbase) * 4 + wc] = ss;
      }
    __syncthreads();
    if (tid < ROWS) {
      const float sum = (red[tid * 4] + red[tid * 4 + 1]) + (red[tid * 4 + 2] + red[tid * 4 + 3]);
      __hip_atomic_store(part + (size_t)u.pn * T + rbase + tid, sum, __ATOMIC_RELAXED, __HIP_MEMORY_SCOPE_AGENT);
    }
    asm volatile("s_waitcnt vmcnt(0)" ::: "memory");
    __syncthreads();
    if (tid == 0) {
      unsigned* c = cnt + (size_t)u.pm * 16;
      __hip_atomic_fetch_add(c, 1u, __ATOMIC_RELAXED, __HIP_MEMORY_SCOPE_AGENT);
      unsigned sp = 0;
      while (__hip_atomic_load(c, __ATOMIC_RELAXED, __HIP_MEMORY_SCOPE_AGENT) < 4u) { __builtin_amdgcn_s_sleep(1); if (++sp > (1u << 22)) break; }
      __builtin_amdgcn_fence(__ATOMIC_ACQUIRE, "agent");
      asm volatile("s_waitcnt vmcnt(0)" ::: "memory");
    }
    __syncthreads();
    if (tid < ROWS) {
      const float* pp = part + rbase + tid;
      const float tot = (__hip_atomic_load(pp, __ATOMIC_RELAXED, __HIP_MEMORY_SCOPE_AGENT) + __hip_atomic_load(pp + T, __ATOMIC_RELAXED, __HIP_MEMORY_SCOPE_AGENT)) +
                        (__hip_atomic_load(pp + 2 * T, __ATOMIC_RELAXED, __HIP_MEMORY_SCOPE_AGENT) + __hip_atomic_load(pp + 3 * T, __ATOMIC_RELAXED, __HIP_MEMORY_SCOPE_AGENT));
      rinvs[tid] = rsqrtf(tot * (1.0f / 1024.0f) + EPS);
    }
    __syncthreads();
#pragma unroll
    for (int ai = 0; ai < 2; ++ai)
#pragma unroll
      for (int m = 0; m < MB; ++m) {
        const int row = row0 + ai * 32 * MB + m * 16;
        const float rv = rinvs[row - rbase];
        const float* md = nmods + cond_of(row) * 6144;
#pragma unroll
        for (int bj = 0; bj < 2; ++bj)
#pragma unroll
          for (int n = 0; n < 2; ++n) {
            const int col = col0 + bj * 128 + n * 16;
            const float4 g = *(const float4*)(gain + col);
            const float4 sh = *(const float4*)(md + col);
            const float4 sc = *(const float4*)(md + 1024 + col);
            const pg8::f32x4 v = acc[ai][bj][m][n];
            uint2 w;
            w.x = pack2(v[0] * rv * g.x * (1.f + sc.x) + sh.x, v[1] * rv * g.y * (1.f + sc.y) + sh.y);
            w.y = pack2(v[2] * rv * g.z * (1.f + sc.z) + sh.z, v[3] * rv * g.w * (1.f + sc.w) + sh.w);
            *(uint2*)(Hout + (size_t)row * 1024 + col) = w;
          }
      }
    __syncthreads();
  }
};
template <int MB>
DI void big_gemm_resnorm(PG8_LAS unsigned char* lds, const u16* A, const u16* Bt, int M, int N, int K, ResNormEpi<MB> E) {
  pg8::Gemm g{A, Bt, M, N, K};
  pg8::StaticOrder S; S.init(M, N, (int)gridDim.x, (int)blockIdx.x);
  S.nM = M / (64 * MB); S.nwg = S.nM * S.nN;
  pg8::gemm_phase<ResNormEpi<MB>, pg8::StaticOrder, false, MB>(lds, g, S, E, nullptr);
}

struct QkvHeadEpi {
  static constexpr bool PERM = false, AFTER_DRAIN = false, HEADPERM = true;
  unsigned char* ws; float* out;
  const float* cqn; const float* ckn; const float* dqn; const float* dkn;
  DI void operator()(const pg8::f32x4 (&acc)[2][2][4][2], const pg8::Unit& u, int wr, int wc, int fr, int fq) const {
    const int hd = u.pn * 4 + wc;
    const int ax = fq >> 1;
    const int dlo = 32 * ax + 8 * (fq & 1);
    const bool isv = (hd >= 16 && hd < 24) || hd >= 34;
    const bool isq = hd < 8 || (hd >= 24 && hd < 32);
    float g0[8], g1[8], frq[8];
#pragma unroll
    for (int e = 0; e < 8; ++e) { g0[e] = 1.f; g1[e] = 1.f; }
    if (hd < 8) {
#pragma unroll
      for (int e = 0; e < 8; ++e) { g0[e] = cqn[dlo + e]; g1[e] = cqn[dlo + 16 + e]; }
    } else if (hd < 16) {
#pragma unroll
      for (int e = 0; e < 8; ++e) { g0[e] = ckn[dlo + e]; g1[e] = ckn[dlo + 16 + e]; }
    } else if (hd >= 24 && hd < 32) {
#pragma unroll
      for (int e = 0; e < 8; ++e) { g0[e] = dqn[dlo + e]; g1[e] = dqn[dlo + 16 + e]; }
    } else if (hd >= 32 && hd < 34) {
#pragma unroll
      for (int e = 0; e < 8; ++e) { g0[e] = dkn[dlo + e]; g1[e] = dkn[dlo + 16 + e]; }
    }
#pragma unroll
    for (int e = 0; e < 8; ++e) {
      frq[e] = exp2f(-(float)(8 * (fq & 1) + e) * (13.287712379549449f / 16.0f)) * 0.15915494309189535f;
    }
    const int row00 = u.pm * 256 + wr * 64 + fr;
    const bool samp = row00 >= 4096;
#pragma unroll
    for (int ai = 0; ai < 2; ++ai)
#pragma unroll
      for (int m = 0; m < 4; ++m) {
        const int row = row00 + ai * 128 + m * 16;
        int b, nl;
        if (!samp) { b = row >> 8; nl = row & 255; } else { b = (row - 4096) >> 12; nl = (row - 4096) & 4095; }
        float x0[8], x1[8];
#pragma unroll
        for (int e = 0; e < 8; ++e) { x0[e] = acc[ai][0][m][e >> 2][e & 3]; x1[e] = acc[ai][1][m][e >> 2][e & 3]; }
        if (isv) {
          const bool cvh = hd < 24;
          const int feat = cvh ? 512 : 128;
          const int c = (cvh ? (hd - 16) : (hd - 34)) * 64 + dlo;
          u16* q; size_t st;
          if (!samp) {
            q = (u16*)(ws + (cvh ? OFF_CVTP : OFF_DVTP)) + ((size_t)(b * feat + c)) * 256 + nl; st = 256;
            float* o = out + (cvh ? OUT_NCV : OUT_NDV) + (size_t)row * feat + c;
            *(float4*)o = make_float4(x0[0], x0[1], x0[2], x0[3]); *(float4*)(o + 4) = make_float4(x0[4], x0[5], x0[6], x0[7]);
            *(float4*)(o + 16) = make_float4(x1[0], x1[1], x1[2], x1[3]); *(float4*)(o + 20) = make_float4(x1[4], x1[5], x1[6], x1[7]);
          } else { q = (u16*)(ws + (cvh ? OFF_CVTS : OFF_DVTS)) + ((size_t)(b * feat + c)) * 4608 + 512 + nl; st = 4608; }
#pragma unroll
          for (int e = 0; e < 8; ++e) { q[e * st] = f2bf(x0[e]); q[(16 + e) * st] = f2bf(x1[e]); }
        } else {
          float ss = 0.f;
#pragma unroll
          for (int e = 0; e < 8; ++e) ss += x0[e] * x0[e] + x1[e] * x1[e];
          ss += __shfl_xor(ss, 16); ss += __shfl_xor(ss, 32);
          const float rinv = rsqrtf(ss * (1.0f / 64.0f) + EPS);
          float o0[8], o1[8];
          const float pos = samp ? (float)(ax ? (nl & 63) : (nl >> 6)) : 0.f;
#pragma unroll
          for (int e = 0; e < 8; ++e) {
            const float y0 = x0[e] * rinv * g0[e], y1 = x1[e] * rinv * g1[e];
            const float rev = pos * frq[e];
            const float cs = samp ? __builtin_amdgcn_cosf(rev) : 1.f, sn = samp ? __builtin_amdgcn_sinf(rev) : 0.f;
            o0[e] = y0 * cs - y1 * sn;
            o1[e] = y1 * cs + y0 * sn;
          }
          if (isq) {
            const int head = hd < 8 ? hd : hd - 24;
            u16* dst = (u16*)(ws + (hd < 8 ? OFF_CQ : OFF_DQ)) + (samp ? (size_t)16 * 8 * 256 * 64 + ((size_t)(b * 8 + head) * 4096 + nl) * 64 : ((size_t)(b * 8 + head) * 256 + nl) * 64) + dlo;
            *(uint4*)dst = make_uint4(pack2(o0[0] * QSCALE, o0[1] * QSCALE), pack2(o0[2] * QSCALE, o0[3] * QSCALE), pack2(o0[4] * QSCALE, o0[5] * QSCALE), pack2(o0[6] * QSCALE, o0[7] * QSCALE));
            *(uint4*)(dst + 16) = make_uint4(pack2(o1[0] * QSCALE, o1[1] * QSCALE), pack2(o1[2] * QSCALE, o1[3] * QSCALE), pack2(o1[4] * QSCALE, o1[5] * QSCALE), pack2(o1[6] * QSCALE, o1[7] * QSCALE));
          } else {
            const bool ckh = hd < 16;
            const int kh = ckh ? hd - 8 : hd - 32, nkh = ckh ? 8 : 2;
            u16* dst = samp ? (u16*)(ws + (ckh ? OFF_CKS : OFF_DKS)) + ((size_t)(b * nkh + kh) * 4608 + 512 + nl) * 64 + dlo
                            : (u16*)(ws + (ckh ? OFF_CKP : OFF_DKP)) + ((size_t)(b * nkh + kh) * 256 + nl) * 64 + dlo;
            *(uint4*)dst = make_uint4(pack2(o0[0], o0[1]), pack2(o0[2], o0[3]), pack2(o0[4], o0[5]), pack2(o0[6], o0[7]));
            *(uint4*)(dst + 16) = make_uint4(pack2(o1[0], o1[1]), pack2(o1[2], o1[3]), pack2(o1[4], o1[5]), pack2(o1[6], o1[7]));
            if (!samp) {
              float* o = out + (ckh ? OUT_NCK + (size_t)row * 512 : OUT_NDK + (size_t)row * 128) + kh * 64 + dlo;
              *(float4*)o = make_float4(o0[0], o0[1], o0[2], o0[3]); *(float4*)(o + 4) = make_float4(o0[4], o0[5], o0[6], o0[7]);
              *(float4*)(o + 16) = make_float4(o1[0], o1[1], o1[2], o1[3]); *(float4*)(o + 20) = make_float4(o1[4], o1[5], o1[6], o1[7]);
            }
          }
        }
      }
  }
};
DI void big_gemm_qkv(PG8_LAS unsigned char* lds, const u16* A, const u16* Bt, int M, int N, int K, QkvHeadEpi E) {
  pg8::Gemm g{A, Bt, M, N, K};
  pg8::StaticOrder S; S.init(M, N, (int)gridDim.x, (int)blockIdx.x);
  pg8::gemm_phase<QkvHeadEpi, pg8::StaticOrder, false, 4>(lds, g, S, E, nullptr);
}

#define XB_TMO      128
#define XB_XCNT(j)  (256  + 64 * (j))
#define XB_XSUB(j)  (1280 + 64 * (j))
#define XB_XGEN(j)  (2304 + 64 * (j))
#define XB_TOP      3328
#define XB_TOPGEN   3392
#define XCD_BAR_WORDS 3456
#define XB_SPIN_CAP (1u << 18)
#define LAS __attribute__((address_space(3)))
DI unsigned xb_ld(unsigned* p)              { return __hip_atomic_load(p, __ATOMIC_RELAXED, __HIP_MEMORY_SCOPE_AGENT); }
DI unsigned xb_add(unsigned* p, unsigned v) { return __hip_atomic_fetch_add(p, v, __ATOMIC_RELAXED, __HIP_MEMORY_SCOPE_AGENT); }
DI unsigned xb_xcc_id() { return (unsigned)__builtin_amdgcn_s_getreg((3 << 11) | 20) & 0xFu; }
#define XB_SPIN(cond, bar) do { unsigned _sp = 0; while (cond) { __builtin_amdgcn_s_sleep(1); \
    if ((++_sp & 255u) == 0u) { if (xb_ld(&(bar)[XB_TMO])) break; if (_sp > XB_SPIN_CAP) { atomicAdd(&(bar)[XB_TMO], 1u); break; } } } } while (0)
struct XcdBarrier { unsigned* bar; unsigned x; volatile LAS unsigned* st; };
DI XcdBarrier xcd_barrier_post(unsigned* bar, volatile LAS unsigned* st) {
  XcdBarrier b; b.bar = bar; b.x = xb_xcc_id(); b.st = st;
  if (threadIdx.x == 0) (void)xb_add(&bar[XB_XCNT(b.x)], 1u);
  return b;
}
DI void xcd_barrier_complete(unsigned* bar, unsigned x, unsigned& nloc, unsigned& nx) {
  const unsigned G = gridDim.x;
  unsigned sum, cnt, mine, sp = 0u;
  for (;;) {
    sum = 0u; cnt = 0u; mine = 0u;
#pragma unroll
    for (unsigned j = 0; j < 16; ++j) { const unsigned c = xb_ld(&bar[XB_XCNT(j)]); sum += c; cnt += (c > 0u) ? 1u : 0u; mine = (j == x) ? c : mine; }
    if (sum == G) break;
    __builtin_amdgcn_s_sleep(1);
    if ((++sp & 255u) == 0u) { if (xb_ld(&bar[XB_TMO])) break; if (sp > XB_SPIN_CAP) { atomicAdd(&bar[XB_TMO], 1u); break; } }
  }
  nloc = mine > 0u ? mine : 1u; nx = cnt > 0u ? cnt : 1u;
}
DI void xcd_barrier(const XcdBarrier& b) {
  asm volatile("s_waitcnt vmcnt(0)" ::: "memory");
  __syncthreads();
  if (threadIdx.x == 0) {
    unsigned* bar = b.bar;
    __builtin_amdgcn_s_waitcnt(0);
    unsigned nloc = b.st[0], nx = b.st[1];
    if (nloc == 0u) { xcd_barrier_complete(bar, b.x, nloc, nx); b.st[0] = nloc; b.st[1] = nx; }
    const unsigned old = xb_add(&bar[XB_XSUB(b.x)], 1u);
    const unsigned gen = old / nloc;
    if (old + 1u == (gen + 1u) * nloc) {
      __builtin_amdgcn_fence(__ATOMIC_RELEASE, "agent");
      asm volatile("s_waitcnt vmcnt(0)" ::: "memory");
      const unsigned og = xb_add(&bar[XB_TOP], 1u);
      const unsigned tg = og / nx;
      if (og + 1u == (tg + 1u) * nx) xb_add(&bar[XB_TOPGEN], 1u);
      else XB_SPIN(xb_ld(&bar[XB_TOPGEN]) == tg, bar);
      __builtin_amdgcn_fence(__ATOMIC_ACQUIRE, "agent");
      xb_add(&bar[XB_XGEN(b.x)], 1u);
      asm volatile("s_waitcnt vmcnt(0)" ::: "memory");
    } else {
      XB_SPIN(xb_ld(&bar[XB_XGEN(b.x)]) == gen, bar);
      __builtin_amdgcn_fence(__ATOMIC_ACQUIRE, "agent");
      asm volatile("s_waitcnt vmcnt(0)" ::: "memory");
    }
  }
  __syncthreads();
}

__global__ void __launch_bounds__(512) fwd_kernel(Params p, int ph_lo, int ph_hi, int dup) {
  extern __shared__ __attribute__((aligned(16))) unsigned char shm[];
  const int half = threadIdx.x >> 8;
  char* lds = (char*)shm + half * LDS_BYTES;
  PG8_LAS unsigned char* lds8 = (PG8_LAS unsigned char*)shm;
  const int G = 2 * (int)gridDim.x;
  int vb0 = blockIdx.x;
  if ((gridDim.x & 7) == 0) vb0 = (blockIdx.x & 7) * (gridDim.x >> 3) + (blockIdx.x >> 3);
  const int vb = 2 * vb0 + half;
  unsigned char* ws = p.ws;
  const float* mods = (const float*)(ws + OFF_MODS);
  float* X = p.out + OUT_Y;
  u16* H = (u16*)(ws + OFF_H);

#define RUNPH(n) ((ONLYPH < 0 || ONLYPH == (n)) && ph_lo <= (n) && (n) < ph_hi)
#define REP(n) _Pragma("unroll 1") for (int rep_ = 0; rep_ < ((DUPPH == (n)) ? ((dup == (n)) ? 2 : 1) : 1); ++rep_)
#define SEAM(n) if (ph_lo < (n) && (n) < ph_hi) xcd_barrier(xb);
  __shared__ uint4 xb_words;
  if (threadIdx.x == 0) xb_words = make_uint4(0u, 0u, 0u, 0u);
  __syncthreads();
  XcdBarrier xb = xcd_barrier_post((unsigned*)(ws + OFF_BAR), (volatile LAS unsigned*)&xb_words);
  if (ph_hi > 1000) cg::this_grid().sync();
  if (RUNPH(0)) REP(0) {
    for (int id = vb; id < 384; id += G) ada_item(p, id, lds);
    prep_transposes(p, vb, G, lds, 0);
    prep_elementwise(p, vb, G);
  }
  SEAM(1)
  if (RUNPH(1)) REP(1) {
    for (int t = vb; t < 128; t += G) {
      const bool f1 = t < 64;
      const int q = t & 63, m0 = (q >> 3) << 7, n0 = (q & 7) << 7;
      const int koff = f1 ? (m0 >> 8) * 128 : n0;
      gemm_tile((f1 ? (const u16*)(ws + OFF_CBD) : (const u16*)(ws + OFF_WOUT_ET)) + koff, f1 ? 512 : 1024,
                (f1 ? (const u16*)(ws + OFF_WINB) : (const u16*)(ws + OFF_BD)) + koff, f1 ? 512 : 1024, 128, m0, n0,
                EpiBf16{f1 ? (u16*)(ws + OFF_WIN_E) + (size_t)512 * 1024 : (u16*)(ws + OFF_WOUT_E), 1024}, lds);
    }
    normmod_phase(p, vb, G, p.in[0], p.in[1], p.in[8], 0, 0);
    if (vb >= 128) prep_transposes(p, vb - 128, G - 128, lds, 1, 0, 832);
  }
  SEAM(2)
  if (RUNPH(2)) REP(2)
  {
    big_gemm8<3>(lds8, H, (const u16*)(ws + OFF_WIN_E), T, 1536, 1024, FUx8{(u16*)(ws + OFF_UA), (u16*)(ws + OFF_PQT)});
    if (blockIdx.x >= 128) prep_transposes(p, ((int)blockIdx.x - 128) * 2 + half, ((int)gridDim.x - 128) * 2, lds, 1, 832, 1856);
  }
  SEAM(3)
  if (RUNPH(3)) REP(3) sym_phase(p, vb, G);
  SEAM(4)
  if (RUNPH(4)) REP(4) {
    const u16* PQT = (const u16*)(ws + OFF_PQT);
    const u16* PEQO = (const u16*)(ws + OFF_PEQO);
    for (int t = vb0; t < 256 + 128; t += (int)gridDim.x) {
      const bool big = t < 256;
      const int q = t - 256, b = q >> 3;
      dft_pair(big ? (const u16*)(ws + OFF_D4096) : (const u16*)(ws + OFF_D256),
               big ? PEQO + (size_t)16 * 512 * 256 : PEQO + (size_t)b * 512 * 256,
               big ? PQT + (size_t)16 * 512 * 512 + 2048 : PQT + (size_t)b * 512 * 512 + 128,
               big ? 8192 : 512, big ? 2048 : 128, big ? (t & 15) << 7 : 0, big ? (t >> 4) << 6 : (q & 7) << 6,
               (u16*)(ws + OFF_AB), big ? 4096 : b * 256, 512, big ? 0.0013810679320049757f : 0.005524271728019903f, (char*)shm, half);
    }
    pool_phase(p, vb, G);
  }
  float* PART = (float*)(ws + OFF_PART);
  unsigned* CNT = (unsigned*)(ws + OFF_CNT);
  SEAM(5)
  if (RUNPH(5))
    big_gemm_resnorm<3>(lds8, (const u16*)(ws + OFF_AB), (const u16*)(ws + OFF_WOUT_E), T, 1024, 1024,
                        ResNormEpi<3>{p.in[0], p.in[1], X, mods + 2048, p.in[9], mods + 3072, H, PART, CNT});
  SEAM(6)
  if (RUNPH(6)) REP(6) big_gemm8<4>(lds8, H, (const u16*)(ws + OFF_W1), T, 4096, 1024, FRelu2x8{(u16*)(ws + OFF_M1)});
  SEAM(7)
  if (RUNPH(7))
    big_gemm_resnorm<3>(lds8, (const u16*)(ws + OFF_M1), (const u16*)(ws + OFF_W2), T, 1024, 4096,
                        ResNormEpi<3>{X, X + (size_t)4096 * 1024, X, mods + 5120, p.in[8] + 1024, mods + 3 * 6144, H, PART + (size_t)4 * T, CNT + 64 * 16});
  SEAM(8)
  if (RUNPH(8)) {
    big_gemm_qkv(lds8, H, (const u16*)(ws + OFF_WIN_O), T, 2304, 1024,
                 QkvHeadEpi{ws, p.out, p.in[18], p.in[19], p.in[25], p.in[26]});
    if (blockIdx.x >= 176) {
      cache_convert(p, ((int)blockIdx.x - 176) * 2 + half, ((int)gridDim.x - 176) * 2);
      prep_transposes(p, ((int)blockIdx.x - 176) * 2 + half, ((int)gridDim.x - 176) * 2, lds, 1, 1856, 2880);
    }
  }
  SEAM(9)
  if (RUNPH(9)) REP(9) attention_phase(p, vb0, half, (char*)shm);
  SEAM(10)
  if (RUNPH(10))
    big_gemm_resnorm<3>(lds8, H, (const u16*)(ws + OFF_WOUT_O), T, 1024, 1024,
                        ResNormEpi<3>{X, X + (size_t)4096 * 1024, X, mods + 3 * 6144 + 2048, p.in[9] + 1024, mods + 3 * 6144 + 3072, (u16*)(ws + OFF_R2), PART + (size_t)8 * T, CNT + 128 * 16});
  SEAM(11)
  if (RUNPH(11)) REP(11) big_gemm8<4>(lds8, (const u16*)(ws + OFF_R2), (const u16*)(ws + OFF_W1) + (size_t)4096 * 1024, T, 4096, 1024, FRelu2x8{(u16*)(ws + OFF_M1)});
  SEAM(12)
  if (RUNPH(12)) REP(12) big_gemm<3>(lds8, (const u16*)(ws + OFF_M1), (const u16*)(ws + OFF_W2) + (size_t)4096 * 1024, T, 1024, 4096, FRes{X, X + (size_t)4096 * 1024, rep_ ? (float*)(ws + OFF_R2) : X, mods + 3 * 6144 + 5120});
}

extern "C" void kernel_launch(void* const* d_in, const int* in_sizes, int n_in, void* d_out, int out_size, void* d_ws, size_t ws_size,
                              hipStream_t stream) {
  constexpr int kDynLds = 2 * LDS_BYTES;
  static int grid = 0;
  if (!grid) {
    int dev = 0, cus = 0, per_cu = 0;
    (void)hipGetDevice(&dev);
    (void)hipDeviceGetAttribute(&cus, hipDeviceAttributeMultiprocessorCount, dev);
    if (hipFuncSetAttribute((const void*)fwd_kernel, hipFuncAttributeMaxDynamicSharedMemorySize, kDynLds) != hipSuccess) fprintf(stderr, "hipFuncSetAttribute(%d) failed\n", kDynLds);
    (void)hipOccupancyMaxActiveBlocksPerMultiprocessor(&per_cu, fwd_kernel, 512, kDynLds);
    if (per_cu < 1) fprintf(stderr, "occupancy query says %d blocks/CU\n", per_cu);
    grid = cus;
    if (ws_size < WS_END) fprintf(stderr, "workspace too small: %zu < %zu\n", ws_size, (size_t)WS_END);
  }
  Params p{};
  for (int i = 0; i < 31; ++i) p.in[i] = (const float*)d_in[i];
  p.out = (float*)d_out;
  p.ws = (unsigned char*)d_ws;
#if ONE_LAUNCH
  hipMemsetAsync((char*)d_ws + OFF_BAR, 0, XCD_BAR_WORDS * 4 + CNT_BYTES, stream);
  int lo = 0, hi = NPH, dup = DUPPH;
  void* args[] = {&p, &lo, &hi, &dup};
  hipError_t e = hipLaunchCooperativeKernel((void*)fwd_kernel, dim3(grid), dim3(512), args, kDynLds, stream);
  if (e != hipSuccess) fprintf(stderr, "cooperative launch failed: %s (grid %d)\n", hipGetErrorString(e), grid);
#else
  for (int ph = 0; ph < NPH; ++ph) hipLaunchKernelGGL(fwd_kernel, dim3(grid), dim3(512), kDynLds, stream, p, ph, ph + 1, -1);
#endif
}
```
